# Optimizing an MI355X kernel written in HIP

```python
import jax
import jax.numpy as jnp
from jax import lax
import numpy as np

D_MODEL = 1024
BATCH = 4
SEQ = 4096
DEPTH = 1

GRID_W = 64
CTX_LEN = 256
D_MIX = D_MODEL
HG_WIDTH = D_MIX // 2
HG_HEAD_DIM = 128
HG_HEADS = HG_WIDTH // HG_HEAD_DIM
ML_WIDTH = D_MIX - HG_WIDTH
ML_HEADS = 4
ML_V_DIM = ML_WIDTH // ML_HEADS
ML_QK_DIM = ML_V_DIM // 2
ML_QK_WIDTH = ML_HEADS * ML_QK_DIM
N_ML_GATES = 4 * ML_HEADS
IN_SIZES = (HG_WIDTH, HG_WIDTH, HG_WIDTH, HG_WIDTH, HG_WIDTH, ML_QK_WIDTH, ML_QK_WIDTH, ML_WIDTH, ML_WIDTH, N_ML_GATES)
D_IN = 5 * HG_WIDTH + 2 * ML_QK_WIDTH + 2 * ML_WIDTH + N_ML_GATES
CONV_K = 3
D_FF = 2816
CHUNK = 64
N_MOD = 9
EPS = 1e-6

kernel_name = 'hybrid_hgrn2_mlstm_macaron_dit_layer'


def rmsnorm(x, w):
    xf = x.astype(jnp.float32)
    y = xf * lax.rsqrt(jnp.mean(xf * xf, axis=-1, keepdims=True) + EPS)
    return (y * w.astype(jnp.float32)).astype(x.dtype)


def head_rmsnorm(x, w, n_heads):
    shp = x.shape
    xf = x.astype(jnp.float32).reshape(shp[:-1] + (n_heads, shp[-1] // n_heads))
    y = xf * lax.rsqrt(jnp.mean(xf * xf, axis=-1, keepdims=True) + EPS)
    return y.reshape(shp) * w.astype(jnp.float32)


def modulate(xn, shift, scale):
    return xn * (1 + scale) + shift


def swiglu(h, w1, w2):
    g, u = jnp.split(h @ w1, 2, axis=-1)
    return (jax.nn.silu(g) * u) @ w2


def split_heads(a, n_heads):
    return a.reshape(a.shape[:-1] + (n_heads, a.shape[-1] // n_heads))


def seg_reverse(a, n_ctx):
    return jnp.concatenate([jnp.flip(a[:, :n_ctx], axis=1), jnp.flip(a[:, n_ctx:], axis=1)], axis=1)


def to_chunks(a):
    bp, t, h, d = a.shape
    return a.reshape(bp, t // CHUNK, CHUNK, h, d).transpose(1, 0, 3, 2, 4)


def gates_to_chunks(g):
    bp, t, h = g.shape
    return g.reshape(bp, t // CHUNK, CHUNK, h).transpose(1, 0, 3, 2)


def from_chunks(a):
    n, bp, h, l, d = a.shape
    return a.transpose(1, 0, 3, 2, 4).reshape(bp, n * l, h, d)


def hgrn2_chunk_scan(q, k, v, log_f):
    bp, _, h, dk = q.shape
    dv = v.shape[-1]
    scan_order = jnp.tril(jnp.ones((CHUNK, CHUNK), dtype=bool))

    def step(state, inp):
        qb, kb, vb, fb = inp
        b = jnp.cumsum(fb, axis=2)
        diff = b[:, :, :, None, :] - b[:, :, None, :, :]
        decay = jnp.exp(jnp.where(scan_order[:, :, None], diff, -jnp.inf))
        scores = jnp.einsum('bhtd,bhtsd,bhsd->bhts', qb, decay, kb)
        o = jnp.einsum('bhts,bhse->bhte', scores, vb) + jnp.einsum('bhtd,bhde->bhte', qb * jnp.exp(b), state)
        b_last = b[:, :, -1:, :]
        state = jnp.exp(b_last[:, :, 0, :, None]) * state + jnp.einsum('bhsd,bhse->bhde', kb * jnp.exp(b_last - b), vb)
        return state, o

    s0 = jnp.zeros((bp, h, dk, dv), jnp.float32)
    _, out = lax.scan(step, s0, (to_chunks(q), to_chunks(k), to_chunks(v), to_chunks(log_f)))
    return from_chunks(out)


def mlstm_chunk_scan(q, k, v, i_pre, log_f):
    bp, _, h, dqk = q.shape
    dv = v.shape[-1]
    scan_order = jnp.tril(jnp.ones((CHUNK, CHUNK), dtype=bool))

    def step(carry, inp):
        c_mem, n_mem, m = carry
        qb, kb, vb, ib, fb = inp
        b = jnp.cumsum(fb, axis=-1)
        d_log = jnp.where(scan_order, b[..., :, None] - b[..., None, :] + ib[..., None, :], -jnp.inf)
        inter_log = b + m[..., None]
        m_t = jnp.maximum(jnp.max(d_log, axis=-1), inter_log)
        w = jnp.exp(d_log - m_t[..., None])
        inter_w = jnp.exp(inter_log - m_t)
        qk = jnp.einsum('bhtd,bhsd->bhts', qb, kb) * w
        num = jnp.einsum('bhts,bhse->bhte', qk, vb) + inter_w[..., None] * jnp.einsum('bhtd,bhde->bhte', qb, c_mem)
        den = jnp.sum(qk, axis=-1) + inter_w * jnp.einsum('bhtd,bhd->bht', qb, n_mem)
        h_out = num / jnp.maximum(jnp.abs(den), jnp.exp(-m_t))[..., None]
        b_last = b[..., -1]
        state_log = b_last[..., None] - b + ib
        m_new = jnp.maximum(b_last + m, jnp.max(state_log, axis=-1))
        carry_w = jnp.exp(b_last + m - m_new)
        s_w = jnp.exp(state_log - m_new[..., None])
        c_mem = carry_w[..., None, None] * c_mem + jnp.einsum('bhs,bhsd,bhse->bhde', s_w, kb, vb)
        n_mem = carry_w[..., None] * n_mem + jnp.einsum('bhs,bhsd->bhd', s_w, kb)
        return (c_mem, n_mem, m_new), h_out

    init = (jnp.zeros((bp, h, dqk, dv), jnp.float32), jnp.zeros((bp, h, dqk), jnp.float32), jnp.zeros((bp, h), jnp.float32))
    _, out = lax.scan(step, init, (to_chunks(q), to_chunks(k), to_chunks(v), gates_to_chunks(i_pre), gates_to_chunks(log_f)))
    return from_chunks(out)


def short_conv(a, w, b, n_ctx):
    w = w.astype(a.dtype)
    a_ctx, a_lat = a[:, :n_ctx], a[:, n_ctx:]
    bsz, s_lat, ch = a_lat.shape
    rows = s_lat // GRID_W
    lat = lax.conv_general_dilated(a_lat.reshape(bsz, rows, GRID_W, ch), w[:, :, None, :], (1, 1), 'SAME',
                                   dimension_numbers=('NHWC', 'HWIO', 'NHWC'), feature_group_count=ch)
    ctx = lax.conv_general_dilated(a_ctx, w[CONV_K // 2][:, None, :], (1,), 'SAME',
                                   dimension_numbers=('NWC', 'WIO', 'NWC'), feature_group_count=ch)
    return jnp.concatenate([ctx, lat.reshape(bsz, s_lat, ch)], axis=1) + b


def parallel_mixer(h_ctx, h_lat, w_in, ml_gate_b, conv_w, conv_b, lb, hg_norm_w, ml_norm_w, w_out, lat_only):
    f32 = jnp.float32
    n_ctx = h_ctx.shape[1]
    bsz = h_lat.shape[0]
    out_dtype = h_lat.dtype
    h_all = jnp.concatenate([h_ctx, h_lat], axis=1)
    proj = h_all @ w_in
    splits = [int(s) for s in np.cumsum(IN_SIZES)[:-1]]
    hg_q, hg_i, hg_g, hg_f_fwd, hg_f_bwd, ml_q, ml_k, ml_v, ml_o, ml_gates = jnp.split(proj, splits, axis=-1)

    def both_dirs(a):
        return jnp.concatenate([a, seg_reverse(a, n_ctx)], axis=0)

    def merge_dirs(o):
        return o[:bsz] + seg_reverse(o[bsz:], n_ctx)

    q = split_heads(jax.nn.silu(hg_q.astype(f32)) * HG_HEAD_DIM ** -0.5, HG_HEADS)
    v = split_heads(hg_i.astype(f32), HG_HEADS)
    lb_dir = jnp.repeat(lb, bsz, axis=0)[:, None, :]
    f_pre = jnp.concatenate([hg_f_fwd, seg_reverse(hg_f_bwd, n_ctx)], axis=0).astype(f32)
    log_f = jnp.log(lb_dir + (1 - lb_dir) * jax.nn.sigmoid(f_pre))
    k_in = (1 - lb_dir) * jax.nn.sigmoid(-f_pre)
    hg_o = hgrn2_chunk_scan(both_dirs(q), split_heads(k_in, HG_HEADS), both_dirs(v), split_heads(log_f, HG_HEADS))
    hg_o = merge_dirs(hg_o).reshape(bsz, -1, HG_WIDTH)
    hg_out = head_rmsnorm(hg_o, hg_norm_w, HG_HEADS) * jax.nn.silu(hg_g.astype(f32))

    qk = jax.nn.silu(short_conv(jnp.concatenate([ml_q, ml_k], axis=-1), conv_w, conv_b, n_ctx)).astype(f32)
    mq, mk = jnp.split(qk, 2, axis=-1)
    mq = split_heads(mq * ML_QK_DIM ** -0.5, ML_HEADS)
    mk = split_heads(mk, ML_HEADS)
    mv = split_heads(ml_v.astype(f32), ML_HEADS)
    gates = ml_gates.astype(f32) + ml_gate_b.astype(f32)
    i_fwd, f_fwd, i_bwd, f_bwd = jnp.split(gates, 4, axis=-1)
    i_dir = jnp.concatenate([i_fwd, seg_reverse(i_bwd, n_ctx)], axis=0)
    logf_dir = jax.nn.log_sigmoid(jnp.concatenate([f_fwd, seg_reverse(f_bwd, n_ctx)], axis=0))
    ml_h = mlstm_chunk_scan(both_dirs(mq), both_dirs(mk), both_dirs(mv), i_dir, logf_dir)
    ml_h = merge_dirs(ml_h).reshape(bsz, -1, ML_WIDTH)
    ml_out = jax.nn.sigmoid(ml_o.astype(f32)) * head_rmsnorm(ml_h, ml_norm_w, ML_HEADS)

    merged = jnp.concatenate([hg_out, ml_out], axis=-1).astype(out_dtype)
    lat_out = merged[:, n_ctx:] @ w_out
    ctx_out = None if lat_only else merged[:, :n_ctx] @ w_out
    return ctx_out, lat_out


def setup_inputs(seed: int = 0) -> dict:
    key = jax.random.key(seed)
    ks = jax.random.split(key, 26)
    nrm = jax.random.normal
    f32 = jnp.float32

    def gain(k, shape):
        return 1.0 + 0.01 * nrm(k, shape, f32)

    def fbias(k):
        return 3.0 + 3.0 * jax.random.uniform(k, (DEPTH, ML_HEADS), f32)

    ml_gate_b = jnp.concatenate([0.1 * nrm(ks[10], (DEPTH, ML_HEADS), f32), fbias(ks[11]),
                                 0.1 * nrm(ks[12], (DEPTH, ML_HEADS), f32), fbias(ks[13])], axis=-1)
    return {
        'x': nrm(ks[0], (BATCH, SEQ, D_MODEL), f32),
        'c': nrm(ks[1], (BATCH, D_MODEL), f32),
        'ctx': nrm(ks[2], (BATCH, CTX_LEN, D_MODEL), f32),
        'c_ctx': nrm(ks[3], (D_MODEL,), f32),
        'w_mod': nrm(ks[4], (DEPTH, D_MODEL, N_MOD * D_MODEL), f32) * D_MODEL ** -0.5,
        'b_mod': 0.01 * nrm(ks[5], (DEPTH, N_MOD * D_MODEL), f32),
        'norm1_w': gain(ks[6], (DEPTH, D_MODEL)),
        'ffn1_w1': nrm(ks[7], (DEPTH, D_MODEL, 2 * D_FF), f32) * D_MODEL ** -0.5,
        'ffn1_w2': nrm(ks[8], (DEPTH, D_FF, D_MODEL), f32) * D_FF ** -0.5,
        'norm2_w': gain(ks[9], (DEPTH, D_MODEL)),
        'w_in': nrm(ks[14], (DEPTH, D_MODEL, D_IN), f32) * D_MODEL ** -0.5,
        'ml_gate_b': ml_gate_b,
        'ml_conv_w': nrm(ks[15], (DEPTH, CONV_K, CONV_K, 2 * ML_QK_WIDTH), f32) / CONV_K,
        'ml_conv_b': 0.01 * nrm(ks[16], (DEPTH, 2 * ML_QK_WIDTH), f32),
        'hg_lb_logits': 0.5 * nrm(ks[17], (DEPTH + 1, 2, HG_WIDTH), f32),
        'hg_norm_w': gain(ks[18], (DEPTH, HG_WIDTH)),
        'ml_norm_w': gain(ks[19], (DEPTH, ML_WIDTH)),
        'w_out': nrm(ks[20], (DEPTH, D_MIX, D_MODEL), f32) * D_MIX ** -0.5,
        'norm3_w': gain(ks[21], (DEPTH, D_MODEL)),
        'ffn2_w1': nrm(ks[22], (DEPTH, D_MODEL, 2 * D_FF), f32) * D_MODEL ** -0.5,
        'ffn2_w2': nrm(ks[23], (DEPTH, D_FF, D_MODEL), f32) * D_FF ** -0.5,
        'final_norm_w': gain(ks[24], (D_MODEL,)),
    }


def reference(x, c, ctx, c_ctx, w_mod, b_mod, norm1_w, ffn1_w1, ffn1_w2, norm2_w, w_in, ml_gate_b,
              ml_conv_w, ml_conv_b, hg_lb_logits, hg_norm_w, ml_norm_w, w_out, norm3_w, ffn2_w1, ffn2_w2,
              final_norm_w):
    lb_all = jnp.cumsum(jax.nn.softmax(hg_lb_logits.astype(jnp.float32), axis=0), axis=0)
    s_ctx = ctx

    def ffn_sub(s, mods, nw, w1, w2):
        shift, scale, gate = mods
        return s + 0.5 * gate * swiglu(modulate(rmsnorm(s, nw), shift, scale), w1, w2)

    for l in range(DEPTH):
        last = l == DEPTH - 1
        mod_lat = jnp.split((jax.nn.silu(c) @ w_mod[l] + b_mod[l])[:, None, :], N_MOD, axis=-1)
        mod_ctx = jnp.split(jax.nn.silu(c_ctx) @ w_mod[l] + b_mod[l], N_MOD, axis=-1)

        x = ffn_sub(x, mod_lat[0:3], norm1_w[l], ffn1_w1[l], ffn1_w2[l])
        s_ctx = ffn_sub(s_ctx, mod_ctx[0:3], norm1_w[l], ffn1_w1[l], ffn1_w2[l])

        h_lat = modulate(rmsnorm(x, norm2_w[l]), mod_lat[3], mod_lat[4])
        h_ctx = modulate(rmsnorm(s_ctx, norm2_w[l]), mod_ctx[3], mod_ctx[4])
        ctx_mix, lat_mix = parallel_mixer(h_ctx, h_lat, w_in[l], ml_gate_b[l], ml_conv_w[l], ml_conv_b[l],
                                          lb_all[l], hg_norm_w[l], ml_norm_w[l], w_out[l], last)
        x = x + mod_lat[5] * lat_mix

        x = ffn_sub(x, mod_lat[6:9], norm3_w[l], ffn2_w1[l], ffn2_w2[l])
        if not last:
            s_ctx = s_ctx + mod_ctx[5] * ctx_mix
            s_ctx = ffn_sub(s_ctx, mod_ctx[6:9], norm3_w[l], ffn2_w1[l], ffn2_w2[l])

    return rmsnorm(x, final_norm_w)
```

```cpp
#include <hip/hip_runtime.h>
#include <cstdio>
#include <cstdint>
namespace pg8 {
#define PG8_LAS __attribute__((address_space(3)))
typedef unsigned short bf16_t;
typedef short bf16x8 __attribute__((ext_vector_type(8)));
typedef float f32x4 __attribute__((ext_vector_type(4)));
typedef unsigned u32x4 __attribute__((ext_vector_type(4)));
constexpr int BM = 256, BK = 64, HALF = 128, HTB = HALF * BK * 2  , STAGE_BYTES = 8 * HTB, NXCD = 8, WGM = 8;

__host__ __device__ __forceinline__ int lds_byte(int r, int c) { const int st = (r >> 4) * 2 + (c >> 5), rr = r & 15, cc = c & 31, ob = rr * 64 + cc * 2; return st * 1024 + (ob ^ (((ob >> 9) & 1) << 5)); }
__host__ __device__ __forceinline__ void stage_rc(int b, int& R, int& C) { const int st = b / 1024, sb = b % 1024, swz = sb ^ (((sb >> 9) & 1) << 5); R = (st >> 1) * 16 + swz / 64; C = (st & 1) * 32 + (swz % 64) / 2; }
__host__ __device__ __forceinline__ int perm32(int rho) { const int n = rho >> 4, i = rho & 15; return 8 * (i >> 2) + 4 * n + (i & 3); }

struct Unit { int pm, pn; };
struct Gemm { const bf16_t* A; const bf16_t* Bt; int M, N, K; };

struct StaticOrder {
    int nM, nN, nwg, G, c;
    __host__ __device__ void init(int M, int N, int G_, int c_) { nM = M / BM; nN = N / BM; nwg = nM * nN; G = G_; c = c_; }
    __host__ __device__ bool next(int i, Unit& u) const {
        const long L = (long)i * G + c; if (L >= nwg) return false;
        int wgid = (int)L; { const int q = nwg / NXCD, r = nwg % NXCD, xcd = wgid % NXCD, off = wgid / NXCD; wgid = (xcd < r ? xcd * (q + 1) : r * (q + 1) + (xcd - r) * q) + off; }
        const int nig = WGM * nN, gid = wgid / nig, fm = gid * WGM, gsz = (nM - fm) < WGM ? (nM - fm) : WGM;
        u.pm = fm + ((wgid % nig) % gsz); u.pn = (wgid % nig) / gsz; return true;
    }
    __device__ __forceinline__ void a_ready(const Unit&) const {}
    __device__ __forceinline__ void done(const Unit&) const {}
};
__device__ __forceinline__ unsigned cvt_pk_bf16(float lo, float hi) { unsigned r; asm volatile("v_cvt_pk_bf16_f32 %0, %1, %2" : "=v"(r) : "v"(lo), "v"(hi)); return r; }
typedef float f32x2 __attribute__((ext_vector_type(2)));
__device__ __forceinline__ float fast_sigmoid(float v) { return __builtin_amdgcn_rcpf(1.0f + __builtin_amdgcn_exp2f(-1.4426950408889634f * v)); }
__device__ __forceinline__ float fast_silu(float v) { return v * fast_sigmoid(v); }

struct EpiSwiglu {
    static constexpr bool PERM = true, AFTER_DRAIN = false;
    bf16_t* H; int ldh;
    __device__ __forceinline__ void operator()(const f32x4 (&acc)[2][2][4][2], const Unit& u, int wr, int wc, int fr, int fq) const {
        const int row0 = u.pm * BM + wr * 64 + fr, col0 = u.pn * HALF + wc * 32 + 8 * fq;
#pragma unroll
        for (int ai = 0; ai < 2; ++ai)
#pragma unroll
            for (int m = 0; m < 4; ++m) { bf16_t* rowp = H + (size_t)(row0 + ai * HALF + m * 16) * ldh + col0;
                float r[8];
#pragma unroll
                for (int n = 0; n < 2; ++n)
#pragma unroll
                    for (int i = 0; i < 4; ++i) r[n * 4 + i] = fast_silu(acc[ai][0][m][n][i]) * acc[ai][1][m][n][i];
                u32x4 w; w.x = cvt_pk_bf16(r[0], r[1]); w.y = cvt_pk_bf16(r[2], r[3]); w.z = cvt_pk_bf16(r[4], r[5]); w.w = cvt_pk_bf16(r[6], r[7]);
                *(u32x4*)rowp = w; }
    }
};

struct EpiResid {
    static constexpr bool PERM = false, AFTER_DRAIN = false;
    const float* base_lat; const float* base_ctx; float* out_lat; float* out_ctx; const float* gate; float coef;
    __device__ __forceinline__ void operator()(const f32x4 (&acc)[2][2][4][2], const Unit& u, int wr, int wc, int fr, int fq) const {
        const bool isctx = u.pm >= 64;
        const float* base = isctx ? base_ctx + (size_t)(u.pm - 64) * BM * 1024 : base_lat + (size_t)u.pm * BM * 1024;
        float* out = isctx ? out_ctx + (size_t)(u.pm - 64) * BM * 1024 : out_lat + (size_t)u.pm * BM * 1024;
        const float* g = gate + (size_t)(isctx ? 4 : (u.pm >> 4)) * 9216;
        const int col0 = u.pn * BM + wc * 32 + 4 * fq;
        f32x4 gv[2][2];
#pragma unroll
        for (int bj = 0; bj < 2; ++bj)
#pragma unroll
            for (int n = 0; n < 2; ++n) gv[bj][n] = *(const f32x4*)(g + col0 + bj * HALF + n * 16) * coef;
#pragma unroll
        for (int ai = 0; ai < 2; ++ai)
#pragma unroll
            for (int m = 0; m < 4; ++m) { const size_t off = (size_t)(ai * HALF + wr * 64 + m * 16 + fr) * 1024 + col0;
#pragma unroll
                for (int bj = 0; bj < 2; ++bj)
#pragma unroll
                    for (int n = 0; n < 2; ++n) { const f32x4 b = *(const f32x4*)(base + off + bj * HALF + n * 16);
                        *(f32x4*)(out + off + bj * HALF + n * 16) = b + gv[bj][n] * acc[ai][bj][m][n]; } }
    }
};

struct EpiProj {
    static constexpr bool PERM = true, AFTER_DRAIN = false;
    bf16_t* O; int ldc;
    __device__ __forceinline__ void operator()(const f32x4 (&acc)[2][2][4][2], const Unit& u, int wr, int wc, int fr, int fq) const {
        const int row0 = u.pm * BM + wr * 64 + fr, col0 = u.pn * BM + wc * 32 + 8 * fq;
        const int mode = (u.pn < 2) ? 1 : ((u.pn == 4 || u.pn == 5) ? 2 : (u.pn >= 14 ? 3 : 0));
#pragma unroll
        for (int ai = 0; ai < 2; ++ai)
#pragma unroll
            for (int m = 0; m < 4; ++m) { bf16_t* rowp = O + (size_t)(row0 + ai * HALF + m * 16) * ldc + col0;
#pragma unroll
                for (int bj = 0; bj < 2; ++bj) { float r[8];
#pragma unroll
                    for (int n = 0; n < 2; ++n)
#pragma unroll
                        for (int i = 0; i < 4; ++i) { const float v = acc[ai][bj][m][n][i];
                            r[n * 4 + i] = mode == 0 ? v : (mode == 1 ? fast_silu(v) * 0.08838834764831845f : (mode == 2 ? fast_silu(v) : fast_sigmoid(v))); }
                    u32x4 w; w.x = cvt_pk_bf16(r[0], r[1]); w.y = cvt_pk_bf16(r[2], r[3]); w.z = cvt_pk_bf16(r[4], r[5]); w.w = cvt_pk_bf16(r[6], r[7]);
                    *(u32x4*)(rowp + bj * HALF) = w; } }
    }
};
template <class Epi, class Sched, bool ALIGN_EPI = false, bool SP2 = false>
__device__ __forceinline__ void gemm_phase(PG8_LAS unsigned char* lds, const Gemm g, const Sched& S, const Epi& E) {
    const int tid = threadIdx.x, wid = __builtin_amdgcn_readfirstlane(tid >> 6), lane = tid & 63, wr = wid >> 2, wc = wid & 3, fr = lane & 15, fq = lane >> 4;
    const int K = g.K, nt = K / BK;
    unsigned voffA[2], voffB[2];
#pragma unroll
    for (int i = 0; i < 2; ++i) { int R, C; stage_rc(tid * 16 + i * 8192, R, C); const int Rb = Epi::PERM ? ((R & ~31) + perm32(R & 31)) : R;
        voffA[i] = (unsigned)(R * K + C) * 2u; voffB[i] = (unsigned)(Rb * K + C) * 2u; }
    const size_t kstep = (size_t)(BK * 2);
    const size_t hstep = (size_t)HALF * K * 2;
    const size_t tstep = 2 * hstep;
    const unsigned ldsw = (unsigned)wid * 1024u;
    const int aoff = lds_byte(wr * 64 + fr, fq * 8), boff = lds_byte(wc * 32 + fr, fq * 8);
#define PG8_SA(b, h) (((b) * 2 + (h)) * HTB)
#define PG8_SB(b, h) ((4 + (b) * 2 + (h)) * HTB)
#define PG8_STAGE(bufoff, gbase, voff) do { _Pragma("unroll") for (int _i = 0; _i < 2; ++_i) \
        __builtin_amdgcn_global_load_lds((const unsigned*)((const char*)(gbase) + (voff)[_i]), (PG8_LAS unsigned*)(lds + (bufoff) + ldsw + _i * 8192), 16, 0, 0); } while (0)
#define PG8_LDA(dst, b, h) do { _Pragma("unroll") for (int m = 0; m < 4; ++m) _Pragma("unroll") for (int k = 0; k < 2; ++k) dst[m][k] = *(const PG8_LAS bf16x8*)(lds + PG8_SA(b, h) + aoff + m * 2048 + k * 1024); } while (0)
#define PG8_LDB(dst, b, h) do { _Pragma("unroll") for (int n = 0; n < 2; ++n) _Pragma("unroll") for (int k = 0; k < 2; ++k) dst[n][k] = *(const PG8_LAS bf16x8*)(lds + PG8_SB(b, h) + boff + n * 2048 + k * 1024); } while (0)
#define PG8_MMA(ai, bj, At, Bt) do { __builtin_amdgcn_s_setprio(1); _Pragma("unroll") for (int m = 0; m < 4; ++m) _Pragma("unroll") for (int n = 0; n < 2; ++n) _Pragma("unroll") for (int k = 0; k < 2; ++k) \
        acc[ai][bj][m][n] = __builtin_amdgcn_mfma_f32_16x16x32_bf16(Bt[n][k], At[m][k], acc[ai][bj][m][n], 0, 0, 0); __builtin_amdgcn_s_setprio(0); } while (0)
#define PG8_WAIT_V(n) asm volatile("s_waitcnt vmcnt(" #n ")" ::: "memory")
#define PG8_WAIT_L(n) asm volatile("s_waitcnt lgkmcnt(" #n ")" ::: "memory")
#define PG8_BAR __builtin_amdgcn_s_barrier()
#define PG8_SCHED __builtin_amdgcn_sched_barrier(0)
    Unit cur, nxt; int ui = 0;
    if (!S.next(0, cur)) return;
    f32x4 acc[2][2][4][2];
#pragma unroll
    for (int a = 0; a < 2; ++a)
#pragma unroll
        for (int b = 0; b < 2; ++b)
#pragma unroll
            for (int m = 0; m < 4; ++m)
#pragma unroll
                for (int n = 0; n < 2; ++n) acc[a][b][m][n] = (f32x4){0.f, 0.f, 0.f, 0.f};
    bf16x8 At[4][2], B0[2][2], B1[2][2];
    const char* cA = (const char*)g.A + (size_t)cur.pm * tstep; const char* cB = (const char*)g.Bt + (size_t)cur.pn * tstep;
    S.a_ready(cur);
    if constexpr (SP2) {
        PG8_STAGE(PG8_SB(0, 0), cB, voffB); PG8_STAGE(PG8_SB(0, 1), cB + hstep, voffB); PG8_STAGE(PG8_SA(0, 0), cA, voffA); PG8_STAGE(PG8_SA(0, 1), cA + hstep, voffA);
        if (wr == 1) PG8_BAR;
        PG8_WAIT_V(2); PG8_BAR;
        PG8_STAGE(PG8_SB(1, 0), cB + kstep, voffB); PG8_STAGE(PG8_SA(1, 0), cA + kstep, voffA); PG8_STAGE(PG8_SB(1, 1), cB + hstep + kstep, voffB);
        PG8_WAIT_V(6); PG8_BAR;
    } else {
        PG8_STAGE(PG8_SB(0, 0), cB, voffB); PG8_STAGE(PG8_SA(0, 0), cA, voffA); PG8_STAGE(PG8_SB(0, 1), cB + hstep, voffB); PG8_STAGE(PG8_SA(0, 1), cA + hstep, voffA);
        if (wr == 1) PG8_BAR;
        PG8_WAIT_V(4); PG8_BAR;
        PG8_STAGE(PG8_SB(1, 0), cB + kstep, voffB); PG8_STAGE(PG8_SA(1, 0), cA + kstep, voffA); PG8_STAGE(PG8_SB(1, 1), cB + hstep + kstep, voffB);
        PG8_WAIT_V(6); PG8_BAR;
    }
    for (;;) {
        const bool has_next = S.next(ui + 1, nxt);
        const char* nA = has_next ? (const char*)g.A + (size_t)nxt.pm * tstep : cA; const char* nB = has_next ? (const char*)g.Bt + (size_t)nxt.pn * tstep : cB;
        for (int t = 0; t < nt; t += 2) {
            const bool last = (t == nt - 2);
            const char* a1 = cA + (size_t)(t + 1) * kstep;
            const char* a2 = last ? nA : cA + (size_t)(t + 2) * kstep; const char* b2 = last ? nB : cB + (size_t)(t + 2) * kstep;
            const char* a3 = a2 + kstep; const char* b3 = b2 + kstep;
            if (last && has_next) S.a_ready(nxt);
            if constexpr (SP2) {
            PG8_LDB(B0, 0, 0); PG8_LDB(B1, 0, 1); PG8_SCHED; PG8_LDA(At, 0, 0); PG8_STAGE(PG8_SA(1, 1), a1 + hstep, voffA);
            PG8_WAIT_V(8); PG8_WAIT_L(0); PG8_BAR; PG8_MMA(0, 0, At, B0); PG8_MMA(0, 1, At, B1); PG8_BAR; PG8_SCHED;
            PG8_LDA(At, 0, 1); PG8_STAGE(PG8_SB(0, 0), b2, voffB); PG8_STAGE(PG8_SB(0, 1), b2 + hstep, voffB); PG8_STAGE(PG8_SA(0, 0), a2, voffA);
            PG8_WAIT_V(8); PG8_WAIT_L(0); PG8_BAR; PG8_MMA(1, 0, At, B0); PG8_MMA(1, 1, At, B1); PG8_BAR; PG8_SCHED;
            PG8_LDB(B0, 1, 0); PG8_LDB(B1, 1, 1); PG8_SCHED; PG8_LDA(At, 1, 0); PG8_STAGE(PG8_SA(0, 1), a2 + hstep, voffA);
            PG8_WAIT_V(8); PG8_WAIT_L(0); PG8_BAR; PG8_MMA(0, 0, At, B0); PG8_MMA(0, 1, At, B1); PG8_BAR; PG8_SCHED;
            PG8_LDA(At, 1, 1); PG8_STAGE(PG8_SB(1, 0), b3, voffB); PG8_STAGE(PG8_SB(1, 1), b3 + hstep, voffB); PG8_STAGE(PG8_SA(1, 0), a3, voffA);
            PG8_WAIT_V(8); PG8_WAIT_L(0); PG8_BAR; PG8_MMA(1, 0, At, B0); PG8_MMA(1, 1, At, B1); PG8_BAR; PG8_SCHED;
            } else {
            PG8_LDB(B0, 0, 0); PG8_SCHED; PG8_LDA(At, 0, 0); PG8_STAGE(PG8_SA(1, 1), a1 + hstep, voffA);
            PG8_WAIT_L(8); PG8_BAR; PG8_WAIT_L(0); PG8_MMA(0, 0, At, B0); PG8_BAR; PG8_SCHED;
            PG8_LDB(B1, 0, 1); PG8_STAGE(PG8_SB(0, 0), b2, voffB);
            PG8_BAR; PG8_WAIT_L(0); PG8_MMA(0, 1, At, B1); PG8_BAR;
            PG8_LDA(At, 0, 1); PG8_STAGE(PG8_SA(0, 0), a2, voffA);
            PG8_BAR; PG8_WAIT_L(0); PG8_MMA(1, 0, At, B0); PG8_BAR; PG8_SCHED;
            PG8_STAGE(PG8_SB(0, 1), b2 + hstep, voffB);
            PG8_WAIT_V(6); PG8_BAR; PG8_MMA(1, 1, At, B1); PG8_BAR;
            PG8_LDB(B0, 1, 0); PG8_SCHED; PG8_LDA(At, 1, 0); PG8_STAGE(PG8_SA(0, 1), a2 + hstep, voffA);
            PG8_WAIT_L(8); PG8_BAR; PG8_WAIT_L(0); PG8_MMA(0, 0, At, B0); PG8_BAR; PG8_SCHED;
            PG8_LDB(B1, 1, 1); PG8_STAGE(PG8_SB(1, 0), b3, voffB);
            PG8_BAR; PG8_WAIT_L(0); PG8_MMA(0, 1, At, B1); PG8_BAR;
            PG8_LDA(At, 1, 1); PG8_STAGE(PG8_SA(1, 0), a3, voffA);
            PG8_BAR; PG8_WAIT_L(0); PG8_MMA(1, 0, At, B0); PG8_BAR; PG8_SCHED;
            PG8_STAGE(PG8_SB(1, 1), b3 + hstep, voffB);
            PG8_WAIT_V(6); PG8_BAR; PG8_MMA(1, 1, At, B1); PG8_BAR;
            }
        }
        if constexpr (ALIGN_EPI) { if (wr == 0) PG8_BAR; }
        if constexpr (!Epi::AFTER_DRAIN) { E(acc, cur, wr, wc, fr, fq); S.done(cur); }
        if (!has_next) break;
#pragma unroll
        for (int a = 0; a < 2; ++a)
#pragma unroll
            for (int b = 0; b < 2; ++b)
#pragma unroll
                for (int m = 0; m < 4; ++m)
#pragma unroll
                    for (int n = 0; n < 2; ++n) acc[a][b][m][n] = (f32x4){0.f, 0.f, 0.f, 0.f};
        cur = nxt; cA = nA; cB = nB; ++ui;
        if constexpr (ALIGN_EPI) { if (wr == 1) PG8_BAR; }
    }
    PG8_WAIT_V(0);
    if constexpr (!ALIGN_EPI) { if (wr == 0) PG8_BAR; }
    PG8_BAR;
    if constexpr (Epi::AFTER_DRAIN) { E.fused(acc, cur, wr, wc, fr, fq, lds, wid, lane); S.done(cur); }
#undef PG8_SA
#undef PG8_SB
#undef PG8_STAGE
#undef PG8_LDA
#undef PG8_LDB
#undef PG8_MMA
#undef PG8_WAIT_V
#undef PG8_WAIT_L
#undef PG8_BAR
#undef PG8_SCHED
}
}
constexpr int DM = 1024, NB = 4, SEQ = 4096, NCTX = 256, DFF = 2816, DIN = 4112, NPROJ = 4096, NMODC = 9216;
constexpr int MLAT = NB * SEQ, MCTX = NB * NCTX, MALL = MLAT + MCTX;
constexpr float EPSN = 1e-6f;
constexpr int NWAVES = 8, NTHREADS = 512;
#ifndef ONE_LAUNCH
#define ONE_LAUNCH 0
#endif
constexpr int NPHASES = 14;

constexpr size_t MiB = 1u << 20;
constexpr size_t WS_CTL = 0, CTL_ZERO_BYTES = 64 * 1024;
constexpr size_t WS_MODS = 1 * MiB;
constexpr size_t WS_GATES = 1 * MiB + 512 * 1024;
constexpr size_t WS_W1 = 3 * MiB;
constexpr size_t WS_W2 = 14 * MiB;
constexpr size_t WS_WIN = 20 * MiB;
constexpr size_t WS_WOUT = 28 * MiB;
constexpr size_t WS_X1CTX = 30 * MiB;
constexpr size_t WS_XN = 34 * MiB;
constexpr size_t WS_PROJ = 68 * MiB;
constexpr size_t WS_QK = 204 * MiB;
constexpr size_t WS_OF = 221 * MiB;
constexpr size_t WS_OB = 34 * MiB;
constexpr size_t WS_END = 256 * MiB;
constexpr int CW_BAR = 1024;

constexpr int RING_BYTES = 131072;
constexpr int LDSCTL_OFF = RING_BYTES, MISC_OFF = LDSCTL_OFF + 320;
constexpr int LDS_BYTES = 147456;

#define GAS __attribute__((address_space(1)))
#define LAS __attribute__((address_space(3)))
typedef unsigned short bf16;
typedef unsigned v4u __attribute__((ext_vector_type(4)));
typedef unsigned v2u __attribute__((ext_vector_type(2)));
typedef float f32x4 __attribute__((ext_vector_type(4)));
#define LDS_WAIT() asm volatile("s_waitcnt lgkmcnt(0)" ::: "memory")
#define VM_WAIT() asm volatile("s_waitcnt vmcnt(0)" ::: "memory")
__device__ __forceinline__ unsigned f2bf(float f) { unsigned u = __builtin_bit_cast(unsigned, f); return (u + 0x7fffu + ((u >> 16) & 1u)) >> 16; }
__device__ __forceinline__ unsigned pk2(float lo, float hi) { return f2bf(lo) | (f2bf(hi) << 16); }
__device__ __forceinline__ float bf2f(unsigned short h) { return __builtin_bit_cast(float, (unsigned)h << 16); }
__device__ __forceinline__ float bflo(unsigned w) { return __builtin_bit_cast(float, w << 16); }
__device__ __forceinline__ float bfhi(unsigned w) { return __builtin_bit_cast(float, w & 0xffff0000u); }
__device__ __forceinline__ float sigmoidf_(float v) { return 1.0f / (1.0f + __expf(-v)); }
__device__ __forceinline__ float siluf_(float v) { return v * sigmoidf_(v); }
__device__ __forceinline__ float wave_sum(float v) {
#pragma unroll
    for (int o = 1; o < 64; o <<= 1) v += __shfl_xor(v, o);
    return v;
}
#define XB_TMO      128
#define XB_XCNT(j)  (256  + 64 * (j))
#define XB_XSUB(j)  (1280 + 64 * (j))
#define XB_XGEN(j)  (2304 + 64 * (j))
#define XB_TOP      3328
#define XB_TOPGEN   3392
#define XCD_BAR_WORDS 3456
#define XB_SPIN_CAP (1u << 18)

__device__ __forceinline__ unsigned xb_ld(unsigned* p)              { return __hip_atomic_load(p, __ATOMIC_RELAXED, __HIP_MEMORY_SCOPE_AGENT); }
__device__ __forceinline__ unsigned xb_add(unsigned* p, unsigned v) { return __hip_atomic_fetch_add(p, v, __ATOMIC_RELAXED, __HIP_MEMORY_SCOPE_AGENT); }
__device__ __forceinline__ unsigned xb_xcc_id() { return (unsigned)__builtin_amdgcn_s_getreg((3 << 11) | 20) & 0xFu; }
#define XB_SPIN(cond, bar) do { unsigned _sp = 0; while (cond) { __builtin_amdgcn_s_sleep(1); \
    if ((++_sp & 255u) == 0u) { if (xb_ld(&(bar)[XB_TMO])) break; if (_sp > XB_SPIN_CAP) { atomicAdd(&(bar)[XB_TMO], 1u); break; } } } } while (0)

struct XcdBarrier {
    unsigned* bar; unsigned x;
    volatile LAS unsigned* st;
};

__device__ __forceinline__ XcdBarrier xcd_barrier_post(unsigned* bar, volatile LAS unsigned* st) {
    XcdBarrier b; b.bar = bar; b.x = xb_xcc_id(); b.st = st;
    if (threadIdx.x == 0) (void)xb_add(&bar[XB_XCNT(b.x)], 1u);
    return b;
}
__device__ __forceinline__ void xcd_barrier_complete(unsigned* bar, unsigned x, unsigned& nloc, unsigned& nx) {
    const unsigned G = gridDim.x * gridDim.y * gridDim.z;
    unsigned sum, cnt, mine, sp = 0u;
    for (;;) {
        sum = 0u; cnt = 0u; mine = 0u;
#pragma unroll
        for (unsigned j = 0; j < 16; ++j) { const unsigned c = xb_ld(&bar[XB_XCNT(j)]); sum += c; cnt += (c > 0u) ? 1u : 0u; mine = (j == x) ? c : mine; }
        if (sum == G) break;
        __builtin_amdgcn_s_sleep(1);
        if ((++sp & 255u) == 0u) { if (xb_ld(&bar[XB_TMO])) break; if (sp > XB_SPIN_CAP) { atomicAdd(&bar[XB_TMO], 1u); break; } }
    }
    nloc = mine > 0u ? mine : 1u; nx = cnt > 0u ? cnt : 1u;
}

__device__ __forceinline__ void xcd_barrier(const XcdBarrier& b) {
    asm volatile("s_waitcnt vmcnt(0)" ::: "memory");
    __syncthreads();
    if (threadIdx.x == 0) {
        unsigned* bar = b.bar;
        __builtin_amdgcn_s_waitcnt(0);
        unsigned nloc = b.st[0], nx = b.st[1];
        if (nloc == 0u) { xcd_barrier_complete(bar, b.x, nloc, nx); b.st[0] = nloc; b.st[1] = nx; }
        const unsigned old = xb_add(&bar[XB_XSUB(b.x)], 1u);
        const unsigned gen = old / nloc;
        if (old + 1u == (gen + 1u) * nloc) {
            __builtin_amdgcn_fence(__ATOMIC_RELEASE, "agent");
            asm volatile("s_waitcnt vmcnt(0)" ::: "memory");
            const unsigned og = xb_add(&bar[XB_TOP], 1u);
            const unsigned tg = og / nx;
            if (og + 1u == (tg + 1u) * nx) xb_add(&bar[XB_TOPGEN], 1u);
            else XB_SPIN(xb_ld(&bar[XB_TOPGEN]) == tg, bar);
            __builtin_amdgcn_fence(__ATOMIC_ACQUIRE, "agent");
            xb_add(&bar[XB_XGEN(b.x)], 1u);
            asm volatile("s_waitcnt vmcnt(0)" ::: "memory");
        } else {
            XB_SPIN(xb_ld(&bar[XB_XGEN(b.x)]) == gen, bar);
            __builtin_amdgcn_fence(__ATOMIC_ACQUIRE, "agent");
            asm volatile("s_waitcnt vmcnt(0)" ::: "memory");
        }
    }
    __syncthreads();
}
struct Args {
    const float* in[22]; float* out; unsigned char* ws; int ph_lo, ph_hi;
};
enum { I_X = 0, I_C, I_CTX, I_CCTX, I_WMOD, I_BMOD, I_N1W, I_F1W1, I_F1W2, I_N2W, I_WIN, I_MLGB, I_CONVW, I_CONVB, I_LBLOG, I_HGNW, I_MLNW, I_WOUT, I_N3W, I_F2W1, I_F2W2, I_FNW };

struct Ctx {
    LAS unsigned char* lds;
    int tid, lane, wave, vcu, G, gw, NGW;
};

__device__ __forceinline__ void mods_item(const Args& a, const Ctx& T, int item) {
    LAS float* sL = (LAS float*)T.lds;
    LAS float* red = (LAS float*)(T.lds + 20480);
    const float* c = a.in[I_C]; const float* cc = a.in[I_CCTX];
    for (int i = T.tid; i < 5 * 1024; i += NTHREADS) { const int r = i >> 10, k = i & 1023; const float v = r < 4 ? c[r * 1024 + k] : cc[k]; sL[i] = siluf_(v); }
    __syncthreads();
    const float* W = a.in[I_WMOD] + (size_t)(T.wave * 128) * NMODC + item * 64 + T.lane;
    float acc[5] = {0.f, 0.f, 0.f, 0.f, 0.f};
#pragma unroll 8
    for (int k = 0; k < 128; ++k) { const float w = W[(size_t)k * NMODC];
#pragma unroll
        for (int r = 0; r < 5; ++r) acc[r] += sL[r * 1024 + T.wave * 128 + k] * w; }
#pragma unroll
    for (int r = 0; r < 5; ++r) red[(T.wave * 5 + r) * 64 + T.lane] = acc[r];
    __syncthreads();
    if (T.tid < 320) { const int r = T.tid >> 6, l = T.tid & 63; float s = 0.f;
#pragma unroll
        for (int w = 0; w < 8; ++w) s += red[(w * 5 + r) * 64 + l];
        const int col = item * 64 + l;
        ((float*)(a.ws + WS_MODS))[r * NMODC + col] = s + a.in[I_BMOD][col]; }
    __syncthreads();
}

__device__ __forceinline__ void transpose_item(const float* W, int ldw, int K, bf16* WT, int k0, int n0, int dest_row0, LAS float* scr, int lane) {
#pragma unroll 8
    for (int i = 0; i < 32; ++i) { const int kk = 2 * i + (lane >> 5); scr[kk * 33 + (lane & 31)] = W[(size_t)(k0 + kk) * ldw + n0 + (lane & 31)]; }
    LDS_WAIT(); asm volatile("" ::: "memory");
    const int c = lane & 7;
#pragma unroll
    for (int j = 0; j < 4; ++j) { const int n = (lane >> 3) + 8 * j; const LAS float* s = scr + (8 * c) * 33 + n;
        v4u o; o.x = pk2(s[0 * 33], s[1 * 33]); o.y = pk2(s[2 * 33], s[3 * 33]); o.z = pk2(s[4 * 33], s[5 * 33]); o.w = pk2(s[6 * 33], s[7 * 33]);
        *(GAS v4u*)(WT + (size_t)(dest_row0 + n) * K + k0 + 8 * c) = o; }
    LDS_WAIT(); asm volatile("" ::: "memory");
}
__device__ __forceinline__ void convert_ffn(const Args& a, const Ctx& T, const float* w1, const float* w2) {
    LAS float* scr = (LAS float*)(T.lds + T.wave * 16384);
    bf16* W1 = (bf16*)(a.ws + WS_W1); bf16* W2 = (bf16*)(a.ws + WS_W2);
    constexpr int I1 = 16 * 176, I2 = 44 * 32;
    for (int it = T.gw; it < I1 + I2; it += T.NGW) {
        if (it < I1) { const int kb = it / 176, nb = it % 176, n0 = nb * 32;
            const int dest = n0 < DFF ? (n0 >> 7) * 256 + (n0 & 127) : ((n0 - DFF) >> 7) * 256 + 128 + ((n0 - DFF) & 127);
            transpose_item(w1, 2 * DFF, DM, W1, kb * 64, n0, dest, scr, T.lane); }
        else { const int r = it - I1, kb = r / 32, nb = r % 32; transpose_item(w2, DM, DFF, W2, kb * 64, nb * 32, nb * 32, scr, T.lane); }
    }
}
__device__ __forceinline__ void convert_mix(const Args& a, const Ctx& T) {
    LAS float* scr = (LAS float*)(T.lds + T.wave * 16384);
    bf16* WI = (bf16*)(a.ws + WS_WIN); bf16* WO = (bf16*)(a.ws + WS_WOUT);
    constexpr int I1 = 16 * 128, I2 = 16 * 32;
    for (int it = T.gw; it < I1 + I2; it += T.NGW) {
        if (it < I1) { const int kb = it / 128, nb = it % 128; transpose_item(a.in[I_WIN], DIN, DM, WI, kb * 64, nb * 32, nb * 32, scr, T.lane); }
        else { const int r = it - I1, kb = r / 32, nb = r % 32; transpose_item(a.in[I_WOUT], DM, DM, WO, kb * 64, nb * 32, nb * 32, scr, T.lane); }
    }
}

template <bool GATES>
__device__ __forceinline__ void norm_mod_rows(const Args& a, const Ctx& T, const float* src_lat, const float* src_ctx, int nrows, const float* nw, int shift_idx, int scale_idx) {
    const float* mods = (const float*)(a.ws + WS_MODS);
    bf16* XN = (bf16*)(a.ws + WS_XN);
    f32x4 wv[4];
#pragma unroll
    for (int j = 0; j < 4; ++j) wv[j] = *((const f32x4*)nw + T.lane + 64 * j);
    for (int m = T.gw; m < nrows; m += T.NGW) {
        const float* xrow = m < MLAT ? src_lat + (size_t)m * DM : src_ctx + (size_t)(m - MLAT) * DM;
        const float* mr = mods + (size_t)(m < MLAT ? (m >> 12) : 4) * NMODC;
        const f32x4* xr = (const f32x4*)xrow + T.lane;
        f32x4 v[4]; float s = 0.f;
#pragma unroll
        for (int j = 0; j < 4; ++j) { v[j] = xr[64 * j]; s += (v[j].x * v[j].x + v[j].y * v[j].y) + (v[j].z * v[j].z + v[j].w * v[j].w); }
        const float rstd = 1.0f / sqrtf(wave_sum(s) * (1.f / DM) + EPSN);
        unsigned long long* o8 = (unsigned long long*)(XN + (size_t)m * DM) + T.lane;
#pragma unroll
        for (int j = 0; j < 4; ++j) { const f32x4 sh = *((const f32x4*)(mr + shift_idx * 1024) + T.lane + 64 * j), sc = *((const f32x4*)(mr + scale_idx * 1024) + T.lane + 64 * j);
            v[j] = (v[j] * rstd * wv[j]) * (sc + 1.0f) + sh;
            o8[64 * j] = (unsigned long long)pk2(v[j].x, v[j].y) | ((unsigned long long)pk2(v[j].z, v[j].w) << 32); }
        if (GATES) {
            float g[16];
#pragma unroll
            for (int q = 0; q < 16; ++q) g[q] = 0.f;
#pragma unroll
            for (int j = 0; j < 4; ++j)
#pragma unroll
                for (int i = 0; i < 4; ++i) { const int c = 4 * T.lane + 256 * j + i; const f32x4* wg = (const f32x4*)(a.in[I_WIN] + (size_t)c * DIN + NPROJ); const float hv = v[j][i];
#pragma unroll
                    for (int q4 = 0; q4 < 4; ++q4) { const f32x4 w = wg[q4]; g[q4 * 4 + 0] += hv * w.x; g[q4 * 4 + 1] += hv * w.y; g[q4 * 4 + 2] += hv * w.z; g[q4 * 4 + 3] += hv * w.w; } }
            float mine = 0.f;
#pragma unroll
            for (int q = 0; q < 16; ++q) { const float t = wave_sum(g[q]); if (T.lane == q) mine = t; }
            if (T.lane < 16) ((float*)(a.ws + WS_GATES))[(size_t)m * 16 + T.lane] = mine + a.in[I_MLGB][T.lane];
        }
    }
}

__device__ __forceinline__ void conv_phase(const Args& a, const Ctx& T) {
    const bf16* P = (const bf16*)(a.ws + WS_PROJ); bf16* QK = (bf16*)(a.ws + WS_QK);
    const float* cw = a.in[I_CONVW]; const float* cb = a.in[I_CONVB];
    const int total = MALL * 64;
    for (int idx = T.vcu * NTHREADS + T.tid; idx < total; idx += T.G * NTHREADS) {
        const int m = idx >> 6, ch0 = (idx & 63) * 8;
        float acc[8];
#pragma unroll
        for (int i = 0; i < 8; ++i) acc[i] = cb[ch0 + i];
        if (m < MLAT) {
            const int b = m >> 12, t = m & 4095, r = t >> 6, c = t & 63;
#pragma unroll
            for (int dr = -1; dr <= 1; ++dr)
#pragma unroll
                for (int dc = -1; dc <= 1; ++dc) {
                    const int rr = r + dr, c2 = c + dc;
                    if (rr >= 0 && rr < 64 && c2 >= 0 && c2 < 64) {
                        const v4u pv = *(const v4u*)(P + (size_t)(b * 4096 + rr * 64 + c2) * NPROJ + 2560 + ch0);
                        const float* w = cw + ((dr + 1) * 3 + (dc + 1)) * 512 + ch0;
                        acc[0] += w[0] * bflo(pv.x); acc[1] += w[1] * bfhi(pv.x); acc[2] += w[2] * bflo(pv.y); acc[3] += w[3] * bfhi(pv.y);
                        acc[4] += w[4] * bflo(pv.z); acc[5] += w[5] * bfhi(pv.z); acc[6] += w[6] * bflo(pv.w); acc[7] += w[7] * bfhi(pv.w);
                    }
                }
        } else {
            const int mc = m - MLAT, b = mc >> 8, t = mc & 255;
#pragma unroll
            for (int d = -1; d <= 1; ++d) {
                const int t2 = t + d;
                if (t2 >= 0 && t2 < 256) {
                    const v4u pv = *(const v4u*)(P + (size_t)(MLAT + b * 256 + t2) * NPROJ + 2560 + ch0);
                    const float* w = cw + (3 + (d + 1)) * 512 + ch0;
                    acc[0] += w[0] * bflo(pv.x); acc[1] += w[1] * bfhi(pv.x); acc[2] += w[2] * bflo(pv.y); acc[3] += w[3] * bfhi(pv.y);
                    acc[4] += w[4] * bflo(pv.z); acc[5] += w[5] * bfhi(pv.z); acc[6] += w[6] * bflo(pv.w); acc[7] += w[7] * bfhi(pv.w);
                }
            }
        }
        const float sc = ch0 < 256 ? 0.125f : 1.0f;
#pragma unroll
        for (int i = 0; i < 8; ++i) acc[i] = siluf_(acc[i]) * sc;
        v4u o; o.x = pk2(acc[0], acc[1]); o.y = pk2(acc[2], acc[3]); o.z = pk2(acc[4], acc[5]); o.w = pk2(acc[6], acc[7]);
        *(v4u*)(QK + (size_t)m * 512 + ch0) = o;
    }
}

__device__ __forceinline__ int scan_row(int b, int dir, int p) {
    if (p < NCTX) return MLAT + b * NCTX + (dir ? NCTX - 1 - p : p);
    const int q = p - NCTX; return b * SEQ + (dir ? SEQ - 1 - q : q);
}
__device__ __forceinline__ void scan_hg_item(const Args& a, const Ctx& T, int item) {
    const int b = item >> 5, dir = (item >> 4) & 1, head = (item >> 2) & 3, es = item & 3;
    const bf16* P = (const bf16*)(a.ws + WS_PROJ);
    bf16* O = (bf16*)(a.ws + (dir ? WS_OB : WS_OF));
    LAS float* fL = (LAS float*)T.lds;
    LAS float* kL = fL + 32 * 128;
    LAS float* qL = kL + 32 * 128;
    LAS float* vL = qL + 32 * 128;
    LAS float* red = vL + 32 * 32;
    const int e = T.tid & 31, dg = T.tid >> 5;
    const float* lbl = a.in[I_LBLOG];
    float S[8];
#pragma unroll
    for (int j = 0; j < 8; ++j) S[j] = 0.f;
    for (int blk = 0; blk < (NCTX + SEQ) / 32; ++blk) {
        for (int idx = T.tid; idx < 32 * 128; idx += NTHREADS) { const int i = idx >> 7, d = idx & 127; const size_t m = (size_t)scan_row(b, dir, blk * 32 + i);
            const float fp = bf2f(P[m * NPROJ + (dir ? 2048 : 1536) + head * 128 + d]);
            const float qv = bf2f(P[m * NPROJ + head * 128 + d]);
            const int ch = head * 128 + d; const float lb = sigmoidf_(lbl[dir * 512 + ch] - lbl[(2 + dir) * 512 + ch]);
            const float sg = sigmoidf_(fp);
            fL[idx] = lb + (1.f - lb) * sg; kL[idx] = (1.f - lb) * (1.f - sg); qL[idx] = qv; }
        for (int idx = T.tid; idx < 32 * 32; idx += NTHREADS) { const int i = idx >> 5, ee = idx & 31; const size_t m = (size_t)scan_row(b, dir, blk * 32 + i);
            vL[idx] = bf2f(P[m * NPROJ + 512 + head * 128 + es * 32 + ee]); }
        __syncthreads();
#pragma unroll 1
        for (int half = 0; half < 2; ++half) {
#pragma unroll 4
            for (int ii = 0; ii < 16; ++ii) { const int i = half * 16 + ii; const float v = vL[i * 32 + e]; float po = 0.f;
#pragma unroll
                for (int j = 0; j < 8; ++j) { const int d = dg * 8 + j; S[j] = fL[i * 128 + d] * S[j] + kL[i * 128 + d] * v; po += qL[i * 128 + d] * S[j]; }
                red[(ii * 16 + dg) * 32 + e] = po; }
            __syncthreads();
            { const int ii = T.tid >> 5; float o = 0.f;
#pragma unroll
                for (int g = 0; g < 16; ++g) o += red[(ii * 16 + g) * 32 + e];
                const int p = blk * 32 + half * 16 + ii;
                if (p >= NCTX) { const size_t m = (size_t)scan_row(b, dir, p); O[m * DM + head * 128 + es * 32 + e] = (bf16)f2bf(o); } }
            __syncthreads();
        }
    }
}
__device__ __forceinline__ void scan_ml_item(const Args& a, const Ctx& T, int item) {
    const int b = item >> 5, dir = (item >> 4) & 1, head = (item >> 2) & 3, es = item & 3;
    const bf16* P = (const bf16*)(a.ws + WS_PROJ); const bf16* QK = (const bf16*)(a.ws + WS_QK); const float* GT = (const float*)(a.ws + WS_GATES);
    bf16* O = (bf16*)(a.ws + (dir ? WS_OB : WS_OF));
    LAS float* qL = (LAS float*)T.lds;
    LAS float* kL = qL + 32 * 64;
    LAS float* vL = kL + 32 * 64;
    LAS float* gi = vL + 32 * 32;
    LAS float* gf = gi + 32;
    LAS float* mv = gf + 32;
    LAS float* rden = mv + 16;
    LAS float* red = rden + 256;
    const int e = T.tid & 31, dg = T.tid >> 5;
    float C[4], n[4], mst = 0.f;
#pragma unroll
    for (int j = 0; j < 4; ++j) { C[j] = 0.f; n[j] = 0.f; }
    for (int blk = 0; blk < (NCTX + SEQ) / 32; ++blk) {
        for (int idx = T.tid; idx < 32 * 64; idx += NTHREADS) { const int i = idx >> 6, d = idx & 63; const size_t m = (size_t)scan_row(b, dir, blk * 32 + i);
            qL[idx] = bf2f(QK[m * 512 + head * 64 + d]); kL[idx] = bf2f(QK[m * 512 + 256 + head * 64 + d]); }
        for (int idx = T.tid; idx < 32 * 32; idx += NTHREADS) { const int i = idx >> 5, ee = idx & 31; const size_t m = (size_t)scan_row(b, dir, blk * 32 + i);
            vL[idx] = bf2f(P[m * NPROJ + 3072 + head * 128 + es * 32 + ee]); }
        if (T.tid < 32) { const size_t m = (size_t)scan_row(b, dir, blk * 32 + T.tid);
            gi[T.tid] = GT[m * 16 + (dir ? 8 : 0) + head]; const float f = GT[m * 16 + (dir ? 12 : 4) + head];
            gf[T.tid] = fminf(f, 0.f) - log1pf(__expf(-fabsf(f))); }
        __syncthreads();
#pragma unroll 1
        for (int half = 0; half < 2; ++half) {
#pragma unroll 2
            for (int ii = 0; ii < 16; ++ii) { const int i = half * 16 + ii; const float v = vL[i * 32 + e];
                const float it = gi[i], lf = gf[i]; const float mn = fmaxf(lf + mst, it); const float ca = __expf(lf + mst - mn), cbv = __expf(it - mn); mst = mn;
                float pn = 0.f, pd = 0.f;
#pragma unroll
                for (int j = 0; j < 4; ++j) { const int d = dg * 4 + j; const float kd = kL[i * 64 + d] * cbv, qd = qL[i * 64 + d]; C[j] = ca * C[j] + kd * v; n[j] = ca * n[j] + kd; pn += qd * C[j]; pd += qd * n[j]; }
                red[(ii * 16 + dg) * 32 + e] = pn; if (e == 0) rden[ii * 16 + dg] = pd; if (T.tid == 0) mv[ii] = mn; }
            __syncthreads();
            { const int ii = T.tid >> 5; float num = 0.f, den = 0.f;
#pragma unroll
                for (int g = 0; g < 16; ++g) { num += red[(ii * 16 + g) * 32 + e]; den += rden[ii * 16 + g]; }
                const int p = blk * 32 + half * 16 + ii;
                if (p >= NCTX) { const size_t m = (size_t)scan_row(b, dir, p); const float h = num / fmaxf(fabsf(den), __expf(-mv[ii])); O[m * DM + 512 + head * 128 + es * 32 + e] = (bf16)f2bf(h); } }
            __syncthreads();
        }
    }
}

__device__ __forceinline__ void headnorm_phase(const Args& a, const Ctx& T) {
    const bf16* P = (const bf16*)(a.ws + WS_PROJ); bf16* OF = (bf16*)(a.ws + WS_OF); const bf16* OB = (const bf16*)(a.ws + WS_OB);
    const int l = T.lane, head = l >> 3;
    const float* nw = head < 4 ? a.in[I_HGNW] + 16 * l : a.in[I_MLNW] + 16 * l - 512;
    const int gcol = head < 4 ? 1024 + 16 * l : 3584 + 16 * l - 512;
    float w[16];
#pragma unroll
    for (int j = 0; j < 16; ++j) w[j] = nw[j];
    for (int m = T.gw; m < MLAT; m += T.NGW) {
        const v4u f0 = *(const v4u*)(OF + (size_t)m * DM + 16 * l), f1 = *(const v4u*)(OF + (size_t)m * DM + 16 * l + 8);
        const v4u b0 = *(const v4u*)(OB + (size_t)m * DM + 16 * l), b1 = *(const v4u*)(OB + (size_t)m * DM + 16 * l + 8);
        const v4u g0 = *(const v4u*)(P + (size_t)m * NPROJ + gcol), g1 = *(const v4u*)(P + (size_t)m * NPROJ + gcol + 8);
        float o[16], g[16];
#pragma unroll
        for (int q = 0; q < 4; ++q) { o[2 * q] = bflo(f0[q]) + bflo(b0[q]); o[2 * q + 1] = bfhi(f0[q]) + bfhi(b0[q]); o[8 + 2 * q] = bflo(f1[q]) + bflo(b1[q]); o[8 + 2 * q + 1] = bfhi(f1[q]) + bfhi(b1[q]);
            g[2 * q] = bflo(g0[q]); g[2 * q + 1] = bfhi(g0[q]); g[8 + 2 * q] = bflo(g1[q]); g[8 + 2 * q + 1] = bfhi(g1[q]); }
        float ss = 0.f;
#pragma unroll
        for (int j = 0; j < 16; ++j) ss += o[j] * o[j];
        ss += __shfl_xor(ss, 1); ss += __shfl_xor(ss, 2); ss += __shfl_xor(ss, 4);
        const float r = 1.0f / sqrtf(ss * (1.f / 128.f) + EPSN);
#pragma unroll
        for (int j = 0; j < 16; ++j) o[j] = o[j] * r * w[j] * g[j];
        v4u o0, o1;
#pragma unroll
        for (int q = 0; q < 4; ++q) { o0[q] = pk2(o[2 * q], o[2 * q + 1]); o1[q] = pk2(o[8 + 2 * q], o[8 + 2 * q + 1]); }
        *(v4u*)(OF + (size_t)m * DM + 16 * l) = o0; *(v4u*)(OF + (size_t)m * DM + 16 * l + 8) = o1;
    }
}

__device__ __forceinline__ void final_norm_phase(const Args& a, const Ctx& T) {
    f32x4 wv[4];
#pragma unroll
    for (int j = 0; j < 4; ++j) wv[j] = *((const f32x4*)a.in[I_FNW] + T.lane + 64 * j);
    for (int m = T.gw; m < MLAT; m += T.NGW) {
        f32x4* xr = (f32x4*)(a.out + (size_t)m * DM) + T.lane;
        f32x4 v[4]; float s = 0.f;
#pragma unroll
        for (int j = 0; j < 4; ++j) { v[j] = xr[64 * j]; s += (v[j].x * v[j].x + v[j].y * v[j].y) + (v[j].z * v[j].z + v[j].w * v[j].w); }
        const float rstd = 1.0f / sqrtf(wave_sum(s) * (1.f / DM) + EPSN);
#pragma unroll
        for (int j = 0; j < 4; ++j) xr[64 * j] = v[j] * rstd * wv[j];
    }
}

__global__ void __launch_bounds__(NTHREADS, 2) fwd_kernel(Args a) {
    extern __shared__ __attribute__((aligned(16))) unsigned char lds_raw[];
    Ctx T;
    T.lds = (LAS unsigned char*)lds_raw;
    T.tid = threadIdx.x; T.lane = T.tid & 63; T.wave = __builtin_amdgcn_readfirstlane(T.tid >> 6);
    T.G = gridDim.x; { const int bx = blockIdx.x; T.vcu = (T.G % 8 == 0) ? (bx % 8) * (T.G / 8) + bx / 8 : bx; }
    T.gw = T.vcu * NWAVES + T.wave; T.NGW = T.G * NWAVES;
    volatile LAS unsigned* MISC = (volatile LAS unsigned*)(T.lds + MISC_OFF);
    for (int u = T.tid; u < (LDS_BYTES - LDSCTL_OFF) / 4; u += NTHREADS) ((LAS unsigned*)(T.lds + LDSCTL_OFF))[u] = 0u;
    __syncthreads();
    XcdBarrier bar; bar.bar = (unsigned*)(a.ws + WS_CTL) + CW_BAR; bar.x = 0; bar.st = nullptr;
    const bool multi = (a.ph_hi - a.ph_lo) > 1;
    if (multi) bar = xcd_barrier_post((unsigned*)(a.ws + WS_CTL) + CW_BAR, MISC + 8);
    const int lo = a.ph_lo, hi = a.ph_hi;
#define IN(k) (lo <= (k) && (k) < hi)
#define SEAM(k) do { if (IN(k) && IN((k) + 1)) xcd_barrier(bar); } while (0)
    bf16* XN = (bf16*)(a.ws + WS_XN); bf16* HB = (bf16*)(a.ws + WS_PROJ); bf16* PROJ = (bf16*)(a.ws + WS_PROJ);
    float* X1C = (float*)(a.ws + WS_X1CTX); const float* mods = (const float*)(a.ws + WS_MODS);
    const int bx = (int)blockIdx.x;

    if (IN(0)) { if (bx < 144) mods_item(a, T, bx); convert_ffn(a, T, a.in[I_F1W1], a.in[I_F1W2]); convert_mix(a, T); }
    SEAM(0);
    if (IN(1)) norm_mod_rows<false>(a, T, a.in[I_X], a.in[I_CTX], MALL, a.in[I_N1W], 0, 1);
    SEAM(1);
    if (IN(2)) { pg8::Gemm g{XN, (const bf16*)(a.ws + WS_W1), MALL, 2 * DFF, DM}; pg8::StaticOrder S; S.init(MALL, 2 * DFF, T.G, bx);
        pg8::EpiSwiglu E{HB, DFF}; pg8::gemm_phase<pg8::EpiSwiglu, pg8::StaticOrder, true, true>(T.lds, g, S, E); }
    SEAM(2);
    if (IN(3)) { pg8::Gemm g{HB, (const bf16*)(a.ws + WS_W2), MALL, DM, DFF}; pg8::StaticOrder S; S.init(MALL, DM, T.G, bx);
        pg8::EpiResid E{a.in[I_X], a.in[I_CTX], a.out, X1C, mods + 2 * 1024, 0.5f}; pg8::gemm_phase<pg8::EpiResid, pg8::StaticOrder, true, true>(T.lds, g, S, E); }
    SEAM(3);
    if (IN(4)) { norm_mod_rows<true>(a, T, a.out, X1C, MALL, a.in[I_N2W], 3, 4); convert_ffn(a, T, a.in[I_F2W1], a.in[I_F2W2]); }
    SEAM(4);
    if (IN(5)) { pg8::Gemm g{XN, (const bf16*)(a.ws + WS_WIN), MALL, NPROJ, DM}; pg8::StaticOrder S; S.init(MALL, NPROJ, T.G, bx);
        pg8::EpiProj E{PROJ, NPROJ}; pg8::gemm_phase<pg8::EpiProj, pg8::StaticOrder, true, true>(T.lds, g, S, E); }
    SEAM(5);
    if (IN(6)) conv_phase(a, T);
    SEAM(6);
    if (IN(7)) { for (int it = bx; it < 256; it += T.G) { if (it < 128) scan_hg_item(a, T, it); else scan_ml_item(a, T, it - 128); } }
    SEAM(7);
    if (IN(8)) headnorm_phase(a, T);
    SEAM(8);
    if (IN(9)) { pg8::Gemm g{(const bf16*)(a.ws + WS_OF), (const bf16*)(a.ws + WS_WOUT), MLAT, DM, DM}; pg8::StaticOrder S; S.init(MLAT, DM, T.G, bx);
        pg8::EpiResid E{a.out, a.out, a.out, a.out, mods + 5 * 1024, 1.0f}; pg8::gemm_phase<pg8::EpiResid, pg8::StaticOrder, true, true>(T.lds, g, S, E); }
    SEAM(9);
    if (IN(10)) norm_mod_rows<false>(a, T, a.out, a.out, MLAT, a.in[I_N3W], 6, 7);
    SEAM(10);
    if (IN(11)) { pg8::Gemm g{XN, (const bf16*)(a.ws + WS_W1), MLAT, 2 * DFF, DM}; pg8::StaticOrder S; S.init(MLAT, 2 * DFF, T.G, bx);
        pg8::EpiSwiglu E{HB, DFF}; pg8::gemm_phase<pg8::EpiSwiglu, pg8::StaticOrder, true, true>(T.lds, g, S, E); }
    SEAM(11);
    if (IN(12)) { pg8::Gemm g{HB, (const bf16*)(a.ws + WS_W2), MLAT, DM, DFF}; pg8::StaticOrder S; S.init(MLAT, DM, T.G, bx);
        pg8::EpiResid E{a.out, a.out, a.out, a.out, mods + 8 * 1024, 0.5f}; pg8::gemm_phase<pg8::EpiResid, pg8::StaticOrder, true, true>(T.lds, g, S, E); }
    SEAM(12);
    if (IN(13)) final_norm_phase(a, T);
#undef IN
#undef SEAM
}

extern "C" void kernel_launch(void* const* d_in, const int* in_sizes, int n_in, void* d_out, int out_size, void* d_ws, size_t ws_size, hipStream_t stream) {
    static int grid = 0;
    if (grid == 0) {
        if (n_in != 22 || out_size != MLAT * DM || ws_size < WS_END) { fprintf(stderr, "kernel_launch: unexpected shapes (n_in %d out %d ws %zu)\n", n_in, out_size, ws_size); grid = -1; return; }
        int dev = 0, cus = 0;
        if (hipGetDevice(&dev) != hipSuccess || hipDeviceGetAttribute(&cus, hipDeviceAttributeMultiprocessorCount, dev) != hipSuccess) { grid = -1; return; }
        if (hipFuncSetAttribute((const void*)fwd_kernel, hipFuncAttributeMaxDynamicSharedMemorySize, LDS_BYTES) != hipSuccess) { fprintf(stderr, "kernel_launch: hipFuncSetAttribute failed\n"); grid = -1; return; }
        (void)hipGetLastError();
        grid = cus;
    }
    if (grid < 0) return;
    (void)hipMemsetAsync((char*)d_ws + WS_CTL, 0, CTL_ZERO_BYTES, stream);
    Args a{};
    for (int i = 0; i < 22; ++i) a.in[i] = (const float*)d_in[i];
    a.out = (float*)d_out; a.ws = (unsigned char*)d_ws;
#if ONE_LAUNCH
    a.ph_lo = 0; a.ph_hi = NPHASES;
    hipLaunchKernelGGL(fwd_kernel, dim3(grid), dim3(NTHREADS), LDS_BYTES, stream, a);
#else
    for (int p = 0; p < NPHASES; ++p) { a.ph_lo = p; a.ph_hi = p + 1; hipLaunchKernelGGL(fwd_kernel, dim3(grid), dim3(NTHREADS), LDS_BYTES, stream, a); }
#endif
}
```

```cpp
#include <hip/hip_runtime.h>
#include <cstdio>
#include <cstdint>
namespace pg8 {
#define PG8_LAS __attribute__((address_space(3)))
typedef unsigned short bf16_t;
typedef short bf16x8 __attribute__((ext_vector_type(8)));
typedef float f32x4 __attribute__((ext_vector_type(4)));
typedef unsigned u32x4 __attribute__((ext_vector_type(4)));
constexpr int BM = 256, BK = 64, HALF = 128, HTB = HALF * BK * 2  , STAGE_BYTES = 8 * HTB, NXCD = 8, WGM = 8;

__host__ __device__ __forceinline__ int lds_byte(int r, int c) { const int st = (r >> 4) * 2 + (c >> 5), rr = r & 15, cc = c & 31, ob = rr * 64 + cc * 2; return st * 1024 + (ob ^ (((ob >> 9) & 1) << 5)); }
__host__ __device__ __forceinline__ void stage_rc(int b, int& R, int& C) { const int st = b / 1024, sb = b % 1024, swz = sb ^ (((sb >> 9) & 1) << 5); R = (st >> 1) * 16 + swz / 64; C = (st & 1) * 32 + (swz % 64) / 2; }
__host__ __device__ __forceinline__ int perm32(int rho) { const int n = rho >> 4, i = rho & 15; return 8 * (i >> 2) + 4 * n + (i & 3); }

struct Unit { int pm, pn; };
struct Gemm { const bf16_t* A; const bf16_t* Bt; int M, N, K; };

struct StaticOrder {
    int nM, nN, nwg, G, c;
    __host__ __device__ void init(int M, int N, int G_, int c_) { nM = M / BM; nN = N / BM; nwg = nM * nN; G = G_; c = c_; }
    __host__ __device__ bool next(int i, Unit& u) const {
        const long L = (long)i * G + c; if (L >= nwg) return false;
        int wgid = (int)L; { const int q = nwg / NXCD, r = nwg % NXCD, xcd = wgid % NXCD, off = wgid / NXCD; wgid = (xcd < r ? xcd * (q + 1) : r * (q + 1) + (xcd - r) * q) + off; }
        const int nig = WGM * nN, gid = wgid / nig, fm = gid * WGM, gsz = (nM - fm) < WGM ? (nM - fm) : WGM;
        u.pm = fm + ((wgid % nig) % gsz); u.pn = (wgid % nig) / gsz; return true;
    }
    __device__ __forceinline__ void a_ready(const Unit&) const {}
    __device__ __forceinline__ void done(const Unit&) const {}
};
__device__ __forceinline__ unsigned cvt_pk_bf16(float lo, float hi) { unsigned r; asm volatile("v_cvt_pk_bf16_f32 %0, %1, %2" : "=v"(r) : "v"(lo), "v"(hi)); return r; }
typedef float f32x2 __attribute__((ext_vector_type(2)));
__device__ __forceinline__ float fast_sigmoid(float v) { return __builtin_amdgcn_rcpf(1.0f + __builtin_amdgcn_exp2f(-1.4426950408889634f * v)); }
__device__ __forceinline__ float fast_silu(float v) { return v * fast_sigmoid(v); }

struct EpiSwiglu {
    static constexpr bool PERM = true, AFTER_DRAIN = false;
    bf16_t* H; int ldh;
    __device__ __forceinline__ void operator()(const f32x4 (&acc)[2][2][4][2], const Unit& u, int wr, int wc, int fr, int fq) const {
        const int row0 = u.pm * BM + wr * 64 + fr, col0 = u.pn * HALF + wc * 32 + 8 * fq;
#pragma unroll
        for (int ai = 0; ai < 2; ++ai)
#pragma unroll
            for (int m = 0; m < 4; ++m) { bf16_t* rowp = H + (size_t)(row0 + ai * HALF + m * 16) * ldh + col0;
                float r[8];
#pragma unroll
                for (int n = 0; n < 2; ++n)
#pragma unroll
                    for (int i = 0; i < 4; ++i) r[n * 4 + i] = fast_silu(acc[ai][0][m][n][i]) * acc[ai][1][m][n][i];
                u32x4 w; w.x = cvt_pk_bf16(r[0], r[1]); w.y = cvt_pk_bf16(r[2], r[3]); w.z = cvt_pk_bf16(r[4], r[5]); w.w = cvt_pk_bf16(r[6], r[7]);
                *(u32x4*)rowp = w; }
    }
};

struct EpiResid {
    static constexpr bool PERM = false, AFTER_DRAIN = false;
    const float* base_lat; const float* base_ctx; float* out_lat; float* out_ctx; const float* gate; float coef;
    __device__ __forceinline__ void operator()(const f32x4 (&acc)[2][2][4][2], const Unit& u, int wr, int wc, int fr, int fq) const {
        const bool isctx = u.pm >= 64;
        const float* base = isctx ? base_ctx + (size_t)(u.pm - 64) * BM * 1024 : base_lat + (size_t)u.pm * BM * 1024;
        float* out = isctx ? out_ctx + (size_t)(u.pm - 64) * BM * 1024 : out_lat + (size_t)u.pm * BM * 1024;
        const float* g = gate + (size_t)(isctx ? 4 : (u.pm >> 4)) * 9216;
        const int col0 = u.pn * BM + wc * 32 + 4 * fq;
        f32x4 gv[2][2];
#pragma unroll
        for (int bj = 0; bj < 2; ++bj)
#pragma unroll
            for (int n = 0; n < 2; ++n) gv[bj][n] = *(const f32x4*)(g + col0 + bj * HALF + n * 16) * coef;
#pragma unroll
        for (int ai = 0; ai < 2; ++ai)
#pragma unroll
            for (int m = 0; m < 4; ++m) { const size_t off = (size_t)(ai * HALF + wr * 64 + m * 16 + fr) * 1024 + col0;
#pragma unroll
                for (int bj = 0; bj < 2; ++bj)
#pragma unroll
                    for (int n = 0; n < 2; ++n) { const f32x4 b = *(const f32x4*)(base + off + bj * HALF + n * 16);
                        *(f32x4*)(out + off + bj * HALF + n * 16) = b + gv[bj][n] * acc[ai][bj][m][n]; } }
    }
};

struct EpiProj {
    static constexpr bool PERM = true, AFTER_DRAIN = false;
    bf16_t* O; int ldc;
    __device__ __forceinline__ void operator()(const f32x4 (&acc)[2][2][4][2], const Unit& u, int wr, int wc, int fr, int fq) const {
        const int row0 = u.pm * BM + wr * 64 + fr, col0 = u.pn * BM + wc * 32 + 8 * fq;
        const int mode = (u.pn < 2) ? 1 : ((u.pn == 4 || u.pn == 5) ? 2 : (u.pn >= 14 ? 3 : 0));
#pragma unroll
        for (int ai = 0; ai < 2; ++ai)
#pragma unroll
            for (int m = 0; m < 4; ++m) { bf16_t* rowp = O + (size_t)(row0 + ai * HALF + m * 16) * ldc + col0;
#pragma unroll
                for (int bj = 0; bj < 2; ++bj) { float r[8];
#pragma unroll
                    for (int n = 0; n < 2; ++n)
#pragma unroll
                        for (int i = 0; i < 4; ++i) { const float v = acc[ai][bj][m][n][i];
                            r[n * 4 + i] = mode == 0 ? v : (mode == 1 ? fast_silu(v) * 0.08838834764831845f : (mode == 2 ? fast_silu(v) : fast_sigmoid(v))); }
                    u32x4 w; w.x = cvt_pk_bf16(r[0], r[1]); w.y = cvt_pk_bf16(r[2], r[3]); w.z = cvt_pk_bf16(r[4], r[5]); w.w = cvt_pk_bf16(r[6], r[7]);
                    *(u32x4*)(rowp + bj * HALF) = w; } }
    }
};
template <class Epi, class Sched, bool ALIGN_EPI = false, bool SP2 = false>
__device__ __forceinline__ void gemm_phase(PG8_LAS unsigned char* lds, const Gemm g, const Sched& S, const Epi& E) {
    const int tid = threadIdx.x, wid = __builtin_amdgcn_readfirstlane(tid >> 6), lane = tid & 63, wr = wid >> 2, wc = wid & 3, fr = lane & 15, fq = lane >> 4;
    const int K = g.K, nt = K / BK;
    unsigned voffA[2], voffB[2];
#pragma unroll
    for (int i = 0; i < 2; ++i) { int R, C; stage_rc(tid * 16 + i * 8192, R, C); const int Rb = Epi::PERM ? ((R & ~31) + perm32(R & 31)) : R;
        voffA[i] = (unsigned)(R * K + C) * 2u; voffB[i] = (unsigned)(Rb * K + C) * 2u; }
    const size_t kstep = (size_t)(BK * 2);
    const size_t hstep = (size_t)HALF * K * 2;
    const size_t tstep = 2 * hstep;
    const unsigned ldsw = (unsigned)wid * 1024u;
    const int aoff = lds_byte(wr * 64 + fr, fq * 8), boff = lds_byte(wc * 32 + fr, fq * 8);
#define PG8_SA(b, h) (((b) * 2 + (h)) * HTB)
#define PG8_SB(b, h) ((4 + (b) * 2 + (h)) * HTB)
#define PG8_STAGE(bufoff, gbase, voff) do { _Pragma("unroll") for (int _i = 0; _i < 2; ++_i) \
        __builtin_amdgcn_global_load_lds((const unsigned*)((const char*)(gbase) + (voff)[_i]), (PG8_LAS unsigned*)(lds + (bufoff) + ldsw + _i * 8192), 16, 0, 0); } while (0)
#define PG8_LDA(dst, b, h) do { _Pragma("unroll") for (int m = 0; m < 4; ++m) _Pragma("unroll") for (int k = 0; k < 2; ++k) dst[m][k] = *(const PG8_LAS bf16x8*)(lds + PG8_SA(b, h) + aoff + m * 2048 + k * 1024); } while (0)
#define PG8_LDB(dst, b, h) do { _Pragma("unroll") for (int n = 0; n < 2; ++n) _Pragma("unroll") for (int k = 0; k < 2; ++k) dst[n][k] = *(const PG8_LAS bf16x8*)(lds + PG8_SB(b, h) + boff + n * 2048 + k * 1024); } while (0)
#define PG8_MMA(ai, bj, At, Bt) do { __builtin_amdgcn_s_setprio(1); _Pragma("unroll") for (int m = 0; m < 4; ++m) _Pragma("unroll") for (int n = 0; n < 2; ++n) _Pragma("unroll") for (int k = 0; k < 2; ++k) \
        acc[ai][bj][m][n] = __builtin_amdgcn_mfma_f32_16x16x32_bf16(Bt[n][k], At[m][k], acc[ai][bj][m][n], 0, 0, 0); __builtin_amdgcn_s_setprio(0); } while (0)
#define PG8_WAIT_V(n) asm volatile("s_waitcnt vmcnt(" #n ")" ::: "memory")
#define PG8_WAIT_L(n) asm volatile("s_waitcnt lgkmcnt(" #n ")" ::: "memory")
#define PG8_BAR __builtin_amdgcn_s_barrier()
#define PG8_SCHED __builtin_amdgcn_sched_barrier(0)
    Unit cur, nxt; int ui = 0;
    if (!S.next(0, cur)) return;
    f32x4 acc[2][2][4][2];
#pragma unroll
    for (int a = 0; a < 2; ++a)
#pragma unroll
        for (int b = 0; b < 2; ++b)
#pragma unroll
            for (int m = 0; m < 4; ++m)
#pragma unroll
                for (int n = 0; n < 2; ++n) acc[a][b][m][n] = (f32x4){0.f, 0.f, 0.f, 0.f};
    bf16x8 At[4][2], B0[2][2], B1[2][2];
    const char* cA = (const char*)g.A + (size_t)cur.pm * tstep; const char* cB = (const char*)g.Bt + (size_t)cur.pn * tstep;
    S.a_ready(cur);
    if constexpr (SP2) {
        PG8_STAGE(PG8_SB(0, 0), cB, voffB); PG8_STAGE(PG8_SB(0, 1), cB + hstep, voffB); PG8_STAGE(PG8_SA(0, 0), cA, voffA); PG8_STAGE(PG8_SA(0, 1), cA + hstep, voffA);
        if (wr == 1) PG8_BAR;
        PG8_WAIT_V(2); PG8_BAR;
        PG8_STAGE(PG8_SB(1, 0), cB + kstep, voffB); PG8_STAGE(PG8_SA(1, 0), cA + kstep, voffA); PG8_STAGE(PG8_SB(1, 1), cB + hstep + kstep, voffB);
        PG8_WAIT_V(6); PG8_BAR;
    } else {
        PG8_STAGE(PG8_SB(0, 0), cB, voffB); PG8_STAGE(PG8_SA(0, 0), cA, voffA); PG8_STAGE(PG8_SB(0, 1), cB + hstep, voffB); PG8_STAGE(PG8_SA(0, 1), cA + hstep, voffA);
        if (wr == 1) PG8_BAR;
        PG8_WAIT_V(4); PG8_BAR;
        PG8_STAGE(PG8_SB(1, 0), cB + kstep, voffB); PG8_STAGE(PG8_SA(1, 0), cA + kstep, voffA); PG8_STAGE(PG8_SB(1, 1), cB + hstep + kstep, voffB);
        PG8_WAIT_V(6); PG8_BAR;
    }
    for (;;) {
        const bool has_next = S.next(ui + 1, nxt);
        const char* nA = has_next ? (const char*)g.A + (size_t)nxt.pm * tstep : cA; const char* nB = has_next ? (const char*)g.Bt + (size_t)nxt.pn * tstep : cB;
        for (int t = 0; t < nt; t += 2) {
            const bool last = (t == nt - 2);
            const char* a1 = cA + (size_t)(t + 1) * kstep;
            const char* a2 = last ? nA : cA + (size_t)(t + 2) * kstep; const char* b2 = last ? nB : cB + (size_t)(t + 2) * kstep;
            const char* a3 = a2 + kstep; const char* b3 = b2 + kstep;
            if (last && has_next) S.a_ready(nxt);
            if constexpr (SP2) {
            PG8_LDB(B0, 0, 0); PG8_LDB(B1, 0, 1); PG8_SCHED; PG8_LDA(At, 0, 0); PG8_STAGE(PG8_SA(1, 1), a1 + hstep, voffA);
            PG8_WAIT_V(8); PG8_WAIT_L(0); PG8_BAR; PG8_MMA(0, 0, At, B0); PG8_MMA(0, 1, At, B1); PG8_BAR; PG8_SCHED;
            PG8_LDA(At, 0, 1); PG8_STAGE(PG8_SB(0, 0), b2, voffB); PG8_STAGE(PG8_SB(0, 1), b2 + hstep, voffB); PG8_STAGE(PG8_SA(0, 0), a2, voffA);
            PG8_WAIT_V(8); PG8_WAIT_L(0); PG8_BAR; PG8_MMA(1, 0, At, B0); PG8_MMA(1, 1, At, B1); PG8_BAR; PG8_SCHED;
            PG8_LDB(B0, 1, 0); PG8_LDB(B1, 1, 1); PG8_SCHED; PG8_LDA(At, 1, 0); PG8_STAGE(PG8_SA(0, 1), a2 + hstep, voffA);
            PG8_WAIT_V(8); PG8_WAIT_L(0); PG8_BAR; PG8_MMA(0, 0, At, B0); PG8_MMA(0, 1, At, B1); PG8_BAR; PG8_SCHED;
            PG8_LDA(At, 1, 1); PG8_STAGE(PG8_SB(1, 0), b3, voffB); PG8_STAGE(PG8_SB(1, 1), b3 + hstep, voffB); PG8_STAGE(PG8_SA(1, 0), a3, voffA);
            PG8_WAIT_V(8); PG8_WAIT_L(0); PG8_BAR; PG8_MMA(1, 0, At, B0); PG8_MMA(1, 1, At, B1); PG8_BAR; PG8_SCHED;
            } else {
            PG8_LDB(B0, 0, 0); PG8_SCHED; PG8_LDA(At, 0, 0); PG8_STAGE(PG8_SA(1, 1), a1 + hstep, voffA);
            PG8_WAIT_L(8); PG8_BAR; PG8_WAIT_L(0); PG8_MMA(0, 0, At, B0); PG8_BAR; PG8_SCHED;
            PG8_LDB(B1, 0, 1); PG8_STAGE(PG8_SB(0, 0), b2, voffB);
            PG8_BAR; PG8_WAIT_L(0); PG8_MMA(0, 1, At, B1); PG8_BAR;
            PG8_LDA(At, 0, 1); PG8_STAGE(PG8_SA(0, 0), a2, voffA);
            PG8_BAR; PG8_WAIT_L(0); PG8_MMA(1, 0, At, B0); PG8_BAR; PG8_SCHED;
            PG8_STAGE(PG8_SB(0, 1), b2 + hstep, voffB);
            PG8_WAIT_V(6); PG8_BAR; PG8_MMA(1, 1, At, B1); PG8_BAR;
            PG8_LDB(B0, 1, 0); PG8_SCHED; PG8_LDA(At, 1, 0); PG8_STAGE(PG8_SA(0, 1), a2 + hstep, voffA);
            PG8_WAIT_L(8); PG8_BAR; PG8_WAIT_L(0); PG8_MMA(0, 0, At, B0); PG8_BAR; PG8_SCHED;
            PG8_LDB(B1, 1, 1); PG8_STAGE(PG8_SB(1, 0), b3, voffB);
            PG8_BAR; PG8_WAIT_L(0); PG8_MMA(0, 1, At, B1); PG8_BAR;
            PG8_LDA(At, 1, 1); PG8_STAGE(PG8_SA(1, 0), a3, voffA);
            PG8_BAR; PG8_WAIT_L(0); PG8_MMA(1, 0, At, B0); PG8_BAR; PG8_SCHED;
            PG8_STAGE(PG8_SB(1, 1), b3 + hstep, voffB);
            PG8_WAIT_V(6); PG8_BAR; PG8_MMA(1, 1, At, B1); PG8_BAR;
            }
        }
        if constexpr (ALIGN_EPI) { if (wr == 0) PG8_BAR; }
        if constexpr (!Epi::AFTER_DRAIN) { E(acc, cur, wr, wc, fr, fq); S.done(cur); }
        if (!has_next) break;
#pragma unroll
        for (int a = 0; a < 2; ++a)
#pragma unroll
            for (int b = 0; b < 2; ++b)
#pragma unroll
                for (int m = 0; m < 4; ++m)
#pragma unroll
                    for (int n = 0; n < 2; ++n) acc[a][b][m][n] = (f32x4){0.f, 0.f, 0.f, 0.f};
        cur = nxt; cA = nA; cB = nB; ++ui;
        if constexpr (ALIGN_EPI) { if (wr == 1) PG8_BAR; }
    }
    PG8_WAIT_V(0);
    if constexpr (!ALIGN_EPI) { if (wr == 0) PG8_BAR; }
    PG8_BAR;
    if constexpr (Epi::AFTER_DRAIN) { E.fused(acc, cur, wr, wc, fr, fq, lds, wid, lane); S.done(cur); }
#undef PG8_SA
#undef PG8_SB
#undef PG8_STAGE
#undef PG8_LDA
#undef PG8_LDB
#undef PG8_MMA
#undef PG8_WAIT_V
#undef PG8_WAIT_L
#undef PG8_BAR
#undef PG8_SCHED
}
}
constexpr int DM = 1024, NB = 4, SEQ = 4096, NCTX = 256, DFF = 2816, DIN = 4112, NPROJ = 4096, NMODC = 9216;
constexpr int MLAT = NB * SEQ, MCTX = NB * NCTX, MALL = MLAT + MCTX;
constexpr float EPSN = 1e-6f;
constexpr int NWAVES = 8, NTHREADS = 512;
#ifndef ONE_LAUNCH
#define ONE_LAUNCH 1
#endif
constexpr int NPHASES = 14;

constexpr size_t MiB = 1u << 20;
constexpr size_t WS_CTL = 0, CTL_ZERO_BYTES = 64 * 1024;
constexpr size_t WS_MODS = 1 * MiB;
constexpr size_t WS_GATES = 1 * MiB + 512 * 1024;
constexpr size_t WS_W1 = 3 * MiB;
constexpr size_t WS_W2 = 14 * MiB;
constexpr size_t WS_WIN = 20 * MiB;
constexpr size_t WS_WOUT = 28 * MiB;
constexpr size_t WS_X1CTX = 30 * MiB;
constexpr size_t WS_XN = 34 * MiB;
constexpr size_t WS_PROJ = 68 * MiB;
constexpr size_t WS_QK = 204 * MiB;
constexpr size_t WS_OF = 221 * MiB;
constexpr size_t WS_OB = 34 * MiB;
constexpr size_t WS_END = 256 * MiB;
constexpr int CW_BAR = 1024;

constexpr int RING_BYTES = 131072;
constexpr int LDSCTL_OFF = RING_BYTES, MISC_OFF = LDSCTL_OFF + 320;
constexpr int LDS_BYTES = 147456;

#define GAS __attribute__((address_space(1)))
#define LAS __attribute__((address_space(3)))
typedef unsigned short bf16;
typedef unsigned v4u __attribute__((ext_vector_type(4)));
typedef unsigned v2u __attribute__((ext_vector_type(2)));
typedef float f32x4 __attribute__((ext_vector_type(4)));
#define LDS_WAIT() asm volatile("s_waitcnt lgkmcnt(0)" ::: "memory")
#define VM_WAIT() asm volatile("s_waitcnt vmcnt(0)" ::: "memory")
__device__ __forceinline__ unsigned f2bf(float f) { unsigned u = __builtin_bit_cast(unsigned, f); return (u + 0x7fffu + ((u >> 16) & 1u)) >> 16; }
__device__ __forceinline__ unsigned pk2(float lo, float hi) { return f2bf(lo) | (f2bf(hi) << 16); }
__device__ __forceinline__ float bf2f(unsigned short h) { return __builtin_bit_cast(float, (unsigned)h << 16); }
__device__ __forceinline__ float bflo(unsigned w) { return __builtin_bit_cast(float, w << 16); }
__device__ __forceinline__ float bfhi(unsigned w) { return __builtin_bit_cast(float, w & 0xffff0000u); }
__device__ __forceinline__ float sigmoidf_(float v) { return 1.0f / (1.0f + __expf(-v)); }
__device__ __forceinline__ float siluf_(float v) { return v * sigmoidf_(v); }
__device__ __forceinline__ float wave_sum(float v) {
#pragma unroll
    for (int o = 1; o < 64; o <<= 1) v += __shfl_xor(v, o);
    return v;
}
#define XB_TMO      128
#define XB_XCNT(j)  (256  + 64 * (j))
#define XB_XSUB(j)  (1280 + 64 * (j))
#define XB_XGEN(j)  (2304 + 64 * (j))
#define XB_TOP      3328
#define XB_TOPGEN   3392
#define XCD_BAR_WORDS 3456
#define XB_SPIN_CAP (1u << 18)

__device__ __forceinline__ unsigned xb_ld(unsigned* p)              { return __hip_atomic_load(p, __ATOMIC_RELAXED, __HIP_MEMORY_SCOPE_AGENT); }
__device__ __forceinline__ unsigned xb_add(unsigned* p, unsigned v) { return __hip_atomic_fetch_add(p, v, __ATOMIC_RELAXED, __HIP_MEMORY_SCOPE_AGENT); }
__device__ __forceinline__ unsigned xb_xcc_id() { return (unsigned)__builtin_amdgcn_s_getreg((3 << 11) | 20) & 0xFu; }
#define XB_SPIN(cond, bar) do { unsigned _sp = 0; while (cond) { __builtin_amdgcn_s_sleep(1); \
    if ((++_sp & 255u) == 0u) { if (xb_ld(&(bar)[XB_TMO])) break; if (_sp > XB_SPIN_CAP) { atomicAdd(&(bar)[XB_TMO], 1u); break; } } } } while (0)

struct XcdBarrier {
    unsigned* bar; unsigned x;
    volatile LAS unsigned* st;
};

__device__ __forceinline__ XcdBarrier xcd_barrier_post(unsigned* bar, volatile LAS unsigned* st) {
    XcdBarrier b; b.bar = bar; b.x = xb_xcc_id(); b.st = st;
    if (threadIdx.x == 0) (void)xb_add(&bar[XB_XCNT(b.x)], 1u);
    return b;
}
__device__ __forceinline__ void xcd_barrier_complete(unsigned* bar, unsigned x, unsigned& nloc, unsigned& nx) {
    const unsigned G = gridDim.x * gridDim.y * gridDim.z;
    unsigned sum, cnt, mine, sp = 0u;
    for (;;) {
        sum = 0u; cnt = 0u; mine = 0u;
#pragma unroll
        for (unsigned j = 0; j < 16; ++j) { const unsigned c = xb_ld(&bar[XB_XCNT(j)]); sum += c; cnt += (c > 0u) ? 1u : 0u; mine = (j == x) ? c : mine; }
        if (sum == G) break;
        __builtin_amdgcn_s_sleep(1);
        if ((++sp & 255u) == 0u) { if (xb_ld(&bar[XB_TMO])) break; if (sp > XB_SPIN_CAP) { atomicAdd(&bar[XB_TMO], 1u); break; } }
    }
    nloc = mine > 0u ? mine : 1u; nx = cnt > 0u ? cnt : 1u;
}

__device__ __forceinline__ void xcd_barrier(const XcdBarrier& b) {
    asm volatile("s_waitcnt vmcnt(0)" ::: "memory");
    __syncthreads();
    if (threadIdx.x == 0) {
        unsigned* bar = b.bar;
        __builtin_amdgcn_s_waitcnt(0);
        unsigned nloc = b.st[0], nx = b.st[1];
        if (nloc == 0u) { xcd_barrier_complete(bar, b.x, nloc, nx); b.st[0] = nloc; b.st[1] = nx; }
        const unsigned old = xb_add(&bar[XB_XSUB(b.x)], 1u);
        const unsigned gen = old / nloc;
        if (old + 1u == (gen + 1u) * nloc) {
            __builtin_amdgcn_fence(__ATOMIC_RELEASE, "agent");
            asm volatile("s_waitcnt vmcnt(0)" ::: "memory");
            const unsigned og = xb_add(&bar[XB_TOP], 1u);
            const unsigned tg = og / nx;
            if (og + 1u == (tg + 1u) * nx) xb_add(&bar[XB_TOPGEN], 1u);
            else XB_SPIN(xb_ld(&bar[XB_TOPGEN]) == tg, bar);
            __builtin_amdgcn_fence(__ATOMIC_ACQUIRE, "agent");
            xb_add(&bar[XB_XGEN(b.x)], 1u);
            asm volatile("s_waitcnt vmcnt(0)" ::: "memory");
        } else {
            XB_SPIN(xb_ld(&bar[XB_XGEN(b.x)]) == gen, bar);
            __builtin_amdgcn_fence(__ATOMIC_ACQUIRE, "agent");
            asm volatile("s_waitcnt vmcnt(0)" ::: "memory");
        }
    }
    __syncthreads();
}
struct Args {
    const float* in[22]; float* out; unsigned char* ws; int ph_lo, ph_hi;
};
enum { I_X = 0, I_C, I_CTX, I_CCTX, I_WMOD, I_BMOD, I_N1W, I_F1W1, I_F1W2, I_N2W, I_WIN, I_MLGB, I_CONVW, I_CONVB, I_LBLOG, I_HGNW, I_MLNW, I_WOUT, I_N3W, I_F2W1, I_F2W2, I_FNW };

struct Ctx {
    LAS unsigned char* lds;
    int tid, lane, wave, vcu, G, gw, NGW;
};

__device__ __forceinline__ void mods_item(const Args& a, const Ctx& T, int item) {
    LAS float* sL = (LAS float*)T.lds;
    LAS float* red = (LAS float*)(T.lds + 20480);
    const float* c = a.in[I_C]; const float* cc = a.in[I_CCTX];
    for (int i = T.tid; i < 5 * 1024; i += NTHREADS) { const int r = i >> 10, k = i & 1023; const float v = r < 4 ? c[r * 1024 + k] : cc[k]; sL[i] = siluf_(v); }
    __syncthreads();
    const float* W = a.in[I_WMOD] + (size_t)(T.wave * 128) * NMODC + item * 64 + T.lane;
    float acc[5] = {0.f, 0.f, 0.f, 0.f, 0.f};
#pragma unroll 8
    for (int k = 0; k < 128; ++k) { const float w = W[(size_t)k * NMODC];
#pragma unroll
        for (int r = 0; r < 5; ++r) acc[r] += sL[r * 1024 + T.wave * 128 + k] * w; }
#pragma unroll
    for (int r = 0; r < 5; ++r) red[(T.wave * 5 + r) * 64 + T.lane] = acc[r];
    __syncthreads();
    if (T.tid < 320) { const int r = T.tid >> 6, l = T.tid & 63; float s = 0.f;
#pragma unroll
        for (int w = 0; w < 8; ++w) s += red[(w * 5 + r) * 64 + l];
        const int col = item * 64 + l;
        ((float*)(a.ws + WS_MODS))[r * NMODC + col] = s + a.in[I_BMOD][col]; }
    __syncthreads();
}

__device__ __forceinline__ void transpose_item(const float* W, int ldw, int K, bf16* WT, int k0, int n0, int dest_row0, LAS float* scr, int lane) {
#pragma unroll 8
    for (int i = 0; i < 32; ++i) { const int kk = 2 * i + (lane >> 5); scr[kk * 33 + (lane & 31)] = W[(size_t)(k0 + kk) * ldw + n0 + (lane & 31)]; }
    LDS_WAIT(); asm volatile("" ::: "memory");
    const int c = lane & 7;
#pragma unroll
    for (int j = 0; j < 4; ++j) { const int n = (lane >> 3) + 8 * j; const LAS float* s = scr + (8 * c) * 33 + n;
        v4u o; o.x = pk2(s[0 * 33], s[1 * 33]); o.y = pk2(s[2 * 33], s[3 * 33]); o.z = pk2(s[4 * 33], s[5 * 33]); o.w = pk2(s[6 * 33], s[7 * 33]);
        *(GAS v4u*)(WT + (size_t)(dest_row0 + n) * K + k0 + 8 * c) = o; }
    LDS_WAIT(); asm volatile("" ::: "memory");
}
__device__ __forceinline__ void convert_ffn(const Args& a, const Ctx& T, const float* w1, const float* w2) {
    LAS float* scr = (LAS float*)(T.lds + T.wave * 16384);
    bf16* W1 = (bf16*)(a.ws + WS_W1); bf16* W2 = (bf16*)(a.ws + WS_W2);
    constexpr int I1 = 16 * 176, I2 = 44 * 32;
    for (int it = T.gw; it < I1 + I2; it += T.NGW) {
        if (it < I1) { const int kb = it / 176, nb = it % 176, n0 = nb * 32;
            const int dest = n0 < DFF ? (n0 >> 7) * 256 + (n0 & 127) : ((n0 - DFF) >> 7) * 256 + 128 + ((n0 - DFF) & 127);
            transpose_item(w1, 2 * DFF, DM, W1, kb * 64, n0, dest, scr, T.lane); }
        else { const int r = it - I1, kb = r / 32, nb = r % 32; transpose_item(w2, DM, DFF, W2, kb * 64, nb * 32, nb * 32, scr, T.lane); }
    }
}
__device__ __forceinline__ void convert_mix(const Args& a, const Ctx& T) {
    LAS float* scr = (LAS float*)(T.lds + T.wave * 16384);
    bf16* WI = (bf16*)(a.ws + WS_WIN); bf16* WO = (bf16*)(a.ws + WS_WOUT);
    constexpr int I1 = 16 * 128, I2 = 16 * 32;
    for (int it = T.gw; it < I1 + I2; it += T.NGW) {
        if (it < I1) { const int kb = it / 128, nb = it % 128; transpose_item(a.in[I_WIN], DIN, DM, WI, kb * 64, nb * 32, nb * 32, scr, T.lane); }
        else { const int r = it - I1, kb = r / 32, nb = r % 32; transpose_item(a.in[I_WOUT], DM, DM, WO, kb * 64, nb * 32, nb * 32, scr, T.lane); }
    }
}

template <bool GATES>
__device__ __forceinline__ void norm_mod_rows(const Args& a, const Ctx& T, const float* src_lat, const float* src_ctx, int nrows, const float* nw, int shift_idx, int scale_idx) {
    const float* mods = (const float*)(a.ws + WS_MODS);
    bf16* XN = (bf16*)(a.ws + WS_XN);
    f32x4 wv[4];
#pragma unroll
    for (int j = 0; j < 4; ++j) wv[j] = *((const f32x4*)nw + T.lane + 64 * j);
    for (int m = T.gw; m < nrows; m += T.NGW) {
        const float* xrow = m < MLAT ? src_lat + (size_t)m * DM : src_ctx + (size_t)(m - MLAT) * DM;
        const float* mr = mods + (size_t)(m < MLAT ? (m >> 12) : 4) * NMODC;
        const f32x4* xr = (const f32x4*)xrow + T.lane;
        f32x4 v[4]; float s = 0.f;
#pragma unroll
        for (int j = 0; j < 4; ++j) { v[j] = xr[64 * j]; s += (v[j].x * v[j].x + v[j].y * v[j].y) + (v[j].z * v[j].z + v[j].w * v[j].w); }
        const float rstd = 1.0f / sqrtf(wave_sum(s) * (1.f / DM) + EPSN);
        unsigned long long* o8 = (unsigned long long*)(XN + (size_t)m * DM) + T.lane;
#pragma unroll
        for (int j = 0; j < 4; ++j) { const f32x4 sh = *((const f32x4*)(mr + shift_idx * 1024) + T.lane + 64 * j), sc = *((const f32x4*)(mr + scale_idx * 1024) + T.lane + 64 * j);
            v[j] = (v[j] * rstd * wv[j]) * (sc + 1.0f) + sh;
            o8[64 * j] = (unsigned long long)pk2(v[j].x, v[j].y) | ((unsigned long long)pk2(v[j].z, v[j].w) << 32); }
        if (GATES) {
            float g[16];
#pragma unroll
            for (int q = 0; q < 16; ++q) g[q] = 0.f;
#pragma unroll
            for (int j = 0; j < 4; ++j)
#pragma unroll
                for (int i = 0; i < 4; ++i) { const int c = 4 * T.lane + 256 * j + i; const f32x4* wg = (const f32x4*)(a.in[I_WIN] + (size_t)c * DIN + NPROJ); const float hv = v[j][i];
#pragma unroll
                    for (int q4 = 0; q4 < 4; ++q4) { const f32x4 w = wg[q4]; g[q4 * 4 + 0] += hv * w.x; g[q4 * 4 + 1] += hv * w.y; g[q4 * 4 + 2] += hv * w.z; g[q4 * 4 + 3] += hv * w.w; } }
            float mine = 0.f;
#pragma unroll
            for (int q = 0; q < 16; ++q) { const float t = wave_sum(g[q]); if (T.lane == q) mine = t; }
            if (T.lane < 16) ((float*)(a.ws + WS_GATES))[(size_t)m * 16 + T.lane] = mine + a.in[I_MLGB][T.lane];
        }
    }
}

__device__ __forceinline__ void conv_phase(const Args& a, const Ctx& T) {
    const bf16* P = (const bf16*)(a.ws + WS_PROJ); bf16* QK = (bf16*)(a.ws + WS_QK);
    const float* cw = a.in[I_CONVW]; const float* cb = a.in[I_CONVB];
    const int total = MALL * 64;
    for (int idx = T.vcu * NTHREADS + T.tid; idx < total; idx += T.G * NTHREADS) {
        const int m = idx >> 6, ch0 = (idx & 63) * 8;
        float acc[8];
#pragma unroll
        for (int i = 0; i < 8; ++i) acc[i] = cb[ch0 + i];
        if (m < MLAT) {
            const int b = m >> 12, t = m & 4095, r = t >> 6, c = t & 63;
#pragma unroll
            for (int dr = -1; dr <= 1; ++dr)
#pragma unroll
                for (int dc = -1; dc <= 1; ++dc) {
                    const int rr = r + dr, c2 = c + dc;
                    if (rr >= 0 && rr < 64 && c2 >= 0 && c2 < 64) {
                        const v4u pv = *(const v4u*)(P + (size_t)(b * 4096 + rr * 64 + c2) * NPROJ + 2560 + ch0);
                        const float* w = cw + ((dr + 1) * 3 + (dc + 1)) * 512 + ch0;
                        acc[0] += w[0] * bflo(pv.x); acc[1] += w[1] * bfhi(pv.x); acc[2] += w[2] * bflo(pv.y); acc[3] += w[3] * bfhi(pv.y);
                        acc[4] += w[4] * bflo(pv.z); acc[5] += w[5] * bfhi(pv.z); acc[6] += w[6] * bflo(pv.w); acc[7] += w[7] * bfhi(pv.w);
                    }
                }
        } else {
            const int mc = m - MLAT, b = mc >> 8, t = mc & 255;
#pragma unroll
            for (int d = -1; d <= 1; ++d) {
                const int t2 = t + d;
                if (t2 >= 0 && t2 < 256) {
                    const v4u pv = *(const v4u*)(P + (size_t)(MLAT + b * 256 + t2) * NPROJ + 2560 + ch0);
                    const float* w = cw + (3 + (d + 1)) * 512 + ch0;
                    acc[0] += w[0] * bflo(pv.x); acc[1] += w[1] * bfhi(pv.x); acc[2] += w[2] * bflo(pv.y); acc[3] += w[3] * bfhi(pv.y);
                    acc[4] += w[4] * bflo(pv.z); acc[5] += w[5] * bfhi(pv.z); acc[6] += w[6] * bflo(pv.w); acc[7] += w[7] * bfhi(pv.w);
                }
            }
        }
        const float sc = ch0 < 256 ? 0.125f : 1.0f;
#pragma unroll
        for (int i = 0; i < 8; ++i) acc[i] = siluf_(acc[i]) * sc;
        v4u o; o.x = pk2(acc[0], acc[1]); o.y = pk2(acc[2], acc[3]); o.z = pk2(acc[4], acc[5]); o.w = pk2(acc[6], acc[7]);
        *(v4u*)(QK + (size_t)m * 512 + ch0) = o;
    }
}

__device__ __forceinline__ int scan_row(int b, int dir, int p) {
    if (p < NCTX) return MLAT + b * NCTX + (dir ? NCTX - 1 - p : p);
    const int q = p - NCTX; return b * SEQ + (dir ? SEQ - 1 - q : q);
}
__device__ __forceinline__ void scan_hg_item(const Args& a, const Ctx& T, int item) {
    const int b = item >> 5, dir = (item >> 4) & 1, head = (item >> 2) & 3, es = item & 3;
    const bf16* P = (const bf16*)(a.ws + WS_PROJ);
    bf16* O = (bf16*)(a.ws + (dir ? WS_OB : WS_OF));
    LAS float* fL = (LAS float*)T.lds;
    LAS float* kL = fL + 32 * 128;
    LAS float* qL = kL + 32 * 128;
    LAS float* vL = qL + 32 * 128;
    LAS float* red = vL + 32 * 32;
    const int e = T.tid & 31, dg = T.tid >> 5;
    const float* lbl = a.in[I_LBLOG];
    float S[8];
#pragma unroll
    for (int j = 0; j < 8; ++j) S[j] = 0.f;
    for (int blk = 0; blk < (NCTX + SEQ) / 32; ++blk) {
        for (int idx = T.tid; idx < 32 * 128; idx += NTHREADS) { const int i = idx >> 7, d = idx & 127; const size_t m = (size_t)scan_row(b, dir, blk * 32 + i);
            const float fp = bf2f(P[m * NPROJ + (dir ? 2048 : 1536) + head * 128 + d]);
            const float qv = bf2f(P[m * NPROJ + head * 128 + d]);
            const int ch = head * 128 + d; const float lb = sigmoidf_(lbl[dir * 512 + ch] - lbl[(2 + dir) * 512 + ch]);
            const float sg = sigmoidf_(fp);
            fL[idx] = lb + (1.f - lb) * sg; kL[idx] = (1.f - lb) * (1.f - sg); qL[idx] = qv; }
        for (int idx = T.tid; idx < 32 * 32; idx += NTHREADS) { const int i = idx >> 5, ee = idx & 31; const size_t m = (size_t)scan_row(b, dir, blk * 32 + i);
            vL[idx] = bf2f(P[m * NPROJ + 512 + head * 128 + es * 32 + ee]); }
        __syncthreads();
#pragma unroll 1
        for (int half = 0; half < 2; ++half) {
#pragma unroll 4
            for (int ii = 0; ii < 16; ++ii) { const int i = half * 16 + ii; const float v = vL[i * 32 + e]; float po = 0.f;
#pragma unroll
                for (int j = 0; j < 8; ++j) { const int d = dg * 8 + j; S[j] = fL[i * 128 + d] * S[j] + kL[i * 128 + d] * v; po += qL[i * 128 + d] * S[j]; }
                red[(ii * 16 + dg) * 32 + e] = po; }
            __syncthreads();
            { const int ii = T.tid >> 5; float o = 0.f;
#pragma unroll
                for (int g = 0; g < 16; ++g) o += red[(ii * 16 + g) * 32 + e];
                const int p = blk * 32 + half * 16 + ii;
                if (p >= NCTX) { const size_t m = (size_t)scan_row(b, dir, p); O[m * DM + head * 128 + es * 32 + e] = (bf16)f2bf(o); } }
            __syncthreads();
        }
    }
}
__device__ __forceinline__ void scan_ml_item(const Args& a, const Ctx& T, int item) {
    const int b = item >> 5, dir = (item >> 4) & 1, head = (item >> 2) & 3, es = item & 3;
    const bf16* P = (const bf16*)(a.ws + WS_PROJ); const bf16* QK = (const bf16*)(a.ws + WS_QK); const float* GT = (const float*)(a.ws + WS_GATES);
    bf16* O = (bf16*)(a.ws + (dir ? WS_OB : WS_OF));
    LAS float* qL = (LAS float*)T.lds;
    LAS float* kL = qL + 32 * 64;
    LAS float* vL = kL + 32 * 64;
    LAS float* gi = vL + 32 * 32;
    LAS float* gf = gi + 32;
    LAS float* mv = gf + 32;
    LAS float* rden = mv + 16;
    LAS float* red = rden + 256;
    const int e = T.tid & 31, dg = T.tid >> 5;
    float C[4], n[4], mst = 0.f;
#pragma unroll
    for (int j = 0; j < 4; ++j) { C[j] = 0.f; n[j] = 0.f; }
    for (int blk = 0; blk < (NCTX + SEQ) / 32; ++blk) {
        for (int idx = T.tid; idx < 32 * 64; idx += NTHREADS) { const int i = idx >> 6, d = idx & 63; const size_t m = (size_t)scan_row(b, dir, blk * 32 + i);
            qL[idx] = bf2f(QK[m * 512 + head * 64 + d]); kL[idx] = bf2f(QK[m * 512 + 256 + head * 64 + d]); }
        for (int idx = T.tid; idx < 32 * 32; idx += NTHREADS) { const int i = idx >> 5, ee = idx & 31; const size_t m = (size_t)scan_row(b, dir, blk * 32 + i);
            vL[idx] = bf2f(P[m * NPROJ + 3072 + head * 128 + es * 32 + ee]); }
        if (T.tid < 32) { const size_t m = (size_t)scan_row(b, dir, blk * 32 + T.tid);
            gi[T.tid] = GT[m * 16 + (dir ? 8 : 0) + head]; const float f = GT[m * 16 + (dir ? 12 : 4) + head];
            gf[T.tid] = fminf(f, 0.f) - log1pf(__expf(-fabsf(f))); }
        __syncthreads();
#pragma unroll 1
        for (int half = 0; half < 2; ++half) {
#pragma unroll 2
            for (int ii = 0; ii < 16; ++ii) { const int i = half * 16 + ii; const float v = vL[i * 32 + e];
                const float it = gi[i], lf = gf[i]; const float mn = fmaxf(lf + mst, it); const float ca = __expf(lf + mst - mn), cbv = __expf(it - mn); mst = mn;
                float pn = 0.f, pd = 0.f;
#pragma unroll
                for (int j = 0; j < 4; ++j) { const int d = dg * 4 + j; const float kd = kL[i * 64 + d] * cbv, qd = qL[i * 64 + d]; C[j] = ca * C[j] + kd * v; n[j] = ca * n[j] + kd; pn += qd * C[j]; pd += qd * n[j]; }
                red[(ii * 16 + dg) * 32 + e] = pn; if (e == 0) rden[ii * 16 + dg] = pd; if (T.tid == 0) mv[ii] = mn; }
            __syncthreads();
            { const int ii = T.tid >> 5; float num = 0.f, den = 0.f;
#pragma unroll
                for (int g = 0; g < 16; ++g) { num += red[(ii * 16 + g) * 32 + e]; den += rden[ii * 16 + g]; }
                const int p = blk * 32 + half * 16 + ii;
                if (p >= NCTX) { const size_t m = (size_t)scan_row(b, dir, p); const float h = num / fmaxf(fabsf(den), __expf(-mv[ii])); O[m * DM + 512 + head * 128 + es * 32 + e] = (bf16)f2bf(h); } }
            __syncthreads();
        }
    }
}

__device__ __forceinline__ void headnorm_phase(const Args& a, const Ctx& T) {
    const bf16* P = (const bf16*)(a.ws + WS_PROJ); bf16* OF = (bf16*)(a.ws + WS_OF); const bf16* OB = (const bf16*)(a.ws + WS_OB);
    const int l = T.lane, head = l >> 3;
    const float* nw = head < 4 ? a.in[I_HGNW] + 16 * l : a.in[I_MLNW] + 16 * l - 512;
    const int gcol = head < 4 ? 1024 + 16 * l : 3584 + 16 * l - 512;
    float w[16];
#pragma unroll
    for (int j = 0; j < 16; ++j) w[j] = nw[j];
    for (int m = T.gw; m < MLAT; m += T.NGW) {
        const v4u f0 = *(const v4u*)(OF + (size_t)m * DM + 16 * l), f1 = *(const v4u*)(OF + (size_t)m * DM + 16 * l + 8);
        const v4u b0 = *(const v4u*)(OB + (size_t)m * DM + 16 * l), b1 = *(const v4u*)(OB + (size_t)m * DM + 16 * l + 8);
        const v4u g0 = *(const v4u*)(P + (size_t)m * NPROJ + gcol), g1 = *(const v4u*)(P + (size_t)m * NPROJ + gcol + 8);
        float o[16], g[16];
#pragma unroll
        for (int q = 0; q < 4; ++q) { o[2 * q] = bflo(f0[q]) + bflo(b0[q]); o[2 * q + 1] = bfhi(f0[q]) + bfhi(b0[q]); o[8 + 2 * q] = bflo(f1[q]) + bflo(b1[q]); o[8 + 2 * q + 1] = bfhi(f1[q]) + bfhi(b1[q]);
            g[2 * q] = bflo(g0[q]); g[2 * q + 1] = bfhi(g0[q]); g[8 + 2 * q] = bflo(g1[q]); g[8 + 2 * q + 1] = bfhi(g1[q]); }
        float ss = 0.f;
#pragma unroll
        for (int j = 0; j < 16; ++j) ss += o[j] * o[j];
        ss += __shfl_xor(ss, 1); ss += __shfl_xor(ss, 2); ss += __shfl_xor(ss, 4);
        const float r = 1.0f / sqrtf(ss * (1.f / 128.f) + EPSN);
#pragma unroll
        for (int j = 0; j < 16; ++j) o[j] = o[j] * r * w[j] * g[j];
        v4u o0, o1;
#pragma unroll
        for (int q = 0; q < 4; ++q) { o0[q] = pk2(o[2 * q], o[2 * q + 1]); o1[q] = pk2(o[8 + 2 * q], o[8 + 2 * q + 1]); }
        *(v4u*)(OF + (size_t)m * DM + 16 * l) = o0; *(v4u*)(OF + (size_t)m * DM + 16 * l + 8) = o1;
    }
}

__device__ __forceinline__ void final_norm_phase(const Args& a, const Ctx& T) {
    f32x4 wv[4];
#pragma unroll
    for (int j = 0; j < 4; ++j) wv[j] = *((const f32x4*)a.in[I_FNW] + T.lane + 64 * j);
    for (int m = T.gw; m < MLAT; m += T.NGW) {
        f32x4* xr = (f32x4*)(a.out + (size_t)m * DM) + T.lane;
        f32x4 v[4]; float s = 0.f;
#pragma unroll
        for (int j = 0; j < 4; ++j) { v[j] = xr[64 * j]; s += (v[j].x * v[j].x + v[j].y * v[j].y) + (v[j].z * v[j].z + v[j].w * v[j].w); }
        const float rstd = 1.0f / sqrtf(wave_sum(s) * (1.f / DM) + EPSN);
#pragma unroll
        for (int j = 0; j < 4; ++j) xr[64 * j] = v[j] * rstd * wv[j];
    }
}

__global__ void __launch_bounds__(NTHREADS, 2) fwd_kernel(Args a) {
    extern __shared__ __attribute__((aligned(16))) unsigned char lds_raw[];
    Ctx T;
    T.lds = (LAS unsigned char*)lds_raw;
    T.tid = threadIdx.x; T.lane = T.tid & 63; T.wave = __builtin_amdgcn_readfirstlane(T.tid >> 6);
    T.G = gridDim.x; { const int bx = blockIdx.x; T.vcu = (T.G % 8 == 0) ? (bx % 8) * (T.G / 8) + bx / 8 : bx; }
    T.gw = T.vcu * NWAVES + T.wave; T.NGW = T.G * NWAVES;
    volatile LAS unsigned* MISC = (volatile LAS unsigned*)(T.lds + MISC_OFF);
    for (int u = T.tid; u < (LDS_BYTES - LDSCTL_OFF) / 4; u += NTHREADS) ((LAS unsigned*)(T.lds + LDSCTL_OFF))[u] = 0u;
    __syncthreads();
    XcdBarrier bar; bar.bar = (unsigned*)(a.ws + WS_CTL) + CW_BAR; bar.x = 0; bar.st = nullptr;
    const bool multi = (a.ph_hi - a.ph_lo) > 1;
    if (multi) bar = xcd_barrier_post((unsigned*)(a.ws + WS_CTL) + CW_BAR, MISC + 8);
    const int lo = a.ph_lo, hi = a.ph_hi;
#define IN(k) (lo <= (k) && (k) < hi)
#define SEAM(k) do { if (IN(k) && IN((k) + 1)) xcd_barrier(bar); } while (0)
    bf16* XN = (bf16*)(a.ws + WS_XN); bf16* HB = (bf16*)(a.ws + WS_PROJ); bf16* PROJ = (bf16*)(a.ws + WS_PROJ);
    float* X1C = (float*)(a.ws + WS_X1CTX); const float* mods = (const float*)(a.ws + WS_MODS);
    const int bx = (int)blockIdx.x;

    if (IN(0)) { if (bx < 144) mods_item(a, T, bx); convert_ffn(a, T, a.in[I_F1W1], a.in[I_F1W2]); convert_mix(a, T); }
    SEAM(0);
    if (IN(1)) norm_mod_rows<false>(a, T, a.in[I_X], a.in[I_CTX], MALL, a.in[I_N1W], 0, 1);
    SEAM(1);
    if (IN(2)) { pg8::Gemm g{XN, (const bf16*)(a.ws + WS_W1), MALL, 2 * DFF, DM}; pg8::StaticOrder S; S.init(MALL, 2 * DFF, T.G, bx);
        pg8::EpiSwiglu E{HB, DFF}; pg8::gemm_phase<pg8::EpiSwiglu, pg8::StaticOrder, true, true>(T.lds, g, S, E); }
    SEAM(2);
    if (IN(3)) { pg8::Gemm g{HB, (const bf16*)(a.ws + WS_W2), MALL, DM, DFF}; pg8::StaticOrder S; S.init(MALL, DM, T.G, bx);
        pg8::EpiResid E{a.in[I_X], a.in[I_CTX], a.out, X1C, mods + 2 * 1024, 0.5f}; pg8::gemm_phase<pg8::EpiResid, pg8::StaticOrder, true, true>(T.lds, g, S, E); }
    SEAM(3);
    if (IN(4)) { norm_mod_rows<true>(a, T, a.out, X1C, MALL, a.in[I_N2W], 3, 4); convert_ffn(a, T, a.in[I_F2W1], a.in[I_F2W2]); }
    SEAM(4);
    if (IN(5)) { pg8::Gemm g{XN, (const bf16*)(a.ws + WS_WIN), MALL, NPROJ, DM}; pg8::StaticOrder S; S.init(MALL, NPROJ, T.G, bx);
        pg8::EpiProj E{PROJ, NPROJ}; pg8::gemm_phase<pg8::EpiProj, pg8::StaticOrder, true, true>(T.lds, g, S, E); }
    SEAM(5);
    if (IN(6)) conv_phase(a, T);
    SEAM(6);
    if (IN(7)) { for (int it = bx; it < 256; it += T.G) { if (it < 128) scan_hg_item(a, T, it); else scan_ml_item(a, T, it - 128); } }
    SEAM(7);
    if (IN(8)) headnorm_phase(a, T);
    SEAM(8);
    if (IN(9)) { pg8::Gemm g{(const bf16*)(a.ws + WS_OF), (const bf16*)(a.ws + WS_WOUT), MLAT, DM, DM}; pg8::StaticOrder S; S.init(MLAT, DM, T.G, bx);
        pg8::EpiResid E{a.out, a.out, a.out, a.out, mods + 5 * 1024, 1.0f}; pg8::gemm_phase<pg8::EpiResid, pg8::StaticOrder, true, true>(T.lds, g, S, E); }
    SEAM(9);
    if (IN(10)) norm_mod_rows<false>(a, T, a.out, a.out, MLAT, a.in[I_N3W], 6, 7);
    SEAM(10);
    if (IN(11)) { pg8::Gemm g{XN, (const bf16*)(a.ws + WS_W1), MLAT, 2 * DFF, DM}; pg8::StaticOrder S; S.init(MLAT, 2 * DFF, T.G, bx);
        pg8::EpiSwiglu E{HB, DFF}; pg8::gemm_phase<pg8::EpiSwiglu, pg8::StaticOrder, true, true>(T.lds, g, S, E); }
    SEAM(11);
    if (IN(12)) { pg8::Gemm g{HB, (const bf16*)(a.ws + WS_W2), MLAT, DM, DFF}; pg8::StaticOrder S; S.init(MLAT, DM, T.G, bx);
        pg8::EpiResid E{a.out, a.out, a.out, a.out, mods + 8 * 1024, 0.5f}; pg8::gemm_phase<pg8::EpiResid, pg8::StaticOrder, true, true>(T.lds, g, S, E); }
    SEAM(12);
    if (IN(13)) final_norm_phase(a, T);
#undef IN
#undef SEAM
}

extern "C" void kernel_launch(void* const* d_in, const int* in_sizes, int n_in, void* d_out, int out_size, void* d_ws, size_t ws_size, hipStream_t stream) {
    static int grid = 0;
    if (grid == 0) {
        if (n_in != 22 || out_size != MLAT * DM || ws_size < WS_END) { fprintf(stderr, "kernel_launch: unexpected shapes (n_in %d out %d ws %zu)\n", n_in, out_size, ws_size); grid = -1; return; }
        int dev = 0, cus = 0;
        if (hipGetDevice(&dev) != hipSuccess || hipDeviceGetAttribute(&cus, hipDeviceAttributeMultiprocessorCount, dev) != hipSuccess) { grid = -1; return; }
        if (hipFuncSetAttribute((const void*)fwd_kernel, hipFuncAttributeMaxDynamicSharedMemorySize, LDS_BYTES) != hipSuccess) { fprintf(stderr, "kernel_launch: hipFuncSetAttribute failed\n"); grid = -1; return; }
        (void)hipGetLastError();
        grid = cus;
    }
    if (grid < 0) return;
    (void)hipMemsetAsync((char*)d_ws + WS_CTL, 0, CTL_ZERO_BYTES, stream);
    Args a{};
    for (int i = 0; i < 22; ++i) a.in[i] = (const float*)d_in[i];
    a.out = (float*)d_out; a.ws = (unsigned char*)d_ws;
#if ONE_LAUNCH
    a.ph_lo = 0; a.ph_hi = NPHASES;
    hipLaunchKernelGGL(fwd_kernel, dim3(grid), dim3(NTHREADS), LDS_BYTES, stream, a);
#else
    for (int p = 0; p < NPHASES; ++p) { a.ph_lo = p; a.ph_hi = p + 1; hipLaunchKernelGGL(fwd_kernel, dim3(grid), dim3(NTHREADS), LDS_BYTES, stream, a); }
#endif
}
```

```cpp
#include <hip/hip_runtime.h>
#include <cstdio>
#include <cstdint>
namespace pg8 {
#define PG8_LAS __attribute__((address_space(3)))
typedef unsigned short bf16_t;
typedef short bf16x8 __attribute__((ext_vector_type(8)));
typedef float f32x4 __attribute__((ext_vector_type(4)));
typedef unsigned u32x4 __attribute__((ext_vector_type(4)));
constexpr int BM = 256, BK = 64, HALF = 128, HTB = HALF * BK * 2  , STAGE_BYTES = 8 * HTB, NXCD = 8, WGM = 8;

__host__ __device__ __forceinline__ int lds_byte(int r, int c) { const int st = (r >> 4) * 2 + (c >> 5), rr = r & 15, cc = c & 31, ob = rr * 64 + cc * 2; return st * 1024 + (ob ^ (((ob >> 9) & 1) << 5)); }
__host__ __device__ __forceinline__ void stage_rc(int b, int& R, int& C) { const int st = b / 1024, sb = b % 1024, swz = sb ^ (((sb >> 9) & 1) << 5); R = (st >> 1) * 16 + swz / 64; C = (st & 1) * 32 + (swz % 64) / 2; }
__host__ __device__ __forceinline__ int perm32(int rho) { const int n = rho >> 4, i = rho & 15; return 8 * (i >> 2) + 4 * n + (i & 3); }

struct Unit { int pm, pn; };
struct Gemm { const bf16_t* A; const bf16_t* Bt; int M, N, K; };

struct StaticOrder {
    int nM, nN, nwg, G, c;
    __host__ __device__ void init(int M, int N, int G_, int c_) { nM = M / BM; nN = N / BM; nwg = nM * nN; G = G_; c = c_; }
    __host__ __device__ bool next(int i, Unit& u) const {
        const long L = (long)i * G + c; if (L >= nwg) return false;
        int wgid = (int)L; { const int q = nwg / NXCD, r = nwg % NXCD, xcd = wgid % NXCD, off = wgid / NXCD; wgid = (xcd < r ? xcd * (q + 1) : r * (q + 1) + (xcd - r) * q) + off; }
        const int nig = WGM * nN, gid = wgid / nig, fm = gid * WGM, gsz = (nM - fm) < WGM ? (nM - fm) : WGM;
        u.pm = fm + ((wgid % nig) % gsz); u.pn = (wgid % nig) / gsz; return true;
    }
    __device__ __forceinline__ void a_ready(const Unit&) const {}
    __device__ __forceinline__ void done(const Unit&) const {}
};
__device__ __forceinline__ unsigned cvt_pk_bf16(float lo, float hi) { unsigned r; asm volatile("v_cvt_pk_bf16_f32 %0, %1, %2" : "=v"(r) : "v"(lo), "v"(hi)); return r; }
typedef float f32x2 __attribute__((ext_vector_type(2)));
__device__ __forceinline__ float fast_sigmoid(float v) { return __builtin_amdgcn_rcpf(1.0f + __builtin_amdgcn_exp2f(-1.4426950408889634f * v)); }
__device__ __forceinline__ float fast_silu(float v) { return v * fast_sigmoid(v); }

struct EpiSwiglu {
    static constexpr bool PERM = true, AFTER_DRAIN = false;
    bf16_t* H; int ldh;
    __device__ __forceinline__ void operator()(const f32x4 (&acc)[2][2][4][2], const Unit& u, int wr, int wc, int fr, int fq) const {
        const int row0 = u.pm * BM + wr * 64 + fr, col0 = u.pn * HALF + wc * 32 + 8 * fq;
#pragma unroll
        for (int ai = 0; ai < 2; ++ai)
#pragma unroll
            for (int m = 0; m < 4; ++m) { bf16_t* rowp = H + (size_t)(row0 + ai * HALF + m * 16) * ldh + col0;
                float r[8];
#pragma unroll
                for (int n = 0; n < 2; ++n)
#pragma unroll
                    for (int i = 0; i < 4; ++i) r[n * 4 + i] = fast_silu(acc[ai][0][m][n][i]) * acc[ai][1][m][n][i];
                u32x4 w; w.x = cvt_pk_bf16(r[0], r[1]); w.y = cvt_pk_bf16(r[2], r[3]); w.z = cvt_pk_bf16(r[4], r[5]); w.w = cvt_pk_bf16(r[6], r[7]);
                *(u32x4*)rowp = w; }
    }
};

struct EpiResid {
    static constexpr bool PERM = false, AFTER_DRAIN = false;
    const float* base_lat; const float* base_ctx; float* out_lat; float* out_ctx; const float* gate; float coef;
    __device__ __forceinline__ void operator()(const f32x4 (&acc)[2][2][4][2], const Unit& u, int wr, int wc, int fr, int fq) const {
        const bool isctx = u.pm >= 64;
        const float* base = isctx ? base_ctx + (size_t)(u.pm - 64) * BM * 1024 : base_lat + (size_t)u.pm * BM * 1024;
        float* out = isctx ? out_ctx + (size_t)(u.pm - 64) * BM * 1024 : out_lat + (size_t)u.pm * BM * 1024;
        const float* g = gate + (size_t)(isctx ? 4 : (u.pm >> 4)) * 9216;
        const int col0 = u.pn * BM + wc * 32 + 4 * fq;
        f32x4 gv[2][2];
#pragma unroll
        for (int bj = 0; bj < 2; ++bj)
#pragma unroll
            for (int n = 0; n < 2; ++n) gv[bj][n] = *(const f32x4*)(g + col0 + bj * HALF + n * 16) * coef;
#pragma unroll
        for (int ai = 0; ai < 2; ++ai)
#pragma unroll
            for (int m = 0; m < 4; ++m) { const size_t off = (size_t)(ai * HALF + wr * 64 + m * 16 + fr) * 1024 + col0;
#pragma unroll
                for (int bj = 0; bj < 2; ++bj)
#pragma unroll
                    for (int n = 0; n < 2; ++n) { const f32x4 b = *(const f32x4*)(base + off + bj * HALF + n * 16);
                        *(f32x4*)(out + off + bj * HALF + n * 16) = b + gv[bj][n] * acc[ai][bj][m][n]; } }
    }
};

struct EpiProj {
    static constexpr bool PERM = true, AFTER_DRAIN = false;
    bf16_t* O; int ldc;
    __device__ __forceinline__ void operator()(const f32x4 (&acc)[2][2][4][2], const Unit& u, int wr, int wc, int fr, int fq) const {
        const int row0 = u.pm * BM + wr * 64 + fr, col0 = u.pn * BM + wc * 32 + 8 * fq;
        const int mode = (u.pn < 2) ? 1 : ((u.pn == 4 || u.pn == 5) ? 2 : (u.pn >= 14 ? 3 : 0));
#pragma unroll
        for (int ai = 0; ai < 2; ++ai)
#pragma unroll
            for (int m = 0; m < 4; ++m) { bf16_t* rowp = O + (size_t)(row0 + ai * HALF + m * 16) * ldc + col0;
#pragma unroll
                for (int bj = 0; bj < 2; ++bj) { float r[8];
#pragma unroll
                    for (int n = 0; n < 2; ++n)
#pragma unroll
                        for (int i = 0; i < 4; ++i) { const float v = acc[ai][bj][m][n][i];
                            r[n * 4 + i] = mode == 0 ? v : (mode == 1 ? fast_silu(v) * 0.08838834764831845f : (mode == 2 ? fast_silu(v) : fast_sigmoid(v))); }
                    u32x4 w; w.x = cvt_pk_bf16(r[0], r[1]); w.y = cvt_pk_bf16(r[2], r[3]); w.z = cvt_pk_bf16(r[4], r[5]); w.w = cvt_pk_bf16(r[6], r[7]);
                    *(u32x4*)(rowp + bj * HALF) = w; } }
    }
};
template <class Epi, class Sched, bool ALIGN_EPI = false, bool SP2 = false>
__device__ __forceinline__ void gemm_phase(PG8_LAS unsigned char* lds, const Gemm g, const Sched& S, const Epi& E) {
    const int tid = threadIdx.x, wid = __builtin_amdgcn_readfirstlane(tid >> 6), lane = tid & 63, wr = wid >> 2, wc = wid & 3, fr = lane & 15, fq = lane >> 4;
    const int K = g.K, nt = K / BK;
    unsigned voffA[2], voffB[2];
#pragma unroll
    for (int i = 0; i < 2; ++i) { int R, C; stage_rc(tid * 16 + i * 8192, R, C); const int Rb = Epi::PERM ? ((R & ~31) + perm32(R & 31)) : R;
        voffA[i] = (unsigned)(R * K + C) * 2u; voffB[i] = (unsigned)(Rb * K + C) * 2u; }
    const size_t kstep = (size_t)(BK * 2);
    const size_t hstep = (size_t)HALF * K * 2;
    const size_t tstep = 2 * hstep;
    const unsigned ldsw = (unsigned)wid * 1024u;
    const int aoff = lds_byte(wr * 64 + fr, fq * 8), boff = lds_byte(wc * 32 + fr, fq * 8);
#define PG8_SA(b, h) (((b) * 2 + (h)) * HTB)
#define PG8_SB(b, h) ((4 + (b) * 2 + (h)) * HTB)
#define PG8_STAGE(bufoff, gbase, voff) do { _Pragma("unroll") for (int _i = 0; _i < 2; ++_i) \
        __builtin_amdgcn_global_load_lds((const unsigned*)((const char*)(gbase) + (voff)[_i]), (PG8_LAS unsigned*)(lds + (bufoff) + ldsw + _i * 8192), 16, 0, 0); } while (0)
#define PG8_LDA(dst, b, h) do { _Pragma("unroll") for (int m = 0; m < 4; ++m) _Pragma("unroll") for (int k = 0; k < 2; ++k) dst[m][k] = *(const PG8_LAS bf16x8*)(lds + PG8_SA(b, h) + aoff + m * 2048 + k * 1024); } while (0)
#define PG8_LDB(dst, b, h) do { _Pragma("unroll") for (int n = 0; n < 2; ++n) _Pragma("unroll") for (int k = 0; k < 2; ++k) dst[n][k] = *(const PG8_LAS bf16x8*)(lds + PG8_SB(b, h) + boff + n * 2048 + k * 1024); } while (0)
#define PG8_MMA(ai, bj, At, Bt) do { __builtin_amdgcn_s_setprio(1); _Pragma("unroll") for (int m = 0; m < 4; ++m) _Pragma("unroll") for (int n = 0; n < 2; ++n) _Pragma("unroll") for (int k = 0; k < 2; ++k) \
        acc[ai][bj][m][n] = __builtin_amdgcn_mfma_f32_16x16x32_bf16(Bt[n][k], At[m][k], acc[ai][bj][m][n], 0, 0, 0); __builtin_amdgcn_s_setprio(0); } while (0)
#define PG8_WAIT_V(n) asm volatile("s_waitcnt vmcnt(" #n ")" ::: "memory")
#define PG8_WAIT_L(n) asm volatile("s_waitcnt lgkmcnt(" #n ")" ::: "memory")
#define PG8_BAR __builtin_amdgcn_s_barrier()
#define PG8_SCHED __builtin_amdgcn_sched_barrier(0)
    Unit cur, nxt; int ui = 0;
    if (!S.next(0, cur)) return;
    f32x4 acc[2][2][4][2];
#pragma unroll
    for (int a = 0; a < 2; ++a)
#pragma unroll
        for (int b = 0; b < 2; ++b)
#pragma unroll
            for (int m = 0; m < 4; ++m)
#pragma unroll
                for (int n = 0; n < 2; ++n) acc[a][b][m][n] = (f32x4){0.f, 0.f, 0.f, 0.f};
    bf16x8 At[4][2], B0[2][2], B1[2][2];
    const char* cA = (const char*)g.A + (size_t)cur.pm * tstep; const char* cB = (const char*)g.Bt + (size_t)cur.pn * tstep;
    S.a_ready(cur);
    if constexpr (SP2) {
        PG8_STAGE(PG8_SB(0, 0), cB, voffB); PG8_STAGE(PG8_SB(0, 1), cB + hstep, voffB); PG8_STAGE(PG8_SA(0, 0), cA, voffA); PG8_STAGE(PG8_SA(0, 1), cA + hstep, voffA);
        if (wr == 1) PG8_BAR;
        PG8_WAIT_V(2); PG8_BAR;
        PG8_STAGE(PG8_SB(1, 0), cB + kstep, voffB); PG8_STAGE(PG8_SA(1, 0), cA + kstep, voffA); PG8_STAGE(PG8_SB(1, 1), cB + hstep + kstep, voffB);
        PG8_WAIT_V(6); PG8_BAR;
    } else {
        PG8_STAGE(PG8_SB(0, 0), cB, voffB); PG8_STAGE(PG8_SA(0, 0), cA, voffA); PG8_STAGE(PG8_SB(0, 1), cB + hstep, voffB); PG8_STAGE(PG8_SA(0, 1), cA + hstep, voffA);
        if (wr == 1) PG8_BAR;
        PG8_WAIT_V(4); PG8_BAR;
        PG8_STAGE(PG8_SB(1, 0), cB + kstep, voffB); PG8_STAGE(PG8_SA(1, 0), cA + kstep, voffA); PG8_STAGE(PG8_SB(1, 1), cB + hstep + kstep, voffB);
        PG8_WAIT_V(6); PG8_BAR;
    }
    for (;;) {
        const bool has_next = S.next(ui + 1, nxt);
        const char* nA = has_next ? (const char*)g.A + (size_t)nxt.pm * tstep : cA; const char* nB = has_next ? (const char*)g.Bt + (size_t)nxt.pn * tstep : cB;
        for (int t = 0; t < nt; t += 2) {
            const bool last = (t == nt - 2);
            const char* a1 = cA + (size_t)(t + 1) * kstep;
            const char* a2 = last ? nA : cA + (size_t)(t + 2) * kstep; const char* b2 = last ? nB : cB + (size_t)(t + 2) * kstep;
            const char* a3 = a2 + kstep; const char* b3 = b2 + kstep;
            if (last && has_next) S.a_ready(nxt);
            if constexpr (SP2) {
            PG8_LDB(B0, 0, 0); PG8_LDB(B1, 0, 1); PG8_SCHED; PG8_LDA(At, 0, 0); PG8_STAGE(PG8_SA(1, 1), a1 + hstep, voffA);
            PG8_WAIT_V(8); PG8_WAIT_L(0); PG8_BAR; PG8_MMA(0, 0, At, B0); PG8_MMA(0, 1, At, B1); PG8_BAR; PG8_SCHED;
            PG8_LDA(At, 0, 1); PG8_STAGE(PG8_SB(0, 0), b2, voffB); PG8_STAGE(PG8_SB(0, 1), b2 + hstep, voffB); PG8_STAGE(PG8_SA(0, 0), a2, voffA);
            PG8_WAIT_V(8); PG8_WAIT_L(0); PG8_BAR; PG8_MMA(1, 0, At, B0); PG8_MMA(1, 1, At, B1); PG8_BAR; PG8_SCHED;
            PG8_LDB(B0, 1, 0); PG8_LDB(B1, 1, 1); PG8_SCHED; PG8_LDA(At, 1, 0); PG8_STAGE(PG8_SA(0, 1), a2 + hstep, voffA);
            PG8_WAIT_V(8); PG8_WAIT_L(0); PG8_BAR; PG8_MMA(0, 0, At, B0); PG8_MMA(0, 1, At, B1); PG8_BAR; PG8_SCHED;
            PG8_LDA(At, 1, 1); PG8_STAGE(PG8_SB(1, 0), b3, voffB); PG8_STAGE(PG8_SB(1, 1), b3 + hstep, voffB); PG8_STAGE(PG8_SA(1, 0), a3, voffA);
            PG8_WAIT_V(8); PG8_WAIT_L(0); PG8_BAR; PG8_MMA(1, 0, At, B0); PG8_MMA(1, 1, At, B1); PG8_BAR; PG8_SCHED;
            } else {
            PG8_LDB(B0, 0, 0); PG8_SCHED; PG8_LDA(At, 0, 0); PG8_STAGE(PG8_SA(1, 1), a1 + hstep, voffA);
            PG8_WAIT_L(8); PG8_BAR; PG8_WAIT_L(0); PG8_MMA(0, 0, At, B0); PG8_BAR; PG8_SCHED;
            PG8_LDB(B1, 0, 1); PG8_STAGE(PG8_SB(0, 0), b2, voffB);
            PG8_BAR; PG8_WAIT_L(0); PG8_MMA(0, 1, At, B1); PG8_BAR;
            PG8_LDA(At, 0, 1); PG8_STAGE(PG8_SA(0, 0), a2, voffA);
            PG8_BAR; PG8_WAIT_L(0); PG8_MMA(1, 0, At, B0); PG8_BAR; PG8_SCHED;
            PG8_STAGE(PG8_SB(0, 1), b2 + hstep, voffB);
            PG8_WAIT_V(6); PG8_BAR; PG8_MMA(1, 1, At, B1); PG8_BAR;
            PG8_LDB(B0, 1, 0); PG8_SCHED; PG8_LDA(At, 1, 0); PG8_STAGE(PG8_SA(0, 1), a2 + hstep, voffA);
            PG8_WAIT_L(8); PG8_BAR; PG8_WAIT_L(0); PG8_MMA(0, 0, At, B0); PG8_BAR; PG8_SCHED;
            PG8_LDB(B1, 1, 1); PG8_STAGE(PG8_SB(1, 0), b3, voffB);
            PG8_BAR; PG8_WAIT_L(0); PG8_MMA(0, 1, At, B1); PG8_BAR;
            PG8_LDA(At, 1, 1); PG8_STAGE(PG8_SA(1, 0), a3, voffA);
            PG8_BAR; PG8_WAIT_L(0); PG8_MMA(1, 0, At, B0); PG8_BAR; PG8_SCHED;
            PG8_STAGE(PG8_SB(1, 1), b3 + hstep, voffB);
            PG8_WAIT_V(6); PG8_BAR; PG8_MMA(1, 1, At, B1); PG8_BAR;
            }
        }
        if constexpr (ALIGN_EPI) { if (wr == 0) PG8_BAR; }
        if constexpr (!Epi::AFTER_DRAIN) { E(acc, cur, wr, wc, fr, fq); S.done(cur); }
        if (!has_next) break;
#pragma unroll
        for (int a = 0; a < 2; ++a)
#pragma unroll
            for (int b = 0; b < 2; ++b)
#pragma unroll
                for (int m = 0; m < 4; ++m)
#pragma unroll
                    for (int n = 0; n < 2; ++n) acc[a][b][m][n] = (f32x4){0.f, 0.f, 0.f, 0.f};
        cur = nxt; cA = nA; cB = nB; ++ui;
        if constexpr (ALIGN_EPI) { if (wr == 1) PG8_BAR; }
    }
    PG8_WAIT_V(0);
    if constexpr (!ALIGN_EPI) { if (wr == 0) PG8_BAR; }
    PG8_BAR;
    if constexpr (Epi::AFTER_DRAIN) { E.fused(acc, cur, wr, wc, fr, fq, lds, wid, lane); S.done(cur); }
#undef PG8_SA
#undef PG8_SB
#undef PG8_STAGE
#undef PG8_LDA
#undef PG8_LDB
#undef PG8_MMA
#undef PG8_WAIT_V
#undef PG8_WAIT_L
#undef PG8_BAR
#undef PG8_SCHED
}
}
constexpr int DM = 1024, NB = 4, SEQ = 4096, NCTX = 256, DFF = 2816, DIN = 4112, NPROJ = 4096, NMODC = 9216;
constexpr int MLAT = NB * SEQ, MCTX = NB * NCTX, MALL = MLAT + MCTX;
constexpr float EPSN = 1e-6f;
constexpr int NWAVES = 8, NTHREADS = 512;
#ifndef ONE_LAUNCH
#define ONE_LAUNCH 1
#endif
constexpr int NPHASES = 16;

constexpr size_t MiB = 1u << 20;
constexpr size_t WS_CTL = 0, CTL_ZERO_BYTES = 64 * 1024;
constexpr size_t WS_MODS = 1 * MiB;
constexpr size_t WS_GATES = 1 * MiB + 512 * 1024;
constexpr size_t WS_W1 = 3 * MiB;
constexpr size_t WS_W2 = 14 * MiB;
constexpr size_t WS_WIN = 20 * MiB;
constexpr size_t WS_WOUT = 28 * MiB;
constexpr size_t WS_X1CTX = 30 * MiB;
constexpr size_t WS_XN = 34 * MiB;
constexpr size_t WS_PROJ = 68 * MiB;
constexpr size_t WS_QK = 204 * MiB;
constexpr size_t WS_OF = 221 * MiB;
constexpr size_t WS_OB = 34 * MiB;
constexpr size_t WS_END = 256 * MiB;
constexpr size_t WS_HGST = 3 * MiB;
constexpr size_t WS_HGG = 19 * MiB;
constexpr size_t WS_MLST = 221 * MiB;
constexpr size_t WS_MLSC = 231 * MiB;
constexpr int CW_BAR = 1024;

constexpr int RING_BYTES = 131072;
constexpr int LDSCTL_OFF = 162816, MISC_OFF = LDSCTL_OFF + 320;
constexpr int LDS_BYTES = 163840;

#define GAS __attribute__((address_space(1)))
#define LAS __attribute__((address_space(3)))
typedef unsigned short bf16;
typedef unsigned v4u __attribute__((ext_vector_type(4)));
typedef unsigned v2u __attribute__((ext_vector_type(2)));
typedef float f32x4 __attribute__((ext_vector_type(4)));
#define LDS_WAIT() asm volatile("s_waitcnt lgkmcnt(0)" ::: "memory")
#define VM_WAIT() asm volatile("s_waitcnt vmcnt(0)" ::: "memory")
__device__ __forceinline__ unsigned f2bf(float f) { unsigned u = __builtin_bit_cast(unsigned, f); return (u + 0x7fffu + ((u >> 16) & 1u)) >> 16; }
__device__ __forceinline__ unsigned pk2(float lo, float hi) { return f2bf(lo) | (f2bf(hi) << 16); }
__device__ __forceinline__ float bf2f(unsigned short h) { return __builtin_bit_cast(float, (unsigned)h << 16); }
__device__ __forceinline__ float bflo(unsigned w) { return __builtin_bit_cast(float, w << 16); }
__device__ __forceinline__ float bfhi(unsigned w) { return __builtin_bit_cast(float, w & 0xffff0000u); }
__device__ __forceinline__ float sigmoidf_(float v) { return 1.0f / (1.0f + __expf(-v)); }
__device__ __forceinline__ float fast_sig(float v) { return __builtin_amdgcn_rcpf(1.0f + __builtin_amdgcn_exp2f(-1.4426950408889634f * v)); }
__device__ __forceinline__ float siluf_(float v) { return v * sigmoidf_(v); }
__device__ __forceinline__ float wave_sum(float v) {
#pragma unroll
    for (int o = 1; o < 64; o <<= 1) v += __shfl_xor(v, o);
    return v;
}
#define XB_TMO      128
#define XB_XCNT(j)  (256  + 64 * (j))
#define XB_XSUB(j)  (1280 + 64 * (j))
#define XB_XGEN(j)  (2304 + 64 * (j))
#define XB_TOP      3328
#define XB_TOPGEN   3392
#define XCD_BAR_WORDS 3456
#define XB_SPIN_CAP (1u << 18)

__device__ __forceinline__ unsigned xb_ld(unsigned* p)              { return __hip_atomic_load(p, __ATOMIC_RELAXED, __HIP_MEMORY_SCOPE_AGENT); }
__device__ __forceinline__ unsigned xb_add(unsigned* p, unsigned v) { return __hip_atomic_fetch_add(p, v, __ATOMIC_RELAXED, __HIP_MEMORY_SCOPE_AGENT); }
__device__ __forceinline__ unsigned xb_xcc_id() { return (unsigned)__builtin_amdgcn_s_getreg((3 << 11) | 20) & 0xFu; }
#define XB_SPIN(cond, bar) do { unsigned _sp = 0; while (cond) { __builtin_amdgcn_s_sleep(1); \
    if ((++_sp & 255u) == 0u) { if (xb_ld(&(bar)[XB_TMO])) break; if (_sp > XB_SPIN_CAP) { atomicAdd(&(bar)[XB_TMO], 1u); break; } } } } while (0)

struct XcdBarrier {
    unsigned* bar; unsigned x;
    volatile LAS unsigned* st;
};

__device__ __forceinline__ XcdBarrier xcd_barrier_post(unsigned* bar, volatile LAS unsigned* st) {
    XcdBarrier b; b.bar = bar; b.x = xb_xcc_id(); b.st = st;
    if (threadIdx.x == 0) (void)xb_add(&bar[XB_XCNT(b.x)], 1u);
    return b;
}
__device__ __forceinline__ void xcd_barrier_complete(unsigned* bar, unsigned x, unsigned& nloc, unsigned& nx) {
    const unsigned G = gridDim.x * gridDim.y * gridDim.z;
    unsigned sum, cnt, mine, sp = 0u;
    for (;;) {
        sum = 0u; cnt = 0u; mine = 0u;
#pragma unroll
        for (unsigned j = 0; j < 16; ++j) { const unsigned c = xb_ld(&bar[XB_XCNT(j)]); sum += c; cnt += (c > 0u) ? 1u : 0u; mine = (j == x) ? c : mine; }
        if (sum == G) break;
        __builtin_amdgcn_s_sleep(1);
        if ((++sp & 255u) == 0u) { if (xb_ld(&bar[XB_TMO])) break; if (sp > XB_SPIN_CAP) { atomicAdd(&bar[XB_TMO], 1u); break; } }
    }
    nloc = mine > 0u ? mine : 1u; nx = cnt > 0u ? cnt : 1u;
}

__device__ __forceinline__ void xcd_barrier(const XcdBarrier& b) {
    asm volatile("s_waitcnt vmcnt(0)" ::: "memory");
    __syncthreads();
    if (threadIdx.x == 0) {
        unsigned* bar = b.bar;
        __builtin_amdgcn_s_waitcnt(0);
        unsigned nloc = b.st[0], nx = b.st[1];
        if (nloc == 0u) { xcd_barrier_complete(bar, b.x, nloc, nx); b.st[0] = nloc; b.st[1] = nx; }
        const unsigned old = xb_add(&bar[XB_XSUB(b.x)], 1u);
        const unsigned gen = old / nloc;
        if (old + 1u == (gen + 1u) * nloc) {
            __builtin_amdgcn_fence(__ATOMIC_RELEASE, "agent");
            asm volatile("s_waitcnt vmcnt(0)" ::: "memory");
            const unsigned og = xb_add(&bar[XB_TOP], 1u);
            const unsigned tg = og / nx;
            if (og + 1u == (tg + 1u) * nx) xb_add(&bar[XB_TOPGEN], 1u);
            else XB_SPIN(xb_ld(&bar[XB_TOPGEN]) == tg, bar);
            __builtin_amdgcn_fence(__ATOMIC_ACQUIRE, "agent");
            xb_add(&bar[XB_XGEN(b.x)], 1u);
            asm volatile("s_waitcnt vmcnt(0)" ::: "memory");
        } else {
            XB_SPIN(xb_ld(&bar[XB_XGEN(b.x)]) == gen, bar);
            __builtin_amdgcn_fence(__ATOMIC_ACQUIRE, "agent");
            asm volatile("s_waitcnt vmcnt(0)" ::: "memory");
        }
    }
    __syncthreads();
}
struct Args {
    const float* in[22]; float* out; unsigned char* ws; int ph_lo, ph_hi;
};
enum { I_X = 0, I_C, I_CTX, I_CCTX, I_WMOD, I_BMOD, I_N1W, I_F1W1, I_F1W2, I_N2W, I_WIN, I_MLGB, I_CONVW, I_CONVB, I_LBLOG, I_HGNW, I_MLNW, I_WOUT, I_N3W, I_F2W1, I_F2W2, I_FNW };

struct Ctx {
    LAS unsigned char* lds;
    int tid, lane, wave, vcu, G, gw, NGW;
};

__device__ __forceinline__ void mods_item(const Args& a, const Ctx& T, int item) {
    LAS float* sL = (LAS float*)T.lds;
    LAS float* red = (LAS float*)(T.lds + 20480);
    const float* c = a.in[I_C]; const float* cc = a.in[I_CCTX];
    for (int i = T.tid; i < 5 * 1024; i += NTHREADS) { const int r = i >> 10, k = i & 1023; const float v = r < 4 ? c[r * 1024 + k] : cc[k]; sL[i] = siluf_(v); }
    __syncthreads();
    const float* W = a.in[I_WMOD] + (size_t)(T.wave * 128) * NMODC + item * 64 + T.lane;
    float acc[5] = {0.f, 0.f, 0.f, 0.f, 0.f};
#pragma unroll 8
    for (int k = 0; k < 128; ++k) { const float w = W[(size_t)k * NMODC];
#pragma unroll
        for (int r = 0; r < 5; ++r) acc[r] += sL[r * 1024 + T.wave * 128 + k] * w; }
#pragma unroll
    for (int r = 0; r < 5; ++r) red[(T.wave * 5 + r) * 64 + T.lane] = acc[r];
    __syncthreads();
    if (T.tid < 320) { const int r = T.tid >> 6, l = T.tid & 63; float s = 0.f;
#pragma unroll
        for (int w = 0; w < 8; ++w) s += red[(w * 5 + r) * 64 + l];
        const int col = item * 64 + l;
        ((float*)(a.ws + WS_MODS))[r * NMODC + col] = s + a.in[I_BMOD][col]; }
    __syncthreads();
}

__device__ __forceinline__ void transpose_item(const float* W, int ldw, int K, bf16* WT, int k0, int n0, int dest_row0, LAS float* scr, int lane) {
#pragma unroll 8
    for (int i = 0; i < 32; ++i) { const int kk = 2 * i + (lane >> 5); scr[kk * 33 + (lane & 31)] = W[(size_t)(k0 + kk) * ldw + n0 + (lane & 31)]; }
    LDS_WAIT(); asm volatile("" ::: "memory");
    const int c = lane & 7;
#pragma unroll
    for (int j = 0; j < 4; ++j) { const int n = (lane >> 3) + 8 * j; const LAS float* s = scr + (8 * c) * 33 + n;
        v4u o; o.x = pk2(s[0 * 33], s[1 * 33]); o.y = pk2(s[2 * 33], s[3 * 33]); o.z = pk2(s[4 * 33], s[5 * 33]); o.w = pk2(s[6 * 33], s[7 * 33]);
        *(GAS v4u*)(WT + (size_t)(dest_row0 + n) * K + k0 + 8 * c) = o; }
    LDS_WAIT(); asm volatile("" ::: "memory");
}
__device__ __forceinline__ void convert_ffn(const Args& a, const Ctx& T, const float* w1, const float* w2) {
    LAS float* scr = (LAS float*)(T.lds + T.wave * 16384);
    bf16* W1 = (bf16*)(a.ws + WS_W1); bf16* W2 = (bf16*)(a.ws + WS_W2);
    constexpr int I1 = 16 * 176, I2 = 44 * 32;
    for (int it = T.gw; it < I1 + I2; it += T.NGW) {
        if (it < I1) { const int kb = it / 176, nb = it % 176, n0 = nb * 32;
            const int dest = n0 < DFF ? (n0 >> 7) * 256 + (n0 & 127) : ((n0 - DFF) >> 7) * 256 + 128 + ((n0 - DFF) & 127);
            transpose_item(w1, 2 * DFF, DM, W1, kb * 64, n0, dest, scr, T.lane); }
        else { const int r = it - I1, kb = r / 32, nb = r % 32; transpose_item(w2, DM, DFF, W2, kb * 64, nb * 32, nb * 32, scr, T.lane); }
    }
}
__device__ __forceinline__ void convert_mix(const Args& a, const Ctx& T) {
    LAS float* scr = (LAS float*)(T.lds + T.wave * 16384);
    bf16* WI = (bf16*)(a.ws + WS_WIN); bf16* WO = (bf16*)(a.ws + WS_WOUT);
    constexpr int I1 = 16 * 128, I2 = 16 * 32;
    for (int it = T.gw; it < I1 + I2; it += T.NGW) {
        if (it < I1) { const int kb = it / 128, nb = it % 128; transpose_item(a.in[I_WIN], DIN, DM, WI, kb * 64, nb * 32, nb * 32, scr, T.lane); }
        else { const int r = it - I1, kb = r / 32, nb = r % 32; transpose_item(a.in[I_WOUT], DM, DM, WO, kb * 64, nb * 32, nb * 32, scr, T.lane); }
    }
}

template <bool GATES>
__device__ __forceinline__ void norm_mod_rows(const Args& a, const Ctx& T, const float* src_lat, const float* src_ctx, int nrows, const float* nw, int shift_idx, int scale_idx) {
    const float* mods = (const float*)(a.ws + WS_MODS);
    bf16* XN = (bf16*)(a.ws + WS_XN);
    f32x4 wv[4];
#pragma unroll
    for (int j = 0; j < 4; ++j) wv[j] = *((const f32x4*)nw + T.lane + 64 * j);
    for (int m = T.gw; m < nrows; m += T.NGW) {
        const float* xrow = m < MLAT ? src_lat + (size_t)m * DM : src_ctx + (size_t)(m - MLAT) * DM;
        const float* mr = mods + (size_t)(m < MLAT ? (m >> 12) : 4) * NMODC;
        const f32x4* xr = (const f32x4*)xrow + T.lane;
        f32x4 v[4]; float s = 0.f;
#pragma unroll
        for (int j = 0; j < 4; ++j) { v[j] = xr[64 * j]; s += (v[j].x * v[j].x + v[j].y * v[j].y) + (v[j].z * v[j].z + v[j].w * v[j].w); }
        const float rstd = 1.0f / sqrtf(wave_sum(s) * (1.f / DM) + EPSN);
        unsigned long long* o8 = (unsigned long long*)(XN + (size_t)m * DM) + T.lane;
#pragma unroll
        for (int j = 0; j < 4; ++j) { const f32x4 sh = *((const f32x4*)(mr + shift_idx * 1024) + T.lane + 64 * j), sc = *((const f32x4*)(mr + scale_idx * 1024) + T.lane + 64 * j);
            v[j] = (v[j] * rstd * wv[j]) * (sc + 1.0f) + sh;
            o8[64 * j] = (unsigned long long)pk2(v[j].x, v[j].y) | ((unsigned long long)pk2(v[j].z, v[j].w) << 32); }
        if (GATES) {
            float g[16];
#pragma unroll
            for (int q = 0; q < 16; ++q) g[q] = 0.f;
#pragma unroll
            for (int j = 0; j < 4; ++j)
#pragma unroll
                for (int i = 0; i < 4; ++i) { const int c = 4 * T.lane + 256 * j + i; const f32x4* wg = (const f32x4*)(a.in[I_WIN] + (size_t)c * DIN + NPROJ); const float hv = v[j][i];
#pragma unroll
                    for (int q4 = 0; q4 < 4; ++q4) { const f32x4 w = wg[q4]; g[q4 * 4 + 0] += hv * w.x; g[q4 * 4 + 1] += hv * w.y; g[q4 * 4 + 2] += hv * w.z; g[q4 * 4 + 3] += hv * w.w; } }
            float mine = 0.f;
#pragma unroll
            for (int q = 0; q < 16; ++q) { const float t = wave_sum(g[q]); if (T.lane == q) mine = t; }
            if (T.lane < 16) ((float*)(a.ws + WS_GATES))[(size_t)m * 16 + T.lane] = mine + a.in[I_MLGB][T.lane];
        }
    }
}

__device__ __forceinline__ void conv_phase(const Args& a, const Ctx& T) {
    const bf16* P = (const bf16*)(a.ws + WS_PROJ); bf16* QK = (bf16*)(a.ws + WS_QK);
    const float* cw = a.in[I_CONVW]; const float* cb = a.in[I_CONVB];
    const int total = MALL * 64;
    for (int idx = T.vcu * NTHREADS + T.tid; idx < total; idx += T.G * NTHREADS) {
        const int m = idx >> 6, ch0 = (idx & 63) * 8;
        float acc[8];
#pragma unroll
        for (int i = 0; i < 8; ++i) acc[i] = cb[ch0 + i];
        if (m < MLAT) {
            const int b = m >> 12, t = m & 4095, r = t >> 6, c = t & 63;
#pragma unroll
            for (int dr = -1; dr <= 1; ++dr)
#pragma unroll
                for (int dc = -1; dc <= 1; ++dc) {
                    const int rr = r + dr, c2 = c + dc;
                    if (rr >= 0 && rr < 64 && c2 >= 0 && c2 < 64) {
                        const v4u pv = *(const v4u*)(P + (size_t)(b * 4096 + rr * 64 + c2) * NPROJ + 2560 + ch0);
                        const float* w = cw + ((dr + 1) * 3 + (dc + 1)) * 512 + ch0;
                        acc[0] += w[0] * bflo(pv.x); acc[1] += w[1] * bfhi(pv.x); acc[2] += w[2] * bflo(pv.y); acc[3] += w[3] * bfhi(pv.y);
                        acc[4] += w[4] * bflo(pv.z); acc[5] += w[5] * bfhi(pv.z); acc[6] += w[6] * bflo(pv.w); acc[7] += w[7] * bfhi(pv.w);
                    }
                }
        } else {
            const int mc = m - MLAT, b = mc >> 8, t = mc & 255;
#pragma unroll
            for (int d = -1; d <= 1; ++d) {
                const int t2 = t + d;
                if (t2 >= 0 && t2 < 256) {
                    const v4u pv = *(const v4u*)(P + (size_t)(MLAT + b * 256 + t2) * NPROJ + 2560 + ch0);
                    const float* w = cw + (3 + (d + 1)) * 512 + ch0;
                    acc[0] += w[0] * bflo(pv.x); acc[1] += w[1] * bfhi(pv.x); acc[2] += w[2] * bflo(pv.y); acc[3] += w[3] * bfhi(pv.y);
                    acc[4] += w[4] * bflo(pv.z); acc[5] += w[5] * bfhi(pv.z); acc[6] += w[6] * bflo(pv.w); acc[7] += w[7] * bfhi(pv.w);
                }
            }
        }
        const float sc = ch0 < 256 ? 0.125f : 1.0f;
#pragma unroll
        for (int i = 0; i < 8; ++i) acc[i] = siluf_(acc[i]) * sc;
        v4u o; o.x = pk2(acc[0], acc[1]); o.y = pk2(acc[2], acc[3]); o.z = pk2(acc[4], acc[5]); o.w = pk2(acc[6], acc[7]);
        *(v4u*)(QK + (size_t)m * 512 + ch0) = o;
    }
}

__device__ __forceinline__ int scan_row(int b, int dir, int p) {
    if (p < NCTX) return MLAT + b * NCTX + (dir ? NCTX - 1 - p : p);
    const int q = p - NCTX; return b * SEQ + (dir ? SEQ - 1 - q : q);
}
__device__ __forceinline__ void scan_hg_item(const Args& a, const Ctx& T, int item) {
    const int b = item >> 5, dir = (item >> 4) & 1, head = (item >> 2) & 3, es = item & 3;
    const bf16* P = (const bf16*)(a.ws + WS_PROJ);
    bf16* O = (bf16*)(a.ws + (dir ? WS_OB : WS_OF));
    LAS float* fL = (LAS float*)T.lds;
    LAS float* kL = fL + 32 * 128;
    LAS float* qL = kL + 32 * 128;
    LAS float* vL = qL + 32 * 128;
    LAS float* red = vL + 32 * 32;
    const int e = T.tid & 31, dg = T.tid >> 5;
    const float* lbl = a.in[I_LBLOG];
    float S[8];
#pragma unroll
    for (int j = 0; j < 8; ++j) S[j] = 0.f;
    for (int blk = 0; blk < (NCTX + SEQ) / 32; ++blk) {
        for (int idx = T.tid; idx < 32 * 128; idx += NTHREADS) { const int i = idx >> 7, d = idx & 127; const size_t m = (size_t)scan_row(b, dir, blk * 32 + i);
            const float fp = bf2f(P[m * NPROJ + (dir ? 2048 : 1536) + head * 128 + d]);
            const float qv = bf2f(P[m * NPROJ + head * 128 + d]);
            const int ch = head * 128 + d; const float lb = sigmoidf_(lbl[dir * 512 + ch] - lbl[(2 + dir) * 512 + ch]);
            const float sg = sigmoidf_(fp);
            fL[idx] = lb + (1.f - lb) * sg; kL[idx] = (1.f - lb) * (1.f - sg); qL[idx] = qv; }
        for (int idx = T.tid; idx < 32 * 32; idx += NTHREADS) { const int i = idx >> 5, ee = idx & 31; const size_t m = (size_t)scan_row(b, dir, blk * 32 + i);
            vL[idx] = bf2f(P[m * NPROJ + 512 + head * 128 + es * 32 + ee]); }
        __syncthreads();
#pragma unroll 1
        for (int half = 0; half < 2; ++half) {
#pragma unroll 4
            for (int ii = 0; ii < 16; ++ii) { const int i = half * 16 + ii; const float v = vL[i * 32 + e]; float po = 0.f;
#pragma unroll
                for (int j = 0; j < 8; ++j) { const int d = dg * 8 + j; S[j] = fL[i * 128 + d] * S[j] + kL[i * 128 + d] * v; po += qL[i * 128 + d] * S[j]; }
                red[(ii * 16 + dg) * 32 + e] = po; }
            __syncthreads();
            { const int ii = T.tid >> 5; float o = 0.f;
#pragma unroll
                for (int g = 0; g < 16; ++g) o += red[(ii * 16 + g) * 32 + e];
                const int p = blk * 32 + half * 16 + ii;
                if (p >= NCTX) { const size_t m = (size_t)scan_row(b, dir, p); O[m * DM + head * 128 + es * 32 + e] = (bf16)f2bf(o); } }
            __syncthreads();
        }
    }
}
__device__ __forceinline__ void scan_ml_item(const Args& a, const Ctx& T, int item) {
    const int b = item >> 5, dir = (item >> 4) & 1, head = (item >> 2) & 3, es = item & 3;
    const bf16* P = (const bf16*)(a.ws + WS_PROJ); const bf16* QK = (const bf16*)(a.ws + WS_QK); const float* GT = (const float*)(a.ws + WS_GATES);
    bf16* O = (bf16*)(a.ws + (dir ? WS_OB : WS_OF));
    LAS float* qL = (LAS float*)T.lds;
    LAS float* kL = qL + 32 * 64;
    LAS float* vL = kL + 32 * 64;
    LAS float* gi = vL + 32 * 32;
    LAS float* gf = gi + 32;
    LAS float* mv = gf + 32;
    LAS float* rden = mv + 16;
    LAS float* red = rden + 256;
    const int e = T.tid & 31, dg = T.tid >> 5;
    float C[4], n[4], mst = 0.f;
#pragma unroll
    for (int j = 0; j < 4; ++j) { C[j] = 0.f; n[j] = 0.f; }
    for (int blk = 0; blk < (NCTX + SEQ) / 32; ++blk) {
        for (int idx = T.tid; idx < 32 * 64; idx += NTHREADS) { const int i = idx >> 6, d = idx & 63; const size_t m = (size_t)scan_row(b, dir, blk * 32 + i);
            qL[idx] = bf2f(QK[m * 512 + head * 64 + d]); kL[idx] = bf2f(QK[m * 512 + 256 + head * 64 + d]); }
        for (int idx = T.tid; idx < 32 * 32; idx += NTHREADS) { const int i = idx >> 5, ee = idx & 31; const size_t m = (size_t)scan_row(b, dir, blk * 32 + i);
            vL[idx] = bf2f(P[m * NPROJ + 3072 + head * 128 + es * 32 + ee]); }
        if (T.tid < 32) { const size_t m = (size_t)scan_row(b, dir, blk * 32 + T.tid);
            gi[T.tid] = GT[m * 16 + (dir ? 8 : 0) + head]; const float f = GT[m * 16 + (dir ? 12 : 4) + head];
            gf[T.tid] = fminf(f, 0.f) - log1pf(__expf(-fabsf(f))); }
        __syncthreads();
#pragma unroll 1
        for (int half = 0; half < 2; ++half) {
#pragma unroll 2
            for (int ii = 0; ii < 16; ++ii) { const int i = half * 16 + ii; const float v = vL[i * 32 + e];
                const float it = gi[i], lf = gf[i]; const float mn = fmaxf(lf + mst, it); const float ca = __expf(lf + mst - mn), cbv = __expf(it - mn); mst = mn;
                float pn = 0.f, pd = 0.f;
#pragma unroll
                for (int j = 0; j < 4; ++j) { const int d = dg * 4 + j; const float kd = kL[i * 64 + d] * cbv, qd = qL[i * 64 + d]; C[j] = ca * C[j] + kd * v; n[j] = ca * n[j] + kd; pn += qd * C[j]; pd += qd * n[j]; }
                red[(ii * 16 + dg) * 32 + e] = pn; if (e == 0) rden[ii * 16 + dg] = pd; if (T.tid == 0) mv[ii] = mn; }
            __syncthreads();
            { const int ii = T.tid >> 5; float num = 0.f, den = 0.f;
#pragma unroll
                for (int g = 0; g < 16; ++g) { num += red[(ii * 16 + g) * 32 + e]; den += rden[ii * 16 + g]; }
                const int p = blk * 32 + half * 16 + ii;
                if (p >= NCTX) { const size_t m = (size_t)scan_row(b, dir, p); const float h = num / fmaxf(fabsf(den), __expf(-mv[ii])); O[m * DM + 512 + head * 128 + es * 32 + e] = (bf16)f2bf(h); } }
            __syncthreads();
        }
    }
}

typedef short bf16x8 __attribute__((ext_vector_type(8)));
typedef float f32x2 __attribute__((ext_vector_type(2)));
#define MFMA16(a, b, c) __builtin_amdgcn_mfma_f32_16x16x32_bf16((a), (b), (c), 0, 0, 0)
template <int KSTEPS>
__device__ __forceinline__ void mma_tile(f32x4& acc, const LAS unsigned char* A, int sa, const LAS unsigned char* B, int sb, int lane) {
    const LAS unsigned char* pa = A + (lane & 15) * sa + (lane >> 4) * 16; const LAS unsigned char* pb = B + (lane & 15) * sb + (lane >> 4) * 16;
#pragma unroll
    for (int ks = 0; ks < KSTEPS; ++ks) { const bf16x8 av = *(const LAS bf16x8*)(pa + ks * 64); const bf16x8 bv = *(const LAS bf16x8*)(pb + ks * 64); acc = MFMA16(av, bv, acc); }
}
__device__ __forceinline__ float ex2(float v) { return __builtin_amdgcn_exp2f(v); }
__device__ __forceinline__ float lg2(float v) { return __builtin_amdgcn_logf(v); }

constexpr int HS_ND = 272;
constexpr int HS_T = 144;
constexpr int HL_QD = 0, HL_KD = HL_QD + 64 * HS_ND, HL_X = HL_KD + 64 * HS_ND, HL_QE = HL_X + 64 * HS_ND;
constexpr int HL_KTT = HL_QE + 64 * HS_ND;
constexpr int HL_VT = HL_KTT + 128 * HS_T;
constexpr int HL_ST = HL_VT + 128 * HS_T;
constexpr int HL_P = HL_ST + 128 * HS_ND;
constexpr int HL_SEG = HL_P + 64 * HS_T;
constexpr int HL_FAC = HL_SEG + 4096;
constexpr int HL_RS = HL_FAC + 512;
constexpr int HL_RSTD = HL_RS + 2048;
constexpr int HL_END = HL_RSTD + 256;
static_assert(HL_END <= 160 * 1024 - 1024, "HGRN2 LDS map");

constexpr size_t HG_SLOT_BYTES = 128 * 128 * 2;
__device__ __forceinline__ size_t hg_seq(int b, int dir, int head) { return (size_t)((b * 2 + dir) * 4 + head); }

__device__ __forceinline__ int sc_row(int b, int dir, int js, int lt) {
    if (js == 0) return MLAT + b * NCTX + (dir ? NCTX - 1 - lt : lt);
    const int q = 256 * (js - 1) + lt; return b * SEQ + (dir ? SEQ - 1 - q : q);
}

__device__ __forceinline__ void hg_pass1_item(const Args& a, const Ctx& T, int item) {
    const int js = item & 15, head = (item >> 4) & 3, dir = (item >> 6) & 1, b = item >> 7;
    const bf16* P = (const bf16*)(a.ws + WS_PROJ);
    LAS unsigned char* L = T.lds;
    const int w = T.wave, l = T.lane, g = l >> 4, c16 = l & 15;
    const int ch = head * 128 + 2 * l;
    const float* lbl = a.in[I_LBLOG];
    float lb[2];
#pragma unroll
    for (int x = 0; x < 2; ++x) lb[x] = sigmoidf_(lbl[dir * 512 + ch + x] - lbl[(2 + dir) * 512 + ch + x]);
    const int fcol = (dir ? 2048 : 1536) + ch, vcol = 512 + ch;
    f32x4 accS[8];
#pragma unroll
    for (int m = 0; m < 8; ++m) accS[m] = (f32x4){0.f, 0.f, 0.f, 0.f};
    float gsum[2] = {0.f, 0.f};
    for (int c = 0; c < 4; ++c) {
        unsigned fw[8], vw[8];
#pragma unroll
        for (int i = 0; i < 8; ++i) { const size_t row = (size_t)sc_row(b, dir, js, 64 * c + 8 * w + i); fw[i] = *(const unsigned*)(P + row * NPROJ + fcol); vw[i] = *(const unsigned*)(P + row * NPROJ + vcol); }
        float kk[2][8], suf[2][8], tot[2];
#pragma unroll
        for (int x = 0; x < 2; ++x) { float run = 0.f;
#pragma unroll
            for (int i = 7; i >= 0; --i) { const float fp = x ? bfhi(fw[i]) : bflo(fw[i]); const float sg = fast_sig(fp); const float f = lb[x] + (1.f - lb[x]) * sg;
                kk[x][i] = (1.f - lb[x]) * (1.f - sg); suf[x][i] = run; run += lg2(f); }
            tot[x] = run; }
        *(LAS f32x2*)(L + HL_SEG + (w * 128 + 2 * l) * 4) = (f32x2){tot[0], tot[1]};
        __syncthreads();
        float later[2] = {0.f, 0.f}, all[2] = {0.f, 0.f};
#pragma unroll
        for (int ww = 0; ww < 8; ++ww) { const f32x2 t2 = *(const LAS f32x2*)(L + HL_SEG + (ww * 128 + 2 * l) * 4); all[0] += t2.x; all[1] += t2.y; if (ww > w) { later[0] += t2.x; later[1] += t2.y; } }
#pragma unroll
        for (int x = 0; x < 2; ++x) { unsigned pk[4], pv[4];
#pragma unroll
            for (int i = 0; i < 8; i += 2) { const float k0 = kk[x][i] * ex2(later[x] + suf[x][i]), k1 = kk[x][i + 1] * ex2(later[x] + suf[x][i + 1]); pk[i >> 1] = pk2(k0, k1);
                const unsigned short v0 = x ? (unsigned short)(vw[i] >> 16) : (unsigned short)(vw[i] & 0xffffu), v1 = x ? (unsigned short)(vw[i + 1] >> 16) : (unsigned short)(vw[i + 1] & 0xffffu);
                pv[i >> 1] = (unsigned)v0 | ((unsigned)v1 << 16); }
            *(LAS v4u*)(L + HL_KTT + (2 * l + x) * HS_T + 16 * w) = (v4u){pk[0], pk[1], pk[2], pk[3]};
            *(LAS v4u*)(L + HL_VT + (2 * l + x) * HS_T + 16 * w) = (v4u){pv[0], pv[1], pv[2], pv[3]};
            gsum[x] += all[x]; }
        if (w == 0) *(LAS f32x2*)(L + HL_FAC + (2 * l) * 4) = (f32x2){ex2(all[0]), ex2(all[1])};
        __syncthreads();
#pragma unroll
        for (int m = 0; m < 8; ++m) { const f32x4 gv = *(const LAS f32x4*)(L + HL_FAC + (16 * m + 4 * g) * 4); accS[m] = accS[m] * gv;
            mma_tile<2>(accS[m], L + HL_KTT + 16 * m * HS_T, HS_T, L + HL_VT + 16 * w * HS_T, HS_T, l); }
        __syncthreads();
    }
    const size_t sidx = hg_seq(b, dir, head) * 16 + js;
    bf16* ST = (bf16*)(a.ws + WS_HGST + sidx * HG_SLOT_BYTES);
#pragma unroll
    for (int m = 0; m < 8; ++m) { v2u o; o.x = pk2(accS[m][0], accS[m][1]); o.y = pk2(accS[m][2], accS[m][3]);
        *(v2u*)(ST + (size_t)(16 * w + c16) * 128 + 16 * m + 4 * g) = o; }
    if (w == 0) *(f32x2*)((float*)(a.ws + WS_HGG) + sidx * 128 + 2 * l) = (f32x2){ex2(gsum[0]), ex2(gsum[1])};
}

__device__ __forceinline__ void hg_pass2(const Args& a, const Ctx& T) {
    const int ntask = 32 * 2048;
    for (int task = T.vcu * NTHREADS + T.tid; task < ntask; task += T.G * NTHREADS) {
        const int seq = task >> 11, el = (task & 2047) * 8, d0 = el & 127;
        float r[8];
#pragma unroll
        for (int i = 0; i < 8; ++i) r[i] = 0.f;
        for (int j = 0; j < 16; ++j) {
            v4u* p = (v4u*)(a.ws + WS_HGST + ((size_t)seq * 16 + j) * HG_SLOT_BYTES + (size_t)el * 2);
            const float* G = (const float*)(a.ws + WS_HGG) + ((size_t)seq * 16 + j) * 128 + d0;
            const v4u dv = *p; const f32x4 g0 = *(const f32x4*)G, g1 = *(const f32x4*)(G + 4);
            r[0] = g0.x * r[0] + bflo(dv.x); r[1] = g0.y * r[1] + bfhi(dv.x); r[2] = g0.z * r[2] + bflo(dv.y); r[3] = g0.w * r[3] + bfhi(dv.y);
            r[4] = g1.x * r[4] + bflo(dv.z); r[5] = g1.y * r[5] + bfhi(dv.z); r[6] = g1.z * r[6] + bflo(dv.w); r[7] = g1.w * r[7] + bfhi(dv.w);
            *p = (v4u){pk2(r[0], r[1]), pk2(r[2], r[3]), pk2(r[4], r[5]), pk2(r[6], r[7])};
        }
    }
}

__device__ __forceinline__ void hg_pass3_item(const Args& a, const Ctx& T, int item, bf16* OUT) {
    const int jt = item & 15, head = (item >> 4) & 3, b = item >> 6;
    const bf16* P = (const bf16*)(a.ws + WS_PROJ);
    LAS unsigned char* L = T.lds;
    const int w = T.wave, l = T.lane, g = l >> 4, c16 = l & 15;
    const int ch = head * 128 + 2 * l;
    const float* lbl = a.in[I_LBLOG];
    for (int i = T.tid; i < 64 * HS_T / 16; i += NTHREADS) *(LAS v4u*)(L + HL_P + i * 16) = (v4u){0u, 0u, 0u, 0u};
    const float nwv = a.in[I_HGNW][head * 128 + 16 * w + c16];
#pragma unroll 1
    for (int dir = 0; dir < 2; ++dir) {
        float lb[2];
#pragma unroll
        for (int x = 0; x < 2; ++x) lb[x] = sigmoidf_(lbl[dir * 512 + ch + x] - lbl[(2 + dir) * 512 + ch + x]);
        const int fcol = (dir ? 2048 : 1536) + ch, qcol = ch, vcol = 512 + ch;
        const int slot = dir ? 15 - jt : jt;
        const bf16* STg = (const bf16*)(a.ws + WS_HGST + (hg_seq(b, dir, head) * 16 + slot) * HG_SLOT_BYTES);
        __syncthreads();
        for (int i = T.tid; i < 128 * 16; i += NTHREADS) { const int e = i >> 4, q = i & 15; *(LAS v4u*)(L + HL_ST + e * HS_ND + q * 16) = *(const v4u*)(STg + (size_t)e * 128 + q * 8); }
        __syncthreads();
        f32x4 accS[8];
#pragma unroll
        for (int m = 0; m < 8; ++m) { const v2u sv = *(const LAS v2u*)(L + HL_ST + (16 * w + c16) * HS_ND + (16 * m + 4 * g) * 2); accS[m] = (f32x4){bflo(sv.x), bfhi(sv.x), bflo(sv.y), bfhi(sv.y)}; }
#pragma unroll 1
        for (int c = 0; c < 4; ++c) {
            unsigned fw[8], qw[8], vw[8];
#pragma unroll
            for (int i = 0; i < 8; ++i) { const int lt = 64 * c + 8 * w + i; const size_t row = (size_t)(b * SEQ + 256 * jt + (dir ? 255 - lt : lt));
                fw[i] = *(const unsigned*)(P + row * NPROJ + fcol); qw[i] = *(const unsigned*)(P + row * NPROJ + qcol); vw[i] = *(const unsigned*)(P + row * NPROJ + vcol); }
            float kk[2][8], cl[2][8];
#pragma unroll
            for (int x = 0; x < 2; ++x) { float run = 0.f;
#pragma unroll
                for (int i = 0; i < 8; ++i) { const float fp = x ? bfhi(fw[i]) : bflo(fw[i]); const float sg = fast_sig(fp); const float f = lb[x] + (1.f - lb[x]) * sg;
                    kk[x][i] = (1.f - lb[x]) * (1.f - sg); run += lg2(f); cl[x][i] = run; } }
            *(LAS f32x2*)(L + HL_SEG + (w * 128 + 2 * l) * 4) = (f32x2){cl[0][7], cl[1][7]};
            __syncthreads();
            const int half = w >> 2;
            float pre[2], mid[2], fx[2], fqe[2], fkt[2];
#pragma unroll
            for (int x = 0; x < 2; ++x) {
                float tt[8];
#pragma unroll
                for (int ww = 0; ww < 8; ++ww) tt[ww] = *(const LAS float*)(L + HL_SEG + (ww * 128 + 2 * l + x) * 4);
                const float r15 = tt[0] + tt[1], r31 = r15 + tt[2] + tt[3], r47 = r31 + tt[4] + tt[5], r63 = r47 + tt[6] + tt[7];
                float p = 0.f;
#pragma unroll
                for (int ww = 0; ww < 8; ++ww) if (ww < w) p += tt[ww];
                pre[x] = p; mid[x] = half ? r47 : r15;
                fx[x] = half ? ex2(r47 - r31) : ex2(r31 - r15); fqe[x] = ex2(mid[x]); fkt[x] = ex2(r63 - mid[x]);
                if (w == 0) *(LAS float*)(L + HL_FAC + (2 * l + x) * 4) = ex2(r63);
            }
            float ktv[2][8];
#pragma unroll
            for (int i = 0; i < 8; ++i) {
                float qd[2], kd[2], xv[2], qe[2];
#pragma unroll
                for (int x = 0; x < 2; ++x) { const float cc = pre[x] + cl[x][i] - mid[x]; const float eq = ex2(cc), ek = ex2(-cc); const float q = x ? bfhi(qw[i]) : bflo(qw[i]);
                    qd[x] = q * eq; kd[x] = kk[x][i] * ek; xv[x] = (half ? qd[x] : kd[x]) * fx[x]; qe[x] = qd[x] * fqe[x]; ktv[x][i] = kd[x] * fkt[x]; }
                const int off = (8 * w + i) * HS_ND + 4 * l;
                *(LAS unsigned*)(L + HL_QD + off) = pk2(qd[0], qd[1]); *(LAS unsigned*)(L + HL_KD + off) = pk2(kd[0], kd[1]);
                *(LAS unsigned*)(L + HL_X + off) = pk2(xv[0], xv[1]); *(LAS unsigned*)(L + HL_QE + off) = pk2(qe[0], qe[1]);
            }
#pragma unroll
            for (int x = 0; x < 2; ++x) {
                unsigned pv[4];
#pragma unroll
                for (int i = 0; i < 8; i += 2) { const unsigned short v0 = x ? (unsigned short)(vw[i] >> 16) : (unsigned short)(vw[i] & 0xffffu), v1 = x ? (unsigned short)(vw[i + 1] >> 16) : (unsigned short)(vw[i + 1] & 0xffffu);
                    pv[i >> 1] = (unsigned)v0 | ((unsigned)v1 << 16); }
                *(LAS v4u*)(L + HL_KTT + (2 * l + x) * HS_T + 16 * w) = (v4u){pk2(ktv[x][0], ktv[x][1]), pk2(ktv[x][2], ktv[x][3]), pk2(ktv[x][4], ktv[x][5]), pk2(ktv[x][6], ktv[x][7])};
                *(LAS v4u*)(L + HL_VT + (2 * l + x) * HS_T + 16 * w) = (v4u){pv[0], pv[1], pv[2], pv[3]};
            }
            __syncthreads();
#pragma unroll 1
            for (int tix = w; tix < 10; tix += 8) {
                const int I = tix < 1 ? 0 : (tix < 3 ? 1 : (tix < 6 ? 2 : 3)); const int J = tix - (I * (I + 1)) / 2;
                const bool same = (I >> 1) == (J >> 1);
                const int abase = same ? HL_KD : HL_X, bbase = same ? HL_QD : HL_X;
                f32x4 at = (f32x4){0.f, 0.f, 0.f, 0.f};
                mma_tile<4>(at, L + abase + 16 * J * HS_ND, HS_ND, L + bbase + 16 * I * HS_ND, HS_ND, l);
                const int tloc = 16 * I + c16, s0 = 16 * J + 4 * g;
                float pr[4];
#pragma unroll
                for (int r = 0; r < 4; ++r) pr[r] = (s0 + r <= tloc) ? at[r] : 0.f;
                v2u o; o.x = pk2(pr[0], pr[1]); o.y = pk2(pr[2], pr[3]);
                *(LAS v2u*)(L + HL_P + tloc * HS_T + s0 * 2) = o;
            }
            f32x4 accO[4];
#pragma unroll
            for (int I = 0; I < 4; ++I) { accO[I] = (f32x4){0.f, 0.f, 0.f, 0.f}; mma_tile<4>(accO[I], L + HL_QE + 16 * I * HS_ND, HS_ND, L + HL_ST + 16 * w * HS_ND, HS_ND, l); }
#pragma unroll
            for (int m = 0; m < 8; ++m) { const f32x4 gv = *(const LAS f32x4*)(L + HL_FAC + (16 * m + 4 * g) * 4); accS[m] = accS[m] * gv;
                mma_tile<2>(accS[m], L + HL_KTT + 16 * m * HS_T, HS_T, L + HL_VT + 16 * w * HS_T, HS_T, l); }
            __syncthreads();
#pragma unroll
            for (int m = 0; m < 8; ++m) { v2u o; o.x = pk2(accS[m][0], accS[m][1]); o.y = pk2(accS[m][2], accS[m][3]); *(LAS v2u*)(L + HL_ST + (16 * w + c16) * HS_ND + (16 * m + 4 * g) * 2) = o; }
#pragma unroll
            for (int I = 0; I < 4; ++I) mma_tile<2>(accO[I], L + HL_P + 16 * I * HS_T, HS_T, L + HL_VT + 16 * w * HS_T, HS_T, l);
            const int ecol = head * 128 + 16 * w + c16;
            if (dir == 0) {
#pragma unroll
                for (int I = 0; I < 4; ++I)
#pragma unroll
                    for (int r = 0; r < 4; ++r) { const int lt = 64 * c + 16 * I + 4 * g + r; const size_t row = (size_t)(b * SEQ + 256 * jt + lt); OUT[row * DM + ecol] = (bf16)f2bf(accO[I][r]); }
                __syncthreads();
            } else {
                float sv[4][4];
#pragma unroll
                for (int I = 0; I < 4; ++I)
#pragma unroll
                    for (int r = 0; r < 4; ++r) { const int lt = 64 * c + 16 * I + 4 * g + r; const size_t row = (size_t)(b * SEQ + 256 * jt + 255 - lt);
                        const float s = accO[I][r] + bf2f(OUT[row * DM + ecol]); sv[I][r] = s; float q = s * s;
                        q += __shfl_xor(q, 1); q += __shfl_xor(q, 2); q += __shfl_xor(q, 4); q += __shfl_xor(q, 8);
                        if (c16 == 0) *(LAS float*)(L + HL_RS + ((16 * I + 4 * g + r) * 8 + w) * 4) = q; }
                __syncthreads();
                if (T.tid < 64) { const f32x4 p0 = *(const LAS f32x4*)(L + HL_RS + T.tid * 32), p1 = *(const LAS f32x4*)(L + HL_RS + T.tid * 32 + 16);
                    const float ss = (p0.x + p0.y) + (p0.z + p0.w) + (p1.x + p1.y) + (p1.z + p1.w); *(LAS float*)(L + HL_RSTD + T.tid * 4) = 1.0f / sqrtf(ss * (1.f / 128.f) + EPSN); }
                __syncthreads();
#pragma unroll
                for (int I = 0; I < 4; ++I) { const f32x4 rs = *(const LAS f32x4*)(L + HL_RSTD + (16 * I + 4 * g) * 4);
#pragma unroll
                    for (int r = 0; r < 4; ++r) { const int lt = 64 * c + 16 * I + 4 * g + r; const size_t row = (size_t)(b * SEQ + 256 * jt + 255 - lt);
                        const float gate = bf2f(P[row * NPROJ + 1024 + ecol]); OUT[row * DM + ecol] = (bf16)f2bf(sv[I][r] * rs[r] * nwv * gate); } }
                __syncthreads();
            }
        }
        if (dir == 0) {
            VM_WAIT(); __syncthreads();
            if (w == 0) { __builtin_amdgcn_fence(__ATOMIC_ACQUIRE, "agent"); VM_WAIT(); }
            __syncthreads();
        }
    }
}

constexpr int MS = 144;
constexpr int ML_Q = 0, ML_K = ML_Q + 64 * MS, ML_KTT = ML_K + 64 * MS, ML_VT = ML_KTT + 64 * MS, ML_CT = ML_VT + 144 * MS, ML_P = ML_CT + 144 * MS;
constexpr int ML_TA = ML_P + 64 * MS;
constexpr int ML_TMU = ML_TA + 256, ML_TIW = ML_TMU + 256, ML_TSW = ML_TIW + 256, ML_TEM = ML_TSW + 256, ML_TRI = ML_TEM + 256;
constexpr int ML_SC = ML_TRI + 256;
constexpr int ML_RS = ML_SC + 64, ML_RSTD = ML_RS + 2048, ML_END = ML_RSTD + 256;
static_assert(ML_END <= 128 * 1024, "mLSTM LDS map");
constexpr size_t ML_SLOT_BYTES = 144 * 64 * 2;
constexpr float LOG2E = 1.4426950408889634f;

__device__ __forceinline__ float wave_incl_sum(float v, int lane) {
#pragma unroll
    for (int o = 1; o < 64; o <<= 1) { const float t = __shfl_up(v, o); if (lane >= o) v += t; }
    return v;
}
__device__ __forceinline__ float wave_incl_max(float v, int lane) {
#pragma unroll
    for (int o = 1; o < 64; o <<= 1) { const float t = __shfl_up(v, o); if (lane >= o) v = fmaxf(v, t); }
    return v;
}
__device__ __forceinline__ float ml_scalars(LAS unsigned char* L, const float* GT, size_t row, int icol, int fcol, float m_prev, float& bsum, int lane) {
    const float ig = GT[row * 16 + icol] * LOG2E; const float fg = GT[row * 16 + fcol];
    const float lf = (fminf(fg, 0.f) - log1pf(__expf(-fabsf(fg)))) * LOG2E;
    const float bcs = wave_incl_sum(lf, lane);
    const float av = ig - bcs;
    const float pm = wave_incl_max(av, lane);
    const float mu = fmaxf(pm, m_prev);
    const float mu63 = __shfl(mu, 63), b63 = __shfl(bcs, 63);
    *(LAS float*)(L + ML_TA + lane * 4) = av; *(LAS float*)(L + ML_TMU + lane * 4) = mu; *(LAS float*)(L + ML_TIW + lane * 4) = ex2(m_prev - mu);
    *(LAS float*)(L + ML_TSW + lane * 4) = ex2(av - mu63); *(LAS float*)(L + ML_TEM + lane * 4) = ex2(-(bcs + mu));
    if (lane == 0) *(LAS float*)(L + ML_SC) = ex2(m_prev - mu63);
    bsum += b63;
    return b63 + mu63;
}
__device__ __forceinline__ void ml_aug_rows(LAS unsigned char* L, int tid) {
    for (int i = tid; i < 16 * 8; i += NTHREADS) { const int r = i >> 3, q = i & 7; const unsigned v = r == 0 ? 0x3F803F80u : 0u; *(LAS v4u*)(L + ML_VT + (128 + r) * MS + q * 16) = (v4u){v, v, v, v}; }
}
#define ML_STAGE_KV(ROWEXPR) do { \
    if (T.tid < 256) { const int dp = T.tid & 31, tg = T.tid >> 5; unsigned kw[8]; \
        _Pragma("unroll") for (int i = 0; i < 8; ++i) { const int lt = 64 * c + 8 * tg + i; const size_t row = (size_t)(ROWEXPR); kw[i] = *(const unsigned*)(QK + row * 512 + 256 + head * 64 + 2 * dp); } \
        const f32x4 s0 = *(const LAS f32x4*)(L + ML_TSW + (8 * tg) * 4), s1 = *(const LAS f32x4*)(L + ML_TSW + (8 * tg + 4) * 4); \
        const float sw[8] = {s0.x, s0.y, s0.z, s0.w, s1.x, s1.y, s1.z, s1.w}; \
        _Pragma("unroll") for (int x = 0; x < 2; ++x) { float kv[8]; _Pragma("unroll") for (int i = 0; i < 8; ++i) kv[i] = (x ? bfhi(kw[i]) : bflo(kw[i])) * sw[i]; \
            *(LAS v4u*)(L + ML_KTT + (2 * dp + x) * MS + 16 * tg) = (v4u){pk2(kv[0], kv[1]), pk2(kv[2], kv[3]), pk2(kv[4], kv[5]), pk2(kv[6], kv[7])}; } } \
    { const int ep = T.tid & 63, tg = T.tid >> 6; unsigned vw[8]; \
        _Pragma("unroll") for (int i = 0; i < 8; ++i) { const int lt = 64 * c + 8 * tg + i; const size_t row = (size_t)(ROWEXPR); vw[i] = *(const unsigned*)(P + row * NPROJ + 3072 + head * 128 + 2 * ep); } \
        _Pragma("unroll") for (int x = 0; x < 2; ++x) { unsigned pv[4]; \
            _Pragma("unroll") for (int i = 0; i < 8; i += 2) { const unsigned v0 = x ? (vw[i] >> 16) : (vw[i] & 0xffffu), v1 = x ? (vw[i + 1] >> 16) : (vw[i + 1] & 0xffffu); pv[i >> 1] = v0 | (v1 << 16); } \
            *(LAS v4u*)(L + ML_VT + (2 * ep + x) * MS + 16 * tg) = (v4u){pv[0], pv[1], pv[2], pv[3]}; } } \
} while (0)

__device__ __forceinline__ void ml_pass1_item(const Args& a, const Ctx& T, int item) {
    const int js = item & 15, head = (item >> 4) & 3, dir = (item >> 6) & 1, b = item >> 7;
    const bf16* P = (const bf16*)(a.ws + WS_PROJ); const bf16* QK = (const bf16*)(a.ws + WS_QK); const float* GT = (const float*)(a.ws + WS_GATES);
    LAS unsigned char* L = T.lds;
    const int w = T.wave, l = T.lane, g = l >> 4, c16 = l & 15;
    const int icol = (dir ? 8 : 0) + head, fcol = (dir ? 12 : 4) + head;
    __syncthreads();
    ml_aug_rows(L, T.tid);
    f32x4 accC[4], accCA = (f32x4){0.f, 0.f, 0.f, 0.f};
#pragma unroll
    for (int m = 0; m < 4; ++m) accC[m] = (f32x4){0.f, 0.f, 0.f, 0.f};
    float mst = -1e30f, bsum = 0.f;
#pragma unroll 1
    for (int c = 0; c < 4; ++c) {
        if (w == 0) mst = ml_scalars(L, GT, (size_t)sc_row(b, dir, js, 64 * c + l), icol, fcol, mst, bsum, l);
        __syncthreads();
        ML_STAGE_KV(sc_row(b, dir, js, lt));
        __syncthreads();
        const float carry = *(const LAS float*)(L + ML_SC);
#pragma unroll
        for (int m = 0; m < 4; ++m) { accC[m] = accC[m] * carry; mma_tile<2>(accC[m], L + ML_KTT + 16 * m * MS, MS, L + ML_VT + 16 * w * MS, MS, l); }
        if (w < 4) { accCA = accCA * carry; mma_tile<2>(accCA, L + ML_KTT + 16 * w * MS, MS, L + ML_VT + 128 * MS, MS, l); }
        __syncthreads();
    }
    const size_t sidx = hg_seq(b, dir, head) * 16 + js;
    bf16* CT = (bf16*)(a.ws + WS_MLST + sidx * ML_SLOT_BYTES);
#pragma unroll
    for (int m = 0; m < 4; ++m) { v2u o; o.x = pk2(accC[m][0], accC[m][1]); o.y = pk2(accC[m][2], accC[m][3]); *(v2u*)(CT + (size_t)(16 * w + c16) * 64 + 16 * m + 4 * g) = o; }
    if (w < 4) { v2u o; o.x = pk2(accCA[0], accCA[1]); o.y = pk2(accCA[2], accCA[3]); *(v2u*)(CT + (size_t)(128 + c16) * 64 + 16 * w + 4 * g) = o; }
    if (T.tid == 0) { float* sc = (float*)(a.ws + WS_MLSC) + sidx * 4; sc[0] = mst; sc[1] = bsum; }
}

__device__ __forceinline__ void ml_pass2(const Args& a, const Ctx& T) {
    const int ntask = 32 * 1152;
    for (int task = T.vcu * NTHREADS + T.tid; task < ntask; task += T.G * NTHREADS) {
        const int seq = task / 1152, el = (task % 1152) * 8;
        float r[8], m = 0.f;
#pragma unroll
        for (int i = 0; i < 8; ++i) r[i] = 0.f;
        for (int j = 0; j < 16; ++j) {
            float* sc = (float*)(a.ws + WS_MLSC) + ((size_t)seq * 16 + j) * 4;
            const float mloc = sc[0], bt = sc[1];
            const float mn = fmaxf(bt + m, mloc); const float cA = ex2(bt + m - mn), cB = ex2(mloc - mn); m = mn;
            v4u* p = (v4u*)(a.ws + WS_MLST + ((size_t)seq * 16 + j) * ML_SLOT_BYTES + (size_t)el * 2);
            const v4u dv = *p;
            r[0] = cA * r[0] + cB * bflo(dv.x); r[1] = cA * r[1] + cB * bfhi(dv.x); r[2] = cA * r[2] + cB * bflo(dv.y); r[3] = cA * r[3] + cB * bfhi(dv.y);
            r[4] = cA * r[4] + cB * bflo(dv.z); r[5] = cA * r[5] + cB * bfhi(dv.z); r[6] = cA * r[6] + cB * bflo(dv.w); r[7] = cA * r[7] + cB * bfhi(dv.w);
            *p = (v4u){pk2(r[0], r[1]), pk2(r[2], r[3]), pk2(r[4], r[5]), pk2(r[6], r[7])};
            if (el == 0) sc[2] = mn;
        }
    }
}

__device__ __forceinline__ void ml_pass3_item(const Args& a, const Ctx& T, int item, bf16* OUT) {
    const int jt = item & 15, head = (item >> 4) & 3, b = item >> 6;
    const bf16* P = (const bf16*)(a.ws + WS_PROJ); const bf16* QK = (const bf16*)(a.ws + WS_QK); const float* GT = (const float*)(a.ws + WS_GATES);
    LAS unsigned char* L = T.lds;
    const int w = T.wave, l = T.lane, g = l >> 4, c16 = l & 15;
    __syncthreads();
    for (int i = T.tid; i < 64 * MS / 16; i += NTHREADS) *(LAS v4u*)(L + ML_P + i * 16) = (v4u){0u, 0u, 0u, 0u};
    ml_aug_rows(L, T.tid);
    const float nwv = a.in[I_MLNW][head * 128 + 16 * w + c16];
    const int ecol = 512 + head * 128 + 16 * w + c16;
#pragma unroll 1
    for (int dir = 0; dir < 2; ++dir) {
        const int icol = (dir ? 8 : 0) + head, fcol = (dir ? 12 : 4) + head;
        const int slot = dir ? 15 - jt : jt;
        const size_t sidx = hg_seq(b, dir, head) * 16 + slot;
        const bf16* CTg = (const bf16*)(a.ws + WS_MLST + sidx * ML_SLOT_BYTES);
        __syncthreads();
        for (int i = T.tid; i < 144 * 8; i += NTHREADS) { const int e = i >> 3, q = i & 7; *(LAS v4u*)(L + ML_CT + e * MS + q * 16) = *(const v4u*)(CTg + (size_t)e * 64 + q * 8); }
        float mst = ((const float*)(a.ws + WS_MLSC))[sidx * 4 + 2], bsum = 0.f;
        __syncthreads();
        f32x4 accC[4], accCA = (f32x4){0.f, 0.f, 0.f, 0.f};
#pragma unroll
        for (int m = 0; m < 4; ++m) { const v2u sv = *(const LAS v2u*)(L + ML_CT + (16 * w + c16) * MS + (16 * m + 4 * g) * 2); accC[m] = (f32x4){bflo(sv.x), bfhi(sv.x), bflo(sv.y), bfhi(sv.y)}; }
        if (w < 4) { const v2u sv = *(const LAS v2u*)(L + ML_CT + (128 + c16) * MS + (16 * w + 4 * g) * 2); accCA = (f32x4){bflo(sv.x), bfhi(sv.x), bflo(sv.y), bfhi(sv.y)}; }
#pragma unroll 1
        for (int c = 0; c < 4; ++c) {
#define ML_ROW3(lt_) (b * SEQ + 256 * jt + (dir ? 255 - (lt_) : (lt_)))
            if (w == 0) mst = ml_scalars(L, GT, (size_t)ML_ROW3(64 * c + l), icol, fcol, mst, bsum, l);
            { const int t = T.tid >> 3, part = T.tid & 7; const size_t row = (size_t)ML_ROW3(64 * c + t);
                *(LAS v4u*)(L + ML_Q + t * MS + part * 16) = *(const v4u*)(QK + row * 512 + head * 64 + part * 8);
                *(LAS v4u*)(L + ML_K + t * MS + part * 16) = *(const v4u*)(QK + row * 512 + 256 + head * 64 + part * 8); }
            __syncthreads();
            ML_STAGE_KV(ML_ROW3(lt));
            __syncthreads();
#pragma unroll 1
            for (int tix = w; tix < 10; tix += 8) {
                const int I = tix < 1 ? 0 : (tix < 3 ? 1 : (tix < 6 ? 2 : 3)); const int J = tix - (I * (I + 1)) / 2;
                f32x4 at = (f32x4){0.f, 0.f, 0.f, 0.f};
                mma_tile<2>(at, L + ML_K + 16 * J * MS, MS, L + ML_Q + 16 * I * MS, MS, l);
                const int tloc = 16 * I + c16, s0 = 16 * J + 4 * g;
                const f32x4 av = *(const LAS f32x4*)(L + ML_TA + s0 * 4); const float mu = *(const LAS float*)(L + ML_TMU + tloc * 4);
                float pr[4];
#pragma unroll
                for (int r = 0; r < 4; ++r) pr[r] = (s0 + r <= tloc) ? at[r] * ex2(av[r] - mu) : 0.f;
                v2u o; o.x = pk2(pr[0], pr[1]); o.y = pk2(pr[2], pr[3]);
                *(LAS v2u*)(L + ML_P + tloc * MS + s0 * 2) = o;
            }
            f32x4 accO[4], accOA = (f32x4){0.f, 0.f, 0.f, 0.f};
#pragma unroll
            for (int I = 0; I < 4; ++I) { accO[I] = (f32x4){0.f, 0.f, 0.f, 0.f}; mma_tile<2>(accO[I], L + ML_Q + 16 * I * MS, MS, L + ML_CT + 16 * w * MS, MS, l);
                const f32x4 iw = *(const LAS f32x4*)(L + ML_TIW + (16 * I + 4 * g) * 4); accO[I] = accO[I] * iw; }
            if (w < 4) { mma_tile<2>(accOA, L + ML_Q + 16 * w * MS, MS, L + ML_CT + 128 * MS, MS, l); const f32x4 iw = *(const LAS f32x4*)(L + ML_TIW + (16 * w + 4 * g) * 4); accOA = accOA * iw; }
            const float carry = *(const LAS float*)(L + ML_SC);
#pragma unroll
            for (int m = 0; m < 4; ++m) { accC[m] = accC[m] * carry; mma_tile<2>(accC[m], L + ML_KTT + 16 * m * MS, MS, L + ML_VT + 16 * w * MS, MS, l); }
            if (w < 4) { accCA = accCA * carry; mma_tile<2>(accCA, L + ML_KTT + 16 * w * MS, MS, L + ML_VT + 128 * MS, MS, l); }
            __syncthreads();
#pragma unroll
            for (int m = 0; m < 4; ++m) { v2u o; o.x = pk2(accC[m][0], accC[m][1]); o.y = pk2(accC[m][2], accC[m][3]); *(LAS v2u*)(L + ML_CT + (16 * w + c16) * MS + (16 * m + 4 * g) * 2) = o; }
            if (w < 4) { v2u o; o.x = pk2(accCA[0], accCA[1]); o.y = pk2(accCA[2], accCA[3]); *(LAS v2u*)(L + ML_CT + (128 + c16) * MS + (16 * w + 4 * g) * 2) = o; }
#pragma unroll
            for (int I = 0; I < 4; ++I) mma_tile<2>(accO[I], L + ML_P + 16 * I * MS, MS, L + ML_VT + 16 * w * MS, MS, l);
            if (w < 4) { mma_tile<2>(accOA, L + ML_P + 16 * w * MS, MS, L + ML_VT + 128 * MS, MS, l);
                if (c16 == 0) { const f32x4 em = *(const LAS f32x4*)(L + ML_TEM + (16 * w + 4 * g) * 4); f32x4 ri;
#pragma unroll
                    for (int r = 0; r < 4; ++r) ri[r] = 1.0f / fmaxf(fabsf(accOA[r]), em[r]);
                    *(LAS f32x4*)(L + ML_TRI + (16 * w + 4 * g) * 4) = ri; } }
            __syncthreads();
            float hv[4][4];
#pragma unroll
            for (int I = 0; I < 4; ++I) { const f32x4 ri = *(const LAS f32x4*)(L + ML_TRI + (16 * I + 4 * g) * 4);
#pragma unroll
                for (int r = 0; r < 4; ++r) hv[I][r] = accO[I][r] * ri[r]; }
            if (dir == 0) {
#pragma unroll
                for (int I = 0; I < 4; ++I)
#pragma unroll
                    for (int r = 0; r < 4; ++r) { const int lt = 64 * c + 16 * I + 4 * g + r; const size_t row = (size_t)ML_ROW3(lt); OUT[row * DM + ecol] = (bf16)f2bf(hv[I][r]); }
                __syncthreads();
            } else {
#pragma unroll
                for (int I = 0; I < 4; ++I)
#pragma unroll
                    for (int r = 0; r < 4; ++r) { const int lt = 64 * c + 16 * I + 4 * g + r; const size_t row = (size_t)ML_ROW3(lt);
                        const float s = hv[I][r] + bf2f(OUT[row * DM + ecol]); hv[I][r] = s; float q = s * s;
                        q += __shfl_xor(q, 1); q += __shfl_xor(q, 2); q += __shfl_xor(q, 4); q += __shfl_xor(q, 8);
                        if (c16 == 0) *(LAS float*)(L + ML_RS + ((16 * I + 4 * g + r) * 8 + w) * 4) = q; }
                __syncthreads();
                if (T.tid < 64) { const f32x4 p0 = *(const LAS f32x4*)(L + ML_RS + T.tid * 32), p1 = *(const LAS f32x4*)(L + ML_RS + T.tid * 32 + 16);
                    const float ss = (p0.x + p0.y) + (p0.z + p0.w) + (p1.x + p1.y) + (p1.z + p1.w); *(LAS float*)(L + ML_RSTD + T.tid * 4) = 1.0f / sqrtf(ss * (1.f / 128.f) + EPSN); }
                __syncthreads();
#pragma unroll
                for (int I = 0; I < 4; ++I) { const f32x4 rs = *(const LAS f32x4*)(L + ML_RSTD + (16 * I + 4 * g) * 4);
#pragma unroll
                    for (int r = 0; r < 4; ++r) { const int lt = 64 * c + 16 * I + 4 * g + r; const size_t row = (size_t)ML_ROW3(lt);
                        const float gate = bf2f(P[row * NPROJ + 3584 + head * 128 + 16 * w + c16]); OUT[row * DM + ecol] = (bf16)f2bf(hv[I][r] * rs[r] * nwv * gate); } }
                __syncthreads();
            }
#undef ML_ROW3
        }
        if (dir == 0) { VM_WAIT(); __syncthreads(); if (w == 0) { __builtin_amdgcn_fence(__ATOMIC_ACQUIRE, "agent"); VM_WAIT(); } __syncthreads(); }
    }
}
__device__ __forceinline__ void headnorm_phase(const Args& a, const Ctx& T, bool ml_only) {
    const bf16* P = (const bf16*)(a.ws + WS_PROJ); bf16* OF = (bf16*)(a.ws + WS_OF); const bf16* OB = (const bf16*)(a.ws + WS_OB);
    const int l = T.lane, head = l >> 3;
    const float* nw = head < 4 ? a.in[I_HGNW] + 16 * l : a.in[I_MLNW] + 16 * l - 512;
    const int gcol = head < 4 ? 1024 + 16 * l : 3584 + 16 * l - 512;
    float w[16];
#pragma unroll
    for (int j = 0; j < 16; ++j) w[j] = nw[j];
    for (int m = T.gw; m < MLAT; m += T.NGW) {
        const v4u f0 = *(const v4u*)(OF + (size_t)m * DM + 16 * l), f1 = *(const v4u*)(OF + (size_t)m * DM + 16 * l + 8);
        const v4u b0 = *(const v4u*)(OB + (size_t)m * DM + 16 * l), b1 = *(const v4u*)(OB + (size_t)m * DM + 16 * l + 8);
        const v4u g0 = *(const v4u*)(P + (size_t)m * NPROJ + gcol), g1 = *(const v4u*)(P + (size_t)m * NPROJ + gcol + 8);
        float o[16], g[16];
#pragma unroll
        for (int q = 0; q < 4; ++q) { o[2 * q] = bflo(f0[q]) + bflo(b0[q]); o[2 * q + 1] = bfhi(f0[q]) + bfhi(b0[q]); o[8 + 2 * q] = bflo(f1[q]) + bflo(b1[q]); o[8 + 2 * q + 1] = bfhi(f1[q]) + bfhi(b1[q]);
            g[2 * q] = bflo(g0[q]); g[2 * q + 1] = bfhi(g0[q]); g[8 + 2 * q] = bflo(g1[q]); g[8 + 2 * q + 1] = bfhi(g1[q]); }
        float ss = 0.f;
#pragma unroll
        for (int j = 0; j < 16; ++j) ss += o[j] * o[j];
        ss += __shfl_xor(ss, 1); ss += __shfl_xor(ss, 2); ss += __shfl_xor(ss, 4);
        const float r = 1.0f / sqrtf(ss * (1.f / 128.f) + EPSN);
#pragma unroll
        for (int j = 0; j < 16; ++j) o[j] = o[j] * r * w[j] * g[j];
        v4u o0, o1;
#pragma unroll
        for (int q = 0; q < 4; ++q) { o0[q] = pk2(o[2 * q], o[2 * q + 1]); o1[q] = pk2(o[8 + 2 * q], o[8 + 2 * q + 1]); }
        if (!(ml_only && head < 4)) { *(v4u*)(OF + (size_t)m * DM + 16 * l) = o0; *(v4u*)(OF + (size_t)m * DM + 16 * l + 8) = o1; }
    }
}

__device__ __forceinline__ void final_norm_phase(const Args& a, const Ctx& T) {
    f32x4 wv[4];
#pragma unroll
    for (int j = 0; j < 4; ++j) wv[j] = *((const f32x4*)a.in[I_FNW] + T.lane + 64 * j);
    for (int m = T.gw; m < MLAT; m += T.NGW) {
        f32x4* xr = (f32x4*)(a.out + (size_t)m * DM) + T.lane;
        f32x4 v[4]; float s = 0.f;
#pragma unroll
        for (int j = 0; j < 4; ++j) { v[j] = xr[64 * j]; s += (v[j].x * v[j].x + v[j].y * v[j].y) + (v[j].z * v[j].z + v[j].w * v[j].w); }
        const float rstd = 1.0f / sqrtf(wave_sum(s) * (1.f / DM) + EPSN);
#pragma unroll
        for (int j = 0; j < 4; ++j) xr[64 * j] = v[j] * rstd * wv[j];
    }
}

__global__ void __launch_bounds__(NTHREADS, 2) fwd_kernel(Args a) {
    extern __shared__ __attribute__((aligned(16))) unsigned char lds_raw[];
    Ctx T;
    T.lds = (LAS unsigned char*)lds_raw;
    T.tid = threadIdx.x; T.lane = T.tid & 63; T.wave = __builtin_amdgcn_readfirstlane(T.tid >> 6);
    T.G = gridDim.x; { const int bx = blockIdx.x; T.vcu = (T.G % 8 == 0) ? (bx % 8) * (T.G / 8) + bx / 8 : bx; }
    T.gw = T.vcu * NWAVES + T.wave; T.NGW = T.G * NWAVES;
    volatile LAS unsigned* MISC = (volatile LAS unsigned*)(T.lds + MISC_OFF);
    for (int u = T.tid; u < (LDS_BYTES - LDSCTL_OFF) / 4; u += NTHREADS) ((LAS unsigned*)(T.lds + LDSCTL_OFF))[u] = 0u;
    __syncthreads();
    XcdBarrier bar; bar.bar = (unsigned*)(a.ws + WS_CTL) + CW_BAR; bar.x = 0; bar.st = nullptr;
    const bool multi = (a.ph_hi - a.ph_lo) > 1;
    if (multi) bar = xcd_barrier_post((unsigned*)(a.ws + WS_CTL) + CW_BAR, MISC + 8);
    const int lo = a.ph_lo, hi = a.ph_hi;
#define IN(k) (lo <= (k) && (k) < hi)
#define SEAM(k) do { if (IN(k) && IN((k) + 1)) xcd_barrier(bar); } while (0)
    bf16* XN = (bf16*)(a.ws + WS_XN); bf16* HB = (bf16*)(a.ws + WS_PROJ); bf16* PROJ = (bf16*)(a.ws + WS_PROJ);
    float* X1C = (float*)(a.ws + WS_X1CTX); const float* mods = (const float*)(a.ws + WS_MODS);
    const int bx = (int)blockIdx.x;

    if (IN(0)) { if (bx < 144) mods_item(a, T, bx); convert_ffn(a, T, a.in[I_F1W1], a.in[I_F1W2]); convert_mix(a, T); }
    SEAM(0);
    if (IN(1)) norm_mod_rows<false>(a, T, a.in[I_X], a.in[I_CTX], MALL, a.in[I_N1W], 0, 1);
    SEAM(1);
    if (IN(2)) { pg8::Gemm g{XN, (const bf16*)(a.ws + WS_W1), MALL, 2 * DFF, DM}; pg8::StaticOrder S; S.init(MALL, 2 * DFF, T.G, bx);
        pg8::EpiSwiglu E{HB, DFF}; pg8::gemm_phase<pg8::EpiSwiglu, pg8::StaticOrder, true, true>(T.lds, g, S, E); }
    SEAM(2);
    if (IN(3)) { pg8::Gemm g{HB, (const bf16*)(a.ws + WS_W2), MALL, DM, DFF}; pg8::StaticOrder S; S.init(MALL, DM, T.G, bx);
        pg8::EpiResid E{a.in[I_X], a.in[I_CTX], a.out, X1C, mods + 2 * 1024, 0.5f}; pg8::gemm_phase<pg8::EpiResid, pg8::StaticOrder, true, true>(T.lds, g, S, E); }
    SEAM(3);
    if (IN(4)) { norm_mod_rows<true>(a, T, a.out, X1C, MALL, a.in[I_N2W], 3, 4); }
    SEAM(4);
    if (IN(5)) { pg8::Gemm g{XN, (const bf16*)(a.ws + WS_WIN), MALL, NPROJ, DM}; pg8::StaticOrder S; S.init(MALL, NPROJ, T.G, bx);
        pg8::EpiProj E{PROJ, NPROJ}; pg8::gemm_phase<pg8::EpiProj, pg8::StaticOrder, true, true>(T.lds, g, S, E); }
    SEAM(5);
    if (IN(6)) conv_phase(a, T);
    SEAM(6);
    if (IN(7)) { for (int it = T.vcu; it < 1024; it += T.G) { if (it < 512) hg_pass1_item(a, T, it); else ml_pass1_item(a, T, it - 512); } }
    SEAM(7);
    if (IN(8)) { hg_pass2(a, T); ml_pass2(a, T); }
    SEAM(8);
    if (IN(9)) { for (int it = T.vcu; it < 512; it += T.G) { if (it < 256) hg_pass3_item(a, T, it, XN); else ml_pass3_item(a, T, it - 256, XN); } }
    SEAM(9);
    if (IN(10)) { convert_ffn(a, T, a.in[I_F2W1], a.in[I_F2W2]); }
    SEAM(10);
    if (IN(11)) { pg8::Gemm g{XN, (const bf16*)(a.ws + WS_WOUT), MLAT, DM, DM}; pg8::StaticOrder S; S.init(MLAT, DM, T.G, bx);
        pg8::EpiResid E{a.out, a.out, a.out, a.out, mods + 5 * 1024, 1.0f}; pg8::gemm_phase<pg8::EpiResid, pg8::StaticOrder, true, true>(T.lds, g, S, E); }
    SEAM(11);
    if (IN(12)) norm_mod_rows<false>(a, T, a.out, a.out, MLAT, a.in[I_N3W], 6, 7);
    SEAM(12);
    if (IN(13)) { pg8::Gemm g{XN, (const bf16*)(a.ws + WS_W1), MLAT, 2 * DFF, DM}; pg8::StaticOrder S; S.init(MLAT, 2 * DFF, T.G, bx);
        pg8::EpiSwiglu E{HB, DFF}; pg8::gemm_phase<pg8::EpiSwiglu, pg8::StaticOrder, true, true>(T.lds, g, S, E); }
    SEAM(13);
    if (IN(14)) { pg8::Gemm g{HB, (const bf16*)(a.ws + WS_W2), MLAT, DM, DFF}; pg8::StaticOrder S; S.init(MLAT, DM, T.G, bx);
        pg8::EpiResid E{a.out, a.out, a.out, a.out, mods + 8 * 1024, 0.5f}; pg8::gemm_phase<pg8::EpiResid, pg8::StaticOrder, true, true>(T.lds, g, S, E); }
    SEAM(14);
    if (IN(15)) final_norm_phase(a, T);
#undef IN
#undef SEAM
}

extern "C" void kernel_launch(void* const* d_in, const int* in_sizes, int n_in, void* d_out, int out_size, void* d_ws, size_t ws_size, hipStream_t stream) {
    static int grid = 0;
    if (grid == 0) {
        if (n_in != 22 || out_size != MLAT * DM || ws_size < WS_END) { fprintf(stderr, "kernel_launch: unexpected shapes (n_in %d out %d ws %zu)\n", n_in, out_size, ws_size); grid = -1; return; }
        int dev = 0, cus = 0;
        if (hipGetDevice(&dev) != hipSuccess || hipDeviceGetAttribute(&cus, hipDeviceAttributeMultiprocessorCount, dev) != hipSuccess) { grid = -1; return; }
        if (hipFuncSetAttribute((const void*)fwd_kernel, hipFuncAttributeMaxDynamicSharedMemorySize, LDS_BYTES) != hipSuccess) { fprintf(stderr, "kernel_launch: hipFuncSetAttribute failed\n"); grid = -1; return; }
        (void)hipGetLastError();
        grid = cus;
    }
    if (grid < 0) return;
    (void)hipMemsetAsync((char*)d_ws + WS_CTL, 0, CTL_ZERO_BYTES, stream);
    Args a{};
    for (int i = 0; i < 22; ++i) a.in[i] = (const float*)d_in[i];
    a.out = (float*)d_out; a.ws = (unsigned char*)d_ws;
#if ONE_LAUNCH
    a.ph_lo = 0; a.ph_hi = NPHASES;
    hipLaunchKernelGGL(fwd_kernel, dim3(grid), dim3(NTHREADS), LDS_BYTES, stream, a);
#else
    for (int p = 0; p < NPHASES; ++p) { a.ph_lo = p; a.ph_hi = p + 1; hipLaunchKernelGGL(fwd_kernel, dim3(grid), dim3(NTHREADS), LDS_BYTES, stream, a); }
#endif
}
```

```cpp
#include <hip/hip_runtime.h>
#include <cstdio>
#include <cstdint>
#ifndef PROF_S
#define PROF_S -1
#endif
#define PG8_PS_BEGIN() do { if (PROF_S == 20 && blockIdx.x == 0 && threadIdx.x == 0) { const unsigned long long t_ = __builtin_amdgcn_s_memrealtime(); volatile __attribute__((address_space(3))) unsigned* M_ = (volatile __attribute__((address_space(3))) unsigned*)(lds + 162816 + 320); M_[20] = (unsigned)t_; M_[21] = (unsigned)(t_ >> 32); } } while (0)
#define PG8_PS_END() do { if (PROF_S == 20 && blockIdx.x == 0 && threadIdx.x == 0) { const unsigned long long t_ = __builtin_amdgcn_s_memrealtime(); volatile __attribute__((address_space(3))) unsigned* M_ = (volatile __attribute__((address_space(3))) unsigned*)(lds + 162816 + 320); \
    const unsigned long long p_ = ((unsigned long long)M_[21] << 32) | M_[20]; const unsigned long long a_ = (((unsigned long long)M_[23] << 32) | M_[22]) + (t_ - p_); M_[22] = (unsigned)a_; M_[23] = (unsigned)(a_ >> 32); } } while (0)
namespace pg8 {
#define PG8_LAS __attribute__((address_space(3)))
typedef unsigned short bf16_t;
typedef short bf16x8 __attribute__((ext_vector_type(8)));
typedef float f32x4 __attribute__((ext_vector_type(4)));
typedef unsigned u32x4 __attribute__((ext_vector_type(4)));
constexpr int BM = 256, BK = 64, HALF = 128, HTB = HALF * BK * 2  , STAGE_BYTES = 8 * HTB, NXCD = 8, WGM = 8;

__host__ __device__ __forceinline__ int lds_byte(int r, int c) { const int st = (r >> 4) * 2 + (c >> 5), rr = r & 15, cc = c & 31, ob = rr * 64 + cc * 2; return st * 1024 + (ob ^ (((ob >> 9) & 1) << 5)); }
__host__ __device__ __forceinline__ void stage_rc(int b, int& R, int& C) { const int st = b / 1024, sb = b % 1024, swz = sb ^ (((sb >> 9) & 1) << 5); R = (st >> 1) * 16 + swz / 64; C = (st & 1) * 32 + (swz % 64) / 2; }
__host__ __device__ __forceinline__ int perm32(int rho) { const int n = rho >> 4, i = rho & 15; return 8 * (i >> 2) + 4 * n + (i & 3); }

struct Unit { int pm, pn, kofs, kt; };
struct Gemm { const bf16_t* A; const bf16_t* Bt; int M, N, K, ld; };

struct StaticOrder {
    int nM, nN, nwg, G, c;
    __host__ __device__ void init(int M, int N, int G_, int c_) { nM = M / BM; nN = N / BM; nwg = nM * nN; G = G_; c = c_; }
    __host__ __device__ bool next(int i, Unit& u) const {
        const long L = (long)i * G + c; if (L >= nwg) return false;
        int wgid = (int)L; { const int q = nwg / NXCD, r = nwg % NXCD, xcd = wgid % NXCD, off = wgid / NXCD; wgid = (xcd < r ? xcd * (q + 1) : r * (q + 1) + (xcd - r) * q) + off; }
        const int nig = WGM * nN, gid = wgid / nig, fm = gid * WGM, gsz = (nM - fm) < WGM ? (nM - fm) : WGM;
        u.pm = fm + ((wgid % nig) % gsz); u.pn = (wgid % nig) / gsz; u.kofs = 0; u.kt = 0; return true;
    }
    __device__ __forceinline__ void a_ready(const Unit&) const {}
    __device__ __forceinline__ void done(const Unit&) const {}
};
__device__ __forceinline__ unsigned cvt_pk_bf16(float lo, float hi) { unsigned r; asm volatile("v_cvt_pk_bf16_f32 %0, %1, %2" : "=v"(r) : "v"(lo), "v"(hi)); return r; }
typedef float f32x2 __attribute__((ext_vector_type(2)));
__device__ __forceinline__ float fast_sigmoid(float v) { return __builtin_amdgcn_rcpf(1.0f + __builtin_amdgcn_exp2f(-1.4426950408889634f * v)); }
__device__ __forceinline__ float fast_silu(float v) { return v * fast_sigmoid(v); }

struct EpiSwiglu {
    static constexpr bool PERM = true, AFTER_DRAIN = false;
    bf16_t* H; int ldh;
    __device__ __forceinline__ void operator()(const f32x4 (&acc)[2][2][4][2], const Unit& u, int wr, int wc, int fr, int fq) const {
        typedef float f2 __attribute__((ext_vector_type(2)));
        const int row0 = u.pm * BM + wr * 64 + fr, col0 = u.pn * HALF + wc * 32 + 8 * fq;
#pragma unroll
        for (int ai = 0; ai < 2; ++ai)
#pragma unroll
            for (int m = 0; m < 4; ++m) { bf16_t* rowp = H + (size_t)(row0 + ai * HALF + m * 16) * ldh + col0;
                unsigned wv[4];
#pragma unroll
                for (int n = 0; n < 2; ++n)
#pragma unroll
                    for (int h = 0; h < 2; ++h) {
                        const f2 g = {acc[ai][0][m][n][2 * h], acc[ai][0][m][n][2 * h + 1]}, uu = {acc[ai][1][m][n][2 * h], acc[ai][1][m][n][2 * h + 1]};
                        const f2 x = g * (-1.4426950408889634f);
                        f2 d; d.x = __builtin_amdgcn_exp2f(x.x); d.y = __builtin_amdgcn_exp2f(x.y); d = d + 1.0f;
                        f2 r; r.x = __builtin_amdgcn_rcpf(d.x); r.y = __builtin_amdgcn_rcpf(d.y);
                        const f2 o = (g * uu) * r;
                        wv[n * 2 + h] = cvt_pk_bf16(o.x, o.y); }
                u32x4 w; w.x = wv[0]; w.y = wv[1]; w.z = wv[2]; w.w = wv[3];
                *(u32x4*)rowp = w; }
    }
};

struct EpiResid {
    static constexpr bool PERM = false, AFTER_DRAIN = false;
    const float* base_lat; const float* base_ctx; float* out_lat; float* out_ctx; const float* gate; float coef;
    __device__ __forceinline__ void operator()(const f32x4 (&acc)[2][2][4][2], const Unit& u, int wr, int wc, int fr, int fq) const {
        const bool isctx = u.pm >= 64;
        const float* base = isctx ? base_ctx + (size_t)(u.pm - 64) * BM * 1024 : base_lat + (size_t)u.pm * BM * 1024;
        float* out = isctx ? out_ctx + (size_t)(u.pm - 64) * BM * 1024 : out_lat + (size_t)u.pm * BM * 1024;
        const float* g = gate + (size_t)(isctx ? 4 : (u.pm >> 4)) * 9216;
        const int col0 = u.pn * BM + wc * 32 + 4 * fq;
        f32x4 gv[2][2];
#pragma unroll
        for (int bj = 0; bj < 2; ++bj)
#pragma unroll
            for (int n = 0; n < 2; ++n) gv[bj][n] = *(const f32x4*)(g + col0 + bj * HALF + n * 16) * coef;
#pragma unroll
        for (int ai = 0; ai < 2; ++ai)
#pragma unroll
            for (int m = 0; m < 4; ++m) { const size_t off = (size_t)(ai * HALF + wr * 64 + m * 16 + fr) * 1024 + col0;
#pragma unroll
                for (int bj = 0; bj < 2; ++bj)
#pragma unroll
                    for (int n = 0; n < 2; ++n) { const f32x4 b = *(const f32x4*)(base + off + bj * HALF + n * 16);
                        *(f32x4*)(out + off + bj * HALF + n * 16) = b + gv[bj][n] * acc[ai][bj][m][n]; } }
    }
};

struct EpiProj {
    static constexpr bool PERM = true, AFTER_DRAIN = false;
    bf16_t* O; int ldc;
    __device__ __forceinline__ void operator()(const f32x4 (&acc)[2][2][4][2], const Unit& u, int wr, int wc, int fr, int fq) const {
        const int row0 = u.pm * BM + wr * 64 + fr, col0 = u.pn * BM + wc * 32 + 8 * fq;
        const int mode = (u.pn < 2) ? 1 : ((u.pn == 4 || u.pn == 5) ? 2 : (u.pn >= 14 ? 3 : 0));
#pragma unroll
        for (int ai = 0; ai < 2; ++ai)
#pragma unroll
            for (int m = 0; m < 4; ++m) { bf16_t* rowp = O + (size_t)(row0 + ai * HALF + m * 16) * ldc + col0;
#pragma unroll
                for (int bj = 0; bj < 2; ++bj) { float r[8];
#pragma unroll
                    for (int n = 0; n < 2; ++n)
#pragma unroll
                        for (int i = 0; i < 4; ++i) { const float v = acc[ai][bj][m][n][i];
                            r[n * 4 + i] = mode == 0 ? v : (mode == 1 ? fast_silu(v) * 0.08838834764831845f : (mode == 2 ? fast_silu(v) : fast_sigmoid(v))); }
                    u32x4 w; w.x = cvt_pk_bf16(r[0], r[1]); w.y = cvt_pk_bf16(r[2], r[3]); w.z = cvt_pk_bf16(r[4], r[5]); w.w = cvt_pk_bf16(r[6], r[7]);
                    *(u32x4*)(rowp + bj * HALF) = w; } }
    }
};

struct DownOrder {
    StaticOrder lat; int c;
    __device__ __forceinline__ bool next(int i, Unit& u) const {
        if (i == 0) return lat.next(0, u);
        if (i != 1 || c >= 176) return false;
        const int ks = c % 11, t = c / 11; u.pn = t & 3; u.pm = 64 + (t >> 2); u.kofs = ks * 256; u.kt = 4; return true; }
    __device__ __forceinline__ void a_ready(const Unit&) const {}
    __device__ __forceinline__ void done(const Unit&) const {}
};
struct EpiDown1 {
    static constexpr bool PERM = true, AFTER_DRAIN = false;
    const float* base; bf16_t* out; const float* gate; float coef; float* slab;
    __device__ __forceinline__ void operator()(const f32x4 (&acc)[2][2][4][2], const Unit& u, int wr, int wc, int fr, int fq) const {
        const int col0 = u.pn * BM + wc * 32 + 8 * fq;
        if (u.kt) {
            float* o = slab + ((size_t)(u.kofs >> 8) * 1024 + (size_t)(u.pm - 64) * BM) * 1024 + col0;
#pragma unroll
            for (int ai = 0; ai < 2; ++ai)
#pragma unroll
                for (int m = 0; m < 4; ++m) { float* rowp = o + (size_t)(ai * HALF + wr * 64 + m * 16 + fr) * 1024;
#pragma unroll
                    for (int bj = 0; bj < 2; ++bj) { *(f32x4*)(rowp + bj * HALF) = acc[ai][bj][m][0]; *(f32x4*)(rowp + bj * HALF + 4) = acc[ai][bj][m][1]; } }
            return;
        }
        const float* g = gate + (size_t)(u.pm >> 4) * 9216;
        f32x4 gv[2][2];
#pragma unroll
        for (int bj = 0; bj < 2; ++bj)
#pragma unroll
            for (int n = 0; n < 2; ++n) gv[bj][n] = *(const f32x4*)(g + col0 + bj * HALF + 4 * n) * coef;
#pragma unroll
        for (int ai = 0; ai < 2; ++ai)
#pragma unroll
            for (int m = 0; m < 4; ++m) { const size_t off = (size_t)(u.pm * BM + ai * HALF + wr * 64 + m * 16 + fr) * 1024 + col0;
#pragma unroll
                for (int bj = 0; bj < 2; ++bj) { const f32x4 b0 = *(const f32x4*)(base + off + bj * HALF), b1 = *(const f32x4*)(base + off + bj * HALF + 4);
                    const f32x4 v0 = b0 + gv[bj][0] * acc[ai][bj][m][0], v1 = b1 + gv[bj][1] * acc[ai][bj][m][1];
                    u32x4 w; w.x = cvt_pk_bf16(v0[0], v0[1]); w.y = cvt_pk_bf16(v0[2], v0[3]); w.z = cvt_pk_bf16(v1[0], v1[1]); w.w = cvt_pk_bf16(v1[2], v1[3]);
                    *(u32x4*)(out + off + bj * HALF) = w; } }
    }
};
struct ProjOrder {
    StaticOrder lat; int c;
    __device__ __forceinline__ bool next(int i, Unit& u) const {
        if (i < 4) return lat.next(i, u);
        if (i != 4 || c >= 144) return false;
        const int ks = c & 3, t = c >> 2, t9 = t % 9;
        u.pm = 64 + t / 9; u.pn = t9 < 2 ? 2 + t9 : (t9 < 6 ? 4 + t9 : 5 + t9); u.kofs = ks * 256; u.kt = 4; return true; }
    __device__ __forceinline__ void a_ready(const Unit&) const {}
    __device__ __forceinline__ void done(const Unit&) const {}
};
struct EpiProjAll {
    static constexpr bool PERM = true, AFTER_DRAIN = false;
    EpiProj lat; bf16_t* slab;
    __device__ __forceinline__ void operator()(const f32x4 (&acc)[2][2][4][2], const Unit& u, int wr, int wc, int fr, int fq) const {
        if (!u.kt) { lat(acc, u, wr, wc, fr, fq); return; }
        const int t9 = u.pn < 4 ? u.pn - 2 : (u.pn < 10 ? u.pn - 4 : u.pn - 5);
        bf16_t* out = slab + ((size_t)(u.kofs >> 8) * 1024 + (size_t)(u.pm - 64) * BM) * 2304 + t9 * 256 + wc * 32 + 8 * fq;
#pragma unroll
        for (int ai = 0; ai < 2; ++ai)
#pragma unroll
            for (int m = 0; m < 4; ++m) { bf16_t* rowp = out + (size_t)(ai * HALF + wr * 64 + m * 16 + fr) * 2304;
#pragma unroll
                for (int bj = 0; bj < 2; ++bj) { const f32x4 v0 = acc[ai][bj][m][0], v1 = acc[ai][bj][m][1];
                    u32x4 w; w.x = cvt_pk_bf16(v0[0], v0[1]); w.y = cvt_pk_bf16(v0[2], v0[3]); w.z = cvt_pk_bf16(v1[0], v1[1]); w.w = cvt_pk_bf16(v1[2], v1[3]);
                    *(u32x4*)(rowp + bj * HALF) = w; } }
    }
};

template <bool BASE_BF16>
struct EpiResidB {
    static constexpr bool PERM = true, AFTER_DRAIN = false;
    const void* base; bf16_t* out; const float* gate; float coef;
    __device__ __forceinline__ void operator()(const f32x4 (&acc)[2][2][4][2], const Unit& u, int wr, int wc, int fr, int fq) const {
        const float* g = gate + (size_t)(u.pm >> 4) * 9216;
        const int col0 = u.pn * BM + wc * 32 + 8 * fq;
        f32x4 gv[2][2];
#pragma unroll
        for (int bj = 0; bj < 2; ++bj)
#pragma unroll
            for (int n = 0; n < 2; ++n) gv[bj][n] = *(const f32x4*)(g + col0 + bj * HALF + 4 * n) * coef;
#pragma unroll
        for (int ai = 0; ai < 2; ++ai)
#pragma unroll
            for (int m = 0; m < 4; ++m) { const size_t off = (size_t)(u.pm * BM + ai * HALF + wr * 64 + m * 16 + fr) * 1024 + col0;
#pragma unroll
                for (int bj = 0; bj < 2; ++bj) { f32x4 b0, b1;
                    if (BASE_BF16) { const u32x4 bw = *(const u32x4*)((const bf16_t*)base + off + bj * HALF);
                        b0 = (f32x4){__builtin_bit_cast(float, bw.x << 16), __builtin_bit_cast(float, bw.x & 0xffff0000u), __builtin_bit_cast(float, bw.y << 16), __builtin_bit_cast(float, bw.y & 0xffff0000u)};
                        b1 = (f32x4){__builtin_bit_cast(float, bw.z << 16), __builtin_bit_cast(float, bw.z & 0xffff0000u), __builtin_bit_cast(float, bw.w << 16), __builtin_bit_cast(float, bw.w & 0xffff0000u)}; }
                    else { b0 = *(const f32x4*)((const float*)base + off + bj * HALF); b1 = *(const f32x4*)((const float*)base + off + bj * HALF + 4); }
                    const f32x4 v0 = b0 + gv[bj][0] * acc[ai][bj][m][0], v1 = b1 + gv[bj][1] * acc[ai][bj][m][1];
                    u32x4 w; w.x = cvt_pk_bf16(v0[0], v0[1]); w.y = cvt_pk_bf16(v0[2], v0[3]); w.z = cvt_pk_bf16(v1[0], v1[1]); w.w = cvt_pk_bf16(v1[2], v1[3]);
                    *(u32x4*)(out + off + bj * HALF) = w; } }
    }
};

template <class Epi, class Sched, bool ALIGN_EPI = false, bool SP2 = false>
__device__ __forceinline__ void gemm_phase(PG8_LAS unsigned char* lds, const Gemm g, const Sched& S, const Epi& E) {
    const int tid = threadIdx.x, wid = __builtin_amdgcn_readfirstlane(tid >> 6), lane = tid & 63, wr = wid >> 2, wc = wid & 3, fr = lane & 15, fq = lane >> 4;
    const int K = g.K, nt = K / BK, LD = g.ld;
    unsigned voffA[2], voffB[2];
#pragma unroll
    for (int i = 0; i < 2; ++i) { int R, C; stage_rc(tid * 16 + i * 8192, R, C); const int Rb = Epi::PERM ? ((R & ~31) + perm32(R & 31)) : R;
        voffA[i] = (unsigned)(R * LD + C) * 2u; voffB[i] = (unsigned)(Rb * LD + C) * 2u; }
    const size_t kstep = (size_t)(BK * 2);
    const size_t hstep = (size_t)HALF * LD * 2;
    const size_t tstep = 2 * hstep;
    const unsigned ldsw = (unsigned)wid * 1024u;
    const int aoff = lds_byte(wr * 64 + fr, fq * 8), boff = lds_byte(wc * 32 + fr, fq * 8);
#define PG8_SA(b, h) (((b) * 2 + (h)) * HTB)
#define PG8_SB(b, h) ((4 + (b) * 2 + (h)) * HTB)
#define PG8_STAGE(bufoff, gbase, voff) do { _Pragma("unroll") for (int _i = 0; _i < 2; ++_i) \
        __builtin_amdgcn_global_load_lds((const unsigned*)((const char*)(gbase) + (voff)[_i]), (PG8_LAS unsigned*)(lds + (bufoff) + ldsw + _i * 8192), 16, 0, 0); } while (0)
#define PG8_LDA(dst, b, h) do { _Pragma("unroll") for (int m = 0; m < 4; ++m) _Pragma("unroll") for (int k = 0; k < 2; ++k) dst[m][k] = *(const PG8_LAS bf16x8*)(lds + PG8_SA(b, h) + aoff + m * 2048 + k * 1024); } while (0)
#define PG8_LDB(dst, b, h) do { _Pragma("unroll") for (int n = 0; n < 2; ++n) _Pragma("unroll") for (int k = 0; k < 2; ++k) dst[n][k] = *(const PG8_LAS bf16x8*)(lds + PG8_SB(b, h) + boff + n * 2048 + k * 1024); } while (0)
#define PG8_MMA(ai, bj, At, Bt) do { __builtin_amdgcn_s_setprio(1); _Pragma("unroll") for (int m = 0; m < 4; ++m) _Pragma("unroll") for (int n = 0; n < 2; ++n) _Pragma("unroll") for (int k = 0; k < 2; ++k) \
        acc[ai][bj][m][n] = __builtin_amdgcn_mfma_f32_16x16x32_bf16(Bt[n][k], At[m][k], acc[ai][bj][m][n], 0, 0, 0); __builtin_amdgcn_s_setprio(0); } while (0)
#define PG8_WAIT_V(n) asm volatile("s_waitcnt vmcnt(" #n ")" ::: "memory")
#define PG8_WAIT_L(n) asm volatile("s_waitcnt lgkmcnt(" #n ")" ::: "memory")
#define PG8_BAR __builtin_amdgcn_s_barrier()
#define PG8_SCHED __builtin_amdgcn_sched_barrier(0)
    Unit cur, nxt; int ui = 0;
    if (!S.next(0, cur)) return;
    f32x4 acc[2][2][4][2];
#pragma unroll
    for (int a = 0; a < 2; ++a)
#pragma unroll
        for (int b = 0; b < 2; ++b)
#pragma unroll
            for (int m = 0; m < 4; ++m)
#pragma unroll
                for (int n = 0; n < 2; ++n) acc[a][b][m][n] = (f32x4){0.f, 0.f, 0.f, 0.f};
    bf16x8 At[4][2], B0[2][2], B1[2][2];
    const char* cA = (const char*)g.A + (size_t)cur.pm * tstep + (size_t)cur.kofs * 2; const char* cB = (const char*)g.Bt + (size_t)cur.pn * tstep + (size_t)cur.kofs * 2;
    S.a_ready(cur);
    if constexpr (SP2) {
        PG8_STAGE(PG8_SB(0, 0), cB, voffB); PG8_STAGE(PG8_SB(0, 1), cB + hstep, voffB); PG8_STAGE(PG8_SA(0, 0), cA, voffA); PG8_STAGE(PG8_SA(0, 1), cA + hstep, voffA);
        if (wr == 1) PG8_BAR;
        PG8_WAIT_V(2); PG8_BAR;
        PG8_STAGE(PG8_SB(1, 0), cB + kstep, voffB); PG8_STAGE(PG8_SA(1, 0), cA + kstep, voffA); PG8_STAGE(PG8_SB(1, 1), cB + hstep + kstep, voffB);
        PG8_WAIT_V(6); PG8_BAR;
    } else {
        PG8_STAGE(PG8_SB(0, 0), cB, voffB); PG8_STAGE(PG8_SA(0, 0), cA, voffA); PG8_STAGE(PG8_SB(0, 1), cB + hstep, voffB); PG8_STAGE(PG8_SA(0, 1), cA + hstep, voffA);
        if (wr == 1) PG8_BAR;
        PG8_WAIT_V(4); PG8_BAR;
        PG8_STAGE(PG8_SB(1, 0), cB + kstep, voffB); PG8_STAGE(PG8_SA(1, 0), cA + kstep, voffA); PG8_STAGE(PG8_SB(1, 1), cB + hstep + kstep, voffB);
        PG8_WAIT_V(6); PG8_BAR;
    }
    for (;;) {
        const bool has_next = S.next(ui + 1, nxt);
        const char* nA = has_next ? (const char*)g.A + (size_t)nxt.pm * tstep + (size_t)nxt.kofs * 2 : cA; const char* nB = has_next ? (const char*)g.Bt + (size_t)nxt.pn * tstep + (size_t)nxt.kofs * 2 : cB;
        const int ntu = cur.kt ? cur.kt : nt;
        for (int t = 0; t < ntu; t += 2) {
            const bool last = (t == ntu - 2);
            const char* a1 = cA + (size_t)(t + 1) * kstep;
            const char* a2 = last ? nA : cA + (size_t)(t + 2) * kstep; const char* b2 = last ? nB : cB + (size_t)(t + 2) * kstep;
            const char* a3 = a2 + kstep; const char* b3 = b2 + kstep;
            if (last && has_next) S.a_ready(nxt);
            if constexpr (SP2) {
            PG8_LDB(B0, 0, 0); PG8_LDB(B1, 0, 1); PG8_SCHED; PG8_LDA(At, 0, 0); PG8_STAGE(PG8_SA(1, 1), a1 + hstep, voffA);
            PG8_WAIT_V(8); PG8_WAIT_L(0); PG8_BAR; PG8_MMA(0, 0, At, B0); PG8_MMA(0, 1, At, B1); PG8_BAR; PG8_SCHED;
            PG8_LDA(At, 0, 1); PG8_STAGE(PG8_SB(0, 0), b2, voffB); PG8_STAGE(PG8_SB(0, 1), b2 + hstep, voffB); PG8_STAGE(PG8_SA(0, 0), a2, voffA);
            PG8_WAIT_V(8); PG8_WAIT_L(0); PG8_BAR; PG8_MMA(1, 0, At, B0); PG8_MMA(1, 1, At, B1); PG8_BAR; PG8_SCHED;
            PG8_LDB(B0, 1, 0); PG8_LDB(B1, 1, 1); PG8_SCHED; PG8_LDA(At, 1, 0); PG8_STAGE(PG8_SA(0, 1), a2 + hstep, voffA);
            PG8_WAIT_V(8); PG8_WAIT_L(0); PG8_BAR; PG8_MMA(0, 0, At, B0); PG8_MMA(0, 1, At, B1); PG8_BAR; PG8_SCHED;
            PG8_LDA(At, 1, 1); PG8_STAGE(PG8_SB(1, 0), b3, voffB); PG8_STAGE(PG8_SB(1, 1), b3 + hstep, voffB); PG8_STAGE(PG8_SA(1, 0), a3, voffA);
            PG8_WAIT_V(8); PG8_WAIT_L(0); PG8_BAR; PG8_MMA(1, 0, At, B0); PG8_MMA(1, 1, At, B1); PG8_BAR; PG8_SCHED;
            } else {
            PG8_LDB(B0, 0, 0); PG8_SCHED; PG8_LDA(At, 0, 0); PG8_STAGE(PG8_SA(1, 1), a1 + hstep, voffA);
            PG8_WAIT_L(8); PG8_BAR; PG8_WAIT_L(0); PG8_MMA(0, 0, At, B0); PG8_BAR; PG8_SCHED;
            PG8_LDB(B1, 0, 1); PG8_STAGE(PG8_SB(0, 0), b2, voffB);
            PG8_BAR; PG8_WAIT_L(0); PG8_MMA(0, 1, At, B1); PG8_BAR;
            PG8_LDA(At, 0, 1); PG8_STAGE(PG8_SA(0, 0), a2, voffA);
            PG8_BAR; PG8_WAIT_L(0); PG8_MMA(1, 0, At, B0); PG8_BAR; PG8_SCHED;
            PG8_STAGE(PG8_SB(0, 1), b2 + hstep, voffB);
            PG8_WAIT_V(6); PG8_BAR; PG8_MMA(1, 1, At, B1); PG8_BAR;
            PG8_LDB(B0, 1, 0); PG8_SCHED; PG8_LDA(At, 1, 0); PG8_STAGE(PG8_SA(0, 1), a2 + hstep, voffA);
            PG8_WAIT_L(8); PG8_BAR; PG8_WAIT_L(0); PG8_MMA(0, 0, At, B0); PG8_BAR; PG8_SCHED;
            PG8_LDB(B1, 1, 1); PG8_STAGE(PG8_SB(1, 0), b3, voffB);
            PG8_BAR; PG8_WAIT_L(0); PG8_MMA(0, 1, At, B1); PG8_BAR;
            PG8_LDA(At, 1, 1); PG8_STAGE(PG8_SA(1, 0), a3, voffA);
            PG8_BAR; PG8_WAIT_L(0); PG8_MMA(1, 0, At, B0); PG8_BAR; PG8_SCHED;
            PG8_STAGE(PG8_SB(1, 1), b3 + hstep, voffB);
            PG8_WAIT_V(6); PG8_BAR; PG8_MMA(1, 1, At, B1); PG8_BAR;
            }
        }
        if constexpr (ALIGN_EPI) { if (wr == 0) PG8_BAR; }
        if constexpr (!Epi::AFTER_DRAIN) { PG8_PS_BEGIN(); E(acc, cur, wr, wc, fr, fq); S.done(cur); PG8_PS_END(); }
        if (!has_next) break;
#pragma unroll
        for (int a = 0; a < 2; ++a)
#pragma unroll
            for (int b = 0; b < 2; ++b)
#pragma unroll
                for (int m = 0; m < 4; ++m)
#pragma unroll
                    for (int n = 0; n < 2; ++n) acc[a][b][m][n] = (f32x4){0.f, 0.f, 0.f, 0.f};
        cur = nxt; cA = nA; cB = nB; ++ui;
        if constexpr (ALIGN_EPI) { if (wr == 1) PG8_BAR; }
    }
    PG8_WAIT_V(0);
    if constexpr (!ALIGN_EPI) { if (wr == 0) PG8_BAR; }
    PG8_BAR;
    if constexpr (Epi::AFTER_DRAIN) { E.fused(acc, cur, wr, wc, fr, fq, lds, wid, lane); S.done(cur); }
#undef PG8_SA
#undef PG8_SB
#undef PG8_STAGE
#undef PG8_LDA
#undef PG8_LDB
#undef PG8_MMA
#undef PG8_WAIT_V
#undef PG8_WAIT_L
#undef PG8_BAR
#undef PG8_SCHED
}
}
constexpr int DM = 1024, NB = 4, SEQ = 4096, NCTX = 256, DFF = 2816, DIN = 4112, NPROJ = 4096, NMODC = 9216;
constexpr int MLAT = NB * SEQ, MCTX = NB * NCTX, MALL = MLAT + MCTX;
constexpr float EPSN = 1e-6f;
constexpr int NWAVES = 8, NTHREADS = 512;
#ifndef ONE_LAUNCH
#define ONE_LAUNCH 1
#endif
constexpr int NPHASES = 15;

constexpr size_t MiB = 1u << 20;
constexpr size_t WS_CTL = 0, CTL_ZERO_BYTES = 64 * 1024;
constexpr size_t WS_MODS = 1 * MiB;
constexpr size_t WS_GATES = 1 * MiB + 512 * 1024;
constexpr size_t WS_W1 = 3 * MiB;
constexpr size_t WS_W2 = 14 * MiB;
constexpr size_t WS_WIN = 20 * MiB;
constexpr size_t WS_WOUT = 28 * MiB;
constexpr size_t WS_X1CTX = 30 * MiB;
constexpr size_t WS_XN = 34 * MiB;
constexpr size_t WS_PROJ = 68 * MiB;
constexpr size_t WS_QK = 204 * MiB;
constexpr size_t WS_OF = 221 * MiB;
constexpr size_t WS_OB = 34 * MiB;
constexpr size_t WS_END = 256 * MiB;
constexpr size_t WS_HGST = 232 * MiB;
constexpr size_t WS_HGG = 248 * MiB;
constexpr size_t WS_WG = 2 * MiB + 640 * 1024;
constexpr size_t WS_MLST = 221 * MiB;
constexpr size_t WS_MLSC = 231 * MiB;
constexpr size_t WS_SLAB = 204 * MiB;
constexpr size_t WS_SLAB2 = 221 * MiB;
constexpr int CW_BAR = 1024;

constexpr int RING_BYTES = 131072;
constexpr int LDSCTL_OFF = 162816, MISC_OFF = LDSCTL_OFF + 320;
constexpr int LDS_BYTES = 163840;

#define GAS __attribute__((address_space(1)))
#define LAS __attribute__((address_space(3)))
typedef unsigned short bf16;
typedef unsigned v4u __attribute__((ext_vector_type(4)));
typedef unsigned v2u __attribute__((ext_vector_type(2)));
typedef float f32x4 __attribute__((ext_vector_type(4)));
#define LDS_WAIT() asm volatile("s_waitcnt lgkmcnt(0)" ::: "memory")
#define VM_WAIT() asm volatile("s_waitcnt vmcnt(0)" ::: "memory")
__device__ __forceinline__ unsigned f2bf(float f) { unsigned u = __builtin_bit_cast(unsigned, f); return (u + 0x7fffu + ((u >> 16) & 1u)) >> 16; }
__device__ __forceinline__ unsigned pk2(float lo, float hi) { return f2bf(lo) | (f2bf(hi) << 16); }
__device__ __forceinline__ float bf2f(unsigned short h) { return __builtin_bit_cast(float, (unsigned)h << 16); }
__device__ __forceinline__ float bflo(unsigned w) { return __builtin_bit_cast(float, w << 16); }
__device__ __forceinline__ float bfhi(unsigned w) { return __builtin_bit_cast(float, w & 0xffff0000u); }
__device__ __forceinline__ float sigmoidf_(float v) { return 1.0f / (1.0f + __expf(-v)); }
__device__ __forceinline__ float fast_sig(float v) { return __builtin_amdgcn_rcpf(1.0f + __builtin_amdgcn_exp2f(-1.4426950408889634f * v)); }
__device__ __forceinline__ float siluf_(float v) { return v * sigmoidf_(v); }
__device__ __forceinline__ float wave_sum(float v) {
#pragma unroll
    for (int o = 1; o < 64; o <<= 1) v += __shfl_xor(v, o);
    return v;
}

#ifndef PROF_S
#define PROF_S -1
#endif
#define PS_BEGIN() do { if (PROF_S >= 0 && blockIdx.x == 0 && threadIdx.x == 0) { const unsigned long long t_ = __builtin_amdgcn_s_memrealtime(); volatile LAS unsigned* M_ = (volatile LAS unsigned*)(T.lds + MISC_OFF); M_[20] = (unsigned)t_; M_[21] = (unsigned)(t_ >> 32); } } while (0)
#define PS_END(id) do { if (PROF_S >= 0 && blockIdx.x == 0 && threadIdx.x == 0) { const unsigned long long t_ = __builtin_amdgcn_s_memrealtime(); volatile LAS unsigned* M_ = (volatile LAS unsigned*)(T.lds + MISC_OFF); \
    if ((id) == PROF_S) { const unsigned long long p_ = ((unsigned long long)M_[21] << 32) | M_[20]; const unsigned long long a_ = (((unsigned long long)M_[23] << 32) | M_[22]) + (t_ - p_); M_[22] = (unsigned)a_; M_[23] = (unsigned)(a_ >> 32); } \
    M_[20] = (unsigned)t_; M_[21] = (unsigned)(t_ >> 32); } } while (0)
#define XB_TMO      128
#define XB_XCNT(j)  (256  + 64 * (j))
#define XB_XSUB(j)  (1280 + 64 * (j))
#define XB_XGEN(j)  (2304 + 64 * (j))
#define XB_TOP      3328
#define XB_TOPGEN   3392
#define XCD_BAR_WORDS 3456
#define XB_SPIN_CAP (1u << 18)

__device__ __forceinline__ unsigned xb_ld(unsigned* p)              { return __hip_atomic_load(p, __ATOMIC_RELAXED, __HIP_MEMORY_SCOPE_AGENT); }
__device__ __forceinline__ unsigned xb_add(unsigned* p, unsigned v) { return __hip_atomic_fetch_add(p, v, __ATOMIC_RELAXED, __HIP_MEMORY_SCOPE_AGENT); }
__device__ __forceinline__ unsigned xb_xcc_id() { return (unsigned)__builtin_amdgcn_s_getreg((3 << 11) | 20) & 0xFu; }
#define XB_SPIN(cond, bar) do { unsigned _sp = 0; while (cond) { __builtin_amdgcn_s_sleep(1); \
    if ((++_sp & 255u) == 0u) { if (xb_ld(&(bar)[XB_TMO])) break; if (_sp > XB_SPIN_CAP) { atomicAdd(&(bar)[XB_TMO], 1u); break; } } } } while (0)

struct XcdBarrier {
    unsigned* bar; unsigned x;
    volatile LAS unsigned* st;
};

__device__ __forceinline__ XcdBarrier xcd_barrier_post(unsigned* bar, volatile LAS unsigned* st) {
    XcdBarrier b; b.bar = bar; b.x = xb_xcc_id(); b.st = st;
    if (threadIdx.x == 0) (void)xb_add(&bar[XB_XCNT(b.x)], 1u);
    return b;
}
__device__ __forceinline__ void xcd_barrier_complete(unsigned* bar, unsigned x, unsigned& nloc, unsigned& nx) {
    const unsigned G = gridDim.x * gridDim.y * gridDim.z;
    unsigned sum, cnt, mine, sp = 0u;
    for (;;) {
        sum = 0u; cnt = 0u; mine = 0u;
#pragma unroll
        for (unsigned j = 0; j < 16; ++j) { const unsigned c = xb_ld(&bar[XB_XCNT(j)]); sum += c; cnt += (c > 0u) ? 1u : 0u; mine = (j == x) ? c : mine; }
        if (sum == G) break;
        __builtin_amdgcn_s_sleep(1);
        if ((++sp & 255u) == 0u) { if (xb_ld(&bar[XB_TMO])) break; if (sp > XB_SPIN_CAP) { atomicAdd(&bar[XB_TMO], 1u); break; } }
    }
    nloc = mine > 0u ? mine : 1u; nx = cnt > 0u ? cnt : 1u;
}

__device__ __forceinline__ void xcd_barrier(const XcdBarrier& b) {
    asm volatile("s_waitcnt vmcnt(0)" ::: "memory");
    __syncthreads();
    if (threadIdx.x == 0) {
        unsigned* bar = b.bar;
        __builtin_amdgcn_s_waitcnt(0);
        unsigned nloc = b.st[0], nx = b.st[1];
        if (nloc == 0u) { xcd_barrier_complete(bar, b.x, nloc, nx); b.st[0] = nloc; b.st[1] = nx; }
        const unsigned old = xb_add(&bar[XB_XSUB(b.x)], 1u);
        const unsigned gen = old / nloc;
        if (old + 1u == (gen + 1u) * nloc) {
            __builtin_amdgcn_fence(__ATOMIC_RELEASE, "agent");
            asm volatile("s_waitcnt vmcnt(0)" ::: "memory");
            const unsigned og = xb_add(&bar[XB_TOP], 1u);
            const unsigned tg = og / nx;
            if (og + 1u == (tg + 1u) * nx) xb_add(&bar[XB_TOPGEN], 1u);
            else XB_SPIN(xb_ld(&bar[XB_TOPGEN]) == tg, bar);
            __builtin_amdgcn_fence(__ATOMIC_ACQUIRE, "agent");
            xb_add(&bar[XB_XGEN(b.x)], 1u);
            asm volatile("s_waitcnt vmcnt(0)" ::: "memory");
        } else {
            XB_SPIN(xb_ld(&bar[XB_XGEN(b.x)]) == gen, bar);
            __builtin_amdgcn_fence(__ATOMIC_ACQUIRE, "agent");
            asm volatile("s_waitcnt vmcnt(0)" ::: "memory");
        }
    }
    __syncthreads();
}
struct Args {
    const float* in[22]; float* out; unsigned char* ws; int ph_lo, ph_hi;
};
enum { I_X = 0, I_C, I_CTX, I_CCTX, I_WMOD, I_BMOD, I_N1W, I_F1W1, I_F1W2, I_N2W, I_WIN, I_MLGB, I_CONVW, I_CONVB, I_LBLOG, I_HGNW, I_MLNW, I_WOUT, I_N3W, I_F2W1, I_F2W2, I_FNW };

struct Ctx {
    LAS unsigned char* lds;
    int tid, lane, wave, vcu, G, gw, NGW;
};

__device__ __forceinline__ void mods_phase(const Args& a, const Ctx& T) {
    LAS float* sL = (LAS float*)T.lds;
    LAS float* red = (LAS float*)(T.lds + 20480);
    const float* c = a.in[I_C]; const float* cc = a.in[I_CCTX];
    for (int i = T.tid; i < 5 * 1024; i += NTHREADS) { const int r = i >> 10, k = i & 1023; const float v = r < 4 ? c[r * 1024 + k] : cc[k]; sL[i] = siluf_(v); }
    __syncthreads();
    typedef float f2 __attribute__((ext_vector_type(2)));
    for (int item = T.vcu; item < 576; item += T.G) {
        const int cb = item >> 3, kr = item & 7; const int k0 = kr * 128 + T.wave * 16;
        const float* W = a.in[I_WMOD] + (size_t)k0 * NMODC + cb * 128 + 2 * T.lane;
        f2 wv[16];
#pragma unroll
        for (int k = 0; k < 16; ++k) wv[k] = *(const f2*)(W + (size_t)k * NMODC);
        float acc[5][2];
#pragma unroll
        for (int r = 0; r < 5; ++r) { acc[r][0] = 0.f; acc[r][1] = 0.f; }
#pragma unroll
        for (int k = 0; k < 16; ++k)
#pragma unroll
            for (int r = 0; r < 5; ++r) { const float s = sL[r * 1024 + k0 + k]; acc[r][0] += s * wv[k].x; acc[r][1] += s * wv[k].y; }
#pragma unroll
        for (int r = 0; r < 5; ++r) *(LAS f2*)(red + (T.wave * 5 + r) * 128 + 2 * T.lane) = (f2){acc[r][0], acc[r][1]};
        __syncthreads();
        for (int o = T.tid; o < 640; o += NTHREADS) { const int r = o >> 7, cl = o & 127; float s = 0.f;
#pragma unroll
            for (int w = 0; w < 8; ++w) s += red[(w * 5 + r) * 128 + cl];
            const int col = cb * 128 + cl; if (kr == 0) s += a.in[I_BMOD][col];
            atomicAdd((float*)(a.ws + WS_MODS) + r * NMODC + col, s); }
        __syncthreads();
    }
}

__device__ __forceinline__ void transpose_item(const float* W, int ldw, int K, bf16* WT, int k0, int n0, int dest_row0, LAS float* scr, int lane) {
    float tv[32];
#pragma unroll
    for (int i = 0; i < 32; ++i) tv[i] = W[(size_t)(k0 + 2 * i + (lane >> 5)) * ldw + n0 + (lane & 31)];
#pragma unroll
    for (int i = 0; i < 32; ++i) scr[(2 * i + (lane >> 5)) * 33 + (lane & 31)] = tv[i];
    LDS_WAIT(); asm volatile("" ::: "memory");
    const int c = lane & 7;
#pragma unroll
    for (int j = 0; j < 4; ++j) { const int n = (lane >> 3) + 8 * j; const LAS float* s = scr + (8 * c) * 33 + n;
        v4u o; o.x = pk2(s[0 * 33], s[1 * 33]); o.y = pk2(s[2 * 33], s[3 * 33]); o.z = pk2(s[4 * 33], s[5 * 33]); o.w = pk2(s[6 * 33], s[7 * 33]);
        *(GAS v4u*)(WT + (size_t)(dest_row0 + n) * K + k0 + 8 * c) = o; }
    LDS_WAIT(); asm volatile("" ::: "memory");
}
__device__ __forceinline__ void convert_ffn(const Args& a, const Ctx& T, const float* w1, const float* w2) {
    LAS float* scr = (LAS float*)(T.lds + T.wave * 16384);
    bf16* W1 = (bf16*)(a.ws + WS_W1); bf16* W2 = (bf16*)(a.ws + WS_W2);
    constexpr int I1 = 16 * 176, I2 = 44 * 32;
    for (int it = T.gw; it < I1 + I2; it += T.NGW) {
        if (it < I1) { const int kb = it / 176, nb = it % 176, n0 = nb * 32;
            const int dest = n0 < DFF ? (n0 >> 7) * 256 + (n0 & 127) : ((n0 - DFF) >> 7) * 256 + 128 + ((n0 - DFF) & 127);
            transpose_item(w1, 2 * DFF, DM, W1, kb * 64, n0, dest, scr, T.lane); }
        else { const int r = it - I1, kb = r / 32, nb = r % 32; transpose_item(w2, DM, DFF, W2, kb * 64, nb * 32, nb * 32, scr, T.lane); }
    }
}
__device__ __forceinline__ void convert_mix(const Args& a, const Ctx& T) {
    LAS float* scr = (LAS float*)(T.lds + T.wave * 16384);
    bf16* WI = (bf16*)(a.ws + WS_WIN); bf16* WO = (bf16*)(a.ws + WS_WOUT);
    constexpr int I1 = 16 * 128, I2 = 16 * 32;
    for (int it = T.gw; it < I1 + I2; it += T.NGW) {
        if (it < I1) { const int kb = it / 128, nb = it % 128; transpose_item(a.in[I_WIN], DIN, DM, WI, kb * 64, nb * 32, nb * 32, scr, T.lane); }
        else { const int r = it - I1, kb = r / 32, nb = r % 32; transpose_item(a.in[I_WOUT], DM, DM, WO, kb * 64, nb * 32, nb * 32, scr, T.lane); }
    }
}

__device__ __forceinline__ void norm_load_row(f32x4 (&v)[4], const void* src_lat, bool latbf, const float* src_ctx, int m, int lane) {
    if (m < MLAT) {
        if (latbf) { const v2u* xr = (const v2u*)((const bf16*)src_lat + (size_t)m * DM) + lane;
#pragma unroll
            for (int j = 0; j < 4; ++j) { const v2u w = xr[64 * j]; v[j] = (f32x4){bflo(w.x), bfhi(w.x), bflo(w.y), bfhi(w.y)}; } }
        else { const f32x4* xr = (const f32x4*)((const float*)src_lat + (size_t)m * DM) + lane;
#pragma unroll
            for (int j = 0; j < 4; ++j) v[j] = xr[64 * j]; }
    } else { const f32x4* xr = (const f32x4*)(src_ctx + (size_t)(m - MLAT) * DM) + lane;
#pragma unroll
        for (int j = 0; j < 4; ++j) v[j] = xr[64 * j]; }
}
template <bool CTXSLAB, bool LATBF>
__device__ __forceinline__ void norm_mod_rows(const Args& a, const Ctx& T, const void* src_lat, const float* src_ctx, int nrows, const float* nw, int shift_idx, int scale_idx) {
    const float* mods = (const float*)(a.ws + WS_MODS);
    bf16* XN = (bf16*)(a.ws + WS_XN);
    f32x4 wv[4];
#pragma unroll
    for (int j = 0; j < 4; ++j) wv[j] = *((const f32x4*)nw + T.lane + 64 * j);
    f32x4 v[4];
    if (T.gw < nrows) norm_load_row(v, src_lat, LATBF, src_ctx, T.gw, T.lane);
    for (int m = T.gw; m < nrows; m += T.NGW) {
        const float* mr = mods + (size_t)(m < MLAT ? (m >> 12) : 4) * NMODC;
        f32x4 sh[4], sc[4];
#pragma unroll
        for (int j = 0; j < 4; ++j) { sh[j] = *((const f32x4*)(mr + shift_idx * 1024) + T.lane + 64 * j); sc[j] = *((const f32x4*)(mr + scale_idx * 1024) + T.lane + 64 * j); }
        f32x4 cur[4]; float s = 0.f;
        if (CTXSLAB && m >= MLAT) {
            const float* gr = mods + (size_t)4 * NMODC + 2 * 1024;
#pragma unroll
            for (int j = 0; j < 4; ++j) { f32x4 acc = (f32x4){0.f, 0.f, 0.f, 0.f};
#pragma unroll 1
                for (int ks = 0; ks < 11; ++ks) acc += *((const f32x4*)((const float*)(a.ws + WS_SLAB) + ((size_t)ks * 1024 + (m - MLAT)) * 1024) + T.lane + 64 * j);
                v[j] = v[j] + acc * (*((const f32x4*)gr + T.lane + 64 * j) * 0.5f); }
        }
#pragma unroll
        for (int j = 0; j < 4; ++j) { cur[j] = v[j]; s += (v[j].x * v[j].x + v[j].y * v[j].y) + (v[j].z * v[j].z + v[j].w * v[j].w); }
        { const int mn = m + T.NGW; if (mn < nrows) norm_load_row(v, src_lat, LATBF, src_ctx, mn, T.lane); }
        const float rstd = __builtin_amdgcn_rsqf(wave_sum(s) * (1.f / DM) + EPSN);
        unsigned long long* o8 = (unsigned long long*)(XN + (size_t)m * DM) + T.lane;
#pragma unroll
        for (int j = 0; j < 4; ++j) { const f32x4 y = (cur[j] * rstd * wv[j]) * (sc[j] + 1.0f) + sh[j];
            o8[64 * j] = (unsigned long long)pk2(y.x, y.y) | ((unsigned long long)pk2(y.z, y.w) << 32); }
    }
}

struct ConvTaps { v4u t[9]; };
__device__ __forceinline__ void conv_load(ConvTaps& R, const bf16* P, int m, int ch0) {
    const v4u z = (v4u){0u, 0u, 0u, 0u};
    const int b = m >> 12, t = m & 4095, r = t >> 6, c = t & 63;
#pragma unroll
    for (int dr = -1; dr <= 1; ++dr)
#pragma unroll
        for (int dc = -1; dc <= 1; ++dc) { const int rr = r + dr, c2 = c + dc; const bool ok = rr >= 0 && rr < 64 && c2 >= 0 && c2 < 64;
            R.t[(dr + 1) * 3 + dc + 1] = ok ? *(const v4u*)(P + (size_t)(b * 4096 + rr * 64 + c2) * NPROJ + 2560 + ch0) : z; }
}
__device__ __forceinline__ void ctx_combine(const Args& a, const Ctx& T) {
    const bf16* S2 = (const bf16*)(a.ws + WS_SLAB2); bf16* P = (bf16*)(a.ws + WS_PROJ);
    for (int task = T.vcu * NTHREADS + T.tid; task < 1024 * 256; task += T.G * NTHREADS) {
        const int r = task >> 8, q = task & 255; const int t8 = q >> 5, c8 = (q & 31) * 8; const int t9 = t8 < 6 ? t8 : t8 + 1;
        const int pn = t9 < 2 ? 2 + t9 : (t9 < 6 ? 4 + t9 : 5 + t9);
        float s[8] = {0.f, 0.f, 0.f, 0.f, 0.f, 0.f, 0.f, 0.f};
#pragma unroll
        for (int ks = 0; ks < 4; ++ks) { const v4u pv = *(const v4u*)(S2 + ((size_t)ks * 1024 + r) * 2304 + t9 * 256 + c8);
            s[0] += bflo(pv.x); s[1] += bfhi(pv.x); s[2] += bflo(pv.y); s[3] += bfhi(pv.y); s[4] += bflo(pv.z); s[5] += bfhi(pv.z); s[6] += bflo(pv.w); s[7] += bfhi(pv.w); }
        *(v4u*)(P + (size_t)(MLAT + r) * NPROJ + pn * 256 + c8) = (v4u){pk2(s[0], s[1]), pk2(s[2], s[3]), pk2(s[4], s[5]), pk2(s[6], s[7])};
    }
}
__device__ __forceinline__ void conv_phase(const Args& a, const Ctx& T) {
    const bf16* P = (const bf16*)(a.ws + WS_PROJ); bf16* QK = (bf16*)(a.ws + WS_QK);
    const float* cw = a.in[I_CONVW]; const float* cb = a.in[I_CONVB];
    const int gid = T.vcu * NTHREADS + T.tid; const int ch0 = (gid & 63) * 8; const int m0 = gid >> 6, mstep = (T.G * NTHREADS) >> 6;
    {
        float w[9][8], bias[8];
#pragma unroll
        for (int k = 0; k < 9; ++k)
#pragma unroll
            for (int i = 0; i < 8; ++i) w[k][i] = cw[k * 512 + ch0 + i];
#pragma unroll
        for (int i = 0; i < 8; ++i) bias[i] = cb[ch0 + i];
        const float sc = ch0 < 256 ? 0.125f : 1.0f;
        ConvTaps R;
        if (m0 < MLAT) conv_load(R, P, m0, ch0);
        for (int m = m0; m < MLAT; m += mstep) {
            float acc[8];
#pragma unroll
            for (int i = 0; i < 8; ++i) acc[i] = bias[i];
#pragma unroll
            for (int k = 0; k < 9; ++k) { const v4u pv = R.t[k];
                acc[0] += w[k][0] * bflo(pv.x); acc[1] += w[k][1] * bfhi(pv.x); acc[2] += w[k][2] * bflo(pv.y); acc[3] += w[k][3] * bfhi(pv.y);
                acc[4] += w[k][4] * bflo(pv.z); acc[5] += w[k][5] * bfhi(pv.z); acc[6] += w[k][6] * bflo(pv.w); acc[7] += w[k][7] * bfhi(pv.w); }
            if (m + mstep < MLAT) conv_load(R, P, m + mstep, ch0);
#pragma unroll
            for (int i = 0; i < 8; ++i) acc[i] = acc[i] * fast_sig(acc[i]) * sc;
            v4u o; o.x = pk2(acc[0], acc[1]); o.y = pk2(acc[2], acc[3]); o.z = pk2(acc[4], acc[5]); o.w = pk2(acc[6], acc[7]);
            *(v4u*)(QK + (size_t)m * 512 + ch0) = o;
        }
    }
    {
        const bf16* S2 = (const bf16*)(a.ws + WS_SLAB2);
#pragma unroll 1
        for (int task = gid; task < MCTX * 32; task += T.G * NTHREADS) {
            const int mc = task >> 5, c8 = (task & 31) * 8, b = mc >> 8, t = mc & 255;
            float acc[8];
#pragma unroll
            for (int i = 0; i < 8; ++i) acc[i] = cb[256 + c8 + i];
#pragma unroll 1
            for (int d = -1; d <= 1; ++d) { const int t2 = t + d; if (t2 < 0 || t2 >= 256) continue;
                float s[8] = {0.f, 0.f, 0.f, 0.f, 0.f, 0.f, 0.f, 0.f};
#pragma unroll
                for (int ks = 0; ks < 4; ++ks) { const v4u pv = *(const v4u*)(S2 + ((size_t)ks * 1024 + b * 256 + t2) * 2304 + 6 * 256 + c8);
                    s[0] += bflo(pv.x); s[1] += bfhi(pv.x); s[2] += bflo(pv.y); s[3] += bfhi(pv.y); s[4] += bflo(pv.z); s[5] += bfhi(pv.z); s[6] += bflo(pv.w); s[7] += bfhi(pv.w); }
                const float* wk = cw + (3 + d + 1) * 512 + 256 + c8;
#pragma unroll
                for (int i = 0; i < 8; ++i) acc[i] += wk[i] * bf2f((unsigned short)f2bf(s[i])); }
#pragma unroll
            for (int i = 0; i < 8; ++i) acc[i] = acc[i] * fast_sig(acc[i]);
            v4u o; o.x = pk2(acc[0], acc[1]); o.y = pk2(acc[2], acc[3]); o.z = pk2(acc[4], acc[5]); o.w = pk2(acc[6], acc[7]);
            *(v4u*)(QK + (size_t)(MLAT + mc) * 512 + 256 + c8) = o;
        }
    }
}

__device__ __forceinline__ int scan_row(int b, int dir, int p) {
    if (p < NCTX) return MLAT + b * NCTX + (dir ? NCTX - 1 - p : p);
    const int q = p - NCTX; return b * SEQ + (dir ? SEQ - 1 - q : q);
}
__device__ __forceinline__ void scan_hg_item(const Args& a, const Ctx& T, int item) {
    const int b = item >> 5, dir = (item >> 4) & 1, head = (item >> 2) & 3, es = item & 3;
    const bf16* P = (const bf16*)(a.ws + WS_PROJ);
    bf16* O = (bf16*)(a.ws + (dir ? WS_OB : WS_OF));
    LAS float* fL = (LAS float*)T.lds;
    LAS float* kL = fL + 32 * 128;
    LAS float* qL = kL + 32 * 128;
    LAS float* vL = qL + 32 * 128;
    LAS float* red = vL + 32 * 32;
    const int e = T.tid & 31, dg = T.tid >> 5;
    const float* lbl = a.in[I_LBLOG];
    float S[8];
#pragma unroll
    for (int j = 0; j < 8; ++j) S[j] = 0.f;
    for (int blk = 0; blk < (NCTX + SEQ) / 32; ++blk) {
        for (int idx = T.tid; idx < 32 * 128; idx += NTHREADS) { const int i = idx >> 7, d = idx & 127; const size_t m = (size_t)scan_row(b, dir, blk * 32 + i);
            const float fp = bf2f(P[m * NPROJ + (dir ? 2048 : 1536) + head * 128 + d]);
            const float qv = bf2f(P[m * NPROJ + head * 128 + d]);
            const int ch = head * 128 + d; const float lb = sigmoidf_(lbl[dir * 512 + ch] - lbl[(2 + dir) * 512 + ch]);
            const float sg = sigmoidf_(fp);
            fL[idx] = lb + (1.f - lb) * sg; kL[idx] = (1.f - lb) * (1.f - sg); qL[idx] = qv; }
        for (int idx = T.tid; idx < 32 * 32; idx += NTHREADS) { const int i = idx >> 5, ee = idx & 31; const size_t m = (size_t)scan_row(b, dir, blk * 32 + i);
            vL[idx] = bf2f(P[m * NPROJ + 512 + head * 128 + es * 32 + ee]); }
        __syncthreads();
#pragma unroll 1
        for (int half = 0; half < 2; ++half) {
#pragma unroll 4
            for (int ii = 0; ii < 16; ++ii) { const int i = half * 16 + ii; const float v = vL[i * 32 + e]; float po = 0.f;
#pragma unroll
                for (int j = 0; j < 8; ++j) { const int d = dg * 8 + j; S[j] = fL[i * 128 + d] * S[j] + kL[i * 128 + d] * v; po += qL[i * 128 + d] * S[j]; }
                red[(ii * 16 + dg) * 32 + e] = po; }
            __syncthreads();
            { const int ii = T.tid >> 5; float o = 0.f;
#pragma unroll
                for (int g = 0; g < 16; ++g) o += red[(ii * 16 + g) * 32 + e];
                const int p = blk * 32 + half * 16 + ii;
                if (p >= NCTX) { const size_t m = (size_t)scan_row(b, dir, p); O[m * DM + head * 128 + es * 32 + e] = (bf16)f2bf(o); } }
            __syncthreads();
        }
    }
}
__device__ __forceinline__ void scan_ml_item(const Args& a, const Ctx& T, int item) {
    const int b = item >> 5, dir = (item >> 4) & 1, head = (item >> 2) & 3, es = item & 3;
    const bf16* P = (const bf16*)(a.ws + WS_PROJ); const bf16* QK = (const bf16*)(a.ws + WS_QK); const float* GT = (const float*)(a.ws + WS_GATES);
    bf16* O = (bf16*)(a.ws + (dir ? WS_OB : WS_OF));
    LAS float* qL = (LAS float*)T.lds;
    LAS float* kL = qL + 32 * 64;
    LAS float* vL = kL + 32 * 64;
    LAS float* gi = vL + 32 * 32;
    LAS float* gf = gi + 32;
    LAS float* mv = gf + 32;
    LAS float* rden = mv + 16;
    LAS float* red = rden + 256;
    const int e = T.tid & 31, dg = T.tid >> 5;
    float C[4], n[4], mst = 0.f;
#pragma unroll
    for (int j = 0; j < 4; ++j) { C[j] = 0.f; n[j] = 0.f; }
    for (int blk = 0; blk < (NCTX + SEQ) / 32; ++blk) {
        for (int idx = T.tid; idx < 32 * 64; idx += NTHREADS) { const int i = idx >> 6, d = idx & 63; const size_t m = (size_t)scan_row(b, dir, blk * 32 + i);
            qL[idx] = bf2f(QK[m * 512 + head * 64 + d]); kL[idx] = bf2f(QK[m * 512 + 256 + head * 64 + d]); }
        for (int idx = T.tid; idx < 32 * 32; idx += NTHREADS) { const int i = idx >> 5, ee = idx & 31; const size_t m = (size_t)scan_row(b, dir, blk * 32 + i);
            vL[idx] = bf2f(P[m * NPROJ + 3072 + head * 128 + es * 32 + ee]); }
        if (T.tid < 32) { const size_t m = (size_t)scan_row(b, dir, blk * 32 + T.tid);
            gi[T.tid] = GT[m * 16 + (dir ? 8 : 0) + head]; const float f = GT[m * 16 + (dir ? 12 : 4) + head];
            gf[T.tid] = fminf(f, 0.f) - log1pf(__expf(-fabsf(f))); }
        __syncthreads();
#pragma unroll 1
        for (int half = 0; half < 2; ++half) {
#pragma unroll 2
            for (int ii = 0; ii < 16; ++ii) { const int i = half * 16 + ii; const float v = vL[i * 32 + e];
                const float it = gi[i], lf = gf[i]; const float mn = fmaxf(lf + mst, it); const float ca = __expf(lf + mst - mn), cbv = __expf(it - mn); mst = mn;
                float pn = 0.f, pd = 0.f;
#pragma unroll
                for (int j = 0; j < 4; ++j) { const int d = dg * 4 + j; const float kd = kL[i * 64 + d] * cbv, qd = qL[i * 64 + d]; C[j] = ca * C[j] + kd * v; n[j] = ca * n[j] + kd; pn += qd * C[j]; pd += qd * n[j]; }
                red[(ii * 16 + dg) * 32 + e] = pn; if (e == 0) rden[ii * 16 + dg] = pd; if (T.tid == 0) mv[ii] = mn; }
            __syncthreads();
            { const int ii = T.tid >> 5; float num = 0.f, den = 0.f;
#pragma unroll
                for (int g = 0; g < 16; ++g) { num += red[(ii * 16 + g) * 32 + e]; den += rden[ii * 16 + g]; }
                const int p = blk * 32 + half * 16 + ii;
                if (p >= NCTX) { const size_t m = (size_t)scan_row(b, dir, p); const float h = num / fmaxf(fabsf(den), __expf(-mv[ii])); O[m * DM + 512 + head * 128 + es * 32 + e] = (bf16)f2bf(h); } }
            __syncthreads();
        }
    }
}

typedef short bf16x8 __attribute__((ext_vector_type(8)));
typedef float f32x2 __attribute__((ext_vector_type(2)));
#define MFMA16(a, b, c) __builtin_amdgcn_mfma_f32_16x16x32_bf16((a), (b), (c), 0, 0, 0)
template <int KSTEPS>
__device__ __forceinline__ void mma_tile(f32x4& acc, const LAS unsigned char* A, int sa, const LAS unsigned char* B, int sb, int lane) {
    const LAS unsigned char* pa = A + (lane & 15) * sa + (lane >> 4) * 16; const LAS unsigned char* pb = B + (lane & 15) * sb + (lane >> 4) * 16;
#pragma unroll
    for (int ks = 0; ks < KSTEPS; ++ks) { const bf16x8 av = *(const LAS bf16x8*)(pa + ks * 64); const bf16x8 bv = *(const LAS bf16x8*)(pb + ks * 64); acc = MFMA16(av, bv, acc); }
}
typedef __bf16 bf16x2_t __attribute__((ext_vector_type(2)));
__device__ __forceinline__ unsigned cvtpk(float lo, float hi) { const f32x2 v = {lo, hi}; const bf16x2_t b = __builtin_convertvector(v, bf16x2_t); return __builtin_bit_cast(unsigned, b); }
struct BF2 { bf16x8 k0, k1; };
struct BF4 { bf16x8 k0, k1, k2, k3; };
__device__ __forceinline__ BF2 ldfrag2(const LAS unsigned char* B, int sb, int lane) { const LAS unsigned char* p = B + (lane & 15) * sb + (lane >> 4) * 16; BF2 f; f.k0 = *(const LAS bf16x8*)p; f.k1 = *(const LAS bf16x8*)(p + 64); return f; }
__device__ __forceinline__ BF4 ldfrag4(const LAS unsigned char* B, int sb, int lane) { const LAS unsigned char* p = B + (lane & 15) * sb + (lane >> 4) * 16; BF4 f; f.k0 = *(const LAS bf16x8*)p; f.k1 = *(const LAS bf16x8*)(p + 64); f.k2 = *(const LAS bf16x8*)(p + 128); f.k3 = *(const LAS bf16x8*)(p + 192); return f; }
__device__ __forceinline__ void mma2(f32x4& acc, const LAS unsigned char* A, int sa, const BF2& b, int lane) { const LAS unsigned char* p = A + (lane & 15) * sa + (lane >> 4) * 16;
    acc = MFMA16(*(const LAS bf16x8*)p, b.k0, acc); acc = MFMA16(*(const LAS bf16x8*)(p + 64), b.k1, acc); }
__device__ __forceinline__ void mma4(f32x4& acc, const LAS unsigned char* A, int sa, const BF4& b, int lane) { const LAS unsigned char* p = A + (lane & 15) * sa + (lane >> 4) * 16;
    acc = MFMA16(*(const LAS bf16x8*)p, b.k0, acc); acc = MFMA16(*(const LAS bf16x8*)(p + 64), b.k1, acc); acc = MFMA16(*(const LAS bf16x8*)(p + 128), b.k2, acc); acc = MFMA16(*(const LAS bf16x8*)(p + 192), b.k3, acc); }
__device__ __forceinline__ float ex2(float v) { return __builtin_amdgcn_exp2f(v); }
__device__ __forceinline__ float lg2(float v) { return __builtin_amdgcn_logf(v); }

constexpr int HS_ND = 272;
constexpr int HS_T = 160;
constexpr int HL_QD = 0, HL_KD = HL_QD + 64 * HS_ND, HL_X = HL_KD + 64 * HS_ND, HL_QE = HL_X + 64 * HS_ND;
constexpr int HL_KTT = HL_QE + 64 * HS_ND;
constexpr int HL_VT = HL_KTT + 128 * HS_T;
constexpr int HL_ST = HL_VT + 128 * HS_T;
constexpr int HL_P = HL_ST + 128 * HS_ND;
constexpr int HL_SEG = HL_P + 64 * HS_T;
constexpr int HL_FAC = HL_SEG + 4096;
constexpr int HL_NW = HL_FAC + 512;
constexpr int HL_END = HL_NW + 512;
constexpr int HL_OT = HL_QD, OT_S = 132 * 4;
static_assert(64 * OT_S <= 2 * 64 * HS_ND, "o tile overlay");
static_assert(HL_END <= 160 * 1024 - 1024, "HGRN2 LDS map");

constexpr size_t HG_SLOT_BYTES = 128 * 128 * 2;
__device__ __forceinline__ size_t hg_seq(int b, int dir, int head) { return (size_t)((b * 2 + dir) * 4 + head); }

__device__ __forceinline__ int sc_row(int b, int dir, int js, int lt) {
    if (js == 0) return MLAT + b * NCTX + (dir ? NCTX - 1 - lt : lt);
    const int q = 256 * (js - 1) + lt; return b * SEQ + (dir ? SEQ - 1 - q : q);
}

constexpr int P1_S = 544;
constexpr int P1_KTT = 0, P1_VT = P1_KTT + 128 * P1_S, P1_SEG = P1_VT + 128 * P1_S, P1_END = P1_SEG + 4096;
static_assert(P1_END <= 159 * 1024, "pass-1 LDS map");
__device__ __forceinline__ int p1_row(int b, int blk, int lt) { return blk < 0 ? MLAT + b * NCTX + lt : b * SEQ + 256 * blk + lt; }
template <int DIR>
__device__ __forceinline__ void hg_p1_dir(const Args& a, const Ctx& T, int b, int head, int blk, int slot, bool load_v) {
    const bf16* P = (const bf16*)(a.ws + WS_PROJ);
    LAS unsigned char* L = T.lds;
    const int w = T.wave, l = T.lane, g = l >> 4, c16 = l & 15;
    const int ch = head * 128 + 2 * l;
    const float* lbl = a.in[I_LBLOG];
    float lb[2];
#pragma unroll
    for (int x = 0; x < 2; ++x) lb[x] = sigmoidf_(lbl[DIR * 512 + ch + x] - lbl[(2 + DIR) * 512 + ch + x]);
    unsigned fw[32];
#pragma unroll
    for (int i = 0; i < 32; ++i) fw[i] = *(const unsigned*)(P + (size_t)p1_row(b, blk, 32 * w + i) * NPROJ + (DIR ? 2048 : 1536) + ch);
    if (load_v) {
        unsigned vw[32];
#pragma unroll
        for (int i = 0; i < 32; ++i) vw[i] = *(const unsigned*)(P + (size_t)p1_row(b, blk, 32 * w + i) * NPROJ + 512 + ch);
#pragma unroll
        for (int x = 0; x < 2; ++x)
#pragma unroll
            for (int q = 0; q < 4; ++q) { unsigned pv[4];
#pragma unroll
                for (int i = 0; i < 8; i += 2) { const unsigned v0 = x ? (vw[8 * q + i] >> 16) : (vw[8 * q + i] & 0xffffu), v1 = x ? (vw[8 * q + i + 1] >> 16) : (vw[8 * q + i + 1] & 0xffffu); pv[i >> 1] = v0 | (v1 << 16); }
                *(LAS v4u*)(L + P1_VT + (2 * l + x) * P1_S + 64 * w + 16 * q) = (v4u){pv[0], pv[1], pv[2], pv[3]}; }
    }
    float tot[2] = {0.f, 0.f};
#pragma unroll
    for (int i = 0; i < 32; ++i) {
        const float s0 = fast_sig(bflo(fw[i])), s1 = fast_sig(bfhi(fw[i]));
        tot[0] += lg2(lb[0] + (1.f - lb[0]) * s0); tot[1] += lg2(lb[1] + (1.f - lb[1]) * s1); }
    *(LAS f32x2*)(L + P1_SEG + (w * 128 + 2 * l) * 4) = (f32x2){tot[0], tot[1]};
    __syncthreads();
    float after[2] = {0.f, 0.f}, all[2] = {0.f, 0.f};
#pragma unroll
    for (int ww = 0; ww < 8; ++ww) { const f32x2 t2 = *(const LAS f32x2*)(L + P1_SEG + (ww * 128 + 2 * l) * 4); all[0] += t2.x; all[1] += t2.y;
        if (DIR ? (ww < w) : (ww > w)) { after[0] += t2.x; after[1] += t2.y; } }
#pragma unroll
    for (int x = 0; x < 2; ++x) {
        float run = after[x];
#pragma unroll
        for (int q = 0; q < 4; ++q) { float kv[8];
#pragma unroll
            for (int ii = 0; ii < 8; ++ii) { const int i = DIR ? 8 * q + ii : 31 - (8 * q + ii);
                const float fp = x ? bfhi(fw[i]) : bflo(fw[i]); const float sg = fast_sig(fp); const float f = lb[x] + (1.f - lb[x]) * sg;
                kv[ii] = (1.f - lb[x]) * (1.f - sg) * ex2(run); run += lg2(f); }
            if (DIR) *(LAS v4u*)(L + P1_KTT + (2 * l + x) * P1_S + 64 * w + 16 * q) = (v4u){cvtpk(kv[0], kv[1]), cvtpk(kv[2], kv[3]), cvtpk(kv[4], kv[5]), cvtpk(kv[6], kv[7])};
            else *(LAS v4u*)(L + P1_KTT + (2 * l + x) * P1_S + 64 * w + 16 * (3 - q)) = (v4u){cvtpk(kv[7], kv[6]), cvtpk(kv[5], kv[4]), cvtpk(kv[3], kv[2]), cvtpk(kv[1], kv[0])};
        }
    }
    __syncthreads();
    f32x4 accS[8];
#pragma unroll
    for (int m = 0; m < 8; ++m) accS[m] = (f32x4){0.f, 0.f, 0.f, 0.f};
#pragma unroll
    for (int kh = 0; kh < 4; ++kh) {
        const BF2 vf = ldfrag2(L + P1_VT + 16 * w * P1_S + 128 * kh, P1_S, l);
#pragma unroll
        for (int mh = 0; mh < 8; mh += 4) { BF2 kf[4];
#pragma unroll
            for (int m = 0; m < 4; ++m) kf[m] = ldfrag2(L + P1_KTT + 16 * (mh + m) * P1_S + 128 * kh, P1_S, l);
#pragma unroll
            for (int m = 0; m < 4; ++m) accS[mh + m] = MFMA16(kf[m].k0, vf.k0, accS[mh + m]);
#pragma unroll
            for (int m = 0; m < 4; ++m) accS[mh + m] = MFMA16(kf[m].k1, vf.k1, accS[mh + m]); } }
    const size_t sidx = hg_seq(b, DIR, head) * 16 + slot;
    bf16* ST = (bf16*)(a.ws + WS_HGST + sidx * HG_SLOT_BYTES);
#pragma unroll
    for (int m = 0; m < 8; ++m) { v2u o; o.x = cvtpk(accS[m][0], accS[m][1]); o.y = cvtpk(accS[m][2], accS[m][3]); *(v2u*)(ST + (size_t)(16 * w + c16) * 128 + 16 * m + 4 * g) = o; }
    if (w == 0) *(f32x2*)((float*)(a.ws + WS_HGG) + sidx * 128 + 2 * l) = (f32x2){ex2(all[0]), ex2(all[1])};
}
__device__ __forceinline__ void hg_pass1_items(const Args& a, const Ctx& T0, int first, int stride, int limit) {
#pragma unroll 1
    for (int item = first; item < limit; item += stride) {
        Ctx T = T0; asm volatile("" : "+v"(T.lane)); T.tid = T.wave * 64 + T.lane;
        const int k = item & 15, head = (item >> 4) & 3, b = item >> 6;
        const int blkF = k == 0 ? -1 : (k == 15 ? 0 : k), slotF = k == 0 ? 0 : (k == 15 ? 1 : k + 1);
        const int blkB = k == 0 ? -1 : (k == 15 ? 15 : k), slotB = k == 0 ? 0 : (k == 15 ? 1 : 16 - k);
        __syncthreads();
        hg_p1_dir<0>(a, T, b, head, blkF, slotF, true);
        __syncthreads();
        hg_p1_dir<1>(a, T, b, head, blkB, slotB, blkB != blkF);
    }
}

__device__ __forceinline__ void hg_pass2(const Args& a, const Ctx& T) {
    const int ntask = 32 * 2048;
    for (int task = T.vcu * NTHREADS + T.tid; task < ntask; task += T.G * NTHREADS) {
        const int seq = task >> 11, el = (task & 2047) * 8, d0 = el & 127;
        float r[8];
#pragma unroll
        for (int i = 0; i < 8; ++i) r[i] = 0.f;
        for (int j = 0; j < 16; ++j) {
            v4u* p = (v4u*)(a.ws + WS_HGST + ((size_t)seq * 16 + j) * HG_SLOT_BYTES + (size_t)el * 2);
            const float* G = (const float*)(a.ws + WS_HGG) + ((size_t)seq * 16 + j) * 128 + d0;
            const v4u dv = *p; const f32x4 g0 = *(const f32x4*)G, g1 = *(const f32x4*)(G + 4);
            r[0] = g0.x * r[0] + bflo(dv.x); r[1] = g0.y * r[1] + bfhi(dv.x); r[2] = g0.z * r[2] + bflo(dv.y); r[3] = g0.w * r[3] + bfhi(dv.y);
            r[4] = g1.x * r[4] + bflo(dv.z); r[5] = g1.y * r[5] + bfhi(dv.z); r[6] = g1.z * r[6] + bflo(dv.w); r[7] = g1.w * r[7] + bfhi(dv.w);
            *p = (v4u){pk2(r[0], r[1]), pk2(r[2], r[3]), pk2(r[4], r[5]), pk2(r[6], r[7])};
        }
    }
}

struct HgP3Pre { unsigned fw[8], qw[8], vw[8]; };
__device__ __forceinline__ void hg_p3_load(HgP3Pre& R, const bf16* P, int b, int head, int jt, int step, int w, int l) {
    const int dir = step >> 2, c = step & 3; const int ch = head * 128 + 2 * l;
#pragma unroll
    for (int i = 0; i < 8; ++i) { const int lt = 64 * c + 8 * w + i; const size_t row = (size_t)(b * SEQ + 256 * jt + (dir ? 255 - lt : lt));
        R.fw[i] = *(const unsigned*)(P + row * NPROJ + (dir ? 2048 : 1536) + ch); R.qw[i] = *(const unsigned*)(P + row * NPROJ + ch); R.vw[i] = *(const unsigned*)(P + row * NPROJ + 512 + ch); }
}
__device__ __forceinline__ void hg_pass3_item(const Args& a, const Ctx& T0, int item, bf16* OUT) {
    const int jt = item & 15, head = (item >> 4) & 3, b = item >> 6;
    const bf16* P = (const bf16*)(a.ws + WS_PROJ);
    Ctx T = T0; asm volatile("" : "+v"(T.lane));
    T.tid = T.wave * 64 + T.lane;
    LAS unsigned char* L = T.lds;
    const int w = T.wave, l = T.lane, g = l >> 4, c16 = l & 15;
    const int ch = head * 128 + 2 * l;
    const float* lbl = a.in[I_LBLOG];
    __syncthreads();
    for (int i = T.tid; i < 64 * HS_T / 16; i += NTHREADS) *(LAS v4u*)(L + HL_P + i * 16) = (v4u){0u, 0u, 0u, 0u};
    if (T.tid < 128) *(LAS float*)(L + HL_NW + T.tid * 4) = a.in[I_HGNW][head * 128 + T.tid];
    HgP3Pre R;
    hg_p3_load(R, P, b, head, jt, 0, w, l);
    v4u stq[4];
#define HG_STATE_LOAD(dir_) do { const bf16* STg_ = (const bf16*)(a.ws + WS_HGST + (hg_seq(b, (dir_), head) * 16 + ((dir_) ? 15 - jt : jt)) * HG_SLOT_BYTES); \
        _Pragma("unroll") for (int q_ = 0; q_ < 4; ++q_) { const int idx_ = l + 64 * q_; stq[q_] = *(const v4u*)(STg_ + (size_t)(16 * w + (idx_ >> 4)) * 128 + (idx_ & 15) * 8); } } while (0)
    HG_STATE_LOAD(0);
    f32x4 accS[8];
    float lb[2] = {0.f, 0.f};
    const int ot = T.tid >> 3, opart = T.tid & 7;
#pragma unroll 1
    for (int step = 0; step < 8; ++step) {
        const int dir = step >> 2, c = step & 3;
        PS_BEGIN();
        if (c == 0) {
#pragma unroll
            for (int x = 0; x < 2; ++x) lb[x] = sigmoidf_(lbl[dir * 512 + ch + x] - lbl[(2 + dir) * 512 + ch + x]);
            if (dir == 1) { HG_STATE_LOAD(1); VM_WAIT(); __syncthreads(); if (w == 0) { __builtin_amdgcn_fence(__ATOMIC_ACQUIRE, "agent"); VM_WAIT(); } __syncthreads(); }
#pragma unroll
            for (int q = 0; q < 4; ++q) { const int idx = l + 64 * q; *(LAS v4u*)(L + HL_ST + (16 * w + (idx >> 4)) * HS_ND + (idx & 15) * 16) = stq[q]; }
            LDS_WAIT();
#pragma unroll
            for (int m = 0; m < 8; ++m) { const v2u sv = *(const LAS v2u*)(L + HL_ST + (16 * w + c16) * HS_ND + (16 * m + 4 * g) * 2); accS[m] = (f32x4){bflo(sv.x), bfhi(sv.x), bflo(sv.y), bfhi(sv.y)}; }
        }
        PS_END(11);
        float kk[2][8], cl[2][8]; unsigned qw[8], vw[8];
#pragma unroll
        for (int i = 0; i < 8; ++i) { qw[i] = R.qw[i]; vw[i] = R.vw[i]; }
#pragma unroll
        for (int x = 0; x < 2; ++x) { float run = 0.f;
#pragma unroll
            for (int i = 0; i < 8; ++i) { const float fp = x ? bfhi(R.fw[i]) : bflo(R.fw[i]); const float sg = fast_sig(fp); const float f = lb[x] + (1.f - lb[x]) * sg;
                kk[x][i] = (1.f - lb[x]) * (1.f - sg); run += lg2(f); cl[x][i] = run; } }
        if (step < 7) hg_p3_load(R, P, b, head, jt, step + 1, w, l);
        *(LAS f32x2*)(L + HL_SEG + (w * 128 + 2 * l) * 4) = (f32x2){cl[0][7], cl[1][7]};
        PS_END(0); __syncthreads(); PS_END(1);
        const int half = w >> 2;
        float pre[2], mid[2], fx[2], fqe[2], fkt[2];
#pragma unroll
        for (int x = 0; x < 2; ++x) {
            float tt[8];
#pragma unroll
            for (int ww = 0; ww < 8; ++ww) tt[ww] = *(const LAS float*)(L + HL_SEG + (ww * 128 + 2 * l + x) * 4);
            const float r15 = tt[0] + tt[1], r31 = r15 + tt[2] + tt[3], r47 = r31 + tt[4] + tt[5], r63 = r47 + tt[6] + tt[7];
            float p = 0.f;
#pragma unroll
            for (int ww = 0; ww < 8; ++ww) if (ww < w) p += tt[ww];
            pre[x] = p; mid[x] = half ? r47 : r15;
            fx[x] = half ? ex2(r47 - r31) : ex2(r31 - r15); fqe[x] = ex2(mid[x]); fkt[x] = ex2(r63 - mid[x]);
            if (w == 0) *(LAS float*)(L + HL_FAC + (2 * l + x) * 4) = ex2(r63);
        }
        float ktv[2][8];
#pragma unroll
        for (int i = 0; i < 8; ++i) {
            float qd[2], kd[2], xv[2], qe[2];
#pragma unroll
            for (int x = 0; x < 2; ++x) { const float cc = pre[x] + cl[x][i] - mid[x]; const float eq = ex2(cc), ek = ex2(-cc); const float q = x ? bfhi(qw[i]) : bflo(qw[i]);
                qd[x] = q * eq; kd[x] = kk[x][i] * ek; xv[x] = (half ? qd[x] : kd[x]) * fx[x]; qe[x] = qd[x] * fqe[x]; ktv[x][i] = kd[x] * fkt[x]; }
            const int off = (8 * w + i) * HS_ND + 4 * l;
            *(LAS unsigned*)(L + HL_QD + off) = cvtpk(qd[0], qd[1]); *(LAS unsigned*)(L + HL_KD + off) = cvtpk(kd[0], kd[1]);
            *(LAS unsigned*)(L + HL_X + off) = cvtpk(xv[0], xv[1]); *(LAS unsigned*)(L + HL_QE + off) = cvtpk(qe[0], qe[1]);
        }
#pragma unroll
        for (int x = 0; x < 2; ++x) {
            unsigned pv[4];
#pragma unroll
            for (int i = 0; i < 8; i += 2) { const unsigned v0 = x ? (vw[i] >> 16) : (vw[i] & 0xffffu), v1 = x ? (vw[i + 1] >> 16) : (vw[i + 1] & 0xffffu); pv[i >> 1] = v0 | (v1 << 16); }
            *(LAS v4u*)(L + HL_KTT + (2 * l + x) * HS_T + 16 * w) = (v4u){cvtpk(ktv[x][0], ktv[x][1]), cvtpk(ktv[x][2], ktv[x][3]), cvtpk(ktv[x][4], ktv[x][5]), cvtpk(ktv[x][6], ktv[x][7])};
            *(LAS v4u*)(L + HL_VT + (2 * l + x) * HS_T + 16 * w) = (v4u){pv[0], pv[1], pv[2], pv[3]};
        }
        PS_END(0); __syncthreads(); PS_END(1);
        const size_t orow = (size_t)(b * SEQ + 256 * jt + (dir ? 255 - (64 * c + ot) : 64 * c + ot));
        bf16* optr = OUT + orow * DM + head * 128 + 16 * opart;
        v4u pf0 = (v4u){0u, 0u, 0u, 0u}, pf1 = pf0, pg0 = pf0, pg1 = pf0;
        if (dir) { pf0 = *(const v4u*)optr; pf1 = *(const v4u*)(optr + 8); const bf16* gp = P + orow * NPROJ + 1024 + head * 128 + 16 * opart; pg0 = *(const v4u*)gp; pg1 = *(const v4u*)(gp + 8); }
        v2u ptile[2]; int paddr[2] = {-1, -1};
#pragma unroll
        for (int rep = 0; rep < 2; ++rep) { const int tix = w + 8 * rep;
            if (tix < 10) {
                const int I = tix < 1 ? 0 : (tix < 3 ? 1 : (tix < 6 ? 2 : 3)); const int J = tix - (I * (I + 1)) / 2;
                const bool same = (I >> 1) == (J >> 1);
                const int abase = same ? HL_KD : HL_X, bbase = same ? HL_QD : HL_X;
                const BF4 af = ldfrag4(L + abase + 16 * J * HS_ND, HS_ND, l), bf = ldfrag4(L + bbase + 16 * I * HS_ND, HS_ND, l);
                f32x4 at = (f32x4){0.f, 0.f, 0.f, 0.f};
                at = MFMA16(af.k0, bf.k0, at); at = MFMA16(af.k1, bf.k1, at); at = MFMA16(af.k2, bf.k2, at); at = MFMA16(af.k3, bf.k3, at);
                const int tloc = 16 * I + c16, s0 = 16 * J + 4 * g;
                float pr[4];
#pragma unroll
                for (int r = 0; r < 4; ++r) pr[r] = (s0 + r <= tloc) ? at[r] : 0.f;
                ptile[rep].x = cvtpk(pr[0], pr[1]); ptile[rep].y = cvtpk(pr[2], pr[3]); paddr[rep] = HL_P + tloc * HS_T + s0 * 2;
            } }
        f32x4 accO[4];
        { const BF4 sf = ldfrag4(L + HL_ST + 16 * w * HS_ND, HS_ND, l);
#pragma unroll
            for (int I = 0; I < 4; ++I) accO[I] = (f32x4){0.f, 0.f, 0.f, 0.f};
#pragma unroll
            for (int ih = 0; ih < 4; ih += 2) {
                const BF4 q0 = ldfrag4(L + HL_QE + ih * 16 * HS_ND, HS_ND, l), q1 = ldfrag4(L + HL_QE + (ih + 1) * 16 * HS_ND, HS_ND, l);
                accO[ih] = MFMA16(q0.k0, sf.k0, accO[ih]); accO[ih + 1] = MFMA16(q1.k0, sf.k0, accO[ih + 1]);
                accO[ih] = MFMA16(q0.k1, sf.k1, accO[ih]); accO[ih + 1] = MFMA16(q1.k1, sf.k1, accO[ih + 1]);
                accO[ih] = MFMA16(q0.k2, sf.k2, accO[ih]); accO[ih + 1] = MFMA16(q1.k2, sf.k2, accO[ih + 1]);
                accO[ih] = MFMA16(q0.k3, sf.k3, accO[ih]); accO[ih + 1] = MFMA16(q1.k3, sf.k3, accO[ih + 1]); } }
        const BF2 vf = ldfrag2(L + HL_VT + 16 * w * HS_T, HS_T, l);
#pragma unroll
        for (int mh = 0; mh < 8; mh += 4) {
            BF2 kf[4]; f32x4 gv[4];
#pragma unroll
            for (int m = 0; m < 4; ++m) { kf[m] = ldfrag2(L + HL_KTT + 16 * (mh + m) * HS_T, HS_T, l); gv[m] = *(const LAS f32x4*)(L + HL_FAC + (16 * (mh + m) + 4 * g) * 4); }
#pragma unroll
            for (int m = 0; m < 4; ++m) accS[mh + m] = accS[mh + m] * gv[m];
#pragma unroll
            for (int m = 0; m < 4; ++m) accS[mh + m] = MFMA16(kf[m].k0, vf.k0, accS[mh + m]);
#pragma unroll
            for (int m = 0; m < 4; ++m) accS[mh + m] = MFMA16(kf[m].k1, vf.k1, accS[mh + m]);
        }
#pragma unroll
        for (int rep = 0; rep < 2; ++rep) if (paddr[rep] >= 0) *(LAS v2u*)(L + paddr[rep]) = ptile[rep];
        PS_END(2); __syncthreads(); PS_END(1);
        { const BF2 p0 = ldfrag2(L + HL_P + 0 * 16 * HS_T, HS_T, l), p1 = ldfrag2(L + HL_P + 1 * 16 * HS_T, HS_T, l), p2 = ldfrag2(L + HL_P + 2 * 16 * HS_T, HS_T, l), p3 = ldfrag2(L + HL_P + 3 * 16 * HS_T, HS_T, l);
            accO[0] = MFMA16(p0.k0, vf.k0, accO[0]); accO[1] = MFMA16(p1.k0, vf.k0, accO[1]); accO[2] = MFMA16(p2.k0, vf.k0, accO[2]); accO[3] = MFMA16(p3.k0, vf.k0, accO[3]);
            accO[0] = MFMA16(p0.k1, vf.k1, accO[0]); accO[1] = MFMA16(p1.k1, vf.k1, accO[1]); accO[2] = MFMA16(p2.k1, vf.k1, accO[2]); accO[3] = MFMA16(p3.k1, vf.k1, accO[3]); }
#pragma unroll
        for (int m = 0; m < 8; ++m) { v2u o; o.x = cvtpk(accS[m][0], accS[m][1]); o.y = cvtpk(accS[m][2], accS[m][3]); *(LAS v2u*)(L + HL_ST + (16 * w + c16) * HS_ND + (16 * m + 4 * g) * 2) = o; }
#pragma unroll
        for (int I = 0; I < 4; ++I)
#pragma unroll
            for (int r = 0; r < 4; ++r) *(LAS float*)(L + HL_OT + (16 * I + 4 * g + r) * OT_S + (16 * w + c16) * 4) = accO[I][r];
        PS_END(3); __syncthreads(); PS_END(1);
        { float ov[16];
#pragma unroll
            for (int q = 0; q < 4; ++q) { const f32x4 t4 = *(const LAS f32x4*)(L + HL_OT + ot * OT_S + (16 * opart + 4 * q) * 4); ov[4 * q] = t4.x; ov[4 * q + 1] = t4.y; ov[4 * q + 2] = t4.z; ov[4 * q + 3] = t4.w; }
            if (dir) {
                float fo[16], gt[16];
#pragma unroll
                for (int q = 0; q < 4; ++q) { fo[2 * q] = bflo(pf0[q]); fo[2 * q + 1] = bfhi(pf0[q]); fo[8 + 2 * q] = bflo(pf1[q]); fo[8 + 2 * q + 1] = bfhi(pf1[q]);
                    gt[2 * q] = bflo(pg0[q]); gt[2 * q + 1] = bfhi(pg0[q]); gt[8 + 2 * q] = bflo(pg1[q]); gt[8 + 2 * q + 1] = bfhi(pg1[q]); }
                float ss = 0.f;
#pragma unroll
                for (int i = 0; i < 16; ++i) { ov[i] += fo[i]; ss += ov[i] * ov[i]; }
                ss += __shfl_xor(ss, 1); ss += __shfl_xor(ss, 2); ss += __shfl_xor(ss, 4);
                const float rstd = __builtin_amdgcn_rsqf(ss * (1.f / 128.f) + EPSN);
#pragma unroll
                for (int q = 0; q < 4; ++q) { const f32x4 nw4 = *(const LAS f32x4*)(L + HL_NW + (16 * opart + 4 * q) * 4);
                    ov[4 * q] *= rstd * nw4.x * gt[4 * q]; ov[4 * q + 1] *= rstd * nw4.y * gt[4 * q + 1]; ov[4 * q + 2] *= rstd * nw4.z * gt[4 * q + 2]; ov[4 * q + 3] *= rstd * nw4.w * gt[4 * q + 3]; }
            }
            *(v4u*)optr = (v4u){cvtpk(ov[0], ov[1]), cvtpk(ov[2], ov[3]), cvtpk(ov[4], ov[5]), cvtpk(ov[6], ov[7])};
            *(v4u*)(optr + 8) = (v4u){cvtpk(ov[8], ov[9]), cvtpk(ov[10], ov[11]), cvtpk(ov[12], ov[13]), cvtpk(ov[14], ov[15])}; }
        PS_END(4);
    }
}

constexpr int MS = 160;
constexpr int ML_Q = 0, ML_K = ML_Q + 64 * MS, ML_KTT = ML_K + 64 * MS, ML_VT = ML_KTT + 64 * MS, ML_CT = ML_VT + 144 * MS, ML_P = ML_CT + 144 * MS;
constexpr int ML_TA = ML_P + 64 * MS;
constexpr int ML_TMU = ML_TA + 1024, ML_TIW = ML_TMU + 1024, ML_TSW = ML_TIW + 1024, ML_TEM = ML_TSW + 1024;
constexpr int ML_TRI = ML_TEM + 1024;
constexpr int ML_SC = ML_TRI + 256;
constexpr int ML_NW = ML_SC + 64;
constexpr int ML_OT = ML_NW + 512;
constexpr int ML_END = ML_OT + 64 * OT_S;
static_assert(ML_END <= 159 * 1024, "mLSTM LDS map");
constexpr size_t ML_SLOT_BYTES = 144 * 64 * 2;
constexpr float LOG2E = 1.4426950408889634f;

__device__ __forceinline__ float wave_incl_sum(float v, int lane) {
#pragma unroll
    for (int o = 1; o < 64; o <<= 1) { const float t = __shfl_up(v, o); if (lane >= o) v += t; }
    return v;
}
__device__ __forceinline__ float wave_incl_max(float v, int lane) {
#pragma unroll
    for (int o = 1; o < 64; o <<= 1) { const float t = __shfl_up(v, o); if (lane >= o) v = fmaxf(v, t); }
    return v;
}
template <bool WHOLE>
__device__ __forceinline__ float ml_scalars256(LAS unsigned char* L, const float (&ig)[4], const float (&fg)[4], float m_prev, float& bsum, int lane, int tb = 0) {
    f32x4 B, av, mu;
    { float run = 0.f;
#pragma unroll
        for (int i = 0; i < 4; ++i) { run += (fminf(fg[i], 0.f) - log1pf(__expf(-fabsf(fg[i])))) * LOG2E; B[i] = run; } }
    { const float incl = wave_incl_sum(B[3], lane); B = B + (incl - B[3]); }
#pragma unroll
    for (int i = 0; i < 4; ++i) av[i] = ig[i] * LOG2E - B[i];
    *(LAS f32x4*)(L + tb + ML_TA + lane * 16) = av;
    { float pm = av[0]; mu[0] = pm; pm = fmaxf(pm, av[1]); mu[1] = pm; pm = fmaxf(pm, av[2]); mu[2] = pm; pm = fmaxf(pm, av[3]); mu[3] = pm;
        const float inclm = wave_incl_max(pm, lane); float exm = __shfl_up(inclm, 1); if (lane == 0) exm = m_prev; exm = fmaxf(exm, m_prev);
#pragma unroll
        for (int i = 0; i < 4; ++i) mu[i] = fmaxf(mu[i], exm); }
    *(LAS f32x4*)(L + tb + ML_TMU + lane * 16) = mu;
    { f32x4 te;
#pragma unroll
        for (int i = 0; i < 4; ++i) te[i] = ex2(-(B[i] + mu[i]));
        *(LAS f32x4*)(L + tb + ML_TEM + lane * 16) = te; }
    const float b255 = __shfl(B[3], 63), mu255 = __shfl(mu[3], 63);
    const int c = lane >> 4;
    const float mu_end = WHOLE ? mu255 : __shfl(mu[3], 16 * c + 15); float mu_start = __shfl(mu[3], (16 * c + 63) & 63); if (c == 0) mu_start = m_prev;
    { f32x4 ti;
#pragma unroll
        for (int i = 0; i < 4; ++i) ti[i] = ex2(mu_start - mu[i]);
        *(LAS f32x4*)(L + tb + ML_TIW + lane * 16) = ti; }
    { f32x4 ts;
#pragma unroll
        for (int i = 0; i < 4; ++i) ts[i] = ex2(av[i] - mu_end);
        *(LAS f32x4*)(L + tb + ML_TSW + lane * 16) = ts; }
    if ((lane & 15) == 0) *(LAS float*)(L + tb + ML_SC + c * 4) = ex2(mu_start - mu_end);
    bsum = b255;
    return b255 + mu255;
}
__device__ __forceinline__ void ml_aug_rows(LAS unsigned char* L, int tid) {
    for (int i = tid; i < 16 * 8; i += NTHREADS) { const int r = i >> 3, q = i & 7; const unsigned v = r == 0 ? 0x3F803F80u : 0u; *(LAS v4u*)(L + ML_VT + (128 + r) * MS + q * 16) = (v4u){v, v, v, v}; }
}
struct MlPre { unsigned kw[8], vw[8]; v4u qn, kn; };
#define ML_LOAD_KV(R, ROWF) do { \
    if (T.tid < 256) { const int dp_ = T.tid & 31, tg_ = T.tid >> 5; _Pragma("unroll") for (int i = 0; i < 8; ++i) { const size_t row_ = (size_t)(ROWF(8 * tg_ + i)); (R).kw[i] = *(const unsigned*)(QK + row_ * 512 + 256 + head * 64 + 2 * dp_); } } \
    { const int ep_ = T.tid & 63, tg_ = T.tid >> 6; _Pragma("unroll") for (int i = 0; i < 8; ++i) { const size_t row_ = (size_t)(ROWF(8 * tg_ + i)); (R).vw[i] = *(const unsigned*)(P + row_ * NPROJ + 3072 + head * 128 + 2 * ep_); } } \
} while (0)
#define ML_STORE_KV(R, cch) do { \
    if (T.tid < 256) { const int dp_ = T.tid & 31, tg_ = T.tid >> 5; \
        const f32x4 s0_ = *(const LAS f32x4*)(L + ML_TSW + ((cch) * 64 + 8 * tg_) * 4), s1_ = *(const LAS f32x4*)(L + ML_TSW + ((cch) * 64 + 8 * tg_ + 4) * 4); \
        const float sw_[8] = {s0_.x, s0_.y, s0_.z, s0_.w, s1_.x, s1_.y, s1_.z, s1_.w}; \
        _Pragma("unroll") for (int x = 0; x < 2; ++x) { float kv_[8]; _Pragma("unroll") for (int i = 0; i < 8; ++i) kv_[i] = (x ? bfhi((R).kw[i]) : bflo((R).kw[i])) * sw_[i]; \
            *(LAS v4u*)(L + ML_KTT + (2 * dp_ + x) * MS + 16 * tg_) = (v4u){cvtpk(kv_[0], kv_[1]), cvtpk(kv_[2], kv_[3]), cvtpk(kv_[4], kv_[5]), cvtpk(kv_[6], kv_[7])}; } } \
    { const int ep_ = T.tid & 63, tg_ = T.tid >> 6; \
        _Pragma("unroll") for (int x = 0; x < 2; ++x) { unsigned pv_[4]; \
            _Pragma("unroll") for (int i = 0; i < 8; i += 2) { const unsigned v0_ = x ? ((R).vw[i] >> 16) : ((R).vw[i] & 0xffffu), v1_ = x ? ((R).vw[i + 1] >> 16) : ((R).vw[i + 1] & 0xffffu); pv_[i >> 1] = v0_ | (v1_ << 16); } \
            *(LAS v4u*)(L + ML_VT + (2 * ep_ + x) * MS + 16 * tg_) = (v4u){pv_[0], pv_[1], pv_[2], pv_[3]}; } } \
} while (0)

constexpr int Q1_KTT = 0, Q1_VT = Q1_KTT + 64 * P1_S, Q1_TAB = Q1_VT + 144 * P1_S;
constexpr int Q1_TB = Q1_TAB - ML_TA;
static_assert(ML_SC + Q1_TB + 64 <= 159 * 1024, "mLSTM pass-1 LDS map");
template <int DIR>
__device__ __forceinline__ void ml_p1_dir(const Args& a, const Ctx& T, int b, int head, int blk, int slot, const unsigned (&kw)[16], const float (&ig)[4], const float (&fg)[4]) {
    LAS unsigned char* L = T.lds;
    const int w = T.wave, l = T.lane, g = l >> 4, c16 = l & 15;
    float mloc = 0.f, bsum = 0.f;
    if (w == 0) mloc = ml_scalars256<true>(L, ig, fg, -1e30f, bsum, l, Q1_TB);
    __syncthreads();
    { const int dp = T.tid & 31, tg = T.tid >> 5;
        float sw[16];
#pragma unroll
        for (int q = 0; q < 4; ++q) { const int s0 = 16 * tg + 4 * q;
            const f32x4 t4 = *(const LAS f32x4*)(L + Q1_TB + ML_TSW + (DIR ? 252 - s0 : s0) * 4);
            sw[4 * q] = DIR ? t4.w : t4.x; sw[4 * q + 1] = DIR ? t4.z : t4.y; sw[4 * q + 2] = DIR ? t4.y : t4.z; sw[4 * q + 3] = DIR ? t4.x : t4.w; }
#pragma unroll
        for (int x = 0; x < 2; ++x)
#pragma unroll
            for (int q = 0; q < 2; ++q) { float kv[8];
#pragma unroll
                for (int i = 0; i < 8; ++i) kv[i] = (x ? bfhi(kw[8 * q + i]) : bflo(kw[8 * q + i])) * sw[8 * q + i];
                *(LAS v4u*)(L + Q1_KTT + (2 * dp + x) * P1_S + 32 * tg + 16 * q) = (v4u){cvtpk(kv[0], kv[1]), cvtpk(kv[2], kv[3]), cvtpk(kv[4], kv[5]), cvtpk(kv[6], kv[7])}; } }
    __syncthreads();
    f32x4 accC[4], accCA = (f32x4){0.f, 0.f, 0.f, 0.f};
#pragma unroll
    for (int m = 0; m < 4; ++m) accC[m] = (f32x4){0.f, 0.f, 0.f, 0.f};
#pragma unroll
    for (int kh = 0; kh < 4; ++kh) {
        const BF2 vf = ldfrag2(L + Q1_VT + 16 * w * P1_S + 128 * kh, P1_S, l);
        BF2 kf[4];
#pragma unroll
        for (int m = 0; m < 4; ++m) kf[m] = ldfrag2(L + Q1_KTT + 16 * m * P1_S + 128 * kh, P1_S, l);
#pragma unroll
        for (int m = 0; m < 4; ++m) accC[m] = MFMA16(kf[m].k0, vf.k0, accC[m]);
#pragma unroll
        for (int m = 0; m < 4; ++m) accC[m] = MFMA16(kf[m].k1, vf.k1, accC[m]);
        if (w < 4) { const BF2 af = ldfrag2(L + Q1_VT + 128 * P1_S + 128 * kh, P1_S, l); const BF2 kfw = ldfrag2(L + Q1_KTT + 16 * w * P1_S + 128 * kh, P1_S, l);
            accCA = MFMA16(kfw.k0, af.k0, accCA); accCA = MFMA16(kfw.k1, af.k1, accCA); } }
    const size_t sidx = hg_seq(b, DIR, head) * 16 + slot;
    bf16* CT = (bf16*)(a.ws + WS_MLST + sidx * ML_SLOT_BYTES);
#pragma unroll
    for (int m = 0; m < 4; ++m) { v2u o; o.x = cvtpk(accC[m][0], accC[m][1]); o.y = cvtpk(accC[m][2], accC[m][3]); *(v2u*)(CT + (size_t)(16 * w + c16) * 64 + 16 * m + 4 * g) = o; }
    if (w < 4) { v2u o; o.x = cvtpk(accCA[0], accCA[1]); o.y = cvtpk(accCA[2], accCA[3]); *(v2u*)(CT + (size_t)(128 + c16) * 64 + 16 * w + 4 * g) = o; }
    if (T.tid == 0) { float* sc = (float*)(a.ws + WS_MLSC) + sidx * 4; sc[0] = mloc; sc[1] = bsum; }
}
__device__ __forceinline__ void ml_pass1_items(const Args& a, const Ctx& T0, int first, int stride, int limit) {
    const bf16* P = (const bf16*)(a.ws + WS_PROJ); const bf16* QK = (const bf16*)(a.ws + WS_QK); const float* GT = (const float*)(a.ws + WS_GATES);
    __syncthreads();
    for (int i = T0.tid; i < 16 * 32; i += NTHREADS) { const int r = i >> 5, q = i & 31; const unsigned v = r == 0 ? 0x3F803F80u : 0u; *(LAS v4u*)(T0.lds + Q1_VT + (128 + r) * P1_S + q * 16) = (v4u){v, v, v, v}; }
#pragma unroll 1
    for (int item = first; item < limit; item += stride) {
        Ctx T = T0; asm volatile("" : "+v"(T.lane)); T.tid = T.wave * 64 + T.lane;
        LAS unsigned char* L = T.lds;
        const int w = T.wave, l = T.lane;
        const int k = item & 15, head = (item >> 4) & 3, b = item >> 6;
        const int blkF = k == 0 ? -1 : (k == 15 ? 0 : k), slotF = k == 0 ? 0 : (k == 15 ? 1 : k + 1);
        const int blkB = k == 0 ? -1 : (k == 15 ? 15 : k), slotB = k == 0 ? 0 : (k == 15 ? 1 : 16 - k);
#pragma unroll 1
        for (int dir = 0; dir < 2; ++dir) {
            const int blk = dir ? blkB : blkF;
            float ig[4] = {0.f, 0.f, 0.f, 0.f}, fg[4] = {0.f, 0.f, 0.f, 0.f};
            if (w == 0) {
#pragma unroll
                for (int c = 0; c < 4; ++c) { const int u = 4 * l + c; const size_t row = (size_t)p1_row(b, blk, dir ? 255 - u : u); ig[c] = GT[row * 16 + (dir ? 8 : 0) + head]; fg[c] = GT[row * 16 + (dir ? 12 : 4) + head]; } }
            unsigned kw[16];
            { const int dp = T.tid & 31, tg = T.tid >> 5;
#pragma unroll
                for (int i = 0; i < 16; ++i) kw[i] = *(const unsigned*)(QK + (size_t)p1_row(b, blk, 16 * tg + i) * 512 + 256 + head * 64 + 2 * dp); }
            __syncthreads();
            if (dir == 0 || blkB != blkF) {
                const int ep = T.tid & 63, tg = T.tid >> 6; unsigned vw[32];
#pragma unroll
                for (int i = 0; i < 32; ++i) vw[i] = *(const unsigned*)(P + (size_t)p1_row(b, blk, 32 * tg + i) * NPROJ + 3072 + head * 128 + 2 * ep);
#pragma unroll
                for (int x = 0; x < 2; ++x)
#pragma unroll
                    for (int q = 0; q < 4; ++q) { unsigned pv[4];
#pragma unroll
                        for (int i = 0; i < 8; i += 2) { const unsigned v0 = x ? (vw[8 * q + i] >> 16) : (vw[8 * q + i] & 0xffffu), v1 = x ? (vw[8 * q + i + 1] >> 16) : (vw[8 * q + i + 1] & 0xffffu); pv[i >> 1] = v0 | (v1 << 16); }
                        *(LAS v4u*)(L + Q1_VT + (2 * ep + x) * P1_S + 64 * tg + 16 * q) = (v4u){pv[0], pv[1], pv[2], pv[3]}; }
            }
            if (dir == 0) ml_p1_dir<0>(a, T, b, head, blk, slotF, kw, ig, fg); else ml_p1_dir<1>(a, T, b, head, blk, slotB, kw, ig, fg);
        }
    }
}

__device__ __forceinline__ void pass2_all(const Args& a, const Ctx& T) {
    const int gid = T.vcu * NTHREADS + T.tid;
    if (gid < 32 * 2048) {
        const int seq = gid >> 11, el = (gid & 2047) * 8, d0 = el & 127;
        float r[8];
#pragma unroll
        for (int i = 0; i < 8; ++i) r[i] = 0.f;
#pragma unroll 1
        for (int j0 = 0; j0 < 16; j0 += 4) {
            v4u dv[4]; f32x4 g0[4], g1[4];
#pragma unroll
            for (int jj = 0; jj < 4; ++jj) { const size_t sidx = (size_t)seq * 16 + j0 + jj; dv[jj] = *(const v4u*)(a.ws + WS_HGST + sidx * HG_SLOT_BYTES + (size_t)el * 2);
                const float* G = (const float*)(a.ws + WS_HGG) + sidx * 128 + d0; g0[jj] = *(const f32x4*)G; g1[jj] = *(const f32x4*)(G + 4); }
#pragma unroll
            for (int jj = 0; jj < 4; ++jj) { const size_t sidx = (size_t)seq * 16 + j0 + jj;
                r[0] = g0[jj].x * r[0] + bflo(dv[jj].x); r[1] = g0[jj].y * r[1] + bfhi(dv[jj].x); r[2] = g0[jj].z * r[2] + bflo(dv[jj].y); r[3] = g0[jj].w * r[3] + bfhi(dv[jj].y);
                r[4] = g1[jj].x * r[4] + bflo(dv[jj].z); r[5] = g1[jj].y * r[5] + bfhi(dv[jj].z); r[6] = g1[jj].z * r[6] + bflo(dv[jj].w); r[7] = g1[jj].w * r[7] + bfhi(dv[jj].w);
                *(v4u*)(a.ws + WS_HGST + sidx * HG_SLOT_BYTES + (size_t)el * 2) = (v4u){cvtpk(r[0], r[1]), cvtpk(r[2], r[3]), cvtpk(r[4], r[5]), cvtpk(r[6], r[7])}; }
        }
    } else if (gid < 32 * 2048 + 32 * 1152) {
        const int t2 = gid - 32 * 2048; const int seq = t2 / 1152, el = (t2 % 1152) * 8;
        float r[8], m = 0.f;
#pragma unroll
        for (int i = 0; i < 8; ++i) r[i] = 0.f;
#pragma unroll 1
        for (int j0 = 0; j0 < 16; j0 += 4) {
            v4u dv[4]; float ml[4], bt[4];
#pragma unroll
            for (int jj = 0; jj < 4; ++jj) { const size_t sidx = (size_t)seq * 16 + j0 + jj; dv[jj] = *(const v4u*)(a.ws + WS_MLST + sidx * ML_SLOT_BYTES + (size_t)el * 2);
                const float* sc = (const float*)(a.ws + WS_MLSC) + sidx * 4; ml[jj] = sc[0]; bt[jj] = sc[1]; }
#pragma unroll
            for (int jj = 0; jj < 4; ++jj) { const size_t sidx = (size_t)seq * 16 + j0 + jj;
                const float mn = fmaxf(bt[jj] + m, ml[jj]); const float cA = ex2(bt[jj] + m - mn), cB = ex2(ml[jj] - mn); m = mn;
                r[0] = cA * r[0] + cB * bflo(dv[jj].x); r[1] = cA * r[1] + cB * bfhi(dv[jj].x); r[2] = cA * r[2] + cB * bflo(dv[jj].y); r[3] = cA * r[3] + cB * bfhi(dv[jj].y);
                r[4] = cA * r[4] + cB * bflo(dv[jj].z); r[5] = cA * r[5] + cB * bfhi(dv[jj].z); r[6] = cA * r[6] + cB * bflo(dv[jj].w); r[7] = cA * r[7] + cB * bfhi(dv[jj].w);
                *(v4u*)(a.ws + WS_MLST + sidx * ML_SLOT_BYTES + (size_t)el * 2) = (v4u){cvtpk(r[0], r[1]), cvtpk(r[2], r[3]), cvtpk(r[4], r[5]), cvtpk(r[6], r[7])};
                if (el == 0) ((float*)(a.ws + WS_MLSC))[sidx * 4 + 2] = mn; }
        }
    }
}

__device__ __forceinline__ void ml_pass3_item(const Args& a, const Ctx& T0, int item, bf16* OUT) {
    const int jt = item & 15, head = (item >> 4) & 3, b = item >> 6;
    const bf16* P = (const bf16*)(a.ws + WS_PROJ); const bf16* QK = (const bf16*)(a.ws + WS_QK); const float* GT = (const float*)(a.ws + WS_GATES);
    Ctx T = T0; asm volatile("" : "+v"(T.lane));
    T.tid = T.wave * 64 + T.lane;
    LAS unsigned char* L = T.lds;
    const int w = T.wave, l = T.lane, g = l >> 4, c16 = l & 15;
    __syncthreads();
    for (int i = T.tid; i < 64 * MS / 16; i += NTHREADS) *(LAS v4u*)(L + ML_P + i * 16) = (v4u){0u, 0u, 0u, 0u};
    ml_aug_rows(L, T.tid);
    if (T.tid < 128) *(LAS float*)(L + ML_NW + T.tid * 4) = a.in[I_MLNW][head * 128 + T.tid];
#define ML_ROW3(st_, lt_) (b * SEQ + 256 * jt + (((st_) >> 2) ? 255 - (64 * ((st_) & 3) + (lt_)) : 64 * ((st_) & 3) + (lt_)))
    MlPre R;
    const int qt = T.tid >> 3, qpart = T.tid & 7;
#define ML_LOAD_ALL(st_) do { ML_LOAD_KV(R, ROWF_); const size_t rq_ = (size_t)ML_ROW3((st_), qt); R.qn = *(const v4u*)(QK + rq_ * 512 + head * 64 + qpart * 8); R.kn = *(const v4u*)(QK + rq_ * 512 + 256 + head * 64 + qpart * 8); } while (0)
#define ROWF_(x_) ML_ROW3(0, (x_))
    ML_LOAD_ALL(0);
#undef ROWF_
    f32x4 accC[4], accCA = (f32x4){0.f, 0.f, 0.f, 0.f};
    v4u stq[2], sta[2];
#define ML_STATE_LOAD(dir_) do { const size_t sidx_ = hg_seq(b, (dir_), head) * 16 + ((dir_) ? 15 - jt : jt); const bf16* CTg_ = (const bf16*)(a.ws + WS_MLST + sidx_ * ML_SLOT_BYTES); \
        _Pragma("unroll") for (int q_ = 0; q_ < 2; ++q_) { const int idx_ = l + 64 * q_; stq[q_] = *(const v4u*)(CTg_ + (size_t)(16 * w + (idx_ >> 3)) * 64 + (idx_ & 7) * 8); \
            if (w == 4) sta[q_] = *(const v4u*)(CTg_ + (size_t)(128 + (idx_ >> 3)) * 64 + (idx_ & 7) * 8); } } while (0)
    ML_STATE_LOAD(0);
#pragma unroll 1
    for (int step = 0; step < 8; ++step) {
        const int dir = step >> 2, c = step & 3;
        PS_BEGIN();
        if (c == 0) {
            const size_t sidx = hg_seq(b, dir, head) * 16 + (dir ? 15 - jt : jt);
            if (dir == 1) { ML_STATE_LOAD(1); VM_WAIT(); __syncthreads(); if (w == 0) { __builtin_amdgcn_fence(__ATOMIC_ACQUIRE, "agent"); VM_WAIT(); } }
            __syncthreads();
#pragma unroll
            for (int q = 0; q < 2; ++q) { const int idx = l + 64 * q; *(LAS v4u*)(L + ML_CT + (16 * w + (idx >> 3)) * MS + (idx & 7) * 16) = stq[q];
                if (w == 4) *(LAS v4u*)(L + ML_CT + (128 + (idx >> 3)) * MS + (idx & 7) * 16) = sta[q]; }
            if (w == 0) { float ig[4], fg[4];
#pragma unroll
                for (int cc = 0; cc < 4; ++cc) { const int lt = 4 * l + cc; const size_t row = (size_t)ML_ROW3(4 * dir + (lt >> 6), lt & 63); ig[cc] = GT[row * 16 + (dir ? 8 : 0) + head]; fg[cc] = GT[row * 16 + (dir ? 12 : 4) + head]; }
                float bsum = 0.f; const float m0 = ((const float*)(a.ws + WS_MLSC))[sidx * 4 + 2]; (void)ml_scalars256<false>(L, ig, fg, m0, bsum, l); }
            __syncthreads();
#pragma unroll
            for (int m = 0; m < 4; ++m) { const v2u sv = *(const LAS v2u*)(L + ML_CT + (16 * w + c16) * MS + (16 * m + 4 * g) * 2); accC[m] = (f32x4){bflo(sv.x), bfhi(sv.x), bflo(sv.y), bfhi(sv.y)}; }
            if (w < 4) { const v2u sv = *(const LAS v2u*)(L + ML_CT + (128 + c16) * MS + (16 * w + 4 * g) * 2); accCA = (f32x4){bflo(sv.x), bfhi(sv.x), bflo(sv.y), bfhi(sv.y)}; }
        }
        PS_END(5);
        *(LAS v4u*)(L + ML_Q + qt * MS + qpart * 16) = R.qn; *(LAS v4u*)(L + ML_K + qt * MS + qpart * 16) = R.kn;
        ML_STORE_KV(R, c);
        if (step < 7) {
#define ROWF_(x_) ML_ROW3(step + 1, (x_))
            ML_LOAD_ALL(step + 1);
#undef ROWF_
        }
        PS_END(6); __syncthreads(); PS_END(10);
        const size_t orow = (size_t)ML_ROW3(step, qt);
        bf16* optr = OUT + orow * DM + 512 + head * 128 + 16 * qpart;
        v2u ptile[2]; int paddr[2] = {-1, -1};
#pragma unroll 1
        for (int rep = 0; rep < 2; ++rep) { const int tix = w + 8 * rep;
            if (tix < 10) {
                const int I = tix < 1 ? 0 : (tix < 3 ? 1 : (tix < 6 ? 2 : 3)); const int J = tix - (I * (I + 1)) / 2;
                const BF2 af = ldfrag2(L + ML_K + 16 * J * MS, MS, l), bf = ldfrag2(L + ML_Q + 16 * I * MS, MS, l);
                const int tloc = 16 * I + c16, s0 = 16 * J + 4 * g;
                const f32x4 av = *(const LAS f32x4*)(L + ML_TA + (c * 64 + s0) * 4); const float mu = *(const LAS float*)(L + ML_TMU + (c * 64 + tloc) * 4);
                f32x4 at = (f32x4){0.f, 0.f, 0.f, 0.f};
                at = MFMA16(af.k0, bf.k0, at); at = MFMA16(af.k1, bf.k1, at);
                float pr[4];
#pragma unroll
                for (int r = 0; r < 4; ++r) pr[r] = (s0 + r <= tloc) ? at[r] * ex2(av[r] - mu) : 0.f;
                ptile[rep].x = cvtpk(pr[0], pr[1]); ptile[rep].y = cvtpk(pr[2], pr[3]); paddr[rep] = ML_P + tloc * MS + s0 * 2;
            } }
        f32x4 accO[4], accOA = (f32x4){0.f, 0.f, 0.f, 0.f};
        const float carry = *(const LAS float*)(L + ML_SC + c * 4);
        const BF2 vf = ldfrag2(L + ML_VT + 16 * w * MS, MS, l);
        { const BF2 cf = ldfrag2(L + ML_CT + 16 * w * MS, MS, l);
            const BF2 q0 = ldfrag2(L + ML_Q + 0 * 16 * MS, MS, l), q1 = ldfrag2(L + ML_Q + 1 * 16 * MS, MS, l), q2 = ldfrag2(L + ML_Q + 2 * 16 * MS, MS, l), q3 = ldfrag2(L + ML_Q + 3 * 16 * MS, MS, l);
#pragma unroll
            for (int I = 0; I < 4; ++I) accO[I] = (f32x4){0.f, 0.f, 0.f, 0.f};
            accO[0] = MFMA16(q0.k0, cf.k0, accO[0]); accO[1] = MFMA16(q1.k0, cf.k0, accO[1]); accO[2] = MFMA16(q2.k0, cf.k0, accO[2]); accO[3] = MFMA16(q3.k0, cf.k0, accO[3]);
            accO[0] = MFMA16(q0.k1, cf.k1, accO[0]); accO[1] = MFMA16(q1.k1, cf.k1, accO[1]); accO[2] = MFMA16(q2.k1, cf.k1, accO[2]); accO[3] = MFMA16(q3.k1, cf.k1, accO[3]); }
        { const BF2 k0f = ldfrag2(L + ML_KTT + 0 * 16 * MS, MS, l), k1f = ldfrag2(L + ML_KTT + 1 * 16 * MS, MS, l), k2f = ldfrag2(L + ML_KTT + 2 * 16 * MS, MS, l), k3f = ldfrag2(L + ML_KTT + 3 * 16 * MS, MS, l);
#pragma unroll
            for (int I = 0; I < 4; ++I) accC[I] = accC[I] * carry;
            accC[0] = MFMA16(k0f.k0, vf.k0, accC[0]); accC[1] = MFMA16(k1f.k0, vf.k0, accC[1]); accC[2] = MFMA16(k2f.k0, vf.k0, accC[2]); accC[3] = MFMA16(k3f.k0, vf.k0, accC[3]);
            accC[0] = MFMA16(k0f.k1, vf.k1, accC[0]); accC[1] = MFMA16(k1f.k1, vf.k1, accC[1]); accC[2] = MFMA16(k2f.k1, vf.k1, accC[2]); accC[3] = MFMA16(k3f.k1, vf.k1, accC[3]); }
#pragma unroll
        for (int I = 0; I < 4; ++I) { const f32x4 iw = *(const LAS f32x4*)(L + ML_TIW + (c * 64 + 16 * I + 4 * g) * 4); accO[I] = accO[I] * iw; }
        BF2 af = vf;
        if (w < 4) { const BF2 cfa = ldfrag2(L + ML_CT + 128 * MS, MS, l), qw_ = ldfrag2(L + ML_Q + 16 * w * MS, MS, l), kw_ = ldfrag2(L + ML_KTT + 16 * w * MS, MS, l);
            af = ldfrag2(L + ML_VT + 128 * MS, MS, l);
            const f32x4 iwa = *(const LAS f32x4*)(L + ML_TIW + (c * 64 + 16 * w + 4 * g) * 4);
            accCA = accCA * carry;
            accOA = MFMA16(qw_.k0, cfa.k0, accOA); accCA = MFMA16(kw_.k0, af.k0, accCA); accOA = MFMA16(qw_.k1, cfa.k1, accOA); accCA = MFMA16(kw_.k1, af.k1, accCA);
            accOA = accOA * iwa; }
#pragma unroll
        for (int rep = 0; rep < 2; ++rep) if (paddr[rep] >= 0) *(LAS v2u*)(L + paddr[rep]) = ptile[rep];
        v4u pf0 = (v4u){0u, 0u, 0u, 0u}, pf1 = pf0, pg0 = pf0, pg1 = pf0;
        if (dir) { pf0 = *(const v4u*)optr; pf1 = *(const v4u*)(optr + 8); const bf16* gp = P + orow * NPROJ + 3584 + head * 128 + 16 * qpart; pg0 = *(const v4u*)gp; pg1 = *(const v4u*)(gp + 8); }
        PS_END(7); __syncthreads(); PS_END(10);
        { const BF2 p0 = ldfrag2(L + ML_P + 0 * 16 * MS, MS, l), p1 = ldfrag2(L + ML_P + 1 * 16 * MS, MS, l), p2 = ldfrag2(L + ML_P + 2 * 16 * MS, MS, l), p3 = ldfrag2(L + ML_P + 3 * 16 * MS, MS, l);
            accO[0] = MFMA16(p0.k0, vf.k0, accO[0]); accO[1] = MFMA16(p1.k0, vf.k0, accO[1]); accO[2] = MFMA16(p2.k0, vf.k0, accO[2]); accO[3] = MFMA16(p3.k0, vf.k0, accO[3]);
            accO[0] = MFMA16(p0.k1, vf.k1, accO[0]); accO[1] = MFMA16(p1.k1, vf.k1, accO[1]); accO[2] = MFMA16(p2.k1, vf.k1, accO[2]); accO[3] = MFMA16(p3.k1, vf.k1, accO[3]);
            if (w < 4) { const BF2 pw_ = ldfrag2(L + ML_P + 16 * w * MS, MS, l); accOA = MFMA16(pw_.k0, af.k0, accOA); accOA = MFMA16(pw_.k1, af.k1, accOA); } }
#pragma unroll
        for (int m = 0; m < 4; ++m) { v2u o; o.x = cvtpk(accC[m][0], accC[m][1]); o.y = cvtpk(accC[m][2], accC[m][3]); *(LAS v2u*)(L + ML_CT + (16 * w + c16) * MS + (16 * m + 4 * g) * 2) = o; }
        if (w < 4) { v2u o; o.x = cvtpk(accCA[0], accCA[1]); o.y = cvtpk(accCA[2], accCA[3]); *(LAS v2u*)(L + ML_CT + (128 + c16) * MS + (16 * w + 4 * g) * 2) = o;
            if (c16 == 0) { const f32x4 em = *(const LAS f32x4*)(L + ML_TEM + (c * 64 + 16 * w + 4 * g) * 4); f32x4 ri;
#pragma unroll
                for (int r = 0; r < 4; ++r) ri[r] = __builtin_amdgcn_rcpf(fmaxf(fabsf(accOA[r]), em[r]));
                *(LAS f32x4*)(L + ML_TRI + (16 * w + 4 * g) * 4) = ri; } }
#pragma unroll
        for (int I = 0; I < 4; ++I)
#pragma unroll
            for (int r = 0; r < 4; ++r) *(LAS float*)(L + ML_OT + (16 * I + 4 * g + r) * OT_S + (16 * w + c16) * 4) = accO[I][r];
        PS_END(8); __syncthreads(); PS_END(10);
        { float ov[16]; const float ri = *(const LAS float*)(L + ML_TRI + qt * 4);
#pragma unroll
            for (int q = 0; q < 4; ++q) { const f32x4 t4 = *(const LAS f32x4*)(L + ML_OT + qt * OT_S + (16 * qpart + 4 * q) * 4); ov[4 * q] = t4.x * ri; ov[4 * q + 1] = t4.y * ri; ov[4 * q + 2] = t4.z * ri; ov[4 * q + 3] = t4.w * ri; }
            if (dir) {
                float fo[16], gt[16];
#pragma unroll
                for (int q = 0; q < 4; ++q) { fo[2 * q] = bflo(pf0[q]); fo[2 * q + 1] = bfhi(pf0[q]); fo[8 + 2 * q] = bflo(pf1[q]); fo[8 + 2 * q + 1] = bfhi(pf1[q]);
                    gt[2 * q] = bflo(pg0[q]); gt[2 * q + 1] = bfhi(pg0[q]); gt[8 + 2 * q] = bflo(pg1[q]); gt[8 + 2 * q + 1] = bfhi(pg1[q]); }
                float ss = 0.f;
#pragma unroll
                for (int i = 0; i < 16; ++i) { ov[i] += fo[i]; ss += ov[i] * ov[i]; }
                ss += __shfl_xor(ss, 1); ss += __shfl_xor(ss, 2); ss += __shfl_xor(ss, 4);
                const float rstd = __builtin_amdgcn_rsqf(ss * (1.f / 128.f) + EPSN);
#pragma unroll
                for (int q = 0; q < 4; ++q) { const f32x4 nw4 = *(const LAS f32x4*)(L + ML_NW + (16 * qpart + 4 * q) * 4);
                    ov[4 * q] *= rstd * nw4.x * gt[4 * q]; ov[4 * q + 1] *= rstd * nw4.y * gt[4 * q + 1]; ov[4 * q + 2] *= rstd * nw4.z * gt[4 * q + 2]; ov[4 * q + 3] *= rstd * nw4.w * gt[4 * q + 3]; }
            }
            *(v4u*)optr = (v4u){cvtpk(ov[0], ov[1]), cvtpk(ov[2], ov[3]), cvtpk(ov[4], ov[5]), cvtpk(ov[6], ov[7])};
            *(v4u*)(optr + 8) = (v4u){cvtpk(ov[8], ov[9]), cvtpk(ov[10], ov[11]), cvtpk(ov[12], ov[13]), cvtpk(ov[14], ov[15])}; }
        PS_END(9);
    }
#undef ML_ROW3
#undef ML_LOAD_ALL
#undef ML_STATE_LOAD
}
__device__ __forceinline__ void headnorm_phase(const Args& a, const Ctx& T, bool ml_only) {
    const bf16* P = (const bf16*)(a.ws + WS_PROJ); bf16* OF = (bf16*)(a.ws + WS_OF); const bf16* OB = (const bf16*)(a.ws + WS_OB);
    const int l = T.lane, head = l >> 3;
    const float* nw = head < 4 ? a.in[I_HGNW] + 16 * l : a.in[I_MLNW] + 16 * l - 512;
    const int gcol = head < 4 ? 1024 + 16 * l : 3584 + 16 * l - 512;
    float w[16];
#pragma unroll
    for (int j = 0; j < 16; ++j) w[j] = nw[j];
    for (int m = T.gw; m < MLAT; m += T.NGW) {
        const v4u f0 = *(const v4u*)(OF + (size_t)m * DM + 16 * l), f1 = *(const v4u*)(OF + (size_t)m * DM + 16 * l + 8);
        const v4u b0 = *(const v4u*)(OB + (size_t)m * DM + 16 * l), b1 = *(const v4u*)(OB + (size_t)m * DM + 16 * l + 8);
        const v4u g0 = *(const v4u*)(P + (size_t)m * NPROJ + gcol), g1 = *(const v4u*)(P + (size_t)m * NPROJ + gcol + 8);
        float o[16], g[16];
#pragma unroll
        for (int q = 0; q < 4; ++q) { o[2 * q] = bflo(f0[q]) + bflo(b0[q]); o[2 * q + 1] = bfhi(f0[q]) + bfhi(b0[q]); o[8 + 2 * q] = bflo(f1[q]) + bflo(b1[q]); o[8 + 2 * q + 1] = bfhi(f1[q]) + bfhi(b1[q]);
            g[2 * q] = bflo(g0[q]); g[2 * q + 1] = bfhi(g0[q]); g[8 + 2 * q] = bflo(g1[q]); g[8 + 2 * q + 1] = bfhi(g1[q]); }
        float ss = 0.f;
#pragma unroll
        for (int j = 0; j < 16; ++j) ss += o[j] * o[j];
        ss += __shfl_xor(ss, 1); ss += __shfl_xor(ss, 2); ss += __shfl_xor(ss, 4);
        const float r = 1.0f / sqrtf(ss * (1.f / 128.f) + EPSN);
#pragma unroll
        for (int j = 0; j < 16; ++j) o[j] = o[j] * r * w[j] * g[j];
        v4u o0, o1;
#pragma unroll
        for (int q = 0; q < 4; ++q) { o0[q] = pk2(o[2 * q], o[2 * q + 1]); o1[q] = pk2(o[8 + 2 * q], o[8 + 2 * q + 1]); }
        if (!(ml_only && head < 4)) { *(v4u*)(OF + (size_t)m * DM + 16 * l) = o0; *(v4u*)(OF + (size_t)m * DM + 16 * l + 8) = o1; }
    }
}

__device__ __forceinline__ void final_norm_phase(const Args& a, const Ctx& T, const bf16* X3) {
    f32x4 wv[4];
#pragma unroll
    for (int j = 0; j < 4; ++j) wv[j] = *((const f32x4*)a.in[I_FNW] + T.lane + 64 * j);
    f32x4 v[4];
    if (T.gw < MLAT) norm_load_row(v, X3, true, nullptr, T.gw, T.lane);
    for (int m = T.gw; m < MLAT; m += T.NGW) {
        f32x4 cur[4]; float s = 0.f;
#pragma unroll
        for (int j = 0; j < 4; ++j) { cur[j] = v[j]; s += (v[j].x * v[j].x + v[j].y * v[j].y) + (v[j].z * v[j].z + v[j].w * v[j].w); }
        { const int mn = m + T.NGW; if (mn < MLAT) norm_load_row(v, X3, true, nullptr, mn, T.lane); }
        const float rstd = __builtin_amdgcn_rsqf(wave_sum(s) * (1.f / DM) + EPSN);
        f32x4* xr = (f32x4*)(a.out + (size_t)m * DM) + T.lane;
#pragma unroll
        for (int j = 0; j < 4; ++j) xr[64 * j] = cur[j] * rstd * wv[j];
    }
}

__device__ __forceinline__ void gates_phase(const Args& a, const Ctx& T) {
    const bf16* XNc = (const bf16*)(a.ws + WS_XN); const bf16* WG = (const bf16*)(a.ws + WS_WG); float* GT = (float*)(a.ws + WS_GATES);
    const int l = T.lane, r = l & 15, g = l >> 4;
    const float bias = a.in[I_MLGB][r];
    for (int rg = T.gw; rg < MALL / 16; rg += T.NGW) {
        f32x4 acc = (f32x4){0.f, 0.f, 0.f, 0.f};
        const bf16* pa = XNc + (size_t)(16 * rg + r) * DM + 8 * g; const bf16* pb = WG + (size_t)r * DM + 8 * g;
#pragma unroll 8
        for (int ks = 0; ks < 32; ++ks) { const bf16x8 av = *(const bf16x8*)(pa + ks * 32); const bf16x8 bv = *(const bf16x8*)(pb + ks * 32); acc = MFMA16(av, bv, acc); }
#pragma unroll
        for (int q = 0; q < 4; ++q) GT[(size_t)(16 * rg + 4 * g + q) * 16 + r] = acc[q] + bias;
    }
}

__global__ void __launch_bounds__(NTHREADS, 2) fwd_kernel(Args a) {
    extern __shared__ __attribute__((aligned(16))) unsigned char lds_raw[];
    Ctx T;
    T.lds = (LAS unsigned char*)lds_raw;
    T.tid = threadIdx.x; T.lane = T.tid & 63; T.wave = __builtin_amdgcn_readfirstlane(T.tid >> 6);
    T.G = gridDim.x; { const int bx = blockIdx.x; T.vcu = (T.G % 8 == 0) ? (bx % 8) * (T.G / 8) + bx / 8 : bx; }
    T.gw = T.vcu * NWAVES + T.wave; T.NGW = T.G * NWAVES;
    volatile LAS unsigned* MISC = (volatile LAS unsigned*)(T.lds + MISC_OFF);
    for (int u = T.tid; u < (LDS_BYTES - LDSCTL_OFF) / 4; u += NTHREADS) ((LAS unsigned*)(T.lds + LDSCTL_OFF))[u] = 0u;
    __syncthreads();
    XcdBarrier bar; bar.bar = (unsigned*)(a.ws + WS_CTL) + CW_BAR; bar.x = 0; bar.st = nullptr;
    const bool multi = (a.ph_hi - a.ph_lo) > 1;
    if (multi) bar = xcd_barrier_post((unsigned*)(a.ws + WS_CTL) + CW_BAR, MISC + 8);
    const int lo = a.ph_lo, hi = a.ph_hi;
#ifndef REP_MASK
#define REP_MASK 0
#endif
#define IN(k) (lo <= (k) && (k) < hi)
#ifndef PROF_K
#define PROF_K -1
#endif
#define STAMP(k) do { if (PROF_K >= 0 && ((k) == PROF_K || (k) == PROF_K + 1) && blockIdx.x == 0 && T.tid == 0) { const unsigned long long t_ = __builtin_amdgcn_s_memrealtime(); MISC[16 + 2 * ((k) - PROF_K)] = (unsigned)t_; MISC[17 + 2 * ((k) - PROF_K)] = (unsigned)(t_ >> 32); } } while (0)
#define REPS(k) for (int rep_ = 0; rep_ < (((REP_MASK >> (k)) & 1) ? 2 : 1); ++rep_)
#if (REP_MASK >> 18) & 1
#define SEAM(k) do { if (IN(k) && IN((k) + 1)) { xcd_barrier(bar); xcd_barrier(bar); } } while (0)
#else
#define SEAM(k) do { if (IN(k) && IN((k) + 1)) xcd_barrier(bar); STAMP((k) + 1); } while (0)
#endif
    bf16* XN = (bf16*)(a.ws + WS_XN); bf16* HB = (bf16*)(a.ws + WS_PROJ); bf16* PROJ = (bf16*)(a.ws + WS_PROJ);
    const float* mods = (const float*)(a.ws + WS_MODS);
    bf16* XB1 = (bf16*)a.out; bf16* XB2 = (bf16*)a.out + (size_t)MLAT * DM; bf16* XB3 = (bf16*)(a.ws + WS_PROJ + 96 * MiB);
    const int bx = (int)blockIdx.x;

    STAMP(0);
    if (IN(0)) REPS(0) { mods_phase(a, T); convert_ffn(a, T, a.in[I_F1W1], a.in[I_F1W2]); convert_mix(a, T);
        if (T.tid < 64) { const int e = bx * 64 + T.tid; if (e < 16384) { const int q = e >> 10, k = e & 1023; ((bf16*)(a.ws + WS_WG))[q * 1024 + k] = (bf16)f2bf(a.in[I_WIN][(size_t)k * DIN + NPROJ + q]); } } }
    SEAM(0);
    if (IN(1)) norm_mod_rows<false, false>(a, T, a.in[I_X], a.in[I_CTX], MALL, a.in[I_N1W], 0, 1);
    SEAM(1);
    if (IN(2)) REPS(2) { pg8::Gemm g{XN, (const bf16*)(a.ws + WS_W1), MALL, 2 * DFF, DM, DM}; pg8::StaticOrder S; S.init(MALL, 2 * DFF, T.G, bx);
        pg8::EpiSwiglu E{HB, DFF}; pg8::gemm_phase<pg8::EpiSwiglu, pg8::StaticOrder, true, true>(T.lds, g, S, E); }
    SEAM(2);
    if (IN(3)) { pg8::Gemm g{HB, (const bf16*)(a.ws + WS_W2), MALL, DM, DFF, DFF}; pg8::DownOrder S; S.lat.init(MLAT, DM, T.G, bx); S.c = bx;
        pg8::EpiDown1 E{a.in[I_X], XB1, mods + 2 * 1024, 0.5f, (float*)(a.ws + WS_SLAB)}; pg8::gemm_phase<pg8::EpiDown1, pg8::DownOrder, true, true>(T.lds, g, S, E); }
    SEAM(3);
    if (IN(4)) REPS(4) { norm_mod_rows<true, true>(a, T, XB1, a.in[I_CTX], MALL, a.in[I_N2W], 3, 4); convert_ffn(a, T, a.in[I_F2W1], a.in[I_F2W2]); }
    SEAM(4);
    if (IN(5)) { pg8::Gemm g{XN, (const bf16*)(a.ws + WS_WIN), MALL, NPROJ, DM, DM}; pg8::ProjOrder S; S.lat.init(MLAT, NPROJ, T.G, bx); S.c = bx;
        pg8::EpiProjAll E{{PROJ, NPROJ}, (bf16*)(a.ws + WS_SLAB2)}; pg8::gemm_phase<pg8::EpiProjAll, pg8::ProjOrder, true, true>(T.lds, g, S, E); }
    SEAM(5);
    if (IN(6)) { gates_phase(a, T); ctx_combine(a, T); conv_phase(a, T); }
    SEAM(6);
    if (IN(7)) REPS(7) { hg_pass1_items(a, T, T.vcu, T.G, 256); ml_pass1_items(a, T, T.vcu, T.G, 256); }
    SEAM(7);
    if (IN(8)) pass2_all(a, T);
    SEAM(8);
    if (IN(9)) REPS(9) { for (int it = T.vcu; it < 256; it += T.G) hg_pass3_item(a, T, it, XN); for (int it = T.vcu; it < 256; it += T.G) ml_pass3_item(a, T, it, XN); }
    SEAM(9);
    if (IN(10)) { pg8::Gemm g{XN, (const bf16*)(a.ws + WS_WOUT), MLAT, DM, DM, DM}; pg8::StaticOrder S; S.init(MLAT, DM, T.G, bx);
        pg8::EpiResidB<true> E{XB1, XB2, mods + 5 * 1024, 1.0f}; pg8::gemm_phase<pg8::EpiResidB<true>, pg8::StaticOrder, true, true>(T.lds, g, S, E); }
    SEAM(10);
    if (IN(11)) REPS(11) norm_mod_rows<false, true>(a, T, XB2, nullptr, MLAT, a.in[I_N3W], 6, 7);
    SEAM(11);
    if (IN(12)) REPS(12) { pg8::Gemm g{XN, (const bf16*)(a.ws + WS_W1), MLAT, 2 * DFF, DM, DM}; pg8::StaticOrder S; S.init(MLAT, 2 * DFF, T.G, bx);
        pg8::EpiSwiglu E{HB, DFF}; pg8::gemm_phase<pg8::EpiSwiglu, pg8::StaticOrder, true, true>(T.lds, g, S, E); }
    SEAM(12);
    if (IN(13)) { pg8::Gemm g{HB, (const bf16*)(a.ws + WS_W2), MLAT, DM, DFF, DFF}; pg8::StaticOrder S; S.init(MLAT, DM, T.G, bx);
        pg8::EpiResidB<true> E{XB2, XB3, mods + 8 * 1024, 0.5f}; pg8::gemm_phase<pg8::EpiResidB<true>, pg8::StaticOrder, true, true>(T.lds, g, S, E); }
    SEAM(13);
    if (IN(14)) final_norm_phase(a, T, XB3);
    STAMP(15);
    if (PROF_S >= 0 && blockIdx.x == 0 && T.tid == 0) { const unsigned long long dt_ = ((((unsigned long long)MISC[23]) << 32) | MISC[22]) * 8ull, te_ = __builtin_amdgcn_s_memrealtime(); while (__builtin_amdgcn_s_memrealtime() - te_ < dt_) __builtin_amdgcn_s_sleep(8); }
    if (PROF_K >= 0 && blockIdx.x == 0 && T.tid == 0) { const unsigned long long t0_ = ((unsigned long long)MISC[17] << 32) | MISC[16], t1_ = ((unsigned long long)MISC[19] << 32) | MISC[18];
        const unsigned long long dt_ = (t1_ - t0_) * 8ull, te_ = __builtin_amdgcn_s_memrealtime(); while (__builtin_amdgcn_s_memrealtime() - te_ < dt_) __builtin_amdgcn_s_sleep(8); }
#undef IN
#undef SEAM
}

extern "C" void kernel_launch(void* const* d_in, const int* in_sizes, int n_in, void* d_out, int out_size, void* d_ws, size_t ws_size, hipStream_t stream) {
    static int grid = 0;
    if (grid == 0) {
        if (n_in != 22 || out_size != MLAT * DM || ws_size < WS_END) { fprintf(stderr, "kernel_launch: unexpected shapes (n_in %d out %d ws %zu)\n", n_in, out_size, ws_size); grid = -1; return; }
        int dev = 0, cus = 0;
        if (hipGetDevice(&dev) != hipSuccess || hipDeviceGetAttribute(&cus, hipDeviceAttributeMultiprocessorCount, dev) != hipSuccess) { grid = -1; return; }
        if (hipFuncSetAttribute((const void*)fwd_kernel, hipFuncAttributeMaxDynamicSharedMemorySize, LDS_BYTES) != hipSuccess) { fprintf(stderr, "kernel_launch: hipFuncSetAttribute failed\n"); grid = -1; return; }
        (void)hipGetLastError();
        grid = cus;
    }
    if (grid < 0) return;
    (void)hipMemsetAsync((char*)d_ws + WS_CTL, 0, CTL_ZERO_BYTES, stream);
    (void)hipMemsetAsync((char*)d_ws + WS_MODS, 0, 5 * NMODC * sizeof(float), stream);
    Args a{};
    for (int i = 0; i < 22; ++i) a.in[i] = (const float*)d_in[i];
    a.out = (float*)d_out; a.ws = (unsigned char*)d_ws;
#if ONE_LAUNCH
    a.ph_lo = 0; a.ph_hi = NPHASES;
    hipLaunchKernelGGL(fwd_kernel, dim3(grid), dim3(NTHREADS), LDS_BYTES, stream, a);
#else
    for (int p = 0; p < NPHASES; ++p) { a.ph_lo = p; a.ph_hi = p + 1; hipLaunchKernelGGL(fwd_kernel, dim3(grid), dim3(NTHREADS), LDS_BYTES, stream, a); }
#endif
}
```

```cpp
#include <hip/hip_runtime.h>
#include <cstdio>
#include <cstdint>
#ifndef PROF_S
#define PROF_S -1
#endif
#define PG8_PS_BEGIN() do { if (PROF_S == 20 && blockIdx.x == 0 && threadIdx.x == 0) { const unsigned long long t_ = __builtin_amdgcn_s_memrealtime(); volatile __attribute__((address_space(3))) unsigned* M_ = (volatile __attribute__((address_space(3))) unsigned*)(lds + 162816 + 320); M_[20] = (unsigned)t_; M_[21] = (unsigned)(t_ >> 32); } } while (0)
#define PG8_PS_END() do { if (PROF_S == 20 && blockIdx.x == 0 && threadIdx.x == 0) { const unsigned long long t_ = __builtin_amdgcn_s_memrealtime(); volatile __attribute__((address_space(3))) unsigned* M_ = (volatile __attribute__((address_space(3))) unsigned*)(lds + 162816 + 320); \
    const unsigned long long p_ = ((unsigned long long)M_[21] << 32) | M_[20]; const unsigned long long a_ = (((unsigned long long)M_[23] << 32) | M_[22]) + (t_ - p_); M_[22] = (unsigned)a_; M_[23] = (unsigned)(a_ >> 32); } } while (0)
namespace pg8 {
#define PG8_LAS __attribute__((address_space(3)))
typedef unsigned short bf16_t;
typedef short bf16x8 __attribute__((ext_vector_type(8)));
typedef float f32x4 __attribute__((ext_vector_type(4)));
typedef unsigned u32x4 __attribute__((ext_vector_type(4)));
constexpr int BM = 256, BK = 64, HALF = 128, HTB = HALF * BK * 2  , STAGE_BYTES = 8 * HTB, NXCD = 8, WGM = 8;

__host__ __device__ __forceinline__ int lds_byte(int r, int c) { const int st = (r >> 4) * 2 + (c >> 5), rr = r & 15, cc = c & 31, ob = rr * 64 + cc * 2; return st * 1024 + (ob ^ (((ob >> 9) & 1) << 5)); }
__host__ __device__ __forceinline__ void stage_rc(int b, int& R, int& C) { const int st = b / 1024, sb = b % 1024, swz = sb ^ (((sb >> 9) & 1) << 5); R = (st >> 1) * 16 + swz / 64; C = (st & 1) * 32 + (swz % 64) / 2; }
__host__ __device__ __forceinline__ int perm32(int rho) { const int n = rho >> 4, i = rho & 15; return 8 * (i >> 2) + 4 * n + (i & 3); }

struct Unit { int pm, pn, kofs, kt; };
struct Gemm { const bf16_t* A; const bf16_t* Bt; int M, N, K, ld; };

struct StaticOrder {
    int nM, nN, nwg, G, c;
    __host__ __device__ void init(int M, int N, int G_, int c_) { nM = M / BM; nN = N / BM; nwg = nM * nN; G = G_; c = c_; }
    __host__ __device__ bool next(int i, Unit& u) const {
        const long L = (long)i * G + c; if (L >= nwg) return false;
        int wgid = (int)L; { const int q = nwg / NXCD, r = nwg % NXCD, xcd = wgid % NXCD, off = wgid / NXCD; wgid = (xcd < r ? xcd * (q + 1) : r * (q + 1) + (xcd - r) * q) + off; }
        const int nig = WGM * nN, gid = wgid / nig, fm = gid * WGM, gsz = (nM - fm) < WGM ? (nM - fm) : WGM;
        u.pm = fm + ((wgid % nig) % gsz); u.pn = (wgid % nig) / gsz; u.kofs = 0; u.kt = 0; return true;
    }
    __device__ __forceinline__ void a_ready(const Unit&) const {}
    __device__ __forceinline__ void done(const Unit&) const {}
};
__device__ __forceinline__ unsigned cvt_pk_bf16(float lo, float hi) { unsigned r; asm volatile("v_cvt_pk_bf16_f32 %0, %1, %2" : "=v"(r) : "v"(lo), "v"(hi)); return r; }
typedef float f32x2 __attribute__((ext_vector_type(2)));
__device__ __forceinline__ float fast_sigmoid(float v) { return __builtin_amdgcn_rcpf(1.0f + __builtin_amdgcn_exp2f(-1.4426950408889634f * v)); }
__device__ __forceinline__ float fast_silu(float v) { return v * fast_sigmoid(v); }

struct EpiSwiglu {
    static constexpr bool PERM = true, AFTER_DRAIN = false;
    bf16_t* H; int ldh;
    __device__ __forceinline__ void operator()(const f32x4 (&acc)[2][2][4][2], const Unit& u, int wr, int wc, int fr, int fq) const {
        typedef float f2 __attribute__((ext_vector_type(2)));
        const int row0 = u.pm * BM + wr * 64 + fr, col0 = u.pn * HALF + wc * 32 + 8 * fq;
#pragma unroll
        for (int ai = 0; ai < 2; ++ai)
#pragma unroll
            for (int m = 0; m < 4; ++m) { bf16_t* rowp = H + (size_t)(row0 + ai * HALF + m * 16) * ldh + col0;
                unsigned wv[4];
#pragma unroll
                for (int n = 0; n < 2; ++n)
#pragma unroll
                    for (int h = 0; h < 2; ++h) {
                        const f2 g = {acc[ai][0][m][n][2 * h], acc[ai][0][m][n][2 * h + 1]}, uu = {acc[ai][1][m][n][2 * h], acc[ai][1][m][n][2 * h + 1]};
                        const f2 x = g * (-1.4426950408889634f);
                        f2 d; d.x = __builtin_amdgcn_exp2f(x.x); d.y = __builtin_amdgcn_exp2f(x.y); d = d + 1.0f;
                        f2 r; r.x = __builtin_amdgcn_rcpf(d.x); r.y = __builtin_amdgcn_rcpf(d.y);
                        const f2 o = (g * uu) * r;
                        wv[n * 2 + h] = cvt_pk_bf16(o.x, o.y); }
                u32x4 w; w.x = wv[0]; w.y = wv[1]; w.z = wv[2]; w.w = wv[3];
                *(u32x4*)rowp = w; }
    }
};

struct EpiResid {
    static constexpr bool PERM = false, AFTER_DRAIN = false;
    const float* base_lat; const float* base_ctx; float* out_lat; float* out_ctx; const float* gate; float coef;
    __device__ __forceinline__ void operator()(const f32x4 (&acc)[2][2][4][2], const Unit& u, int wr, int wc, int fr, int fq) const {
        const bool isctx = u.pm >= 64;
        const float* base = isctx ? base_ctx + (size_t)(u.pm - 64) * BM * 1024 : base_lat + (size_t)u.pm * BM * 1024;
        float* out = isctx ? out_ctx + (size_t)(u.pm - 64) * BM * 1024 : out_lat + (size_t)u.pm * BM * 1024;
        const float* g = gate + (size_t)(isctx ? 4 : (u.pm >> 4)) * 9216;
        const int col0 = u.pn * BM + wc * 32 + 4 * fq;
        f32x4 gv[2][2];
#pragma unroll
        for (int bj = 0; bj < 2; ++bj)
#pragma unroll
            for (int n = 0; n < 2; ++n) gv[bj][n] = *(const f32x4*)(g + col0 + bj * HALF + n * 16) * coef;
#pragma unroll
        for (int ai = 0; ai < 2; ++ai)
#pragma unroll
            for (int m = 0; m < 4; ++m) { const size_t off = (size_t)(ai * HALF + wr * 64 + m * 16 + fr) * 1024 + col0;
#pragma unroll
                for (int bj = 0; bj < 2; ++bj)
#pragma unroll
                    for (int n = 0; n < 2; ++n) { const f32x4 b = *(const f32x4*)(base + off + bj * HALF + n * 16);
                        *(f32x4*)(out + off + bj * HALF + n * 16) = b + gv[bj][n] * acc[ai][bj][m][n]; } }
    }
};

struct EpiProj {
    static constexpr bool PERM = true, AFTER_DRAIN = false;
    bf16_t* O; int ldc;
    __device__ __forceinline__ void operator()(const f32x4 (&acc)[2][2][4][2], const Unit& u, int wr, int wc, int fr, int fq) const {
        const int row0 = u.pm * BM + wr * 64 + fr, col0 = u.pn * BM + wc * 32 + 8 * fq;
        const int mode = (u.pn < 2) ? 1 : ((u.pn == 4 || u.pn == 5) ? 2 : (u.pn >= 14 ? 3 : 0));
#pragma unroll
        for (int ai = 0; ai < 2; ++ai)
#pragma unroll
            for (int m = 0; m < 4; ++m) { bf16_t* rowp = O + (size_t)(row0 + ai * HALF + m * 16) * ldc + col0;
#pragma unroll
                for (int bj = 0; bj < 2; ++bj) { float r[8];
#pragma unroll
                    for (int n = 0; n < 2; ++n)
#pragma unroll
                        for (int i = 0; i < 4; ++i) { const float v = acc[ai][bj][m][n][i];
                            r[n * 4 + i] = mode == 0 ? v : (mode == 1 ? fast_silu(v) * 0.08838834764831845f : (mode == 2 ? fast_silu(v) : fast_sigmoid(v))); }
                    u32x4 w; w.x = cvt_pk_bf16(r[0], r[1]); w.y = cvt_pk_bf16(r[2], r[3]); w.z = cvt_pk_bf16(r[4], r[5]); w.w = cvt_pk_bf16(r[6], r[7]);
                    *(u32x4*)(rowp + bj * HALF) = w; } }
    }
};

struct DownOrder {
    StaticOrder lat; int c;
    __device__ __forceinline__ bool next(int i, Unit& u) const {
        if (i == 0) return lat.next(0, u);
        if (i != 1 || c >= 176) return false;
        const int ks = c % 11, t = c / 11; u.pn = t & 3; u.pm = 64 + (t >> 2); u.kofs = ks * 256; u.kt = 4; return true; }
    __device__ __forceinline__ void a_ready(const Unit&) const {}
    __device__ __forceinline__ void done(const Unit&) const {}
};
struct EpiDown1 {
    static constexpr bool PERM = true, AFTER_DRAIN = false;
    const float* base; bf16_t* out; const float* gate; float coef; float* slab;
    __device__ __forceinline__ void operator()(const f32x4 (&acc)[2][2][4][2], const Unit& u, int wr, int wc, int fr, int fq) const {
        const int col0 = u.pn * BM + wc * 32 + 8 * fq;
        if (u.kt) {
            float* o = slab + ((size_t)(u.kofs >> 8) * 1024 + (size_t)(u.pm - 64) * BM) * 1024 + col0;
#pragma unroll
            for (int ai = 0; ai < 2; ++ai)
#pragma unroll
                for (int m = 0; m < 4; ++m) { float* rowp = o + (size_t)(ai * HALF + wr * 64 + m * 16 + fr) * 1024;
#pragma unroll
                    for (int bj = 0; bj < 2; ++bj) { *(f32x4*)(rowp + bj * HALF) = acc[ai][bj][m][0]; *(f32x4*)(rowp + bj * HALF + 4) = acc[ai][bj][m][1]; } }
            return;
        }
        const float* g = gate + (size_t)(u.pm >> 4) * 9216;
        f32x4 gv[2][2];
#pragma unroll
        for (int bj = 0; bj < 2; ++bj)
#pragma unroll
            for (int n = 0; n < 2; ++n) gv[bj][n] = *(const f32x4*)(g + col0 + bj * HALF + 4 * n) * coef;
#pragma unroll
        for (int ai = 0; ai < 2; ++ai)
#pragma unroll
            for (int m = 0; m < 4; ++m) { const size_t off = (size_t)(u.pm * BM + ai * HALF + wr * 64 + m * 16 + fr) * 1024 + col0;
#pragma unroll
                for (int bj = 0; bj < 2; ++bj) { const f32x4 b0 = *(const f32x4*)(base + off + bj * HALF), b1 = *(const f32x4*)(base + off + bj * HALF + 4);
                    const f32x4 v0 = b0 + gv[bj][0] * acc[ai][bj][m][0], v1 = b1 + gv[bj][1] * acc[ai][bj][m][1];
                    u32x4 w; w.x = cvt_pk_bf16(v0[0], v0[1]); w.y = cvt_pk_bf16(v0[2], v0[3]); w.z = cvt_pk_bf16(v1[0], v1[1]); w.w = cvt_pk_bf16(v1[2], v1[3]);
                    *(u32x4*)(out + off + bj * HALF) = w; } }
    }
};
struct ProjOrder {
    StaticOrder lat; int c;
    __device__ __forceinline__ bool next(int i, Unit& u) const {
        if (i < 4) return lat.next(i, u);
        if (i != 4 || c >= 144) return false;
        const int ks = c & 3, t = c >> 2, t9 = t % 9;
        u.pm = 64 + t / 9; u.pn = t9 < 2 ? 2 + t9 : (t9 < 6 ? 4 + t9 : 5 + t9); u.kofs = ks * 256; u.kt = 4; return true; }
    __device__ __forceinline__ void a_ready(const Unit&) const {}
    __device__ __forceinline__ void done(const Unit&) const {}
};
struct EpiProjAll {
    static constexpr bool PERM = true, AFTER_DRAIN = false;
    EpiProj lat; bf16_t* slab;
    __device__ __forceinline__ void operator()(const f32x4 (&acc)[2][2][4][2], const Unit& u, int wr, int wc, int fr, int fq) const {
        if (!u.kt) { lat(acc, u, wr, wc, fr, fq); return; }
        const int t9 = u.pn < 4 ? u.pn - 2 : (u.pn < 10 ? u.pn - 4 : u.pn - 5);
        bf16_t* out = slab + ((size_t)(u.kofs >> 8) * 1024 + (size_t)(u.pm - 64) * BM) * 2304 + t9 * 256 + wc * 32 + 8 * fq;
#pragma unroll
        for (int ai = 0; ai < 2; ++ai)
#pragma unroll
            for (int m = 0; m < 4; ++m) { bf16_t* rowp = out + (size_t)(ai * HALF + wr * 64 + m * 16 + fr) * 2304;
#pragma unroll
                for (int bj = 0; bj < 2; ++bj) { const f32x4 v0 = acc[ai][bj][m][0], v1 = acc[ai][bj][m][1];
                    u32x4 w; w.x = cvt_pk_bf16(v0[0], v0[1]); w.y = cvt_pk_bf16(v0[2], v0[3]); w.z = cvt_pk_bf16(v1[0], v1[1]); w.w = cvt_pk_bf16(v1[2], v1[3]);
                    *(u32x4*)(rowp + bj * HALF) = w; } }
    }
};

template <bool BASE_BF16>
struct EpiResidB {
    static constexpr bool PERM = true, AFTER_DRAIN = false;
    const void* base; bf16_t* out; const float* gate; float coef;
    __device__ __forceinline__ void operator()(const f32x4 (&acc)[2][2][4][2], const Unit& u, int wr, int wc, int fr, int fq) const {
        const float* g = gate + (size_t)(u.pm >> 4) * 9216;
        const int col0 = u.pn * BM + wc * 32 + 8 * fq;
        f32x4 gv[2][2];
#pragma unroll
        for (int bj = 0; bj < 2; ++bj)
#pragma unroll
            for (int n = 0; n < 2; ++n) gv[bj][n] = *(const f32x4*)(g + col0 + bj * HALF + 4 * n) * coef;
#pragma unroll
        for (int ai = 0; ai < 2; ++ai)
#pragma unroll
            for (int m = 0; m < 4; ++m) { const size_t off = (size_t)(u.pm * BM + ai * HALF + wr * 64 + m * 16 + fr) * 1024 + col0;
#pragma unroll
                for (int bj = 0; bj < 2; ++bj) { f32x4 b0, b1;
                    if (BASE_BF16) { const u32x4 bw = *(const u32x4*)((const bf16_t*)base + off + bj * HALF);
                        b0 = (f32x4){__builtin_bit_cast(float, bw.x << 16), __builtin_bit_cast(float, bw.x & 0xffff0000u), __builtin_bit_cast(float, bw.y << 16), __builtin_bit_cast(float, bw.y & 0xffff0000u)};
                        b1 = (f32x4){__builtin_bit_cast(float, bw.z << 16), __builtin_bit_cast(float, bw.z & 0xffff0000u), __builtin_bit_cast(float, bw.w << 16), __builtin_bit_cast(float, bw.w & 0xffff0000u)}; }
                    else { b0 = *(const f32x4*)((const float*)base + off + bj * HALF); b1 = *(const f32x4*)((const float*)base + off + bj * HALF + 4); }
                    const f32x4 v0 = b0 + gv[bj][0] * acc[ai][bj][m][0], v1 = b1 + gv[bj][1] * acc[ai][bj][m][1];
                    u32x4 w; w.x = cvt_pk_bf16(v0[0], v0[1]); w.y = cvt_pk_bf16(v0[2], v0[3]); w.z = cvt_pk_bf16(v1[0], v1[1]); w.w = cvt_pk_bf16(v1[2], v1[3]);
                    *(u32x4*)(out + off + bj * HALF) = w; } }
    }
};

template <class Epi, class Sched, bool ALIGN_EPI = false, bool SP2 = false>
__device__ __forceinline__ void gemm_phase(PG8_LAS unsigned char* lds, const Gemm g, const Sched& S, const Epi& E) {
    const int tid = threadIdx.x, wid = __builtin_amdgcn_readfirstlane(tid >> 6), lane = tid & 63, wr = wid >> 2, wc = wid & 3, fr = lane & 15, fq = lane >> 4;
    const int K = g.K, nt = K / BK, LD = g.ld;
    unsigned voffA[2], voffB[2];
#pragma unroll
    for (int i = 0; i < 2; ++i) { int R, C; stage_rc(tid * 16 + i * 8192, R, C); const int Rb = Epi::PERM ? ((R & ~31) + perm32(R & 31)) : R;
        voffA[i] = (unsigned)(R * LD + C) * 2u; voffB[i] = (unsigned)(Rb * LD + C) * 2u; }
    const size_t kstep = (size_t)(BK * 2);
    const size_t hstep = (size_t)HALF * LD * 2;
    const size_t tstep = 2 * hstep;
    const unsigned ldsw = (unsigned)wid * 1024u;
    const int aoff = lds_byte(wr * 64 + fr, fq * 8), boff = lds_byte(wc * 32 + fr, fq * 8);
#define PG8_SA(b, h) (((b) * 2 + (h)) * HTB)
#define PG8_SB(b, h) ((4 + (b) * 2 + (h)) * HTB)
#define PG8_STAGE(bufoff, gbase, voff) do { _Pragma("unroll") for (int _i = 0; _i < 2; ++_i) \
        __builtin_amdgcn_global_load_lds((const unsigned*)((const char*)(gbase) + (voff)[_i]), (PG8_LAS unsigned*)(lds + (bufoff) + ldsw + _i * 8192), 16, 0, 0); } while (0)
#define PG8_LDA(dst, b, h) do { _Pragma("unroll") for (int m = 0; m < 4; ++m) _Pragma("unroll") for (int k = 0; k < 2; ++k) dst[m][k] = *(const PG8_LAS bf16x8*)(lds + PG8_SA(b, h) + aoff + m * 2048 + k * 1024); } while (0)
#define PG8_LDB(dst, b, h) do { _Pragma("unroll") for (int n = 0; n < 2; ++n) _Pragma("unroll") for (int k = 0; k < 2; ++k) dst[n][k] = *(const PG8_LAS bf16x8*)(lds + PG8_SB(b, h) + boff + n * 2048 + k * 1024); } while (0)
#define PG8_MMA(ai, bj, At, Bt) do { __builtin_amdgcn_s_setprio(1); _Pragma("unroll") for (int m = 0; m < 4; ++m) _Pragma("unroll") for (int n = 0; n < 2; ++n) _Pragma("unroll") for (int k = 0; k < 2; ++k) \
        acc[ai][bj][m][n] = __builtin_amdgcn_mfma_f32_16x16x32_bf16(Bt[n][k], At[m][k], acc[ai][bj][m][n], 0, 0, 0); __builtin_amdgcn_s_setprio(0); } while (0)
#define PG8_WAIT_V(n) asm volatile("s_waitcnt vmcnt(" #n ")" ::: "memory")
#define PG8_WAIT_L(n) asm volatile("s_waitcnt lgkmcnt(" #n ")" ::: "memory")
#define PG8_BAR __builtin_amdgcn_s_barrier()
#define PG8_SCHED __builtin_amdgcn_sched_barrier(0)
    Unit cur, nxt; int ui = 0;
    if (!S.next(0, cur)) return;
    f32x4 acc[2][2][4][2];
#pragma unroll
    for (int a = 0; a < 2; ++a)
#pragma unroll
        for (int b = 0; b < 2; ++b)
#pragma unroll
            for (int m = 0; m < 4; ++m)
#pragma unroll
                for (int n = 0; n < 2; ++n) acc[a][b][m][n] = (f32x4){0.f, 0.f, 0.f, 0.f};
    bf16x8 At[4][2], B0[2][2], B1[2][2];
    const char* cA = (const char*)g.A + (size_t)cur.pm * tstep + (size_t)cur.kofs * 2; const char* cB = (const char*)g.Bt + (size_t)cur.pn * tstep + (size_t)cur.kofs * 2;
    S.a_ready(cur);
    if constexpr (SP2) {
        PG8_STAGE(PG8_SB(0, 0), cB, voffB); PG8_STAGE(PG8_SB(0, 1), cB + hstep, voffB); PG8_STAGE(PG8_SA(0, 0), cA, voffA); PG8_STAGE(PG8_SA(0, 1), cA + hstep, voffA);
        if (wr == 1) PG8_BAR;
        PG8_WAIT_V(2); PG8_BAR;
        PG8_STAGE(PG8_SB(1, 0), cB + kstep, voffB); PG8_STAGE(PG8_SA(1, 0), cA + kstep, voffA); PG8_STAGE(PG8_SB(1, 1), cB + hstep + kstep, voffB);
        PG8_WAIT_V(6); PG8_BAR;
    } else {
        PG8_STAGE(PG8_SB(0, 0), cB, voffB); PG8_STAGE(PG8_SA(0, 0), cA, voffA); PG8_STAGE(PG8_SB(0, 1), cB + hstep, voffB); PG8_STAGE(PG8_SA(0, 1), cA + hstep, voffA);
        if (wr == 1) PG8_BAR;
        PG8_WAIT_V(4); PG8_BAR;
        PG8_STAGE(PG8_SB(1, 0), cB + kstep, voffB); PG8_STAGE(PG8_SA(1, 0), cA + kstep, voffA); PG8_STAGE(PG8_SB(1, 1), cB + hstep + kstep, voffB);
        PG8_WAIT_V(6); PG8_BAR;
    }
    for (;;) {
        const bool has_next = S.next(ui + 1, nxt);
        const char* nA = has_next ? (const char*)g.A + (size_t)nxt.pm * tstep + (size_t)nxt.kofs * 2 : cA; const char* nB = has_next ? (const char*)g.Bt + (size_t)nxt.pn * tstep + (size_t)nxt.kofs * 2 : cB;
        const int ntu = cur.kt ? cur.kt : nt;
        for (int t = 0; t < ntu; t += 2) {
            const bool last = (t == ntu - 2);
            const char* a1 = cA + (size_t)(t + 1) * kstep;
            const char* a2 = last ? nA : cA + (size_t)(t + 2) * kstep; const char* b2 = last ? nB : cB + (size_t)(t + 2) * kstep;
            const char* a3 = a2 + kstep; const char* b3 = b2 + kstep;
            if (last && has_next) S.a_ready(nxt);
            if constexpr (SP2) {
            PG8_LDB(B0, 0, 0); PG8_LDB(B1, 0, 1); PG8_SCHED; PG8_LDA(At, 0, 0); PG8_STAGE(PG8_SA(1, 1), a1 + hstep, voffA);
            PG8_WAIT_V(8); PG8_WAIT_L(0); PG8_BAR; PG8_MMA(0, 0, At, B0); PG8_MMA(0, 1, At, B1); PG8_BAR; PG8_SCHED;
            PG8_LDA(At, 0, 1); PG8_STAGE(PG8_SB(0, 0), b2, voffB); PG8_STAGE(PG8_SB(0, 1), b2 + hstep, voffB); PG8_STAGE(PG8_SA(0, 0), a2, voffA);
            PG8_WAIT_V(8); PG8_WAIT_L(0); PG8_BAR; PG8_MMA(1, 0, At, B0); PG8_MMA(1, 1, At, B1); PG8_BAR; PG8_SCHED;
            PG8_LDB(B0, 1, 0); PG8_LDB(B1, 1, 1); PG8_SCHED; PG8_LDA(At, 1, 0); PG8_STAGE(PG8_SA(0, 1), a2 + hstep, voffA);
            PG8_WAIT_V(8); PG8_WAIT_L(0); PG8_BAR; PG8_MMA(0, 0, At, B0); PG8_MMA(0, 1, At, B1); PG8_BAR; PG8_SCHED;
            PG8_LDA(At, 1, 1); PG8_STAGE(PG8_SB(1, 0), b3, voffB); PG8_STAGE(PG8_SB(1, 1), b3 + hstep, voffB); PG8_STAGE(PG8_SA(1, 0), a3, voffA);
            PG8_WAIT_V(8); PG8_WAIT_L(0); PG8_BAR; PG8_MMA(1, 0, At, B0); PG8_MMA(1, 1, At, B1); PG8_BAR; PG8_SCHED;
            } else {
            PG8_LDB(B0, 0, 0); PG8_SCHED; PG8_LDA(At, 0, 0); PG8_STAGE(PG8_SA(1, 1), a1 + hstep, voffA);
            PG8_WAIT_L(8); PG8_BAR; PG8_WAIT_L(0); PG8_MMA(0, 0, At, B0); PG8_BAR; PG8_SCHED;
            PG8_LDB(B1, 0, 1); PG8_STAGE(PG8_SB(0, 0), b2, voffB);
            PG8_BAR; PG8_WAIT_L(0); PG8_MMA(0, 1, At, B1); PG8_BAR;
            PG8_LDA(At, 0, 1); PG8_STAGE(PG8_SA(0, 0), a2, voffA);
            PG8_BAR; PG8_WAIT_L(0); PG8_MMA(1, 0, At, B0); PG8_BAR; PG8_SCHED;
            PG8_STAGE(PG8_SB(0, 1), b2 + hstep, voffB);
            PG8_WAIT_V(6); PG8_BAR; PG8_MMA(1, 1, At, B1); PG8_BAR;
            PG8_LDB(B0, 1, 0); PG8_SCHED; PG8_LDA(At, 1, 0); PG8_STAGE(PG8_SA(0, 1), a2 + hstep, voffA);
            PG8_WAIT_L(8); PG8_BAR; PG8_WAIT_L(0); PG8_MMA(0, 0, At, B0); PG8_BAR; PG8_SCHED;
            PG8_LDB(B1, 1, 1); PG8_STAGE(PG8_SB(1, 0), b3, voffB);
            PG8_BAR; PG8_WAIT_L(0); PG8_MMA(0, 1, At, B1); PG8_BAR;
            PG8_LDA(At, 1, 1); PG8_STAGE(PG8_SA(1, 0), a3, voffA);
            PG8_BAR; PG8_WAIT_L(0); PG8_MMA(1, 0, At, B0); PG8_BAR; PG8_SCHED;
            PG8_STAGE(PG8_SB(1, 1), b3 + hstep, voffB);
            PG8_WAIT_V(6); PG8_BAR; PG8_MMA(1, 1, At, B1); PG8_BAR;
            }
        }
        if constexpr (ALIGN_EPI) { if (wr == 0) PG8_BAR; }
        if constexpr (!Epi::AFTER_DRAIN) { PG8_PS_BEGIN(); E(acc, cur, wr, wc, fr, fq); S.done(cur); PG8_PS_END(); }
        if (!has_next) break;
#pragma unroll
        for (int a = 0; a < 2; ++a)
#pragma unroll
            for (int b = 0; b < 2; ++b)
#pragma unroll
                for (int m = 0; m < 4; ++m)
#pragma unroll
                    for (int n = 0; n < 2; ++n) acc[a][b][m][n] = (f32x4){0.f, 0.f, 0.f, 0.f};
        cur = nxt; cA = nA; cB = nB; ++ui;
        if constexpr (ALIGN_EPI) { if (wr == 1) PG8_BAR; }
    }
    PG8_WAIT_V(0);
    if constexpr (!ALIGN_EPI) { if (wr == 0) PG8_BAR; }
    PG8_BAR;
    if constexpr (Epi::AFTER_DRAIN) { E.fused(acc, cur, wr, wc, fr, fq, lds, wid, lane); S.done(cur); }
#undef PG8_SA
#undef PG8_SB
#undef PG8_STAGE
#undef PG8_LDA
#undef PG8_LDB
#undef PG8_MMA
#undef PG8_WAIT_V
#undef PG8_WAIT_L
#undef PG8_BAR
#undef PG8_SCHED
}
}
constexpr int DM = 1024, NB = 4, SEQ = 4096, NCTX = 256, DFF = 2816, DIN = 4112, NPROJ = 4096, NMODC = 9216;
constexpr int LDP = 4224;
constexpr int MLAT = NB * SEQ, MCTX = NB * NCTX, MALL = MLAT + MCTX;
constexpr float EPSN = 1e-6f;
constexpr int NWAVES = 8, NTHREADS = 512;
#ifndef ONE_LAUNCH
#define ONE_LAUNCH 1
#endif
constexpr int NPHASES = 15;

constexpr size_t MiB = 1u << 20;
constexpr size_t WS_CTL = 0, CTL_ZERO_BYTES = 64 * 1024;
constexpr size_t WS_MODS = 1 * MiB;
constexpr size_t WS_GATES = 1 * MiB + 512 * 1024;
constexpr size_t WS_W1 = 3 * MiB;
constexpr size_t WS_W2 = 14 * MiB;
constexpr size_t WS_WIN = 20 * MiB;
constexpr size_t WS_WOUT = 28 * MiB;
constexpr size_t WS_XN = 34 * MiB;
constexpr size_t WS_PROJ = 68 * MiB;
constexpr size_t WS_QK = 209 * MiB;
constexpr size_t WS_END = 256 * MiB;
constexpr size_t WS_HGST = 237 * MiB;
constexpr size_t WS_HGG = 253 * MiB;
constexpr size_t WS_WG = 2 * MiB + 640 * 1024;
constexpr size_t WS_MLST = 226 * MiB;
constexpr size_t WS_MLSC = 236 * MiB;
constexpr size_t WS_SLAB = 204 * MiB;
constexpr size_t WS_SLAB2 = 237 * MiB;
constexpr int CW_BAR = 1024;

constexpr int RING_BYTES = 131072;
constexpr int LDSCTL_OFF = 162816, MISC_OFF = LDSCTL_OFF + 320;
constexpr int LDS_BYTES = 163840;

#define GAS __attribute__((address_space(1)))
#define LAS __attribute__((address_space(3)))
typedef unsigned short bf16;
typedef unsigned v4u __attribute__((ext_vector_type(4)));
typedef unsigned v2u __attribute__((ext_vector_type(2)));
typedef float f32x4 __attribute__((ext_vector_type(4)));
#define LDS_WAIT() asm volatile("s_waitcnt lgkmcnt(0)" ::: "memory")
#define VM_WAIT() asm volatile("s_waitcnt vmcnt(0)" ::: "memory")
__device__ __forceinline__ unsigned f2bf(float f) { unsigned u = __builtin_bit_cast(unsigned, f); return (u + 0x7fffu + ((u >> 16) & 1u)) >> 16; }
__device__ __forceinline__ unsigned pk2(float lo, float hi) { return f2bf(lo) | (f2bf(hi) << 16); }
__device__ __forceinline__ float bf2f(unsigned short h) { return __builtin_bit_cast(float, (unsigned)h << 16); }
__device__ __forceinline__ float bflo(unsigned w) { return __builtin_bit_cast(float, w << 16); }
__device__ __forceinline__ float bfhi(unsigned w) { return __builtin_bit_cast(float, w & 0xffff0000u); }
__device__ __forceinline__ float sigmoidf_(float v) { return 1.0f / (1.0f + __expf(-v)); }
__device__ __forceinline__ float fast_sig(float v) { return __builtin_amdgcn_rcpf(1.0f + __builtin_amdgcn_exp2f(-1.4426950408889634f * v)); }
__device__ __forceinline__ float siluf_(float v) { return v * sigmoidf_(v); }
__device__ __forceinline__ float wave_sum(float v) {
#pragma unroll
    for (int o = 1; o < 64; o <<= 1) v += __shfl_xor(v, o);
    return v;
}

#ifndef PROF_S
#define PROF_S -1
#endif
#define PS_BEGIN() do { if (PROF_S >= 0 && blockIdx.x == 0 && threadIdx.x == 0) { const unsigned long long t_ = __builtin_amdgcn_s_memrealtime(); volatile LAS unsigned* M_ = (volatile LAS unsigned*)(T.lds + MISC_OFF); M_[20] = (unsigned)t_; M_[21] = (unsigned)(t_ >> 32); } } while (0)
#define PS_END(id) do { if (PROF_S >= 0 && blockIdx.x == 0 && threadIdx.x == 0) { const unsigned long long t_ = __builtin_amdgcn_s_memrealtime(); volatile LAS unsigned* M_ = (volatile LAS unsigned*)(T.lds + MISC_OFF); \
    if ((id) == PROF_S) { const unsigned long long p_ = ((unsigned long long)M_[21] << 32) | M_[20]; const unsigned long long a_ = (((unsigned long long)M_[23] << 32) | M_[22]) + (t_ - p_); M_[22] = (unsigned)a_; M_[23] = (unsigned)(a_ >> 32); } \
    M_[20] = (unsigned)t_; M_[21] = (unsigned)(t_ >> 32); } } while (0)
#define XB_TMO      128
#define XB_XCNT(j)  (256  + 64 * (j))
#define XB_XSUB(j)  (1280 + 64 * (j))
#define XB_XGEN(j)  (2304 + 64 * (j))
#define XB_TOP      3328
#define XB_TOPGEN   3392
#define XCD_BAR_WORDS 3456
#define XB_SPIN_CAP (1u << 18)

__device__ __forceinline__ unsigned xb_ld(unsigned* p)              { return __hip_atomic_load(p, __ATOMIC_RELAXED, __HIP_MEMORY_SCOPE_AGENT); }
__device__ __forceinline__ unsigned xb_add(unsigned* p, unsigned v) { return __hip_atomic_fetch_add(p, v, __ATOMIC_RELAXED, __HIP_MEMORY_SCOPE_AGENT); }
__device__ __forceinline__ unsigned xb_xcc_id() { return (unsigned)__builtin_amdgcn_s_getreg((3 << 11) | 20) & 0xFu; }
#define XB_SPIN(cond, bar) do { unsigned _sp = 0; while (cond) { __builtin_amdgcn_s_sleep(1); \
    if ((++_sp & 255u) == 0u) { if (xb_ld(&(bar)[XB_TMO])) break; if (_sp > XB_SPIN_CAP) { atomicAdd(&(bar)[XB_TMO], 1u); break; } } } } while (0)

struct XcdBarrier {
    unsigned* bar; unsigned x;
    volatile LAS unsigned* st;
};

__device__ __forceinline__ XcdBarrier xcd_barrier_post(unsigned* bar, volatile LAS unsigned* st) {
    XcdBarrier b; b.bar = bar; b.x = xb_xcc_id(); b.st = st;
    if (threadIdx.x == 0) (void)xb_add(&bar[XB_XCNT(b.x)], 1u);
    return b;
}
__device__ __forceinline__ void xcd_barrier_complete(unsigned* bar, unsigned x, unsigned& nloc, unsigned& nx) {
    const unsigned G = gridDim.x * gridDim.y * gridDim.z;
    unsigned sum, cnt, mine, sp = 0u;
    for (;;) {
        sum = 0u; cnt = 0u; mine = 0u;
#pragma unroll
        for (unsigned j = 0; j < 16; ++j) { const unsigned c = xb_ld(&bar[XB_XCNT(j)]); sum += c; cnt += (c > 0u) ? 1u : 0u; mine = (j == x) ? c : mine; }
        if (sum == G) break;
        __builtin_amdgcn_s_sleep(1);
        if ((++sp & 255u) == 0u) { if (xb_ld(&bar[XB_TMO])) break; if (sp > XB_SPIN_CAP) { atomicAdd(&bar[XB_TMO], 1u); break; } }
    }
    nloc = mine > 0u ? mine : 1u; nx = cnt > 0u ? cnt : 1u;
}

__device__ __forceinline__ void xcd_barrier(const XcdBarrier& b) {
    asm volatile("s_waitcnt vmcnt(0)" ::: "memory");
    __syncthreads();
    if (threadIdx.x == 0) {
        unsigned* bar = b.bar;
        __builtin_amdgcn_s_waitcnt(0);
        unsigned nloc = b.st[0], nx = b.st[1];
        if (nloc == 0u) { xcd_barrier_complete(bar, b.x, nloc, nx); b.st[0] = nloc; b.st[1] = nx; }
        const unsigned old = xb_add(&bar[XB_XSUB(b.x)], 1u);
        const unsigned gen = old / nloc;
        if (old + 1u == (gen + 1u) * nloc) {
            __builtin_amdgcn_fence(__ATOMIC_RELEASE, "agent");
            asm volatile("s_waitcnt vmcnt(0)" ::: "memory");
            const unsigned og = xb_add(&bar[XB_TOP], 1u);
            const unsigned tg = og / nx;
            if (og + 1u == (tg + 1u) * nx) xb_add(&bar[XB_TOPGEN], 1u);
            else XB_SPIN(xb_ld(&bar[XB_TOPGEN]) == tg, bar);
            __builtin_amdgcn_fence(__ATOMIC_ACQUIRE, "agent");
            xb_add(&bar[XB_XGEN(b.x)], 1u);
            asm volatile("s_waitcnt vmcnt(0)" ::: "memory");
        } else {
            XB_SPIN(xb_ld(&bar[XB_XGEN(b.x)]) == gen, bar);
            __builtin_amdgcn_fence(__ATOMIC_ACQUIRE, "agent");
            asm volatile("s_waitcnt vmcnt(0)" ::: "memory");
        }
    }
    __syncthreads();
}
struct Args {
    const float* in[22]; float* out; unsigned char* ws; int ph_lo, ph_hi;
};
enum { I_X = 0, I_C, I_CTX, I_CCTX, I_WMOD, I_BMOD, I_N1W, I_F1W1, I_F1W2, I_N2W, I_WIN, I_MLGB, I_CONVW, I_CONVB, I_LBLOG, I_HGNW, I_MLNW, I_WOUT, I_N3W, I_F2W1, I_F2W2, I_FNW };

struct Ctx {
    LAS unsigned char* lds;
    int tid, lane, wave, vcu, G, gw, NGW;
};

__device__ __forceinline__ void mods_phase(const Args& a, const Ctx& T) {
    LAS float* sL = (LAS float*)T.lds;
    LAS float* red = (LAS float*)(T.lds + 20480);
    const float* c = a.in[I_C]; const float* cc = a.in[I_CCTX];
    for (int i = T.tid; i < 5 * 1024; i += NTHREADS) { const int r = i >> 10, k = i & 1023; const float v = r < 4 ? c[r * 1024 + k] : cc[k]; sL[i] = siluf_(v); }
    __syncthreads();
    typedef float f2 __attribute__((ext_vector_type(2)));
    for (int item = T.vcu; item < 576; item += T.G) {
        const int cb = item >> 3, kr = item & 7; const int k0 = kr * 128 + T.wave * 16;
        const float* W = a.in[I_WMOD] + (size_t)k0 * NMODC + cb * 128 + 2 * T.lane;
        f2 wv[16];
#pragma unroll
        for (int k = 0; k < 16; ++k) wv[k] = *(const f2*)(W + (size_t)k * NMODC);
        float acc[5][2];
#pragma unroll
        for (int r = 0; r < 5; ++r) { acc[r][0] = 0.f; acc[r][1] = 0.f; }
#pragma unroll
        for (int k = 0; k < 16; ++k)
#pragma unroll
            for (int r = 0; r < 5; ++r) { const float s = sL[r * 1024 + k0 + k]; acc[r][0] += s * wv[k].x; acc[r][1] += s * wv[k].y; }
#pragma unroll
        for (int r = 0; r < 5; ++r) *(LAS f2*)(red + (T.wave * 5 + r) * 128 + 2 * T.lane) = (f2){acc[r][0], acc[r][1]};
        __syncthreads();
        for (int o = T.tid; o < 640; o += NTHREADS) { const int r = o >> 7, cl = o & 127; float s = 0.f;
#pragma unroll
            for (int w = 0; w < 8; ++w) s += red[(w * 5 + r) * 128 + cl];
            const int col = cb * 128 + cl; if (kr == 0) s += a.in[I_BMOD][col];
            atomicAdd((float*)(a.ws + WS_MODS) + r * NMODC + col, s); }
        __syncthreads();
    }
}

__device__ __forceinline__ void transpose_item(const float* W, int ldw, int K, bf16* WT, int k0, int n0, int dest_row0, LAS float* scr, int lane) {
    float tv[32];
#pragma unroll
    for (int i = 0; i < 32; ++i) tv[i] = W[(size_t)(k0 + 2 * i + (lane >> 5)) * ldw + n0 + (lane & 31)];
#pragma unroll
    for (int i = 0; i < 32; ++i) scr[(2 * i + (lane >> 5)) * 33 + (lane & 31)] = tv[i];
    LDS_WAIT(); asm volatile("" ::: "memory");
    const int c = lane & 7;
#pragma unroll
    for (int j = 0; j < 4; ++j) { const int n = (lane >> 3) + 8 * j; const LAS float* s = scr + (8 * c) * 33 + n;
        v4u o; o.x = pk2(s[0 * 33], s[1 * 33]); o.y = pk2(s[2 * 33], s[3 * 33]); o.z = pk2(s[4 * 33], s[5 * 33]); o.w = pk2(s[6 * 33], s[7 * 33]);
        *(GAS v4u*)(WT + (size_t)(dest_row0 + n) * K + k0 + 8 * c) = o; }
    LDS_WAIT(); asm volatile("" ::: "memory");
}
__device__ __forceinline__ void convert_ffn(const Args& a, const Ctx& T, const float* w1, const float* w2) {
    LAS float* scr = (LAS float*)(T.lds + T.wave * 16384);
    bf16* W1 = (bf16*)(a.ws + WS_W1); bf16* W2 = (bf16*)(a.ws + WS_W2);
    constexpr int I1 = 16 * 176, I2 = 44 * 32;
    for (int it = T.gw; it < I1 + I2; it += T.NGW) {
        if (it < I1) { const int kb = it / 176, nb = it % 176, n0 = nb * 32;
            const int dest = n0 < DFF ? (n0 >> 7) * 256 + (n0 & 127) : ((n0 - DFF) >> 7) * 256 + 128 + ((n0 - DFF) & 127);
            transpose_item(w1, 2 * DFF, DM, W1, kb * 64, n0, dest, scr, T.lane); }
        else { const int r = it - I1, kb = r / 32, nb = r % 32; transpose_item(w2, DM, DFF, W2, kb * 64, nb * 32, nb * 32, scr, T.lane); }
    }
}
__device__ __forceinline__ void convert_mix(const Args& a, const Ctx& T) {
    LAS float* scr = (LAS float*)(T.lds + T.wave * 16384);
    bf16* WI = (bf16*)(a.ws + WS_WIN); bf16* WO = (bf16*)(a.ws + WS_WOUT);
    constexpr int I1 = 16 * 128, I2 = 16 * 32;
    for (int it = T.gw; it < I1 + I2; it += T.NGW) {
        if (it < I1) { const int kb = it / 128, nb = it % 128; transpose_item(a.in[I_WIN], DIN, DM, WI, kb * 64, nb * 32, nb * 32, scr, T.lane); }
        else { const int r = it - I1, kb = r / 32, nb = r % 32; transpose_item(a.in[I_WOUT], DM, DM, WO, kb * 64, nb * 32, nb * 32, scr, T.lane); }
    }
}

__device__ __forceinline__ void norm_load_row(f32x4 (&v)[4], const void* src_lat, bool latbf, const float* src_ctx, int m, int lane) {
    if (m < MLAT) {
        if (latbf) { const v2u* xr = (const v2u*)((const bf16*)src_lat + (size_t)m * DM) + lane;
#pragma unroll
            for (int j = 0; j < 4; ++j) { const v2u w = xr[64 * j]; v[j] = (f32x4){bflo(w.x), bfhi(w.x), bflo(w.y), bfhi(w.y)}; } }
        else { const f32x4* xr = (const f32x4*)((const float*)src_lat + (size_t)m * DM) + lane;
#pragma unroll
            for (int j = 0; j < 4; ++j) v[j] = xr[64 * j]; }
    } else { const f32x4* xr = (const f32x4*)(src_ctx + (size_t)(m - MLAT) * DM) + lane;
#pragma unroll
        for (int j = 0; j < 4; ++j) v[j] = xr[64 * j]; }
}
template <bool CTXSLAB, bool LATBF>
__device__ __forceinline__ void norm_mod_rows(const Args& a, const Ctx& T, const void* src_lat, const float* src_ctx, int nrows, const float* nw, int shift_idx, int scale_idx) {
    const float* mods = (const float*)(a.ws + WS_MODS);
    bf16* XN = (bf16*)(a.ws + WS_XN);
    f32x4 wv[4];
#pragma unroll
    for (int j = 0; j < 4; ++j) wv[j] = *((const f32x4*)nw + T.lane + 64 * j);
    f32x4 v[4];
    if (T.gw < nrows) norm_load_row(v, src_lat, LATBF, src_ctx, T.gw, T.lane);
    for (int m = T.gw; m < nrows; m += T.NGW) {
        const float* mr = mods + (size_t)(m < MLAT ? (m >> 12) : 4) * NMODC;
        f32x4 sh[4], sc[4];
#pragma unroll
        for (int j = 0; j < 4; ++j) { sh[j] = *((const f32x4*)(mr + shift_idx * 1024) + T.lane + 64 * j); sc[j] = *((const f32x4*)(mr + scale_idx * 1024) + T.lane + 64 * j); }
        f32x4 cur[4]; float s = 0.f;
        if (CTXSLAB && m >= MLAT) {
            const float* gr = mods + (size_t)4 * NMODC + 2 * 1024;
#pragma unroll
            for (int j = 0; j < 4; ++j) { f32x4 acc = (f32x4){0.f, 0.f, 0.f, 0.f};
#pragma unroll 1
                for (int ks = 0; ks < 11; ++ks) acc += *((const f32x4*)((const float*)(a.ws + WS_SLAB) + ((size_t)ks * 1024 + (m - MLAT)) * 1024) + T.lane + 64 * j);
                v[j] = v[j] + acc * (*((const f32x4*)gr + T.lane + 64 * j) * 0.5f); }
        }
#pragma unroll
        for (int j = 0; j < 4; ++j) { cur[j] = v[j]; s += (v[j].x * v[j].x + v[j].y * v[j].y) + (v[j].z * v[j].z + v[j].w * v[j].w); }
        { const int mn = m + T.NGW; if (mn < nrows) norm_load_row(v, src_lat, LATBF, src_ctx, mn, T.lane); }
        const float rstd = __builtin_amdgcn_rsqf(wave_sum(s) * (1.f / DM) + EPSN);
        unsigned long long* o8 = (unsigned long long*)(XN + (size_t)m * DM) + T.lane;
#pragma unroll
        for (int j = 0; j < 4; ++j) { const f32x4 y = (cur[j] * rstd * wv[j]) * (sc[j] + 1.0f) + sh[j];
            o8[64 * j] = (unsigned long long)pk2(y.x, y.y) | ((unsigned long long)pk2(y.z, y.w) << 32); }
    }
}

struct ConvTaps { v4u t[9]; };
__device__ __forceinline__ void conv_load(ConvTaps& R, const bf16* P, int m, int ch0) {
    const v4u z = (v4u){0u, 0u, 0u, 0u};
    const int b = m >> 12, t = m & 4095, r = t >> 6, c = t & 63;
#pragma unroll
    for (int dr = -1; dr <= 1; ++dr)
#pragma unroll
        for (int dc = -1; dc <= 1; ++dc) { const int rr = r + dr, c2 = c + dc; const bool ok = rr >= 0 && rr < 64 && c2 >= 0 && c2 < 64;
            R.t[(dr + 1) * 3 + dc + 1] = ok ? *(const v4u*)(P + (size_t)(b * 4096 + rr * 64 + c2) * LDP + 2560 + ch0) : z; }
}
__device__ __forceinline__ void ctx_combine(const Args& a, const Ctx& T) {
    const bf16* S2 = (const bf16*)(a.ws + WS_SLAB2); bf16* P = (bf16*)(a.ws + WS_PROJ);
    for (int task = T.vcu * NTHREADS + T.tid; task < 1024 * 256; task += T.G * NTHREADS) {
        const int r = task >> 8, q = task & 255; const int t8 = q >> 5, c8 = (q & 31) * 8; const int t9 = t8 < 6 ? t8 : t8 + 1;
        const int pn = t9 < 2 ? 2 + t9 : (t9 < 6 ? 4 + t9 : 5 + t9);
        float s[8] = {0.f, 0.f, 0.f, 0.f, 0.f, 0.f, 0.f, 0.f};
#pragma unroll
        for (int ks = 0; ks < 4; ++ks) { const v4u pv = *(const v4u*)(S2 + ((size_t)ks * 1024 + r) * 2304 + t9 * 256 + c8);
            s[0] += bflo(pv.x); s[1] += bfhi(pv.x); s[2] += bflo(pv.y); s[3] += bfhi(pv.y); s[4] += bflo(pv.z); s[5] += bfhi(pv.z); s[6] += bflo(pv.w); s[7] += bfhi(pv.w); }
        *(v4u*)(P + (size_t)(MLAT + r) * LDP + pn * 256 + c8) = (v4u){pk2(s[0], s[1]), pk2(s[2], s[3]), pk2(s[4], s[5]), pk2(s[6], s[7])};
    }
}
__device__ __forceinline__ void conv_phase(const Args& a, const Ctx& T) {
    const bf16* P = (const bf16*)(a.ws + WS_PROJ); bf16* QK = (bf16*)(a.ws + WS_QK);
    const float* cw = a.in[I_CONVW]; const float* cb = a.in[I_CONVB];
    const int gid = T.vcu * NTHREADS + T.tid; const int ch0 = (gid & 63) * 8; const int m0 = gid >> 6, mstep = (T.G * NTHREADS) >> 6;
    {
        float w[9][8], bias[8];
#pragma unroll
        for (int k = 0; k < 9; ++k)
#pragma unroll
            for (int i = 0; i < 8; ++i) w[k][i] = cw[k * 512 + ch0 + i];
#pragma unroll
        for (int i = 0; i < 8; ++i) bias[i] = cb[ch0 + i];
        const float sc = ch0 < 256 ? 0.125f : 1.0f;
        ConvTaps R;
        if (m0 < MLAT) conv_load(R, P, m0, ch0);
        for (int m = m0; m < MLAT; m += mstep) {
            float acc[8];
#pragma unroll
            for (int i = 0; i < 8; ++i) acc[i] = bias[i];
#pragma unroll
            for (int k = 0; k < 9; ++k) { const v4u pv = R.t[k];
                acc[0] += w[k][0] * bflo(pv.x); acc[1] += w[k][1] * bfhi(pv.x); acc[2] += w[k][2] * bflo(pv.y); acc[3] += w[k][3] * bfhi(pv.y);
                acc[4] += w[k][4] * bflo(pv.z); acc[5] += w[k][5] * bfhi(pv.z); acc[6] += w[k][6] * bflo(pv.w); acc[7] += w[k][7] * bfhi(pv.w); }
            if (m + mstep < MLAT) conv_load(R, P, m + mstep, ch0);
#pragma unroll
            for (int i = 0; i < 8; ++i) acc[i] = acc[i] * fast_sig(acc[i]) * sc;
            v4u o; o.x = pk2(acc[0], acc[1]); o.y = pk2(acc[2], acc[3]); o.z = pk2(acc[4], acc[5]); o.w = pk2(acc[6], acc[7]);
            *(v4u*)(QK + (size_t)m * 512 + ch0) = o;
        }
    }
    {
        const bf16* S2 = (const bf16*)(a.ws + WS_SLAB2);
#pragma unroll 1
        for (int task = gid; task < MCTX * 32; task += T.G * NTHREADS) {
            const int mc = task >> 5, c8 = (task & 31) * 8, b = mc >> 8, t = mc & 255;
            float acc[8];
#pragma unroll
            for (int i = 0; i < 8; ++i) acc[i] = cb[256 + c8 + i];
#pragma unroll 1
            for (int d = -1; d <= 1; ++d) { const int t2 = t + d; if (t2 < 0 || t2 >= 256) continue;
                float s[8] = {0.f, 0.f, 0.f, 0.f, 0.f, 0.f, 0.f, 0.f};
#pragma unroll
                for (int ks = 0; ks < 4; ++ks) { const v4u pv = *(const v4u*)(S2 + ((size_t)ks * 1024 + b * 256 + t2) * 2304 + 6 * 256 + c8);
                    s[0] += bflo(pv.x); s[1] += bfhi(pv.x); s[2] += bflo(pv.y); s[3] += bfhi(pv.y); s[4] += bflo(pv.z); s[5] += bfhi(pv.z); s[6] += bflo(pv.w); s[7] += bfhi(pv.w); }
                const float* wk = cw + (3 + d + 1) * 512 + 256 + c8;
#pragma unroll
                for (int i = 0; i < 8; ++i) acc[i] += wk[i] * bf2f((unsigned short)f2bf(s[i])); }
#pragma unroll
            for (int i = 0; i < 8; ++i) acc[i] = acc[i] * fast_sig(acc[i]);
            v4u o; o.x = pk2(acc[0], acc[1]); o.y = pk2(acc[2], acc[3]); o.z = pk2(acc[4], acc[5]); o.w = pk2(acc[6], acc[7]);
            *(v4u*)(QK + (size_t)(MLAT + mc) * 512 + 256 + c8) = o;
        }
    }
}

typedef short bf16x8 __attribute__((ext_vector_type(8)));
typedef float f32x2 __attribute__((ext_vector_type(2)));
#define MFMA16(a, b, c) __builtin_amdgcn_mfma_f32_16x16x32_bf16((a), (b), (c), 0, 0, 0)
template <int KSTEPS>
__device__ __forceinline__ void mma_tile(f32x4& acc, const LAS unsigned char* A, int sa, const LAS unsigned char* B, int sb, int lane) {
    const LAS unsigned char* pa = A + (lane & 15) * sa + (lane >> 4) * 16; const LAS unsigned char* pb = B + (lane & 15) * sb + (lane >> 4) * 16;
#pragma unroll
    for (int ks = 0; ks < KSTEPS; ++ks) { const bf16x8 av = *(const LAS bf16x8*)(pa + ks * 64); const bf16x8 bv = *(const LAS bf16x8*)(pb + ks * 64); acc = MFMA16(av, bv, acc); }
}
typedef __bf16 bf16x2_t __attribute__((ext_vector_type(2)));
__device__ __forceinline__ unsigned cvtpk(float lo, float hi) { const f32x2 v = {lo, hi}; const bf16x2_t b = __builtin_convertvector(v, bf16x2_t); return __builtin_bit_cast(unsigned, b); }
struct BF2 { bf16x8 k0, k1; };
struct BF4 { bf16x8 k0, k1, k2, k3; };
__device__ __forceinline__ BF2 ldfrag2(const LAS unsigned char* B, int sb, int lane) { const LAS unsigned char* p = B + (lane & 15) * sb + (lane >> 4) * 16; BF2 f; f.k0 = *(const LAS bf16x8*)p; f.k1 = *(const LAS bf16x8*)(p + 64); return f; }
__device__ __forceinline__ BF4 ldfrag4(const LAS unsigned char* B, int sb, int lane) { const LAS unsigned char* p = B + (lane & 15) * sb + (lane >> 4) * 16; BF4 f; f.k0 = *(const LAS bf16x8*)p; f.k1 = *(const LAS bf16x8*)(p + 64); f.k2 = *(const LAS bf16x8*)(p + 128); f.k3 = *(const LAS bf16x8*)(p + 192); return f; }
__device__ __forceinline__ void mma2(f32x4& acc, const LAS unsigned char* A, int sa, const BF2& b, int lane) { const LAS unsigned char* p = A + (lane & 15) * sa + (lane >> 4) * 16;
    acc = MFMA16(*(const LAS bf16x8*)p, b.k0, acc); acc = MFMA16(*(const LAS bf16x8*)(p + 64), b.k1, acc); }
__device__ __forceinline__ void mma4(f32x4& acc, const LAS unsigned char* A, int sa, const BF4& b, int lane) { const LAS unsigned char* p = A + (lane & 15) * sa + (lane >> 4) * 16;
    acc = MFMA16(*(const LAS bf16x8*)p, b.k0, acc); acc = MFMA16(*(const LAS bf16x8*)(p + 64), b.k1, acc); acc = MFMA16(*(const LAS bf16x8*)(p + 128), b.k2, acc); acc = MFMA16(*(const LAS bf16x8*)(p + 192), b.k3, acc); }
__device__ __forceinline__ float ex2(float v) { return __builtin_amdgcn_exp2f(v); }
__device__ __forceinline__ float lg2(float v) { return __builtin_amdgcn_logf(v); }

constexpr int HS_ND = 272;
constexpr int HS_T = 160;
constexpr int HL_QD = 0, HL_KD = HL_QD + 64 * HS_ND, HL_X = HL_KD + 64 * HS_ND, HL_QE = HL_X + 64 * HS_ND;
constexpr int HL_KTT = HL_QE + 64 * HS_ND;
constexpr int HL_VT = HL_KTT + 128 * HS_T;
constexpr int HL_ST = HL_VT + 128 * HS_T;
constexpr int HL_P = HL_ST + 128 * HS_ND;
constexpr int HL_SEG = HL_P + 64 * HS_T;
constexpr int HL_FAC = HL_SEG + 4096;
constexpr int HL_NW = HL_FAC + 512;
constexpr int HL_END = HL_NW + 512;
constexpr int HL_OT = HL_QD, OT_S = 132 * 4;
static_assert(64 * OT_S <= 2 * 64 * HS_ND, "o tile overlay");
static_assert(HL_END <= 160 * 1024 - 1024, "HGRN2 LDS map");

constexpr size_t HG_SLOT_BYTES = 128 * 128 * 2;
__device__ __forceinline__ size_t hg_seq(int b, int dir, int head) { return (size_t)((b * 2 + dir) * 4 + head); }

__device__ __forceinline__ int sc_row(int b, int dir, int js, int lt) {
    if (js == 0) return MLAT + b * NCTX + (dir ? NCTX - 1 - lt : lt);
    const int q = 256 * (js - 1) + lt; return b * SEQ + (dir ? SEQ - 1 - q : q);
}

constexpr int P1_S = 544;
constexpr int P1_KTT = 0, P1_VT = P1_KTT + 128 * P1_S, P1_SEG = P1_VT + 128 * P1_S, P1_END = P1_SEG + 4096;
static_assert(P1_END <= 159 * 1024, "pass-1 LDS map");
__device__ __forceinline__ int p1_row(int b, int blk, int lt) { return blk < 0 ? MLAT + b * NCTX + lt : b * SEQ + 256 * blk + lt; }
template <int DIR>
__device__ __forceinline__ void hg_p1_dir(const Args& a, const Ctx& T, int b, int head, int blk, int slot, bool load_v) {
    const bf16* P = (const bf16*)(a.ws + WS_PROJ);
    LAS unsigned char* L = T.lds;
    const int w = T.wave, l = T.lane, g = l >> 4, c16 = l & 15;
    const int ch = head * 128 + 2 * l;
    const float* lbl = a.in[I_LBLOG];
    float lb[2];
#pragma unroll
    for (int x = 0; x < 2; ++x) lb[x] = sigmoidf_(lbl[DIR * 512 + ch + x] - lbl[(2 + DIR) * 512 + ch + x]);
    unsigned fw[32];
#pragma unroll
    for (int i = 0; i < 32; ++i) fw[i] = *(const unsigned*)(P + (size_t)p1_row(b, blk, 32 * w + i) * LDP + (DIR ? 2048 : 1536) + ch);
    if (load_v) {
        unsigned vw[32];
#pragma unroll
        for (int i = 0; i < 32; ++i) vw[i] = *(const unsigned*)(P + (size_t)p1_row(b, blk, 32 * w + i) * LDP + 512 + ch);
#pragma unroll
        for (int x = 0; x < 2; ++x)
#pragma unroll
            for (int q = 0; q < 4; ++q) { unsigned pv[4];
#pragma unroll
                for (int i = 0; i < 8; i += 2) { const unsigned v0 = x ? (vw[8 * q + i] >> 16) : (vw[8 * q + i] & 0xffffu), v1 = x ? (vw[8 * q + i + 1] >> 16) : (vw[8 * q + i + 1] & 0xffffu); pv[i >> 1] = v0 | (v1 << 16); }
                *(LAS v4u*)(L + P1_VT + (2 * l + x) * P1_S + 64 * w + 16 * q) = (v4u){pv[0], pv[1], pv[2], pv[3]}; }
    }
    float tot[2] = {0.f, 0.f};
#pragma unroll
    for (int i = 0; i < 32; ++i) {
        const float s0 = fast_sig(bflo(fw[i])), s1 = fast_sig(bfhi(fw[i]));
        tot[0] += lg2(lb[0] + (1.f - lb[0]) * s0); tot[1] += lg2(lb[1] + (1.f - lb[1]) * s1); }
    *(LAS f32x2*)(L + P1_SEG + (w * 128 + 2 * l) * 4) = (f32x2){tot[0], tot[1]};
    __syncthreads();
    float after[2] = {0.f, 0.f}, all[2] = {0.f, 0.f};
#pragma unroll
    for (int ww = 0; ww < 8; ++ww) { const f32x2 t2 = *(const LAS f32x2*)(L + P1_SEG + (ww * 128 + 2 * l) * 4); all[0] += t2.x; all[1] += t2.y;
        if (DIR ? (ww < w) : (ww > w)) { after[0] += t2.x; after[1] += t2.y; } }
#pragma unroll
    for (int x = 0; x < 2; ++x) {
        float run = after[x];
#pragma unroll
        for (int q = 0; q < 4; ++q) { float kv[8];
#pragma unroll
            for (int ii = 0; ii < 8; ++ii) { const int i = DIR ? 8 * q + ii : 31 - (8 * q + ii);
                const float fp = x ? bfhi(fw[i]) : bflo(fw[i]); const float sg = fast_sig(fp); const float f = lb[x] + (1.f - lb[x]) * sg;
                kv[ii] = (1.f - lb[x]) * (1.f - sg) * ex2(run); run += lg2(f); }
            if (DIR) *(LAS v4u*)(L + P1_KTT + (2 * l + x) * P1_S + 64 * w + 16 * q) = (v4u){cvtpk(kv[0], kv[1]), cvtpk(kv[2], kv[3]), cvtpk(kv[4], kv[5]), cvtpk(kv[6], kv[7])};
            else *(LAS v4u*)(L + P1_KTT + (2 * l + x) * P1_S + 64 * w + 16 * (3 - q)) = (v4u){cvtpk(kv[7], kv[6]), cvtpk(kv[5], kv[4]), cvtpk(kv[3], kv[2]), cvtpk(kv[1], kv[0])};
        }
    }
    __syncthreads();
    f32x4 accS[8];
#pragma unroll
    for (int m = 0; m < 8; ++m) accS[m] = (f32x4){0.f, 0.f, 0.f, 0.f};
#pragma unroll
    for (int kh = 0; kh < 4; ++kh) {
        const BF2 vf = ldfrag2(L + P1_VT + 16 * w * P1_S + 128 * kh, P1_S, l);
#pragma unroll
        for (int mh = 0; mh < 8; mh += 4) { BF2 kf[4];
#pragma unroll
            for (int m = 0; m < 4; ++m) kf[m] = ldfrag2(L + P1_KTT + 16 * (mh + m) * P1_S + 128 * kh, P1_S, l);
#pragma unroll
            for (int m = 0; m < 4; ++m) accS[mh + m] = MFMA16(kf[m].k0, vf.k0, accS[mh + m]);
#pragma unroll
            for (int m = 0; m < 4; ++m) accS[mh + m] = MFMA16(kf[m].k1, vf.k1, accS[mh + m]); } }
    const size_t sidx = hg_seq(b, DIR, head) * 16 + slot;
    bf16* ST = (bf16*)(a.ws + WS_HGST + sidx * HG_SLOT_BYTES);
#pragma unroll
    for (int m = 0; m < 8; ++m) { v2u o; o.x = cvtpk(accS[m][0], accS[m][1]); o.y = cvtpk(accS[m][2], accS[m][3]); *(v2u*)(ST + (size_t)(16 * w + c16) * 128 + 16 * m + 4 * g) = o; }
    if (w == 0) *(f32x2*)((float*)(a.ws + WS_HGG) + sidx * 128 + 2 * l) = (f32x2){ex2(all[0]), ex2(all[1])};
}
__device__ __forceinline__ void hg_pass1_items(const Args& a, const Ctx& T0, int first, int stride, int limit) {
#pragma unroll 1
    for (int item = first; item < limit; item += stride) {
        Ctx T = T0; asm volatile("" : "+v"(T.lane)); T.tid = T.wave * 64 + T.lane;
        const int k = item & 15, head = (item >> 4) & 3, b = item >> 6;
        const int blkF = k == 0 ? -1 : (k == 15 ? 0 : k), slotF = k == 0 ? 0 : (k == 15 ? 1 : k + 1);
        const int blkB = k == 0 ? -1 : (k == 15 ? 15 : k), slotB = k == 0 ? 0 : (k == 15 ? 1 : 16 - k);
        __syncthreads();
        hg_p1_dir<0>(a, T, b, head, blkF, slotF, true);
        __syncthreads();
        hg_p1_dir<1>(a, T, b, head, blkB, slotB, blkB != blkF);
    }
}

__device__ __forceinline__ void hg_pass2(const Args& a, const Ctx& T) {
    const int ntask = 32 * 2048;
    for (int task = T.vcu * NTHREADS + T.tid; task < ntask; task += T.G * NTHREADS) {
        const int seq = task >> 11, el = (task & 2047) * 8, d0 = el & 127;
        float r[8];
#pragma unroll
        for (int i = 0; i < 8; ++i) r[i] = 0.f;
        for (int j = 0; j < 16; ++j) {
            v4u* p = (v4u*)(a.ws + WS_HGST + ((size_t)seq * 16 + j) * HG_SLOT_BYTES + (size_t)el * 2);
            const float* G = (const float*)(a.ws + WS_HGG) + ((size_t)seq * 16 + j) * 128 + d0;
            const v4u dv = *p; const f32x4 g0 = *(const f32x4*)G, g1 = *(const f32x4*)(G + 4);
            r[0] = g0.x * r[0] + bflo(dv.x); r[1] = g0.y * r[1] + bfhi(dv.x); r[2] = g0.z * r[2] + bflo(dv.y); r[3] = g0.w * r[3] + bfhi(dv.y);
            r[4] = g1.x * r[4] + bflo(dv.z); r[5] = g1.y * r[5] + bfhi(dv.z); r[6] = g1.z * r[6] + bflo(dv.w); r[7] = g1.w * r[7] + bfhi(dv.w);
            *p = (v4u){pk2(r[0], r[1]), pk2(r[2], r[3]), pk2(r[4], r[5]), pk2(r[6], r[7])};
        }
    }
}

struct HgP3Pre { unsigned fw[8], qw[8], vw[8]; };
__device__ __forceinline__ void hg_p3_load(HgP3Pre& R, const bf16* P, int b, int head, int jt, int step, int w, int l) {
    const int dir = step >> 2, c = step & 3; const int ch = head * 128 + 2 * l;
#pragma unroll
    for (int i = 0; i < 8; ++i) { const int lt = 64 * c + 8 * w + i; const size_t row = (size_t)(b * SEQ + 256 * jt + (dir ? 255 - lt : lt));
        R.fw[i] = *(const unsigned*)(P + row * LDP + (dir ? 2048 : 1536) + ch); R.qw[i] = *(const unsigned*)(P + row * LDP + ch); R.vw[i] = *(const unsigned*)(P + row * LDP + 512 + ch); }
}
__device__ __forceinline__ void hg_pass3_item(const Args& a, const Ctx& T0, int item, bf16* OUT) {
    const int jt = item & 15, head = (item >> 4) & 3, b = item >> 6;
    const bf16* P = (const bf16*)(a.ws + WS_PROJ);
    Ctx T = T0; asm volatile("" : "+v"(T.lane));
    T.tid = T.wave * 64 + T.lane;
    LAS unsigned char* L = T.lds;
    const int w = T.wave, l = T.lane, g = l >> 4, c16 = l & 15;
    const int ch = head * 128 + 2 * l;
    const float* lbl = a.in[I_LBLOG];
    __syncthreads();
    for (int i = T.tid; i < 64 * HS_T / 16; i += NTHREADS) *(LAS v4u*)(L + HL_P + i * 16) = (v4u){0u, 0u, 0u, 0u};
    if (T.tid < 128) *(LAS float*)(L + HL_NW + T.tid * 4) = a.in[I_HGNW][head * 128 + T.tid];
    HgP3Pre R;
    hg_p3_load(R, P, b, head, jt, 0, w, l);
    v4u stq[4];
#define HG_STATE_LOAD(dir_) do { const bf16* STg_ = (const bf16*)(a.ws + WS_HGST + (hg_seq(b, (dir_), head) * 16 + ((dir_) ? 15 - jt : jt)) * HG_SLOT_BYTES); \
        _Pragma("unroll") for (int q_ = 0; q_ < 4; ++q_) { const int idx_ = l + 64 * q_; stq[q_] = *(const v4u*)(STg_ + (size_t)(16 * w + (idx_ >> 4)) * 128 + (idx_ & 15) * 8); } } while (0)
    HG_STATE_LOAD(0);
    f32x4 accS[8];
    float lb[2] = {0.f, 0.f};
    const int ot = T.tid >> 3, opart = T.tid & 7;
#pragma unroll 1
    for (int step = 0; step < 8; ++step) {
        const int dir = step >> 2, c = step & 3;
        PS_BEGIN();
        if (c == 0) {
#pragma unroll
            for (int x = 0; x < 2; ++x) lb[x] = sigmoidf_(lbl[dir * 512 + ch + x] - lbl[(2 + dir) * 512 + ch + x]);
            if (dir == 1) { HG_STATE_LOAD(1); VM_WAIT(); __syncthreads(); if (w == 0) { __builtin_amdgcn_fence(__ATOMIC_ACQUIRE, "agent"); VM_WAIT(); } __syncthreads(); }
#pragma unroll
            for (int q = 0; q < 4; ++q) { const int idx = l + 64 * q; *(LAS v4u*)(L + HL_ST + (16 * w + (idx >> 4)) * HS_ND + (idx & 15) * 16) = stq[q]; }
            LDS_WAIT();
#pragma unroll
            for (int m = 0; m < 8; ++m) { const v2u sv = *(const LAS v2u*)(L + HL_ST + (16 * w + c16) * HS_ND + (16 * m + 4 * g) * 2); accS[m] = (f32x4){bflo(sv.x), bfhi(sv.x), bflo(sv.y), bfhi(sv.y)}; }
        }
        PS_END(11);
        float kk[2][8], cl[2][8]; unsigned qw[8], vw[8];
#pragma unroll
        for (int i = 0; i < 8; ++i) { qw[i] = R.qw[i]; vw[i] = R.vw[i]; }
#pragma unroll
        for (int x = 0; x < 2; ++x) { float run = 0.f;
#pragma unroll
            for (int i = 0; i < 8; ++i) { const float fp = x ? bfhi(R.fw[i]) : bflo(R.fw[i]); const float sg = fast_sig(fp); const float f = lb[x] + (1.f - lb[x]) * sg;
                kk[x][i] = (1.f - lb[x]) * (1.f - sg); run += lg2(f); cl[x][i] = run; } }
        if (step < 7) hg_p3_load(R, P, b, head, jt, step + 1, w, l);
        *(LAS f32x2*)(L + HL_SEG + (w * 128 + 2 * l) * 4) = (f32x2){cl[0][7], cl[1][7]};
        PS_END(0); __syncthreads(); PS_END(1);
        const int half = w >> 2;
        float pre[2], mid[2], fx[2], fqe[2], fkt[2];
#pragma unroll
        for (int x = 0; x < 2; ++x) {
            float tt[8];
#pragma unroll
            for (int ww = 0; ww < 8; ++ww) tt[ww] = *(const LAS float*)(L + HL_SEG + (ww * 128 + 2 * l + x) * 4);
            const float r15 = tt[0] + tt[1], r31 = r15 + tt[2] + tt[3], r47 = r31 + tt[4] + tt[5], r63 = r47 + tt[6] + tt[7];
            float p = 0.f;
#pragma unroll
            for (int ww = 0; ww < 8; ++ww) if (ww < w) p += tt[ww];
            pre[x] = p; mid[x] = half ? r47 : r15;
            fx[x] = half ? ex2(r47 - r31) : ex2(r31 - r15); fqe[x] = ex2(mid[x]); fkt[x] = ex2(r63 - mid[x]);
            if (w == 0) *(LAS float*)(L + HL_FAC + (2 * l + x) * 4) = ex2(r63);
        }
        float ktv[2][8];
#pragma unroll
        for (int i = 0; i < 8; ++i) {
            float qd[2], kd[2], xv[2], qe[2];
#pragma unroll
            for (int x = 0; x < 2; ++x) { const float cc = pre[x] + cl[x][i] - mid[x]; const float eq = ex2(cc), ek = ex2(-cc); const float q = x ? bfhi(qw[i]) : bflo(qw[i]);
                qd[x] = q * eq; kd[x] = kk[x][i] * ek; xv[x] = (half ? qd[x] : kd[x]) * fx[x]; qe[x] = qd[x] * fqe[x]; ktv[x][i] = kd[x] * fkt[x]; }
            const int off = (8 * w + i) * HS_ND + 4 * l;
            *(LAS unsigned*)(L + HL_QD + off) = cvtpk(qd[0], qd[1]); *(LAS unsigned*)(L + HL_KD + off) = cvtpk(kd[0], kd[1]);
            *(LAS unsigned*)(L + HL_X + off) = cvtpk(xv[0], xv[1]); *(LAS unsigned*)(L + HL_QE + off) = cvtpk(qe[0], qe[1]);
        }
#pragma unroll
        for (int x = 0; x < 2; ++x) {
            unsigned pv[4];
#pragma unroll
            for (int i = 0; i < 8; i += 2) { const unsigned v0 = x ? (vw[i] >> 16) : (vw[i] & 0xffffu), v1 = x ? (vw[i + 1] >> 16) : (vw[i + 1] & 0xffffu); pv[i >> 1] = v0 | (v1 << 16); }
            *(LAS v4u*)(L + HL_KTT + (2 * l + x) * HS_T + 16 * w) = (v4u){cvtpk(ktv[x][0], ktv[x][1]), cvtpk(ktv[x][2], ktv[x][3]), cvtpk(ktv[x][4], ktv[x][5]), cvtpk(ktv[x][6], ktv[x][7])};
            *(LAS v4u*)(L + HL_VT + (2 * l + x) * HS_T + 16 * w) = (v4u){pv[0], pv[1], pv[2], pv[3]};
        }
        PS_END(0); __syncthreads(); PS_END(1);
        const size_t orow = (size_t)(b * SEQ + 256 * jt + (dir ? 255 - (64 * c + ot) : 64 * c + ot));
        bf16* optr = OUT + orow * DM + head * 128 + 16 * opart;
        v4u pf0 = (v4u){0u, 0u, 0u, 0u}, pf1 = pf0, pg0 = pf0, pg1 = pf0;
        if (dir) { pf0 = *(const v4u*)optr; pf1 = *(const v4u*)(optr + 8); const bf16* gp = P + orow * LDP + 1024 + head * 128 + 16 * opart; pg0 = *(const v4u*)gp; pg1 = *(const v4u*)(gp + 8); }
        v2u ptile[2]; int paddr[2] = {-1, -1};
#pragma unroll
        for (int rep = 0; rep < 2; ++rep) { const int tix = w + 8 * rep;
            if (tix < 10) {
                const int I = tix < 1 ? 0 : (tix < 3 ? 1 : (tix < 6 ? 2 : 3)); const int J = tix - (I * (I + 1)) / 2;
                const bool same = (I >> 1) == (J >> 1);
                const int abase = same ? HL_KD : HL_X, bbase = same ? HL_QD : HL_X;
                const BF4 af = ldfrag4(L + abase + 16 * J * HS_ND, HS_ND, l), bf = ldfrag4(L + bbase + 16 * I * HS_ND, HS_ND, l);
                f32x4 at = (f32x4){0.f, 0.f, 0.f, 0.f};
                at = MFMA16(af.k0, bf.k0, at); at = MFMA16(af.k1, bf.k1, at); at = MFMA16(af.k2, bf.k2, at); at = MFMA16(af.k3, bf.k3, at);
                const int tloc = 16 * I + c16, s0 = 16 * J + 4 * g;
                float pr[4];
#pragma unroll
                for (int r = 0; r < 4; ++r) pr[r] = (s0 + r <= tloc) ? at[r] : 0.f;
                ptile[rep].x = cvtpk(pr[0], pr[1]); ptile[rep].y = cvtpk(pr[2], pr[3]); paddr[rep] = HL_P + tloc * HS_T + s0 * 2;
            } }
        f32x4 accO[4];
        { const BF4 sf = ldfrag4(L + HL_ST + 16 * w * HS_ND, HS_ND, l);
#pragma unroll
            for (int I = 0; I < 4; ++I) accO[I] = (f32x4){0.f, 0.f, 0.f, 0.f};
#pragma unroll
            for (int ih = 0; ih < 4; ih += 2) {
                const BF4 q0 = ldfrag4(L + HL_QE + ih * 16 * HS_ND, HS_ND, l), q1 = ldfrag4(L + HL_QE + (ih + 1) * 16 * HS_ND, HS_ND, l);
                accO[ih] = MFMA16(q0.k0, sf.k0, accO[ih]); accO[ih + 1] = MFMA16(q1.k0, sf.k0, accO[ih + 1]);
                accO[ih] = MFMA16(q0.k1, sf.k1, accO[ih]); accO[ih + 1] = MFMA16(q1.k1, sf.k1, accO[ih + 1]);
                accO[ih] = MFMA16(q0.k2, sf.k2, accO[ih]); accO[ih + 1] = MFMA16(q1.k2, sf.k2, accO[ih + 1]);
                accO[ih] = MFMA16(q0.k3, sf.k3, accO[ih]); accO[ih + 1] = MFMA16(q1.k3, sf.k3, accO[ih + 1]); } }
        const BF2 vf = ldfrag2(L + HL_VT + 16 * w * HS_T, HS_T, l);
#pragma unroll
        for (int mh = 0; mh < 8; mh += 4) {
            BF2 kf[4]; f32x4 gv[4];
#pragma unroll
            for (int m = 0; m < 4; ++m) { kf[m] = ldfrag2(L + HL_KTT + 16 * (mh + m) * HS_T, HS_T, l); gv[m] = *(const LAS f32x4*)(L + HL_FAC + (16 * (mh + m) + 4 * g) * 4); }
#pragma unroll
            for (int m = 0; m < 4; ++m) accS[mh + m] = accS[mh + m] * gv[m];
#pragma unroll
            for (int m = 0; m < 4; ++m) accS[mh + m] = MFMA16(kf[m].k0, vf.k0, accS[mh + m]);
#pragma unroll
            for (int m = 0; m < 4; ++m) accS[mh + m] = MFMA16(kf[m].k1, vf.k1, accS[mh + m]);
        }
#pragma unroll
        for (int rep = 0; rep < 2; ++rep) if (paddr[rep] >= 0) *(LAS v2u*)(L + paddr[rep]) = ptile[rep];
        PS_END(2); __syncthreads(); PS_END(1);
        { const BF2 p0 = ldfrag2(L + HL_P + 0 * 16 * HS_T, HS_T, l), p1 = ldfrag2(L + HL_P + 1 * 16 * HS_T, HS_T, l), p2 = ldfrag2(L + HL_P + 2 * 16 * HS_T, HS_T, l), p3 = ldfrag2(L + HL_P + 3 * 16 * HS_T, HS_T, l);
            accO[0] = MFMA16(p0.k0, vf.k0, accO[0]); accO[1] = MFMA16(p1.k0, vf.k0, accO[1]); accO[2] = MFMA16(p2.k0, vf.k0, accO[2]); accO[3] = MFMA16(p3.k0, vf.k0, accO[3]);
            accO[0] = MFMA16(p0.k1, vf.k1, accO[0]); accO[1] = MFMA16(p1.k1, vf.k1, accO[1]); accO[2] = MFMA16(p2.k1, vf.k1, accO[2]); accO[3] = MFMA16(p3.k1, vf.k1, accO[3]); }
#pragma unroll
        for (int m = 0; m < 8; ++m) { v2u o; o.x = cvtpk(accS[m][0], accS[m][1]); o.y = cvtpk(accS[m][2], accS[m][3]); *(LAS v2u*)(L + HL_ST + (16 * w + c16) * HS_ND + (16 * m + 4 * g) * 2) = o; }
#pragma unroll
        for (int I = 0; I < 4; ++I)
#pragma unroll
            for (int r = 0; r < 4; ++r) *(LAS float*)(L + HL_OT + (16 * I + 4 * g + r) * OT_S + (16 * w + c16) * 4) = accO[I][r];
        PS_END(3); __syncthreads(); PS_END(1);
        { float ov[16];
#pragma unroll
            for (int q = 0; q < 4; ++q) { const f32x4 t4 = *(const LAS f32x4*)(L + HL_OT + ot * OT_S + (16 * opart + 4 * q) * 4); ov[4 * q] = t4.x; ov[4 * q + 1] = t4.y; ov[4 * q + 2] = t4.z; ov[4 * q + 3] = t4.w; }
            if (dir) {
                float fo[16], gt[16];
#pragma unroll
                for (int q = 0; q < 4; ++q) { fo[2 * q] = bflo(pf0[q]); fo[2 * q + 1] = bfhi(pf0[q]); fo[8 + 2 * q] = bflo(pf1[q]); fo[8 + 2 * q + 1] = bfhi(pf1[q]);
                    gt[2 * q] = bflo(pg0[q]); gt[2 * q + 1] = bfhi(pg0[q]); gt[8 + 2 * q] = bflo(pg1[q]); gt[8 + 2 * q + 1] = bfhi(pg1[q]); }
                float ss = 0.f;
#pragma unroll
                for (int i = 0; i < 16; ++i) { ov[i] += fo[i]; ss += ov[i] * ov[i]; }
                ss += __shfl_xor(ss, 1); ss += __shfl_xor(ss, 2); ss += __shfl_xor(ss, 4);
                const float rstd = __builtin_amdgcn_rsqf(ss * (1.f / 128.f) + EPSN);
#pragma unroll
                for (int q = 0; q < 4; ++q) { const f32x4 nw4 = *(const LAS f32x4*)(L + HL_NW + (16 * opart + 4 * q) * 4);
                    ov[4 * q] *= rstd * nw4.x * gt[4 * q]; ov[4 * q + 1] *= rstd * nw4.y * gt[4 * q + 1]; ov[4 * q + 2] *= rstd * nw4.z * gt[4 * q + 2]; ov[4 * q + 3] *= rstd * nw4.w * gt[4 * q + 3]; }
            }
            *(v4u*)optr = (v4u){cvtpk(ov[0], ov[1]), cvtpk(ov[2], ov[3]), cvtpk(ov[4], ov[5]), cvtpk(ov[6], ov[7])};
            *(v4u*)(optr + 8) = (v4u){cvtpk(ov[8], ov[9]), cvtpk(ov[10], ov[11]), cvtpk(ov[12], ov[13]), cvtpk(ov[14], ov[15])}; }
        PS_END(4);
    }
}

constexpr int MS = 160;
constexpr int ML_Q = 0, ML_K = ML_Q + 64 * MS, ML_KTT = ML_K + 64 * MS, ML_VT = ML_KTT + 64 * MS, ML_CT = ML_VT + 144 * MS, ML_P = ML_CT + 144 * MS;
constexpr int ML_TA = ML_P + 64 * MS;
constexpr int ML_TMU = ML_TA + 1024, ML_TIW = ML_TMU + 1024, ML_TSW = ML_TIW + 1024, ML_TEM = ML_TSW + 1024;
constexpr int ML_TRI = ML_TEM + 1024;
constexpr int ML_SC = ML_TRI + 256;
constexpr int ML_NW = ML_SC + 64;
constexpr int ML_OT = ML_NW + 512;
constexpr int ML_END = ML_OT + 64 * OT_S;
static_assert(ML_END <= 159 * 1024, "mLSTM LDS map");
constexpr size_t ML_SLOT_BYTES = 144 * 64 * 2;
constexpr float LOG2E = 1.4426950408889634f;

__device__ __forceinline__ float wave_incl_sum(float v, int lane) {
#pragma unroll
    for (int o = 1; o < 64; o <<= 1) { const float t = __shfl_up(v, o); if (lane >= o) v += t; }
    return v;
}
__device__ __forceinline__ float wave_incl_max(float v, int lane) {
#pragma unroll
    for (int o = 1; o < 64; o <<= 1) { const float t = __shfl_up(v, o); if (lane >= o) v = fmaxf(v, t); }
    return v;
}
template <bool WHOLE>
__device__ __forceinline__ float ml_scalars256(LAS unsigned char* L, const float (&ig)[4], const float (&fg)[4], float m_prev, float& bsum, int lane, int tb = 0) {
    f32x4 B, av, mu;
    { float run = 0.f;
#pragma unroll
        for (int i = 0; i < 4; ++i) { run += (fminf(fg[i], 0.f) - log1pf(__expf(-fabsf(fg[i])))) * LOG2E; B[i] = run; } }
    { const float incl = wave_incl_sum(B[3], lane); B = B + (incl - B[3]); }
#pragma unroll
    for (int i = 0; i < 4; ++i) av[i] = ig[i] * LOG2E - B[i];
    *(LAS f32x4*)(L + tb + ML_TA + lane * 16) = av;
    { float pm = av[0]; mu[0] = pm; pm = fmaxf(pm, av[1]); mu[1] = pm; pm = fmaxf(pm, av[2]); mu[2] = pm; pm = fmaxf(pm, av[3]); mu[3] = pm;
        const float inclm = wave_incl_max(pm, lane); float exm = __shfl_up(inclm, 1); if (lane == 0) exm = m_prev; exm = fmaxf(exm, m_prev);
#pragma unroll
        for (int i = 0; i < 4; ++i) mu[i] = fmaxf(mu[i], exm); }
    *(LAS f32x4*)(L + tb + ML_TMU + lane * 16) = mu;
    { f32x4 te;
#pragma unroll
        for (int i = 0; i < 4; ++i) te[i] = ex2(-(B[i] + mu[i]));
        *(LAS f32x4*)(L + tb + ML_TEM + lane * 16) = te; }
    const float b255 = __shfl(B[3], 63), mu255 = __shfl(mu[3], 63);
    const int c = lane >> 4;
    const float mu_end = WHOLE ? mu255 : __shfl(mu[3], 16 * c + 15); float mu_start = __shfl(mu[3], (16 * c + 63) & 63); if (c == 0) mu_start = m_prev;
    { f32x4 ti;
#pragma unroll
        for (int i = 0; i < 4; ++i) ti[i] = ex2(mu_start - mu[i]);
        *(LAS f32x4*)(L + tb + ML_TIW + lane * 16) = ti; }
    { f32x4 ts;
#pragma unroll
        for (int i = 0; i < 4; ++i) ts[i] = ex2(av[i] - mu_end);
        *(LAS f32x4*)(L + tb + ML_TSW + lane * 16) = ts; }
    if ((lane & 15) == 0) *(LAS float*)(L + tb + ML_SC + c * 4) = ex2(mu_start - mu_end);
    bsum = b255;
    return b255 + mu255;
}
__device__ __forceinline__ void ml_aug_rows(LAS unsigned char* L, int tid) {
    for (int i = tid; i < 16 * 8; i += NTHREADS) { const int r = i >> 3, q = i & 7; const unsigned v = r == 0 ? 0x3F803F80u : 0u; *(LAS v4u*)(L + ML_VT + (128 + r) * MS + q * 16) = (v4u){v, v, v, v}; }
}
struct MlPre { unsigned kw[8], vw[8]; v4u qn, kn; };
#define ML_LOAD_KV(R, ROWF) do { \
    if (T.tid < 256) { const int dp_ = T.tid & 31, tg_ = T.tid >> 5; _Pragma("unroll") for (int i = 0; i < 8; ++i) { const size_t row_ = (size_t)(ROWF(8 * tg_ + i)); (R).kw[i] = *(const unsigned*)(QK + row_ * 512 + 256 + head * 64 + 2 * dp_); } } \
    { const int ep_ = T.tid & 63, tg_ = T.tid >> 6; _Pragma("unroll") for (int i = 0; i < 8; ++i) { const size_t row_ = (size_t)(ROWF(8 * tg_ + i)); (R).vw[i] = *(const unsigned*)(P + row_ * LDP + 3072 + head * 128 + 2 * ep_); } } \
} while (0)
#define ML_STORE_KV(R, cch) do { \
    if (T.tid < 256) { const int dp_ = T.tid & 31, tg_ = T.tid >> 5; \
        const f32x4 s0_ = *(const LAS f32x4*)(L + ML_TSW + ((cch) * 64 + 8 * tg_) * 4), s1_ = *(const LAS f32x4*)(L + ML_TSW + ((cch) * 64 + 8 * tg_ + 4) * 4); \
        const float sw_[8] = {s0_.x, s0_.y, s0_.z, s0_.w, s1_.x, s1_.y, s1_.z, s1_.w}; \
        _Pragma("unroll") for (int x = 0; x < 2; ++x) { float kv_[8]; _Pragma("unroll") for (int i = 0; i < 8; ++i) kv_[i] = (x ? bfhi((R).kw[i]) : bflo((R).kw[i])) * sw_[i]; \
            *(LAS v4u*)(L + ML_KTT + (2 * dp_ + x) * MS + 16 * tg_) = (v4u){cvtpk(kv_[0], kv_[1]), cvtpk(kv_[2], kv_[3]), cvtpk(kv_[4], kv_[5]), cvtpk(kv_[6], kv_[7])}; } } \
    { const int ep_ = T.tid & 63, tg_ = T.tid >> 6; \
        _Pragma("unroll") for (int x = 0; x < 2; ++x) { unsigned pv_[4]; \
            _Pragma("unroll") for (int i = 0; i < 8; i += 2) { const unsigned v0_ = x ? ((R).vw[i] >> 16) : ((R).vw[i] & 0xffffu), v1_ = x ? ((R).vw[i + 1] >> 16) : ((R).vw[i + 1] & 0xffffu); pv_[i >> 1] = v0_ | (v1_ << 16); } \
            *(LAS v4u*)(L + ML_VT + (2 * ep_ + x) * MS + 16 * tg_) = (v4u){pv_[0], pv_[1], pv_[2], pv_[3]}; } } \
} while (0)

constexpr int Q1_KTT = 0, Q1_VT = Q1_KTT + 64 * P1_S, Q1_TAB = Q1_VT + 144 * P1_S;
constexpr int Q1_TB = Q1_TAB - ML_TA;
static_assert(ML_SC + Q1_TB + 64 <= 159 * 1024, "mLSTM pass-1 LDS map");
template <int DIR>
__device__ __forceinline__ void ml_p1_dir(const Args& a, const Ctx& T, int b, int head, int blk, int slot, const unsigned (&kw)[16], const float (&ig)[4], const float (&fg)[4]) {
    LAS unsigned char* L = T.lds;
    const int w = T.wave, l = T.lane, g = l >> 4, c16 = l & 15;
    float mloc = 0.f, bsum = 0.f;
    if (w == 0) mloc = ml_scalars256<true>(L, ig, fg, -1e30f, bsum, l, Q1_TB);
    __syncthreads();
    { const int dp = T.tid & 31, tg = T.tid >> 5;
        float sw[16];
#pragma unroll
        for (int q = 0; q < 4; ++q) { const int s0 = 16 * tg + 4 * q;
            const f32x4 t4 = *(const LAS f32x4*)(L + Q1_TB + ML_TSW + (DIR ? 252 - s0 : s0) * 4);
            sw[4 * q] = DIR ? t4.w : t4.x; sw[4 * q + 1] = DIR ? t4.z : t4.y; sw[4 * q + 2] = DIR ? t4.y : t4.z; sw[4 * q + 3] = DIR ? t4.x : t4.w; }
#pragma unroll
        for (int x = 0; x < 2; ++x)
#pragma unroll
            for (int q = 0; q < 2; ++q) { float kv[8];
#pragma unroll
                for (int i = 0; i < 8; ++i) kv[i] = (x ? bfhi(kw[8 * q + i]) : bflo(kw[8 * q + i])) * sw[8 * q + i];
                *(LAS v4u*)(L + Q1_KTT + (2 * dp + x) * P1_S + 32 * tg + 16 * q) = (v4u){cvtpk(kv[0], kv[1]), cvtpk(kv[2], kv[3]), cvtpk(kv[4], kv[5]), cvtpk(kv[6], kv[7])}; } }
    __syncthreads();
    f32x4 accC[4], accCA = (f32x4){0.f, 0.f, 0.f, 0.f};
#pragma unroll
    for (int m = 0; m < 4; ++m) accC[m] = (f32x4){0.f, 0.f, 0.f, 0.f};
#pragma unroll
    for (int kh = 0; kh < 4; ++kh) {
        const BF2 vf = ldfrag2(L + Q1_VT + 16 * w * P1_S + 128 * kh, P1_S, l);
        BF2 kf[4];
#pragma unroll
        for (int m = 0; m < 4; ++m) kf[m] = ldfrag2(L + Q1_KTT + 16 * m * P1_S + 128 * kh, P1_S, l);
#pragma unroll
        for (int m = 0; m < 4; ++m) accC[m] = MFMA16(kf[m].k0, vf.k0, accC[m]);
#pragma unroll
        for (int m = 0; m < 4; ++m) accC[m] = MFMA16(kf[m].k1, vf.k1, accC[m]);
        if (w < 4) { const BF2 af = ldfrag2(L + Q1_VT + 128 * P1_S + 128 * kh, P1_S, l); const BF2 kfw = ldfrag2(L + Q1_KTT + 16 * w * P1_S + 128 * kh, P1_S, l);
            accCA = MFMA16(kfw.k0, af.k0, accCA); accCA = MFMA16(kfw.k1, af.k1, accCA); } }
    const size_t sidx = hg_seq(b, DIR, head) * 16 + slot;
    bf16* CT = (bf16*)(a.ws + WS_MLST + sidx * ML_SLOT_BYTES);
#pragma unroll
    for (int m = 0; m < 4; ++m) { v2u o; o.x = cvtpk(accC[m][0], accC[m][1]); o.y = cvtpk(accC[m][2], accC[m][3]); *(v2u*)(CT + (size_t)(16 * w + c16) * 64 + 16 * m + 4 * g) = o; }
    if (w < 4) { v2u o; o.x = cvtpk(accCA[0], accCA[1]); o.y = cvtpk(accCA[2], accCA[3]); *(v2u*)(CT + (size_t)(128 + c16) * 64 + 16 * w + 4 * g) = o; }
    if (T.tid == 0) { float* sc = (float*)(a.ws + WS_MLSC) + sidx * 4; sc[0] = mloc; sc[1] = bsum; }
}
__device__ __forceinline__ void ml_pass1_items(const Args& a, const Ctx& T0, int first, int stride, int limit) {
    const bf16* P = (const bf16*)(a.ws + WS_PROJ); const bf16* QK = (const bf16*)(a.ws + WS_QK); const float* GT = (const float*)(a.ws + WS_GATES);
    __syncthreads();
    for (int i = T0.tid; i < 16 * 32; i += NTHREADS) { const int r = i >> 5, q = i & 31; const unsigned v = r == 0 ? 0x3F803F80u : 0u; *(LAS v4u*)(T0.lds + Q1_VT + (128 + r) * P1_S + q * 16) = (v4u){v, v, v, v}; }
#pragma unroll 1
    for (int item = first; item < limit; item += stride) {
        Ctx T = T0; asm volatile("" : "+v"(T.lane)); T.tid = T.wave * 64 + T.lane;
        LAS unsigned char* L = T.lds;
        const int w = T.wave, l = T.lane;
        const int k = item & 15, head = (item >> 4) & 3, b = item >> 6;
        const int blkF = k == 0 ? -1 : (k == 15 ? 0 : k), slotF = k == 0 ? 0 : (k == 15 ? 1 : k + 1);
        const int blkB = k == 0 ? -1 : (k == 15 ? 15 : k), slotB = k == 0 ? 0 : (k == 15 ? 1 : 16 - k);
#pragma unroll 1
        for (int dir = 0; dir < 2; ++dir) {
            const int blk = dir ? blkB : blkF;
            float ig[4] = {0.f, 0.f, 0.f, 0.f}, fg[4] = {0.f, 0.f, 0.f, 0.f};
            if (w == 0) {
#pragma unroll
                for (int c = 0; c < 4; ++c) { const int u = 4 * l + c; const size_t row = (size_t)p1_row(b, blk, dir ? 255 - u : u); ig[c] = GT[row * 16 + (dir ? 8 : 0) + head]; fg[c] = GT[row * 16 + (dir ? 12 : 4) + head]; } }
            unsigned kw[16];
            { const int dp = T.tid & 31, tg = T.tid >> 5;
#pragma unroll
                for (int i = 0; i < 16; ++i) kw[i] = *(const unsigned*)(QK + (size_t)p1_row(b, blk, 16 * tg + i) * 512 + 256 + head * 64 + 2 * dp); }
            __syncthreads();
            if (dir == 0 || blkB != blkF) {
                const int ep = T.tid & 63, tg = T.tid >> 6; unsigned vw[32];
#pragma unroll
                for (int i = 0; i < 32; ++i) vw[i] = *(const unsigned*)(P + (size_t)p1_row(b, blk, 32 * tg + i) * LDP + 3072 + head * 128 + 2 * ep);
#pragma unroll
                for (int x = 0; x < 2; ++x)
#pragma unroll
                    for (int q = 0; q < 4; ++q) { unsigned pv[4];
#pragma unroll
                        for (int i = 0; i < 8; i += 2) { const unsigned v0 = x ? (vw[8 * q + i] >> 16) : (vw[8 * q + i] & 0xffffu), v1 = x ? (vw[8 * q + i + 1] >> 16) : (vw[8 * q + i + 1] & 0xffffu); pv[i >> 1] = v0 | (v1 << 16); }
                        *(LAS v4u*)(L + Q1_VT + (2 * ep + x) * P1_S + 64 * tg + 16 * q) = (v4u){pv[0], pv[1], pv[2], pv[3]}; }
            }
            if (dir == 0) ml_p1_dir<0>(a, T, b, head, blk, slotF, kw, ig, fg); else ml_p1_dir<1>(a, T, b, head, blk, slotB, kw, ig, fg);
        }
    }
}

__device__ __forceinline__ void pass2_all(const Args& a, const Ctx& T) {
    const int gid = T.vcu * NTHREADS + T.tid;
    if (gid < 32 * 2048) {
        const int seq = gid >> 11, el = (gid & 2047) * 8, d0 = el & 127;
        float r[8];
#pragma unroll
        for (int i = 0; i < 8; ++i) r[i] = 0.f;
#pragma unroll 1
        for (int j0 = 0; j0 < 16; j0 += 4) {
            v4u dv[4]; f32x4 g0[4], g1[4];
#pragma unroll
            for (int jj = 0; jj < 4; ++jj) { const size_t sidx = (size_t)seq * 16 + j0 + jj; dv[jj] = *(const v4u*)(a.ws + WS_HGST + sidx * HG_SLOT_BYTES + (size_t)el * 2);
                const float* G = (const float*)(a.ws + WS_HGG) + sidx * 128 + d0; g0[jj] = *(const f32x4*)G; g1[jj] = *(const f32x4*)(G + 4); }
#pragma unroll
            for (int jj = 0; jj < 4; ++jj) { const size_t sidx = (size_t)seq * 16 + j0 + jj;
                r[0] = g0[jj].x * r[0] + bflo(dv[jj].x); r[1] = g0[jj].y * r[1] + bfhi(dv[jj].x); r[2] = g0[jj].z * r[2] + bflo(dv[jj].y); r[3] = g0[jj].w * r[3] + bfhi(dv[jj].y);
                r[4] = g1[jj].x * r[4] + bflo(dv[jj].z); r[5] = g1[jj].y * r[5] + bfhi(dv[jj].z); r[6] = g1[jj].z * r[6] + bflo(dv[jj].w); r[7] = g1[jj].w * r[7] + bfhi(dv[jj].w);
                *(v4u*)(a.ws + WS_HGST + sidx * HG_SLOT_BYTES + (size_t)el * 2) = (v4u){cvtpk(r[0], r[1]), cvtpk(r[2], r[3]), cvtpk(r[4], r[5]), cvtpk(r[6], r[7])}; }
        }
    } else if (gid < 32 * 2048 + 32 * 1152) {
        const int t2 = gid - 32 * 2048; const int seq = t2 / 1152, el = (t2 % 1152) * 8;
        float r[8], m = 0.f;
#pragma unroll
        for (int i = 0; i < 8; ++i) r[i] = 0.f;
#pragma unroll 1
        for (int j0 = 0; j0 < 16; j0 += 4) {
            v4u dv[4]; float ml[4], bt[4];
#pragma unroll
            for (int jj = 0; jj < 4; ++jj) { const size_t sidx = (size_t)seq * 16 + j0 + jj; dv[jj] = *(const v4u*)(a.ws + WS_MLST + sidx * ML_SLOT_BYTES + (size_t)el * 2);
                const float* sc = (const float*)(a.ws + WS_MLSC) + sidx * 4; ml[jj] = sc[0]; bt[jj] = sc[1]; }
#pragma unroll
            for (int jj = 0; jj < 4; ++jj) { const size_t sidx = (size_t)seq * 16 + j0 + jj;
                const float mn = fmaxf(bt[jj] + m, ml[jj]); const float cA = ex2(bt[jj] + m - mn), cB = ex2(ml[jj] - mn); m = mn;
                r[0] = cA * r[0] + cB * bflo(dv[jj].x); r[1] = cA * r[1] + cB * bfhi(dv[jj].x); r[2] = cA * r[2] + cB * bflo(dv[jj].y); r[3] = cA * r[3] + cB * bfhi(dv[jj].y);
                r[4] = cA * r[4] + cB * bflo(dv[jj].z); r[5] = cA * r[5] + cB * bfhi(dv[jj].z); r[6] = cA * r[6] + cB * bflo(dv[jj].w); r[7] = cA * r[7] + cB * bfhi(dv[jj].w);
                *(v4u*)(a.ws + WS_MLST + sidx * ML_SLOT_BYTES + (size_t)el * 2) = (v4u){cvtpk(r[0], r[1]), cvtpk(r[2], r[3]), cvtpk(r[4], r[5]), cvtpk(r[6], r[7])};
                if (el == 0) ((float*)(a.ws + WS_MLSC))[sidx * 4 + 2] = mn; }
        }
    }
}

__device__ __forceinline__ void ml_pass3_item(const Args& a, const Ctx& T0, int item, bf16* OUT) {
    const int jt = item & 15, head = (item >> 4) & 3, b = item >> 6;
    const bf16* P = (const bf16*)(a.ws + WS_PROJ); const bf16* QK = (const bf16*)(a.ws + WS_QK); const float* GT = (const float*)(a.ws + WS_GATES);
    Ctx T = T0; asm volatile("" : "+v"(T.lane));
    T.tid = T.wave * 64 + T.lane;
    LAS unsigned char* L = T.lds;
    const int w = T.wave, l = T.lane, g = l >> 4, c16 = l & 15;
    __syncthreads();
    for (int i = T.tid; i < 64 * MS / 16; i += NTHREADS) *(LAS v4u*)(L + ML_P + i * 16) = (v4u){0u, 0u, 0u, 0u};
    ml_aug_rows(L, T.tid);
    if (T.tid < 128) *(LAS float*)(L + ML_NW + T.tid * 4) = a.in[I_MLNW][head * 128 + T.tid];
#define ML_ROW3(st_, lt_) (b * SEQ + 256 * jt + (((st_) >> 2) ? 255 - (64 * ((st_) & 3) + (lt_)) : 64 * ((st_) & 3) + (lt_)))
    MlPre R;
    const int qt = T.tid >> 3, qpart = T.tid & 7;
#define ML_LOAD_ALL(st_) do { ML_LOAD_KV(R, ROWF_); const size_t rq_ = (size_t)ML_ROW3((st_), qt); R.qn = *(const v4u*)(QK + rq_ * 512 + head * 64 + qpart * 8); R.kn = *(const v4u*)(QK + rq_ * 512 + 256 + head * 64 + qpart * 8); } while (0)
#define ROWF_(x_) ML_ROW3(0, (x_))
    ML_LOAD_ALL(0);
#undef ROWF_
    f32x4 accC[4], accCA = (f32x4){0.f, 0.f, 0.f, 0.f};
    v4u stq[2], sta[2];
#define ML_STATE_LOAD(dir_) do { const size_t sidx_ = hg_seq(b, (dir_), head) * 16 + ((dir_) ? 15 - jt : jt); const bf16* CTg_ = (const bf16*)(a.ws + WS_MLST + sidx_ * ML_SLOT_BYTES); \
        _Pragma("unroll") for (int q_ = 0; q_ < 2; ++q_) { const int idx_ = l + 64 * q_; stq[q_] = *(const v4u*)(CTg_ + (size_t)(16 * w + (idx_ >> 3)) * 64 + (idx_ & 7) * 8); \
            if (w == 4) sta[q_] = *(const v4u*)(CTg_ + (size_t)(128 + (idx_ >> 3)) * 64 + (idx_ & 7) * 8); } } while (0)
    ML_STATE_LOAD(0);
#pragma unroll 1
    for (int step = 0; step < 8; ++step) {
        const int dir = step >> 2, c = step & 3;
        PS_BEGIN();
        if (c == 0) {
            const size_t sidx = hg_seq(b, dir, head) * 16 + (dir ? 15 - jt : jt);
            if (dir == 1) { ML_STATE_LOAD(1); VM_WAIT(); __syncthreads(); if (w == 0) { __builtin_amdgcn_fence(__ATOMIC_ACQUIRE, "agent"); VM_WAIT(); } }
            __syncthreads();
#pragma unroll
            for (int q = 0; q < 2; ++q) { const int idx = l + 64 * q; *(LAS v4u*)(L + ML_CT + (16 * w + (idx >> 3)) * MS + (idx & 7) * 16) = stq[q];
                if (w == 4) *(LAS v4u*)(L + ML_CT + (128 + (idx >> 3)) * MS + (idx & 7) * 16) = sta[q]; }
            if (w == 0) { float ig[4], fg[4];
#pragma unroll
                for (int cc = 0; cc < 4; ++cc) { const int lt = 4 * l + cc; const size_t row = (size_t)ML_ROW3(4 * dir + (lt >> 6), lt & 63); ig[cc] = GT[row * 16 + (dir ? 8 : 0) + head]; fg[cc] = GT[row * 16 + (dir ? 12 : 4) + head]; }
                float bsum = 0.f; const float m0 = ((const float*)(a.ws + WS_MLSC))[sidx * 4 + 2]; (void)ml_scalars256<false>(L, ig, fg, m0, bsum, l); }
            __syncthreads();
#pragma unroll
            for (int m = 0; m < 4; ++m) { const v2u sv = *(const LAS v2u*)(L + ML_CT + (16 * w + c16) * MS + (16 * m + 4 * g) * 2); accC[m] = (f32x4){bflo(sv.x), bfhi(sv.x), bflo(sv.y), bfhi(sv.y)}; }
            if (w < 4) { const v2u sv = *(const LAS v2u*)(L + ML_CT + (128 + c16) * MS + (16 * w + 4 * g) * 2); accCA = (f32x4){bflo(sv.x), bfhi(sv.x), bflo(sv.y), bfhi(sv.y)}; }
        }
        PS_END(5);
        *(LAS v4u*)(L + ML_Q + qt * MS + qpart * 16) = R.qn; *(LAS v4u*)(L + ML_K + qt * MS + qpart * 16) = R.kn;
        ML_STORE_KV(R, c);
        if (step < 7) {
#define ROWF_(x_) ML_ROW3(step + 1, (x_))
            ML_LOAD_ALL(step + 1);
#undef ROWF_
        }
        PS_END(6); __syncthreads(); PS_END(10);
        const size_t orow = (size_t)ML_ROW3(step, qt);
        bf16* optr = OUT + orow * DM + 512 + head * 128 + 16 * qpart;
        v2u ptile[2]; int paddr[2] = {-1, -1};
#pragma unroll 1
        for (int rep = 0; rep < 2; ++rep) { const int tix = w + 8 * rep;
            if (tix < 10) {
                const int I = tix < 1 ? 0 : (tix < 3 ? 1 : (tix < 6 ? 2 : 3)); const int J = tix - (I * (I + 1)) / 2;
                const BF2 af = ldfrag2(L + ML_K + 16 * J * MS, MS, l), bf = ldfrag2(L + ML_Q + 16 * I * MS, MS, l);
                const int tloc = 16 * I + c16, s0 = 16 * J + 4 * g;
                const f32x4 av = *(const LAS f32x4*)(L + ML_TA + (c * 64 + s0) * 4); const float mu = *(const LAS float*)(L + ML_TMU + (c * 64 + tloc) * 4);
                f32x4 at = (f32x4){0.f, 0.f, 0.f, 0.f};
                at = MFMA16(af.k0, bf.k0, at); at = MFMA16(af.k1, bf.k1, at);
                float pr[4];
#pragma unroll
                for (int r = 0; r < 4; ++r) pr[r] = (s0 + r <= tloc) ? at[r] * ex2(av[r] - mu) : 0.f;
                ptile[rep].x = cvtpk(pr[0], pr[1]); ptile[rep].y = cvtpk(pr[2], pr[3]); paddr[rep] = ML_P + tloc * MS + s0 * 2;
            } }
        f32x4 accO[4], accOA = (f32x4){0.f, 0.f, 0.f, 0.f};
        const float carry = *(const LAS float*)(L + ML_SC + c * 4);
        const BF2 vf = ldfrag2(L + ML_VT + 16 * w * MS, MS, l);
        { const BF2 cf = ldfrag2(L + ML_CT + 16 * w * MS, MS, l);
            const BF2 q0 = ldfrag2(L + ML_Q + 0 * 16 * MS, MS, l), q1 = ldfrag2(L + ML_Q + 1 * 16 * MS, MS, l), q2 = ldfrag2(L + ML_Q + 2 * 16 * MS, MS, l), q3 = ldfrag2(L + ML_Q + 3 * 16 * MS, MS, l);
#pragma unroll
            for (int I = 0; I < 4; ++I) accO[I] = (f32x4){0.f, 0.f, 0.f, 0.f};
            accO[0] = MFMA16(q0.k0, cf.k0, accO[0]); accO[1] = MFMA16(q1.k0, cf.k0, accO[1]); accO[2] = MFMA16(q2.k0, cf.k0, accO[2]); accO[3] = MFMA16(q3.k0, cf.k0, accO[3]);
            accO[0] = MFMA16(q0.k1, cf.k1, accO[0]); accO[1] = MFMA16(q1.k1, cf.k1, accO[1]); accO[2] = MFMA16(q2.k1, cf.k1, accO[2]); accO[3] = MFMA16(q3.k1, cf.k1, accO[3]); }
        { const BF2 k0f = ldfrag2(L + ML_KTT + 0 * 16 * MS, MS, l), k1f = ldfrag2(L + ML_KTT + 1 * 16 * MS, MS, l), k2f = ldfrag2(L + ML_KTT + 2 * 16 * MS, MS, l), k3f = ldfrag2(L + ML_KTT + 3 * 16 * MS, MS, l);
#pragma unroll
            for (int I = 0; I < 4; ++I) accC[I] = accC[I] * carry;
            accC[0] = MFMA16(k0f.k0, vf.k0, accC[0]); accC[1] = MFMA16(k1f.k0, vf.k0, accC[1]); accC[2] = MFMA16(k2f.k0, vf.k0, accC[2]); accC[3] = MFMA16(k3f.k0, vf.k0, accC[3]);
            accC[0] = MFMA16(k0f.k1, vf.k1, accC[0]); accC[1] = MFMA16(k1f.k1, vf.k1, accC[1]); accC[2] = MFMA16(k2f.k1, vf.k1, accC[2]); accC[3] = MFMA16(k3f.k1, vf.k1, accC[3]); }
#pragma unroll
        for (int I = 0; I < 4; ++I) { const f32x4 iw = *(const LAS f32x4*)(L + ML_TIW + (c * 64 + 16 * I + 4 * g) * 4); accO[I] = accO[I] * iw; }
        BF2 af = vf;
        if (w < 4) { const BF2 cfa = ldfrag2(L + ML_CT + 128 * MS, MS, l), qw_ = ldfrag2(L + ML_Q + 16 * w * MS, MS, l), kw_ = ldfrag2(L + ML_KTT + 16 * w * MS, MS, l);
            af = ldfrag2(L + ML_VT + 128 * MS, MS, l);
            const f32x4 iwa = *(const LAS f32x4*)(L + ML_TIW + (c * 64 + 16 * w + 4 * g) * 4);
            accCA = accCA * carry;
            accOA = MFMA16(qw_.k0, cfa.k0, accOA); accCA = MFMA16(kw_.k0, af.k0, accCA); accOA = MFMA16(qw_.k1, cfa.k1, accOA); accCA = MFMA16(kw_.k1, af.k1, accCA);
            accOA = accOA * iwa; }
#pragma unroll
        for (int rep = 0; rep < 2; ++rep) if (paddr[rep] >= 0) *(LAS v2u*)(L + paddr[rep]) = ptile[rep];
        v4u pf0 = (v4u){0u, 0u, 0u, 0u}, pf1 = pf0, pg0 = pf0, pg1 = pf0;
        if (dir) { pf0 = *(const v4u*)optr; pf1 = *(const v4u*)(optr + 8); const bf16* gp = P + orow * LDP + 3584 + head * 128 + 16 * qpart; pg0 = *(const v4u*)gp; pg1 = *(const v4u*)(gp + 8); }
        PS_END(7); __syncthreads(); PS_END(10);
        { const BF2 p0 = ldfrag2(L + ML_P + 0 * 16 * MS, MS, l), p1 = ldfrag2(L + ML_P + 1 * 16 * MS, MS, l), p2 = ldfrag2(L + ML_P + 2 * 16 * MS, MS, l), p3 = ldfrag2(L + ML_P + 3 * 16 * MS, MS, l);
            accO[0] = MFMA16(p0.k0, vf.k0, accO[0]); accO[1] = MFMA16(p1.k0, vf.k0, accO[1]); accO[2] = MFMA16(p2.k0, vf.k0, accO[2]); accO[3] = MFMA16(p3.k0, vf.k0, accO[3]);
            accO[0] = MFMA16(p0.k1, vf.k1, accO[0]); accO[1] = MFMA16(p1.k1, vf.k1, accO[1]); accO[2] = MFMA16(p2.k1, vf.k1, accO[2]); accO[3] = MFMA16(p3.k1, vf.k1, accO[3]);
            if (w < 4) { const BF2 pw_ = ldfrag2(L + ML_P + 16 * w * MS, MS, l); accOA = MFMA16(pw_.k0, af.k0, accOA); accOA = MFMA16(pw_.k1, af.k1, accOA); } }
#pragma unroll
        for (int m = 0; m < 4; ++m) { v2u o; o.x = cvtpk(accC[m][0], accC[m][1]); o.y = cvtpk(accC[m][2], accC[m][3]); *(LAS v2u*)(L + ML_CT + (16 * w + c16) * MS + (16 * m + 4 * g) * 2) = o; }
        if (w < 4) { v2u o; o.x = cvtpk(accCA[0], accCA[1]); o.y = cvtpk(accCA[2], accCA[3]); *(LAS v2u*)(L + ML_CT + (128 + c16) * MS + (16 * w + 4 * g) * 2) = o;
            if (c16 == 0) { const f32x4 em = *(const LAS f32x4*)(L + ML_TEM + (c * 64 + 16 * w + 4 * g) * 4); f32x4 ri;
#pragma unroll
                for (int r = 0; r < 4; ++r) ri[r] = __builtin_amdgcn_rcpf(fmaxf(fabsf(accOA[r]), em[r]));
                *(LAS f32x4*)(L + ML_TRI + (16 * w + 4 * g) * 4) = ri; } }
#pragma unroll
        for (int I = 0; I < 4; ++I)
#pragma unroll
            for (int r = 0; r < 4; ++r) *(LAS float*)(L + ML_OT + (16 * I + 4 * g + r) * OT_S + (16 * w + c16) * 4) = accO[I][r];
        PS_END(8); __syncthreads(); PS_END(10);
        { float ov[16]; const float ri = *(const LAS float*)(L + ML_TRI + qt * 4);
#pragma unroll
            for (int q = 0; q < 4; ++q) { const f32x4 t4 = *(const LAS f32x4*)(L + ML_OT + qt * OT_S + (16 * qpart + 4 * q) * 4); ov[4 * q] = t4.x * ri; ov[4 * q + 1] = t4.y * ri; ov[4 * q + 2] = t4.z * ri; ov[4 * q + 3] = t4.w * ri; }
            if (dir) {
                float fo[16], gt[16];
#pragma unroll
                for (int q = 0; q < 4; ++q) { fo[2 * q] = bflo(pf0[q]); fo[2 * q + 1] = bfhi(pf0[q]); fo[8 + 2 * q] = bflo(pf1[q]); fo[8 + 2 * q + 1] = bfhi(pf1[q]);
                    gt[2 * q] = bflo(pg0[q]); gt[2 * q + 1] = bfhi(pg0[q]); gt[8 + 2 * q] = bflo(pg1[q]); gt[8 + 2 * q + 1] = bfhi(pg1[q]); }
                float ss = 0.f;
#pragma unroll
                for (int i = 0; i < 16; ++i) { ov[i] += fo[i]; ss += ov[i] * ov[i]; }
                ss += __shfl_xor(ss, 1); ss += __shfl_xor(ss, 2); ss += __shfl_xor(ss, 4);
                const float rstd = __builtin_amdgcn_rsqf(ss * (1.f / 128.f) + EPSN);
#pragma unroll
                for (int q = 0; q < 4; ++q) { const f32x4 nw4 = *(const LAS f32x4*)(L + ML_NW + (16 * qpart + 4 * q) * 4);
                    ov[4 * q] *= rstd * nw4.x * gt[4 * q]; ov[4 * q + 1] *= rstd * nw4.y * gt[4 * q + 1]; ov[4 * q + 2] *= rstd * nw4.z * gt[4 * q + 2]; ov[4 * q + 3] *= rstd * nw4.w * gt[4 * q + 3]; }
            }
            *(v4u*)optr = (v4u){cvtpk(ov[0], ov[1]), cvtpk(ov[2], ov[3]), cvtpk(ov[4], ov[5]), cvtpk(ov[6], ov[7])};
            *(v4u*)(optr + 8) = (v4u){cvtpk(ov[8], ov[9]), cvtpk(ov[10], ov[11]), cvtpk(ov[12], ov[13]), cvtpk(ov[14], ov[15])}; }
        PS_END(9);
    }
#undef ML_ROW3
#undef ML_LOAD_ALL
#undef ML_STATE_LOAD
}
__device__ __forceinline__ void final_norm_phase(const Args& a, const Ctx& T, const bf16* X3) {
    f32x4 wv[4];
#pragma unroll
    for (int j = 0; j < 4; ++j) wv[j] = *((const f32x4*)a.in[I_FNW] + T.lane + 64 * j);
    f32x4 v[4];
    if (T.gw < MLAT) norm_load_row(v, X3, true, nullptr, T.gw, T.lane);
    for (int m = T.gw; m < MLAT; m += T.NGW) {
        f32x4 cur[4]; float s = 0.f;
#pragma unroll
        for (int j = 0; j < 4; ++j) { cur[j] = v[j]; s += (v[j].x * v[j].x + v[j].y * v[j].y) + (v[j].z * v[j].z + v[j].w * v[j].w); }
        { const int mn = m + T.NGW; if (mn < MLAT) norm_load_row(v, X3, true, nullptr, mn, T.lane); }
        const float rstd = __builtin_amdgcn_rsqf(wave_sum(s) * (1.f / DM) + EPSN);
        f32x4* xr = (f32x4*)(a.out + (size_t)m * DM) + T.lane;
#pragma unroll
        for (int j = 0; j < 4; ++j) xr[64 * j] = cur[j] * rstd * wv[j];
    }
}

__device__ __forceinline__ void gates_phase(const Args& a, const Ctx& T) {
    const bf16* XNc = (const bf16*)(a.ws + WS_XN); const bf16* WG = (const bf16*)(a.ws + WS_WG); float* GT = (float*)(a.ws + WS_GATES);
    const int l = T.lane, r = l & 15, g = l >> 4;
    const float bias = a.in[I_MLGB][r];
    for (int rg = T.gw; rg < MALL / 16; rg += T.NGW) {
        f32x4 acc = (f32x4){0.f, 0.f, 0.f, 0.f};
        const bf16* pa = XNc + (size_t)(16 * rg + r) * DM + 8 * g; const bf16* pb = WG + (size_t)r * DM + 8 * g;
#pragma unroll 8
        for (int ks = 0; ks < 32; ++ks) { const bf16x8 av = *(const bf16x8*)(pa + ks * 32); const bf16x8 bv = *(const bf16x8*)(pb + ks * 32); acc = MFMA16(av, bv, acc); }
#pragma unroll
        for (int q = 0; q < 4; ++q) GT[(size_t)(16 * rg + 4 * g + q) * 16 + r] = acc[q] + bias;
    }
}

__global__ void __launch_bounds__(NTHREADS, 2) fwd_kernel(Args a) {
    extern __shared__ __attribute__((aligned(16))) unsigned char lds_raw[];
    Ctx T;
    T.lds = (LAS unsigned char*)lds_raw;
    T.tid = threadIdx.x; T.lane = T.tid & 63; T.wave = __builtin_amdgcn_readfirstlane(T.tid >> 6);
    T.G = gridDim.x; { const int bx = blockIdx.x; T.vcu = (T.G % 8 == 0) ? (bx % 8) * (T.G / 8) + bx / 8 : bx; }
    T.gw = T.vcu * NWAVES + T.wave; T.NGW = T.G * NWAVES;
    volatile LAS unsigned* MISC = (volatile LAS unsigned*)(T.lds + MISC_OFF);
    for (int u = T.tid; u < (LDS_BYTES - LDSCTL_OFF) / 4; u += NTHREADS) ((LAS unsigned*)(T.lds + LDSCTL_OFF))[u] = 0u;
    __syncthreads();
    XcdBarrier bar; bar.bar = (unsigned*)(a.ws + WS_CTL) + CW_BAR; bar.x = 0; bar.st = nullptr;
    const bool multi = (a.ph_hi - a.ph_lo) > 1;
    if (multi) bar = xcd_barrier_post((unsigned*)(a.ws + WS_CTL) + CW_BAR, MISC + 8);
    const int lo = a.ph_lo, hi = a.ph_hi;
#ifndef REP_MASK
#define REP_MASK 0
#endif
#define IN(k) (lo <= (k) && (k) < hi)
#ifndef PROF_K
#define PROF_K -1
#endif
#define STAMP(k) do { if (PROF_K >= 0 && ((k) == PROF_K || (k) == PROF_K + 1) && blockIdx.x == 0 && T.tid == 0) { const unsigned long long t_ = __builtin_amdgcn_s_memrealtime(); MISC[16 + 2 * ((k) - PROF_K)] = (unsigned)t_; MISC[17 + 2 * ((k) - PROF_K)] = (unsigned)(t_ >> 32); } } while (0)
#define REPS(k) for (int rep_ = 0; rep_ < (((REP_MASK >> (k)) & 1) ? 2 : 1); ++rep_)
#if (REP_MASK >> 18) & 1
#define SEAM(k) do { if (IN(k) && IN((k) + 1)) { xcd_barrier(bar); xcd_barrier(bar); } } while (0)
#else
#define SEAM(k) do { if (IN(k) && IN((k) + 1)) xcd_barrier(bar); STAMP((k) + 1); } while (0)
#endif
    bf16* XN = (bf16*)(a.ws + WS_XN); bf16* HB = (bf16*)(a.ws + WS_PROJ); bf16* PROJ = (bf16*)(a.ws + WS_PROJ);
    const float* mods = (const float*)(a.ws + WS_MODS);
    bf16* XB1 = (bf16*)a.out; bf16* XB2 = (bf16*)a.out + (size_t)MLAT * DM; bf16* XB3 = (bf16*)(a.ws + WS_PROJ + 96 * MiB);
    const int bx = (int)blockIdx.x;

    STAMP(0);
    if (IN(0)) REPS(0) { mods_phase(a, T); convert_ffn(a, T, a.in[I_F1W1], a.in[I_F1W2]); convert_mix(a, T);
        if (T.tid < 64) { const int e = bx * 64 + T.tid; if (e < 16384) { const int q = e >> 10, k = e & 1023; ((bf16*)(a.ws + WS_WG))[q * 1024 + k] = (bf16)f2bf(a.in[I_WIN][(size_t)k * DIN + NPROJ + q]); } } }
    SEAM(0);
    if (IN(1)) norm_mod_rows<false, false>(a, T, a.in[I_X], a.in[I_CTX], MALL, a.in[I_N1W], 0, 1);
    SEAM(1);
    if (IN(2)) REPS(2) { pg8::Gemm g{XN, (const bf16*)(a.ws + WS_W1), MALL, 2 * DFF, DM, DM}; pg8::StaticOrder S; S.init(MALL, 2 * DFF, T.G, bx);
        pg8::EpiSwiglu E{HB, DFF}; pg8::gemm_phase<pg8::EpiSwiglu, pg8::StaticOrder, true, true>(T.lds, g, S, E); }
    SEAM(2);
    if (IN(3)) { pg8::Gemm g{HB, (const bf16*)(a.ws + WS_W2), MALL, DM, DFF, DFF}; pg8::DownOrder S; S.lat.init(MLAT, DM, T.G, bx); S.c = bx;
        pg8::EpiDown1 E{a.in[I_X], XB1, mods + 2 * 1024, 0.5f, (float*)(a.ws + WS_SLAB)}; pg8::gemm_phase<pg8::EpiDown1, pg8::DownOrder, true, true>(T.lds, g, S, E); }
    SEAM(3);
    if (IN(4)) REPS(4) { norm_mod_rows<true, true>(a, T, XB1, a.in[I_CTX], MALL, a.in[I_N2W], 3, 4); convert_ffn(a, T, a.in[I_F2W1], a.in[I_F2W2]); }
    SEAM(4);
    if (IN(5)) { pg8::Gemm g{XN, (const bf16*)(a.ws + WS_WIN), MALL, NPROJ, DM, DM}; pg8::ProjOrder S; S.lat.init(MLAT, NPROJ, T.G, bx); S.c = bx;
        pg8::EpiProjAll E{{PROJ, LDP}, (bf16*)(a.ws + WS_SLAB2)}; pg8::gemm_phase<pg8::EpiProjAll, pg8::ProjOrder, true, true>(T.lds, g, S, E); }
    SEAM(5);
    if (IN(6)) { gates_phase(a, T); ctx_combine(a, T); conv_phase(a, T); }
    SEAM(6);
    if (IN(7)) REPS(7) { hg_pass1_items(a, T, T.vcu, T.G, 256); ml_pass1_items(a, T, T.vcu, T.G, 256); }
    SEAM(7);
    if (IN(8)) pass2_all(a, T);
    SEAM(8);
    if (IN(9)) REPS(9) { for (int it = T.vcu; it < 256; it += T.G) hg_pass3_item(a, T, it, XN); for (int it = T.vcu; it < 256; it += T.G) ml_pass3_item(a, T, it, XN); }
    SEAM(9);
    if (IN(10)) { pg8::Gemm g{XN, (const bf16*)(a.ws + WS_WOUT), MLAT, DM, DM, DM}; pg8::StaticOrder S; S.init(MLAT, DM, T.G, bx);
        pg8::EpiResidB<true> E{XB1, XB2, mods + 5 * 1024, 1.0f}; pg8::gemm_phase<pg8::EpiResidB<true>, pg8::StaticOrder, true, true>(T.lds, g, S, E); }
    SEAM(10);
    if (IN(11)) REPS(11) norm_mod_rows<false, true>(a, T, XB2, nullptr, MLAT, a.in[I_N3W], 6, 7);
    SEAM(11);
    if (IN(12)) REPS(12) { pg8::Gemm g{XN, (const bf16*)(a.ws + WS_W1), MLAT, 2 * DFF, DM, DM}; pg8::StaticOrder S; S.init(MLAT, 2 * DFF, T.G, bx);
        pg8::EpiSwiglu E{HB, DFF}; pg8::gemm_phase<pg8::EpiSwiglu, pg8::StaticOrder, true, true>(T.lds, g, S, E); }
    SEAM(12);
    if (IN(13)) { pg8::Gemm g{HB, (const bf16*)(a.ws + WS_W2), MLAT, DM, DFF, DFF}; pg8::StaticOrder S; S.init(MLAT, DM, T.G, bx);
        pg8::EpiResidB<true> E{XB2, XB3, mods + 8 * 1024, 0.5f}; pg8::gemm_phase<pg8::EpiResidB<true>, pg8::StaticOrder, true, true>(T.lds, g, S, E); }
    SEAM(13);
    if (IN(14)) final_norm_phase(a, T, XB3);
    STAMP(15);
    if (PROF_S >= 0 && blockIdx.x == 0 && T.tid == 0) { const unsigned long long dt_ = ((((unsigned long long)MISC[23]) << 32) | MISC[22]) * 8ull, te_ = __builtin_amdgcn_s_memrealtime(); while (__builtin_amdgcn_s_memrealtime() - te_ < dt_) __builtin_amdgcn_s_sleep(8); }
    if (PROF_K >= 0 && blockIdx.x == 0 && T.tid == 0) { const unsigned long long t0_ = ((unsigned long long)MISC[17] << 32) | MISC[16], t1_ = ((unsigned long long)MISC[19] << 32) | MISC[18];
        const unsigned long long dt_ = (t1_ - t0_) * 8ull, te_ = __builtin_amdgcn_s_memrealtime(); while (__builtin_amdgcn_s_memrealtime() - te_ < dt_) __builtin_amdgcn_s_sleep(8); }
#undef IN
#undef SEAM
}

extern "C" void kernel_launch(void* const* d_in, const int* in_sizes, int n_in, void* d_out, int out_size, void* d_ws, size_t ws_size, hipStream_t stream) {
    static int grid = 0;
    if (grid == 0) {
        if (n_in != 22 || out_size != MLAT * DM || ws_size < WS_END) { fprintf(stderr, "kernel_launch: unexpected shapes (n_in %d out %d ws %zu)\n", n_in, out_size, ws_size); grid = -1; return; }
        int dev = 0, cus = 0;
        if (hipGetDevice(&dev) != hipSuccess || hipDeviceGetAttribute(&cus, hipDeviceAttributeMultiprocessorCount, dev) != hipSuccess) { grid = -1; return; }
        if (hipFuncSetAttribute((const void*)fwd_kernel, hipFuncAttributeMaxDynamicSharedMemorySize, LDS_BYTES) != hipSuccess) { fprintf(stderr, "kernel_launch: hipFuncSetAttribute failed\n"); grid = -1; return; }
        (void)hipGetLastError();
        grid = cus;
    }
    if (grid < 0) return;
    (void)hipMemsetAsync((char*)d_ws + WS_CTL, 0, CTL_ZERO_BYTES, stream);
    (void)hipMemsetAsync((char*)d_ws + WS_MODS, 0, 5 * NMODC * sizeof(float), stream);
    Args a{};
    for (int i = 0; i < 22; ++i) a.in[i] = (const float*)d_in[i];
    a.out = (float*)d_out; a.ws = (unsigned char*)d_ws;
#if ONE_LAUNCH
    a.ph_lo = 0; a.ph_hi = NPHASES;
    hipLaunchKernelGGL(fwd_kernel, dim3(grid), dim3(NTHREADS), LDS_BYTES, stream, a);
#else
    for (int p = 0; p < NPHASES; ++p) { a.ph_lo = p; a.ph_hi = p + 1; hipLaunchKernelGGL(fwd_kernel, dim3(grid), dim3(NTHREADS), LDS_BYTES, stream, a); }
#endif
}
```

```cpp
#include <hip/hip_runtime.h>
#include <cstdio>
#include <cstdint>
#ifndef PROF_S
#define PROF_S -1
#endif
#define PG8_PS_BEGIN() do { if (PROF_S == 20 && blockIdx.x == 0 && threadIdx.x == 0) { const unsigned long long t_ = __builtin_amdgcn_s_memrealtime(); volatile __attribute__((address_space(3))) unsigned* M_ = (volatile __attribute__((address_space(3))) unsigned*)(lds + 162816 + 320); M_[20] = (unsigned)t_; M_[21] = (unsigned)(t_ >> 32); } } while (0)
#define PG8_PS_END() do { if (PROF_S == 20 && blockIdx.x == 0 && threadIdx.x == 0) { const unsigned long long t_ = __builtin_amdgcn_s_memrealtime(); volatile __attribute__((address_space(3))) unsigned* M_ = (volatile __attribute__((address_space(3))) unsigned*)(lds + 162816 + 320); \
    const unsigned long long p_ = ((unsigned long long)M_[21] << 32) | M_[20]; const unsigned long long a_ = (((unsigned long long)M_[23] << 32) | M_[22]) + (t_ - p_); M_[22] = (unsigned)a_; M_[23] = (unsigned)(a_ >> 32); } } while (0)
namespace pg8 {
#define PG8_LAS __attribute__((address_space(3)))
typedef unsigned short bf16_t;
typedef short bf16x8 __attribute__((ext_vector_type(8)));
typedef float f32x4 __attribute__((ext_vector_type(4)));
typedef unsigned u32x4 __attribute__((ext_vector_type(4)));
constexpr int BM = 256, BK = 64, HALF = 128, HTB = HALF * BK * 2  , STAGE_BYTES = 8 * HTB, NXCD = 8, WGM = 8;

__host__ __device__ __forceinline__ int lds_byte(int r, int c) { const int st = (r >> 4) * 2 + (c >> 5), rr = r & 15, cc = c & 31, ob = rr * 64 + cc * 2; return st * 1024 + (ob ^ (((ob >> 9) & 1) << 5)); }
__host__ __device__ __forceinline__ void stage_rc(int b, int& R, int& C) { const int st = b / 1024, sb = b % 1024, swz = sb ^ (((sb >> 9) & 1) << 5); R = (st >> 1) * 16 + swz / 64; C = (st & 1) * 32 + (swz % 64) / 2; }
__host__ __device__ __forceinline__ int perm32(int rho) { const int n = rho >> 4, i = rho & 15; return 8 * (i >> 2) + 4 * n + (i & 3); }

struct Unit { int pm, pn, kofs, kt; };
struct Gemm { const bf16_t* A; const bf16_t* Bt; int M, N, K, ld; };

struct StaticOrder {
    int nM, nN, nwg, G, c;
    __host__ __device__ void init(int M, int N, int G_, int c_) { nM = M / BM; nN = N / BM; nwg = nM * nN; G = G_; c = c_; }
    __host__ __device__ bool next(int i, Unit& u) const {
        const long L = (long)i * G + c; if (L >= nwg) return false;
        int wgid = (int)L; { const int q = nwg / NXCD, r = nwg % NXCD, xcd = wgid % NXCD, off = wgid / NXCD; wgid = (xcd < r ? xcd * (q + 1) : r * (q + 1) + (xcd - r) * q) + off; }
        const int nig = WGM * nN, gid = wgid / nig, fm = gid * WGM, gsz = (nM - fm) < WGM ? (nM - fm) : WGM;
        u.pm = fm + ((wgid % nig) % gsz); u.pn = (wgid % nig) / gsz; u.kofs = 0; u.kt = 0; return true;
    }
    __device__ __forceinline__ void a_ready(const Unit&) const {}
    __device__ __forceinline__ void done(const Unit&) const {}
};
__device__ __forceinline__ unsigned cvt_pk_bf16(float lo, float hi) { unsigned r; asm volatile("v_cvt_pk_bf16_f32 %0, %1, %2" : "=v"(r) : "v"(lo), "v"(hi)); return r; }
typedef float f32x2 __attribute__((ext_vector_type(2)));
__device__ __forceinline__ float fast_sigmoid(float v) { return __builtin_amdgcn_rcpf(1.0f + __builtin_amdgcn_exp2f(-1.4426950408889634f * v)); }
__device__ __forceinline__ float fast_silu(float v) { return v * fast_sigmoid(v); }

struct EpiSwiglu {
    static constexpr bool PERM = true, AFTER_DRAIN = false;
    bf16_t* H; int ldh;
    __device__ __forceinline__ void operator()(const f32x4 (&acc)[2][2][4][2], const Unit& u, int wr, int wc, int fr, int fq) const {
        typedef float f2 __attribute__((ext_vector_type(2)));
        const int row0 = u.pm * BM + wr * 64 + fr, col0 = u.pn * HALF + wc * 32 + 8 * fq;
#pragma unroll
        for (int ai = 0; ai < 2; ++ai)
#pragma unroll
            for (int m = 0; m < 4; ++m) { bf16_t* rowp = H + (size_t)(row0 + ai * HALF + m * 16) * ldh + col0;
                unsigned wv[4];
#pragma unroll
                for (int n = 0; n < 2; ++n)
#pragma unroll
                    for (int h = 0; h < 2; ++h) {
                        const f2 g = {acc[ai][0][m][n][2 * h], acc[ai][0][m][n][2 * h + 1]}, uu = {acc[ai][1][m][n][2 * h], acc[ai][1][m][n][2 * h + 1]};
                        const f2 x = g * (-1.4426950408889634f);
                        f2 d; d.x = __builtin_amdgcn_exp2f(x.x); d.y = __builtin_amdgcn_exp2f(x.y); d = d + 1.0f;
                        f2 r; r.x = __builtin_amdgcn_rcpf(d.x); r.y = __builtin_amdgcn_rcpf(d.y);
                        const f2 o = (g * uu) * r;
                        wv[n * 2 + h] = cvt_pk_bf16(o.x, o.y); }
                u32x4 w; w.x = wv[0]; w.y = wv[1]; w.z = wv[2]; w.w = wv[3];
                *(u32x4*)rowp = w; }
    }
};

struct EpiResid {
    static constexpr bool PERM = false, AFTER_DRAIN = false;
    const float* base_lat; const float* base_ctx; float* out_lat; float* out_ctx; const float* gate; float coef;
    __device__ __forceinline__ void operator()(const f32x4 (&acc)[2][2][4][2], const Unit& u, int wr, int wc, int fr, int fq) const {
        const bool isctx = u.pm >= 64;
        const float* base = isctx ? base_ctx + (size_t)(u.pm - 64) * BM * 1024 : base_lat + (size_t)u.pm * BM * 1024;
        float* out = isctx ? out_ctx + (size_t)(u.pm - 64) * BM * 1024 : out_lat + (size_t)u.pm * BM * 1024;
        const float* g = gate + (size_t)(isctx ? 4 : (u.pm >> 4)) * 9216;
        const int col0 = u.pn * BM + wc * 32 + 4 * fq;
        f32x4 gv[2][2];
#pragma unroll
        for (int bj = 0; bj < 2; ++bj)
#pragma unroll
            for (int n = 0; n < 2; ++n) gv[bj][n] = *(const f32x4*)(g + col0 + bj * HALF + n * 16) * coef;
#pragma unroll
        for (int ai = 0; ai < 2; ++ai)
#pragma unroll
            for (int m = 0; m < 4; ++m) { const size_t off = (size_t)(ai * HALF + wr * 64 + m * 16 + fr) * 1024 + col0;
#pragma unroll
                for (int bj = 0; bj < 2; ++bj)
#pragma unroll
                    for (int n = 0; n < 2; ++n) { const f32x4 b = *(const f32x4*)(base + off + bj * HALF + n * 16);
                        *(f32x4*)(out + off + bj * HALF + n * 16) = b + gv[bj][n] * acc[ai][bj][m][n]; } }
    }
};

struct EpiProj {
    static constexpr bool PERM = true, AFTER_DRAIN = false;
    bf16_t* O; int ldc;
    __device__ __forceinline__ void operator()(const f32x4 (&acc)[2][2][4][2], const Unit& u, int wr, int wc, int fr, int fq) const {
        const int row0 = u.pm * BM + wr * 64 + fr, col0 = u.pn * BM + wc * 32 + 8 * fq;
        const int mode = (u.pn < 2) ? 1 : ((u.pn == 4 || u.pn == 5) ? 2 : (u.pn >= 14 ? 3 : 0));
#pragma unroll
        for (int ai = 0; ai < 2; ++ai)
#pragma unroll
            for (int m = 0; m < 4; ++m) { bf16_t* rowp = O + (size_t)(row0 + ai * HALF + m * 16) * ldc + col0;
#pragma unroll
                for (int bj = 0; bj < 2; ++bj) { float r[8];
#pragma unroll
                    for (int n = 0; n < 2; ++n)
#pragma unroll
                        for (int i = 0; i < 4; ++i) { const float v = acc[ai][bj][m][n][i];
                            r[n * 4 + i] = mode == 0 ? v : (mode == 1 ? fast_silu(v) * 0.08838834764831845f : (mode == 2 ? fast_silu(v) : fast_sigmoid(v))); }
                    u32x4 w; w.x = cvt_pk_bf16(r[0], r[1]); w.y = cvt_pk_bf16(r[2], r[3]); w.z = cvt_pk_bf16(r[4], r[5]); w.w = cvt_pk_bf16(r[6], r[7]);
                    *(u32x4*)(rowp + bj * HALF) = w; } }
    }
};

struct DownOrder {
    StaticOrder lat; int c;
    __device__ __forceinline__ bool next(int i, Unit& u) const {
        if (i == 0) return lat.next(0, u);
        if (i != 1 || c >= 176) return false;
        const int ks = c % 11, t = c / 11; u.pn = t & 3; u.pm = 64 + (t >> 2); u.kofs = ks * 256; u.kt = 4; return true; }
    __device__ __forceinline__ void a_ready(const Unit&) const {}
    __device__ __forceinline__ void done(const Unit&) const {}
};
struct EpiDown1 {
    static constexpr bool PERM = true, AFTER_DRAIN = false;
    const float* base; bf16_t* out; const float* gate; float coef; float* slab;
    __device__ __forceinline__ void operator()(const f32x4 (&acc)[2][2][4][2], const Unit& u, int wr, int wc, int fr, int fq) const {
        const int col0 = u.pn * BM + wc * 32 + 8 * fq;
        if (u.kt) {
            float* o = slab + ((size_t)(u.kofs >> 8) * 1024 + (size_t)(u.pm - 64) * BM) * 1024 + col0;
#pragma unroll
            for (int ai = 0; ai < 2; ++ai)
#pragma unroll
                for (int m = 0; m < 4; ++m) { float* rowp = o + (size_t)(ai * HALF + wr * 64 + m * 16 + fr) * 1024;
#pragma unroll
                    for (int bj = 0; bj < 2; ++bj) { *(f32x4*)(rowp + bj * HALF) = acc[ai][bj][m][0]; *(f32x4*)(rowp + bj * HALF + 4) = acc[ai][bj][m][1]; } }
            return;
        }
        const float* g = gate + (size_t)(u.pm >> 4) * 9216;
        f32x4 gv[2][2];
#pragma unroll
        for (int bj = 0; bj < 2; ++bj)
#pragma unroll
            for (int n = 0; n < 2; ++n) gv[bj][n] = *(const f32x4*)(g + col0 + bj * HALF + 4 * n) * coef;
#pragma unroll
        for (int ai = 0; ai < 2; ++ai)
#pragma unroll
            for (int m = 0; m < 4; ++m) { const size_t off = (size_t)(u.pm * BM + ai * HALF + wr * 64 + m * 16 + fr) * 1024 + col0;
#pragma unroll
                for (int bj = 0; bj < 2; ++bj) { const f32x4 b0 = *(const f32x4*)(base + off + bj * HALF), b1 = *(const f32x4*)(base + off + bj * HALF + 4);
                    const f32x4 v0 = b0 + gv[bj][0] * acc[ai][bj][m][0], v1 = b1 + gv[bj][1] * acc[ai][bj][m][1];
                    u32x4 w; w.x = cvt_pk_bf16(v0[0], v0[1]); w.y = cvt_pk_bf16(v0[2], v0[3]); w.z = cvt_pk_bf16(v1[0], v1[1]); w.w = cvt_pk_bf16(v1[2], v1[3]);
                    *(u32x4*)(out + off + bj * HALF) = w; } }
    }
};
struct ProjOrder {
    StaticOrder lat; int c;
    __device__ __forceinline__ bool next(int i, Unit& u) const {
        if (i < 4) return lat.next(i, u);
        if (i != 4 || c >= 144) return false;
        const int ks = c & 3, t = c >> 2, t9 = t % 9;
        u.pm = 64 + t / 9; u.pn = t9 < 2 ? 2 + t9 : (t9 < 6 ? 4 + t9 : 5 + t9); u.kofs = ks * 256; u.kt = 4; return true; }
    __device__ __forceinline__ void a_ready(const Unit&) const {}
    __device__ __forceinline__ void done(const Unit&) const {}
};
struct EpiProjAll {
    static constexpr bool PERM = true, AFTER_DRAIN = false;
    EpiProj lat; bf16_t* slab;
    __device__ __forceinline__ void operator()(const f32x4 (&acc)[2][2][4][2], const Unit& u, int wr, int wc, int fr, int fq) const {
        if (!u.kt) { lat(acc, u, wr, wc, fr, fq); return; }
        const int t9 = u.pn < 4 ? u.pn - 2 : (u.pn < 10 ? u.pn - 4 : u.pn - 5);
        bf16_t* out = slab + ((size_t)(u.kofs >> 8) * 1024 + (size_t)(u.pm - 64) * BM) * 2304 + t9 * 256 + wc * 32 + 8 * fq;
#pragma unroll
        for (int ai = 0; ai < 2; ++ai)
#pragma unroll
            for (int m = 0; m < 4; ++m) { bf16_t* rowp = out + (size_t)(ai * HALF + wr * 64 + m * 16 + fr) * 2304;
#pragma unroll
                for (int bj = 0; bj < 2; ++bj) { const f32x4 v0 = acc[ai][bj][m][0], v1 = acc[ai][bj][m][1];
                    u32x4 w; w.x = cvt_pk_bf16(v0[0], v0[1]); w.y = cvt_pk_bf16(v0[2], v0[3]); w.z = cvt_pk_bf16(v1[0], v1[1]); w.w = cvt_pk_bf16(v1[2], v1[3]);
                    *(u32x4*)(rowp + bj * HALF) = w; } }
    }
};

template <bool BASE_BF16>
struct EpiResidB {
    static constexpr bool PERM = true, AFTER_DRAIN = false;
    const void* base; bf16_t* out; const float* gate; float coef;
    __device__ __forceinline__ void operator()(const f32x4 (&acc)[2][2][4][2], const Unit& u, int wr, int wc, int fr, int fq) const {
        const float* g = gate + (size_t)(u.pm >> 4) * 9216;
        const int col0 = u.pn * BM + wc * 32 + 8 * fq;
        f32x4 gv[2][2];
#pragma unroll
        for (int bj = 0; bj < 2; ++bj)
#pragma unroll
            for (int n = 0; n < 2; ++n) gv[bj][n] = *(const f32x4*)(g + col0 + bj * HALF + 4 * n) * coef;
#pragma unroll
        for (int ai = 0; ai < 2; ++ai)
#pragma unroll
            for (int m = 0; m < 4; ++m) { const size_t off = (size_t)(u.pm * BM + ai * HALF + wr * 64 + m * 16 + fr) * 1024 + col0;
#pragma unroll
                for (int bj = 0; bj < 2; ++bj) { f32x4 b0, b1;
                    if (BASE_BF16) { const u32x4 bw = *(const u32x4*)((const bf16_t*)base + off + bj * HALF);
                        b0 = (f32x4){__builtin_bit_cast(float, bw.x << 16), __builtin_bit_cast(float, bw.x & 0xffff0000u), __builtin_bit_cast(float, bw.y << 16), __builtin_bit_cast(float, bw.y & 0xffff0000u)};
                        b1 = (f32x4){__builtin_bit_cast(float, bw.z << 16), __builtin_bit_cast(float, bw.z & 0xffff0000u), __builtin_bit_cast(float, bw.w << 16), __builtin_bit_cast(float, bw.w & 0xffff0000u)}; }
                    else { b0 = *(const f32x4*)((const float*)base + off + bj * HALF); b1 = *(const f32x4*)((const float*)base + off + bj * HALF + 4); }
                    const f32x4 v0 = b0 + gv[bj][0] * acc[ai][bj][m][0], v1 = b1 + gv[bj][1] * acc[ai][bj][m][1];
                    u32x4 w; w.x = cvt_pk_bf16(v0[0], v0[1]); w.y = cvt_pk_bf16(v0[2], v0[3]); w.z = cvt_pk_bf16(v1[0], v1[1]); w.w = cvt_pk_bf16(v1[2], v1[3]);
                    *(u32x4*)(out + off + bj * HALF) = w; } }
    }
};

template <class Epi, class Sched, bool ALIGN_EPI = false, bool SP2 = false>
__device__ __forceinline__ void gemm_phase(PG8_LAS unsigned char* lds, const Gemm g, const Sched& S, const Epi& E) {
    const int tid = threadIdx.x, wid = __builtin_amdgcn_readfirstlane(tid >> 6), lane = tid & 63, wr = wid >> 2, wc = wid & 3, fr = lane & 15, fq = lane >> 4;
    const int K = g.K, nt = K / BK, LD = g.ld;
    unsigned voffA[2], voffB[2];
#pragma unroll
    for (int i = 0; i < 2; ++i) { int R, C; stage_rc(tid * 16 + i * 8192, R, C); const int Rb = Epi::PERM ? ((R & ~31) + perm32(R & 31)) : R;
        voffA[i] = (unsigned)(R * LD + C) * 2u; voffB[i] = (unsigned)(Rb * LD + C) * 2u; }
    const size_t kstep = (size_t)(BK * 2);
    const size_t hstep = (size_t)HALF * LD * 2;
    const size_t tstep = 2 * hstep;
    const unsigned ldsw = (unsigned)wid * 1024u;
    const int aoff = lds_byte(wr * 64 + fr, fq * 8), boff = lds_byte(wc * 32 + fr, fq * 8);
#define PG8_SA(b, h) (((b) * 2 + (h)) * HTB)
#define PG8_SB(b, h) ((4 + (b) * 2 + (h)) * HTB)
#define PG8_STAGE(bufoff, gbase, voff) do { _Pragma("unroll") for (int _i = 0; _i < 2; ++_i) \
        __builtin_amdgcn_global_load_lds((const unsigned*)((const char*)(gbase) + (voff)[_i]), (PG8_LAS unsigned*)(lds + (bufoff) + ldsw + _i * 8192), 16, 0, 0); } while (0)
#define PG8_LDA(dst, b, h) do { _Pragma("unroll") for (int m = 0; m < 4; ++m) _Pragma("unroll") for (int k = 0; k < 2; ++k) dst[m][k] = *(const PG8_LAS bf16x8*)(lds + PG8_SA(b, h) + aoff + m * 2048 + k * 1024); } while (0)
#define PG8_LDB(dst, b, h) do { _Pragma("unroll") for (int n = 0; n < 2; ++n) _Pragma("unroll") for (int k = 0; k < 2; ++k) dst[n][k] = *(const PG8_LAS bf16x8*)(lds + PG8_SB(b, h) + boff + n * 2048 + k * 1024); } while (0)
#define PG8_MMA(ai, bj, At, Bt) do { __builtin_amdgcn_s_setprio(1); _Pragma("unroll") for (int m = 0; m < 4; ++m) _Pragma("unroll") for (int n = 0; n < 2; ++n) _Pragma("unroll") for (int k = 0; k < 2; ++k) \
        acc[ai][bj][m][n] = __builtin_amdgcn_mfma_f32_16x16x32_bf16(Bt[n][k], At[m][k], acc[ai][bj][m][n], 0, 0, 0); __builtin_amdgcn_s_setprio(0); } while (0)
#define PG8_WAIT_V(n) asm volatile("s_waitcnt vmcnt(" #n ")" ::: "memory")
#define PG8_WAIT_L(n) asm volatile("s_waitcnt lgkmcnt(" #n ")" ::: "memory")
#define PG8_BAR __builtin_amdgcn_s_barrier()
#define PG8_SCHED __builtin_amdgcn_sched_barrier(0)
    Unit cur, nxt; int ui = 0;
    if (!S.next(0, cur)) return;
    f32x4 acc[2][2][4][2];
#pragma unroll
    for (int a = 0; a < 2; ++a)
#pragma unroll
        for (int b = 0; b < 2; ++b)
#pragma unroll
            for (int m = 0; m < 4; ++m)
#pragma unroll
                for (int n = 0; n < 2; ++n) acc[a][b][m][n] = (f32x4){0.f, 0.f, 0.f, 0.f};
    bf16x8 At[4][2], B0[2][2], B1[2][2];
    const char* cA = (const char*)g.A + (size_t)cur.pm * tstep + (size_t)cur.kofs * 2; const char* cB = (const char*)g.Bt + (size_t)cur.pn * tstep + (size_t)cur.kofs * 2;
    S.a_ready(cur);
    if constexpr (SP2) {
        PG8_STAGE(PG8_SB(0, 0), cB, voffB); PG8_STAGE(PG8_SB(0, 1), cB + hstep, voffB); PG8_STAGE(PG8_SA(0, 0), cA, voffA); PG8_STAGE(PG8_SA(0, 1), cA + hstep, voffA);
        if (wr == 1) PG8_BAR;
        PG8_WAIT_V(2); PG8_BAR;
        PG8_STAGE(PG8_SB(1, 0), cB + kstep, voffB); PG8_STAGE(PG8_SA(1, 0), cA + kstep, voffA); PG8_STAGE(PG8_SB(1, 1), cB + hstep + kstep, voffB);
        PG8_WAIT_V(6); PG8_BAR;
    } else {
        PG8_STAGE(PG8_SB(0, 0), cB, voffB); PG8_STAGE(PG8_SA(0, 0), cA, voffA); PG8_STAGE(PG8_SB(0, 1), cB + hstep, voffB); PG8_STAGE(PG8_SA(0, 1), cA + hstep, voffA);
        if (wr == 1) PG8_BAR;
        PG8_WAIT_V(4); PG8_BAR;
        PG8_STAGE(PG8_SB(1, 0), cB + kstep, voffB); PG8_STAGE(PG8_SA(1, 0), cA + kstep, voffA); PG8_STAGE(PG8_SB(1, 1), cB + hstep + kstep, voffB);
        PG8_WAIT_V(6); PG8_BAR;
    }
    for (;;) {
        const bool has_next = S.next(ui + 1, nxt);
        const char* nA = has_next ? (const char*)g.A + (size_t)nxt.pm * tstep + (size_t)nxt.kofs * 2 : cA; const char* nB = has_next ? (const char*)g.Bt + (size_t)nxt.pn * tstep + (size_t)nxt.kofs * 2 : cB;
        const int ntu = cur.kt ? cur.kt : nt;
        for (int t = 0; t < ntu; t += 2) {
            const bool last = (t == ntu - 2);
            const char* a1 = cA + (size_t)(t + 1) * kstep;
            const char* a2 = last ? nA : cA + (size_t)(t + 2) * kstep; const char* b2 = last ? nB : cB + (size_t)(t + 2) * kstep;
            const char* a3 = a2 + kstep; const char* b3 = b2 + kstep;
            if (last && has_next) S.a_ready(nxt);
            if constexpr (SP2) {
            PG8_LDB(B0, 0, 0); PG8_LDB(B1, 0, 1); PG8_SCHED; PG8_LDA(At, 0, 0); PG8_STAGE(PG8_SA(1, 1), a1 + hstep, voffA);
            PG8_WAIT_V(8); PG8_WAIT_L(0); PG8_BAR; PG8_MMA(0, 0, At, B0); PG8_MMA(0, 1, At, B1); PG8_BAR; PG8_SCHED;
            PG8_LDA(At, 0, 1); PG8_STAGE(PG8_SB(0, 0), b2, voffB); PG8_STAGE(PG8_SB(0, 1), b2 + hstep, voffB); PG8_STAGE(PG8_SA(0, 0), a2, voffA);
            PG8_WAIT_V(8); PG8_WAIT_L(0); PG8_BAR; PG8_MMA(1, 0, At, B0); PG8_MMA(1, 1, At, B1); PG8_BAR; PG8_SCHED;
            PG8_LDB(B0, 1, 0); PG8_LDB(B1, 1, 1); PG8_SCHED; PG8_LDA(At, 1, 0); PG8_STAGE(PG8_SA(0, 1), a2 + hstep, voffA);
            PG8_WAIT_V(8); PG8_WAIT_L(0); PG8_BAR; PG8_MMA(0, 0, At, B0); PG8_MMA(0, 1, At, B1); PG8_BAR; PG8_SCHED;
            PG8_LDA(At, 1, 1); PG8_STAGE(PG8_SB(1, 0), b3, voffB); PG8_STAGE(PG8_SB(1, 1), b3 + hstep, voffB); PG8_STAGE(PG8_SA(1, 0), a3, voffA);
            PG8_WAIT_V(8); PG8_WAIT_L(0); PG8_BAR; PG8_MMA(1, 0, At, B0); PG8_MMA(1, 1, At, B1); PG8_BAR; PG8_SCHED;
            } else {
            PG8_LDB(B0, 0, 0); PG8_SCHED; PG8_LDA(At, 0, 0); PG8_STAGE(PG8_SA(1, 1), a1 + hstep, voffA);
            PG8_WAIT_L(8); PG8_BAR; PG8_WAIT_L(0); PG8_MMA(0, 0, At, B0); PG8_BAR; PG8_SCHED;
            PG8_LDB(B1, 0, 1); PG8_STAGE(PG8_SB(0, 0), b2, voffB);
            PG8_BAR; PG8_WAIT_L(0); PG8_MMA(0, 1, At, B1); PG8_BAR;
            PG8_LDA(At, 0, 1); PG8_STAGE(PG8_SA(0, 0), a2, voffA);
            PG8_BAR; PG8_WAIT_L(0); PG8_MMA(1, 0, At, B0); PG8_BAR; PG8_SCHED;
            PG8_STAGE(PG8_SB(0, 1), b2 + hstep, voffB);
            PG8_WAIT_V(6); PG8_BAR; PG8_MMA(1, 1, At, B1); PG8_BAR;
            PG8_LDB(B0, 1, 0); PG8_SCHED; PG8_LDA(At, 1, 0); PG8_STAGE(PG8_SA(0, 1), a2 + hstep, voffA);
            PG8_WAIT_L(8); PG8_BAR; PG8_WAIT_L(0); PG8_MMA(0, 0, At, B0); PG8_BAR; PG8_SCHED;
            PG8_LDB(B1, 1, 1); PG8_STAGE(PG8_SB(1, 0), b3, voffB);
            PG8_BAR; PG8_WAIT_L(0); PG8_MMA(0, 1, At, B1); PG8_BAR;
            PG8_LDA(At, 1, 1); PG8_STAGE(PG8_SA(1, 0), a3, voffA);
            PG8_BAR; PG8_WAIT_L(0); PG8_MMA(1, 0, At, B0); PG8_BAR; PG8_SCHED;
            PG8_STAGE(PG8_SB(1, 1), b3 + hstep, voffB);
            PG8_WAIT_V(6); PG8_BAR; PG8_MMA(1, 1, At, B1); PG8_BAR;
            }
        }
        if constexpr (ALIGN_EPI) { if (wr == 0) PG8_BAR; }
        if constexpr (!Epi::AFTER_DRAIN) { PG8_PS_BEGIN(); E(acc, cur, wr, wc, fr, fq); S.done(cur); PG8_PS_END(); }
        if (!has_next) break;
#pragma unroll
        for (int a = 0; a < 2; ++a)
#pragma unroll
            for (int b = 0; b < 2; ++b)
#pragma unroll
                for (int m = 0; m < 4; ++m)
#pragma unroll
                    for (int n = 0; n < 2; ++n) acc[a][b][m][n] = (f32x4){0.f, 0.f, 0.f, 0.f};
        cur = nxt; cA = nA; cB = nB; ++ui;
        if constexpr (ALIGN_EPI) { if (wr == 1) PG8_BAR; }
    }
    PG8_WAIT_V(0);
    if constexpr (!ALIGN_EPI) { if (wr == 0) PG8_BAR; }
    PG8_BAR;
    if constexpr (Epi::AFTER_DRAIN) { E.fused(acc, cur, wr, wc, fr, fq, lds, wid, lane); S.done(cur); }
#undef PG8_SA
#undef PG8_SB
#undef PG8_STAGE
#undef PG8_LDA
#undef PG8_LDB
#undef PG8_MMA
#undef PG8_WAIT_V
#undef PG8_WAIT_L
#undef PG8_BAR
#undef PG8_SCHED
}
}
constexpr int DM = 1024, NB = 4, SEQ = 4096, NCTX = 256, DFF = 2816, DIN = 4112, NPROJ = 4096, NMODC = 9216;
constexpr int LDP = 4224;
constexpr int MLAT = NB * SEQ, MCTX = NB * NCTX, MALL = MLAT + MCTX;
constexpr float EPSN = 1e-6f;
constexpr int NWAVES = 8, NTHREADS = 512;
#ifndef ONE_LAUNCH
#define ONE_LAUNCH 1
#endif
constexpr int NPHASES = 15;

constexpr size_t MiB = 1u << 20;
constexpr size_t WS_CTL = 0, CTL_ZERO_BYTES = 64 * 1024;
constexpr size_t WS_MODS = 1 * MiB;
constexpr size_t WS_GATES = 1 * MiB + 512 * 1024;
constexpr size_t WS_W1 = 3 * MiB;
constexpr size_t WS_W2 = 14 * MiB;
constexpr size_t WS_WIN = 20 * MiB;
constexpr size_t WS_WOUT = 28 * MiB;
constexpr size_t WS_XN = 34 * MiB;
constexpr size_t WS_PROJ = 68 * MiB;
constexpr size_t WS_QK = 209 * MiB;
constexpr size_t WS_END = 256 * MiB;
constexpr size_t WS_HGST = 237 * MiB;
constexpr size_t WS_HGG = 253 * MiB;
constexpr size_t WS_WG = 2 * MiB + 640 * 1024;
constexpr size_t WS_MLST = 226 * MiB;
constexpr size_t WS_MLSC = 236 * MiB;
constexpr size_t WS_SLAB = 204 * MiB;
constexpr size_t WS_SLAB2 = 237 * MiB;
constexpr int CW_BAR = 1024;

constexpr int RING_BYTES = 131072;
constexpr int LDSCTL_OFF = 162816, MISC_OFF = LDSCTL_OFF + 320;
constexpr int LDS_BYTES = 163840;

#define GAS __attribute__((address_space(1)))
#define LAS __attribute__((address_space(3)))
typedef unsigned short bf16;
typedef unsigned v4u __attribute__((ext_vector_type(4)));
typedef unsigned v2u __attribute__((ext_vector_type(2)));
typedef float f32x4 __attribute__((ext_vector_type(4)));
#define LDS_WAIT() asm volatile("s_waitcnt lgkmcnt(0)" ::: "memory")
#define VM_WAIT() asm volatile("s_waitcnt vmcnt(0)" ::: "memory")
__device__ __forceinline__ unsigned f2bf(float f) { unsigned u = __builtin_bit_cast(unsigned, f); return (u + 0x7fffu + ((u >> 16) & 1u)) >> 16; }
__device__ __forceinline__ unsigned pk2(float lo, float hi) { return f2bf(lo) | (f2bf(hi) << 16); }
__device__ __forceinline__ float bf2f(unsigned short h) { return __builtin_bit_cast(float, (unsigned)h << 16); }
__device__ __forceinline__ float bflo(unsigned w) { return __builtin_bit_cast(float, w << 16); }
__device__ __forceinline__ float bfhi(unsigned w) { return __builtin_bit_cast(float, w & 0xffff0000u); }
__device__ __forceinline__ float sigmoidf_(float v) { return 1.0f / (1.0f + __expf(-v)); }
__device__ __forceinline__ float fast_sig(float v) { return __builtin_amdgcn_rcpf(1.0f + __builtin_amdgcn_exp2f(-1.4426950408889634f * v)); }
__device__ __forceinline__ float siluf_(float v) { return v * sigmoidf_(v); }
__device__ __forceinline__ float wave_sum(float v) {
#pragma unroll
    for (int o = 1; o < 64; o <<= 1) v += __shfl_xor(v, o);
    return v;
}

#ifndef PROF_S
#define PROF_S -1
#endif
#define PS_BEGIN() do { if (PROF_S >= 0 && blockIdx.x == 0 && threadIdx.x == 0) { const unsigned long long t_ = __builtin_amdgcn_s_memrealtime(); volatile LAS unsigned* M_ = (volatile LAS unsigned*)(T.lds + MISC_OFF); M_[20] = (unsigned)t_; M_[21] = (unsigned)(t_ >> 32); } } while (0)
#define PS_END(id) do { if (PROF_S >= 0 && blockIdx.x == 0 && threadIdx.x == 0) { const unsigned long long t_ = __builtin_amdgcn_s_memrealtime(); volatile LAS unsigned* M_ = (volatile LAS unsigned*)(T.lds + MISC_OFF); \
    if ((id) == PROF_S) { const unsigned long long p_ = ((unsigned long long)M_[21] << 32) | M_[20]; const unsigned long long a_ = (((unsigned long long)M_[23] << 32) | M_[22]) + (t_ - p_); M_[22] = (unsigned)a_; M_[23] = (unsigned)(a_ >> 32); } \
    M_[20] = (unsigned)t_; M_[21] = (unsigned)(t_ >> 32); } } while (0)
#define XB_TMO      128
#define XB_XCNT(j)  (256  + 64 * (j))
#define XB_XSUB(j)  (1280 + 64 * (j))
#define XB_XGEN(j)  (2304 + 64 * (j))
#define XB_TOP      3328
#define XB_TOPGEN   3392
#define XCD_BAR_WORDS 3456
#define XB_SPIN_CAP (1u << 18)

__device__ __forceinline__ unsigned xb_ld(unsigned* p)              { return __hip_atomic_load(p, __ATOMIC_RELAXED, __HIP_MEMORY_SCOPE_AGENT); }
__device__ __forceinline__ unsigned xb_add(unsigned* p, unsigned v) { return __hip_atomic_fetch_add(p, v, __ATOMIC_RELAXED, __HIP_MEMORY_SCOPE_AGENT); }
__device__ __forceinline__ unsigned xb_xcc_id() { return (unsigned)__builtin_amdgcn_s_getreg((3 << 11) | 20) & 0xFu; }
#define XB_SPIN(cond, bar) do { unsigned _sp = 0; while (cond) { __builtin_amdgcn_s_sleep(1); \
    if ((++_sp & 255u) == 0u) { if (xb_ld(&(bar)[XB_TMO])) break; if (_sp > XB_SPIN_CAP) { atomicAdd(&(bar)[XB_TMO], 1u); break; } } } } while (0)

struct XcdBarrier {
    unsigned* bar; unsigned x;
    volatile LAS unsigned* st;
};

__device__ __forceinline__ XcdBarrier xcd_barrier_post(unsigned* bar, volatile LAS unsigned* st) {
    XcdBarrier b; b.bar = bar; b.x = xb_xcc_id(); b.st = st;
    if (threadIdx.x == 0) (void)xb_add(&bar[XB_XCNT(b.x)], 1u);
    return b;
}
__device__ __forceinline__ void xcd_barrier_complete(unsigned* bar, unsigned x, unsigned& nloc, unsigned& nx) {
    const unsigned G = gridDim.x * gridDim.y * gridDim.z;
    unsigned sum, cnt, mine, sp = 0u;
    for (;;) {
        sum = 0u; cnt = 0u; mine = 0u;
#pragma unroll
        for (unsigned j = 0; j < 16; ++j) { const unsigned c = xb_ld(&bar[XB_XCNT(j)]); sum += c; cnt += (c > 0u) ? 1u : 0u; mine = (j == x) ? c : mine; }
        if (sum == G) break;
        __builtin_amdgcn_s_sleep(1);
        if ((++sp & 255u) == 0u) { if (xb_ld(&bar[XB_TMO])) break; if (sp > XB_SPIN_CAP) { atomicAdd(&bar[XB_TMO], 1u); break; } }
    }
    nloc = mine > 0u ? mine : 1u; nx = cnt > 0u ? cnt : 1u;
}

__device__ __forceinline__ void xcd_barrier(const XcdBarrier& b) {
    asm volatile("s_waitcnt vmcnt(0)" ::: "memory");
    __syncthreads();
    if (threadIdx.x == 0) {
        unsigned* bar = b.bar;
        __builtin_amdgcn_s_waitcnt(0);
        unsigned nloc = b.st[0], nx = b.st[1];
        if (nloc == 0u) { xcd_barrier_complete(bar, b.x, nloc, nx); b.st[0] = nloc; b.st[1] = nx; }
        const unsigned old = xb_add(&bar[XB_XSUB(b.x)], 1u);
        const unsigned gen = old / nloc;
        if (old + 1u == (gen + 1u) * nloc) {
            __builtin_amdgcn_fence(__ATOMIC_RELEASE, "agent");
            asm volatile("s_waitcnt vmcnt(0)" ::: "memory");
            const unsigned og = xb_add(&bar[XB_TOP], 1u);
            const unsigned tg = og / nx;
            if (og + 1u == (tg + 1u) * nx) xb_add(&bar[XB_TOPGEN], 1u);
            else XB_SPIN(xb_ld(&bar[XB_TOPGEN]) == tg, bar);
            __builtin_amdgcn_fence(__ATOMIC_ACQUIRE, "agent");
            xb_add(&bar[XB_XGEN(b.x)], 1u);
            asm volatile("s_waitcnt vmcnt(0)" ::: "memory");
        } else {
            XB_SPIN(xb_ld(&bar[XB_XGEN(b.x)]) == gen, bar);
            __builtin_amdgcn_fence(__ATOMIC_ACQUIRE, "agent");
            asm volatile("s_waitcnt vmcnt(0)" ::: "memory");
        }
    }
    __syncthreads();
}
struct Args {
    const float* in[22]; float* out; unsigned char* ws; int ph_lo, ph_hi;
};
enum { I_X = 0, I_C, I_CTX, I_CCTX, I_WMOD, I_BMOD, I_N1W, I_F1W1, I_F1W2, I_N2W, I_WIN, I_MLGB, I_CONVW, I_CONVB, I_LBLOG, I_HGNW, I_MLNW, I_WOUT, I_N3W, I_F2W1, I_F2W2, I_FNW };

struct Ctx {
    LAS unsigned char* lds;
    int tid, lane, wave, vcu, G, gw, NGW;
};

__device__ __forceinline__ void mods_phase(const Args& a, const Ctx& T) {
    LAS float* sL = (LAS float*)T.lds;
    LAS float* red = (LAS float*)(T.lds + 20480);
    const float* c = a.in[I_C]; const float* cc = a.in[I_CCTX];
    for (int i = T.tid; i < 5 * 1024; i += NTHREADS) { const int r = i >> 10, k = i & 1023; const float v = r < 4 ? c[r * 1024 + k] : cc[k]; sL[i] = siluf_(v); }
    __syncthreads();
    typedef float f2 __attribute__((ext_vector_type(2)));
    for (int item = T.vcu; item < 576; item += T.G) {
        const int cb = item >> 3, kr = item & 7; const int k0 = kr * 128 + T.wave * 16;
        const float* W = a.in[I_WMOD] + (size_t)k0 * NMODC + cb * 128 + 2 * T.lane;
        f2 wv[16];
#pragma unroll
        for (int k = 0; k < 16; ++k) wv[k] = __builtin_nontemporal_load((const f2*)(W + (size_t)k * NMODC));
        float acc[5][2];
#pragma unroll
        for (int r = 0; r < 5; ++r) { acc[r][0] = 0.f; acc[r][1] = 0.f; }
#pragma unroll
        for (int k = 0; k < 16; ++k)
#pragma unroll
            for (int r = 0; r < 5; ++r) { const float s = sL[r * 1024 + k0 + k]; acc[r][0] += s * wv[k].x; acc[r][1] += s * wv[k].y; }
#pragma unroll
        for (int r = 0; r < 5; ++r) *(LAS f2*)(red + (T.wave * 5 + r) * 128 + 2 * T.lane) = (f2){acc[r][0], acc[r][1]};
        __syncthreads();
        for (int o = T.tid; o < 640; o += NTHREADS) { const int r = o >> 7, cl = o & 127; float s = 0.f;
#pragma unroll
            for (int w = 0; w < 8; ++w) s += red[(w * 5 + r) * 128 + cl];
            const int col = cb * 128 + cl; if (kr == 0) s += a.in[I_BMOD][col];
            atomicAdd((float*)(a.ws + WS_MODS) + r * NMODC + col, s); }
        __syncthreads();
    }
}

__device__ __forceinline__ void transpose_item(const float* W, int ldw, int K, bf16* WT, int k0, int n0, int dest_row0, LAS float* scr, int lane) {
    float tv[32];
#pragma unroll
    for (int i = 0; i < 32; ++i) tv[i] = __builtin_nontemporal_load(W + (size_t)(k0 + 2 * i + (lane >> 5)) * ldw + n0 + (lane & 31));
#pragma unroll
    for (int i = 0; i < 32; ++i) scr[(2 * i + (lane >> 5)) * 33 + (lane & 31)] = tv[i];
    LDS_WAIT(); asm volatile("" ::: "memory");
    const int c = lane & 7;
#pragma unroll
    for (int j = 0; j < 4; ++j) { const int n = (lane >> 3) + 8 * j; const LAS float* s = scr + (8 * c) * 33 + n;
        v4u o; o.x = pk2(s[0 * 33], s[1 * 33]); o.y = pk2(s[2 * 33], s[3 * 33]); o.z = pk2(s[4 * 33], s[5 * 33]); o.w = pk2(s[6 * 33], s[7 * 33]);
        *(GAS v4u*)(WT + (size_t)(dest_row0 + n) * K + k0 + 8 * c) = o; }
    LDS_WAIT(); asm volatile("" ::: "memory");
}
__device__ __forceinline__ void convert_ffn(const Args& a, const Ctx& T, const float* w1, const float* w2) {
    LAS float* scr = (LAS float*)(T.lds + T.wave * 16384);
    bf16* W1 = (bf16*)(a.ws + WS_W1); bf16* W2 = (bf16*)(a.ws + WS_W2);
    constexpr int I1 = 16 * 176, I2 = 44 * 32;
    for (int it = T.gw; it < I1 + I2; it += T.NGW) {
        if (it < I1) { const int kb = it / 176, nb = it % 176, n0 = nb * 32;
            const int dest = n0 < DFF ? (n0 >> 7) * 256 + (n0 & 127) : ((n0 - DFF) >> 7) * 256 + 128 + ((n0 - DFF) & 127);
            transpose_item(w1, 2 * DFF, DM, W1, kb * 64, n0, dest, scr, T.lane); }
        else { const int r = it - I1, kb = r / 32, nb = r % 32; transpose_item(w2, DM, DFF, W2, kb * 64, nb * 32, nb * 32, scr, T.lane); }
    }
}
__device__ __forceinline__ void convert_mix(const Args& a, const Ctx& T) {
    LAS float* scr = (LAS float*)(T.lds + T.wave * 16384);
    bf16* WI = (bf16*)(a.ws + WS_WIN); bf16* WO = (bf16*)(a.ws + WS_WOUT);
    constexpr int I1 = 16 * 128, I2 = 16 * 32;
    for (int it = T.gw; it < I1 + I2; it += T.NGW) {
        if (it < I1) { const int kb = it / 128, nb = it % 128; transpose_item(a.in[I_WIN], DIN, DM, WI, kb * 64, nb * 32, nb * 32, scr, T.lane); }
        else { const int r = it - I1, kb = r / 32, nb = r % 32; transpose_item(a.in[I_WOUT], DM, DM, WO, kb * 64, nb * 32, nb * 32, scr, T.lane); }
    }
}

__device__ __forceinline__ void norm_load_row(f32x4 (&v)[4], const void* src_lat, bool latbf, const float* src_ctx, int m, int lane) {
    if (m < MLAT) {
        if (latbf) { const v2u* xr = (const v2u*)((const bf16*)src_lat + (size_t)m * DM) + lane;
#pragma unroll
            for (int j = 0; j < 4; ++j) { const v2u w = xr[64 * j]; v[j] = (f32x4){bflo(w.x), bfhi(w.x), bflo(w.y), bfhi(w.y)}; } }
        else { const f32x4* xr = (const f32x4*)((const float*)src_lat + (size_t)m * DM) + lane;
#pragma unroll
            for (int j = 0; j < 4; ++j) v[j] = xr[64 * j]; }
    } else { const f32x4* xr = (const f32x4*)(src_ctx + (size_t)(m - MLAT) * DM) + lane;
#pragma unroll
        for (int j = 0; j < 4; ++j) v[j] = xr[64 * j]; }
}
template <bool CTXSLAB, bool LATBF>
__device__ __forceinline__ void norm_mod_rows(const Args& a, const Ctx& T, const void* src_lat, const float* src_ctx, int nrows, const float* nw, int shift_idx, int scale_idx) {
    const float* mods = (const float*)(a.ws + WS_MODS);
    bf16* XN = (bf16*)(a.ws + WS_XN);
    f32x4 wv[4];
#pragma unroll
    for (int j = 0; j < 4; ++j) wv[j] = *((const f32x4*)nw + T.lane + 64 * j);
    f32x4 v[4];
    if (T.gw < nrows) norm_load_row(v, src_lat, LATBF, src_ctx, T.gw, T.lane);
    for (int m = T.gw; m < nrows; m += T.NGW) {
        const float* mr = mods + (size_t)(m < MLAT ? (m >> 12) : 4) * NMODC;
        f32x4 sh[4], sc[4];
#pragma unroll
        for (int j = 0; j < 4; ++j) { sh[j] = *((const f32x4*)(mr + shift_idx * 1024) + T.lane + 64 * j); sc[j] = *((const f32x4*)(mr + scale_idx * 1024) + T.lane + 64 * j); }
        f32x4 cur[4]; float s = 0.f;
        if (CTXSLAB && m >= MLAT) {
            const float* gr = mods + (size_t)4 * NMODC + 2 * 1024;
#pragma unroll
            for (int j = 0; j < 4; ++j) { f32x4 acc = (f32x4){0.f, 0.f, 0.f, 0.f};
#pragma unroll 1
                for (int ks = 0; ks < 11; ++ks) acc += *((const f32x4*)((const float*)(a.ws + WS_SLAB) + ((size_t)ks * 1024 + (m - MLAT)) * 1024) + T.lane + 64 * j);
                v[j] = v[j] + acc * (*((const f32x4*)gr + T.lane + 64 * j) * 0.5f); }
        }
#pragma unroll
        for (int j = 0; j < 4; ++j) { cur[j] = v[j]; s += (v[j].x * v[j].x + v[j].y * v[j].y) + (v[j].z * v[j].z + v[j].w * v[j].w); }
        { const int mn = m + T.NGW; if (mn < nrows) norm_load_row(v, src_lat, LATBF, src_ctx, mn, T.lane); }
        const float rstd = __builtin_amdgcn_rsqf(wave_sum(s) * (1.f / DM) + EPSN);
        unsigned long long* o8 = (unsigned long long*)(XN + (size_t)m * DM) + T.lane;
#pragma unroll
        for (int j = 0; j < 4; ++j) { const f32x4 y = (cur[j] * rstd * wv[j]) * (sc[j] + 1.0f) + sh[j];
            o8[64 * j] = (unsigned long long)pk2(y.x, y.y) | ((unsigned long long)pk2(y.z, y.w) << 32); }
    }
}

struct ConvTaps { v4u t[9]; };
__device__ __forceinline__ void conv_load(ConvTaps& R, const bf16* P, int m, int ch0) {
    const v4u z = (v4u){0u, 0u, 0u, 0u};
    const int b = m >> 12, t = m & 4095, r = t >> 6, c = t & 63;
#pragma unroll
    for (int dr = -1; dr <= 1; ++dr)
#pragma unroll
        for (int dc = -1; dc <= 1; ++dc) { const int rr = r + dr, c2 = c + dc; const bool ok = rr >= 0 && rr < 64 && c2 >= 0 && c2 < 64;
            R.t[(dr + 1) * 3 + dc + 1] = ok ? *(const v4u*)(P + (size_t)(b * 4096 + rr * 64 + c2) * LDP + 2560 + ch0) : z; }
}
__device__ __forceinline__ void ctx_combine(const Args& a, const Ctx& T) {
    const bf16* S2 = (const bf16*)(a.ws + WS_SLAB2); bf16* P = (bf16*)(a.ws + WS_PROJ);
    for (int task = T.vcu * NTHREADS + T.tid; task < 1024 * 256; task += T.G * NTHREADS) {
        const int r = task >> 8, q = task & 255; const int t8 = q >> 5, c8 = (q & 31) * 8; const int t9 = t8 < 6 ? t8 : t8 + 1;
        const int pn = t9 < 2 ? 2 + t9 : (t9 < 6 ? 4 + t9 : 5 + t9);
        float s[8] = {0.f, 0.f, 0.f, 0.f, 0.f, 0.f, 0.f, 0.f};
#pragma unroll
        for (int ks = 0; ks < 4; ++ks) { const v4u pv = *(const v4u*)(S2 + ((size_t)ks * 1024 + r) * 2304 + t9 * 256 + c8);
            s[0] += bflo(pv.x); s[1] += bfhi(pv.x); s[2] += bflo(pv.y); s[3] += bfhi(pv.y); s[4] += bflo(pv.z); s[5] += bfhi(pv.z); s[6] += bflo(pv.w); s[7] += bfhi(pv.w); }
        *(v4u*)(P + (size_t)(MLAT + r) * LDP + pn * 256 + c8) = (v4u){pk2(s[0], s[1]), pk2(s[2], s[3]), pk2(s[4], s[5]), pk2(s[6], s[7])};
    }
}
__device__ __forceinline__ void conv_phase(const Args& a, const Ctx& T) {
    const bf16* P = (const bf16*)(a.ws + WS_PROJ); bf16* QK = (bf16*)(a.ws + WS_QK);
    const float* cw = a.in[I_CONVW]; const float* cb = a.in[I_CONVB];
    const int gid = T.vcu * NTHREADS + T.tid; const int ch0 = (gid & 63) * 8; const int m0 = gid >> 6, mstep = (T.G * NTHREADS) >> 6;
    {
        float w[9][8], bias[8];
#pragma unroll
        for (int k = 0; k < 9; ++k)
#pragma unroll
            for (int i = 0; i < 8; ++i) w[k][i] = cw[k * 512 + ch0 + i];
#pragma unroll
        for (int i = 0; i < 8; ++i) bias[i] = cb[ch0 + i];
        const float sc = ch0 < 256 ? 0.125f : 1.0f;
        ConvTaps R;
        if (m0 < MLAT) conv_load(R, P, m0, ch0);
        for (int m = m0; m < MLAT; m += mstep) {
            float acc[8];
#pragma unroll
            for (int i = 0; i < 8; ++i) acc[i] = bias[i];
#pragma unroll
            for (int k = 0; k < 9; ++k) { const v4u pv = R.t[k];
                acc[0] += w[k][0] * bflo(pv.x); acc[1] += w[k][1] * bfhi(pv.x); acc[2] += w[k][2] * bflo(pv.y); acc[3] += w[k][3] * bfhi(pv.y);
                acc[4] += w[k][4] * bflo(pv.z); acc[5] += w[k][5] * bfhi(pv.z); acc[6] += w[k][6] * bflo(pv.w); acc[7] += w[k][7] * bfhi(pv.w); }
            if (m + mstep < MLAT) conv_load(R, P, m + mstep, ch0);
#pragma unroll
            for (int i = 0; i < 8; ++i) acc[i] = acc[i] * fast_sig(acc[i]) * sc;
            v4u o; o.x = pk2(acc[0], acc[1]); o.y = pk2(acc[2], acc[3]); o.z = pk2(acc[4], acc[5]); o.w = pk2(acc[6], acc[7]);
            *(v4u*)(QK + (size_t)m * 512 + ch0) = o;
        }
    }
    {
        const bf16* S2 = (const bf16*)(a.ws + WS_SLAB2);
#pragma unroll 1
        for (int task = gid; task < MCTX * 32; task += T.G * NTHREADS) {
            const int mc = task >> 5, c8 = (task & 31) * 8, b = mc >> 8, t = mc & 255;
            float acc[8];
#pragma unroll
            for (int i = 0; i < 8; ++i) acc[i] = cb[256 + c8 + i];
#pragma unroll 1
            for (int d = -1; d <= 1; ++d) { const int t2 = t + d; if (t2 < 0 || t2 >= 256) continue;
                float s[8] = {0.f, 0.f, 0.f, 0.f, 0.f, 0.f, 0.f, 0.f};
#pragma unroll
                for (int ks = 0; ks < 4; ++ks) { const v4u pv = *(const v4u*)(S2 + ((size_t)ks * 1024 + b * 256 + t2) * 2304 + 6 * 256 + c8);
                    s[0] += bflo(pv.x); s[1] += bfhi(pv.x); s[2] += bflo(pv.y); s[3] += bfhi(pv.y); s[4] += bflo(pv.z); s[5] += bfhi(pv.z); s[6] += bflo(pv.w); s[7] += bfhi(pv.w); }
                const float* wk = cw + (3 + d + 1) * 512 + 256 + c8;
#pragma unroll
                for (int i = 0; i < 8; ++i) acc[i] += wk[i] * bf2f((unsigned short)f2bf(s[i])); }
#pragma unroll
            for (int i = 0; i < 8; ++i) acc[i] = acc[i] * fast_sig(acc[i]);
            v4u o; o.x = pk2(acc[0], acc[1]); o.y = pk2(acc[2], acc[3]); o.z = pk2(acc[4], acc[5]); o.w = pk2(acc[6], acc[7]);
            *(v4u*)(QK + (size_t)(MLAT + mc) * 512 + 256 + c8) = o;
        }
    }
}

typedef short bf16x8 __attribute__((ext_vector_type(8)));
typedef float f32x2 __attribute__((ext_vector_type(2)));
#define MFMA16(a, b, c) __builtin_amdgcn_mfma_f32_16x16x32_bf16((a), (b), (c), 0, 0, 0)
template <int KSTEPS>
__device__ __forceinline__ void mma_tile(f32x4& acc, const LAS unsigned char* A, int sa, const LAS unsigned char* B, int sb, int lane) {
    const LAS unsigned char* pa = A + (lane & 15) * sa + (lane >> 4) * 16; const LAS unsigned char* pb = B + (lane & 15) * sb + (lane >> 4) * 16;
#pragma unroll
    for (int ks = 0; ks < KSTEPS; ++ks) { const bf16x8 av = *(const LAS bf16x8*)(pa + ks * 64); const bf16x8 bv = *(const LAS bf16x8*)(pb + ks * 64); acc = MFMA16(av, bv, acc); }
}
typedef __bf16 bf16x2_t __attribute__((ext_vector_type(2)));
__device__ __forceinline__ unsigned cvtpk(float lo, float hi) { const f32x2 v = {lo, hi}; const bf16x2_t b = __builtin_convertvector(v, bf16x2_t); return __builtin_bit_cast(unsigned, b); }
struct BF2 { bf16x8 k0, k1; };
struct BF4 { bf16x8 k0, k1, k2, k3; };
__device__ __forceinline__ BF2 ldfrag2(const LAS unsigned char* B, int sb, int lane) { const LAS unsigned char* p = B + (lane & 15) * sb + (lane >> 4) * 16; BF2 f; f.k0 = *(const LAS bf16x8*)p; f.k1 = *(const LAS bf16x8*)(p + 64); return f; }
__device__ __forceinline__ BF4 ldfrag4(const LAS unsigned char* B, int sb, int lane) { const LAS unsigned char* p = B + (lane & 15) * sb + (lane >> 4) * 16; BF4 f; f.k0 = *(const LAS bf16x8*)p; f.k1 = *(const LAS bf16x8*)(p + 64); f.k2 = *(const LAS bf16x8*)(p + 128); f.k3 = *(const LAS bf16x8*)(p + 192); return f; }
__device__ __forceinline__ void mma2(f32x4& acc, const LAS unsigned char* A, int sa, const BF2& b, int lane) { const LAS unsigned char* p = A + (lane & 15) * sa + (lane >> 4) * 16;
    acc = MFMA16(*(const LAS bf16x8*)p, b.k0, acc); acc = MFMA16(*(const LAS bf16x8*)(p + 64), b.k1, acc); }
__device__ __forceinline__ void mma4(f32x4& acc, const LAS unsigned char* A, int sa, const BF4& b, int lane) { const LAS unsigned char* p = A + (lane & 15) * sa + (lane >> 4) * 16;
    acc = MFMA16(*(const LAS bf16x8*)p, b.k0, acc); acc = MFMA16(*(const LAS bf16x8*)(p + 64), b.k1, acc); acc = MFMA16(*(const LAS bf16x8*)(p + 128), b.k2, acc); acc = MFMA16(*(const LAS bf16x8*)(p + 192), b.k3, acc); }
__device__ __forceinline__ float ex2(float v) { return __builtin_amdgcn_exp2f(v); }
__device__ __forceinline__ float lg2(float v) { return __builtin_amdgcn_logf(v); }

constexpr int HS_ND = 272;
constexpr int HS_T = 160;
constexpr int HL_QD = 0, HL_KD = HL_QD + 64 * HS_ND, HL_X = HL_KD + 64 * HS_ND, HL_QE = HL_X + 64 * HS_ND;
constexpr int HL_KTT = HL_QE + 64 * HS_ND;
constexpr int HL_VT = HL_KTT + 128 * HS_T;
constexpr int HL_ST = HL_VT + 128 * HS_T;
constexpr int HL_P = HL_ST + 128 * HS_ND;
constexpr int HL_SEG = HL_P + 64 * HS_T;
constexpr int HL_FAC = HL_SEG + 4096;
constexpr int HL_NW = HL_FAC + 512;
constexpr int HL_END = HL_NW + 512;
constexpr int HL_OT = HL_QD, OT_S = 132 * 4;
static_assert(64 * OT_S <= 2 * 64 * HS_ND, "o tile overlay");
static_assert(HL_END <= 160 * 1024 - 1024, "HGRN2 LDS map");

constexpr size_t HG_SLOT_BYTES = 128 * 128 * 2;
__device__ __forceinline__ size_t hg_seq(int b, int dir, int head) { return (size_t)((b * 2 + dir) * 4 + head); }

__device__ __forceinline__ int sc_row(int b, int dir, int js, int lt) {
    if (js == 0) return MLAT + b * NCTX + (dir ? NCTX - 1 - lt : lt);
    const int q = 256 * (js - 1) + lt; return b * SEQ + (dir ? SEQ - 1 - q : q);
}

constexpr int P1_S = 544;
constexpr int P1_KTT = 0, P1_VT = P1_KTT + 128 * P1_S, P1_SEG = P1_VT + 128 * P1_S, P1_END = P1_SEG + 4096;
static_assert(P1_END <= 159 * 1024, "pass-1 LDS map");
__device__ __forceinline__ int p1_row(int b, int blk, int lt) { return blk < 0 ? MLAT + b * NCTX + lt : b * SEQ + 256 * blk + lt; }
template <int DIR>
__device__ __forceinline__ void hg_p1_dir(const Args& a, const Ctx& T, int b, int head, int blk, int slot, bool load_v) {
    const bf16* P = (const bf16*)(a.ws + WS_PROJ);
    LAS unsigned char* L = T.lds;
    const int w = T.wave, l = T.lane, g = l >> 4, c16 = l & 15;
    const int ch = head * 128 + 2 * l;
    const float* lbl = a.in[I_LBLOG];
    float lb[2];
#pragma unroll
    for (int x = 0; x < 2; ++x) lb[x] = sigmoidf_(lbl[DIR * 512 + ch + x] - lbl[(2 + DIR) * 512 + ch + x]);
    unsigned fw[32];
#pragma unroll
    for (int i = 0; i < 32; ++i) fw[i] = *(const unsigned*)(P + (size_t)p1_row(b, blk, 32 * w + i) * LDP + (DIR ? 2048 : 1536) + ch);
    if (load_v) {
        unsigned vw[32];
#pragma unroll
        for (int i = 0; i < 32; ++i) vw[i] = *(const unsigned*)(P + (size_t)p1_row(b, blk, 32 * w + i) * LDP + 512 + ch);
#pragma unroll
        for (int x = 0; x < 2; ++x)
#pragma unroll
            for (int q = 0; q < 4; ++q) { unsigned pv[4];
#pragma unroll
                for (int i = 0; i < 8; i += 2) { const unsigned v0 = x ? (vw[8 * q + i] >> 16) : (vw[8 * q + i] & 0xffffu), v1 = x ? (vw[8 * q + i + 1] >> 16) : (vw[8 * q + i + 1] & 0xffffu); pv[i >> 1] = v0 | (v1 << 16); }
                *(LAS v4u*)(L + P1_VT + (2 * l + x) * P1_S + 64 * w + 16 * q) = (v4u){pv[0], pv[1], pv[2], pv[3]}; }
    }
    float tot[2] = {0.f, 0.f};
#pragma unroll
    for (int i = 0; i < 32; ++i) {
        const float s0 = fast_sig(bflo(fw[i])), s1 = fast_sig(bfhi(fw[i]));
        tot[0] += lg2(lb[0] + (1.f - lb[0]) * s0); tot[1] += lg2(lb[1] + (1.f - lb[1]) * s1); }
    *(LAS f32x2*)(L + P1_SEG + (w * 128 + 2 * l) * 4) = (f32x2){tot[0], tot[1]};
    __syncthreads();
    float after[2] = {0.f, 0.f}, all[2] = {0.f, 0.f};
#pragma unroll
    for (int ww = 0; ww < 8; ++ww) { const f32x2 t2 = *(const LAS f32x2*)(L + P1_SEG + (ww * 128 + 2 * l) * 4); all[0] += t2.x; all[1] += t2.y;
        if (DIR ? (ww < w) : (ww > w)) { after[0] += t2.x; after[1] += t2.y; } }
#pragma unroll
    for (int x = 0; x < 2; ++x) {
        float run = after[x];
#pragma unroll
        for (int q = 0; q < 4; ++q) { float kv[8];
#pragma unroll
            for (int ii = 0; ii < 8; ++ii) { const int i = DIR ? 8 * q + ii : 31 - (8 * q + ii);
                const float fp = x ? bfhi(fw[i]) : bflo(fw[i]); const float sg = fast_sig(fp); const float f = lb[x] + (1.f - lb[x]) * sg;
                kv[ii] = (1.f - lb[x]) * (1.f - sg) * ex2(run); run += lg2(f); }
            if (DIR) *(LAS v4u*)(L + P1_KTT + (2 * l + x) * P1_S + 64 * w + 16 * q) = (v4u){cvtpk(kv[0], kv[1]), cvtpk(kv[2], kv[3]), cvtpk(kv[4], kv[5]), cvtpk(kv[6], kv[7])};
            else *(LAS v4u*)(L + P1_KTT + (2 * l + x) * P1_S + 64 * w + 16 * (3 - q)) = (v4u){cvtpk(kv[7], kv[6]), cvtpk(kv[5], kv[4]), cvtpk(kv[3], kv[2]), cvtpk(kv[1], kv[0])};
        }
    }
    __syncthreads();
    f32x4 accS[8];
#pragma unroll
    for (int m = 0; m < 8; ++m) accS[m] = (f32x4){0.f, 0.f, 0.f, 0.f};
#pragma unroll
    for (int kh = 0; kh < 4; ++kh) {
        const BF2 vf = ldfrag2(L + P1_VT + 16 * w * P1_S + 128 * kh, P1_S, l);
#pragma unroll
        for (int mh = 0; mh < 8; mh += 4) { BF2 kf[4];
#pragma unroll
            for (int m = 0; m < 4; ++m) kf[m] = ldfrag2(L + P1_KTT + 16 * (mh + m) * P1_S + 128 * kh, P1_S, l);
#pragma unroll
            for (int m = 0; m < 4; ++m) accS[mh + m] = MFMA16(kf[m].k0, vf.k0, accS[mh + m]);
#pragma unroll
            for (int m = 0; m < 4; ++m) accS[mh + m] = MFMA16(kf[m].k1, vf.k1, accS[mh + m]); } }
    const size_t sidx = hg_seq(b, DIR, head) * 16 + slot;
    bf16* ST = (bf16*)(a.ws + WS_HGST + sidx * HG_SLOT_BYTES);
#pragma unroll
    for (int m = 0; m < 8; ++m) { v2u o; o.x = cvtpk(accS[m][0], accS[m][1]); o.y = cvtpk(accS[m][2], accS[m][3]); *(v2u*)(ST + (size_t)(16 * w + c16) * 128 + 16 * m + 4 * g) = o; }
    if (w == 0) *(f32x2*)((float*)(a.ws + WS_HGG) + sidx * 128 + 2 * l) = (f32x2){ex2(all[0]), ex2(all[1])};
}
__device__ __forceinline__ void hg_pass1_items(const Args& a, const Ctx& T0, int first, int stride, int limit) {
#pragma unroll 1
    for (int item = first; item < limit; item += stride) {
        Ctx T = T0; asm volatile("" : "+v"(T.lane)); T.tid = T.wave * 64 + T.lane;
        const int k = item & 15, head = (item >> 4) & 3, b = item >> 6;
        const int blkF = k == 0 ? -1 : (k == 15 ? 0 : k), slotF = k == 0 ? 0 : (k == 15 ? 1 : k + 1);
        const int blkB = k == 0 ? -1 : (k == 15 ? 15 : k), slotB = k == 0 ? 0 : (k == 15 ? 1 : 16 - k);
        __syncthreads();
        hg_p1_dir<0>(a, T, b, head, blkF, slotF, true);
        __syncthreads();
        hg_p1_dir<1>(a, T, b, head, blkB, slotB, blkB != blkF);
    }
}

__device__ __forceinline__ void hg_pass2(const Args& a, const Ctx& T) {
    const int ntask = 32 * 2048;
    for (int task = T.vcu * NTHREADS + T.tid; task < ntask; task += T.G * NTHREADS) {
        const int seq = task >> 11, el = (task & 2047) * 8, d0 = el & 127;
        float r[8];
#pragma unroll
        for (int i = 0; i < 8; ++i) r[i] = 0.f;
        for (int j = 0; j < 16; ++j) {
            v4u* p = (v4u*)(a.ws + WS_HGST + ((size_t)seq * 16 + j) * HG_SLOT_BYTES + (size_t)el * 2);
            const float* G = (const float*)(a.ws + WS_HGG) + ((size_t)seq * 16 + j) * 128 + d0;
            const v4u dv = *p; const f32x4 g0 = *(const f32x4*)G, g1 = *(const f32x4*)(G + 4);
            r[0] = g0.x * r[0] + bflo(dv.x); r[1] = g0.y * r[1] + bfhi(dv.x); r[2] = g0.z * r[2] + bflo(dv.y); r[3] = g0.w * r[3] + bfhi(dv.y);
            r[4] = g1.x * r[4] + bflo(dv.z); r[5] = g1.y * r[5] + bfhi(dv.z); r[6] = g1.z * r[6] + bflo(dv.w); r[7] = g1.w * r[7] + bfhi(dv.w);
            *p = (v4u){pk2(r[0], r[1]), pk2(r[2], r[3]), pk2(r[4], r[5]), pk2(r[6], r[7])};
        }
    }
}

struct HgP3Pre { unsigned fw[8], qw[8], vw[8]; };
__device__ __forceinline__ void hg_p3_load(HgP3Pre& R, const bf16* P, int b, int head, int jt, int step, int w, int l) {
    const int dir = step >> 2, c = step & 3; const int ch = head * 128 + 2 * l;
#pragma unroll
    for (int i = 0; i < 8; ++i) { const int lt = 64 * c + 8 * w + i; const size_t row = (size_t)(b * SEQ + 256 * jt + (dir ? 255 - lt : lt));
        R.fw[i] = *(const unsigned*)(P + row * LDP + (dir ? 2048 : 1536) + ch); R.qw[i] = *(const unsigned*)(P + row * LDP + ch); R.vw[i] = *(const unsigned*)(P + row * LDP + 512 + ch); }
}
__device__ __forceinline__ void hg_pass3_item(const Args& a, const Ctx& T0, int item, bf16* OUT) {
    const int jt = item & 15, head = (item >> 4) & 3, b = item >> 6;
    const bf16* P = (const bf16*)(a.ws + WS_PROJ);
    Ctx T = T0; asm volatile("" : "+v"(T.lane));
    T.tid = T.wave * 64 + T.lane;
    LAS unsigned char* L = T.lds;
    const int w = T.wave, l = T.lane, g = l >> 4, c16 = l & 15;
    const int ch = head * 128 + 2 * l;
    const float* lbl = a.in[I_LBLOG];
    __syncthreads();
    for (int i = T.tid; i < 64 * HS_T / 16; i += NTHREADS) *(LAS v4u*)(L + HL_P + i * 16) = (v4u){0u, 0u, 0u, 0u};
    if (T.tid < 128) *(LAS float*)(L + HL_NW + T.tid * 4) = a.in[I_HGNW][head * 128 + T.tid];
    HgP3Pre R;
    hg_p3_load(R, P, b, head, jt, 0, w, l);
    v4u stq[4];
#define HG_STATE_LOAD(dir_) do { const bf16* STg_ = (const bf16*)(a.ws + WS_HGST + (hg_seq(b, (dir_), head) * 16 + ((dir_) ? 15 - jt : jt)) * HG_SLOT_BYTES); \
        _Pragma("unroll") for (int q_ = 0; q_ < 4; ++q_) { const int idx_ = l + 64 * q_; stq[q_] = *(const v4u*)(STg_ + (size_t)(16 * w + (idx_ >> 4)) * 128 + (idx_ & 15) * 8); } } while (0)
    HG_STATE_LOAD(0);
    f32x4 accS[8];
    float lb[2] = {0.f, 0.f};
    const int ot = T.tid >> 3, opart = T.tid & 7;
#pragma unroll 1
    for (int step = 0; step < 8; ++step) {
        const int dir = step >> 2, c = step & 3;
        PS_BEGIN();
        if (c == 0) {
#pragma unroll
            for (int x = 0; x < 2; ++x) lb[x] = sigmoidf_(lbl[dir * 512 + ch + x] - lbl[(2 + dir) * 512 + ch + x]);
            if (dir == 1) { HG_STATE_LOAD(1); VM_WAIT(); __syncthreads(); if (w == 0) { __builtin_amdgcn_fence(__ATOMIC_ACQUIRE, "agent"); VM_WAIT(); } __syncthreads(); }
#pragma unroll
            for (int q = 0; q < 4; ++q) { const int idx = l + 64 * q; *(LAS v4u*)(L + HL_ST + (16 * w + (idx >> 4)) * HS_ND + (idx & 15) * 16) = stq[q]; }
            LDS_WAIT();
#pragma unroll
            for (int m = 0; m < 8; ++m) { const v2u sv = *(const LAS v2u*)(L + HL_ST + (16 * w + c16) * HS_ND + (16 * m + 4 * g) * 2); accS[m] = (f32x4){bflo(sv.x), bfhi(sv.x), bflo(sv.y), bfhi(sv.y)}; }
        }
        PS_END(11);
        float kk[2][8], cl[2][8]; unsigned qw[8], vw[8];
#pragma unroll
        for (int i = 0; i < 8; ++i) { qw[i] = R.qw[i]; vw[i] = R.vw[i]; }
#pragma unroll
        for (int x = 0; x < 2; ++x) { float run = 0.f;
#pragma unroll
            for (int i = 0; i < 8; ++i) { const float fp = x ? bfhi(R.fw[i]) : bflo(R.fw[i]); const float sg = fast_sig(fp); const float f = lb[x] + (1.f - lb[x]) * sg;
                kk[x][i] = (1.f - lb[x]) * (1.f - sg); run += lg2(f); cl[x][i] = run; } }
        if (step < 7) hg_p3_load(R, P, b, head, jt, step + 1, w, l);
        *(LAS f32x2*)(L + HL_SEG + (w * 128 + 2 * l) * 4) = (f32x2){cl[0][7], cl[1][7]};
        PS_END(0); __syncthreads(); PS_END(1);
        const int half = w >> 2;
        float pre[2], mid[2], fx[2], fqe[2], fkt[2];
#pragma unroll
        for (int x = 0; x < 2; ++x) {
            float tt[8];
#pragma unroll
            for (int ww = 0; ww < 8; ++ww) tt[ww] = *(const LAS float*)(L + HL_SEG + (ww * 128 + 2 * l + x) * 4);
            const float r15 = tt[0] + tt[1], r31 = r15 + tt[2] + tt[3], r47 = r31 + tt[4] + tt[5], r63 = r47 + tt[6] + tt[7];
            float p = 0.f;
#pragma unroll
            for (int ww = 0; ww < 8; ++ww) if (ww < w) p += tt[ww];
            pre[x] = p; mid[x] = half ? r47 : r15;
            fx[x] = half ? ex2(r47 - r31) : ex2(r31 - r15); fqe[x] = ex2(mid[x]); fkt[x] = ex2(r63 - mid[x]);
            if (w == 0) *(LAS float*)(L + HL_FAC + (2 * l + x) * 4) = ex2(r63);
        }
        float ktv[2][8];
#pragma unroll
        for (int i = 0; i < 8; ++i) {
            float qd[2], kd[2], xv[2], qe[2];
#pragma unroll
            for (int x = 0; x < 2; ++x) { const float cc = pre[x] + cl[x][i] - mid[x]; const float eq = ex2(cc), ek = ex2(-cc); const float q = x ? bfhi(qw[i]) : bflo(qw[i]);
                qd[x] = q * eq; kd[x] = kk[x][i] * ek; xv[x] = (half ? qd[x] : kd[x]) * fx[x]; qe[x] = qd[x] * fqe[x]; ktv[x][i] = kd[x] * fkt[x]; }
            const int off = (8 * w + i) * HS_ND + 4 * l;
            *(LAS unsigned*)(L + HL_QD + off) = cvtpk(qd[0], qd[1]); *(LAS unsigned*)(L + HL_KD + off) = cvtpk(kd[0], kd[1]);
            *(LAS unsigned*)(L + HL_X + off) = cvtpk(xv[0], xv[1]); *(LAS unsigned*)(L + HL_QE + off) = cvtpk(qe[0], qe[1]);
        }
#pragma unroll
        for (int x = 0; x < 2; ++x) {
            unsigned pv[4];
#pragma unroll
            for (int i = 0; i < 8; i += 2) { const unsigned v0 = x ? (vw[i] >> 16) : (vw[i] & 0xffffu), v1 = x ? (vw[i + 1] >> 16) : (vw[i + 1] & 0xffffu); pv[i >> 1] = v0 | (v1 << 16); }
            *(LAS v4u*)(L + HL_KTT + (2 * l + x) * HS_T + 16 * w) = (v4u){cvtpk(ktv[x][0], ktv[x][1]), cvtpk(ktv[x][2], ktv[x][3]), cvtpk(ktv[x][4], ktv[x][5]), cvtpk(ktv[x][6], ktv[x][7])};
            *(LAS v4u*)(L + HL_VT + (2 * l + x) * HS_T + 16 * w) = (v4u){pv[0], pv[1], pv[2], pv[3]};
        }
        PS_END(0); __syncthreads(); PS_END(1);
        const size_t orow = (size_t)(b * SEQ + 256 * jt + (dir ? 255 - (64 * c + ot) : 64 * c + ot));
        bf16* optr = OUT + orow * DM + head * 128 + 16 * opart;
        v4u pf0 = (v4u){0u, 0u, 0u, 0u}, pf1 = pf0, pg0 = pf0, pg1 = pf0;
        if (dir) { pf0 = *(const v4u*)optr; pf1 = *(const v4u*)(optr + 8); const bf16* gp = P + orow * LDP + 1024 + head * 128 + 16 * opart; pg0 = *(const v4u*)gp; pg1 = *(const v4u*)(gp + 8); }
        v2u ptile[2]; int paddr[2] = {-1, -1};
#pragma unroll
        for (int rep = 0; rep < 2; ++rep) { const int tix = w + 8 * rep;
            if (tix < 10) {
                const int I = tix < 1 ? 0 : (tix < 3 ? 1 : (tix < 6 ? 2 : 3)); const int J = tix - (I * (I + 1)) / 2;
                const bool same = (I >> 1) == (J >> 1);
                const int abase = same ? HL_KD : HL_X, bbase = same ? HL_QD : HL_X;
                const BF4 af = ldfrag4(L + abase + 16 * J * HS_ND, HS_ND, l), bf = ldfrag4(L + bbase + 16 * I * HS_ND, HS_ND, l);
                f32x4 at = (f32x4){0.f, 0.f, 0.f, 0.f};
                at = MFMA16(af.k0, bf.k0, at); at = MFMA16(af.k1, bf.k1, at); at = MFMA16(af.k2, bf.k2, at); at = MFMA16(af.k3, bf.k3, at);
                const int tloc = 16 * I + c16, s0 = 16 * J + 4 * g;
                float pr[4];
#pragma unroll
                for (int r = 0; r < 4; ++r) pr[r] = (s0 + r <= tloc) ? at[r] : 0.f;
                ptile[rep].x = cvtpk(pr[0], pr[1]); ptile[rep].y = cvtpk(pr[2], pr[3]); paddr[rep] = HL_P + tloc * HS_T + s0 * 2;
            } }
        f32x4 accO[4];
        { const BF4 sf = ldfrag4(L + HL_ST + 16 * w * HS_ND, HS_ND, l);
#pragma unroll
            for (int I = 0; I < 4; ++I) accO[I] = (f32x4){0.f, 0.f, 0.f, 0.f};
#pragma unroll
            for (int ih = 0; ih < 4; ih += 2) {
                const BF4 q0 = ldfrag4(L + HL_QE + ih * 16 * HS_ND, HS_ND, l), q1 = ldfrag4(L + HL_QE + (ih + 1) * 16 * HS_ND, HS_ND, l);
                accO[ih] = MFMA16(q0.k0, sf.k0, accO[ih]); accO[ih + 1] = MFMA16(q1.k0, sf.k0, accO[ih + 1]);
                accO[ih] = MFMA16(q0.k1, sf.k1, accO[ih]); accO[ih + 1] = MFMA16(q1.k1, sf.k1, accO[ih + 1]);
                accO[ih] = MFMA16(q0.k2, sf.k2, accO[ih]); accO[ih + 1] = MFMA16(q1.k2, sf.k2, accO[ih + 1]);
                accO[ih] = MFMA16(q0.k3, sf.k3, accO[ih]); accO[ih + 1] = MFMA16(q1.k3, sf.k3, accO[ih + 1]); } }
        const BF2 vf = ldfrag2(L + HL_VT + 16 * w * HS_T, HS_T, l);
#pragma unroll
        for (int mh = 0; mh < 8; mh += 4) {
            BF2 kf[4]; f32x4 gv[4];
#pragma unroll
            for (int m = 0; m < 4; ++m) { kf[m] = ldfrag2(L + HL_KTT + 16 * (mh + m) * HS_T, HS_T, l); gv[m] = *(const LAS f32x4*)(L + HL_FAC + (16 * (mh + m) + 4 * g) * 4); }
#pragma unroll
            for (int m = 0; m < 4; ++m) accS[mh + m] = accS[mh + m] * gv[m];
#pragma unroll
            for (int m = 0; m < 4; ++m) accS[mh + m] = MFMA16(kf[m].k0, vf.k0, accS[mh + m]);
#pragma unroll
            for (int m = 0; m < 4; ++m) accS[mh + m] = MFMA16(kf[m].k1, vf.k1, accS[mh + m]);
        }
#pragma unroll
        for (int rep = 0; rep < 2; ++rep) if (paddr[rep] >= 0) *(LAS v2u*)(L + paddr[rep]) = ptile[rep];
        PS_END(2); __syncthreads(); PS_END(1);
        { const BF2 p0 = ldfrag2(L + HL_P + 0 * 16 * HS_T, HS_T, l), p1 = ldfrag2(L + HL_P + 1 * 16 * HS_T, HS_T, l), p2 = ldfrag2(L + HL_P + 2 * 16 * HS_T, HS_T, l), p3 = ldfrag2(L + HL_P + 3 * 16 * HS_T, HS_T, l);
            accO[0] = MFMA16(p0.k0, vf.k0, accO[0]); accO[1] = MFMA16(p1.k0, vf.k0, accO[1]); accO[2] = MFMA16(p2.k0, vf.k0, accO[2]); accO[3] = MFMA16(p3.k0, vf.k0, accO[3]);
            accO[0] = MFMA16(p0.k1, vf.k1, accO[0]); accO[1] = MFMA16(p1.k1, vf.k1, accO[1]); accO[2] = MFMA16(p2.k1, vf.k1, accO[2]); accO[3] = MFMA16(p3.k1, vf.k1, accO[3]); }
#pragma unroll
        for (int m = 0; m < 8; ++m) { v2u o; o.x = cvtpk(accS[m][0], accS[m][1]); o.y = cvtpk(accS[m][2], accS[m][3]); *(LAS v2u*)(L + HL_ST + (16 * w + c16) * HS_ND + (16 * m + 4 * g) * 2) = o; }
#pragma unroll
        for (int I = 0; I < 4; ++I)
#pragma unroll
            for (int r = 0; r < 4; ++r) *(LAS float*)(L + HL_OT + (16 * I + 4 * g + r) * OT_S + (16 * w + c16) * 4) = accO[I][r];
        PS_END(3); __syncthreads(); PS_END(1);
        { float ov[16];
#pragma unroll
            for (int q = 0; q < 4; ++q) { const f32x4 t4 = *(const LAS f32x4*)(L + HL_OT + ot * OT_S + (16 * opart + 4 * q) * 4); ov[4 * q] = t4.x; ov[4 * q + 1] = t4.y; ov[4 * q + 2] = t4.z; ov[4 * q + 3] = t4.w; }
            if (dir) {
                float fo[16], gt[16];
#pragma unroll
                for (int q = 0; q < 4; ++q) { fo[2 * q] = bflo(pf0[q]); fo[2 * q + 1] = bfhi(pf0[q]); fo[8 + 2 * q] = bflo(pf1[q]); fo[8 + 2 * q + 1] = bfhi(pf1[q]);
                    gt[2 * q] = bflo(pg0[q]); gt[2 * q + 1] = bfhi(pg0[q]); gt[8 + 2 * q] = bflo(pg1[q]); gt[8 + 2 * q + 1] = bfhi(pg1[q]); }
                float ss = 0.f;
#pragma unroll
                for (int i = 0; i < 16; ++i) { ov[i] += fo[i]; ss += ov[i] * ov[i]; }
                ss += __shfl_xor(ss, 1); ss += __shfl_xor(ss, 2); ss += __shfl_xor(ss, 4);
                const float rstd = __builtin_amdgcn_rsqf(ss * (1.f / 128.f) + EPSN);
#pragma unroll
                for (int q = 0; q < 4; ++q) { const f32x4 nw4 = *(const LAS f32x4*)(L + HL_NW + (16 * opart + 4 * q) * 4);
                    ov[4 * q] *= rstd * nw4.x * gt[4 * q]; ov[4 * q + 1] *= rstd * nw4.y * gt[4 * q + 1]; ov[4 * q + 2] *= rstd * nw4.z * gt[4 * q + 2]; ov[4 * q + 3] *= rstd * nw4.w * gt[4 * q + 3]; }
            }
            *(v4u*)optr = (v4u){cvtpk(ov[0], ov[1]), cvtpk(ov[2], ov[3]), cvtpk(ov[4], ov[5]), cvtpk(ov[6], ov[7])};
            *(v4u*)(optr + 8) = (v4u){cvtpk(ov[8], ov[9]), cvtpk(ov[10], ov[11]), cvtpk(ov[12], ov[13]), cvtpk(ov[14], ov[15])}; }
        PS_END(4);
    }
}

constexpr int MS = 160;
constexpr int ML_Q = 0, ML_K = ML_Q + 64 * MS, ML_KTT = ML_K + 64 * MS, ML_VT = ML_KTT + 64 * MS, ML_CT = ML_VT + 144 * MS, ML_P = ML_CT + 144 * MS;
constexpr int ML_TA = ML_P + 64 * MS;
constexpr int ML_TMU = ML_TA + 1024, ML_TIW = ML_TMU + 1024, ML_TSW = ML_TIW + 1024, ML_TEM = ML_TSW + 1024;
constexpr int ML_TRI = ML_TEM + 1024;
constexpr int ML_SC = ML_TRI + 256;
constexpr int ML_NW = ML_SC + 64;
constexpr int ML_OT = ML_NW + 512;
constexpr int ML_END = ML_OT + 64 * OT_S;
static_assert(ML_END <= 159 * 1024, "mLSTM LDS map");
constexpr size_t ML_SLOT_BYTES = 144 * 64 * 2;
constexpr float LOG2E = 1.4426950408889634f;

__device__ __forceinline__ float wave_incl_sum(float v, int lane) {
#pragma unroll
    for (int o = 1; o < 64; o <<= 1) { const float t = __shfl_up(v, o); if (lane >= o) v += t; }
    return v;
}
__device__ __forceinline__ float wave_incl_max(float v, int lane) {
#pragma unroll
    for (int o = 1; o < 64; o <<= 1) { const float t = __shfl_up(v, o); if (lane >= o) v = fmaxf(v, t); }
    return v;
}
template <bool WHOLE>
__device__ __forceinline__ float ml_scalars256(LAS unsigned char* L, const float (&ig)[4], const float (&fg)[4], float m_prev, float& bsum, int lane, int tb = 0) {
    f32x4 B, av, mu;
    { float run = 0.f;
#pragma unroll
        for (int i = 0; i < 4; ++i) { run += (fminf(fg[i], 0.f) - log1pf(__expf(-fabsf(fg[i])))) * LOG2E; B[i] = run; } }
    { const float incl = wave_incl_sum(B[3], lane); B = B + (incl - B[3]); }
#pragma unroll
    for (int i = 0; i < 4; ++i) av[i] = ig[i] * LOG2E - B[i];
    *(LAS f32x4*)(L + tb + ML_TA + lane * 16) = av;
    { float pm = av[0]; mu[0] = pm; pm = fmaxf(pm, av[1]); mu[1] = pm; pm = fmaxf(pm, av[2]); mu[2] = pm; pm = fmaxf(pm, av[3]); mu[3] = pm;
        const float inclm = wave_incl_max(pm, lane); float exm = __shfl_up(inclm, 1); if (lane == 0) exm = m_prev; exm = fmaxf(exm, m_prev);
#pragma unroll
        for (int i = 0; i < 4; ++i) mu[i] = fmaxf(mu[i], exm); }
    *(LAS f32x4*)(L + tb + ML_TMU + lane * 16) = mu;
    { f32x4 te;
#pragma unroll
        for (int i = 0; i < 4; ++i) te[i] = ex2(-(B[i] + mu[i]));
        *(LAS f32x4*)(L + tb + ML_TEM + lane * 16) = te; }
    const float b255 = __shfl(B[3], 63), mu255 = __shfl(mu[3], 63);
    const int c = lane >> 4;
    const float mu_end = WHOLE ? mu255 : __shfl(mu[3], 16 * c + 15); float mu_start = __shfl(mu[3], (16 * c + 63) & 63); if (c == 0) mu_start = m_prev;
    { f32x4 ti;
#pragma unroll
        for (int i = 0; i < 4; ++i) ti[i] = ex2(mu_start - mu[i]);
        *(LAS f32x4*)(L + tb + ML_TIW + lane * 16) = ti; }
    { f32x4 ts;
#pragma unroll
        for (int i = 0; i < 4; ++i) ts[i] = ex2(av[i] - mu_end);
        *(LAS f32x4*)(L + tb + ML_TSW + lane * 16) = ts; }
    if ((lane & 15) == 0) *(LAS float*)(L + tb + ML_SC + c * 4) = ex2(mu_start - mu_end);
    bsum = b255;
    return b255 + mu255;
}
__device__ __forceinline__ void ml_aug_rows(LAS unsigned char* L, int tid) {
    for (int i = tid; i < 16 * 8; i += NTHREADS) { const int r = i >> 3, q = i & 7; const unsigned v = r == 0 ? 0x3F803F80u : 0u; *(LAS v4u*)(L + ML_VT + (128 + r) * MS + q * 16) = (v4u){v, v, v, v}; }
}
struct MlPre { unsigned kw[8], vw[8]; v4u qn, kn; };
#define ML_LOAD_KV(R, ROWF) do { \
    if (T.tid < 256) { const int dp_ = T.tid & 31, tg_ = T.tid >> 5; _Pragma("unroll") for (int i = 0; i < 8; ++i) { const size_t row_ = (size_t)(ROWF(8 * tg_ + i)); (R).kw[i] = *(const unsigned*)(QK + row_ * 512 + 256 + head * 64 + 2 * dp_); } } \
    { const int ep_ = T.tid & 63, tg_ = T.tid >> 6; _Pragma("unroll") for (int i = 0; i < 8; ++i) { const size_t row_ = (size_t)(ROWF(8 * tg_ + i)); (R).vw[i] = *(const unsigned*)(P + row_ * LDP + 3072 + head * 128 + 2 * ep_); } } \
} while (0)
#define ML_STORE_KV(R, cch) do { \
    if (T.tid < 256) { const int dp_ = T.tid & 31, tg_ = T.tid >> 5; \
        const f32x4 s0_ = *(const LAS f32x4*)(L + ML_TSW + ((cch) * 64 + 8 * tg_) * 4), s1_ = *(const LAS f32x4*)(L + ML_TSW + ((cch) * 64 + 8 * tg_ + 4) * 4); \
        const float sw_[8] = {s0_.x, s0_.y, s0_.z, s0_.w, s1_.x, s1_.y, s1_.z, s1_.w}; \
        _Pragma("unroll") for (int x = 0; x < 2; ++x) { float kv_[8]; _Pragma("unroll") for (int i = 0; i < 8; ++i) kv_[i] = (x ? bfhi((R).kw[i]) : bflo((R).kw[i])) * sw_[i]; \
            *(LAS v4u*)(L + ML_KTT + (2 * dp_ + x) * MS + 16 * tg_) = (v4u){cvtpk(kv_[0], kv_[1]), cvtpk(kv_[2], kv_[3]), cvtpk(kv_[4], kv_[5]), cvtpk(kv_[6], kv_[7])}; } } \
    { const int ep_ = T.tid & 63, tg_ = T.tid >> 6; \
        _Pragma("unroll") for (int x = 0; x < 2; ++x) { unsigned pv_[4]; \
            _Pragma("unroll") for (int i = 0; i < 8; i += 2) { const unsigned v0_ = x ? ((R).vw[i] >> 16) : ((R).vw[i] & 0xffffu), v1_ = x ? ((R).vw[i + 1] >> 16) : ((R).vw[i + 1] & 0xffffu); pv_[i >> 1] = v0_ | (v1_ << 16); } \
            *(LAS v4u*)(L + ML_VT + (2 * ep_ + x) * MS + 16 * tg_) = (v4u){pv_[0], pv_[1], pv_[2], pv_[3]}; } } \
} while (0)

constexpr int Q1_KTT = 0, Q1_VT = Q1_KTT + 64 * P1_S, Q1_TAB = Q1_VT + 144 * P1_S;
constexpr int Q1_TB = Q1_TAB - ML_TA;
static_assert(ML_SC + Q1_TB + 64 <= 159 * 1024, "mLSTM pass-1 LDS map");
template <int DIR>
__device__ __forceinline__ void ml_p1_dir(const Args& a, const Ctx& T, int b, int head, int blk, int slot, const unsigned (&kw)[16], const float (&ig)[4], const float (&fg)[4]) {
    LAS unsigned char* L = T.lds;
    const int w = T.wave, l = T.lane, g = l >> 4, c16 = l & 15;
    float mloc = 0.f, bsum = 0.f;
    if (w == 0) mloc = ml_scalars256<true>(L, ig, fg, -1e30f, bsum, l, Q1_TB);
    __syncthreads();
    { const int dp = T.tid & 31, tg = T.tid >> 5;
        float sw[16];
#pragma unroll
        for (int q = 0; q < 4; ++q) { const int s0 = 16 * tg + 4 * q;
            const f32x4 t4 = *(const LAS f32x4*)(L + Q1_TB + ML_TSW + (DIR ? 252 - s0 : s0) * 4);
            sw[4 * q] = DIR ? t4.w : t4.x; sw[4 * q + 1] = DIR ? t4.z : t4.y; sw[4 * q + 2] = DIR ? t4.y : t4.z; sw[4 * q + 3] = DIR ? t4.x : t4.w; }
#pragma unroll
        for (int x = 0; x < 2; ++x)
#pragma unroll
            for (int q = 0; q < 2; ++q) { float kv[8];
#pragma unroll
                for (int i = 0; i < 8; ++i) kv[i] = (x ? bfhi(kw[8 * q + i]) : bflo(kw[8 * q + i])) * sw[8 * q + i];
                *(LAS v4u*)(L + Q1_KTT + (2 * dp + x) * P1_S + 32 * tg + 16 * q) = (v4u){cvtpk(kv[0], kv[1]), cvtpk(kv[2], kv[3]), cvtpk(kv[4], kv[5]), cvtpk(kv[6], kv[7])}; } }
    __syncthreads();
    f32x4 accC[4], accCA = (f32x4){0.f, 0.f, 0.f, 0.f};
#pragma unroll
    for (int m = 0; m < 4; ++m) accC[m] = (f32x4){0.f, 0.f, 0.f, 0.f};
#pragma unroll
    for (int kh = 0; kh < 4; ++kh) {
        const BF2 vf = ldfrag2(L + Q1_VT + 16 * w * P1_S + 128 * kh, P1_S, l);
        BF2 kf[4];
#pragma unroll
        for (int m = 0; m < 4; ++m) kf[m] = ldfrag2(L + Q1_KTT + 16 * m * P1_S + 128 * kh, P1_S, l);
#pragma unroll
        for (int m = 0; m < 4; ++m) accC[m] = MFMA16(kf[m].k0, vf.k0, accC[m]);
#pragma unroll
        for (int m = 0; m < 4; ++m) accC[m] = MFMA16(kf[m].k1, vf.k1, accC[m]);
        if (w < 4) { const BF2 af = ldfrag2(L + Q1_VT + 128 * P1_S + 128 * kh, P1_S, l); const BF2 kfw = ldfrag2(L + Q1_KTT + 16 * w * P1_S + 128 * kh, P1_S, l);
            accCA = MFMA16(kfw.k0, af.k0, accCA); accCA = MFMA16(kfw.k1, af.k1, accCA); } }
    const size_t sidx = hg_seq(b, DIR, head) * 16 + slot;
    bf16* CT = (bf16*)(a.ws + WS_MLST + sidx * ML_SLOT_BYTES);
#pragma unroll
    for (int m = 0; m < 4; ++m) { v2u o; o.x = cvtpk(accC[m][0], accC[m][1]); o.y = cvtpk(accC[m][2], accC[m][3]); *(v2u*)(CT + (size_t)(16 * w + c16) * 64 + 16 * m + 4 * g) = o; }
    if (w < 4) { v2u o; o.x = cvtpk(accCA[0], accCA[1]); o.y = cvtpk(accCA[2], accCA[3]); *(v2u*)(CT + (size_t)(128 + c16) * 64 + 16 * w + 4 * g) = o; }
    if (T.tid == 0) { float* sc = (float*)(a.ws + WS_MLSC) + sidx * 4; sc[0] = mloc; sc[1] = bsum; }
}
__device__ __forceinline__ void ml_pass1_items(const Args& a, const Ctx& T0, int first, int stride, int limit) {
    const bf16* P = (const bf16*)(a.ws + WS_PROJ); const bf16* QK = (const bf16*)(a.ws + WS_QK); const float* GT = (const float*)(a.ws + WS_GATES);
    __syncthreads();
    for (int i = T0.tid; i < 16 * 32; i += NTHREADS) { const int r = i >> 5, q = i & 31; const unsigned v = r == 0 ? 0x3F803F80u : 0u; *(LAS v4u*)(T0.lds + Q1_VT + (128 + r) * P1_S + q * 16) = (v4u){v, v, v, v}; }
#pragma unroll 1
    for (int item = first; item < limit; item += stride) {
        Ctx T = T0; asm volatile("" : "+v"(T.lane)); T.tid = T.wave * 64 + T.lane;
        LAS unsigned char* L = T.lds;
        const int w = T.wave, l = T.lane;
        const int k = item & 15, head = (item >> 4) & 3, b = item >> 6;
        const int blkF = k == 0 ? -1 : (k == 15 ? 0 : k), slotF = k == 0 ? 0 : (k == 15 ? 1 : k + 1);
        const int blkB = k == 0 ? -1 : (k == 15 ? 15 : k), slotB = k == 0 ? 0 : (k == 15 ? 1 : 16 - k);
#pragma unroll 1
        for (int dir = 0; dir < 2; ++dir) {
            const int blk = dir ? blkB : blkF;
            float ig[4] = {0.f, 0.f, 0.f, 0.f}, fg[4] = {0.f, 0.f, 0.f, 0.f};
            if (w == 0) {
#pragma unroll
                for (int c = 0; c < 4; ++c) { const int u = 4 * l + c; const size_t row = (size_t)p1_row(b, blk, dir ? 255 - u : u); ig[c] = GT[row * 16 + (dir ? 8 : 0) + head]; fg[c] = GT[row * 16 + (dir ? 12 : 4) + head]; } }
            unsigned kw[16];
            { const int dp = T.tid & 31, tg = T.tid >> 5;
#pragma unroll
                for (int i = 0; i < 16; ++i) kw[i] = *(const unsigned*)(QK + (size_t)p1_row(b, blk, 16 * tg + i) * 512 + 256 + head * 64 + 2 * dp); }
            __syncthreads();
            if (dir == 0 || blkB != blkF) {
                const int ep = T.tid & 63, tg = T.tid >> 6; unsigned vw[32];
#pragma unroll
                for (int i = 0; i < 32; ++i) vw[i] = *(const unsigned*)(P + (size_t)p1_row(b, blk, 32 * tg + i) * LDP + 3072 + head * 128 + 2 * ep);
#pragma unroll
                for (int x = 0; x < 2; ++x)
#pragma unroll
                    for (int q = 0; q < 4; ++q) { unsigned pv[4];
#pragma unroll
                        for (int i = 0; i < 8; i += 2) { const unsigned v0 = x ? (vw[8 * q + i] >> 16) : (vw[8 * q + i] & 0xffffu), v1 = x ? (vw[8 * q + i + 1] >> 16) : (vw[8 * q + i + 1] & 0xffffu); pv[i >> 1] = v0 | (v1 << 16); }
                        *(LAS v4u*)(L + Q1_VT + (2 * ep + x) * P1_S + 64 * tg + 16 * q) = (v4u){pv[0], pv[1], pv[2], pv[3]}; }
            }
            if (dir == 0) ml_p1_dir<0>(a, T, b, head, blk, slotF, kw, ig, fg); else ml_p1_dir<1>(a, T, b, head, blk, slotB, kw, ig, fg);
        }
    }
}

__device__ __forceinline__ void pass2_all(const Args& a, const Ctx& T) {
    const int gid = T.vcu * NTHREADS + T.tid;
    if (gid < 32 * 2048) {
        const int seq = gid >> 11, el = (gid & 2047) * 8, d0 = el & 127;
        float r[8];
#pragma unroll
        for (int i = 0; i < 8; ++i) r[i] = 0.f;
#pragma unroll 1
        for (int j0 = 0; j0 < 16; j0 += 4) {
            v4u dv[4]; f32x4 g0[4], g1[4];
#pragma unroll
            for (int jj = 0; jj < 4; ++jj) { const size_t sidx = (size_t)seq * 16 + j0 + jj; dv[jj] = *(const v4u*)(a.ws + WS_HGST + sidx * HG_SLOT_BYTES + (size_t)el * 2);
                const float* G = (const float*)(a.ws + WS_HGG) + sidx * 128 + d0; g0[jj] = *(const f32x4*)G; g1[jj] = *(const f32x4*)(G + 4); }
#pragma unroll
            for (int jj = 0; jj < 4; ++jj) { const size_t sidx = (size_t)seq * 16 + j0 + jj;
                r[0] = g0[jj].x * r[0] + bflo(dv[jj].x); r[1] = g0[jj].y * r[1] + bfhi(dv[jj].x); r[2] = g0[jj].z * r[2] + bflo(dv[jj].y); r[3] = g0[jj].w * r[3] + bfhi(dv[jj].y);
                r[4] = g1[jj].x * r[4] + bflo(dv[jj].z); r[5] = g1[jj].y * r[5] + bfhi(dv[jj].z); r[6] = g1[jj].z * r[6] + bflo(dv[jj].w); r[7] = g1[jj].w * r[7] + bfhi(dv[jj].w);
                *(v4u*)(a.ws + WS_HGST + sidx * HG_SLOT_BYTES + (size_t)el * 2) = (v4u){cvtpk(r[0], r[1]), cvtpk(r[2], r[3]), cvtpk(r[4], r[5]), cvtpk(r[6], r[7])}; }
        }
    } else if (gid < 32 * 2048 + 32 * 1152) {
        const int t2 = gid - 32 * 2048; const int seq = t2 / 1152, el = (t2 % 1152) * 8;
        float r[8], m = 0.f;
#pragma unroll
        for (int i = 0; i < 8; ++i) r[i] = 0.f;
#pragma unroll 1
        for (int j0 = 0; j0 < 16; j0 += 4) {
            v4u dv[4]; float ml[4], bt[4];
#pragma unroll
            for (int jj = 0; jj < 4; ++jj) { const size_t sidx = (size_t)seq * 16 + j0 + jj; dv[jj] = *(const v4u*)(a.ws + WS_MLST + sidx * ML_SLOT_BYTES + (size_t)el * 2);
                const float* sc = (const float*)(a.ws + WS_MLSC) + sidx * 4; ml[jj] = sc[0]; bt[jj] = sc[1]; }
#pragma unroll
            for (int jj = 0; jj < 4; ++jj) { const size_t sidx = (size_t)seq * 16 + j0 + jj;
                const float mn = fmaxf(bt[jj] + m, ml[jj]); const float cA = ex2(bt[jj] + m - mn), cB = ex2(ml[jj] - mn); m = mn;
                r[0] = cA * r[0] + cB * bflo(dv[jj].x); r[1] = cA * r[1] + cB * bfhi(dv[jj].x); r[2] = cA * r[2] + cB * bflo(dv[jj].y); r[3] = cA * r[3] + cB * bfhi(dv[jj].y);
                r[4] = cA * r[4] + cB * bflo(dv[jj].z); r[5] = cA * r[5] + cB * bfhi(dv[jj].z); r[6] = cA * r[6] + cB * bflo(dv[jj].w); r[7] = cA * r[7] + cB * bfhi(dv[jj].w);
                *(v4u*)(a.ws + WS_MLST + sidx * ML_SLOT_BYTES + (size_t)el * 2) = (v4u){cvtpk(r[0], r[1]), cvtpk(r[2], r[3]), cvtpk(r[4], r[5]), cvtpk(r[6], r[7])};
                if (el == 0) ((float*)(a.ws + WS_MLSC))[sidx * 4 + 2] = mn; }
        }
    }
}

__device__ __forceinline__ void ml_pass3_item(const Args& a, const Ctx& T0, int item, bf16* OUT) {
    const int jt = item & 15, head = (item >> 4) & 3, b = item >> 6;
    const bf16* P = (const bf16*)(a.ws + WS_PROJ); const bf16* QK = (const bf16*)(a.ws + WS_QK); const float* GT = (const float*)(a.ws + WS_GATES);
    Ctx T = T0; asm volatile("" : "+v"(T.lane));
    T.tid = T.wave * 64 + T.lane;
    LAS unsigned char* L = T.lds;
    const int w = T.wave, l = T.lane, g = l >> 4, c16 = l & 15;
    __syncthreads();
    for (int i = T.tid; i < 64 * MS / 16; i += NTHREADS) *(LAS v4u*)(L + ML_P + i * 16) = (v4u){0u, 0u, 0u, 0u};
    ml_aug_rows(L, T.tid);
    if (T.tid < 128) *(LAS float*)(L + ML_NW + T.tid * 4) = a.in[I_MLNW][head * 128 + T.tid];
#define ML_ROW3(st_, lt_) (b * SEQ + 256 * jt + (((st_) >> 2) ? 255 - (64 * ((st_) & 3) + (lt_)) : 64 * ((st_) & 3) + (lt_)))
    MlPre R;
    const int qt = T.tid >> 3, qpart = T.tid & 7;
#define ML_LOAD_ALL(st_) do { ML_LOAD_KV(R, ROWF_); const size_t rq_ = (size_t)ML_ROW3((st_), qt); R.qn = *(const v4u*)(QK + rq_ * 512 + head * 64 + qpart * 8); R.kn = *(const v4u*)(QK + rq_ * 512 + 256 + head * 64 + qpart * 8); } while (0)
#define ROWF_(x_) ML_ROW3(0, (x_))
    ML_LOAD_ALL(0);
#undef ROWF_
    f32x4 accC[4], accCA = (f32x4){0.f, 0.f, 0.f, 0.f};
    v4u stq[2], sta[2];
#define ML_STATE_LOAD(dir_) do { const size_t sidx_ = hg_seq(b, (dir_), head) * 16 + ((dir_) ? 15 - jt : jt); const bf16* CTg_ = (const bf16*)(a.ws + WS_MLST + sidx_ * ML_SLOT_BYTES); \
        _Pragma("unroll") for (int q_ = 0; q_ < 2; ++q_) { const int idx_ = l + 64 * q_; stq[q_] = *(const v4u*)(CTg_ + (size_t)(16 * w + (idx_ >> 3)) * 64 + (idx_ & 7) * 8); \
            if (w == 4) sta[q_] = *(const v4u*)(CTg_ + (size_t)(128 + (idx_ >> 3)) * 64 + (idx_ & 7) * 8); } } while (0)
    ML_STATE_LOAD(0);
#pragma unroll 1
    for (int step = 0; step < 8; ++step) {
        const int dir = step >> 2, c = step & 3;
        PS_BEGIN();
        if (c == 0) {
            const size_t sidx = hg_seq(b, dir, head) * 16 + (dir ? 15 - jt : jt);
            if (dir == 1) { ML_STATE_LOAD(1); VM_WAIT(); __syncthreads(); if (w == 0) { __builtin_amdgcn_fence(__ATOMIC_ACQUIRE, "agent"); VM_WAIT(); } }
            __syncthreads();
#pragma unroll
            for (int q = 0; q < 2; ++q) { const int idx = l + 64 * q; *(LAS v4u*)(L + ML_CT + (16 * w + (idx >> 3)) * MS + (idx & 7) * 16) = stq[q];
                if (w == 4) *(LAS v4u*)(L + ML_CT + (128 + (idx >> 3)) * MS + (idx & 7) * 16) = sta[q]; }
            if (w == 0) { float ig[4], fg[4];
#pragma unroll
                for (int cc = 0; cc < 4; ++cc) { const int lt = 4 * l + cc; const size_t row = (size_t)ML_ROW3(4 * dir + (lt >> 6), lt & 63); ig[cc] = GT[row * 16 + (dir ? 8 : 0) + head]; fg[cc] = GT[row * 16 + (dir ? 12 : 4) + head]; }
                float bsum = 0.f; const float m0 = ((const float*)(a.ws + WS_MLSC))[sidx * 4 + 2]; (void)ml_scalars256<false>(L, ig, fg, m0, bsum, l); }
            __syncthreads();
#pragma unroll
            for (int m = 0; m < 4; ++m) { const v2u sv = *(const LAS v2u*)(L + ML_CT + (16 * w + c16) * MS + (16 * m + 4 * g) * 2); accC[m] = (f32x4){bflo(sv.x), bfhi(sv.x), bflo(sv.y), bfhi(sv.y)}; }
            if (w < 4) { const v2u sv = *(const LAS v2u*)(L + ML_CT + (128 + c16) * MS + (16 * w + 4 * g) * 2); accCA = (f32x4){bflo(sv.x), bfhi(sv.x), bflo(sv.y), bfhi(sv.y)}; }
        }
        PS_END(5);
        *(LAS v4u*)(L + ML_Q + qt * MS + qpart * 16) = R.qn; *(LAS v4u*)(L + ML_K + qt * MS + qpart * 16) = R.kn;
        ML_STORE_KV(R, c);
        if (step < 7) {
#define ROWF_(x_) ML_ROW3(step + 1, (x_))
            ML_LOAD_ALL(step + 1);
#undef ROWF_
        }
        PS_END(6); __syncthreads(); PS_END(10);
        const size_t orow = (size_t)ML_ROW3(step, qt);
        bf16* optr = OUT + orow * DM + 512 + head * 128 + 16 * qpart;
        v2u ptile[2]; int paddr[2] = {-1, -1};
#pragma unroll 1
        for (int rep = 0; rep < 2; ++rep) { const int tix = w + 8 * rep;
            if (tix < 10) {
                const int I = tix < 1 ? 0 : (tix < 3 ? 1 : (tix < 6 ? 2 : 3)); const int J = tix - (I * (I + 1)) / 2;
                const BF2 af = ldfrag2(L + ML_K + 16 * J * MS, MS, l), bf = ldfrag2(L + ML_Q + 16 * I * MS, MS, l);
                const int tloc = 16 * I + c16, s0 = 16 * J + 4 * g;
                const f32x4 av = *(const LAS f32x4*)(L + ML_TA + (c * 64 + s0) * 4); const float mu = *(const LAS float*)(L + ML_TMU + (c * 64 + tloc) * 4);
                f32x4 at = (f32x4){0.f, 0.f, 0.f, 0.f};
                at = MFMA16(af.k0, bf.k0, at); at = MFMA16(af.k1, bf.k1, at);
                float pr[4];
#pragma unroll
                for (int r = 0; r < 4; ++r) pr[r] = (s0 + r <= tloc) ? at[r] * ex2(av[r] - mu) : 0.f;
                ptile[rep].x = cvtpk(pr[0], pr[1]); ptile[rep].y = cvtpk(pr[2], pr[3]); paddr[rep] = ML_P + tloc * MS + s0 * 2;
            } }
        f32x4 accO[4], accOA = (f32x4){0.f, 0.f, 0.f, 0.f};
        const float carry = *(const LAS float*)(L + ML_SC + c * 4);
        const BF2 vf = ldfrag2(L + ML_VT + 16 * w * MS, MS, l);
        { const BF2 cf = ldfrag2(L + ML_CT + 16 * w * MS, MS, l);
            const BF2 q0 = ldfrag2(L + ML_Q + 0 * 16 * MS, MS, l), q1 = ldfrag2(L + ML_Q + 1 * 16 * MS, MS, l), q2 = ldfrag2(L + ML_Q + 2 * 16 * MS, MS, l), q3 = ldfrag2(L + ML_Q + 3 * 16 * MS, MS, l);
#pragma unroll
            for (int I = 0; I < 4; ++I) accO[I] = (f32x4){0.f, 0.f, 0.f, 0.f};
            accO[0] = MFMA16(q0.k0, cf.k0, accO[0]); accO[1] = MFMA16(q1.k0, cf.k0, accO[1]); accO[2] = MFMA16(q2.k0, cf.k0, accO[2]); accO[3] = MFMA16(q3.k0, cf.k0, accO[3]);
            accO[0] = MFMA16(q0.k1, cf.k1, accO[0]); accO[1] = MFMA16(q1.k1, cf.k1, accO[1]); accO[2] = MFMA16(q2.k1, cf.k1, accO[2]); accO[3] = MFMA16(q3.k1, cf.k1, accO[3]); }
        { const BF2 k0f = ldfrag2(L + ML_KTT + 0 * 16 * MS, MS, l), k1f = ldfrag2(L + ML_KTT + 1 * 16 * MS, MS, l), k2f = ldfrag2(L + ML_KTT + 2 * 16 * MS, MS, l), k3f = ldfrag2(L + ML_KTT + 3 * 16 * MS, MS, l);
#pragma unroll
            for (int I = 0; I < 4; ++I) accC[I] = accC[I] * carry;
            accC[0] = MFMA16(k0f.k0, vf.k0, accC[0]); accC[1] = MFMA16(k1f.k0, vf.k0, accC[1]); accC[2] = MFMA16(k2f.k0, vf.k0, accC[2]); accC[3] = MFMA16(k3f.k0, vf.k0, accC[3]);
            accC[0] = MFMA16(k0f.k1, vf.k1, accC[0]); accC[1] = MFMA16(k1f.k1, vf.k1, accC[1]); accC[2] = MFMA16(k2f.k1, vf.k1, accC[2]); accC[3] = MFMA16(k3f.k1, vf.k1, accC[3]); }
#pragma unroll
        for (int I = 0; I < 4; ++I) { const f32x4 iw = *(const LAS f32x4*)(L + ML_TIW + (c * 64 + 16 * I + 4 * g) * 4); accO[I] = accO[I] * iw; }
        BF2 af = vf;
        if (w < 4) { const BF2 cfa = ldfrag2(L + ML_CT + 128 * MS, MS, l), qw_ = ldfrag2(L + ML_Q + 16 * w * MS, MS, l), kw_ = ldfrag2(L + ML_KTT + 16 * w * MS, MS, l);
            af = ldfrag2(L + ML_VT + 128 * MS, MS, l);
            const f32x4 iwa = *(const LAS f32x4*)(L + ML_TIW + (c * 64 + 16 * w + 4 * g) * 4);
            accCA = accCA * carry;
            accOA = MFMA16(qw_.k0, cfa.k0, accOA); accCA = MFMA16(kw_.k0, af.k0, accCA); accOA = MFMA16(qw_.k1, cfa.k1, accOA); accCA = MFMA16(kw_.k1, af.k1, accCA);
            accOA = accOA * iwa; }
#pragma unroll
        for (int rep = 0; rep < 2; ++rep) if (paddr[rep] >= 0) *(LAS v2u*)(L + paddr[rep]) = ptile[rep];
        v4u pf0 = (v4u){0u, 0u, 0u, 0u}, pf1 = pf0, pg0 = pf0, pg1 = pf0;
        if (dir) { pf0 = *(const v4u*)optr; pf1 = *(const v4u*)(optr + 8); const bf16* gp = P + orow * LDP + 3584 + head * 128 + 16 * qpart; pg0 = *(const v4u*)gp; pg1 = *(const v4u*)(gp + 8); }
        PS_END(7); __syncthreads(); PS_END(10);
        { const BF2 p0 = ldfrag2(L + ML_P + 0 * 16 * MS, MS, l), p1 = ldfrag2(L + ML_P + 1 * 16 * MS, MS, l), p2 = ldfrag2(L + ML_P + 2 * 16 * MS, MS, l), p3 = ldfrag2(L + ML_P + 3 * 16 * MS, MS, l);
            accO[0] = MFMA16(p0.k0, vf.k0, accO[0]); accO[1] = MFMA16(p1.k0, vf.k0, accO[1]); accO[2] = MFMA16(p2.k0, vf.k0, accO[2]); accO[3] = MFMA16(p3.k0, vf.k0, accO[3]);
            accO[0] = MFMA16(p0.k1, vf.k1, accO[0]); accO[1] = MFMA16(p1.k1, vf.k1, accO[1]); accO[2] = MFMA16(p2.k1, vf.k1, accO[2]); accO[3] = MFMA16(p3.k1, vf.k1, accO[3]);
            if (w < 4) { const BF2 pw_ = ldfrag2(L + ML_P + 16 * w * MS, MS, l); accOA = MFMA16(pw_.k0, af.k0, accOA); accOA = MFMA16(pw_.k1, af.k1, accOA); } }
#pragma unroll
        for (int m = 0; m < 4; ++m) { v2u o; o.x = cvtpk(accC[m][0], accC[m][1]); o.y = cvtpk(accC[m][2], accC[m][3]); *(LAS v2u*)(L + ML_CT + (16 * w + c16) * MS + (16 * m + 4 * g) * 2) = o; }
        if (w < 4) { v2u o; o.x = cvtpk(accCA[0], accCA[1]); o.y = cvtpk(accCA[2], accCA[3]); *(LAS v2u*)(L + ML_CT + (128 + c16) * MS + (16 * w + 4 * g) * 2) = o;
            if (c16 == 0) { const f32x4 em = *(const LAS f32x4*)(L + ML_TEM + (c * 64 + 16 * w + 4 * g) * 4); f32x4 ri;
#pragma unroll
                for (int r = 0; r < 4; ++r) ri[r] = __builtin_amdgcn_rcpf(fmaxf(fabsf(accOA[r]), em[r]));
                *(LAS f32x4*)(L + ML_TRI + (16 * w + 4 * g) * 4) = ri; } }
#pragma unroll
        for (int I = 0; I < 4; ++I)
#pragma unroll
            for (int r = 0; r < 4; ++r) *(LAS float*)(L + ML_OT + (16 * I + 4 * g + r) * OT_S + (16 * w + c16) * 4) = accO[I][r];
        PS_END(8); __syncthreads(); PS_END(10);
        { float ov[16]; const float ri = *(const LAS float*)(L + ML_TRI + qt * 4);
#pragma unroll
            for (int q = 0; q < 4; ++q) { const f32x4 t4 = *(const LAS f32x4*)(L + ML_OT + qt * OT_S + (16 * qpart + 4 * q) * 4); ov[4 * q] = t4.x * ri; ov[4 * q + 1] = t4.y * ri; ov[4 * q + 2] = t4.z * ri; ov[4 * q + 3] = t4.w * ri; }
            if (dir) {
                float fo[16], gt[16];
#pragma unroll
                for (int q = 0; q < 4; ++q) { fo[2 * q] = bflo(pf0[q]); fo[2 * q + 1] = bfhi(pf0[q]); fo[8 + 2 * q] = bflo(pf1[q]); fo[8 + 2 * q + 1] = bfhi(pf1[q]);
                    gt[2 * q] = bflo(pg0[q]); gt[2 * q + 1] = bfhi(pg0[q]); gt[8 + 2 * q] = bflo(pg1[q]); gt[8 + 2 * q + 1] = bfhi(pg1[q]); }
                float ss = 0.f;
#pragma unroll
                for (int i = 0; i < 16; ++i) { ov[i] += fo[i]; ss += ov[i] * ov[i]; }
                ss += __shfl_xor(ss, 1); ss += __shfl_xor(ss, 2); ss += __shfl_xor(ss, 4);
                const float rstd = __builtin_amdgcn_rsqf(ss * (1.f / 128.f) + EPSN);
#pragma unroll
                for (int q = 0; q < 4; ++q) { const f32x4 nw4 = *(const LAS f32x4*)(L + ML_NW + (16 * qpart + 4 * q) * 4);
                    ov[4 * q] *= rstd * nw4.x * gt[4 * q]; ov[4 * q + 1] *= rstd * nw4.y * gt[4 * q + 1]; ov[4 * q + 2] *= rstd * nw4.z * gt[4 * q + 2]; ov[4 * q + 3] *= rstd * nw4.w * gt[4 * q + 3]; }
            }
            *(v4u*)optr = (v4u){cvtpk(ov[0], ov[1]), cvtpk(ov[2], ov[3]), cvtpk(ov[4], ov[5]), cvtpk(ov[6], ov[7])};
            *(v4u*)(optr + 8) = (v4u){cvtpk(ov[8], ov[9]), cvtpk(ov[10], ov[11]), cvtpk(ov[12], ov[13]), cvtpk(ov[14], ov[15])}; }
        PS_END(9);
    }
#undef ML_ROW3
#undef ML_LOAD_ALL
#undef ML_STATE_LOAD
}
__device__ __forceinline__ void final_norm_phase(const Args& a, const Ctx& T, const bf16* X3) {
    f32x4 wv[4];
#pragma unroll
    for (int j = 0; j < 4; ++j) wv[j] = *((const f32x4*)a.in[I_FNW] + T.lane + 64 * j);
    f32x4 v[4];
    if (T.gw < MLAT) norm_load_row(v, X3, true, nullptr, T.gw, T.lane);
    for (int m = T.gw; m < MLAT; m += T.NGW) {
        f32x4 cur[4]; float s = 0.f;
#pragma unroll
        for (int j = 0; j < 4; ++j) { cur[j] = v[j]; s += (v[j].x * v[j].x + v[j].y * v[j].y) + (v[j].z * v[j].z + v[j].w * v[j].w); }
        { const int mn = m + T.NGW; if (mn < MLAT) norm_load_row(v, X3, true, nullptr, mn, T.lane); }
        const float rstd = __builtin_amdgcn_rsqf(wave_sum(s) * (1.f / DM) + EPSN);
        f32x4* xr = (f32x4*)(a.out + (size_t)m * DM) + T.lane;
#pragma unroll
        for (int j = 0; j < 4; ++j) xr[64 * j] = cur[j] * rstd * wv[j];
    }
}

__device__ __forceinline__ void gates_phase(const Args& a, const Ctx& T) {
    const bf16* XNc = (const bf16*)(a.ws + WS_XN); const bf16* WG = (const bf16*)(a.ws + WS_WG); float* GT = (float*)(a.ws + WS_GATES);
    const int l = T.lane, r = l & 15, g = l >> 4;
    const float bias = a.in[I_MLGB][r];
    for (int rg = T.gw; rg < MALL / 16; rg += T.NGW) {
        f32x4 acc = (f32x4){0.f, 0.f, 0.f, 0.f};
        const bf16* pa = XNc + (size_t)(16 * rg + r) * DM + 8 * g; const bf16* pb = WG + (size_t)r * DM + 8 * g;
#pragma unroll 8
        for (int ks = 0; ks < 32; ++ks) { const bf16x8 av = *(const bf16x8*)(pa + ks * 32); const bf16x8 bv = *(const bf16x8*)(pb + ks * 32); acc = MFMA16(av, bv, acc); }
#pragma unroll
        for (int q = 0; q < 4; ++q) GT[(size_t)(16 * rg + 4 * g + q) * 16 + r] = acc[q] + bias;
    }
}

__global__ void __launch_bounds__(NTHREADS, 2) fwd_kernel(Args a) {
    extern __shared__ __attribute__((aligned(16))) unsigned char lds_raw[];
    Ctx T;
    T.lds = (LAS unsigned char*)lds_raw;
    T.tid = threadIdx.x; T.lane = T.tid & 63; T.wave = __builtin_amdgcn_readfirstlane(T.tid >> 6);
    T.G = gridDim.x; { const int bx = blockIdx.x; T.vcu = (T.G % 8 == 0) ? (bx % 8) * (T.G / 8) + bx / 8 : bx; }
    T.gw = T.vcu * NWAVES + T.wave; T.NGW = T.G * NWAVES;
    volatile LAS unsigned* MISC = (volatile LAS unsigned*)(T.lds + MISC_OFF);
    for (int u = T.tid; u < (LDS_BYTES - LDSCTL_OFF) / 4; u += NTHREADS) ((LAS unsigned*)(T.lds + LDSCTL_OFF))[u] = 0u;
    __syncthreads();
    XcdBarrier bar; bar.bar = (unsigned*)(a.ws + WS_CTL) + CW_BAR; bar.x = 0; bar.st = nullptr;
    const bool multi = (a.ph_hi - a.ph_lo) > 1;
    if (multi) bar = xcd_barrier_post((unsigned*)(a.ws + WS_CTL) + CW_BAR, MISC + 8);
    const int lo = a.ph_lo, hi = a.ph_hi;
#ifndef REP_MASK
#define REP_MASK 0
#endif
#define IN(k) (lo <= (k) && (k) < hi)
#ifndef PROF_K
#define PROF_K -1
#endif
#define STAMP(k) do { if (PROF_K >= 0 && ((k) == PROF_K || (k) == PROF_K + 1) && blockIdx.x == 0 && T.tid == 0) { const unsigned long long t_ = __builtin_amdgcn_s_memrealtime(); MISC[16 + 2 * ((k) - PROF_K)] = (unsigned)t_; MISC[17 + 2 * ((k) - PROF_K)] = (unsigned)(t_ >> 32); } } while (0)
#define REPS(k) for (int rep_ = 0; rep_ < (((REP_MASK >> (k)) & 1) ? 2 : 1); ++rep_)
#if (REP_MASK >> 18) & 1
#define SEAM(k) do { if (IN(k) && IN((k) + 1)) { xcd_barrier(bar); xcd_barrier(bar); } } while (0)
#else
#define SEAM(k) do { if (IN(k) && IN((k) + 1)) xcd_barrier(bar); STAMP((k) + 1); } while (0)
#endif
    bf16* XN = (bf16*)(a.ws + WS_XN); bf16* HB = (bf16*)(a.ws + WS_PROJ); bf16* PROJ = (bf16*)(a.ws + WS_PROJ);
    const float* mods = (const float*)(a.ws + WS_MODS);
    bf16* XB1 = (bf16*)a.out; bf16* XB2 = (bf16*)a.out + (size_t)MLAT * DM; bf16* XB3 = (bf16*)(a.ws + WS_PROJ + 96 * MiB);
    const int bx = (int)blockIdx.x;

    STAMP(0);
    if (IN(0)) REPS(0) { mods_phase(a, T); convert_ffn(a, T, a.in[I_F1W1], a.in[I_F1W2]); convert_mix(a, T);
        if (T.tid < 64) { const int e = bx * 64 + T.tid; if (e < 16384) { const int q = e >> 10, k = e & 1023; ((bf16*)(a.ws + WS_WG))[q * 1024 + k] = (bf16)f2bf(a.in[I_WIN][(size_t)k * DIN + NPROJ + q]); } } }
    SEAM(0);
    if (IN(1)) norm_mod_rows<false, false>(a, T, a.in[I_X], a.in[I_CTX], MALL, a.in[I_N1W], 0, 1);
    SEAM(1);
    if (IN(2)) REPS(2) { pg8::Gemm g{XN, (const bf16*)(a.ws + WS_W1), MALL, 2 * DFF, DM, DM}; pg8::StaticOrder S; S.init(MALL, 2 * DFF, T.G, bx);
        pg8::EpiSwiglu E{HB, DFF}; pg8::gemm_phase<pg8::EpiSwiglu, pg8::StaticOrder, true, true>(T.lds, g, S, E); }
    SEAM(2);
    if (IN(3)) { pg8::Gemm g{HB, (const bf16*)(a.ws + WS_W2), MALL, DM, DFF, DFF}; pg8::DownOrder S; S.lat.init(MLAT, DM, T.G, bx); S.c = bx;
        pg8::EpiDown1 E{a.in[I_X], XB1, mods + 2 * 1024, 0.5f, (float*)(a.ws + WS_SLAB)}; pg8::gemm_phase<pg8::EpiDown1, pg8::DownOrder, true, true>(T.lds, g, S, E); }
    SEAM(3);
    if (IN(4)) REPS(4) { norm_mod_rows<true, true>(a, T, XB1, a.in[I_CTX], MALL, a.in[I_N2W], 3, 4); convert_ffn(a, T, a.in[I_F2W1], a.in[I_F2W2]); }
    SEAM(4);
    if (IN(5)) { pg8::Gemm g{XN, (const bf16*)(a.ws + WS_WIN), MALL, NPROJ, DM, DM}; pg8::ProjOrder S; S.lat.init(MLAT, NPROJ, T.G, bx); S.c = bx;
        pg8::EpiProjAll E{{PROJ, LDP}, (bf16*)(a.ws + WS_SLAB2)}; pg8::gemm_phase<pg8::EpiProjAll, pg8::ProjOrder, true, true>(T.lds, g, S, E); }
    SEAM(5);
    if (IN(6)) { gates_phase(a, T); ctx_combine(a, T); conv_phase(a, T); }
    SEAM(6);
    if (IN(7)) REPS(7) { hg_pass1_items(a, T, T.vcu, T.G, 256); ml_pass1_items(a, T, T.vcu, T.G, 256); }
    SEAM(7);
    if (IN(8)) pass2_all(a, T);
    SEAM(8);
    if (IN(9)) REPS(9) { for (int it = T.vcu; it < 256; it += T.G) hg_pass3_item(a, T, it, XN); for (int it = T.vcu; it < 256; it += T.G) ml_pass3_item(a, T, it, XN); }
    SEAM(9);
    if (IN(10)) { pg8::Gemm g{XN, (const bf16*)(a.ws + WS_WOUT), MLAT, DM, DM, DM}; pg8::StaticOrder S; S.init(MLAT, DM, T.G, bx);
        pg8::EpiResidB<true> E{XB1, XB2, mods + 5 * 1024, 1.0f}; pg8::gemm_phase<pg8::EpiResidB<true>, pg8::StaticOrder, true, true>(T.lds, g, S, E); }
    SEAM(10);
    if (IN(11)) REPS(11) norm_mod_rows<false, true>(a, T, XB2, nullptr, MLAT, a.in[I_N3W], 6, 7);
    SEAM(11);
    if (IN(12)) REPS(12) { pg8::Gemm g{XN, (const bf16*)(a.ws + WS_W1), MLAT, 2 * DFF, DM, DM}; pg8::StaticOrder S; S.init(MLAT, 2 * DFF, T.G, bx);
        pg8::EpiSwiglu E{HB, DFF}; pg8::gemm_phase<pg8::EpiSwiglu, pg8::StaticOrder, true, true>(T.lds, g, S, E); }
    SEAM(12);
    if (IN(13)) { pg8::Gemm g{HB, (const bf16*)(a.ws + WS_W2), MLAT, DM, DFF, DFF}; pg8::StaticOrder S; S.init(MLAT, DM, T.G, bx);
        pg8::EpiResidB<true> E{XB2, XB3, mods + 8 * 1024, 0.5f}; pg8::gemm_phase<pg8::EpiResidB<true>, pg8::StaticOrder, true, true>(T.lds, g, S, E); }
    SEAM(13);
    if (IN(14)) final_norm_phase(a, T, XB3);
    STAMP(15);
    if (PROF_S >= 0 && blockIdx.x == 0 && T.tid == 0) { const unsigned long long dt_ = ((((unsigned long long)MISC[23]) << 32) | MISC[22]) * 8ull, te_ = __builtin_amdgcn_s_memrealtime(); while (__builtin_amdgcn_s_memrealtime() - te_ < dt_) __builtin_amdgcn_s_sleep(8); }
    if (PROF_K >= 0 && blockIdx.x == 0 && T.tid == 0) { const unsigned long long t0_ = ((unsigned long long)MISC[17] << 32) | MISC[16], t1_ = ((unsigned long long)MISC[19] << 32) | MISC[18];
        const unsigned long long dt_ = (t1_ - t0_) * 8ull, te_ = __builtin_amdgcn_s_memrealtime(); while (__builtin_amdgcn_s_memrealtime() - te_ < dt_) __builtin_amdgcn_s_sleep(8); }
#undef IN
#undef SEAM
}

extern "C" void kernel_launch(void* const* d_in, const int* in_sizes, int n_in, void* d_out, int out_size, void* d_ws, size_t ws_size, hipStream_t stream) {
    static int grid = 0;
    if (grid == 0) {
        if (n_in != 22 || out_size != MLAT * DM || ws_size < WS_END) { fprintf(stderr, "kernel_launch: unexpected shapes (n_in %d out %d ws %zu)\n", n_in, out_size, ws_size); grid = -1; return; }
        int dev = 0, cus = 0;
        if (hipGetDevice(&dev) != hipSuccess || hipDeviceGetAttribute(&cus, hipDeviceAttributeMultiprocessorCount, dev) != hipSuccess) { grid = -1; return; }
        if (hipFuncSetAttribute((const void*)fwd_kernel, hipFuncAttributeMaxDynamicSharedMemorySize, LDS_BYTES) != hipSuccess) { fprintf(stderr, "kernel_launch: hipFuncSetAttribute failed\n"); grid = -1; return; }
        (void)hipGetLastError();
        grid = cus;
    }
    if (grid < 0) return;
    (void)hipMemsetAsync((char*)d_ws + WS_CTL, 0, CTL_ZERO_BYTES, stream);
    (void)hipMemsetAsync((char*)d_ws + WS_MODS, 0, 5 * NMODC * sizeof(float), stream);
    Args a{};
    for (int i = 0; i < 22; ++i) a.in[i] = (const float*)d_in[i];
    a.out = (float*)d_out; a.ws = (unsigned char*)d_ws;
#if ONE_LAUNCH
    a.ph_lo = 0; a.ph_hi = NPHASES;
    hipLaunchKernelGGL(fwd_kernel, dim3(grid), dim3(NTHREADS), LDS_BYTES, stream, a);
#else
    for (int p = 0; p < NPHASES; ++p) { a.ph_lo = p; a.ph_hi = p + 1; hipLaunchKernelGGL(fwd_kernel, dim3(grid), dim3(NTHREADS), LDS_BYTES, stream, a); }
#endif
}
```

```cpp
#include <hip/hip_runtime.h>
#include <cstdio>
#include <cstdint>
#ifndef PROF_S
#define PROF_S -1
#endif
#define PG8_PS_BEGIN() do { if (PROF_S == 20 && blockIdx.x == 0 && threadIdx.x == 0) { const unsigned long long t_ = __builtin_amdgcn_s_memrealtime(); volatile __attribute__((address_space(3))) unsigned* M_ = (volatile __attribute__((address_space(3))) unsigned*)(lds + 162816 + 320); M_[20] = (unsigned)t_; M_[21] = (unsigned)(t_ >> 32); } } while (0)
#define PG8_PS_END() do { if (PROF_S == 20 && blockIdx.x == 0 && threadIdx.x == 0) { const unsigned long long t_ = __builtin_amdgcn_s_memrealtime(); volatile __attribute__((address_space(3))) unsigned* M_ = (volatile __attribute__((address_space(3))) unsigned*)(lds + 162816 + 320); \
    const unsigned long long p_ = ((unsigned long long)M_[21] << 32) | M_[20]; const unsigned long long a_ = (((unsigned long long)M_[23] << 32) | M_[22]) + (t_ - p_); M_[22] = (unsigned)a_; M_[23] = (unsigned)(a_ >> 32); } } while (0)
namespace pg8 {
#define PG8_LAS __attribute__((address_space(3)))
typedef unsigned short bf16_t;
typedef short bf16x8 __attribute__((ext_vector_type(8)));
typedef float f32x4 __attribute__((ext_vector_type(4)));
typedef unsigned u32x4 __attribute__((ext_vector_type(4)));
constexpr int BM = 256, BK = 64, HALF = 128, HTB = HALF * BK * 2  , STAGE_BYTES = 8 * HTB, NXCD = 8, WGM = 8;

__host__ __device__ __forceinline__ int lds_byte(int r, int c) { const int st = (r >> 4) * 2 + (c >> 5), rr = r & 15, cc = c & 31, ob = rr * 64 + cc * 2; return st * 1024 + (ob ^ (((ob >> 9) & 1) << 5)); }
__host__ __device__ __forceinline__ void stage_rc(int b, int& R, int& C) { const int st = b / 1024, sb = b % 1024, swz = sb ^ (((sb >> 9) & 1) << 5); R = (st >> 1) * 16 + swz / 64; C = (st & 1) * 32 + (swz % 64) / 2; }
__host__ __device__ __forceinline__ int perm32(int rho) { const int n = rho >> 4, i = rho & 15; return 8 * (i >> 2) + 4 * n + (i & 3); }

struct Unit { int pm, pn, kofs, kt; };
struct Gemm { const bf16_t* A; const bf16_t* Bt; int M, N, K, ld; };

struct StaticOrder {
    int nM, nN, nwg, G, c;
    __host__ __device__ void init(int M, int N, int G_, int c_) { nM = M / BM; nN = N / BM; nwg = nM * nN; G = G_; c = c_; }
    __host__ __device__ bool next(int i, Unit& u) const {
        const long L = (long)i * G + c; if (L >= nwg) return false;
        int wgid = (int)L; { const int q = nwg / NXCD, r = nwg % NXCD, xcd = wgid % NXCD, off = wgid / NXCD; wgid = (xcd < r ? xcd * (q + 1) : r * (q + 1) + (xcd - r) * q) + off; }
        const int nig = WGM * nN, gid = wgid / nig, fm = gid * WGM, gsz = (nM - fm) < WGM ? (nM - fm) : WGM;
        u.pm = fm + ((wgid % nig) % gsz); u.pn = (wgid % nig) / gsz; u.kofs = 0; u.kt = 0; return true;
    }
    __device__ __forceinline__ void a_ready(const Unit&) const {}
    __device__ __forceinline__ void done(const Unit&) const {}
};
__device__ __forceinline__ unsigned cvt_pk_bf16(float lo, float hi) { unsigned r; asm volatile("v_cvt_pk_bf16_f32 %0, %1, %2" : "=v"(r) : "v"(lo), "v"(hi)); return r; }
typedef float f32x2 __attribute__((ext_vector_type(2)));
__device__ __forceinline__ float fast_sigmoid(float v) { return __builtin_amdgcn_rcpf(1.0f + __builtin_amdgcn_exp2f(-1.4426950408889634f * v)); }
__device__ __forceinline__ float fast_silu(float v) { return v * fast_sigmoid(v); }

struct EpiSwiglu {
    static constexpr bool PERM = true, AFTER_DRAIN = false;
    bf16_t* H; int ldh;
    __device__ __forceinline__ void operator()(const f32x4 (&acc)[2][2][4][2], const Unit& u, int wr, int wc, int fr, int fq) const {
        typedef float f2 __attribute__((ext_vector_type(2)));
        const int row0 = u.pm * BM + wr * 64 + fr, col0 = u.pn * HALF + wc * 32 + 8 * fq;
#pragma unroll
        for (int ai = 0; ai < 2; ++ai)
#pragma unroll
            for (int m = 0; m < 4; ++m) { bf16_t* rowp = H + (size_t)(row0 + ai * HALF + m * 16) * ldh + col0;
                unsigned wv[4];
#pragma unroll
                for (int n = 0; n < 2; ++n)
#pragma unroll
                    for (int h = 0; h < 2; ++h) {
                        const f2 g = {acc[ai][0][m][n][2 * h], acc[ai][0][m][n][2 * h + 1]}, uu = {acc[ai][1][m][n][2 * h], acc[ai][1][m][n][2 * h + 1]};
                        const f2 x = g * (-1.4426950408889634f);
                        f2 d; d.x = __builtin_amdgcn_exp2f(x.x); d.y = __builtin_amdgcn_exp2f(x.y); d = d + 1.0f;
                        f2 r; r.x = __builtin_amdgcn_rcpf(d.x); r.y = __builtin_amdgcn_rcpf(d.y);
                        const f2 o = (g * uu) * r;
                        wv[n * 2 + h] = cvt_pk_bf16(o.x, o.y); }
                u32x4 w; w.x = wv[0]; w.y = wv[1]; w.z = wv[2]; w.w = wv[3];
                __builtin_nontemporal_store(w, (u32x4*)rowp); }
    }
};

struct EpiResid {
    static constexpr bool PERM = false, AFTER_DRAIN = false;
    const float* base_lat; const float* base_ctx; float* out_lat; float* out_ctx; const float* gate; float coef;
    __device__ __forceinline__ void operator()(const f32x4 (&acc)[2][2][4][2], const Unit& u, int wr, int wc, int fr, int fq) const {
        const bool isctx = u.pm >= 64;
        const float* base = isctx ? base_ctx + (size_t)(u.pm - 64) * BM * 1024 : base_lat + (size_t)u.pm * BM * 1024;
        float* out = isctx ? out_ctx + (size_t)(u.pm - 64) * BM * 1024 : out_lat + (size_t)u.pm * BM * 1024;
        const float* g = gate + (size_t)(isctx ? 4 : (u.pm >> 4)) * 9216;
        const int col0 = u.pn * BM + wc * 32 + 4 * fq;
        f32x4 gv[2][2];
#pragma unroll
        for (int bj = 0; bj < 2; ++bj)
#pragma unroll
            for (int n = 0; n < 2; ++n) gv[bj][n] = *(const f32x4*)(g + col0 + bj * HALF + n * 16) * coef;
#pragma unroll
        for (int ai = 0; ai < 2; ++ai)
#pragma unroll
            for (int m = 0; m < 4; ++m) { const size_t off = (size_t)(ai * HALF + wr * 64 + m * 16 + fr) * 1024 + col0;
#pragma unroll
                for (int bj = 0; bj < 2; ++bj)
#pragma unroll
                    for (int n = 0; n < 2; ++n) { const f32x4 b = *(const f32x4*)(base + off + bj * HALF + n * 16);
                        *(f32x4*)(out + off + bj * HALF + n * 16) = b + gv[bj][n] * acc[ai][bj][m][n]; } }
    }
};

struct EpiProj {
    static constexpr bool PERM = true, AFTER_DRAIN = false;
    bf16_t* O; int ldc;
    __device__ __forceinline__ void operator()(const f32x4 (&acc)[2][2][4][2], const Unit& u, int wr, int wc, int fr, int fq) const {
        const int row0 = u.pm * BM + wr * 64 + fr, col0 = u.pn * BM + wc * 32 + 8 * fq;
        const int mode = (u.pn < 2) ? 1 : ((u.pn == 4 || u.pn == 5) ? 2 : (u.pn >= 14 ? 3 : 0));
#pragma unroll
        for (int ai = 0; ai < 2; ++ai)
#pragma unroll
            for (int m = 0; m < 4; ++m) { bf16_t* rowp = O + (size_t)(row0 + ai * HALF + m * 16) * ldc + col0;
#pragma unroll
                for (int bj = 0; bj < 2; ++bj) { float r[8];
#pragma unroll
                    for (int n = 0; n < 2; ++n)
#pragma unroll
                        for (int i = 0; i < 4; ++i) { const float v = acc[ai][bj][m][n][i];
                            r[n * 4 + i] = mode == 0 ? v : (mode == 1 ? fast_silu(v) * 0.08838834764831845f : (mode == 2 ? fast_silu(v) : fast_sigmoid(v))); }
                    u32x4 w; w.x = cvt_pk_bf16(r[0], r[1]); w.y = cvt_pk_bf16(r[2], r[3]); w.z = cvt_pk_bf16(r[4], r[5]); w.w = cvt_pk_bf16(r[6], r[7]);
                    *(u32x4*)(rowp + bj * HALF) = w; } }
    }
};

struct DownOrder {
    StaticOrder lat; int c;
    __device__ __forceinline__ bool next(int i, Unit& u) const {
        if (i == 0) return lat.next(0, u);
        if (i != 1 || c >= 176) return false;
        const int ks = c % 11, t = c / 11; u.pn = t & 3; u.pm = 64 + (t >> 2); u.kofs = ks * 256; u.kt = 4; return true; }
    __device__ __forceinline__ void a_ready(const Unit&) const {}
    __device__ __forceinline__ void done(const Unit&) const {}
};
struct EpiDown1 {
    static constexpr bool PERM = true, AFTER_DRAIN = false;
    const float* base; bf16_t* out; const float* gate; float coef; float* slab;
    __device__ __forceinline__ void operator()(const f32x4 (&acc)[2][2][4][2], const Unit& u, int wr, int wc, int fr, int fq) const {
        const int col0 = u.pn * BM + wc * 32 + 8 * fq;
        if (u.kt) {
            float* o = slab + ((size_t)(u.kofs >> 8) * 1024 + (size_t)(u.pm - 64) * BM) * 1024 + col0;
#pragma unroll
            for (int ai = 0; ai < 2; ++ai)
#pragma unroll
                for (int m = 0; m < 4; ++m) { float* rowp = o + (size_t)(ai * HALF + wr * 64 + m * 16 + fr) * 1024;
#pragma unroll
                    for (int bj = 0; bj < 2; ++bj) { *(f32x4*)(rowp + bj * HALF) = acc[ai][bj][m][0]; *(f32x4*)(rowp + bj * HALF + 4) = acc[ai][bj][m][1]; } }
            return;
        }
        const float* g = gate + (size_t)(u.pm >> 4) * 9216;
        f32x4 gv[2][2];
#pragma unroll
        for (int bj = 0; bj < 2; ++bj)
#pragma unroll
            for (int n = 0; n < 2; ++n) gv[bj][n] = *(const f32x4*)(g + col0 + bj * HALF + 4 * n) * coef;
#pragma unroll
        for (int ai = 0; ai < 2; ++ai)
#pragma unroll
            for (int m = 0; m < 4; ++m) { const size_t off = (size_t)(u.pm * BM + ai * HALF + wr * 64 + m * 16 + fr) * 1024 + col0;
#pragma unroll
                for (int bj = 0; bj < 2; ++bj) { const f32x4 b0 = *(const f32x4*)(base + off + bj * HALF), b1 = *(const f32x4*)(base + off + bj * HALF + 4);
                    const f32x4 v0 = b0 + gv[bj][0] * acc[ai][bj][m][0], v1 = b1 + gv[bj][1] * acc[ai][bj][m][1];
                    u32x4 w; w.x = cvt_pk_bf16(v0[0], v0[1]); w.y = cvt_pk_bf16(v0[2], v0[3]); w.z = cvt_pk_bf16(v1[0], v1[1]); w.w = cvt_pk_bf16(v1[2], v1[3]);
                    *(u32x4*)(out + off + bj * HALF) = w; } }
    }
};
struct ProjOrder {
    StaticOrder lat; int c;
    __device__ __forceinline__ bool next(int i, Unit& u) const {
        if (i < 4) return lat.next(i, u);
        if (i != 4 || c >= 144) return false;
        const int ks = c & 3, t = c >> 2, t9 = t % 9;
        u.pm = 64 + t / 9; u.pn = t9 < 2 ? 2 + t9 : (t9 < 6 ? 4 + t9 : 5 + t9); u.kofs = ks * 256; u.kt = 4; return true; }
    __device__ __forceinline__ void a_ready(const Unit&) const {}
    __device__ __forceinline__ void done(const Unit&) const {}
};
struct EpiProjAll {
    static constexpr bool PERM = true, AFTER_DRAIN = false;
    EpiProj lat; bf16_t* slab;
    __device__ __forceinline__ void operator()(const f32x4 (&acc)[2][2][4][2], const Unit& u, int wr, int wc, int fr, int fq) const {
        if (!u.kt) { lat(acc, u, wr, wc, fr, fq); return; }
        const int t9 = u.pn < 4 ? u.pn - 2 : (u.pn < 10 ? u.pn - 4 : u.pn - 5);
        bf16_t* out = slab + ((size_t)(u.kofs >> 8) * 1024 + (size_t)(u.pm - 64) * BM) * 2304 + t9 * 256 + wc * 32 + 8 * fq;
#pragma unroll
        for (int ai = 0; ai < 2; ++ai)
#pragma unroll
            for (int m = 0; m < 4; ++m) { bf16_t* rowp = out + (size_t)(ai * HALF + wr * 64 + m * 16 + fr) * 2304;
#pragma unroll
                for (int bj = 0; bj < 2; ++bj) { const f32x4 v0 = acc[ai][bj][m][0], v1 = acc[ai][bj][m][1];
                    u32x4 w; w.x = cvt_pk_bf16(v0[0], v0[1]); w.y = cvt_pk_bf16(v0[2], v0[3]); w.z = cvt_pk_bf16(v1[0], v1[1]); w.w = cvt_pk_bf16(v1[2], v1[3]);
                    *(u32x4*)(rowp + bj * HALF) = w; } }
    }
};

template <bool BASE_BF16>
struct EpiResidB {
    static constexpr bool PERM = true, AFTER_DRAIN = false;
    const void* base; bf16_t* out; const float* gate; float coef;
    __device__ __forceinline__ void operator()(const f32x4 (&acc)[2][2][4][2], const Unit& u, int wr, int wc, int fr, int fq) const {
        const float* g = gate + (size_t)(u.pm >> 4) * 9216;
        const int col0 = u.pn * BM + wc * 32 + 8 * fq;
        f32x4 gv[2][2];
#pragma unroll
        for (int bj = 0; bj < 2; ++bj)
#pragma unroll
            for (int n = 0; n < 2; ++n) gv[bj][n] = *(const f32x4*)(g + col0 + bj * HALF + 4 * n) * coef;
#pragma unroll
        for (int ai = 0; ai < 2; ++ai)
#pragma unroll
            for (int m = 0; m < 4; ++m) { const size_t off = (size_t)(u.pm * BM + ai * HALF + wr * 64 + m * 16 + fr) * 1024 + col0;
#pragma unroll
                for (int bj = 0; bj < 2; ++bj) { f32x4 b0, b1;
                    if (BASE_BF16) { const u32x4 bw = *(const u32x4*)((const bf16_t*)base + off + bj * HALF);
                        b0 = (f32x4){__builtin_bit_cast(float, bw.x << 16), __builtin_bit_cast(float, bw.x & 0xffff0000u), __builtin_bit_cast(float, bw.y << 16), __builtin_bit_cast(float, bw.y & 0xffff0000u)};
                        b1 = (f32x4){__builtin_bit_cast(float, bw.z << 16), __builtin_bit_cast(float, bw.z & 0xffff0000u), __builtin_bit_cast(float, bw.w << 16), __builtin_bit_cast(float, bw.w & 0xffff0000u)}; }
                    else { b0 = *(const f32x4*)((const float*)base + off + bj * HALF); b1 = *(const f32x4*)((const float*)base + off + bj * HALF + 4); }
                    const f32x4 v0 = b0 + gv[bj][0] * acc[ai][bj][m][0], v1 = b1 + gv[bj][1] * acc[ai][bj][m][1];
                    u32x4 w; w.x = cvt_pk_bf16(v0[0], v0[1]); w.y = cvt_pk_bf16(v0[2], v0[3]); w.z = cvt_pk_bf16(v1[0], v1[1]); w.w = cvt_pk_bf16(v1[2], v1[3]);
                    *(u32x4*)(out + off + bj * HALF) = w; } }
    }
};

template <class Epi, class Sched, bool ALIGN_EPI = false, bool SP2 = false>
__device__ __forceinline__ void gemm_phase(PG8_LAS unsigned char* lds, const Gemm g, const Sched& S, const Epi& E) {
    const int tid = threadIdx.x, wid = __builtin_amdgcn_readfirstlane(tid >> 6), lane = tid & 63, wr = wid >> 2, wc = wid & 3, fr = lane & 15, fq = lane >> 4;
    const int K = g.K, nt = K / BK, LD = g.ld;
    unsigned voffA[2], voffB[2];
#pragma unroll
    for (int i = 0; i < 2; ++i) { int R, C; stage_rc(tid * 16 + i * 8192, R, C); const int Rb = Epi::PERM ? ((R & ~31) + perm32(R & 31)) : R;
        voffA[i] = (unsigned)(R * LD + C) * 2u; voffB[i] = (unsigned)(Rb * LD + C) * 2u; }
    const size_t kstep = (size_t)(BK * 2);
    const size_t hstep = (size_t)HALF * LD * 2;
    const size_t tstep = 2 * hstep;
    const unsigned ldsw = (unsigned)wid * 1024u;
    const int aoff = lds_byte(wr * 64 + fr, fq * 8), boff = lds_byte(wc * 32 + fr, fq * 8);
#define PG8_SA(b, h) (((b) * 2 + (h)) * HTB)
#define PG8_SB(b, h) ((4 + (b) * 2 + (h)) * HTB)
#define PG8_STAGE(bufoff, gbase, voff) do { _Pragma("unroll") for (int _i = 0; _i < 2; ++_i) \
        __builtin_amdgcn_global_load_lds((const unsigned*)((const char*)(gbase) + (voff)[_i]), (PG8_LAS unsigned*)(lds + (bufoff) + ldsw + _i * 8192), 16, 0, 0); } while (0)
#define PG8_LDA(dst, b, h) do { _Pragma("unroll") for (int m = 0; m < 4; ++m) _Pragma("unroll") for (int k = 0; k < 2; ++k) dst[m][k] = *(const PG8_LAS bf16x8*)(lds + PG8_SA(b, h) + aoff + m * 2048 + k * 1024); } while (0)
#define PG8_LDB(dst, b, h) do { _Pragma("unroll") for (int n = 0; n < 2; ++n) _Pragma("unroll") for (int k = 0; k < 2; ++k) dst[n][k] = *(const PG8_LAS bf16x8*)(lds + PG8_SB(b, h) + boff + n * 2048 + k * 1024); } while (0)
#define PG8_MMA(ai, bj, At, Bt) do { __builtin_amdgcn_s_setprio(1); _Pragma("unroll") for (int m = 0; m < 4; ++m) _Pragma("unroll") for (int n = 0; n < 2; ++n) _Pragma("unroll") for (int k = 0; k < 2; ++k) \
        acc[ai][bj][m][n] = __builtin_amdgcn_mfma_f32_16x16x32_bf16(Bt[n][k], At[m][k], acc[ai][bj][m][n], 0, 0, 0); __builtin_amdgcn_s_setprio(0); } while (0)
#define PG8_WAIT_V(n) asm volatile("s_waitcnt vmcnt(" #n ")" ::: "memory")
#define PG8_WAIT_L(n) asm volatile("s_waitcnt lgkmcnt(" #n ")" ::: "memory")
#define PG8_BAR __builtin_amdgcn_s_barrier()
#define PG8_SCHED __builtin_amdgcn_sched_barrier(0)
    Unit cur, nxt; int ui = 0;
    if (!S.next(0, cur)) return;
    f32x4 acc[2][2][4][2];
#pragma unroll
    for (int a = 0; a < 2; ++a)
#pragma unroll
        for (int b = 0; b < 2; ++b)
#pragma unroll
            for (int m = 0; m < 4; ++m)
#pragma unroll
                for (int n = 0; n < 2; ++n) acc[a][b][m][n] = (f32x4){0.f, 0.f, 0.f, 0.f};
    bf16x8 At[4][2], B0[2][2], B1[2][2];
    const char* cA = (const char*)g.A + (size_t)cur.pm * tstep + (size_t)cur.kofs * 2; const char* cB = (const char*)g.Bt + (size_t)cur.pn * tstep + (size_t)cur.kofs * 2;
    S.a_ready(cur);
    if constexpr (SP2) {
        PG8_STAGE(PG8_SB(0, 0), cB, voffB); PG8_STAGE(PG8_SB(0, 1), cB + hstep, voffB); PG8_STAGE(PG8_SA(0, 0), cA, voffA); PG8_STAGE(PG8_SA(0, 1), cA + hstep, voffA);
        if (wr == 1) PG8_BAR;
        PG8_WAIT_V(2); PG8_BAR;
        PG8_STAGE(PG8_SB(1, 0), cB + kstep, voffB); PG8_STAGE(PG8_SA(1, 0), cA + kstep, voffA); PG8_STAGE(PG8_SB(1, 1), cB + hstep + kstep, voffB);
        PG8_WAIT_V(6); PG8_BAR;
    } else {
        PG8_STAGE(PG8_SB(0, 0), cB, voffB); PG8_STAGE(PG8_SA(0, 0), cA, voffA); PG8_STAGE(PG8_SB(0, 1), cB + hstep, voffB); PG8_STAGE(PG8_SA(0, 1), cA + hstep, voffA);
        if (wr == 1) PG8_BAR;
        PG8_WAIT_V(4); PG8_BAR;
        PG8_STAGE(PG8_SB(1, 0), cB + kstep, voffB); PG8_STAGE(PG8_SA(1, 0), cA + kstep, voffA); PG8_STAGE(PG8_SB(1, 1), cB + hstep + kstep, voffB);
        PG8_WAIT_V(6); PG8_BAR;
    }
    for (;;) {
        const bool has_next = S.next(ui + 1, nxt);
        const char* nA = has_next ? (const char*)g.A + (size_t)nxt.pm * tstep + (size_t)nxt.kofs * 2 : cA; const char* nB = has_next ? (const char*)g.Bt + (size_t)nxt.pn * tstep + (size_t)nxt.kofs * 2 : cB;
        const int ntu = cur.kt ? cur.kt : nt;
        for (int t = 0; t < ntu; t += 2) {
            const bool last = (t == ntu - 2);
            const char* a1 = cA + (size_t)(t + 1) * kstep;
            const char* a2 = last ? nA : cA + (size_t)(t + 2) * kstep; const char* b2 = last ? nB : cB + (size_t)(t + 2) * kstep;
            const char* a3 = a2 + kstep; const char* b3 = b2 + kstep;
            if (last && has_next) S.a_ready(nxt);
            if constexpr (SP2) {
            PG8_LDB(B0, 0, 0); PG8_LDB(B1, 0, 1); PG8_SCHED; PG8_LDA(At, 0, 0); PG8_STAGE(PG8_SA(1, 1), a1 + hstep, voffA);
            PG8_WAIT_V(8); PG8_WAIT_L(0); PG8_BAR; PG8_MMA(0, 0, At, B0); PG8_MMA(0, 1, At, B1); PG8_BAR; PG8_SCHED;
            PG8_LDA(At, 0, 1); PG8_STAGE(PG8_SB(0, 0), b2, voffB); PG8_STAGE(PG8_SB(0, 1), b2 + hstep, voffB); PG8_STAGE(PG8_SA(0, 0), a2, voffA);
            PG8_WAIT_V(8); PG8_WAIT_L(0); PG8_BAR; PG8_MMA(1, 0, At, B0); PG8_MMA(1, 1, At, B1); PG8_BAR; PG8_SCHED;
            PG8_LDB(B0, 1, 0); PG8_LDB(B1, 1, 1); PG8_SCHED; PG8_LDA(At, 1, 0); PG8_STAGE(PG8_SA(0, 1), a2 + hstep, voffA);
            PG8_WAIT_V(8); PG8_WAIT_L(0); PG8_BAR; PG8_MMA(0, 0, At, B0); PG8_MMA(0, 1, At, B1); PG8_BAR; PG8_SCHED;
            PG8_LDA(At, 1, 1); PG8_STAGE(PG8_SB(1, 0), b3, voffB); PG8_STAGE(PG8_SB(1, 1), b3 + hstep, voffB); PG8_STAGE(PG8_SA(1, 0), a3, voffA);
            PG8_WAIT_V(8); PG8_WAIT_L(0); PG8_BAR; PG8_MMA(1, 0, At, B0); PG8_MMA(1, 1, At, B1); PG8_BAR; PG8_SCHED;
            } else {
            PG8_LDB(B0, 0, 0); PG8_SCHED; PG8_LDA(At, 0, 0); PG8_STAGE(PG8_SA(1, 1), a1 + hstep, voffA);
            PG8_WAIT_L(8); PG8_BAR; PG8_WAIT_L(0); PG8_MMA(0, 0, At, B0); PG8_BAR; PG8_SCHED;
            PG8_LDB(B1, 0, 1); PG8_STAGE(PG8_SB(0, 0), b2, voffB);
            PG8_BAR; PG8_WAIT_L(0); PG8_MMA(0, 1, At, B1); PG8_BAR;
            PG8_LDA(At, 0, 1); PG8_STAGE(PG8_SA(0, 0), a2, voffA);
            PG8_BAR; PG8_WAIT_L(0); PG8_MMA(1, 0, At, B0); PG8_BAR; PG8_SCHED;
            PG8_STAGE(PG8_SB(0, 1), b2 + hstep, voffB);
            PG8_WAIT_V(6); PG8_BAR; PG8_MMA(1, 1, At, B1); PG8_BAR;
            PG8_LDB(B0, 1, 0); PG8_SCHED; PG8_LDA(At, 1, 0); PG8_STAGE(PG8_SA(0, 1), a2 + hstep, voffA);
            PG8_WAIT_L(8); PG8_BAR; PG8_WAIT_L(0); PG8_MMA(0, 0, At, B0); PG8_BAR; PG8_SCHED;
            PG8_LDB(B1, 1, 1); PG8_STAGE(PG8_SB(1, 0), b3, voffB);
            PG8_BAR; PG8_WAIT_L(0); PG8_MMA(0, 1, At, B1); PG8_BAR;
            PG8_LDA(At, 1, 1); PG8_STAGE(PG8_SA(1, 0), a3, voffA);
            PG8_BAR; PG8_WAIT_L(0); PG8_MMA(1, 0, At, B0); PG8_BAR; PG8_SCHED;
            PG8_STAGE(PG8_SB(1, 1), b3 + hstep, voffB);
            PG8_WAIT_V(6); PG8_BAR; PG8_MMA(1, 1, At, B1); PG8_BAR;
            }
        }
        if constexpr (ALIGN_EPI) { if (wr == 0) PG8_BAR; }
        if constexpr (!Epi::AFTER_DRAIN) { PG8_PS_BEGIN(); E(acc, cur, wr, wc, fr, fq); S.done(cur); PG8_PS_END(); }
        if (!has_next) break;
#pragma unroll
        for (int a = 0; a < 2; ++a)
#pragma unroll
            for (int b = 0; b < 2; ++b)
#pragma unroll
                for (int m = 0; m < 4; ++m)
#pragma unroll
                    for (int n = 0; n < 2; ++n) acc[a][b][m][n] = (f32x4){0.f, 0.f, 0.f, 0.f};
        cur = nxt; cA = nA; cB = nB; ++ui;
        if constexpr (ALIGN_EPI) { if (wr == 1) PG8_BAR; }
    }
    PG8_WAIT_V(0);
    if constexpr (!ALIGN_EPI) { if (wr == 0) PG8_BAR; }
    PG8_BAR;
    if constexpr (Epi::AFTER_DRAIN) { E.fused(acc, cur, wr, wc, fr, fq, lds, wid, lane); S.done(cur); }
#undef PG8_SA
#undef PG8_SB
#undef PG8_STAGE
#undef PG8_LDA
#undef PG8_LDB
#undef PG8_MMA
#undef PG8_WAIT_V
#undef PG8_WAIT_L
#undef PG8_BAR
#undef PG8_SCHED
}
}
constexpr int DM = 1024, NB = 4, SEQ = 4096, NCTX = 256, DFF = 2816, DIN = 4112, NPROJ = 4096, NMODC = 9216;
constexpr int LDP = 4224;
constexpr int MLAT = NB * SEQ, MCTX = NB * NCTX, MALL = MLAT + MCTX;
constexpr float EPSN = 1e-6f;
constexpr int NWAVES = 8, NTHREADS = 512;
#ifndef ONE_LAUNCH
#define ONE_LAUNCH 1
#endif
constexpr int NPHASES = 15;

constexpr size_t MiB = 1u << 20;
constexpr size_t WS_CTL = 0, CTL_ZERO_BYTES = 64 * 1024;
constexpr size_t WS_MODS = 1 * MiB;
constexpr size_t WS_GATES = 1 * MiB + 512 * 1024;
constexpr size_t WS_W1 = 3 * MiB;
constexpr size_t WS_W2 = 14 * MiB;
constexpr size_t WS_WIN = 20 * MiB;
constexpr size_t WS_WOUT = 28 * MiB;
constexpr size_t WS_XN = 34 * MiB;
constexpr size_t WS_PROJ = 68 * MiB;
constexpr size_t WS_QK = 209 * MiB;
constexpr size_t WS_END = 256 * MiB;
constexpr size_t WS_HGST = 237 * MiB;
constexpr size_t WS_HGG = 253 * MiB;
constexpr size_t WS_WG = 2 * MiB + 640 * 1024;
constexpr size_t WS_MLST = 226 * MiB;
constexpr size_t WS_MLSC = 236 * MiB;
constexpr size_t WS_SLAB = 204 * MiB;
constexpr size_t WS_SLAB2 = 237 * MiB;
constexpr int CW_BAR = 1024;

constexpr int RING_BYTES = 131072;
constexpr int LDSCTL_OFF = 162816, MISC_OFF = LDSCTL_OFF + 320;
constexpr int LDS_BYTES = 163840;

#define GAS __attribute__((address_space(1)))
#define LAS __attribute__((address_space(3)))
typedef unsigned short bf16;
typedef unsigned v4u __attribute__((ext_vector_type(4)));
typedef unsigned v2u __attribute__((ext_vector_type(2)));
typedef float f32x4 __attribute__((ext_vector_type(4)));
#define LDS_WAIT() asm volatile("s_waitcnt lgkmcnt(0)" ::: "memory")
#define VM_WAIT() asm volatile("s_waitcnt vmcnt(0)" ::: "memory")
__device__ __forceinline__ unsigned f2bf(float f) { unsigned u = __builtin_bit_cast(unsigned, f); return (u + 0x7fffu + ((u >> 16) & 1u)) >> 16; }
__device__ __forceinline__ unsigned pk2(float lo, float hi) { return f2bf(lo) | (f2bf(hi) << 16); }
__device__ __forceinline__ float bf2f(unsigned short h) { return __builtin_bit_cast(float, (unsigned)h << 16); }
__device__ __forceinline__ float bflo(unsigned w) { return __builtin_bit_cast(float, w << 16); }
__device__ __forceinline__ float bfhi(unsigned w) { return __builtin_bit_cast(float, w & 0xffff0000u); }
__device__ __forceinline__ float sigmoidf_(float v) { return 1.0f / (1.0f + __expf(-v)); }
__device__ __forceinline__ float fast_sig(float v) { return __builtin_amdgcn_rcpf(1.0f + __builtin_amdgcn_exp2f(-1.4426950408889634f * v)); }
__device__ __forceinline__ float siluf_(float v) { return v * sigmoidf_(v); }
__device__ __forceinline__ float wave_sum(float v) {
#pragma unroll
    for (int o = 1; o < 64; o <<= 1) v += __shfl_xor(v, o);
    return v;
}

#ifndef PROF_S
#define PROF_S -1
#endif
#define PS_BEGIN() do { if (PROF_S >= 0 && blockIdx.x == 0 && threadIdx.x == 0) { const unsigned long long t_ = __builtin_amdgcn_s_memrealtime(); volatile LAS unsigned* M_ = (volatile LAS unsigned*)(T.lds + MISC_OFF); M_[20] = (unsigned)t_; M_[21] = (unsigned)(t_ >> 32); } } while (0)
#define PS_END(id) do { if (PROF_S >= 0 && blockIdx.x == 0 && threadIdx.x == 0) { const unsigned long long t_ = __builtin_amdgcn_s_memrealtime(); volatile LAS unsigned* M_ = (volatile LAS unsigned*)(T.lds + MISC_OFF); \
    if ((id) == PROF_S) { const unsigned long long p_ = ((unsigned long long)M_[21] << 32) | M_[20]; const unsigned long long a_ = (((unsigned long long)M_[23] << 32) | M_[22]) + (t_ - p_); M_[22] = (unsigned)a_; M_[23] = (unsigned)(a_ >> 32); } \
    M_[20] = (unsigned)t_; M_[21] = (unsigned)(t_ >> 32); } } while (0)
#define XB_TMO      128
#define XB_XCNT(j)  (256  + 64 * (j))
#define XB_XSUB(j)  (1280 + 64 * (j))
#define XB_XGEN(j)  (2304 + 64 * (j))
#define XB_TOP      3328
#define XB_TOPGEN   3392
#define XCD_BAR_WORDS 3456
#define XB_SPIN_CAP (1u << 18)

__device__ __forceinline__ unsigned xb_ld(unsigned* p)              { return __hip_atomic_load(p, __ATOMIC_RELAXED, __HIP_MEMORY_SCOPE_AGENT); }
__device__ __forceinline__ unsigned xb_add(unsigned* p, unsigned v) { return __hip_atomic_fetch_add(p, v, __ATOMIC_RELAXED, __HIP_MEMORY_SCOPE_AGENT); }
__device__ __forceinline__ unsigned xb_xcc_id() { return (unsigned)__builtin_amdgcn_s_getreg((3 << 11) | 20) & 0xFu; }
#define XB_SPIN(cond, bar) do { unsigned _sp = 0; while (cond) { __builtin_amdgcn_s_sleep(1); \
    if ((++_sp & 255u) == 0u) { if (xb_ld(&(bar)[XB_TMO])) break; if (_sp > XB_SPIN_CAP) { atomicAdd(&(bar)[XB_TMO], 1u); break; } } } } while (0)

struct XcdBarrier {
    unsigned* bar; unsigned x;
    volatile LAS unsigned* st;
};

__device__ __forceinline__ XcdBarrier xcd_barrier_post(unsigned* bar, volatile LAS unsigned* st) {
    XcdBarrier b; b.bar = bar; b.x = xb_xcc_id(); b.st = st;
    if (threadIdx.x == 0) (void)xb_add(&bar[XB_XCNT(b.x)], 1u);
    return b;
}
__device__ __forceinline__ void xcd_barrier_complete(unsigned* bar, unsigned x, unsigned& nloc, unsigned& nx) {
    const unsigned G = gridDim.x * gridDim.y * gridDim.z;
    unsigned sum, cnt, mine, sp = 0u;
    for (;;) {
        sum = 0u; cnt = 0u; mine = 0u;
#pragma unroll
        for (unsigned j = 0; j < 16; ++j) { const unsigned c = xb_ld(&bar[XB_XCNT(j)]); sum += c; cnt += (c > 0u) ? 1u : 0u; mine = (j == x) ? c : mine; }
        if (sum == G) break;
        __builtin_amdgcn_s_sleep(1);
        if ((++sp & 255u) == 0u) { if (xb_ld(&bar[XB_TMO])) break; if (sp > XB_SPIN_CAP) { atomicAdd(&bar[XB_TMO], 1u); break; } }
    }
    nloc = mine > 0u ? mine : 1u; nx = cnt > 0u ? cnt : 1u;
}

__device__ __forceinline__ void xcd_barrier(const XcdBarrier& b) {
    asm volatile("s_waitcnt vmcnt(0)" ::: "memory");
    __syncthreads();
    if (threadIdx.x == 0) {
        unsigned* bar = b.bar;
        __builtin_amdgcn_s_waitcnt(0);
        unsigned nloc = b.st[0], nx = b.st[1];
        if (nloc == 0u) { xcd_barrier_complete(bar, b.x, nloc, nx); b.st[0] = nloc; b.st[1] = nx; }
        const unsigned old = xb_add(&bar[XB_XSUB(b.x)], 1u);
        const unsigned gen = old / nloc;
        if (old + 1u == (gen + 1u) * nloc) {
            __builtin_amdgcn_fence(__ATOMIC_RELEASE, "agent");
            asm volatile("s_waitcnt vmcnt(0)" ::: "memory");
            const unsigned og = xb_add(&bar[XB_TOP], 1u);
            const unsigned tg = og / nx;
            if (og + 1u == (tg + 1u) * nx) xb_add(&bar[XB_TOPGEN], 1u);
            else XB_SPIN(xb_ld(&bar[XB_TOPGEN]) == tg, bar);
            __builtin_amdgcn_fence(__ATOMIC_ACQUIRE, "agent");
            xb_add(&bar[XB_XGEN(b.x)], 1u);
            asm volatile("s_waitcnt vmcnt(0)" ::: "memory");
        } else {
            XB_SPIN(xb_ld(&bar[XB_XGEN(b.x)]) == gen, bar);
            __builtin_amdgcn_fence(__ATOMIC_ACQUIRE, "agent");
            asm volatile("s_waitcnt vmcnt(0)" ::: "memory");
        }
    }
    __syncthreads();
}
struct Args {
    const float* in[22]; float* out; unsigned char* ws; int ph_lo, ph_hi;
};
enum { I_X = 0, I_C, I_CTX, I_CCTX, I_WMOD, I_BMOD, I_N1W, I_F1W1, I_F1W2, I_N2W, I_WIN, I_MLGB, I_CONVW, I_CONVB, I_LBLOG, I_HGNW, I_MLNW, I_WOUT, I_N3W, I_F2W1, I_F2W2, I_FNW };

struct Ctx {
    LAS unsigned char* lds;
    int tid, lane, wave, vcu, G, gw, NGW;
};

__device__ __forceinline__ void mods_phase(const Args& a, const Ctx& T) {
    LAS float* sL = (LAS float*)T.lds;
    LAS float* red = (LAS float*)(T.lds + 20480);
    const float* c = a.in[I_C]; const float* cc = a.in[I_CCTX];
    for (int i = T.tid; i < 5 * 1024; i += NTHREADS) { const int r = i >> 10, k = i & 1023; const float v = r < 4 ? c[r * 1024 + k] : cc[k]; sL[i] = siluf_(v); }
    __syncthreads();
    typedef float f2 __attribute__((ext_vector_type(2)));
    for (int item = T.vcu; item < 576; item += T.G) {
        const int cb = item >> 3, kr = item & 7; const int k0 = kr * 128 + T.wave * 16;
        const float* W = a.in[I_WMOD] + (size_t)k0 * NMODC + cb * 128 + 2 * T.lane;
        f2 wv[16];
#pragma unroll
        for (int k = 0; k < 16; ++k) wv[k] = __builtin_nontemporal_load((const f2*)(W + (size_t)k * NMODC));
        float acc[5][2];
#pragma unroll
        for (int r = 0; r < 5; ++r) { acc[r][0] = 0.f; acc[r][1] = 0.f; }
#pragma unroll
        for (int k = 0; k < 16; ++k)
#pragma unroll
            for (int r = 0; r < 5; ++r) { const float s = sL[r * 1024 + k0 + k]; acc[r][0] += s * wv[k].x; acc[r][1] += s * wv[k].y; }
#pragma unroll
        for (int r = 0; r < 5; ++r) *(LAS f2*)(red + (T.wave * 5 + r) * 128 + 2 * T.lane) = (f2){acc[r][0], acc[r][1]};
        __syncthreads();
        for (int o = T.tid; o < 640; o += NTHREADS) { const int r = o >> 7, cl = o & 127; float s = 0.f;
#pragma unroll
            for (int w = 0; w < 8; ++w) s += red[(w * 5 + r) * 128 + cl];
            const int col = cb * 128 + cl; if (kr == 0) s += a.in[I_BMOD][col];
            atomicAdd((float*)(a.ws + WS_MODS) + r * NMODC + col, s); }
        __syncthreads();
    }
}

__device__ __forceinline__ void transpose_item(const float* W, int ldw, int K, bf16* WT, int k0, int n0, int dest_row0, LAS float* scr, int lane) {
    float tv[32];
#pragma unroll
    for (int i = 0; i < 32; ++i) tv[i] = __builtin_nontemporal_load(W + (size_t)(k0 + 2 * i + (lane >> 5)) * ldw + n0 + (lane & 31));
#pragma unroll
    for (int i = 0; i < 32; ++i) scr[(2 * i + (lane >> 5)) * 33 + (lane & 31)] = tv[i];
    LDS_WAIT(); asm volatile("" ::: "memory");
    const int c = lane & 7;
#pragma unroll
    for (int j = 0; j < 4; ++j) { const int n = (lane >> 3) + 8 * j; const LAS float* s = scr + (8 * c) * 33 + n;
        v4u o; o.x = pk2(s[0 * 33], s[1 * 33]); o.y = pk2(s[2 * 33], s[3 * 33]); o.z = pk2(s[4 * 33], s[5 * 33]); o.w = pk2(s[6 * 33], s[7 * 33]);
        *(GAS v4u*)(WT + (size_t)(dest_row0 + n) * K + k0 + 8 * c) = o; }
    LDS_WAIT(); asm volatile("" ::: "memory");
}
__device__ __forceinline__ void convert_ffn(const Args& a, const Ctx& T, const float* w1, const float* w2) {
    LAS float* scr = (LAS float*)(T.lds + T.wave * 16384);
    bf16* W1 = (bf16*)(a.ws + WS_W1); bf16* W2 = (bf16*)(a.ws + WS_W2);
    constexpr int I1 = 16 * 176, I2 = 44 * 32;
    for (int it = T.gw; it < I1 + I2; it += T.NGW) {
        if (it < I1) { const int kb = it / 176, nb = it % 176, n0 = nb * 32;
            const int dest = n0 < DFF ? (n0 >> 7) * 256 + (n0 & 127) : ((n0 - DFF) >> 7) * 256 + 128 + ((n0 - DFF) & 127);
            transpose_item(w1, 2 * DFF, DM, W1, kb * 64, n0, dest, scr, T.lane); }
        else { const int r = it - I1, kb = r / 32, nb = r % 32; transpose_item(w2, DM, DFF, W2, kb * 64, nb * 32, nb * 32, scr, T.lane); }
    }
}
__device__ __forceinline__ void convert_mix(const Args& a, const Ctx& T) {
    LAS float* scr = (LAS float*)(T.lds + T.wave * 16384);
    bf16* WI = (bf16*)(a.ws + WS_WIN); bf16* WO = (bf16*)(a.ws + WS_WOUT);
    constexpr int I1 = 16 * 128, I2 = 16 * 32;
    for (int it = T.gw; it < I1 + I2; it += T.NGW) {
        if (it < I1) { const int kb = it / 128, nb = it % 128; transpose_item(a.in[I_WIN], DIN, DM, WI, kb * 64, nb * 32, nb * 32, scr, T.lane); }
        else { const int r = it - I1, kb = r / 32, nb = r % 32; transpose_item(a.in[I_WOUT], DM, DM, WO, kb * 64, nb * 32, nb * 32, scr, T.lane); }
    }
}

__device__ __forceinline__ void norm_load_row(f32x4 (&v)[4], const void* src_lat, bool latbf, const float* src_ctx, int m, int lane) {
    if (m < MLAT) {
        if (latbf) { const v2u* xr = (const v2u*)((const bf16*)src_lat + (size_t)m * DM) + lane;
#pragma unroll
            for (int j = 0; j < 4; ++j) { const v2u w = xr[64 * j]; v[j] = (f32x4){bflo(w.x), bfhi(w.x), bflo(w.y), bfhi(w.y)}; } }
        else { const f32x4* xr = (const f32x4*)((const float*)src_lat + (size_t)m * DM) + lane;
#pragma unroll
            for (int j = 0; j < 4; ++j) v[j] = xr[64 * j]; }
    } else { const f32x4* xr = (const f32x4*)(src_ctx + (size_t)(m - MLAT) * DM) + lane;
#pragma unroll
        for (int j = 0; j < 4; ++j) v[j] = xr[64 * j]; }
}
template <bool CTXSLAB, bool LATBF>
__device__ __forceinline__ void norm_mod_rows(const Args& a, const Ctx& T, const void* src_lat, const float* src_ctx, int nrows, const float* nw, int shift_idx, int scale_idx) {
    const float* mods = (const float*)(a.ws + WS_MODS);
    bf16* XN = (bf16*)(a.ws + WS_XN);
    f32x4 wv[4];
#pragma unroll
    for (int j = 0; j < 4; ++j) wv[j] = *((const f32x4*)nw + T.lane + 64 * j);
    f32x4 v[4];
    if (T.gw < nrows) norm_load_row(v, src_lat, LATBF, src_ctx, T.gw, T.lane);
    for (int m = T.gw; m < nrows; m += T.NGW) {
        const float* mr = mods + (size_t)(m < MLAT ? (m >> 12) : 4) * NMODC;
        f32x4 sh[4], sc[4];
#pragma unroll
        for (int j = 0; j < 4; ++j) { sh[j] = *((const f32x4*)(mr + shift_idx * 1024) + T.lane + 64 * j); sc[j] = *((const f32x4*)(mr + scale_idx * 1024) + T.lane + 64 * j); }
        f32x4 cur[4]; float s = 0.f;
        if (CTXSLAB && m >= MLAT) {
            const float* gr = mods + (size_t)4 * NMODC + 2 * 1024;
#pragma unroll
            for (int j = 0; j < 4; ++j) { f32x4 acc = (f32x4){0.f, 0.f, 0.f, 0.f};
#pragma unroll 1
                for (int ks = 0; ks < 11; ++ks) acc += *((const f32x4*)((const float*)(a.ws + WS_SLAB) + ((size_t)ks * 1024 + (m - MLAT)) * 1024) + T.lane + 64 * j);
                v[j] = v[j] + acc * (*((const f32x4*)gr + T.lane + 64 * j) * 0.5f); }
        }
#pragma unroll
        for (int j = 0; j < 4; ++j) { cur[j] = v[j]; s += (v[j].x * v[j].x + v[j].y * v[j].y) + (v[j].z * v[j].z + v[j].w * v[j].w); }
        { const int mn = m + T.NGW; if (mn < nrows) norm_load_row(v, src_lat, LATBF, src_ctx, mn, T.lane); }
        const float rstd = __builtin_amdgcn_rsqf(wave_sum(s) * (1.f / DM) + EPSN);
        unsigned long long* o8 = (unsigned long long*)(XN + (size_t)m * DM) + T.lane;
#pragma unroll
        for (int j = 0; j < 4; ++j) { const f32x4 y = (cur[j] * rstd * wv[j]) * (sc[j] + 1.0f) + sh[j];
            o8[64 * j] = (unsigned long long)pk2(y.x, y.y) | ((unsigned long long)pk2(y.z, y.w) << 32); }
    }
}

struct ConvTaps { v4u t[9]; };
__device__ __forceinline__ void conv_load(ConvTaps& R, const bf16* P, int m, int ch0) {
    const v4u z = (v4u){0u, 0u, 0u, 0u};
    const int b = m >> 12, t = m & 4095, r = t >> 6, c = t & 63;
#pragma unroll
    for (int dr = -1; dr <= 1; ++dr)
#pragma unroll
        for (int dc = -1; dc <= 1; ++dc) { const int rr = r + dr, c2 = c + dc; const bool ok = rr >= 0 && rr < 64 && c2 >= 0 && c2 < 64;
            R.t[(dr + 1) * 3 + dc + 1] = ok ? *(const v4u*)(P + (size_t)(b * 4096 + rr * 64 + c2) * LDP + 2560 + ch0) : z; }
}
__device__ __forceinline__ void ctx_combine(const Args& a, const Ctx& T) {
    const bf16* S2 = (const bf16*)(a.ws + WS_SLAB2); bf16* P = (bf16*)(a.ws + WS_PROJ);
    for (int task = T.vcu * NTHREADS + T.tid; task < 1024 * 256; task += T.G * NTHREADS) {
        const int r = task >> 8, q = task & 255; const int t8 = q >> 5, c8 = (q & 31) * 8; const int t9 = t8 < 6 ? t8 : t8 + 1;
        const int pn = t9 < 2 ? 2 + t9 : (t9 < 6 ? 4 + t9 : 5 + t9);
        float s[8] = {0.f, 0.f, 0.f, 0.f, 0.f, 0.f, 0.f, 0.f};
#pragma unroll
        for (int ks = 0; ks < 4; ++ks) { const v4u pv = *(const v4u*)(S2 + ((size_t)ks * 1024 + r) * 2304 + t9 * 256 + c8);
            s[0] += bflo(pv.x); s[1] += bfhi(pv.x); s[2] += bflo(pv.y); s[3] += bfhi(pv.y); s[4] += bflo(pv.z); s[5] += bfhi(pv.z); s[6] += bflo(pv.w); s[7] += bfhi(pv.w); }
        *(v4u*)(P + (size_t)(MLAT + r) * LDP + pn * 256 + c8) = (v4u){pk2(s[0], s[1]), pk2(s[2], s[3]), pk2(s[4], s[5]), pk2(s[6], s[7])};
    }
}
__device__ __forceinline__ void conv_phase(const Args& a, const Ctx& T) {
    const bf16* P = (const bf16*)(a.ws + WS_PROJ); bf16* QK = (bf16*)(a.ws + WS_QK);
    const float* cw = a.in[I_CONVW]; const float* cb = a.in[I_CONVB];
    const int gid = T.vcu * NTHREADS + T.tid; const int ch0 = (gid & 63) * 8; const int m0 = gid >> 6, mstep = (T.G * NTHREADS) >> 6;
    {
        float w[9][8], bias[8];
#pragma unroll
        for (int k = 0; k < 9; ++k)
#pragma unroll
            for (int i = 0; i < 8; ++i) w[k][i] = cw[k * 512 + ch0 + i];
#pragma unroll
        for (int i = 0; i < 8; ++i) bias[i] = cb[ch0 + i];
        const float sc = ch0 < 256 ? 0.125f : 1.0f;
        ConvTaps R;
        if (m0 < MLAT) conv_load(R, P, m0, ch0);
        for (int m = m0; m < MLAT; m += mstep) {
            float acc[8];
#pragma unroll
            for (int i = 0; i < 8; ++i) acc[i] = bias[i];
#pragma unroll
            for (int k = 0; k < 9; ++k) { const v4u pv = R.t[k];
                acc[0] += w[k][0] * bflo(pv.x); acc[1] += w[k][1] * bfhi(pv.x); acc[2] += w[k][2] * bflo(pv.y); acc[3] += w[k][3] * bfhi(pv.y);
                acc[4] += w[k][4] * bflo(pv.z); acc[5] += w[k][5] * bfhi(pv.z); acc[6] += w[k][6] * bflo(pv.w); acc[7] += w[k][7] * bfhi(pv.w); }
            if (m + mstep < MLAT) conv_load(R, P, m + mstep, ch0);
#pragma unroll
            for (int i = 0; i < 8; ++i) acc[i] = acc[i] * fast_sig(acc[i]) * sc;
            v4u o; o.x = pk2(acc[0], acc[1]); o.y = pk2(acc[2], acc[3]); o.z = pk2(acc[4], acc[5]); o.w = pk2(acc[6], acc[7]);
            *(v4u*)(QK + (size_t)m * 512 + ch0) = o;
        }
    }
    {
        const bf16* S2 = (const bf16*)(a.ws + WS_SLAB2);
#pragma unroll 1
        for (int task = gid; task < MCTX * 32; task += T.G * NTHREADS) {
            const int mc = task >> 5, c8 = (task & 31) * 8, b = mc >> 8, t = mc & 255;
            float acc[8];
#pragma unroll
            for (int i = 0; i < 8; ++i) acc[i] = cb[256 + c8 + i];
#pragma unroll 1
            for (int d = -1; d <= 1; ++d) { const int t2 = t + d; if (t2 < 0 || t2 >= 256) continue;
                float s[8] = {0.f, 0.f, 0.f, 0.f, 0.f, 0.f, 0.f, 0.f};
#pragma unroll
                for (int ks = 0; ks < 4; ++ks) { const v4u pv = *(const v4u*)(S2 + ((size_t)ks * 1024 + b * 256 + t2) * 2304 + 6 * 256 + c8);
                    s[0] += bflo(pv.x); s[1] += bfhi(pv.x); s[2] += bflo(pv.y); s[3] += bfhi(pv.y); s[4] += bflo(pv.z); s[5] += bfhi(pv.z); s[6] += bflo(pv.w); s[7] += bfhi(pv.w); }
                const float* wk = cw + (3 + d + 1) * 512 + 256 + c8;
#pragma unroll
                for (int i = 0; i < 8; ++i) acc[i] += wk[i] * bf2f((unsigned short)f2bf(s[i])); }
#pragma unroll
            for (int i = 0; i < 8; ++i) acc[i] = acc[i] * fast_sig(acc[i]);
            v4u o; o.x = pk2(acc[0], acc[1]); o.y = pk2(acc[2], acc[3]); o.z = pk2(acc[4], acc[5]); o.w = pk2(acc[6], acc[7]);
            *(v4u*)(QK + (size_t)(MLAT + mc) * 512 + 256 + c8) = o;
        }
    }
}

typedef short bf16x8 __attribute__((ext_vector_type(8)));
typedef float f32x2 __attribute__((ext_vector_type(2)));
#define MFMA16(a, b, c) __builtin_amdgcn_mfma_f32_16x16x32_bf16((a), (b), (c), 0, 0, 0)
template <int KSTEPS>
__device__ __forceinline__ void mma_tile(f32x4& acc, const LAS unsigned char* A, int sa, const LAS unsigned char* B, int sb, int lane) {
    const LAS unsigned char* pa = A + (lane & 15) * sa + (lane >> 4) * 16; const LAS unsigned char* pb = B + (lane & 15) * sb + (lane >> 4) * 16;
#pragma unroll
    for (int ks = 0; ks < KSTEPS; ++ks) { const bf16x8 av = *(const LAS bf16x8*)(pa + ks * 64); const bf16x8 bv = *(const LAS bf16x8*)(pb + ks * 64); acc = MFMA16(av, bv, acc); }
}
typedef __bf16 bf16x2_t __attribute__((ext_vector_type(2)));
__device__ __forceinline__ unsigned cvtpk(float lo, float hi) { const f32x2 v = {lo, hi}; const bf16x2_t b = __builtin_convertvector(v, bf16x2_t); return __builtin_bit_cast(unsigned, b); }
struct BF2 { bf16x8 k0, k1; };
struct BF4 { bf16x8 k0, k1, k2, k3; };
__device__ __forceinline__ BF2 ldfrag2(const LAS unsigned char* B, int sb, int lane) { const LAS unsigned char* p = B + (lane & 15) * sb + (lane >> 4) * 16; BF2 f; f.k0 = *(const LAS bf16x8*)p; f.k1 = *(const LAS bf16x8*)(p + 64); return f; }
__device__ __forceinline__ BF4 ldfrag4(const LAS unsigned char* B, int sb, int lane) { const LAS unsigned char* p = B + (lane & 15) * sb + (lane >> 4) * 16; BF4 f; f.k0 = *(const LAS bf16x8*)p; f.k1 = *(const LAS bf16x8*)(p + 64); f.k2 = *(const LAS bf16x8*)(p + 128); f.k3 = *(const LAS bf16x8*)(p + 192); return f; }
__device__ __forceinline__ void mma2(f32x4& acc, const LAS unsigned char* A, int sa, const BF2& b, int lane) { const LAS unsigned char* p = A + (lane & 15) * sa + (lane >> 4) * 16;
    acc = MFMA16(*(const LAS bf16x8*)p, b.k0, acc); acc = MFMA16(*(const LAS bf16x8*)(p + 64), b.k1, acc); }
__device__ __forceinline__ void mma4(f32x4& acc, const LAS unsigned char* A, int sa, const BF4& b, int lane) { const LAS unsigned char* p = A + (lane & 15) * sa + (lane >> 4) * 16;
    acc = MFMA16(*(const LAS bf16x8*)p, b.k0, acc); acc = MFMA16(*(const LAS bf16x8*)(p + 64), b.k1, acc); acc = MFMA16(*(const LAS bf16x8*)(p + 128), b.k2, acc); acc = MFMA16(*(const LAS bf16x8*)(p + 192), b.k3, acc); }
__device__ __forceinline__ float ex2(float v) { return __builtin_amdgcn_exp2f(v); }
__device__ __forceinline__ float lg2(float v) { return __builtin_amdgcn_logf(v); }

constexpr int HS_ND = 272;
constexpr int HS_T = 160;
constexpr int HL_QD = 0, HL_KD = HL_QD + 64 * HS_ND, HL_X = HL_KD + 64 * HS_ND, HL_QE = HL_X + 64 * HS_ND;
constexpr int HL_KTT = HL_QE + 64 * HS_ND;
constexpr int HL_VT = HL_KTT + 128 * HS_T;
constexpr int HL_ST = HL_VT + 128 * HS_T;
constexpr int HL_P = HL_ST + 128 * HS_ND;
constexpr int HL_SEG = HL_P + 64 * HS_T;
constexpr int HL_FAC = HL_SEG + 4096;
constexpr int HL_NW = HL_FAC + 512;
constexpr int HL_END = HL_NW + 512;
constexpr int HL_OT = HL_QD, OT_S = 132 * 4;
static_assert(64 * OT_S <= 2 * 64 * HS_ND, "o tile overlay");
static_assert(HL_END <= 160 * 1024 - 1024, "HGRN2 LDS map");

constexpr size_t HG_SLOT_BYTES = 128 * 128 * 2;
__device__ __forceinline__ size_t hg_seq(int b, int dir, int head) { return (size_t)((b * 2 + dir) * 4 + head); }

__device__ __forceinline__ int sc_row(int b, int dir, int js, int lt) {
    if (js == 0) return MLAT + b * NCTX + (dir ? NCTX - 1 - lt : lt);
    const int q = 256 * (js - 1) + lt; return b * SEQ + (dir ? SEQ - 1 - q : q);
}

constexpr int P1_S = 544;
constexpr int P1_KTT = 0, P1_VT = P1_KTT + 128 * P1_S, P1_SEG = P1_VT + 128 * P1_S, P1_END = P1_SEG + 4096;
static_assert(P1_END <= 159 * 1024, "pass-1 LDS map");
__device__ __forceinline__ int p1_row(int b, int blk, int lt) { return blk < 0 ? MLAT + b * NCTX + lt : b * SEQ + 256 * blk + lt; }
template <int DIR>
__device__ __forceinline__ void hg_p1_dir(const Args& a, const Ctx& T, int b, int head, int blk, int slot, bool load_v) {
    const bf16* P = (const bf16*)(a.ws + WS_PROJ);
    LAS unsigned char* L = T.lds;
    const int w = T.wave, l = T.lane, g = l >> 4, c16 = l & 15;
    const int ch = head * 128 + 2 * l;
    const float* lbl = a.in[I_LBLOG];
    float lb[2];
#pragma unroll
    for (int x = 0; x < 2; ++x) lb[x] = sigmoidf_(lbl[DIR * 512 + ch + x] - lbl[(2 + DIR) * 512 + ch + x]);
    unsigned fw[32];
#pragma unroll
    for (int i = 0; i < 32; ++i) fw[i] = *(const unsigned*)(P + (size_t)p1_row(b, blk, 32 * w + i) * LDP + (DIR ? 2048 : 1536) + ch);
    if (load_v) {
        unsigned vw[32];
#pragma unroll
        for (int i = 0; i < 32; ++i) vw[i] = *(const unsigned*)(P + (size_t)p1_row(b, blk, 32 * w + i) * LDP + 512 + ch);
#pragma unroll
        for (int x = 0; x < 2; ++x)
#pragma unroll
            for (int q = 0; q < 4; ++q) { unsigned pv[4];
#pragma unroll
                for (int i = 0; i < 8; i += 2) { const unsigned v0 = x ? (vw[8 * q + i] >> 16) : (vw[8 * q + i] & 0xffffu), v1 = x ? (vw[8 * q + i + 1] >> 16) : (vw[8 * q + i + 1] & 0xffffu); pv[i >> 1] = v0 | (v1 << 16); }
                *(LAS v4u*)(L + P1_VT + (2 * l + x) * P1_S + 64 * w + 16 * q) = (v4u){pv[0], pv[1], pv[2], pv[3]}; }
    }
    float tot[2] = {0.f, 0.f};
#pragma unroll
    for (int i = 0; i < 32; ++i) {
        const float s0 = fast_sig(bflo(fw[i])), s1 = fast_sig(bfhi(fw[i]));
        tot[0] += lg2(lb[0] + (1.f - lb[0]) * s0); tot[1] += lg2(lb[1] + (1.f - lb[1]) * s1); }
    *(LAS f32x2*)(L + P1_SEG + (w * 128 + 2 * l) * 4) = (f32x2){tot[0], tot[1]};
    __syncthreads();
    float after[2] = {0.f, 0.f}, all[2] = {0.f, 0.f};
#pragma unroll
    for (int ww = 0; ww < 8; ++ww) { const f32x2 t2 = *(const LAS f32x2*)(L + P1_SEG + (ww * 128 + 2 * l) * 4); all[0] += t2.x; all[1] += t2.y;
        if (DIR ? (ww < w) : (ww > w)) { after[0] += t2.x; after[1] += t2.y; } }
#pragma unroll
    for (int x = 0; x < 2; ++x) {
        float run = after[x];
#pragma unroll
        for (int q = 0; q < 4; ++q) { float kv[8];
#pragma unroll
            for (int ii = 0; ii < 8; ++ii) { const int i = DIR ? 8 * q + ii : 31 - (8 * q + ii);
                const float fp = x ? bfhi(fw[i]) : bflo(fw[i]); const float sg = fast_sig(fp); const float f = lb[x] + (1.f - lb[x]) * sg;
                kv[ii] = (1.f - lb[x]) * (1.f - sg) * ex2(run); run += lg2(f); }
            if (DIR) *(LAS v4u*)(L + P1_KTT + (2 * l + x) * P1_S + 64 * w + 16 * q) = (v4u){cvtpk(kv[0], kv[1]), cvtpk(kv[2], kv[3]), cvtpk(kv[4], kv[5]), cvtpk(kv[6], kv[7])};
            else *(LAS v4u*)(L + P1_KTT + (2 * l + x) * P1_S + 64 * w + 16 * (3 - q)) = (v4u){cvtpk(kv[7], kv[6]), cvtpk(kv[5], kv[4]), cvtpk(kv[3], kv[2]), cvtpk(kv[1], kv[0])};
        }
    }
    __syncthreads();
    f32x4 accS[8];
#pragma unroll
    for (int m = 0; m < 8; ++m) accS[m] = (f32x4){0.f, 0.f, 0.f, 0.f};
#pragma unroll
    for (int kh = 0; kh < 4; ++kh) {
        const BF2 vf = ldfrag2(L + P1_VT + 16 * w * P1_S + 128 * kh, P1_S, l);
#pragma unroll
        for (int mh = 0; mh < 8; mh += 4) { BF2 kf[4];
#pragma unroll
            for (int m = 0; m < 4; ++m) kf[m] = ldfrag2(L + P1_KTT + 16 * (mh + m) * P1_S + 128 * kh, P1_S, l);
#pragma unroll
            for (int m = 0; m < 4; ++m) accS[mh + m] = MFMA16(kf[m].k0, vf.k0, accS[mh + m]);
#pragma unroll
            for (int m = 0; m < 4; ++m) accS[mh + m] = MFMA16(kf[m].k1, vf.k1, accS[mh + m]); } }
    const size_t sidx = hg_seq(b, DIR, head) * 16 + slot;
    bf16* ST = (bf16*)(a.ws + WS_HGST + sidx * HG_SLOT_BYTES);
#pragma unroll
    for (int m = 0; m < 8; ++m) { v2u o; o.x = cvtpk(accS[m][0], accS[m][1]); o.y = cvtpk(accS[m][2], accS[m][3]); *(v2u*)(ST + (size_t)(16 * w + c16) * 128 + 16 * m + 4 * g) = o; }
    if (w == 0) *(f32x2*)((float*)(a.ws + WS_HGG) + sidx * 128 + 2 * l) = (f32x2){ex2(all[0]), ex2(all[1])};
}
__device__ __forceinline__ void hg_pass1_items(const Args& a, const Ctx& T0, int first, int stride, int limit) {
#pragma unroll 1
    for (int item = first; item < limit; item += stride) {
        Ctx T = T0; asm volatile("" : "+v"(T.lane)); T.tid = T.wave * 64 + T.lane;
        const int k = item & 15, head = (item >> 4) & 3, b = item >> 6;
        const int blkF = k == 0 ? -1 : (k == 15 ? 0 : k), slotF = k == 0 ? 0 : (k == 15 ? 1 : k + 1);
        const int blkB = k == 0 ? -1 : (k == 15 ? 15 : k), slotB = k == 0 ? 0 : (k == 15 ? 1 : 16 - k);
        __syncthreads();
        hg_p1_dir<0>(a, T, b, head, blkF, slotF, true);
        __syncthreads();
        hg_p1_dir<1>(a, T, b, head, blkB, slotB, blkB != blkF);
    }
}

__device__ __forceinline__ void hg_pass2(const Args& a, const Ctx& T) {
    const int ntask = 32 * 2048;
    for (int task = T.vcu * NTHREADS + T.tid; task < ntask; task += T.G * NTHREADS) {
        const int seq = task >> 11, el = (task & 2047) * 8, d0 = el & 127;
        float r[8];
#pragma unroll
        for (int i = 0; i < 8; ++i) r[i] = 0.f;
        for (int j = 0; j < 16; ++j) {
            v4u* p = (v4u*)(a.ws + WS_HGST + ((size_t)seq * 16 + j) * HG_SLOT_BYTES + (size_t)el * 2);
            const float* G = (const float*)(a.ws + WS_HGG) + ((size_t)seq * 16 + j) * 128 + d0;
            const v4u dv = *p; const f32x4 g0 = *(const f32x4*)G, g1 = *(const f32x4*)(G + 4);
            r[0] = g0.x * r[0] + bflo(dv.x); r[1] = g0.y * r[1] + bfhi(dv.x); r[2] = g0.z * r[2] + bflo(dv.y); r[3] = g0.w * r[3] + bfhi(dv.y);
            r[4] = g1.x * r[4] + bflo(dv.z); r[5] = g1.y * r[5] + bfhi(dv.z); r[6] = g1.z * r[6] + bflo(dv.w); r[7] = g1.w * r[7] + bfhi(dv.w);
            *p = (v4u){pk2(r[0], r[1]), pk2(r[2], r[3]), pk2(r[4], r[5]), pk2(r[6], r[7])};
        }
    }
}

struct HgP3Pre { unsigned fw[8], qw[8], vw[8]; };
__device__ __forceinline__ void hg_p3_load(HgP3Pre& R, const bf16* P, int b, int head, int jt, int step, int w, int l) {
    const int dir = step >> 2, c = step & 3; const int ch = head * 128 + 2 * l;
#pragma unroll
    for (int i = 0; i < 8; ++i) { const int lt = 64 * c + 8 * w + i; const size_t row = (size_t)(b * SEQ + 256 * jt + (dir ? 255 - lt : lt));
        R.fw[i] = *(const unsigned*)(P + row * LDP + (dir ? 2048 : 1536) + ch); R.qw[i] = *(const unsigned*)(P + row * LDP + ch); R.vw[i] = *(const unsigned*)(P + row * LDP + 512 + ch); }
}
__device__ __forceinline__ void hg_pass3_item(const Args& a, const Ctx& T0, int item, bf16* OUT) {
    const int jt = item & 15, head = (item >> 4) & 3, b = item >> 6;
    const bf16* P = (const bf16*)(a.ws + WS_PROJ);
    Ctx T = T0; asm volatile("" : "+v"(T.lane));
    T.tid = T.wave * 64 + T.lane;
    LAS unsigned char* L = T.lds;
    const int w = T.wave, l = T.lane, g = l >> 4, c16 = l & 15;
    const int ch = head * 128 + 2 * l;
    const float* lbl = a.in[I_LBLOG];
    __syncthreads();
    for (int i = T.tid; i < 64 * HS_T / 16; i += NTHREADS) *(LAS v4u*)(L + HL_P + i * 16) = (v4u){0u, 0u, 0u, 0u};
    if (T.tid < 128) *(LAS float*)(L + HL_NW + T.tid * 4) = a.in[I_HGNW][head * 128 + T.tid];
    HgP3Pre R;
    hg_p3_load(R, P, b, head, jt, 0, w, l);
    v4u stq[4];
#define HG_STATE_LOAD(dir_) do { const bf16* STg_ = (const bf16*)(a.ws + WS_HGST + (hg_seq(b, (dir_), head) * 16 + ((dir_) ? 15 - jt : jt)) * HG_SLOT_BYTES); \
        _Pragma("unroll") for (int q_ = 0; q_ < 4; ++q_) { const int idx_ = l + 64 * q_; stq[q_] = *(const v4u*)(STg_ + (size_t)(16 * w + (idx_ >> 4)) * 128 + (idx_ & 15) * 8); } } while (0)
    HG_STATE_LOAD(0);
    f32x4 accS[8];
    float lb[2] = {0.f, 0.f};
    const int ot = T.tid >> 3, opart = T.tid & 7;
#pragma unroll 1
    for (int step = 0; step < 8; ++step) {
        const int dir = step >> 2, c = step & 3;
        PS_BEGIN();
        if (c == 0) {
#pragma unroll
            for (int x = 0; x < 2; ++x) lb[x] = sigmoidf_(lbl[dir * 512 + ch + x] - lbl[(2 + dir) * 512 + ch + x]);
            if (dir == 1) { HG_STATE_LOAD(1); VM_WAIT(); __syncthreads(); if (w == 0) { __builtin_amdgcn_fence(__ATOMIC_ACQUIRE, "agent"); VM_WAIT(); } __syncthreads(); }
#pragma unroll
            for (int q = 0; q < 4; ++q) { const int idx = l + 64 * q; *(LAS v4u*)(L + HL_ST + (16 * w + (idx >> 4)) * HS_ND + (idx & 15) * 16) = stq[q]; }
            LDS_WAIT();
#pragma unroll
            for (int m = 0; m < 8; ++m) { const v2u sv = *(const LAS v2u*)(L + HL_ST + (16 * w + c16) * HS_ND + (16 * m + 4 * g) * 2); accS[m] = (f32x4){bflo(sv.x), bfhi(sv.x), bflo(sv.y), bfhi(sv.y)}; }
        }
        PS_END(11);
        float kk[2][8], cl[2][8]; unsigned qw[8], vw[8];
#pragma unroll
        for (int i = 0; i < 8; ++i) { qw[i] = R.qw[i]; vw[i] = R.vw[i]; }
#pragma unroll
        for (int x = 0; x < 2; ++x) { float run = 0.f;
#pragma unroll
            for (int i = 0; i < 8; ++i) { const float fp = x ? bfhi(R.fw[i]) : bflo(R.fw[i]); const float sg = fast_sig(fp); const float f = lb[x] + (1.f - lb[x]) * sg;
                kk[x][i] = (1.f - lb[x]) * (1.f - sg); run += lg2(f); cl[x][i] = run; } }
        if (step < 7) hg_p3_load(R, P, b, head, jt, step + 1, w, l);
        *(LAS f32x2*)(L + HL_SEG + (w * 128 + 2 * l) * 4) = (f32x2){cl[0][7], cl[1][7]};
        PS_END(0); __syncthreads(); PS_END(1);
        const int half = w >> 2;
        float pre[2], mid[2], fx[2], fqe[2], fkt[2];
#pragma unroll
        for (int x = 0; x < 2; ++x) {
            float tt[8];
#pragma unroll
            for (int ww = 0; ww < 8; ++ww) tt[ww] = *(const LAS float*)(L + HL_SEG + (ww * 128 + 2 * l + x) * 4);
            const float r15 = tt[0] + tt[1], r31 = r15 + tt[2] + tt[3], r47 = r31 + tt[4] + tt[5], r63 = r47 + tt[6] + tt[7];
            float p = 0.f;
#pragma unroll
            for (int ww = 0; ww < 8; ++ww) if (ww < w) p += tt[ww];
            pre[x] = p; mid[x] = half ? r47 : r15;
            fx[x] = half ? ex2(r47 - r31) : ex2(r31 - r15); fqe[x] = ex2(mid[x]); fkt[x] = ex2(r63 - mid[x]);
            if (w == 0) *(LAS float*)(L + HL_FAC + (2 * l + x) * 4) = ex2(r63);
        }
        float ktv[2][8];
#pragma unroll
        for (int i = 0; i < 8; ++i) {
            float qd[2], kd[2], xv[2], qe[2];
#pragma unroll
            for (int x = 0; x < 2; ++x) { const float cc = pre[x] + cl[x][i] - mid[x]; const float eq = ex2(cc), ek = ex2(-cc); const float q = x ? bfhi(qw[i]) : bflo(qw[i]);
                qd[x] = q * eq; kd[x] = kk[x][i] * ek; xv[x] = (half ? qd[x] : kd[x]) * fx[x]; qe[x] = qd[x] * fqe[x]; ktv[x][i] = kd[x] * fkt[x]; }
            const int off = (8 * w + i) * HS_ND + 4 * l;
            *(LAS unsigned*)(L + HL_QD + off) = cvtpk(qd[0], qd[1]); *(LAS unsigned*)(L + HL_KD + off) = cvtpk(kd[0], kd[1]);
            *(LAS unsigned*)(L + HL_X + off) = cvtpk(xv[0], xv[1]); *(LAS unsigned*)(L + HL_QE + off) = cvtpk(qe[0], qe[1]);
        }
#pragma unroll
        for (int x = 0; x < 2; ++x) {
            unsigned pv[4];
#pragma unroll
            for (int i = 0; i < 8; i += 2) { const unsigned v0 = x ? (vw[i] >> 16) : (vw[i] & 0xffffu), v1 = x ? (vw[i + 1] >> 16) : (vw[i + 1] & 0xffffu); pv[i >> 1] = v0 | (v1 << 16); }
            *(LAS v4u*)(L + HL_KTT + (2 * l + x) * HS_T + 16 * w) = (v4u){cvtpk(ktv[x][0], ktv[x][1]), cvtpk(ktv[x][2], ktv[x][3]), cvtpk(ktv[x][4], ktv[x][5]), cvtpk(ktv[x][6], ktv[x][7])};
            *(LAS v4u*)(L + HL_VT + (2 * l + x) * HS_T + 16 * w) = (v4u){pv[0], pv[1], pv[2], pv[3]};
        }
        PS_END(0); __syncthreads(); PS_END(1);
        const size_t orow = (size_t)(b * SEQ + 256 * jt + (dir ? 255 - (64 * c + ot) : 64 * c + ot));
        bf16* optr = OUT + orow * DM + head * 128 + 16 * opart;
        v4u pf0 = (v4u){0u, 0u, 0u, 0u}, pf1 = pf0, pg0 = pf0, pg1 = pf0;
        if (dir) { pf0 = *(const v4u*)optr; pf1 = *(const v4u*)(optr + 8); const bf16* gp = P + orow * LDP + 1024 + head * 128 + 16 * opart; pg0 = *(const v4u*)gp; pg1 = *(const v4u*)(gp + 8); }
        v2u ptile[2]; int paddr[2] = {-1, -1};
#pragma unroll
        for (int rep = 0; rep < 2; ++rep) { const int tix = w + 8 * rep;
            if (tix < 10) {
                const int I = tix < 1 ? 0 : (tix < 3 ? 1 : (tix < 6 ? 2 : 3)); const int J = tix - (I * (I + 1)) / 2;
                const bool same = (I >> 1) == (J >> 1);
                const int abase = same ? HL_KD : HL_X, bbase = same ? HL_QD : HL_X;
                const BF4 af = ldfrag4(L + abase + 16 * J * HS_ND, HS_ND, l), bf = ldfrag4(L + bbase + 16 * I * HS_ND, HS_ND, l);
                f32x4 at = (f32x4){0.f, 0.f, 0.f, 0.f};
                at = MFMA16(af.k0, bf.k0, at); at = MFMA16(af.k1, bf.k1, at); at = MFMA16(af.k2, bf.k2, at); at = MFMA16(af.k3, bf.k3, at);
                const int tloc = 16 * I + c16, s0 = 16 * J + 4 * g;
                float pr[4];
#pragma unroll
                for (int r = 0; r < 4; ++r) pr[r] = (s0 + r <= tloc) ? at[r] : 0.f;
                ptile[rep].x = cvtpk(pr[0], pr[1]); ptile[rep].y = cvtpk(pr[2], pr[3]); paddr[rep] = HL_P + tloc * HS_T + s0 * 2;
            } }
        f32x4 accO[4];
        { const BF4 sf = ldfrag4(L + HL_ST + 16 * w * HS_ND, HS_ND, l);
#pragma unroll
            for (int I = 0; I < 4; ++I) accO[I] = (f32x4){0.f, 0.f, 0.f, 0.f};
#pragma unroll
            for (int ih = 0; ih < 4; ih += 2) {
                const BF4 q0 = ldfrag4(L + HL_QE + ih * 16 * HS_ND, HS_ND, l), q1 = ldfrag4(L + HL_QE + (ih + 1) * 16 * HS_ND, HS_ND, l);
                accO[ih] = MFMA16(q0.k0, sf.k0, accO[ih]); accO[ih + 1] = MFMA16(q1.k0, sf.k0, accO[ih + 1]);
                accO[ih] = MFMA16(q0.k1, sf.k1, accO[ih]); accO[ih + 1] = MFMA16(q1.k1, sf.k1, accO[ih + 1]);
                accO[ih] = MFMA16(q0.k2, sf.k2, accO[ih]); accO[ih + 1] = MFMA16(q1.k2, sf.k2, accO[ih + 1]);
                accO[ih] = MFMA16(q0.k3, sf.k3, accO[ih]); accO[ih + 1] = MFMA16(q1.k3, sf.k3, accO[ih + 1]); } }
        const BF2 vf = ldfrag2(L + HL_VT + 16 * w * HS_T, HS_T, l);
#pragma unroll
        for (int mh = 0; mh < 8; mh += 4) {
            BF2 kf[4]; f32x4 gv[4];
#pragma unroll
            for (int m = 0; m < 4; ++m) { kf[m] = ldfrag2(L + HL_KTT + 16 * (mh + m) * HS_T, HS_T, l); gv[m] = *(const LAS f32x4*)(L + HL_FAC + (16 * (mh + m) + 4 * g) * 4); }
#pragma unroll
            for (int m = 0; m < 4; ++m) accS[mh + m] = accS[mh + m] * gv[m];
#pragma unroll
            for (int m = 0; m < 4; ++m) accS[mh + m] = MFMA16(kf[m].k0, vf.k0, accS[mh + m]);
#pragma unroll
            for (int m = 0; m < 4; ++m) accS[mh + m] = MFMA16(kf[m].k1, vf.k1, accS[mh + m]);
        }
#pragma unroll
        for (int rep = 0; rep < 2; ++rep) if (paddr[rep] >= 0) *(LAS v2u*)(L + paddr[rep]) = ptile[rep];
        PS_END(2); __syncthreads(); PS_END(1);
        { const BF2 p0 = ldfrag2(L + HL_P + 0 * 16 * HS_T, HS_T, l), p1 = ldfrag2(L + HL_P + 1 * 16 * HS_T, HS_T, l), p2 = ldfrag2(L + HL_P + 2 * 16 * HS_T, HS_T, l), p3 = ldfrag2(L + HL_P + 3 * 16 * HS_T, HS_T, l);
            accO[0] = MFMA16(p0.k0, vf.k0, accO[0]); accO[1] = MFMA16(p1.k0, vf.k0, accO[1]); accO[2] = MFMA16(p2.k0, vf.k0, accO[2]); accO[3] = MFMA16(p3.k0, vf.k0, accO[3]);
            accO[0] = MFMA16(p0.k1, vf.k1, accO[0]); accO[1] = MFMA16(p1.k1, vf.k1, accO[1]); accO[2] = MFMA16(p2.k1, vf.k1, accO[2]); accO[3] = MFMA16(p3.k1, vf.k1, accO[3]); }
#pragma unroll
        for (int m = 0; m < 8; ++m) { v2u o; o.x = cvtpk(accS[m][0], accS[m][1]); o.y = cvtpk(accS[m][2], accS[m][3]); *(LAS v2u*)(L + HL_ST + (16 * w + c16) * HS_ND + (16 * m + 4 * g) * 2) = o; }
#pragma unroll
        for (int I = 0; I < 4; ++I)
#pragma unroll
            for (int r = 0; r < 4; ++r) *(LAS float*)(L + HL_OT + (16 * I + 4 * g + r) * OT_S + (16 * w + c16) * 4) = accO[I][r];
        PS_END(3); __syncthreads(); PS_END(1);
        { float ov[16];
#pragma unroll
            for (int q = 0; q < 4; ++q) { const f32x4 t4 = *(const LAS f32x4*)(L + HL_OT + ot * OT_S + (16 * opart + 4 * q) * 4); ov[4 * q] = t4.x; ov[4 * q + 1] = t4.y; ov[4 * q + 2] = t4.z; ov[4 * q + 3] = t4.w; }
            if (dir) {
                float fo[16], gt[16];
#pragma unroll
                for (int q = 0; q < 4; ++q) { fo[2 * q] = bflo(pf0[q]); fo[2 * q + 1] = bfhi(pf0[q]); fo[8 + 2 * q] = bflo(pf1[q]); fo[8 + 2 * q + 1] = bfhi(pf1[q]);
                    gt[2 * q] = bflo(pg0[q]); gt[2 * q + 1] = bfhi(pg0[q]); gt[8 + 2 * q] = bflo(pg1[q]); gt[8 + 2 * q + 1] = bfhi(pg1[q]); }
                float ss = 0.f;
#pragma unroll
                for (int i = 0; i < 16; ++i) { ov[i] += fo[i]; ss += ov[i] * ov[i]; }
                ss += __shfl_xor(ss, 1); ss += __shfl_xor(ss, 2); ss += __shfl_xor(ss, 4);
                const float rstd = __builtin_amdgcn_rsqf(ss * (1.f / 128.f) + EPSN);
#pragma unroll
                for (int q = 0; q < 4; ++q) { const f32x4 nw4 = *(const LAS f32x4*)(L + HL_NW + (16 * opart + 4 * q) * 4);
                    ov[4 * q] *= rstd * nw4.x * gt[4 * q]; ov[4 * q + 1] *= rstd * nw4.y * gt[4 * q + 1]; ov[4 * q + 2] *= rstd * nw4.z * gt[4 * q + 2]; ov[4 * q + 3] *= rstd * nw4.w * gt[4 * q + 3]; }
            }
            *(v4u*)optr = (v4u){cvtpk(ov[0], ov[1]), cvtpk(ov[2], ov[3]), cvtpk(ov[4], ov[5]), cvtpk(ov[6], ov[7])};
            *(v4u*)(optr + 8) = (v4u){cvtpk(ov[8], ov[9]), cvtpk(ov[10], ov[11]), cvtpk(ov[12], ov[13]), cvtpk(ov[14], ov[15])}; }
        PS_END(4);
    }
}

constexpr int MS = 160;
constexpr int ML_Q = 0, ML_K = ML_Q + 64 * MS, ML_KTT = ML_K + 64 * MS, ML_VT = ML_KTT + 64 * MS, ML_CT = ML_VT + 144 * MS, ML_P = ML_CT + 144 * MS;
constexpr int ML_TA = ML_P + 64 * MS;
constexpr int ML_TMU = ML_TA + 1024, ML_TIW = ML_TMU + 1024, ML_TSW = ML_TIW + 1024, ML_TEM = ML_TSW + 1024;
constexpr int ML_TRI = ML_TEM + 1024;
constexpr int ML_SC = ML_TRI + 256;
constexpr int ML_NW = ML_SC + 64;
constexpr int ML_OT = ML_NW + 512;
constexpr int ML_END = ML_OT + 64 * OT_S;
static_assert(ML_END <= 159 * 1024, "mLSTM LDS map");
constexpr size_t ML_SLOT_BYTES = 144 * 64 * 2;
constexpr float LOG2E = 1.4426950408889634f;

__device__ __forceinline__ float wave_incl_sum(float v, int lane) {
#pragma unroll
    for (int o = 1; o < 64; o <<= 1) { const float t = __shfl_up(v, o); if (lane >= o) v += t; }
    return v;
}
__device__ __forceinline__ float wave_incl_max(float v, int lane) {
#pragma unroll
    for (int o = 1; o < 64; o <<= 1) { const float t = __shfl_up(v, o); if (lane >= o) v = fmaxf(v, t); }
    return v;
}
template <bool WHOLE>
__device__ __forceinline__ float ml_scalars256(LAS unsigned char* L, const float (&ig)[4], const float (&fg)[4], float m_prev, float& bsum, int lane, int tb = 0) {
    f32x4 B, av, mu;
    { float run = 0.f;
#pragma unroll
        for (int i = 0; i < 4; ++i) { run += (fminf(fg[i], 0.f) - log1pf(__expf(-fabsf(fg[i])))) * LOG2E; B[i] = run; } }
    { const float incl = wave_incl_sum(B[3], lane); B = B + (incl - B[3]); }
#pragma unroll
    for (int i = 0; i < 4; ++i) av[i] = ig[i] * LOG2E - B[i];
    *(LAS f32x4*)(L + tb + ML_TA + lane * 16) = av;
    { float pm = av[0]; mu[0] = pm; pm = fmaxf(pm, av[1]); mu[1] = pm; pm = fmaxf(pm, av[2]); mu[2] = pm; pm = fmaxf(pm, av[3]); mu[3] = pm;
        const float inclm = wave_incl_max(pm, lane); float exm = __shfl_up(inclm, 1); if (lane == 0) exm = m_prev; exm = fmaxf(exm, m_prev);
#pragma unroll
        for (int i = 0; i < 4; ++i) mu[i] = fmaxf(mu[i], exm); }
    *(LAS f32x4*)(L + tb + ML_TMU + lane * 16) = mu;
    { f32x4 te;
#pragma unroll
        for (int i = 0; i < 4; ++i) te[i] = ex2(-(B[i] + mu[i]));
        *(LAS f32x4*)(L + tb + ML_TEM + lane * 16) = te; }
    const float b255 = __shfl(B[3], 63), mu255 = __shfl(mu[3], 63);
    const int c = lane >> 4;
    const float mu_end = WHOLE ? mu255 : __shfl(mu[3], 16 * c + 15); float mu_start = __shfl(mu[3], (16 * c + 63) & 63); if (c == 0) mu_start = m_prev;
    { f32x4 ti;
#pragma unroll
        for (int i = 0; i < 4; ++i) ti[i] = ex2(mu_start - mu[i]);
        *(LAS f32x4*)(L + tb + ML_TIW + lane * 16) = ti; }
    { f32x4 ts;
#pragma unroll
        for (int i = 0; i < 4; ++i) ts[i] = ex2(av[i] - mu_end);
        *(LAS f32x4*)(L + tb + ML_TSW + lane * 16) = ts; }
    if ((lane & 15) == 0) *(LAS float*)(L + tb + ML_SC + c * 4) = ex2(mu_start - mu_end);
    bsum = b255;
    return b255 + mu255;
}
__device__ __forceinline__ void ml_aug_rows(LAS unsigned char* L, int tid) {
    for (int i = tid; i < 16 * 8; i += NTHREADS) { const int r = i >> 3, q = i & 7; const unsigned v = r == 0 ? 0x3F803F80u : 0u; *(LAS v4u*)(L + ML_VT + (128 + r) * MS + q * 16) = (v4u){v, v, v, v}; }
}
struct MlPre { unsigned kw[8], vw[8]; v4u qn, kn; };
#define ML_LOAD_KV(R, ROWF) do { \
    if (T.tid < 256) { const int dp_ = T.tid & 31, tg_ = T.tid >> 5; _Pragma("unroll") for (int i = 0; i < 8; ++i) { const size_t row_ = (size_t)(ROWF(8 * tg_ + i)); (R).kw[i] = *(const unsigned*)(QK + row_ * 512 + 256 + head * 64 + 2 * dp_); } } \
    { const int ep_ = T.tid & 63, tg_ = T.tid >> 6; _Pragma("unroll") for (int i = 0; i < 8; ++i) { const size_t row_ = (size_t)(ROWF(8 * tg_ + i)); (R).vw[i] = *(const unsigned*)(P + row_ * LDP + 3072 + head * 128 + 2 * ep_); } } \
} while (0)
#define ML_STORE_KV(R, cch) do { \
    if (T.tid < 256) { const int dp_ = T.tid & 31, tg_ = T.tid >> 5; \
        const f32x4 s0_ = *(const LAS f32x4*)(L + ML_TSW + ((cch) * 64 + 8 * tg_) * 4), s1_ = *(const LAS f32x4*)(L + ML_TSW + ((cch) * 64 + 8 * tg_ + 4) * 4); \
        const float sw_[8] = {s0_.x, s0_.y, s0_.z, s0_.w, s1_.x, s1_.y, s1_.z, s1_.w}; \
        _Pragma("unroll") for (int x = 0; x < 2; ++x) { float kv_[8]; _Pragma("unroll") for (int i = 0; i < 8; ++i) kv_[i] = (x ? bfhi((R).kw[i]) : bflo((R).kw[i])) * sw_[i]; \
            *(LAS v4u*)(L + ML_KTT + (2 * dp_ + x) * MS + 16 * tg_) = (v4u){cvtpk(kv_[0], kv_[1]), cvtpk(kv_[2], kv_[3]), cvtpk(kv_[4], kv_[5]), cvtpk(kv_[6], kv_[7])}; } } \
    { const int ep_ = T.tid & 63, tg_ = T.tid >> 6; \
        _Pragma("unroll") for (int x = 0; x < 2; ++x) { unsigned pv_[4]; \
            _Pragma("unroll") for (int i = 0; i < 8; i += 2) { const unsigned v0_ = x ? ((R).vw[i] >> 16) : ((R).vw[i] & 0xffffu), v1_ = x ? ((R).vw[i + 1] >> 16) : ((R).vw[i + 1] & 0xffffu); pv_[i >> 1] = v0_ | (v1_ << 16); } \
            *(LAS v4u*)(L + ML_VT + (2 * ep_ + x) * MS + 16 * tg_) = (v4u){pv_[0], pv_[1], pv_[2], pv_[3]}; } } \
} while (0)

constexpr int Q1_KTT = 0, Q1_VT = Q1_KTT + 64 * P1_S, Q1_TAB = Q1_VT + 144 * P1_S;
constexpr int Q1_TB = Q1_TAB - ML_TA;
static_assert(ML_SC + Q1_TB + 64 <= 159 * 1024, "mLSTM pass-1 LDS map");
template <int DIR>
__device__ __forceinline__ void ml_p1_dir(const Args& a, const Ctx& T, int b, int head, int blk, int slot, const unsigned (&kw)[16], const float (&ig)[4], const float (&fg)[4]) {
    LAS unsigned char* L = T.lds;
    const int w = T.wave, l = T.lane, g = l >> 4, c16 = l & 15;
    float mloc = 0.f, bsum = 0.f;
    if (w == 0) mloc = ml_scalars256<true>(L, ig, fg, -1e30f, bsum, l, Q1_TB);
    __syncthreads();
    { const int dp = T.tid & 31, tg = T.tid >> 5;
        float sw[16];
#pragma unroll
        for (int q = 0; q < 4; ++q) { const int s0 = 16 * tg + 4 * q;
            const f32x4 t4 = *(const LAS f32x4*)(L + Q1_TB + ML_TSW + (DIR ? 252 - s0 : s0) * 4);
            sw[4 * q] = DIR ? t4.w : t4.x; sw[4 * q + 1] = DIR ? t4.z : t4.y; sw[4 * q + 2] = DIR ? t4.y : t4.z; sw[4 * q + 3] = DIR ? t4.x : t4.w; }
#pragma unroll
        for (int x = 0; x < 2; ++x)
#pragma unroll
            for (int q = 0; q < 2; ++q) { float kv[8];
#pragma unroll
                for (int i = 0; i < 8; ++i) kv[i] = (x ? bfhi(kw[8 * q + i]) : bflo(kw[8 * q + i])) * sw[8 * q + i];
                *(LAS v4u*)(L + Q1_KTT + (2 * dp + x) * P1_S + 32 * tg + 16 * q) = (v4u){cvtpk(kv[0], kv[1]), cvtpk(kv[2], kv[3]), cvtpk(kv[4], kv[5]), cvtpk(kv[6], kv[7])}; } }
    __syncthreads();
    f32x4 accC[4], accCA = (f32x4){0.f, 0.f, 0.f, 0.f};
#pragma unroll
    for (int m = 0; m < 4; ++m) accC[m] = (f32x4){0.f, 0.f, 0.f, 0.f};
#pragma unroll
    for (int kh = 0; kh < 4; ++kh) {
        const BF2 vf = ldfrag2(L + Q1_VT + 16 * w * P1_S + 128 * kh, P1_S, l);
        BF2 kf[4];
#pragma unroll
        for (int m = 0; m < 4; ++m) kf[m] = ldfrag2(L + Q1_KTT + 16 * m * P1_S + 128 * kh, P1_S, l);
#pragma unroll
        for (int m = 0; m < 4; ++m) accC[m] = MFMA16(kf[m].k0, vf.k0, accC[m]);
#pragma unroll
        for (int m = 0; m < 4; ++m) accC[m] = MFMA16(kf[m].k1, vf.k1, accC[m]);
        if (w < 4) { const BF2 af = ldfrag2(L + Q1_VT + 128 * P1_S + 128 * kh, P1_S, l); const BF2 kfw = ldfrag2(L + Q1_KTT + 16 * w * P1_S + 128 * kh, P1_S, l);
            accCA = MFMA16(kfw.k0, af.k0, accCA); accCA = MFMA16(kfw.k1, af.k1, accCA); } }
    const size_t sidx = hg_seq(b, DIR, head) * 16 + slot;
    bf16* CT = (bf16*)(a.ws + WS_MLST + sidx * ML_SLOT_BYTES);
#pragma unroll
    for (int m = 0; m < 4; ++m) { v2u o; o.x = cvtpk(accC[m][0], accC[m][1]); o.y = cvtpk(accC[m][2], accC[m][3]); *(v2u*)(CT + (size_t)(16 * w + c16) * 64 + 16 * m + 4 * g) = o; }
    if (w < 4) { v2u o; o.x = cvtpk(accCA[0], accCA[1]); o.y = cvtpk(accCA[2], accCA[3]); *(v2u*)(CT + (size_t)(128 + c16) * 64 + 16 * w + 4 * g) = o; }
    if (T.tid == 0) { float* sc = (float*)(a.ws + WS_MLSC) + sidx * 4; sc[0] = mloc; sc[1] = bsum; }
}
__device__ __forceinline__ void ml_pass1_items(const Args& a, const Ctx& T0, int first, int stride, int limit) {
    const bf16* P = (const bf16*)(a.ws + WS_PROJ); const bf16* QK = (const bf16*)(a.ws + WS_QK); const float* GT = (const float*)(a.ws + WS_GATES);
    __syncthreads();
    for (int i = T0.tid; i < 16 * 32; i += NTHREADS) { const int r = i >> 5, q = i & 31; const unsigned v = r == 0 ? 0x3F803F80u : 0u; *(LAS v4u*)(T0.lds + Q1_VT + (128 + r) * P1_S + q * 16) = (v4u){v, v, v, v}; }
#pragma unroll 1
    for (int item = first; item < limit; item += stride) {
        Ctx T = T0; asm volatile("" : "+v"(T.lane)); T.tid = T.wave * 64 + T.lane;
        LAS unsigned char* L = T.lds;
        const int w = T.wave, l = T.lane;
        const int k = item & 15, head = (item >> 4) & 3, b = item >> 6;
        const int blkF = k == 0 ? -1 : (k == 15 ? 0 : k), slotF = k == 0 ? 0 : (k == 15 ? 1 : k + 1);
        const int blkB = k == 0 ? -1 : (k == 15 ? 15 : k), slotB = k == 0 ? 0 : (k == 15 ? 1 : 16 - k);
#pragma unroll 1
        for (int dir = 0; dir < 2; ++dir) {
            const int blk = dir ? blkB : blkF;
            float ig[4] = {0.f, 0.f, 0.f, 0.f}, fg[4] = {0.f, 0.f, 0.f, 0.f};
            if (w == 0) {
#pragma unroll
                for (int c = 0; c < 4; ++c) { const int u = 4 * l + c; const size_t row = (size_t)p1_row(b, blk, dir ? 255 - u : u); ig[c] = GT[row * 16 + (dir ? 8 : 0) + head]; fg[c] = GT[row * 16 + (dir ? 12 : 4) + head]; } }
            unsigned kw[16];
            { const int dp = T.tid & 31, tg = T.tid >> 5;
#pragma unroll
                for (int i = 0; i < 16; ++i) kw[i] = *(const unsigned*)(QK + (size_t)p1_row(b, blk, 16 * tg + i) * 512 + 256 + head * 64 + 2 * dp); }
            __syncthreads();
            if (dir == 0 || blkB != blkF) {
                const int ep = T.tid & 63, tg = T.tid >> 6; unsigned vw[32];
#pragma unroll
                for (int i = 0; i < 32; ++i) vw[i] = *(const unsigned*)(P + (size_t)p1_row(b, blk, 32 * tg + i) * LDP + 3072 + head * 128 + 2 * ep);
#pragma unroll
                for (int x = 0; x < 2; ++x)
#pragma unroll
                    for (int q = 0; q < 4; ++q) { unsigned pv[4];
#pragma unroll
                        for (int i = 0; i < 8; i += 2) { const unsigned v0 = x ? (vw[8 * q + i] >> 16) : (vw[8 * q + i] & 0xffffu), v1 = x ? (vw[8 * q + i + 1] >> 16) : (vw[8 * q + i + 1] & 0xffffu); pv[i >> 1] = v0 | (v1 << 16); }
                        *(LAS v4u*)(L + Q1_VT + (2 * ep + x) * P1_S + 64 * tg + 16 * q) = (v4u){pv[0], pv[1], pv[2], pv[3]}; }
            }
            if (dir == 0) ml_p1_dir<0>(a, T, b, head, blk, slotF, kw, ig, fg); else ml_p1_dir<1>(a, T, b, head, blk, slotB, kw, ig, fg);
        }
    }
}

__device__ __forceinline__ void pass2_all(const Args& a, const Ctx& T) {
    const int gid = T.vcu * NTHREADS + T.tid;
    if (gid < 32 * 2048) {
        const int seq = gid >> 11, el = (gid & 2047) * 8, d0 = el & 127;
        float r[8];
#pragma unroll
        for (int i = 0; i < 8; ++i) r[i] = 0.f;
#pragma unroll 1
        for (int j0 = 0; j0 < 16; j0 += 4) {
            v4u dv[4]; f32x4 g0[4], g1[4];
#pragma unroll
            for (int jj = 0; jj < 4; ++jj) { const size_t sidx = (size_t)seq * 16 + j0 + jj; dv[jj] = *(const v4u*)(a.ws + WS_HGST + sidx * HG_SLOT_BYTES + (size_t)el * 2);
                const float* G = (const float*)(a.ws + WS_HGG) + sidx * 128 + d0; g0[jj] = *(const f32x4*)G; g1[jj] = *(const f32x4*)(G + 4); }
#pragma unroll
            for (int jj = 0; jj < 4; ++jj) { const size_t sidx = (size_t)seq * 16 + j0 + jj;
                r[0] = g0[jj].x * r[0] + bflo(dv[jj].x); r[1] = g0[jj].y * r[1] + bfhi(dv[jj].x); r[2] = g0[jj].z * r[2] + bflo(dv[jj].y); r[3] = g0[jj].w * r[3] + bfhi(dv[jj].y);
                r[4] = g1[jj].x * r[4] + bflo(dv[jj].z); r[5] = g1[jj].y * r[5] + bfhi(dv[jj].z); r[6] = g1[jj].z * r[6] + bflo(dv[jj].w); r[7] = g1[jj].w * r[7] + bfhi(dv[jj].w);
                *(v4u*)(a.ws + WS_HGST + sidx * HG_SLOT_BYTES + (size_t)el * 2) = (v4u){cvtpk(r[0], r[1]), cvtpk(r[2], r[3]), cvtpk(r[4], r[5]), cvtpk(r[6], r[7])}; }
        }
    } else if (gid < 32 * 2048 + 32 * 1152) {
        const int t2 = gid - 32 * 2048; const int seq = t2 / 1152, el = (t2 % 1152) * 8;
        float r[8], m = 0.f;
#pragma unroll
        for (int i = 0; i < 8; ++i) r[i] = 0.f;
#pragma unroll 1
        for (int j0 = 0; j0 < 16; j0 += 4) {
            v4u dv[4]; float ml[4], bt[4];
#pragma unroll
            for (int jj = 0; jj < 4; ++jj) { const size_t sidx = (size_t)seq * 16 + j0 + jj; dv[jj] = *(const v4u*)(a.ws + WS_MLST + sidx * ML_SLOT_BYTES + (size_t)el * 2);
                const float* sc = (const float*)(a.ws + WS_MLSC) + sidx * 4; ml[jj] = sc[0]; bt[jj] = sc[1]; }
#pragma unroll
            for (int jj = 0; jj < 4; ++jj) { const size_t sidx = (size_t)seq * 16 + j0 + jj;
                const float mn = fmaxf(bt[jj] + m, ml[jj]); const float cA = ex2(bt[jj] + m - mn), cB = ex2(ml[jj] - mn); m = mn;
                r[0] = cA * r[0] + cB * bflo(dv[jj].x); r[1] = cA * r[1] + cB * bfhi(dv[jj].x); r[2] = cA * r[2] + cB * bflo(dv[jj].y); r[3] = cA * r[3] + cB * bfhi(dv[jj].y);
                r[4] = cA * r[4] + cB * bflo(dv[jj].z); r[5] = cA * r[5] + cB * bfhi(dv[jj].z); r[6] = cA * r[6] + cB * bflo(dv[jj].w); r[7] = cA * r[7] + cB * bfhi(dv[jj].w);
                *(v4u*)(a.ws + WS_MLST + sidx * ML_SLOT_BYTES + (size_t)el * 2) = (v4u){cvtpk(r[0], r[1]), cvtpk(r[2], r[3]), cvtpk(r[4], r[5]), cvtpk(r[6], r[7])};
                if (el == 0) ((float*)(a.ws + WS_MLSC))[sidx * 4 + 2] = mn; }
        }
    }
}

__device__ __forceinline__ void ml_pass3_item(const Args& a, const Ctx& T0, int item, bf16* OUT) {
    const int jt = item & 15, head = (item >> 4) & 3, b = item >> 6;
    const bf16* P = (const bf16*)(a.ws + WS_PROJ); const bf16* QK = (const bf16*)(a.ws + WS_QK); const float* GT = (const float*)(a.ws + WS_GATES);
    Ctx T = T0; asm volatile("" : "+v"(T.lane));
    T.tid = T.wave * 64 + T.lane;
    LAS unsigned char* L = T.lds;
    const int w = T.wave, l = T.lane, g = l >> 4, c16 = l & 15;
    __syncthreads();
    for (int i = T.tid; i < 64 * MS / 16; i += NTHREADS) *(LAS v4u*)(L + ML_P + i * 16) = (v4u){0u, 0u, 0u, 0u};
    ml_aug_rows(L, T.tid);
    if (T.tid < 128) *(LAS float*)(L + ML_NW + T.tid * 4) = a.in[I_MLNW][head * 128 + T.tid];
#define ML_ROW3(st_, lt_) (b * SEQ + 256 * jt + (((st_) >> 2) ? 255 - (64 * ((st_) & 3) + (lt_)) : 64 * ((st_) & 3) + (lt_)))
    MlPre R;
    const int qt = T.tid >> 3, qpart = T.tid & 7;
#define ML_LOAD_ALL(st_) do { ML_LOAD_KV(R, ROWF_); const size_t rq_ = (size_t)ML_ROW3((st_), qt); R.qn = *(const v4u*)(QK + rq_ * 512 + head * 64 + qpart * 8); R.kn = *(const v4u*)(QK + rq_ * 512 + 256 + head * 64 + qpart * 8); } while (0)
#define ROWF_(x_) ML_ROW3(0, (x_))
    ML_LOAD_ALL(0);
#undef ROWF_
    f32x4 accC[4], accCA = (f32x4){0.f, 0.f, 0.f, 0.f};
    v4u stq[2], sta[2];
#define ML_STATE_LOAD(dir_) do { const size_t sidx_ = hg_seq(b, (dir_), head) * 16 + ((dir_) ? 15 - jt : jt); const bf16* CTg_ = (const bf16*)(a.ws + WS_MLST + sidx_ * ML_SLOT_BYTES); \
        _Pragma("unroll") for (int q_ = 0; q_ < 2; ++q_) { const int idx_ = l + 64 * q_; stq[q_] = *(const v4u*)(CTg_ + (size_t)(16 * w + (idx_ >> 3)) * 64 + (idx_ & 7) * 8); \
            if (w == 4) sta[q_] = *(const v4u*)(CTg_ + (size_t)(128 + (idx_ >> 3)) * 64 + (idx_ & 7) * 8); } } while (0)
    ML_STATE_LOAD(0);
#pragma unroll 1
    for (int step = 0; step < 8; ++step) {
        const int dir = step >> 2, c = step & 3;
        PS_BEGIN();
        if (c == 0) {
            const size_t sidx = hg_seq(b, dir, head) * 16 + (dir ? 15 - jt : jt);
            if (dir == 1) { ML_STATE_LOAD(1); VM_WAIT(); __syncthreads(); if (w == 0) { __builtin_amdgcn_fence(__ATOMIC_ACQUIRE, "agent"); VM_WAIT(); } }
            __syncthreads();
#pragma unroll
            for (int q = 0; q < 2; ++q) { const int idx = l + 64 * q; *(LAS v4u*)(L + ML_CT + (16 * w + (idx >> 3)) * MS + (idx & 7) * 16) = stq[q];
                if (w == 4) *(LAS v4u*)(L + ML_CT + (128 + (idx >> 3)) * MS + (idx & 7) * 16) = sta[q]; }
            if (w == 0) { float ig[4], fg[4];
#pragma unroll
                for (int cc = 0; cc < 4; ++cc) { const int lt = 4 * l + cc; const size_t row = (size_t)ML_ROW3(4 * dir + (lt >> 6), lt & 63); ig[cc] = GT[row * 16 + (dir ? 8 : 0) + head]; fg[cc] = GT[row * 16 + (dir ? 12 : 4) + head]; }
                float bsum = 0.f; const float m0 = ((const float*)(a.ws + WS_MLSC))[sidx * 4 + 2]; (void)ml_scalars256<false>(L, ig, fg, m0, bsum, l); }
            __syncthreads();
#pragma unroll
            for (int m = 0; m < 4; ++m) { const v2u sv = *(const LAS v2u*)(L + ML_CT + (16 * w + c16) * MS + (16 * m + 4 * g) * 2); accC[m] = (f32x4){bflo(sv.x), bfhi(sv.x), bflo(sv.y), bfhi(sv.y)}; }
            if (w < 4) { const v2u sv = *(const LAS v2u*)(L + ML_CT + (128 + c16) * MS + (16 * w + 4 * g) * 2); accCA = (f32x4){bflo(sv.x), bfhi(sv.x), bflo(sv.y), bfhi(sv.y)}; }
        }
        PS_END(5);
        *(LAS v4u*)(L + ML_Q + qt * MS + qpart * 16) = R.qn; *(LAS v4u*)(L + ML_K + qt * MS + qpart * 16) = R.kn;
        ML_STORE_KV(R, c);
        if (step < 7) {
#define ROWF_(x_) ML_ROW3(step + 1, (x_))
            ML_LOAD_ALL(step + 1);
#undef ROWF_
        }
        PS_END(6); __syncthreads(); PS_END(10);
        const size_t orow = (size_t)ML_ROW3(step, qt);
        bf16* optr = OUT + orow * DM + 512 + head * 128 + 16 * qpart;
        v2u ptile[2]; int paddr[2] = {-1, -1};
#pragma unroll 1
        for (int rep = 0; rep < 2; ++rep) { const int tix = w + 8 * rep;
            if (tix < 10) {
                const int I = tix < 1 ? 0 : (tix < 3 ? 1 : (tix < 6 ? 2 : 3)); const int J = tix - (I * (I + 1)) / 2;
                const BF2 af = ldfrag2(L + ML_K + 16 * J * MS, MS, l), bf = ldfrag2(L + ML_Q + 16 * I * MS, MS, l);
                const int tloc = 16 * I + c16, s0 = 16 * J + 4 * g;
                const f32x4 av = *(const LAS f32x4*)(L + ML_TA + (c * 64 + s0) * 4); const float mu = *(const LAS float*)(L + ML_TMU + (c * 64 + tloc) * 4);
                f32x4 at = (f32x4){0.f, 0.f, 0.f, 0.f};
                at = MFMA16(af.k0, bf.k0, at); at = MFMA16(af.k1, bf.k1, at);
                float pr[4];
#pragma unroll
                for (int r = 0; r < 4; ++r) pr[r] = (s0 + r <= tloc) ? at[r] * ex2(av[r] - mu) : 0.f;
                ptile[rep].x = cvtpk(pr[0], pr[1]); ptile[rep].y = cvtpk(pr[2], pr[3]); paddr[rep] = ML_P + tloc * MS + s0 * 2;
            } }
        f32x4 accO[4], accOA = (f32x4){0.f, 0.f, 0.f, 0.f};
        const float carry = *(const LAS float*)(L + ML_SC + c * 4);
        const BF2 vf = ldfrag2(L + ML_VT + 16 * w * MS, MS, l);
        { const BF2 cf = ldfrag2(L + ML_CT + 16 * w * MS, MS, l);
            const BF2 q0 = ldfrag2(L + ML_Q + 0 * 16 * MS, MS, l), q1 = ldfrag2(L + ML_Q + 1 * 16 * MS, MS, l), q2 = ldfrag2(L + ML_Q + 2 * 16 * MS, MS, l), q3 = ldfrag2(L + ML_Q + 3 * 16 * MS, MS, l);
#pragma unroll
            for (int I = 0; I < 4; ++I) accO[I] = (f32x4){0.f, 0.f, 0.f, 0.f};
            accO[0] = MFMA16(q0.k0, cf.k0, accO[0]); accO[1] = MFMA16(q1.k0, cf.k0, accO[1]); accO[2] = MFMA16(q2.k0, cf.k0, accO[2]); accO[3] = MFMA16(q3.k0, cf.k0, accO[3]);
            accO[0] = MFMA16(q0.k1, cf.k1, accO[0]); accO[1] = MFMA16(q1.k1, cf.k1, accO[1]); accO[2] = MFMA16(q2.k1, cf.k1, accO[2]); accO[3] = MFMA16(q3.k1, cf.k1, accO[3]); }
        { const BF2 k0f = ldfrag2(L + ML_KTT + 0 * 16 * MS, MS, l), k1f = ldfrag2(L + ML_KTT + 1 * 16 * MS, MS, l), k2f = ldfrag2(L + ML_KTT + 2 * 16 * MS, MS, l), k3f = ldfrag2(L + ML_KTT + 3 * 16 * MS, MS, l);
#pragma unroll
            for (int I = 0; I < 4; ++I) accC[I] = accC[I] * carry;
            accC[0] = MFMA16(k0f.k0, vf.k0, accC[0]); accC[1] = MFMA16(k1f.k0, vf.k0, accC[1]); accC[2] = MFMA16(k2f.k0, vf.k0, accC[2]); accC[3] = MFMA16(k3f.k0, vf.k0, accC[3]);
            accC[0] = MFMA16(k0f.k1, vf.k1, accC[0]); accC[1] = MFMA16(k1f.k1, vf.k1, accC[1]); accC[2] = MFMA16(k2f.k1, vf.k1, accC[2]); accC[3] = MFMA16(k3f.k1, vf.k1, accC[3]); }
#pragma unroll
        for (int I = 0; I < 4; ++I) { const f32x4 iw = *(const LAS f32x4*)(L + ML_TIW + (c * 64 + 16 * I + 4 * g) * 4); accO[I] = accO[I] * iw; }
        BF2 af = vf;
        if (w < 4) { const BF2 cfa = ldfrag2(L + ML_CT + 128 * MS, MS, l), qw_ = ldfrag2(L + ML_Q + 16 * w * MS, MS, l), kw_ = ldfrag2(L + ML_KTT + 16 * w * MS, MS, l);
            af = ldfrag2(L + ML_VT + 128 * MS, MS, l);
            const f32x4 iwa = *(const LAS f32x4*)(L + ML_TIW + (c * 64 + 16 * w + 4 * g) * 4);
            accCA = accCA * carry;
            accOA = MFMA16(qw_.k0, cfa.k0, accOA); accCA = MFMA16(kw_.k0, af.k0, accCA); accOA = MFMA16(qw_.k1, cfa.k1, accOA); accCA = MFMA16(kw_.k1, af.k1, accCA);
            accOA = accOA * iwa; }
#pragma unroll
        for (int rep = 0; rep < 2; ++rep) if (paddr[rep] >= 0) *(LAS v2u*)(L + paddr[rep]) = ptile[rep];
        v4u pf0 = (v4u){0u, 0u, 0u, 0u}, pf1 = pf0, pg0 = pf0, pg1 = pf0;
        if (dir) { pf0 = *(const v4u*)optr; pf1 = *(const v4u*)(optr + 8); const bf16* gp = P + orow * LDP + 3584 + head * 128 + 16 * qpart; pg0 = *(const v4u*)gp; pg1 = *(const v4u*)(gp + 8); }
        PS_END(7); __syncthreads(); PS_END(10);
        { const BF2 p0 = ldfrag2(L + ML_P + 0 * 16 * MS, MS, l), p1 = ldfrag2(L + ML_P + 1 * 16 * MS, MS, l), p2 = ldfrag2(L + ML_P + 2 * 16 * MS, MS, l), p3 = ldfrag2(L + ML_P + 3 * 16 * MS, MS, l);
            accO[0] = MFMA16(p0.k0, vf.k0, accO[0]); accO[1] = MFMA16(p1.k0, vf.k0, accO[1]); accO[2] = MFMA16(p2.k0, vf.k0, accO[2]); accO[3] = MFMA16(p3.k0, vf.k0, accO[3]);
            accO[0] = MFMA16(p0.k1, vf.k1, accO[0]); accO[1] = MFMA16(p1.k1, vf.k1, accO[1]); accO[2] = MFMA16(p2.k1, vf.k1, accO[2]); accO[3] = MFMA16(p3.k1, vf.k1, accO[3]);
            if (w < 4) { const BF2 pw_ = ldfrag2(L + ML_P + 16 * w * MS, MS, l); accOA = MFMA16(pw_.k0, af.k0, accOA); accOA = MFMA16(pw_.k1, af.k1, accOA); } }
#pragma unroll
        for (int m = 0; m < 4; ++m) { v2u o; o.x = cvtpk(accC[m][0], accC[m][1]); o.y = cvtpk(accC[m][2], accC[m][3]); *(LAS v2u*)(L + ML_CT + (16 * w + c16) * MS + (16 * m + 4 * g) * 2) = o; }
        if (w < 4) { v2u o; o.x = cvtpk(accCA[0], accCA[1]); o.y = cvtpk(accCA[2], accCA[3]); *(LAS v2u*)(L + ML_CT + (128 + c16) * MS + (16 * w + 4 * g) * 2) = o;
            if (c16 == 0) { const f32x4 em = *(const LAS f32x4*)(L + ML_TEM + (c * 64 + 16 * w + 4 * g) * 4); f32x4 ri;
#pragma unroll
                for (int r = 0; r < 4; ++r) ri[r] = __builtin_amdgcn_rcpf(fmaxf(fabsf(accOA[r]), em[r]));
                *(LAS f32x4*)(L + ML_TRI + (16 * w + 4 * g) * 4) = ri; } }
#pragma unroll
        for (int I = 0; I < 4; ++I)
#pragma unroll
            for (int r = 0; r < 4; ++r) *(LAS float*)(L + ML_OT + (16 * I + 4 * g + r) * OT_S + (16 * w + c16) * 4) = accO[I][r];
        PS_END(8); __syncthreads(); PS_END(10);
        { float ov[16]; const float ri = *(const LAS float*)(L + ML_TRI + qt * 4);
#pragma unroll
            for (int q = 0; q < 4; ++q) { const f32x4 t4 = *(const LAS f32x4*)(L + ML_OT + qt * OT_S + (16 * qpart + 4 * q) * 4); ov[4 * q] = t4.x * ri; ov[4 * q + 1] = t4.y * ri; ov[4 * q + 2] = t4.z * ri; ov[4 * q + 3] = t4.w * ri; }
            if (dir) {
                float fo[16], gt[16];
#pragma unroll
                for (int q = 0; q < 4; ++q) { fo[2 * q] = bflo(pf0[q]); fo[2 * q + 1] = bfhi(pf0[q]); fo[8 + 2 * q] = bflo(pf1[q]); fo[8 + 2 * q + 1] = bfhi(pf1[q]);
                    gt[2 * q] = bflo(pg0[q]); gt[2 * q + 1] = bfhi(pg0[q]); gt[8 + 2 * q] = bflo(pg1[q]); gt[8 + 2 * q + 1] = bfhi(pg1[q]); }
                float ss = 0.f;
#pragma unroll
                for (int i = 0; i < 16; ++i) { ov[i] += fo[i]; ss += ov[i] * ov[i]; }
                ss += __shfl_xor(ss, 1); ss += __shfl_xor(ss, 2); ss += __shfl_xor(ss, 4);
                const float rstd = __builtin_amdgcn_rsqf(ss * (1.f / 128.f) + EPSN);
#pragma unroll
                for (int q = 0; q < 4; ++q) { const f32x4 nw4 = *(const LAS f32x4*)(L + ML_NW + (16 * qpart + 4 * q) * 4);
                    ov[4 * q] *= rstd * nw4.x * gt[4 * q]; ov[4 * q + 1] *= rstd * nw4.y * gt[4 * q + 1]; ov[4 * q + 2] *= rstd * nw4.z * gt[4 * q + 2]; ov[4 * q + 3] *= rstd * nw4.w * gt[4 * q + 3]; }
            }
            *(v4u*)optr = (v4u){cvtpk(ov[0], ov[1]), cvtpk(ov[2], ov[3]), cvtpk(ov[4], ov[5]), cvtpk(ov[6], ov[7])};
            *(v4u*)(optr + 8) = (v4u){cvtpk(ov[8], ov[9]), cvtpk(ov[10], ov[11]), cvtpk(ov[12], ov[13]), cvtpk(ov[14], ov[15])}; }
        PS_END(9);
    }
#undef ML_ROW3
#undef ML_LOAD_ALL
#undef ML_STATE_LOAD
}
__device__ __forceinline__ void final_norm_phase(const Args& a, const Ctx& T, const bf16* X3) {
    f32x4 wv[4];
#pragma unroll
    for (int j = 0; j < 4; ++j) wv[j] = *((const f32x4*)a.in[I_FNW] + T.lane + 64 * j);
    f32x4 v[4];
    if (T.gw < MLAT) norm_load_row(v, X3, true, nullptr, T.gw, T.lane);
    for (int m = T.gw; m < MLAT; m += T.NGW) {
        f32x4 cur[4]; float s = 0.f;
#pragma unroll
        for (int j = 0; j < 4; ++j) { cur[j] = v[j]; s += (v[j].x * v[j].x + v[j].y * v[j].y) + (v[j].z * v[j].z + v[j].w * v[j].w); }
        { const int mn = m + T.NGW; if (mn < MLAT) norm_load_row(v, X3, true, nullptr, mn, T.lane); }
        const float rstd = __builtin_amdgcn_rsqf(wave_sum(s) * (1.f / DM) + EPSN);
        f32x4* xr = (f32x4*)(a.out + (size_t)m * DM) + T.lane;
#pragma unroll
        for (int j = 0; j < 4; ++j) xr[64 * j] = cur[j] * rstd * wv[j];
    }
}

__device__ __forceinline__ void gates_phase(const Args& a, const Ctx& T) {
    const bf16* XNc = (const bf16*)(a.ws + WS_XN); const bf16* WG = (const bf16*)(a.ws + WS_WG); float* GT = (float*)(a.ws + WS_GATES);
    const int l = T.lane, r = l & 15, g = l >> 4;
    const float bias = a.in[I_MLGB][r];
    for (int rg = T.gw; rg < MALL / 16; rg += T.NGW) {
        f32x4 acc = (f32x4){0.f, 0.f, 0.f, 0.f};
        const bf16* pa = XNc + (size_t)(16 * rg + r) * DM + 8 * g; const bf16* pb = WG + (size_t)r * DM + 8 * g;
#pragma unroll 8
        for (int ks = 0; ks < 32; ++ks) { const bf16x8 av = *(const bf16x8*)(pa + ks * 32); const bf16x8 bv = *(const bf16x8*)(pb + ks * 32); acc = MFMA16(av, bv, acc); }
#pragma unroll
        for (int q = 0; q < 4; ++q) GT[(size_t)(16 * rg + 4 * g + q) * 16 + r] = acc[q] + bias;
    }
}

__global__ void __launch_bounds__(NTHREADS, 2) fwd_kernel(Args a) {
    extern __shared__ __attribute__((aligned(16))) unsigned char lds_raw[];
    Ctx T;
    T.lds = (LAS unsigned char*)lds_raw;
    T.tid = threadIdx.x; T.lane = T.tid & 63; T.wave = __builtin_amdgcn_readfirstlane(T.tid >> 6);
    T.G = gridDim.x; { const int bx = blockIdx.x; T.vcu = (T.G % 8 == 0) ? (bx % 8) * (T.G / 8) + bx / 8 : bx; }
    T.gw = T.vcu * NWAVES + T.wave; T.NGW = T.G * NWAVES;
    volatile LAS unsigned* MISC = (volatile LAS unsigned*)(T.lds + MISC_OFF);
    for (int u = T.tid; u < (LDS_BYTES - LDSCTL_OFF) / 4; u += NTHREADS) ((LAS unsigned*)(T.lds + LDSCTL_OFF))[u] = 0u;
    __syncthreads();
    XcdBarrier bar; bar.bar = (unsigned*)(a.ws + WS_CTL) + CW_BAR; bar.x = 0; bar.st = nullptr;
    const bool multi = (a.ph_hi - a.ph_lo) > 1;
    if (multi) bar = xcd_barrier_post((unsigned*)(a.ws + WS_CTL) + CW_BAR, MISC + 8);
    const int lo = a.ph_lo, hi = a.ph_hi;
#ifndef REP_MASK
#define REP_MASK 0
#endif
#define IN(k) (lo <= (k) && (k) < hi)
#ifndef PROF_K
#define PROF_K -1
#endif
#define STAMP(k) do { if (PROF_K >= 0 && ((k) == PROF_K || (k) == PROF_K + 1) && blockIdx.x == 0 && T.tid == 0) { const unsigned long long t_ = __builtin_amdgcn_s_memrealtime(); MISC[16 + 2 * ((k) - PROF_K)] = (unsigned)t_; MISC[17 + 2 * ((k) - PROF_K)] = (unsigned)(t_ >> 32); } } while (0)
#define REPS(k) for (int rep_ = 0; rep_ < (((REP_MASK >> (k)) & 1) ? 2 : 1); ++rep_)
#if (REP_MASK >> 18) & 1
#define SEAM(k) do { if (IN(k) && IN((k) + 1)) { xcd_barrier(bar); xcd_barrier(bar); } } while (0)
#else
#define SEAM(k) do { if (IN(k) && IN((k) + 1)) xcd_barrier(bar); STAMP((k) + 1); } while (0)
#endif
    bf16* XN = (bf16*)(a.ws + WS_XN); bf16* HB = (bf16*)(a.ws + WS_PROJ); bf16* PROJ = (bf16*)(a.ws + WS_PROJ);
    const float* mods = (const float*)(a.ws + WS_MODS);
    bf16* XB1 = (bf16*)a.out; bf16* XB2 = (bf16*)a.out + (size_t)MLAT * DM; bf16* XB3 = (bf16*)(a.ws + WS_PROJ + 96 * MiB);
    const int bx = (int)blockIdx.x;

    STAMP(0);
    if (IN(0)) REPS(0) { mods_phase(a, T); convert_ffn(a, T, a.in[I_F1W1], a.in[I_F1W2]); convert_mix(a, T);
        if (T.tid < 64) { const int e = bx * 64 + T.tid; if (e < 16384) { const int q = e >> 10, k = e & 1023; ((bf16*)(a.ws + WS_WG))[q * 1024 + k] = (bf16)f2bf(a.in[I_WIN][(size_t)k * DIN + NPROJ + q]); } } }
    SEAM(0);
    if (IN(1)) norm_mod_rows<false, false>(a, T, a.in[I_X], a.in[I_CTX], MALL, a.in[I_N1W], 0, 1);
    SEAM(1);
    if (IN(2)) REPS(2) { pg8::Gemm g{XN, (const bf16*)(a.ws + WS_W1), MALL, 2 * DFF, DM, DM}; pg8::StaticOrder S; S.init(MALL, 2 * DFF, T.G, bx);
        pg8::EpiSwiglu E{HB, DFF}; pg8::gemm_phase<pg8::EpiSwiglu, pg8::StaticOrder, true, true>(T.lds, g, S, E); }
    SEAM(2);
    if (IN(3)) { pg8::Gemm g{HB, (const bf16*)(a.ws + WS_W2), MALL, DM, DFF, DFF}; pg8::DownOrder S; S.lat.init(MLAT, DM, T.G, bx); S.c = bx;
        pg8::EpiDown1 E{a.in[I_X], XB1, mods + 2 * 1024, 0.5f, (float*)(a.ws + WS_SLAB)}; pg8::gemm_phase<pg8::EpiDown1, pg8::DownOrder, true, true>(T.lds, g, S, E); }
    SEAM(3);
    if (IN(4)) REPS(4) { norm_mod_rows<true, true>(a, T, XB1, a.in[I_CTX], MALL, a.in[I_N2W], 3, 4); convert_ffn(a, T, a.in[I_F2W1], a.in[I_F2W2]); }
    SEAM(4);
    if (IN(5)) { pg8::Gemm g{XN, (const bf16*)(a.ws + WS_WIN), MALL, NPROJ, DM, DM}; pg8::ProjOrder S; S.lat.init(MLAT, NPROJ, T.G, bx); S.c = bx;
        pg8::EpiProjAll E{{PROJ, LDP}, (bf16*)(a.ws + WS_SLAB2)}; pg8::gemm_phase<pg8::EpiProjAll, pg8::ProjOrder, true, true>(T.lds, g, S, E); }
    SEAM(5);
    if (IN(6)) { gates_phase(a, T); ctx_combine(a, T); conv_phase(a, T); }
    SEAM(6);
    if (IN(7)) REPS(7) { hg_pass1_items(a, T, T.vcu, T.G, 256); ml_pass1_items(a, T, T.vcu, T.G, 256); }
    SEAM(7);
    if (IN(8)) pass2_all(a, T);
    SEAM(8);
    if (IN(9)) REPS(9) { for (int it = T.vcu; it < 256; it += T.G) hg_pass3_item(a, T, it, XN); for (int it = T.vcu; it < 256; it += T.G) ml_pass3_item(a, T, it, XN); }
    SEAM(9);
    if (IN(10)) { pg8::Gemm g{XN, (const bf16*)(a.ws + WS_WOUT), MLAT, DM, DM, DM}; pg8::StaticOrder S; S.init(MLAT, DM, T.G, bx);
        pg8::EpiResidB<true> E{XB1, XB2, mods + 5 * 1024, 1.0f}; pg8::gemm_phase<pg8::EpiResidB<true>, pg8::StaticOrder, true, true>(T.lds, g, S, E); }
    SEAM(10);
    if (IN(11)) REPS(11) norm_mod_rows<false, true>(a, T, XB2, nullptr, MLAT, a.in[I_N3W], 6, 7);
    SEAM(11);
    if (IN(12)) REPS(12) { pg8::Gemm g{XN, (const bf16*)(a.ws + WS_W1), MLAT, 2 * DFF, DM, DM}; pg8::StaticOrder S; S.init(MLAT, 2 * DFF, T.G, bx);
        pg8::EpiSwiglu E{HB, DFF}; pg8::gemm_phase<pg8::EpiSwiglu, pg8::StaticOrder, true, true>(T.lds, g, S, E); }
    SEAM(12);
    if (IN(13)) { pg8::Gemm g{HB, (const bf16*)(a.ws + WS_W2), MLAT, DM, DFF, DFF}; pg8::StaticOrder S; S.init(MLAT, DM, T.G, bx);
        pg8::EpiResidB<true> E{XB2, XB3, mods + 8 * 1024, 0.5f}; pg8::gemm_phase<pg8::EpiResidB<true>, pg8::StaticOrder, true, true>(T.lds, g, S, E); }
    SEAM(13);
    if (IN(14)) final_norm_phase(a, T, XB3);
    STAMP(15);
    if (PROF_S >= 0 && blockIdx.x == 0 && T.tid == 0) { const unsigned long long dt_ = ((((unsigned long long)MISC[23]) << 32) | MISC[22]) * 8ull, te_ = __builtin_amdgcn_s_memrealtime(); while (__builtin_amdgcn_s_memrealtime() - te_ < dt_) __builtin_amdgcn_s_sleep(8); }
    if (PROF_K >= 0 && blockIdx.x == 0 && T.tid == 0) { const unsigned long long t0_ = ((unsigned long long)MISC[17] << 32) | MISC[16], t1_ = ((unsigned long long)MISC[19] << 32) | MISC[18];
        const unsigned long long dt_ = (t1_ - t0_) * 8ull, te_ = __builtin_amdgcn_s_memrealtime(); while (__builtin_amdgcn_s_memrealtime() - te_ < dt_) __builtin_amdgcn_s_sleep(8); }
#undef IN
#undef SEAM
}

extern "C" void kernel_launch(void* const* d_in, const int* in_sizes, int n_in, void* d_out, int out_size, void* d_ws, size_t ws_size, hipStream_t stream) {
    static int grid = 0;
    if (grid == 0) {
        if (n_in != 22 || out_size != MLAT * DM || ws_size < WS_END) { fprintf(stderr, "kernel_launch: unexpected shapes (n_in %d out %d ws %zu)\n", n_in, out_size, ws_size); grid = -1; return; }
        int dev = 0, cus = 0;
        if (hipGetDevice(&dev) != hipSuccess || hipDeviceGetAttribute(&cus, hipDeviceAttributeMultiprocessorCount, dev) != hipSuccess) { grid = -1; return; }
        if (hipFuncSetAttribute((const void*)fwd_kernel, hipFuncAttributeMaxDynamicSharedMemorySize, LDS_BYTES) != hipSuccess) { fprintf(stderr, "kernel_launch: hipFuncSetAttribute failed\n"); grid = -1; return; }
        (void)hipGetLastError();
        grid = cus;
    }
    if (grid < 0) return;
    (void)hipMemsetAsync((char*)d_ws + WS_CTL, 0, CTL_ZERO_BYTES, stream);
    (void)hipMemsetAsync((char*)d_ws + WS_MODS, 0, 5 * NMODC * sizeof(float), stream);
    Args a{};
    for (int i = 0; i < 22; ++i) a.in[i] = (const float*)d_in[i];
    a.out = (float*)d_out; a.ws = (unsigned char*)d_ws;
#if ONE_LAUNCH
    a.ph_lo = 0; a.ph_hi = NPHASES;
    hipLaunchKernelGGL(fwd_kernel, dim3(grid), dim3(NTHREADS), LDS_BYTES, stream, a);
#else
    for (int p = 0; p < NPHASES; ++p) { a.ph_lo = p; a.ph_hi = p + 1; hipLaunchKernelGGL(fwd_kernel, dim3(grid), dim3(NTHREADS), LDS_BYTES, stream, a); }
#endif
}
```

```cpp
#include <hip/hip_runtime.h>
#include <cstdio>
#include <cstdint>
#ifndef PROF_S
#define PROF_S -1
#endif
#define PG8_PS_BEGIN() do { if (PROF_S == 20 && blockIdx.x == 0 && threadIdx.x == 0) { const unsigned long long t_ = __builtin_amdgcn_s_memrealtime(); volatile __attribute__((address_space(3))) unsigned* M_ = (volatile __attribute__((address_space(3))) unsigned*)(lds + 162816 + 320); M_[20] = (unsigned)t_; M_[21] = (unsigned)(t_ >> 32); } } while (0)
#define PG8_PS_END() do { if (PROF_S == 20 && blockIdx.x == 0 && threadIdx.x == 0) { const unsigned long long t_ = __builtin_amdgcn_s_memrealtime(); volatile __attribute__((address_space(3))) unsigned* M_ = (volatile __attribute__((address_space(3))) unsigned*)(lds + 162816 + 320); \
    const unsigned long long p_ = ((unsigned long long)M_[21] << 32) | M_[20]; const unsigned long long a_ = (((unsigned long long)M_[23] << 32) | M_[22]) + (t_ - p_); M_[22] = (unsigned)a_; M_[23] = (unsigned)(a_ >> 32); } } while (0)
namespace pg8 {
#define PG8_LAS __attribute__((address_space(3)))
typedef unsigned short bf16_t;
typedef short bf16x8 __attribute__((ext_vector_type(8)));
typedef float f32x4 __attribute__((ext_vector_type(4)));
typedef unsigned u32x4 __attribute__((ext_vector_type(4)));
constexpr int BM = 256, BK = 64, HALF = 128, HTB = HALF * BK * 2  , STAGE_BYTES = 8 * HTB, NXCD = 8, WGM = 8;

__host__ __device__ __forceinline__ int lds_byte(int r, int c) { const int st = (r >> 4) * 2 + (c >> 5), rr = r & 15, cc = c & 31, ob = rr * 64 + cc * 2; return st * 1024 + (ob ^ (((ob >> 9) & 1) << 5)); }
__host__ __device__ __forceinline__ void stage_rc(int b, int& R, int& C) { const int st = b / 1024, sb = b % 1024, swz = sb ^ (((sb >> 9) & 1) << 5); R = (st >> 1) * 16 + swz / 64; C = (st & 1) * 32 + (swz % 64) / 2; }
__host__ __device__ __forceinline__ int perm32(int rho) { const int n = rho >> 4, i = rho & 15; return 8 * (i >> 2) + 4 * n + (i & 3); }

struct Unit { int pm, pn, kofs, kt; };
struct Gemm { const bf16_t* A; const bf16_t* Bt; int M, N, K, ld; };

struct StaticOrder {
    int nM, nN, nwg, G, c;
    __host__ __device__ void init(int M, int N, int G_, int c_) { nM = M / BM; nN = N / BM; nwg = nM * nN; G = G_; c = c_; }
    __host__ __device__ bool next(int i, Unit& u) const {
        const long L = (long)i * G + c; if (L >= nwg) return false;
        int wgid = (int)L; { const int q = nwg / NXCD, r = nwg % NXCD, xcd = wgid % NXCD, off = wgid / NXCD; wgid = (xcd < r ? xcd * (q + 1) : r * (q + 1) + (xcd - r) * q) + off; }
        const int nig = WGM * nN, gid = wgid / nig, fm = gid * WGM, gsz = (nM - fm) < WGM ? (nM - fm) : WGM;
        u.pm = fm + ((wgid % nig) % gsz); u.pn = (wgid % nig) / gsz; u.kofs = 0; u.kt = 0; return true;
    }
    __device__ __forceinline__ void a_ready(const Unit&) const {}
    __device__ __forceinline__ void done(const Unit&) const {}
};
__device__ __forceinline__ unsigned cvt_pk_bf16(float lo, float hi) { unsigned r; asm volatile("v_cvt_pk_bf16_f32 %0, %1, %2" : "=v"(r) : "v"(lo), "v"(hi)); return r; }
typedef float f32x2 __attribute__((ext_vector_type(2)));
__device__ __forceinline__ float fast_sigmoid(float v) { return __builtin_amdgcn_rcpf(1.0f + __builtin_amdgcn_exp2f(-1.4426950408889634f * v)); }
__device__ __forceinline__ float fast_silu(float v) { return v * fast_sigmoid(v); }

struct EpiSwiglu {
    static constexpr bool PERM = true, AFTER_DRAIN = false;
    bf16_t* H; int ldh;
    __device__ __forceinline__ void operator()(const f32x4 (&acc)[2][2][4][2], const Unit& u, int wr, int wc, int fr, int fq) const {
        typedef float f2 __attribute__((ext_vector_type(2)));
        const int row0 = u.pm * BM + wr * 64 + fr, col0 = u.pn * HALF + wc * 32 + 8 * fq;
#pragma unroll
        for (int ai = 0; ai < 2; ++ai)
#pragma unroll
            for (int m = 0; m < 4; ++m) { bf16_t* rowp = H + (size_t)(row0 + ai * HALF + m * 16) * ldh + col0;
                unsigned wv[4];
#pragma unroll
                for (int n = 0; n < 2; ++n)
#pragma unroll
                    for (int h = 0; h < 2; ++h) {
                        const f2 g = {acc[ai][0][m][n][2 * h], acc[ai][0][m][n][2 * h + 1]}, uu = {acc[ai][1][m][n][2 * h], acc[ai][1][m][n][2 * h + 1]};
                        const f2 x = g * (-1.4426950408889634f);
                        f2 d; d.x = __builtin_amdgcn_exp2f(x.x); d.y = __builtin_amdgcn_exp2f(x.y); d = d + 1.0f;
                        f2 r; r.x = __builtin_amdgcn_rcpf(d.x); r.y = __builtin_amdgcn_rcpf(d.y);
                        const f2 o = (g * uu) * r;
                        wv[n * 2 + h] = cvt_pk_bf16(o.x, o.y); }
                u32x4 w; w.x = wv[0]; w.y = wv[1]; w.z = wv[2]; w.w = wv[3];
                __builtin_nontemporal_store(w, (u32x4*)rowp); }
    }
};

struct EpiResid {
    static constexpr bool PERM = false, AFTER_DRAIN = false;
    const float* base_lat; const float* base_ctx; float* out_lat; float* out_ctx; const float* gate; float coef;
    __device__ __forceinline__ void operator()(const f32x4 (&acc)[2][2][4][2], const Unit& u, int wr, int wc, int fr, int fq) const {
        const bool isctx = u.pm >= 64;
        const float* base = isctx ? base_ctx + (size_t)(u.pm - 64) * BM * 1024 : base_lat + (size_t)u.pm * BM * 1024;
        float* out = isctx ? out_ctx + (size_t)(u.pm - 64) * BM * 1024 : out_lat + (size_t)u.pm * BM * 1024;
        const float* g = gate + (size_t)(isctx ? 4 : (u.pm >> 4)) * 9216;
        const int col0 = u.pn * BM + wc * 32 + 4 * fq;
        f32x4 gv[2][2];
#pragma unroll
        for (int bj = 0; bj < 2; ++bj)
#pragma unroll
            for (int n = 0; n < 2; ++n) gv[bj][n] = *(const f32x4*)(g + col0 + bj * HALF + n * 16) * coef;
#pragma unroll
        for (int ai = 0; ai < 2; ++ai)
#pragma unroll
            for (int m = 0; m < 4; ++m) { const size_t off = (size_t)(ai * HALF + wr * 64 + m * 16 + fr) * 1024 + col0;
#pragma unroll
                for (int bj = 0; bj < 2; ++bj)
#pragma unroll
                    for (int n = 0; n < 2; ++n) { const f32x4 b = *(const f32x4*)(base + off + bj * HALF + n * 16);
                        *(f32x4*)(out + off + bj * HALF + n * 16) = b + gv[bj][n] * acc[ai][bj][m][n]; } }
    }
};

struct EpiProj {
    static constexpr bool PERM = true, AFTER_DRAIN = false;
    bf16_t* O; int ldc;
    __device__ __forceinline__ void operator()(const f32x4 (&acc)[2][2][4][2], const Unit& u, int wr, int wc, int fr, int fq) const {
        const int row0 = u.pm * BM + wr * 64 + fr, col0 = u.pn * BM + wc * 32 + 8 * fq;
        const int mode = (u.pn < 2) ? 1 : ((u.pn == 4 || u.pn == 5) ? 2 : (u.pn >= 14 ? 3 : 0));
#pragma unroll
        for (int ai = 0; ai < 2; ++ai)
#pragma unroll
            for (int m = 0; m < 4; ++m) { bf16_t* rowp = O + (size_t)(row0 + ai * HALF + m * 16) * ldc + col0;
#pragma unroll
                for (int bj = 0; bj < 2; ++bj) { float r[8];
#pragma unroll
                    for (int n = 0; n < 2; ++n)
#pragma unroll
                        for (int i = 0; i < 4; ++i) { const float v = acc[ai][bj][m][n][i];
                            r[n * 4 + i] = mode == 0 ? v : (mode == 1 ? fast_silu(v) * 0.08838834764831845f : (mode == 2 ? fast_silu(v) : fast_sigmoid(v))); }
                    u32x4 w; w.x = cvt_pk_bf16(r[0], r[1]); w.y = cvt_pk_bf16(r[2], r[3]); w.z = cvt_pk_bf16(r[4], r[5]); w.w = cvt_pk_bf16(r[6], r[7]);
                    *(u32x4*)(rowp + bj * HALF) = w; } }
    }
};

struct DownOrder {
    StaticOrder lat; int c;
    __device__ __forceinline__ bool next(int i, Unit& u) const {
        if (i == 0) return lat.next(0, u);
        if (i != 1 || c >= 176) return false;
        const int ks = c % 11, t = c / 11; u.pn = t & 3; u.pm = 64 + (t >> 2); u.kofs = ks * 256; u.kt = 4; return true; }
    __device__ __forceinline__ void a_ready(const Unit&) const {}
    __device__ __forceinline__ void done(const Unit&) const {}
};
struct EpiDown1 {
    static constexpr bool PERM = true, AFTER_DRAIN = false;
    const float* base; bf16_t* out; const float* gate; float coef; bf16_t* slab;
    __device__ __forceinline__ void operator()(const f32x4 (&acc)[2][2][4][2], const Unit& u, int wr, int wc, int fr, int fq) const {
        const int col0 = u.pn * BM + wc * 32 + 8 * fq;
        if (u.kt) {
            bf16_t* o = slab + ((size_t)(u.kofs >> 8) * 1024 + (size_t)(u.pm - 64) * BM) * 1024 + col0;
#pragma unroll
            for (int ai = 0; ai < 2; ++ai)
#pragma unroll
                for (int m = 0; m < 4; ++m) { bf16_t* rowp = o + (size_t)(ai * HALF + wr * 64 + m * 16 + fr) * 1024;
#pragma unroll
                    for (int bj = 0; bj < 2; ++bj) { const f32x4 v0 = acc[ai][bj][m][0], v1 = acc[ai][bj][m][1];
                        u32x4 w; w.x = cvt_pk_bf16(v0[0], v0[1]); w.y = cvt_pk_bf16(v0[2], v0[3]); w.z = cvt_pk_bf16(v1[0], v1[1]); w.w = cvt_pk_bf16(v1[2], v1[3]);
                        *(u32x4*)(rowp + bj * HALF) = w; } }
            return;
        }
        const float* g = gate + (size_t)(u.pm >> 4) * 9216;
        f32x4 gv[2][2];
#pragma unroll
        for (int bj = 0; bj < 2; ++bj)
#pragma unroll
            for (int n = 0; n < 2; ++n) gv[bj][n] = *(const f32x4*)(g + col0 + bj * HALF + 4 * n) * coef;
#pragma unroll
        for (int ai = 0; ai < 2; ++ai)
#pragma unroll
            for (int m = 0; m < 4; ++m) { const size_t off = (size_t)(u.pm * BM + ai * HALF + wr * 64 + m * 16 + fr) * 1024 + col0;
#pragma unroll
                for (int bj = 0; bj < 2; ++bj) { const f32x4 b0 = *(const f32x4*)(base + off + bj * HALF), b1 = *(const f32x4*)(base + off + bj * HALF + 4);
                    const f32x4 v0 = b0 + gv[bj][0] * acc[ai][bj][m][0], v1 = b1 + gv[bj][1] * acc[ai][bj][m][1];
                    u32x4 w; w.x = cvt_pk_bf16(v0[0], v0[1]); w.y = cvt_pk_bf16(v0[2], v0[3]); w.z = cvt_pk_bf16(v1[0], v1[1]); w.w = cvt_pk_bf16(v1[2], v1[3]);
                    *(u32x4*)(out + off + bj * HALF) = w; } }
    }
};
struct ProjOrder {
    StaticOrder lat; int c;
    __device__ __forceinline__ bool next(int i, Unit& u) const {
        if (i < 4) return lat.next(i, u);
        if (i != 4 || c >= 144) return false;
        const int ks = c & 3, t = c >> 2, t9 = t % 9;
        u.pm = 64 + t / 9; u.pn = t9 < 2 ? 2 + t9 : (t9 < 6 ? 4 + t9 : 5 + t9); u.kofs = ks * 256; u.kt = 4; return true; }
    __device__ __forceinline__ void a_ready(const Unit&) const {}
    __device__ __forceinline__ void done(const Unit&) const {}
};
struct EpiProjAll {
    static constexpr bool PERM = true, AFTER_DRAIN = false;
    EpiProj lat; bf16_t* slab;
    __device__ __forceinline__ void operator()(const f32x4 (&acc)[2][2][4][2], const Unit& u, int wr, int wc, int fr, int fq) const {
        if (!u.kt) { lat(acc, u, wr, wc, fr, fq); return; }
        const int t9 = u.pn < 4 ? u.pn - 2 : (u.pn < 10 ? u.pn - 4 : u.pn - 5);
        bf16_t* out = slab + ((size_t)(u.kofs >> 8) * 1024 + (size_t)(u.pm - 64) * BM) * 2304 + t9 * 256 + wc * 32 + 8 * fq;
#pragma unroll
        for (int ai = 0; ai < 2; ++ai)
#pragma unroll
            for (int m = 0; m < 4; ++m) { bf16_t* rowp = out + (size_t)(ai * HALF + wr * 64 + m * 16 + fr) * 2304;
#pragma unroll
                for (int bj = 0; bj < 2; ++bj) { const f32x4 v0 = acc[ai][bj][m][0], v1 = acc[ai][bj][m][1];
                    u32x4 w; w.x = cvt_pk_bf16(v0[0], v0[1]); w.y = cvt_pk_bf16(v0[2], v0[3]); w.z = cvt_pk_bf16(v1[0], v1[1]); w.w = cvt_pk_bf16(v1[2], v1[3]);
                    *(u32x4*)(rowp + bj * HALF) = w; } }
    }
};

template <bool BASE_BF16>
struct EpiResidB {
    static constexpr bool PERM = true, AFTER_DRAIN = false;
    const void* base; bf16_t* out; const float* gate; float coef;
    __device__ __forceinline__ void operator()(const f32x4 (&acc)[2][2][4][2], const Unit& u, int wr, int wc, int fr, int fq) const {
        const float* g = gate + (size_t)(u.pm >> 4) * 9216;
        const int col0 = u.pn * BM + wc * 32 + 8 * fq;
        f32x4 gv[2][2];
#pragma unroll
        for (int bj = 0; bj < 2; ++bj)
#pragma unroll
            for (int n = 0; n < 2; ++n) gv[bj][n] = *(const f32x4*)(g + col0 + bj * HALF + 4 * n) * coef;
#pragma unroll
        for (int ai = 0; ai < 2; ++ai)
#pragma unroll
            for (int m = 0; m < 4; ++m) { const size_t off = (size_t)(u.pm * BM + ai * HALF + wr * 64 + m * 16 + fr) * 1024 + col0;
#pragma unroll
                for (int bj = 0; bj < 2; ++bj) { f32x4 b0, b1;
                    if (BASE_BF16) { const u32x4 bw = *(const u32x4*)((const bf16_t*)base + off + bj * HALF);
                        b0 = (f32x4){__builtin_bit_cast(float, bw.x << 16), __builtin_bit_cast(float, bw.x & 0xffff0000u), __builtin_bit_cast(float, bw.y << 16), __builtin_bit_cast(float, bw.y & 0xffff0000u)};
                        b1 = (f32x4){__builtin_bit_cast(float, bw.z << 16), __builtin_bit_cast(float, bw.z & 0xffff0000u), __builtin_bit_cast(float, bw.w << 16), __builtin_bit_cast(float, bw.w & 0xffff0000u)}; }
                    else { b0 = *(const f32x4*)((const float*)base + off + bj * HALF); b1 = *(const f32x4*)((const float*)base + off + bj * HALF + 4); }
                    const f32x4 v0 = b0 + gv[bj][0] * acc[ai][bj][m][0], v1 = b1 + gv[bj][1] * acc[ai][bj][m][1];
                    u32x4 w; w.x = cvt_pk_bf16(v0[0], v0[1]); w.y = cvt_pk_bf16(v0[2], v0[3]); w.z = cvt_pk_bf16(v1[0], v1[1]); w.w = cvt_pk_bf16(v1[2], v1[3]);
                    *(u32x4*)(out + off + bj * HALF) = w; } }
    }
};

template <class Epi, class Sched, bool ALIGN_EPI = false, bool SP2 = false>
__device__ __forceinline__ void gemm_phase(PG8_LAS unsigned char* lds, const Gemm g, const Sched& S, const Epi& E) {
    const int tid = threadIdx.x, wid = __builtin_amdgcn_readfirstlane(tid >> 6), lane = tid & 63, wr = wid >> 2, wc = wid & 3, fr = lane & 15, fq = lane >> 4;
    const int K = g.K, nt = K / BK, LD = g.ld;
    unsigned voffA[2], voffB[2];
#pragma unroll
    for (int i = 0; i < 2; ++i) { int R, C; stage_rc(tid * 16 + i * 8192, R, C); const int Rb = Epi::PERM ? ((R & ~31) + perm32(R & 31)) : R;
        voffA[i] = (unsigned)(R * LD + C) * 2u; voffB[i] = (unsigned)(Rb * LD + C) * 2u; }
    const size_t kstep = (size_t)(BK * 2);
    const size_t hstep = (size_t)HALF * LD * 2;
    const size_t tstep = 2 * hstep;
    const unsigned ldsw = (unsigned)wid * 1024u;
    const int aoff = lds_byte(wr * 64 + fr, fq * 8), boff = lds_byte(wc * 32 + fr, fq * 8);
#define PG8_SA(b, h) (((b) * 2 + (h)) * HTB)
#define PG8_SB(b, h) ((4 + (b) * 2 + (h)) * HTB)
#define PG8_STAGE(bufoff, gbase, voff) do { _Pragma("unroll") for (int _i = 0; _i < 2; ++_i) \
        __builtin_amdgcn_global_load_lds((const unsigned*)((const char*)(gbase) + (voff)[_i]), (PG8_LAS unsigned*)(lds + (bufoff) + ldsw + _i * 8192), 16, 0, 0); } while (0)
#define PG8_LDA(dst, b, h) do { _Pragma("unroll") for (int m = 0; m < 4; ++m) _Pragma("unroll") for (int k = 0; k < 2; ++k) dst[m][k] = *(const PG8_LAS bf16x8*)(lds + PG8_SA(b, h) + aoff + m * 2048 + k * 1024); } while (0)
#define PG8_LDB(dst, b, h) do { _Pragma("unroll") for (int n = 0; n < 2; ++n) _Pragma("unroll") for (int k = 0; k < 2; ++k) dst[n][k] = *(const PG8_LAS bf16x8*)(lds + PG8_SB(b, h) + boff + n * 2048 + k * 1024); } while (0)
#define PG8_MMA(ai, bj, At, Bt) do { __builtin_amdgcn_s_setprio(1); _Pragma("unroll") for (int m = 0; m < 4; ++m) _Pragma("unroll") for (int n = 0; n < 2; ++n) _Pragma("unroll") for (int k = 0; k < 2; ++k) \
        acc[ai][bj][m][n] = __builtin_amdgcn_mfma_f32_16x16x32_bf16(Bt[n][k], At[m][k], acc[ai][bj][m][n], 0, 0, 0); __builtin_amdgcn_s_setprio(0); } while (0)
#define PG8_WAIT_V(n) asm volatile("s_waitcnt vmcnt(" #n ")" ::: "memory")
#define PG8_WAIT_L(n) asm volatile("s_waitcnt lgkmcnt(" #n ")" ::: "memory")
#define PG8_BAR __builtin_amdgcn_s_barrier()
#define PG8_SCHED __builtin_amdgcn_sched_barrier(0)
    Unit cur, nxt; int ui = 0;
    if (!S.next(0, cur)) return;
    f32x4 acc[2][2][4][2];
#pragma unroll
    for (int a = 0; a < 2; ++a)
#pragma unroll
        for (int b = 0; b < 2; ++b)
#pragma unroll
            for (int m = 0; m < 4; ++m)
#pragma unroll
                for (int n = 0; n < 2; ++n) acc[a][b][m][n] = (f32x4){0.f, 0.f, 0.f, 0.f};
    bf16x8 At[4][2], B0[2][2], B1[2][2];
    const char* cA = (const char*)g.A + (size_t)cur.pm * tstep + (size_t)cur.kofs * 2; const char* cB = (const char*)g.Bt + (size_t)cur.pn * tstep + (size_t)cur.kofs * 2;
    S.a_ready(cur);
    if constexpr (SP2) {
        PG8_STAGE(PG8_SB(0, 0), cB, voffB); PG8_STAGE(PG8_SB(0, 1), cB + hstep, voffB); PG8_STAGE(PG8_SA(0, 0), cA, voffA); PG8_STAGE(PG8_SA(0, 1), cA + hstep, voffA);
        if (wr == 1) PG8_BAR;
        PG8_WAIT_V(2); PG8_BAR;
        PG8_STAGE(PG8_SB(1, 0), cB + kstep, voffB); PG8_STAGE(PG8_SA(1, 0), cA + kstep, voffA); PG8_STAGE(PG8_SB(1, 1), cB + hstep + kstep, voffB);
        PG8_WAIT_V(6); PG8_BAR;
    } else {
        PG8_STAGE(PG8_SB(0, 0), cB, voffB); PG8_STAGE(PG8_SA(0, 0), cA, voffA); PG8_STAGE(PG8_SB(0, 1), cB + hstep, voffB); PG8_STAGE(PG8_SA(0, 1), cA + hstep, voffA);
        if (wr == 1) PG8_BAR;
        PG8_WAIT_V(4); PG8_BAR;
        PG8_STAGE(PG8_SB(1, 0), cB + kstep, voffB); PG8_STAGE(PG8_SA(1, 0), cA + kstep, voffA); PG8_STAGE(PG8_SB(1, 1), cB + hstep + kstep, voffB);
        PG8_WAIT_V(6); PG8_BAR;
    }
    for (;;) {
        const bool has_next = S.next(ui + 1, nxt);
        const char* nA = has_next ? (const char*)g.A + (size_t)nxt.pm * tstep + (size_t)nxt.kofs * 2 : cA; const char* nB = has_next ? (const char*)g.Bt + (size_t)nxt.pn * tstep + (size_t)nxt.kofs * 2 : cB;
        const int ntu = cur.kt ? cur.kt : nt;
        for (int t = 0; t < ntu; t += 2) {
            const bool last = (t == ntu - 2);
            const char* a1 = cA + (size_t)(t + 1) * kstep;
            const char* a2 = last ? nA : cA + (size_t)(t + 2) * kstep; const char* b2 = last ? nB : cB + (size_t)(t + 2) * kstep;
            const char* a3 = a2 + kstep; const char* b3 = b2 + kstep;
            if (last && has_next) S.a_ready(nxt);
            if constexpr (SP2) {
            PG8_LDB(B0, 0, 0); PG8_LDB(B1, 0, 1); PG8_SCHED; PG8_LDA(At, 0, 0); PG8_STAGE(PG8_SA(1, 1), a1 + hstep, voffA);
            PG8_WAIT_V(8); PG8_WAIT_L(0); PG8_BAR; PG8_MMA(0, 0, At, B0); PG8_MMA(0, 1, At, B1); PG8_BAR; PG8_SCHED;
            PG8_LDA(At, 0, 1); PG8_STAGE(PG8_SB(0, 0), b2, voffB); PG8_STAGE(PG8_SB(0, 1), b2 + hstep, voffB); PG8_STAGE(PG8_SA(0, 0), a2, voffA);
            PG8_WAIT_V(8); PG8_WAIT_L(0); PG8_BAR; PG8_MMA(1, 0, At, B0); PG8_MMA(1, 1, At, B1); PG8_BAR; PG8_SCHED;
            PG8_LDB(B0, 1, 0); PG8_LDB(B1, 1, 1); PG8_SCHED; PG8_LDA(At, 1, 0); PG8_STAGE(PG8_SA(0, 1), a2 + hstep, voffA);
            PG8_WAIT_V(8); PG8_WAIT_L(0); PG8_BAR; PG8_MMA(0, 0, At, B0); PG8_MMA(0, 1, At, B1); PG8_BAR; PG8_SCHED;
            PG8_LDA(At, 1, 1); PG8_STAGE(PG8_SB(1, 0), b3, voffB); PG8_STAGE(PG8_SB(1, 1), b3 + hstep, voffB); PG8_STAGE(PG8_SA(1, 0), a3, voffA);
            PG8_WAIT_V(8); PG8_WAIT_L(0); PG8_BAR; PG8_MMA(1, 0, At, B0); PG8_MMA(1, 1, At, B1); PG8_BAR; PG8_SCHED;
            } else {
            PG8_LDB(B0, 0, 0); PG8_SCHED; PG8_LDA(At, 0, 0); PG8_STAGE(PG8_SA(1, 1), a1 + hstep, voffA);
            PG8_WAIT_L(8); PG8_BAR; PG8_WAIT_L(0); PG8_MMA(0, 0, At, B0); PG8_BAR; PG8_SCHED;
            PG8_LDB(B1, 0, 1); PG8_STAGE(PG8_SB(0, 0), b2, voffB);
            PG8_BAR; PG8_WAIT_L(0); PG8_MMA(0, 1, At, B1); PG8_BAR;
            PG8_LDA(At, 0, 1); PG8_STAGE(PG8_SA(0, 0), a2, voffA);
            PG8_BAR; PG8_WAIT_L(0); PG8_MMA(1, 0, At, B0); PG8_BAR; PG8_SCHED;
            PG8_STAGE(PG8_SB(0, 1), b2 + hstep, voffB);
            PG8_WAIT_V(6); PG8_BAR; PG8_MMA(1, 1, At, B1); PG8_BAR;
            PG8_LDB(B0, 1, 0); PG8_SCHED; PG8_LDA(At, 1, 0); PG8_STAGE(PG8_SA(0, 1), a2 + hstep, voffA);
            PG8_WAIT_L(8); PG8_BAR; PG8_WAIT_L(0); PG8_MMA(0, 0, At, B0); PG8_BAR; PG8_SCHED;
            PG8_LDB(B1, 1, 1); PG8_STAGE(PG8_SB(1, 0), b3, voffB);
            PG8_BAR; PG8_WAIT_L(0); PG8_MMA(0, 1, At, B1); PG8_BAR;
            PG8_LDA(At, 1, 1); PG8_STAGE(PG8_SA(1, 0), a3, voffA);
            PG8_BAR; PG8_WAIT_L(0); PG8_MMA(1, 0, At, B0); PG8_BAR; PG8_SCHED;
            PG8_STAGE(PG8_SB(1, 1), b3 + hstep, voffB);
            PG8_WAIT_V(6); PG8_BAR; PG8_MMA(1, 1, At, B1); PG8_BAR;
            }
        }
        if constexpr (ALIGN_EPI) { if (wr == 0) PG8_BAR; }
        if constexpr (!Epi::AFTER_DRAIN) { PG8_PS_BEGIN(); E(acc, cur, wr, wc, fr, fq); S.done(cur); PG8_PS_END(); }
        if (!has_next) break;
#pragma unroll
        for (int a = 0; a < 2; ++a)
#pragma unroll
            for (int b = 0; b < 2; ++b)
#pragma unroll
                for (int m = 0; m < 4; ++m)
#pragma unroll
                    for (int n = 0; n < 2; ++n) acc[a][b][m][n] = (f32x4){0.f, 0.f, 0.f, 0.f};
        cur = nxt; cA = nA; cB = nB; ++ui;
        if constexpr (ALIGN_EPI) { if (wr == 1) PG8_BAR; }
    }
    PG8_WAIT_V(0);
    if constexpr (!ALIGN_EPI) { if (wr == 0) PG8_BAR; }
    PG8_BAR;
    if constexpr (Epi::AFTER_DRAIN) { E.fused(acc, cur, wr, wc, fr, fq, lds, wid, lane); S.done(cur); }
#undef PG8_SA
#undef PG8_SB
#undef PG8_STAGE
#undef PG8_LDA
#undef PG8_LDB
#undef PG8_MMA
#undef PG8_WAIT_V
#undef PG8_WAIT_L
#undef PG8_BAR
#undef PG8_SCHED
}
}
constexpr int DM = 1024, NB = 4, SEQ = 4096, NCTX = 256, DFF = 2816, DIN = 4112, NPROJ = 4096, NMODC = 9216;
constexpr int LDP = 4224;
constexpr int MLAT = NB * SEQ, MCTX = NB * NCTX, MALL = MLAT + MCTX;
constexpr float EPSN = 1e-6f;
constexpr int NWAVES = 8, NTHREADS = 512;
#ifndef ONE_LAUNCH
#define ONE_LAUNCH 1
#endif
constexpr int NPHASES = 15;

constexpr size_t MiB = 1u << 20;
constexpr size_t WS_CTL = 0, CTL_ZERO_BYTES = 64 * 1024;
constexpr size_t WS_MODS = 1 * MiB;
constexpr size_t WS_GATES = 1 * MiB + 512 * 1024;
constexpr size_t WS_W1 = 3 * MiB;
constexpr size_t WS_W2 = 14 * MiB;
constexpr size_t WS_WIN = 20 * MiB;
constexpr size_t WS_WOUT = 28 * MiB;
constexpr size_t WS_XN = 34 * MiB;
constexpr size_t WS_PROJ = 68 * MiB;
constexpr size_t WS_QK = 209 * MiB;
constexpr size_t WS_END = 256 * MiB;
constexpr size_t WS_HGST = 237 * MiB;
constexpr size_t WS_HGG = 253 * MiB;
constexpr size_t WS_WG = 2 * MiB + 640 * 1024;
constexpr size_t WS_MLST = 226 * MiB;
constexpr size_t WS_MLSC = 236 * MiB;
constexpr size_t WS_SLAB = 204 * MiB;
constexpr size_t WS_SLAB2 = 237 * MiB;
constexpr int CW_BAR = 1024;

constexpr int RING_BYTES = 131072;
constexpr int LDSCTL_OFF = 162816, MISC_OFF = LDSCTL_OFF + 320;
constexpr int LDS_BYTES = 163840;

#define GAS __attribute__((address_space(1)))
#define LAS __attribute__((address_space(3)))
typedef unsigned short bf16;
typedef unsigned v4u __attribute__((ext_vector_type(4)));
typedef unsigned v2u __attribute__((ext_vector_type(2)));
typedef float f32x4 __attribute__((ext_vector_type(4)));
#define LDS_WAIT() asm volatile("s_waitcnt lgkmcnt(0)" ::: "memory")
#define VM_WAIT() asm volatile("s_waitcnt vmcnt(0)" ::: "memory")
__device__ __forceinline__ unsigned f2bf(float f) { unsigned u = __builtin_bit_cast(unsigned, f); return (u + 0x7fffu + ((u >> 16) & 1u)) >> 16; }
__device__ __forceinline__ unsigned pk2(float lo, float hi) { return f2bf(lo) | (f2bf(hi) << 16); }
__device__ __forceinline__ float bf2f(unsigned short h) { return __builtin_bit_cast(float, (unsigned)h << 16); }
__device__ __forceinline__ float bflo(unsigned w) { return __builtin_bit_cast(float, w << 16); }
__device__ __forceinline__ float bfhi(unsigned w) { return __builtin_bit_cast(float, w & 0xffff0000u); }
__device__ __forceinline__ float sigmoidf_(float v) { return 1.0f / (1.0f + __expf(-v)); }
__device__ __forceinline__ float fast_sig(float v) { return __builtin_amdgcn_rcpf(1.0f + __builtin_amdgcn_exp2f(-1.4426950408889634f * v)); }
__device__ __forceinline__ float siluf_(float v) { return v * sigmoidf_(v); }
__device__ __forceinline__ float wave_sum(float v) {
#pragma unroll
    for (int o = 1; o < 64; o <<= 1) v += __shfl_xor(v, o);
    return v;
}

#ifndef PROF_S
#define PROF_S -1
#endif
#define PS_BEGIN() do { if (PROF_S >= 0 && blockIdx.x == 0 && threadIdx.x == 0) { const unsigned long long t_ = __builtin_amdgcn_s_memrealtime(); volatile LAS unsigned* M_ = (volatile LAS unsigned*)(T.lds + MISC_OFF); M_[20] = (unsigned)t_; M_[21] = (unsigned)(t_ >> 32); } } while (0)
#define PS_END(id) do { if (PROF_S >= 0 && blockIdx.x == 0 && threadIdx.x == 0) { const unsigned long long t_ = __builtin_amdgcn_s_memrealtime(); volatile LAS unsigned* M_ = (volatile LAS unsigned*)(T.lds + MISC_OFF); \
    if ((id) == PROF_S) { const unsigned long long p_ = ((unsigned long long)M_[21] << 32) | M_[20]; const unsigned long long a_ = (((unsigned long long)M_[23] << 32) | M_[22]) + (t_ - p_); M_[22] = (unsigned)a_; M_[23] = (unsigned)(a_ >> 32); } \
    M_[20] = (unsigned)t_; M_[21] = (unsigned)(t_ >> 32); } } while (0)
#define XB_TMO      128
#define XB_XCNT(j)  (256  + 64 * (j))
#define XB_XSUB(j)  (1280 + 64 * (j))
#define XB_XGEN(j)  (2304 + 64 * (j))
#define XB_TOP      3328
#define XB_TOPGEN   3392
#define XCD_BAR_WORDS 3456
#define XB_SPIN_CAP (1u << 18)

__device__ __forceinline__ unsigned xb_ld(unsigned* p)              { return __hip_atomic_load(p, __ATOMIC_RELAXED, __HIP_MEMORY_SCOPE_AGENT); }
__device__ __forceinline__ unsigned xb_add(unsigned* p, unsigned v) { return __hip_atomic_fetch_add(p, v, __ATOMIC_RELAXED, __HIP_MEMORY_SCOPE_AGENT); }
__device__ __forceinline__ unsigned xb_xcc_id() { return (unsigned)__builtin_amdgcn_s_getreg((3 << 11) | 20) & 0xFu; }
#define XB_SPIN(cond, bar) do { unsigned _sp = 0; while (cond) { __builtin_amdgcn_s_sleep(1); \
    if ((++_sp & 255u) == 0u) { if (xb_ld(&(bar)[XB_TMO])) break; if (_sp > XB_SPIN_CAP) { atomicAdd(&(bar)[XB_TMO], 1u); break; } } } } while (0)

struct XcdBarrier {
    unsigned* bar; unsigned x;
    volatile LAS unsigned* st;
};

__device__ __forceinline__ XcdBarrier xcd_barrier_post(unsigned* bar, volatile LAS unsigned* st) {
    XcdBarrier b; b.bar = bar; b.x = xb_xcc_id(); b.st = st;
    if (threadIdx.x == 0) (void)xb_add(&bar[XB_XCNT(b.x)], 1u);
    return b;
}
__device__ __forceinline__ void xcd_barrier_complete(unsigned* bar, unsigned x, unsigned& nloc, unsigned& nx) {
    const unsigned G = gridDim.x * gridDim.y * gridDim.z;
    unsigned sum, cnt, mine, sp = 0u;
    for (;;) {
        sum = 0u; cnt = 0u; mine = 0u;
#pragma unroll
        for (unsigned j = 0; j < 16; ++j) { const unsigned c = xb_ld(&bar[XB_XCNT(j)]); sum += c; cnt += (c > 0u) ? 1u : 0u; mine = (j == x) ? c : mine; }
        if (sum == G) break;
        __builtin_amdgcn_s_sleep(1);
        if ((++sp & 255u) == 0u) { if (xb_ld(&bar[XB_TMO])) break; if (sp > XB_SPIN_CAP) { atomicAdd(&bar[XB_TMO], 1u); break; } }
    }
    nloc = mine > 0u ? mine : 1u; nx = cnt > 0u ? cnt : 1u;
}

__device__ __forceinline__ void xcd_barrier(const XcdBarrier& b) {
    asm volatile("s_waitcnt vmcnt(0)" ::: "memory");
    __syncthreads();
    if (threadIdx.x == 0) {
        unsigned* bar = b.bar;
        __builtin_amdgcn_s_waitcnt(0);
        unsigned nloc = b.st[0], nx = b.st[1];
        if (nloc == 0u) { xcd_barrier_complete(bar, b.x, nloc, nx); b.st[0] = nloc; b.st[1] = nx; }
        const unsigned old = xb_add(&bar[XB_XSUB(b.x)], 1u);
        const unsigned gen = old / nloc;
        if (old + 1u == (gen + 1u) * nloc) {
            __builtin_amdgcn_fence(__ATOMIC_RELEASE, "agent");
            asm volatile("s_waitcnt vmcnt(0)" ::: "memory");
            const unsigned og = xb_add(&bar[XB_TOP], 1u);
            const unsigned tg = og / nx;
            if (og + 1u == (tg + 1u) * nx) xb_add(&bar[XB_TOPGEN], 1u);
            else XB_SPIN(xb_ld(&bar[XB_TOPGEN]) == tg, bar);
            __builtin_amdgcn_fence(__ATOMIC_ACQUIRE, "agent");
            xb_add(&bar[XB_XGEN(b.x)], 1u);
            asm volatile("s_waitcnt vmcnt(0)" ::: "memory");
        } else {
            XB_SPIN(xb_ld(&bar[XB_XGEN(b.x)]) == gen, bar);
            __builtin_amdgcn_fence(__ATOMIC_ACQUIRE, "agent");
            asm volatile("s_waitcnt vmcnt(0)" ::: "memory");
        }
    }
    __syncthreads();
}
struct Args {
    const float* in[22]; float* out; unsigned char* ws; int ph_lo, ph_hi;
};
enum { I_X = 0, I_C, I_CTX, I_CCTX, I_WMOD, I_BMOD, I_N1W, I_F1W1, I_F1W2, I_N2W, I_WIN, I_MLGB, I_CONVW, I_CONVB, I_LBLOG, I_HGNW, I_MLNW, I_WOUT, I_N3W, I_F2W1, I_F2W2, I_FNW };

struct Ctx {
    LAS unsigned char* lds;
    int tid, lane, wave, vcu, G, gw, NGW;
};

__device__ __forceinline__ void mods_phase(const Args& a, const Ctx& T) {
    LAS float* sL = (LAS float*)T.lds;
    LAS float* red = (LAS float*)(T.lds + 20480);
    const float* c = a.in[I_C]; const float* cc = a.in[I_CCTX];
    for (int i = T.tid; i < 5 * 1024; i += NTHREADS) { const int r = i >> 10, k = i & 1023; const float v = r < 4 ? c[r * 1024 + k] : cc[k]; sL[i] = siluf_(v); }
    __syncthreads();
    typedef float f2 __attribute__((ext_vector_type(2)));
    for (int item = T.vcu; item < 576; item += T.G) {
        const int cb = item >> 3, kr = item & 7; const int k0 = kr * 128 + T.wave * 16;
        const float* W = a.in[I_WMOD] + (size_t)k0 * NMODC + cb * 128 + 2 * T.lane;
        f2 wv[16];
#pragma unroll
        for (int k = 0; k < 16; ++k) wv[k] = __builtin_nontemporal_load((const f2*)(W + (size_t)k * NMODC));
        float acc[5][2];
#pragma unroll
        for (int r = 0; r < 5; ++r) { acc[r][0] = 0.f; acc[r][1] = 0.f; }
#pragma unroll
        for (int k = 0; k < 16; ++k)
#pragma unroll
            for (int r = 0; r < 5; ++r) { const float s = sL[r * 1024 + k0 + k]; acc[r][0] += s * wv[k].x; acc[r][1] += s * wv[k].y; }
#pragma unroll
        for (int r = 0; r < 5; ++r) *(LAS f2*)(red + (T.wave * 5 + r) * 128 + 2 * T.lane) = (f2){acc[r][0], acc[r][1]};
        __syncthreads();
        for (int o = T.tid; o < 640; o += NTHREADS) { const int r = o >> 7, cl = o & 127; float s = 0.f;
#pragma unroll
            for (int w = 0; w < 8; ++w) s += red[(w * 5 + r) * 128 + cl];
            const int col = cb * 128 + cl; if (kr == 0) s += a.in[I_BMOD][col];
            atomicAdd((float*)(a.ws + WS_MODS) + r * NMODC + col, s); }
        __syncthreads();
    }
}

__device__ __forceinline__ void transpose_item(const float* W, int ldw, int K, bf16* WT, int k0, int n0, int dest_row0, LAS float* scr, int lane) {
    float tv[32];
#pragma unroll
    for (int i = 0; i < 32; ++i) tv[i] = __builtin_nontemporal_load(W + (size_t)(k0 + 2 * i + (lane >> 5)) * ldw + n0 + (lane & 31));
#pragma unroll
    for (int i = 0; i < 32; ++i) scr[(2 * i + (lane >> 5)) * 33 + (lane & 31)] = tv[i];
    LDS_WAIT(); asm volatile("" ::: "memory");
    const int c = lane & 7;
#pragma unroll
    for (int j = 0; j < 4; ++j) { const int n = (lane >> 3) + 8 * j; const LAS float* s = scr + (8 * c) * 33 + n;
        v4u o; o.x = pk2(s[0 * 33], s[1 * 33]); o.y = pk2(s[2 * 33], s[3 * 33]); o.z = pk2(s[4 * 33], s[5 * 33]); o.w = pk2(s[6 * 33], s[7 * 33]);
        *(GAS v4u*)(WT + (size_t)(dest_row0 + n) * K + k0 + 8 * c) = o; }
    LDS_WAIT(); asm volatile("" ::: "memory");
}
__device__ __forceinline__ void convert_ffn(const Args& a, const Ctx& T, const float* w1, const float* w2) {
    LAS float* scr = (LAS float*)(T.lds + T.wave * 16384);
    bf16* W1 = (bf16*)(a.ws + WS_W1); bf16* W2 = (bf16*)(a.ws + WS_W2);
    constexpr int I1 = 16 * 176, I2 = 44 * 32;
    for (int it = T.gw; it < I1 + I2; it += T.NGW) {
        if (it < I1) { const int kb = it / 176, nb = it % 176, n0 = nb * 32;
            const int dest = n0 < DFF ? (n0 >> 7) * 256 + (n0 & 127) : ((n0 - DFF) >> 7) * 256 + 128 + ((n0 - DFF) & 127);
            transpose_item(w1, 2 * DFF, DM, W1, kb * 64, n0, dest, scr, T.lane); }
        else { const int r = it - I1, kb = r / 32, nb = r % 32; transpose_item(w2, DM, DFF, W2, kb * 64, nb * 32, nb * 32, scr, T.lane); }
    }
}
__device__ __forceinline__ void convert_mix(const Args& a, const Ctx& T) {
    LAS float* scr = (LAS float*)(T.lds + T.wave * 16384);
    bf16* WI = (bf16*)(a.ws + WS_WIN); bf16* WO = (bf16*)(a.ws + WS_WOUT);
    constexpr int I1 = 16 * 128, I2 = 16 * 32;
    for (int it = T.gw; it < I1 + I2; it += T.NGW) {
        if (it < I1) { const int kb = it / 128, nb = it % 128; transpose_item(a.in[I_WIN], DIN, DM, WI, kb * 64, nb * 32, nb * 32, scr, T.lane); }
        else { const int r = it - I1, kb = r / 32, nb = r % 32; transpose_item(a.in[I_WOUT], DM, DM, WO, kb * 64, nb * 32, nb * 32, scr, T.lane); }
    }
}

__device__ __forceinline__ void norm_load_row(f32x4 (&v)[4], const void* src_lat, bool latbf, const float* src_ctx, int m, int lane) {
    if (m < MLAT) {
        if (latbf) { const v2u* xr = (const v2u*)((const bf16*)src_lat + (size_t)m * DM) + lane;
#pragma unroll
            for (int j = 0; j < 4; ++j) { const v2u w = xr[64 * j]; v[j] = (f32x4){bflo(w.x), bfhi(w.x), bflo(w.y), bfhi(w.y)}; } }
        else { const f32x4* xr = (const f32x4*)((const float*)src_lat + (size_t)m * DM) + lane;
#pragma unroll
            for (int j = 0; j < 4; ++j) v[j] = xr[64 * j]; }
    } else { const f32x4* xr = (const f32x4*)(src_ctx + (size_t)(m - MLAT) * DM) + lane;
#pragma unroll
        for (int j = 0; j < 4; ++j) v[j] = xr[64 * j]; }
}
template <bool CTXSLAB, bool LATBF>
__device__ __forceinline__ void norm_mod_rows(const Args& a, const Ctx& T, const void* src_lat, const float* src_ctx, int nrows, const float* nw, int shift_idx, int scale_idx) {
    const float* mods = (const float*)(a.ws + WS_MODS);
    bf16* XN = (bf16*)(a.ws + WS_XN);
    f32x4 wv[4];
#pragma unroll
    for (int j = 0; j < 4; ++j) wv[j] = *((const f32x4*)nw + T.lane + 64 * j);
    f32x4 v[4];
    if (T.gw < nrows) norm_load_row(v, src_lat, LATBF, src_ctx, T.gw, T.lane);
    for (int m = T.gw; m < nrows; m += T.NGW) {
        const float* mr = mods + (size_t)(m < MLAT ? (m >> 12) : 4) * NMODC;
        f32x4 sh[4], sc[4];
#pragma unroll
        for (int j = 0; j < 4; ++j) { sh[j] = *((const f32x4*)(mr + shift_idx * 1024) + T.lane + 64 * j); sc[j] = *((const f32x4*)(mr + scale_idx * 1024) + T.lane + 64 * j); }
        f32x4 cur[4]; float s = 0.f;
        if (CTXSLAB && m >= MLAT) {
            const float* gr = mods + (size_t)4 * NMODC + 2 * 1024;
#pragma unroll
            for (int j = 0; j < 4; ++j) { f32x4 acc = (f32x4){0.f, 0.f, 0.f, 0.f};
#pragma unroll 1
                for (int ks = 0; ks < 11; ++ks) { const v2u sw_ = *((const v2u*)((const bf16*)(a.ws + WS_SLAB) + ((size_t)ks * 1024 + (m - MLAT)) * 1024) + T.lane + 64 * j); acc += (f32x4){bflo(sw_.x), bfhi(sw_.x), bflo(sw_.y), bfhi(sw_.y)}; }
                v[j] = v[j] + acc * (*((const f32x4*)gr + T.lane + 64 * j) * 0.5f); }
        }
#pragma unroll
        for (int j = 0; j < 4; ++j) { cur[j] = v[j]; s += (v[j].x * v[j].x + v[j].y * v[j].y) + (v[j].z * v[j].z + v[j].w * v[j].w); }
        { const int mn = m + T.NGW; if (mn < nrows) norm_load_row(v, src_lat, LATBF, src_ctx, mn, T.lane); }
        const float rstd = __builtin_amdgcn_rsqf(wave_sum(s) * (1.f / DM) + EPSN);
        unsigned long long* o8 = (unsigned long long*)(XN + (size_t)m * DM) + T.lane;
#pragma unroll
        for (int j = 0; j < 4; ++j) { const f32x4 y = (cur[j] * rstd * wv[j]) * (sc[j] + 1.0f) + sh[j];
            o8[64 * j] = (unsigned long long)pk2(y.x, y.y) | ((unsigned long long)pk2(y.z, y.w) << 32); }
    }
}

struct ConvTaps { v4u t[9]; };
__device__ __forceinline__ void conv_load(ConvTaps& R, const bf16* P, int m, int ch0) {
    const v4u z = (v4u){0u, 0u, 0u, 0u};
    const int b = m >> 12, t = m & 4095, r = t >> 6, c = t & 63;
#pragma unroll
    for (int dr = -1; dr <= 1; ++dr)
#pragma unroll
        for (int dc = -1; dc <= 1; ++dc) { const int rr = r + dr, c2 = c + dc; const bool ok = rr >= 0 && rr < 64 && c2 >= 0 && c2 < 64;
            R.t[(dr + 1) * 3 + dc + 1] = ok ? *(const v4u*)(P + (size_t)(b * 4096 + rr * 64 + c2) * LDP + 2560 + ch0) : z; }
}
__device__ __forceinline__ void ctx_combine(const Args& a, const Ctx& T) {
    const bf16* S2 = (const bf16*)(a.ws + WS_SLAB2); bf16* P = (bf16*)(a.ws + WS_PROJ);
    for (int task = T.vcu * NTHREADS + T.tid; task < 1024 * 256; task += T.G * NTHREADS) {
        const int r = task >> 8, q = task & 255; const int t8 = q >> 5, c8 = (q & 31) * 8; const int t9 = t8 < 6 ? t8 : t8 + 1;
        const int pn = t9 < 2 ? 2 + t9 : (t9 < 6 ? 4 + t9 : 5 + t9);
        float s[8] = {0.f, 0.f, 0.f, 0.f, 0.f, 0.f, 0.f, 0.f};
#pragma unroll
        for (int ks = 0; ks < 4; ++ks) { const v4u pv = *(const v4u*)(S2 + ((size_t)ks * 1024 + r) * 2304 + t9 * 256 + c8);
            s[0] += bflo(pv.x); s[1] += bfhi(pv.x); s[2] += bflo(pv.y); s[3] += bfhi(pv.y); s[4] += bflo(pv.z); s[5] += bfhi(pv.z); s[6] += bflo(pv.w); s[7] += bfhi(pv.w); }
        *(v4u*)(P + (size_t)(MLAT + r) * LDP + pn * 256 + c8) = (v4u){pk2(s[0], s[1]), pk2(s[2], s[3]), pk2(s[4], s[5]), pk2(s[6], s[7])};
    }
}
__device__ __forceinline__ void conv_phase(const Args& a, const Ctx& T) {
    const bf16* P = (const bf16*)(a.ws + WS_PROJ); bf16* QK = (bf16*)(a.ws + WS_QK);
    const float* cw = a.in[I_CONVW]; const float* cb = a.in[I_CONVB];
    const int gid = T.vcu * NTHREADS + T.tid; const int ch0 = (gid & 63) * 8; const int m0 = gid >> 6, mstep = (T.G * NTHREADS) >> 6;
    {
        float w[9][8], bias[8];
#pragma unroll
        for (int k = 0; k < 9; ++k)
#pragma unroll
            for (int i = 0; i < 8; ++i) w[k][i] = cw[k * 512 + ch0 + i];
#pragma unroll
        for (int i = 0; i < 8; ++i) bias[i] = cb[ch0 + i];
        const float sc = ch0 < 256 ? 0.125f : 1.0f;
        ConvTaps R;
        if (m0 < MLAT) conv_load(R, P, m0, ch0);
        for (int m = m0; m < MLAT; m += mstep) {
            float acc[8];
#pragma unroll
            for (int i = 0; i < 8; ++i) acc[i] = bias[i];
#pragma unroll
            for (int k = 0; k < 9; ++k) { const v4u pv = R.t[k];
                acc[0] += w[k][0] * bflo(pv.x); acc[1] += w[k][1] * bfhi(pv.x); acc[2] += w[k][2] * bflo(pv.y); acc[3] += w[k][3] * bfhi(pv.y);
                acc[4] += w[k][4] * bflo(pv.z); acc[5] += w[k][5] * bfhi(pv.z); acc[6] += w[k][6] * bflo(pv.w); acc[7] += w[k][7] * bfhi(pv.w); }
            if (m + mstep < MLAT) conv_load(R, P, m + mstep, ch0);
#pragma unroll
            for (int i = 0; i < 8; ++i) acc[i] = acc[i] * fast_sig(acc[i]) * sc;
            v4u o; o.x = pk2(acc[0], acc[1]); o.y = pk2(acc[2], acc[3]); o.z = pk2(acc[4], acc[5]); o.w = pk2(acc[6], acc[7]);
            *(v4u*)(QK + (size_t)m * 512 + ch0) = o;
        }
    }
    {
        const bf16* S2 = (const bf16*)(a.ws + WS_SLAB2);
#pragma unroll 1
        for (int task = gid; task < MCTX * 32; task += T.G * NTHREADS) {
            const int mc = task >> 5, c8 = (task & 31) * 8, b = mc >> 8, t = mc & 255;
            float acc[8];
#pragma unroll
            for (int i = 0; i < 8; ++i) acc[i] = cb[256 + c8 + i];
#pragma unroll 1
            for (int d = -1; d <= 1; ++d) { const int t2 = t + d; if (t2 < 0 || t2 >= 256) continue;
                float s[8] = {0.f, 0.f, 0.f, 0.f, 0.f, 0.f, 0.f, 0.f};
#pragma unroll
                for (int ks = 0; ks < 4; ++ks) { const v4u pv = *(const v4u*)(S2 + ((size_t)ks * 1024 + b * 256 + t2) * 2304 + 6 * 256 + c8);
                    s[0] += bflo(pv.x); s[1] += bfhi(pv.x); s[2] += bflo(pv.y); s[3] += bfhi(pv.y); s[4] += bflo(pv.z); s[5] += bfhi(pv.z); s[6] += bflo(pv.w); s[7] += bfhi(pv.w); }
                const float* wk = cw + (3 + d + 1) * 512 + 256 + c8;
#pragma unroll
                for (int i = 0; i < 8; ++i) acc[i] += wk[i] * bf2f((unsigned short)f2bf(s[i])); }
#pragma unroll
            for (int i = 0; i < 8; ++i) acc[i] = acc[i] * fast_sig(acc[i]);
            v4u o; o.x = pk2(acc[0], acc[1]); o.y = pk2(acc[2], acc[3]); o.z = pk2(acc[4], acc[5]); o.w = pk2(acc[6], acc[7]);
            *(v4u*)(QK + (size_t)(MLAT + mc) * 512 + 256 + c8) = o;
        }
    }
}

typedef short bf16x8 __attribute__((ext_vector_type(8)));
typedef float f32x2 __attribute__((ext_vector_type(2)));
#define MFMA16(a, b, c) __builtin_amdgcn_mfma_f32_16x16x32_bf16((a), (b), (c), 0, 0, 0)
template <int KSTEPS>
__device__ __forceinline__ void mma_tile(f32x4& acc, const LAS unsigned char* A, int sa, const LAS unsigned char* B, int sb, int lane) {
    const LAS unsigned char* pa = A + (lane & 15) * sa + (lane >> 4) * 16; const LAS unsigned char* pb = B + (lane & 15) * sb + (lane >> 4) * 16;
#pragma unroll
    for (int ks = 0; ks < KSTEPS; ++ks) { const bf16x8 av = *(const LAS bf16x8*)(pa + ks * 64); const bf16x8 bv = *(const LAS bf16x8*)(pb + ks * 64); acc = MFMA16(av, bv, acc); }
}
typedef __bf16 bf16x2_t __attribute__((ext_vector_type(2)));
__device__ __forceinline__ unsigned cvtpk(float lo, float hi) { const f32x2 v = {lo, hi}; const bf16x2_t b = __builtin_convertvector(v, bf16x2_t); return __builtin_bit_cast(unsigned, b); }
struct BF2 { bf16x8 k0, k1; };
struct BF4 { bf16x8 k0, k1, k2, k3; };
__device__ __forceinline__ BF2 ldfrag2(const LAS unsigned char* B, int sb, int lane) { const LAS unsigned char* p = B + (lane & 15) * sb + (lane >> 4) * 16; BF2 f; f.k0 = *(const LAS bf16x8*)p; f.k1 = *(const LAS bf16x8*)(p + 64); return f; }
__device__ __forceinline__ BF4 ldfrag4(const LAS unsigned char* B, int sb, int lane) { const LAS unsigned char* p = B + (lane & 15) * sb + (lane >> 4) * 16; BF4 f; f.k0 = *(const LAS bf16x8*)p; f.k1 = *(const LAS bf16x8*)(p + 64); f.k2 = *(const LAS bf16x8*)(p + 128); f.k3 = *(const LAS bf16x8*)(p + 192); return f; }
__device__ __forceinline__ void mma2(f32x4& acc, const LAS unsigned char* A, int sa, const BF2& b, int lane) { const LAS unsigned char* p = A + (lane & 15) * sa + (lane >> 4) * 16;
    acc = MFMA16(*(const LAS bf16x8*)p, b.k0, acc); acc = MFMA16(*(const LAS bf16x8*)(p + 64), b.k1, acc); }
__device__ __forceinline__ void mma4(f32x4& acc, const LAS unsigned char* A, int sa, const BF4& b, int lane) { const LAS unsigned char* p = A + (lane & 15) * sa + (lane >> 4) * 16;
    acc = MFMA16(*(const LAS bf16x8*)p, b.k0, acc); acc = MFMA16(*(const LAS bf16x8*)(p + 64), b.k1, acc); acc = MFMA16(*(const LAS bf16x8*)(p + 128), b.k2, acc); acc = MFMA16(*(const LAS bf16x8*)(p + 192), b.k3, acc); }
__device__ __forceinline__ float ex2(float v) { return __builtin_amdgcn_exp2f(v); }
__device__ __forceinline__ float lg2(float v) { return __builtin_amdgcn_logf(v); }

constexpr int HS_ND = 272;
constexpr int HS_T = 160;
constexpr int HL_QD = 0, HL_KD = HL_QD + 64 * HS_ND, HL_X = HL_KD + 64 * HS_ND, HL_QE = HL_X + 64 * HS_ND;
constexpr int HL_KTT = HL_QE + 64 * HS_ND;
constexpr int HL_VT = HL_KTT + 128 * HS_T;
constexpr int HL_ST = HL_VT + 128 * HS_T;
constexpr int HL_P = HL_ST + 128 * HS_ND;
constexpr int HL_SEG = HL_P + 64 * HS_T;
constexpr int HL_FAC = HL_SEG + 4096;
constexpr int HL_NW = HL_FAC + 512;
constexpr int HL_END = HL_NW + 512;
constexpr int HL_OT = HL_QD, OT_S = 132 * 4;
static_assert(64 * OT_S <= 2 * 64 * HS_ND, "o tile overlay");
static_assert(HL_END <= 160 * 1024 - 1024, "HGRN2 LDS map");

constexpr size_t HG_SLOT_BYTES = 128 * 128 * 2;
__device__ __forceinline__ size_t hg_seq(int b, int dir, int head) { return (size_t)((b * 2 + dir) * 4 + head); }

__device__ __forceinline__ int sc_row(int b, int dir, int js, int lt) {
    if (js == 0) return MLAT + b * NCTX + (dir ? NCTX - 1 - lt : lt);
    const int q = 256 * (js - 1) + lt; return b * SEQ + (dir ? SEQ - 1 - q : q);
}

constexpr int P1_S = 544;
constexpr int P1_KTT = 0, P1_VT = P1_KTT + 128 * P1_S, P1_SEG = P1_VT + 128 * P1_S, P1_END = P1_SEG + 4096;
static_assert(P1_END <= 159 * 1024, "pass-1 LDS map");
__device__ __forceinline__ int p1_row(int b, int blk, int lt) { return blk < 0 ? MLAT + b * NCTX + lt : b * SEQ + 256 * blk + lt; }
template <int DIR>
__device__ __forceinline__ void hg_p1_dir(const Args& a, const Ctx& T, int b, int head, int blk, int slot, bool load_v) {
    const bf16* P = (const bf16*)(a.ws + WS_PROJ);
    LAS unsigned char* L = T.lds;
    const int w = T.wave, l = T.lane, g = l >> 4, c16 = l & 15;
    const int ch = head * 128 + 2 * l;
    const float* lbl = a.in[I_LBLOG];
    float lb[2];
#pragma unroll
    for (int x = 0; x < 2; ++x) lb[x] = sigmoidf_(lbl[DIR * 512 + ch + x] - lbl[(2 + DIR) * 512 + ch + x]);
    unsigned fw[32];
#pragma unroll
    for (int i = 0; i < 32; ++i) fw[i] = *(const unsigned*)(P + (size_t)p1_row(b, blk, 32 * w + i) * LDP + (DIR ? 2048 : 1536) + ch);
    if (load_v) {
        unsigned vw[32];
#pragma unroll
        for (int i = 0; i < 32; ++i) vw[i] = *(const unsigned*)(P + (size_t)p1_row(b, blk, 32 * w + i) * LDP + 512 + ch);
#pragma unroll
        for (int x = 0; x < 2; ++x)
#pragma unroll
            for (int q = 0; q < 4; ++q) { unsigned pv[4];
#pragma unroll
                for (int i = 0; i < 8; i += 2) { const unsigned v0 = x ? (vw[8 * q + i] >> 16) : (vw[8 * q + i] & 0xffffu), v1 = x ? (vw[8 * q + i + 1] >> 16) : (vw[8 * q + i + 1] & 0xffffu); pv[i >> 1] = v0 | (v1 << 16); }
                *(LAS v4u*)(L + P1_VT + (2 * l + x) * P1_S + 64 * w + 16 * q) = (v4u){pv[0], pv[1], pv[2], pv[3]}; }
    }
    float tot[2] = {0.f, 0.f};
#pragma unroll
    for (int i = 0; i < 32; ++i) {
        const float s0 = fast_sig(bflo(fw[i])), s1 = fast_sig(bfhi(fw[i]));
        tot[0] += lg2(lb[0] + (1.f - lb[0]) * s0); tot[1] += lg2(lb[1] + (1.f - lb[1]) * s1); }
    *(LAS f32x2*)(L + P1_SEG + (w * 128 + 2 * l) * 4) = (f32x2){tot[0], tot[1]};
    __syncthreads();
    float after[2] = {0.f, 0.f}, all[2] = {0.f, 0.f};
#pragma unroll
    for (int ww = 0; ww < 8; ++ww) { const f32x2 t2 = *(const LAS f32x2*)(L + P1_SEG + (ww * 128 + 2 * l) * 4); all[0] += t2.x; all[1] += t2.y;
        if (DIR ? (ww < w) : (ww > w)) { after[0] += t2.x; after[1] += t2.y; } }
#pragma unroll
    for (int x = 0; x < 2; ++x) {
        float run = after[x];
#pragma unroll
        for (int q = 0; q < 4; ++q) { float kv[8];
#pragma unroll
            for (int ii = 0; ii < 8; ++ii) { const int i = DIR ? 8 * q + ii : 31 - (8 * q + ii);
                const float fp = x ? bfhi(fw[i]) : bflo(fw[i]); const float sg = fast_sig(fp); const float f = lb[x] + (1.f - lb[x]) * sg;
                kv[ii] = (1.f - lb[x]) * (1.f - sg) * ex2(run); run += lg2(f); }
            if (DIR) *(LAS v4u*)(L + P1_KTT + (2 * l + x) * P1_S + 64 * w + 16 * q) = (v4u){cvtpk(kv[0], kv[1]), cvtpk(kv[2], kv[3]), cvtpk(kv[4], kv[5]), cvtpk(kv[6], kv[7])};
            else *(LAS v4u*)(L + P1_KTT + (2 * l + x) * P1_S + 64 * w + 16 * (3 - q)) = (v4u){cvtpk(kv[7], kv[6]), cvtpk(kv[5], kv[4]), cvtpk(kv[3], kv[2]), cvtpk(kv[1], kv[0])};
        }
    }
    __syncthreads();
    f32x4 accS[8];
#pragma unroll
    for (int m = 0; m < 8; ++m) accS[m] = (f32x4){0.f, 0.f, 0.f, 0.f};
#pragma unroll
    for (int kh = 0; kh < 4; ++kh) {
        const BF2 vf = ldfrag2(L + P1_VT + 16 * w * P1_S + 128 * kh, P1_S, l);
#pragma unroll
        for (int mh = 0; mh < 8; mh += 4) { BF2 kf[4];
#pragma unroll
            for (int m = 0; m < 4; ++m) kf[m] = ldfrag2(L + P1_KTT + 16 * (mh + m) * P1_S + 128 * kh, P1_S, l);
#pragma unroll
            for (int m = 0; m < 4; ++m) accS[mh + m] = MFMA16(kf[m].k0, vf.k0, accS[mh + m]);
#pragma unroll
            for (int m = 0; m < 4; ++m) accS[mh + m] = MFMA16(kf[m].k1, vf.k1, accS[mh + m]); } }
    const size_t sidx = hg_seq(b, DIR, head) * 16 + slot;
    bf16* ST = (bf16*)(a.ws + WS_HGST + sidx * HG_SLOT_BYTES);
#pragma unroll
    for (int m = 0; m < 8; ++m) { v2u o; o.x = cvtpk(accS[m][0], accS[m][1]); o.y = cvtpk(accS[m][2], accS[m][3]); *(v2u*)(ST + (size_t)(16 * w + c16) * 128 + 16 * m + 4 * g) = o; }
    if (w == 0) *(f32x2*)((float*)(a.ws + WS_HGG) + sidx * 128 + 2 * l) = (f32x2){ex2(all[0]), ex2(all[1])};
}
__device__ __forceinline__ void hg_pass1_items(const Args& a, const Ctx& T0, int first, int stride, int limit) {
#pragma unroll 1
    for (int item = first; item < limit; item += stride) {
        Ctx T = T0; asm volatile("" : "+v"(T.lane)); T.tid = T.wave * 64 + T.lane;
        const int k = item & 15, head = (item >> 4) & 3, b = item >> 6;
        const int blkF = k == 0 ? -1 : (k == 15 ? 0 : k), slotF = k == 0 ? 0 : (k == 15 ? 1 : k + 1);
        const int blkB = k == 0 ? -1 : (k == 15 ? 15 : k), slotB = k == 0 ? 0 : (k == 15 ? 1 : 16 - k);
        __syncthreads();
        hg_p1_dir<0>(a, T, b, head, blkF, slotF, true);
        __syncthreads();
        hg_p1_dir<1>(a, T, b, head, blkB, slotB, blkB != blkF);
    }
}

__device__ __forceinline__ void hg_pass2(const Args& a, const Ctx& T) {
    const int ntask = 32 * 2048;
    for (int task = T.vcu * NTHREADS + T.tid; task < ntask; task += T.G * NTHREADS) {
        const int seq = task >> 11, el = (task & 2047) * 8, d0 = el & 127;
        float r[8];
#pragma unroll
        for (int i = 0; i < 8; ++i) r[i] = 0.f;
        for (int j = 0; j < 16; ++j) {
            v4u* p = (v4u*)(a.ws + WS_HGST + ((size_t)seq * 16 + j) * HG_SLOT_BYTES + (size_t)el * 2);
            const float* G = (const float*)(a.ws + WS_HGG) + ((size_t)seq * 16 + j) * 128 + d0;
            const v4u dv = *p; const f32x4 g0 = *(const f32x4*)G, g1 = *(const f32x4*)(G + 4);
            r[0] = g0.x * r[0] + bflo(dv.x); r[1] = g0.y * r[1] + bfhi(dv.x); r[2] = g0.z * r[2] + bflo(dv.y); r[3] = g0.w * r[3] + bfhi(dv.y);
            r[4] = g1.x * r[4] + bflo(dv.z); r[5] = g1.y * r[5] + bfhi(dv.z); r[6] = g1.z * r[6] + bflo(dv.w); r[7] = g1.w * r[7] + bfhi(dv.w);
            *p = (v4u){pk2(r[0], r[1]), pk2(r[2], r[3]), pk2(r[4], r[5]), pk2(r[6], r[7])};
        }
    }
}

struct HgP3Pre { unsigned fw[8], qw[8], vw[8]; };
__device__ __forceinline__ void hg_p3_load(HgP3Pre& R, const bf16* P, int b, int head, int jt, int step, int w, int l) {
    const int dir = step >> 2, c = step & 3; const int ch = head * 128 + 2 * l;
#pragma unroll
    for (int i = 0; i < 8; ++i) { const int lt = 64 * c + 8 * w + i; const size_t row = (size_t)(b * SEQ + 256 * jt + (dir ? 255 - lt : lt));
        R.fw[i] = *(const unsigned*)(P + row * LDP + (dir ? 2048 : 1536) + ch); R.qw[i] = *(const unsigned*)(P + row * LDP + ch); R.vw[i] = *(const unsigned*)(P + row * LDP + 512 + ch); }
}
__device__ __forceinline__ void hg_pass3_item(const Args& a, const Ctx& T0, int item, bf16* OUT) {
    const int jt = item & 15, head = (item >> 4) & 3, b = item >> 6;
    const bf16* P = (const bf16*)(a.ws + WS_PROJ);
    Ctx T = T0; asm volatile("" : "+v"(T.lane));
    T.tid = T.wave * 64 + T.lane;
    LAS unsigned char* L = T.lds;
    const int w = T.wave, l = T.lane, g = l >> 4, c16 = l & 15;
    const int ch = head * 128 + 2 * l;
    const float* lbl = a.in[I_LBLOG];
    __syncthreads();
    for (int i = T.tid; i < 64 * HS_T / 16; i += NTHREADS) *(LAS v4u*)(L + HL_P + i * 16) = (v4u){0u, 0u, 0u, 0u};
    if (T.tid < 128) *(LAS float*)(L + HL_NW + T.tid * 4) = a.in[I_HGNW][head * 128 + T.tid];
    HgP3Pre R;
    hg_p3_load(R, P, b, head, jt, 0, w, l);
    v4u stq[4];
#define HG_STATE_LOAD(dir_) do { const bf16* STg_ = (const bf16*)(a.ws + WS_HGST + (hg_seq(b, (dir_), head) * 16 + ((dir_) ? 15 - jt : jt)) * HG_SLOT_BYTES); \
        _Pragma("unroll") for (int q_ = 0; q_ < 4; ++q_) { const int idx_ = l + 64 * q_; stq[q_] = *(const v4u*)(STg_ + (size_t)(16 * w + (idx_ >> 4)) * 128 + (idx_ & 15) * 8); } } while (0)
    HG_STATE_LOAD(0);
    f32x4 accS[8];
    float lb[2] = {0.f, 0.f};
    const int ot = T.tid >> 3, opart = T.tid & 7;
#pragma unroll 1
    for (int step = 0; step < 8; ++step) {
        const int dir = step >> 2, c = step & 3;
        PS_BEGIN();
        if (c == 0) {
#pragma unroll
            for (int x = 0; x < 2; ++x) lb[x] = sigmoidf_(lbl[dir * 512 + ch + x] - lbl[(2 + dir) * 512 + ch + x]);
            if (dir == 1) { HG_STATE_LOAD(1); VM_WAIT(); __syncthreads(); if (w == 0) { __builtin_amdgcn_fence(__ATOMIC_ACQUIRE, "agent"); VM_WAIT(); } __syncthreads(); }
#pragma unroll
            for (int q = 0; q < 4; ++q) { const int idx = l + 64 * q; *(LAS v4u*)(L + HL_ST + (16 * w + (idx >> 4)) * HS_ND + (idx & 15) * 16) = stq[q]; }
            LDS_WAIT();
#pragma unroll
            for (int m = 0; m < 8; ++m) { const v2u sv = *(const LAS v2u*)(L + HL_ST + (16 * w + c16) * HS_ND + (16 * m + 4 * g) * 2); accS[m] = (f32x4){bflo(sv.x), bfhi(sv.x), bflo(sv.y), bfhi(sv.y)}; }
        }
        PS_END(11);
        float kk[2][8], cl[2][8]; unsigned qw[8], vw[8];
#pragma unroll
        for (int i = 0; i < 8; ++i) { qw[i] = R.qw[i]; vw[i] = R.vw[i]; }
#pragma unroll
        for (int x = 0; x < 2; ++x) { float run = 0.f;
#pragma unroll
            for (int i = 0; i < 8; ++i) { const float fp = x ? bfhi(R.fw[i]) : bflo(R.fw[i]); const float sg = fast_sig(fp); const float f = lb[x] + (1.f - lb[x]) * sg;
                kk[x][i] = (1.f - lb[x]) * (1.f - sg); run += lg2(f); cl[x][i] = run; } }
        if (step < 7) hg_p3_load(R, P, b, head, jt, step + 1, w, l);
        *(LAS f32x2*)(L + HL_SEG + (w * 128 + 2 * l) * 4) = (f32x2){cl[0][7], cl[1][7]};
        PS_END(0); __syncthreads(); PS_END(1);
        const int half = w >> 2;
        float pre[2], mid[2], fx[2], fqe[2], fkt[2];
#pragma unroll
        for (int x = 0; x < 2; ++x) {
            float tt[8];
#pragma unroll
            for (int ww = 0; ww < 8; ++ww) tt[ww] = *(const LAS float*)(L + HL_SEG + (ww * 128 + 2 * l + x) * 4);
            const float r15 = tt[0] + tt[1], r31 = r15 + tt[2] + tt[3], r47 = r31 + tt[4] + tt[5], r63 = r47 + tt[6] + tt[7];
            float p = 0.f;
#pragma unroll
            for (int ww = 0; ww < 8; ++ww) if (ww < w) p += tt[ww];
            pre[x] = p; mid[x] = half ? r47 : r15;
            fx[x] = half ? ex2(r47 - r31) : ex2(r31 - r15); fqe[x] = ex2(mid[x]); fkt[x] = ex2(r63 - mid[x]);
            if (w == 0) *(LAS float*)(L + HL_FAC + (2 * l + x) * 4) = ex2(r63);
        }
        float ktv[2][8];
#pragma unroll
        for (int i = 0; i < 8; ++i) {
            float qd[2], kd[2], xv[2], qe[2];
#pragma unroll
            for (int x = 0; x < 2; ++x) { const float cc = pre[x] + cl[x][i] - mid[x]; const float eq = ex2(cc), ek = ex2(-cc); const float q = x ? bfhi(qw[i]) : bflo(qw[i]);
                qd[x] = q * eq; kd[x] = kk[x][i] * ek; xv[x] = (half ? qd[x] : kd[x]) * fx[x]; qe[x] = qd[x] * fqe[x]; ktv[x][i] = kd[x] * fkt[x]; }
            const int off = (8 * w + i) * HS_ND + 4 * l;
            *(LAS unsigned*)(L + HL_QD + off) = cvtpk(qd[0], qd[1]); *(LAS unsigned*)(L + HL_KD + off) = cvtpk(kd[0], kd[1]);
            *(LAS unsigned*)(L + HL_X + off) = cvtpk(xv[0], xv[1]); *(LAS unsigned*)(L + HL_QE + off) = cvtpk(qe[0], qe[1]);
        }
#pragma unroll
        for (int x = 0; x < 2; ++x) {
            unsigned pv[4];
#pragma unroll
            for (int i = 0; i < 8; i += 2) { const unsigned v0 = x ? (vw[i] >> 16) : (vw[i] & 0xffffu), v1 = x ? (vw[i + 1] >> 16) : (vw[i + 1] & 0xffffu); pv[i >> 1] = v0 | (v1 << 16); }
            *(LAS v4u*)(L + HL_KTT + (2 * l + x) * HS_T + 16 * w) = (v4u){cvtpk(ktv[x][0], ktv[x][1]), cvtpk(ktv[x][2], ktv[x][3]), cvtpk(ktv[x][4], ktv[x][5]), cvtpk(ktv[x][6], ktv[x][7])};
            *(LAS v4u*)(L + HL_VT + (2 * l + x) * HS_T + 16 * w) = (v4u){pv[0], pv[1], pv[2], pv[3]};
        }
        PS_END(0); __syncthreads(); PS_END(1);
        const size_t orow = (size_t)(b * SEQ + 256 * jt + (dir ? 255 - (64 * c + ot) : 64 * c + ot));
        bf16* optr = OUT + orow * DM + head * 128 + 16 * opart;
        v4u pf0 = (v4u){0u, 0u, 0u, 0u}, pf1 = pf0, pg0 = pf0, pg1 = pf0;
        if (dir) { pf0 = *(const v4u*)optr; pf1 = *(const v4u*)(optr + 8); const bf16* gp = P + orow * LDP + 1024 + head * 128 + 16 * opart; pg0 = *(const v4u*)gp; pg1 = *(const v4u*)(gp + 8); }
        v2u ptile[2]; int paddr[2] = {-1, -1};
#pragma unroll
        for (int rep = 0; rep < 2; ++rep) { const int tix = w + 8 * rep;
            if (tix < 10) {
                const int I = tix < 1 ? 0 : (tix < 3 ? 1 : (tix < 6 ? 2 : 3)); const int J = tix - (I * (I + 1)) / 2;
                const bool same = (I >> 1) == (J >> 1);
                const int abase = same ? HL_KD : HL_X, bbase = same ? HL_QD : HL_X;
                const BF4 af = ldfrag4(L + abase + 16 * J * HS_ND, HS_ND, l), bf = ldfrag4(L + bbase + 16 * I * HS_ND, HS_ND, l);
                f32x4 at = (f32x4){0.f, 0.f, 0.f, 0.f};
                at = MFMA16(af.k0, bf.k0, at); at = MFMA16(af.k1, bf.k1, at); at = MFMA16(af.k2, bf.k2, at); at = MFMA16(af.k3, bf.k3, at);
                const int tloc = 16 * I + c16, s0 = 16 * J + 4 * g;
                float pr[4];
#pragma unroll
                for (int r = 0; r < 4; ++r) pr[r] = (s0 + r <= tloc) ? at[r] : 0.f;
                ptile[rep].x = cvtpk(pr[0], pr[1]); ptile[rep].y = cvtpk(pr[2], pr[3]); paddr[rep] = HL_P + tloc * HS_T + s0 * 2;
            } }
        f32x4 accO[4];
        { const BF4 sf = ldfrag4(L + HL_ST + 16 * w * HS_ND, HS_ND, l);
#pragma unroll
            for (int I = 0; I < 4; ++I) accO[I] = (f32x4){0.f, 0.f, 0.f, 0.f};
#pragma unroll
            for (int ih = 0; ih < 4; ih += 2) {
                const BF4 q0 = ldfrag4(L + HL_QE + ih * 16 * HS_ND, HS_ND, l), q1 = ldfrag4(L + HL_QE + (ih + 1) * 16 * HS_ND, HS_ND, l);
                accO[ih] = MFMA16(q0.k0, sf.k0, accO[ih]); accO[ih + 1] = MFMA16(q1.k0, sf.k0, accO[ih + 1]);
                accO[ih] = MFMA16(q0.k1, sf.k1, accO[ih]); accO[ih + 1] = MFMA16(q1.k1, sf.k1, accO[ih + 1]);
                accO[ih] = MFMA16(q0.k2, sf.k2, accO[ih]); accO[ih + 1] = MFMA16(q1.k2, sf.k2, accO[ih + 1]);
                accO[ih] = MFMA16(q0.k3, sf.k3, accO[ih]); accO[ih + 1] = MFMA16(q1.k3, sf.k3, accO[ih + 1]); } }
        const BF2 vf = ldfrag2(L + HL_VT + 16 * w * HS_T, HS_T, l);
#pragma unroll
        for (int mh = 0; mh < 8; mh += 4) {
            BF2 kf[4]; f32x4 gv[4];
#pragma unroll
            for (int m = 0; m < 4; ++m) { kf[m] = ldfrag2(L + HL_KTT + 16 * (mh + m) * HS_T, HS_T, l); gv[m] = *(const LAS f32x4*)(L + HL_FAC + (16 * (mh + m) + 4 * g) * 4); }
#pragma unroll
            for (int m = 0; m < 4; ++m) accS[mh + m] = accS[mh + m] * gv[m];
#pragma unroll
            for (int m = 0; m < 4; ++m) accS[mh + m] = MFMA16(kf[m].k0, vf.k0, accS[mh + m]);
#pragma unroll
            for (int m = 0; m < 4; ++m) accS[mh + m] = MFMA16(kf[m].k1, vf.k1, accS[mh + m]);
        }
#pragma unroll
        for (int rep = 0; rep < 2; ++rep) if (paddr[rep] >= 0) *(LAS v2u*)(L + paddr[rep]) = ptile[rep];
        PS_END(2); __syncthreads(); PS_END(1);
        { const BF2 p0 = ldfrag2(L + HL_P + 0 * 16 * HS_T, HS_T, l), p1 = ldfrag2(L + HL_P + 1 * 16 * HS_T, HS_T, l), p2 = ldfrag2(L + HL_P + 2 * 16 * HS_T, HS_T, l), p3 = ldfrag2(L + HL_P + 3 * 16 * HS_T, HS_T, l);
            accO[0] = MFMA16(p0.k0, vf.k0, accO[0]); accO[1] = MFMA16(p1.k0, vf.k0, accO[1]); accO[2] = MFMA16(p2.k0, vf.k0, accO[2]); accO[3] = MFMA16(p3.k0, vf.k0, accO[3]);
            accO[0] = MFMA16(p0.k1, vf.k1, accO[0]); accO[1] = MFMA16(p1.k1, vf.k1, accO[1]); accO[2] = MFMA16(p2.k1, vf.k1, accO[2]); accO[3] = MFMA16(p3.k1, vf.k1, accO[3]); }
#pragma unroll
        for (int m = 0; m < 8; ++m) { v2u o; o.x = cvtpk(accS[m][0], accS[m][1]); o.y = cvtpk(accS[m][2], accS[m][3]); *(LAS v2u*)(L + HL_ST + (16 * w + c16) * HS_ND + (16 * m + 4 * g) * 2) = o; }
#pragma unroll
        for (int I = 0; I < 4; ++I)
#pragma unroll
            for (int r = 0; r < 4; ++r) *(LAS float*)(L + HL_OT + (16 * I + 4 * g + r) * OT_S + (16 * w + c16) * 4) = accO[I][r];
        PS_END(3); __syncthreads(); PS_END(1);
        { float ov[16];
#pragma unroll
            for (int q = 0; q < 4; ++q) { const f32x4 t4 = *(const LAS f32x4*)(L + HL_OT + ot * OT_S + (16 * opart + 4 * q) * 4); ov[4 * q] = t4.x; ov[4 * q + 1] = t4.y; ov[4 * q + 2] = t4.z; ov[4 * q + 3] = t4.w; }
            if (dir) {
                float fo[16], gt[16];
#pragma unroll
                for (int q = 0; q < 4; ++q) { fo[2 * q] = bflo(pf0[q]); fo[2 * q + 1] = bfhi(pf0[q]); fo[8 + 2 * q] = bflo(pf1[q]); fo[8 + 2 * q + 1] = bfhi(pf1[q]);
                    gt[2 * q] = bflo(pg0[q]); gt[2 * q + 1] = bfhi(pg0[q]); gt[8 + 2 * q] = bflo(pg1[q]); gt[8 + 2 * q + 1] = bfhi(pg1[q]); }
                float ss = 0.f;
#pragma unroll
                for (int i = 0; i < 16; ++i) { ov[i] += fo[i]; ss += ov[i] * ov[i]; }
                ss += __shfl_xor(ss, 1); ss += __shfl_xor(ss, 2); ss += __shfl_xor(ss, 4);
                const float rstd = __builtin_amdgcn_rsqf(ss * (1.f / 128.f) + EPSN);
#pragma unroll
                for (int q = 0; q < 4; ++q) { const f32x4 nw4 = *(const LAS f32x4*)(L + HL_NW + (16 * opart + 4 * q) * 4);
                    ov[4 * q] *= rstd * nw4.x * gt[4 * q]; ov[4 * q + 1] *= rstd * nw4.y * gt[4 * q + 1]; ov[4 * q + 2] *= rstd * nw4.z * gt[4 * q + 2]; ov[4 * q + 3] *= rstd * nw4.w * gt[4 * q + 3]; }
            }
            *(v4u*)optr = (v4u){cvtpk(ov[0], ov[1]), cvtpk(ov[2], ov[3]), cvtpk(ov[4], ov[5]), cvtpk(ov[6], ov[7])};
            *(v4u*)(optr + 8) = (v4u){cvtpk(ov[8], ov[9]), cvtpk(ov[10], ov[11]), cvtpk(ov[12], ov[13]), cvtpk(ov[14], ov[15])}; }
        PS_END(4);
    }
}

constexpr int MS = 160;
constexpr int ML_Q = 0, ML_K = ML_Q + 64 * MS, ML_KTT = ML_K + 64 * MS, ML_VT = ML_KTT + 64 * MS, ML_CT = ML_VT + 144 * MS, ML_P = ML_CT + 144 * MS;
constexpr int ML_TA = ML_P + 64 * MS;
constexpr int ML_TMU = ML_TA + 1024, ML_TIW = ML_TMU + 1024, ML_TSW = ML_TIW + 1024, ML_TEM = ML_TSW + 1024;
constexpr int ML_TRI = ML_TEM + 1024;
constexpr int ML_SC = ML_TRI + 256;
constexpr int ML_NW = ML_SC + 64;
constexpr int ML_OT = ML_NW + 512;
constexpr int ML_END = ML_OT + 64 * OT_S;
static_assert(ML_END <= 159 * 1024, "mLSTM LDS map");
constexpr size_t ML_SLOT_BYTES = 144 * 64 * 2;
constexpr float LOG2E = 1.4426950408889634f;

__device__ __forceinline__ float wave_incl_sum(float v, int lane) {
#pragma unroll
    for (int o = 1; o < 64; o <<= 1) { const float t = __shfl_up(v, o); if (lane >= o) v += t; }
    return v;
}
__device__ __forceinline__ float wave_incl_max(float v, int lane) {
#pragma unroll
    for (int o = 1; o < 64; o <<= 1) { const float t = __shfl_up(v, o); if (lane >= o) v = fmaxf(v, t); }
    return v;
}
template <bool WHOLE>
__device__ __forceinline__ float ml_scalars256(LAS unsigned char* L, const float (&ig)[4], const float (&fg)[4], float m_prev, float& bsum, int lane, int tb = 0) {
    f32x4 B, av, mu;
    { float run = 0.f;
#pragma unroll
        for (int i = 0; i < 4; ++i) { run += (fminf(fg[i], 0.f) - log1pf(__expf(-fabsf(fg[i])))) * LOG2E; B[i] = run; } }
    { const float incl = wave_incl_sum(B[3], lane); B = B + (incl - B[3]); }
#pragma unroll
    for (int i = 0; i < 4; ++i) av[i] = ig[i] * LOG2E - B[i];
    *(LAS f32x4*)(L + tb + ML_TA + lane * 16) = av;
    { float pm = av[0]; mu[0] = pm; pm = fmaxf(pm, av[1]); mu[1] = pm; pm = fmaxf(pm, av[2]); mu[2] = pm; pm = fmaxf(pm, av[3]); mu[3] = pm;
        const float inclm = wave_incl_max(pm, lane); float exm = __shfl_up(inclm, 1); if (lane == 0) exm = m_prev; exm = fmaxf(exm, m_prev);
#pragma unroll
        for (int i = 0; i < 4; ++i) mu[i] = fmaxf(mu[i], exm); }
    *(LAS f32x4*)(L + tb + ML_TMU + lane * 16) = mu;
    { f32x4 te;
#pragma unroll
        for (int i = 0; i < 4; ++i) te[i] = ex2(-(B[i] + mu[i]));
        *(LAS f32x4*)(L + tb + ML_TEM + lane * 16) = te; }
    const float b255 = __shfl(B[3], 63), mu255 = __shfl(mu[3], 63);
    const int c = lane >> 4;
    const float mu_end = WHOLE ? mu255 : __shfl(mu[3], 16 * c + 15); float mu_start = __shfl(mu[3], (16 * c + 63) & 63); if (c == 0) mu_start = m_prev;
    { f32x4 ti;
#pragma unroll
        for (int i = 0; i < 4; ++i) ti[i] = ex2(mu_start - mu[i]);
        *(LAS f32x4*)(L + tb + ML_TIW + lane * 16) = ti; }
    { f32x4 ts;
#pragma unroll
        for (int i = 0; i < 4; ++i) ts[i] = ex2(av[i] - mu_end);
        *(LAS f32x4*)(L + tb + ML_TSW + lane * 16) = ts; }
    if ((lane & 15) == 0) *(LAS float*)(L + tb + ML_SC + c * 4) = ex2(mu_start - mu_end);
    bsum = b255;
    return b255 + mu255;
}
__device__ __forceinline__ void ml_aug_rows(LAS unsigned char* L, int tid) {
    for (int i = tid; i < 16 * 8; i += NTHREADS) { const int r = i >> 3, q = i & 7; const unsigned v = r == 0 ? 0x3F803F80u : 0u; *(LAS v4u*)(L + ML_VT + (128 + r) * MS + q * 16) = (v4u){v, v, v, v}; }
}
struct MlPre { unsigned kw[8], vw[8]; v4u qn, kn; };
#define ML_LOAD_KV(R, ROWF) do { \
    if (T.tid < 256) { const int dp_ = T.tid & 31, tg_ = T.tid >> 5; _Pragma("unroll") for (int i = 0; i < 8; ++i) { const size_t row_ = (size_t)(ROWF(8 * tg_ + i)); (R).kw[i] = *(const unsigned*)(QK + row_ * 512 + 256 + head * 64 + 2 * dp_); } } \
    { const int ep_ = T.tid & 63, tg_ = T.tid >> 6; _Pragma("unroll") for (int i = 0; i < 8; ++i) { const size_t row_ = (size_t)(ROWF(8 * tg_ + i)); (R).vw[i] = *(const unsigned*)(P + row_ * LDP + 3072 + head * 128 + 2 * ep_); } } \
} while (0)
#define ML_STORE_KV(R, cch) do { \
    if (T.tid < 256) { const int dp_ = T.tid & 31, tg_ = T.tid >> 5; \
        const f32x4 s0_ = *(const LAS f32x4*)(L + ML_TSW + ((cch) * 64 + 8 * tg_) * 4), s1_ = *(const LAS f32x4*)(L + ML_TSW + ((cch) * 64 + 8 * tg_ + 4) * 4); \
        const float sw_[8] = {s0_.x, s0_.y, s0_.z, s0_.w, s1_.x, s1_.y, s1_.z, s1_.w}; \
        _Pragma("unroll") for (int x = 0; x < 2; ++x) { float kv_[8]; _Pragma("unroll") for (int i = 0; i < 8; ++i) kv_[i] = (x ? bfhi((R).kw[i]) : bflo((R).kw[i])) * sw_[i]; \
            *(LAS v4u*)(L + ML_KTT + (2 * dp_ + x) * MS + 16 * tg_) = (v4u){cvtpk(kv_[0], kv_[1]), cvtpk(kv_[2], kv_[3]), cvtpk(kv_[4], kv_[5]), cvtpk(kv_[6], kv_[7])}; } } \
    { const int ep_ = T.tid & 63, tg_ = T.tid >> 6; \
        _Pragma("unroll") for (int x = 0; x < 2; ++x) { unsigned pv_[4]; \
            _Pragma("unroll") for (int i = 0; i < 8; i += 2) { const unsigned v0_ = x ? ((R).vw[i] >> 16) : ((R).vw[i] & 0xffffu), v1_ = x ? ((R).vw[i + 1] >> 16) : ((R).vw[i + 1] & 0xffffu); pv_[i >> 1] = v0_ | (v1_ << 16); } \
            *(LAS v4u*)(L + ML_VT + (2 * ep_ + x) * MS + 16 * tg_) = (v4u){pv_[0], pv_[1], pv_[2], pv_[3]}; } } \
} while (0)

constexpr int Q1_KTT = 0, Q1_VT = Q1_KTT + 64 * P1_S, Q1_TAB = Q1_VT + 144 * P1_S;
constexpr int Q1_TB = Q1_TAB - ML_TA;
static_assert(ML_SC + Q1_TB + 64 <= 159 * 1024, "mLSTM pass-1 LDS map");
template <int DIR>
__device__ __forceinline__ void ml_p1_dir(const Args& a, const Ctx& T, int b, int head, int blk, int slot, const unsigned (&kw)[16], const float (&ig)[4], const float (&fg)[4]) {
    LAS unsigned char* L = T.lds;
    const int w = T.wave, l = T.lane, g = l >> 4, c16 = l & 15;
    float mloc = 0.f, bsum = 0.f;
    if (w == 0) mloc = ml_scalars256<true>(L, ig, fg, -1e30f, bsum, l, Q1_TB);
    __syncthreads();
    { const int dp = T.tid & 31, tg = T.tid >> 5;
        float sw[16];
#pragma unroll
        for (int q = 0; q < 4; ++q) { const int s0 = 16 * tg + 4 * q;
            const f32x4 t4 = *(const LAS f32x4*)(L + Q1_TB + ML_TSW + (DIR ? 252 - s0 : s0) * 4);
            sw[4 * q] = DIR ? t4.w : t4.x; sw[4 * q + 1] = DIR ? t4.z : t4.y; sw[4 * q + 2] = DIR ? t4.y : t4.z; sw[4 * q + 3] = DIR ? t4.x : t4.w; }
#pragma unroll
        for (int x = 0; x < 2; ++x)
#pragma unroll
            for (int q = 0; q < 2; ++q) { float kv[8];
#pragma unroll
                for (int i = 0; i < 8; ++i) kv[i] = (x ? bfhi(kw[8 * q + i]) : bflo(kw[8 * q + i])) * sw[8 * q + i];
                *(LAS v4u*)(L + Q1_KTT + (2 * dp + x) * P1_S + 32 * tg + 16 * q) = (v4u){cvtpk(kv[0], kv[1]), cvtpk(kv[2], kv[3]), cvtpk(kv[4], kv[5]), cvtpk(kv[6], kv[7])}; } }
    __syncthreads();
    f32x4 accC[4], accCA = (f32x4){0.f, 0.f, 0.f, 0.f};
#pragma unroll
    for (int m = 0; m < 4; ++m) accC[m] = (f32x4){0.f, 0.f, 0.f, 0.f};
#pragma unroll
    for (int kh = 0; kh < 4; ++kh) {
        const BF2 vf = ldfrag2(L + Q1_VT + 16 * w * P1_S + 128 * kh, P1_S, l);
        BF2 kf[4];
#pragma unroll
        for (int m = 0; m < 4; ++m) kf[m] = ldfrag2(L + Q1_KTT + 16 * m * P1_S + 128 * kh, P1_S, l);
#pragma unroll
        for (int m = 0; m < 4; ++m) accC[m] = MFMA16(kf[m].k0, vf.k0, accC[m]);
#pragma unroll
        for (int m = 0; m < 4; ++m) accC[m] = MFMA16(kf[m].k1, vf.k1, accC[m]);
        if (w < 4) { const BF2 af = ldfrag2(L + Q1_VT + 128 * P1_S + 128 * kh, P1_S, l); const BF2 kfw = ldfrag2(L + Q1_KTT + 16 * w * P1_S + 128 * kh, P1_S, l);
            accCA = MFMA16(kfw.k0, af.k0, accCA); accCA = MFMA16(kfw.k1, af.k1, accCA); } }
    const size_t sidx = hg_seq(b, DIR, head) * 16 + slot;
    bf16* CT = (bf16*)(a.ws + WS_MLST + sidx * ML_SLOT_BYTES);
#pragma unroll
    for (int m = 0; m < 4; ++m) { v2u o; o.x = cvtpk(accC[m][0], accC[m][1]); o.y = cvtpk(accC[m][2], accC[m][3]); *(v2u*)(CT + (size_t)(16 * w + c16) * 64 + 16 * m + 4 * g) = o; }
    if (w < 4) { v2u o; o.x = cvtpk(accCA[0], accCA[1]); o.y = cvtpk(accCA[2], accCA[3]); *(v2u*)(CT + (size_t)(128 + c16) * 64 + 16 * w + 4 * g) = o; }
    if (T.tid == 0) { float* sc = (float*)(a.ws + WS_MLSC) + sidx * 4; sc[0] = mloc; sc[1] = bsum; }
}
__device__ __forceinline__ void ml_pass1_items(const Args& a, const Ctx& T0, int first, int stride, int limit) {
    const bf16* P = (const bf16*)(a.ws + WS_PROJ); const bf16* QK = (const bf16*)(a.ws + WS_QK); const float* GT = (const float*)(a.ws + WS_GATES);
    __syncthreads();
    for (int i = T0.tid; i < 16 * 32; i += NTHREADS) { const int r = i >> 5, q = i & 31; const unsigned v = r == 0 ? 0x3F803F80u : 0u; *(LAS v4u*)(T0.lds + Q1_VT + (128 + r) * P1_S + q * 16) = (v4u){v, v, v, v}; }
#pragma unroll 1
    for (int item = first; item < limit; item += stride) {
        Ctx T = T0; asm volatile("" : "+v"(T.lane)); T.tid = T.wave * 64 + T.lane;
        LAS unsigned char* L = T.lds;
        const int w = T.wave, l = T.lane;
        const int k = item & 15, head = (item >> 4) & 3, b = item >> 6;
        const int blkF = k == 0 ? -1 : (k == 15 ? 0 : k), slotF = k == 0 ? 0 : (k == 15 ? 1 : k + 1);
        const int blkB = k == 0 ? -1 : (k == 15 ? 15 : k), slotB = k == 0 ? 0 : (k == 15 ? 1 : 16 - k);
#pragma unroll 1
        for (int dir = 0; dir < 2; ++dir) {
            const int blk = dir ? blkB : blkF;
            float ig[4] = {0.f, 0.f, 0.f, 0.f}, fg[4] = {0.f, 0.f, 0.f, 0.f};
            if (w == 0) {
#pragma unroll
                for (int c = 0; c < 4; ++c) { const int u = 4 * l + c; const size_t row = (size_t)p1_row(b, blk, dir ? 255 - u : u); ig[c] = GT[row * 16 + (dir ? 8 : 0) + head]; fg[c] = GT[row * 16 + (dir ? 12 : 4) + head]; } }
            unsigned kw[16];
            { const int dp = T.tid & 31, tg = T.tid >> 5;
#pragma unroll
                for (int i = 0; i < 16; ++i) kw[i] = *(const unsigned*)(QK + (size_t)p1_row(b, blk, 16 * tg + i) * 512 + 256 + head * 64 + 2 * dp); }
            __syncthreads();
            if (dir == 0 || blkB != blkF) {
                const int ep = T.tid & 63, tg = T.tid >> 6; unsigned vw[32];
#pragma unroll
                for (int i = 0; i < 32; ++i) vw[i] = *(const unsigned*)(P + (size_t)p1_row(b, blk, 32 * tg + i) * LDP + 3072 + head * 128 + 2 * ep);
#pragma unroll
                for (int x = 0; x < 2; ++x)
#pragma unroll
                    for (int q = 0; q < 4; ++q) { unsigned pv[4];
#pragma unroll
                        for (int i = 0; i < 8; i += 2) { const unsigned v0 = x ? (vw[8 * q + i] >> 16) : (vw[8 * q + i] & 0xffffu), v1 = x ? (vw[8 * q + i + 1] >> 16) : (vw[8 * q + i + 1] & 0xffffu); pv[i >> 1] = v0 | (v1 << 16); }
                        *(LAS v4u*)(L + Q1_VT + (2 * ep + x) * P1_S + 64 * tg + 16 * q) = (v4u){pv[0], pv[1], pv[2], pv[3]}; }
            }
            if (dir == 0) ml_p1_dir<0>(a, T, b, head, blk, slotF, kw, ig, fg); else ml_p1_dir<1>(a, T, b, head, blk, slotB, kw, ig, fg);
        }
    }
}

__device__ __forceinline__ void pass2_all(const Args& a, const Ctx& T) {
    const int gid = T.vcu * NTHREADS + T.tid;
    if (gid < 32 * 2048) {
        const int seq = gid >> 11, el = (gid & 2047) * 8, d0 = el & 127;
        float r[8];
#pragma unroll
        for (int i = 0; i < 8; ++i) r[i] = 0.f;
#pragma unroll 1
        for (int j0 = 0; j0 < 16; j0 += 4) {
            v4u dv[4]; f32x4 g0[4], g1[4];
#pragma unroll
            for (int jj = 0; jj < 4; ++jj) { const size_t sidx = (size_t)seq * 16 + j0 + jj; dv[jj] = *(const v4u*)(a.ws + WS_HGST + sidx * HG_SLOT_BYTES + (size_t)el * 2);
                const float* G = (const float*)(a.ws + WS_HGG) + sidx * 128 + d0; g0[jj] = *(const f32x4*)G; g1[jj] = *(const f32x4*)(G + 4); }
#pragma unroll
            for (int jj = 0; jj < 4; ++jj) { const size_t sidx = (size_t)seq * 16 + j0 + jj;
                r[0] = g0[jj].x * r[0] + bflo(dv[jj].x); r[1] = g0[jj].y * r[1] + bfhi(dv[jj].x); r[2] = g0[jj].z * r[2] + bflo(dv[jj].y); r[3] = g0[jj].w * r[3] + bfhi(dv[jj].y);
                r[4] = g1[jj].x * r[4] + bflo(dv[jj].z); r[5] = g1[jj].y * r[5] + bfhi(dv[jj].z); r[6] = g1[jj].z * r[6] + bflo(dv[jj].w); r[7] = g1[jj].w * r[7] + bfhi(dv[jj].w);
                *(v4u*)(a.ws + WS_HGST + sidx * HG_SLOT_BYTES + (size_t)el * 2) = (v4u){cvtpk(r[0], r[1]), cvtpk(r[2], r[3]), cvtpk(r[4], r[5]), cvtpk(r[6], r[7])}; }
        }
    } else if (gid < 32 * 2048 + 32 * 1152) {
        const int t2 = gid - 32 * 2048; const int seq = t2 / 1152, el = (t2 % 1152) * 8;
        float r[8], m = 0.f;
#pragma unroll
        for (int i = 0; i < 8; ++i) r[i] = 0.f;
#pragma unroll 1
        for (int j0 = 0; j0 < 16; j0 += 4) {
            v4u dv[4]; float ml[4], bt[4];
#pragma unroll
            for (int jj = 0; jj < 4; ++jj) { const size_t sidx = (size_t)seq * 16 + j0 + jj; dv[jj] = *(const v4u*)(a.ws + WS_MLST + sidx * ML_SLOT_BYTES + (size_t)el * 2);
                const float* sc = (const float*)(a.ws + WS_MLSC) + sidx * 4; ml[jj] = sc[0]; bt[jj] = sc[1]; }
#pragma unroll
            for (int jj = 0; jj < 4; ++jj) { const size_t sidx = (size_t)seq * 16 + j0 + jj;
                const float mn = fmaxf(bt[jj] + m, ml[jj]); const float cA = ex2(bt[jj] + m - mn), cB = ex2(ml[jj] - mn); m = mn;
                r[0] = cA * r[0] + cB * bflo(dv[jj].x); r[1] = cA * r[1] + cB * bfhi(dv[jj].x); r[2] = cA * r[2] + cB * bflo(dv[jj].y); r[3] = cA * r[3] + cB * bfhi(dv[jj].y);
                r[4] = cA * r[4] + cB * bflo(dv[jj].z); r[5] = cA * r[5] + cB * bfhi(dv[jj].z); r[6] = cA * r[6] + cB * bflo(dv[jj].w); r[7] = cA * r[7] + cB * bfhi(dv[jj].w);
                *(v4u*)(a.ws + WS_MLST + sidx * ML_SLOT_BYTES + (size_t)el * 2) = (v4u){cvtpk(r[0], r[1]), cvtpk(r[2], r[3]), cvtpk(r[4], r[5]), cvtpk(r[6], r[7])};
                if (el == 0) ((float*)(a.ws + WS_MLSC))[sidx * 4 + 2] = mn; }
        }
    }
}

__device__ __forceinline__ void ml_pass3_item(const Args& a, const Ctx& T0, int item, bf16* OUT) {
    const int jt = item & 15, head = (item >> 4) & 3, b = item >> 6;
    const bf16* P = (const bf16*)(a.ws + WS_PROJ); const bf16* QK = (const bf16*)(a.ws + WS_QK); const float* GT = (const float*)(a.ws + WS_GATES);
    Ctx T = T0; asm volatile("" : "+v"(T.lane));
    T.tid = T.wave * 64 + T.lane;
    LAS unsigned char* L = T.lds;
    const int w = T.wave, l = T.lane, g = l >> 4, c16 = l & 15;
    __syncthreads();
    for (int i = T.tid; i < 64 * MS / 16; i += NTHREADS) *(LAS v4u*)(L + ML_P + i * 16) = (v4u){0u, 0u, 0u, 0u};
    ml_aug_rows(L, T.tid);
    if (T.tid < 128) *(LAS float*)(L + ML_NW + T.tid * 4) = a.in[I_MLNW][head * 128 + T.tid];
#define ML_ROW3(st_, lt_) (b * SEQ + 256 * jt + (((st_) >> 2) ? 255 - (64 * ((st_) & 3) + (lt_)) : 64 * ((st_) & 3) + (lt_)))
    MlPre R;
    const int qt = T.tid >> 3, qpart = T.tid & 7;
#define ML_LOAD_ALL(st_) do { ML_LOAD_KV(R, ROWF_); const size_t rq_ = (size_t)ML_ROW3((st_), qt); R.qn = *(const v4u*)(QK + rq_ * 512 + head * 64 + qpart * 8); R.kn = *(const v4u*)(QK + rq_ * 512 + 256 + head * 64 + qpart * 8); } while (0)
#define ROWF_(x_) ML_ROW3(0, (x_))
    ML_LOAD_ALL(0);
#undef ROWF_
    f32x4 accC[4], accCA = (f32x4){0.f, 0.f, 0.f, 0.f};
    v4u stq[2], sta[2];
#define ML_STATE_LOAD(dir_) do { const size_t sidx_ = hg_seq(b, (dir_), head) * 16 + ((dir_) ? 15 - jt : jt); const bf16* CTg_ = (const bf16*)(a.ws + WS_MLST + sidx_ * ML_SLOT_BYTES); \
        _Pragma("unroll") for (int q_ = 0; q_ < 2; ++q_) { const int idx_ = l + 64 * q_; stq[q_] = *(const v4u*)(CTg_ + (size_t)(16 * w + (idx_ >> 3)) * 64 + (idx_ & 7) * 8); \
            if (w == 4) sta[q_] = *(const v4u*)(CTg_ + (size_t)(128 + (idx_ >> 3)) * 64 + (idx_ & 7) * 8); } } while (0)
    ML_STATE_LOAD(0);
#pragma unroll 1
    for (int step = 0; step < 8; ++step) {
        const int dir = step >> 2, c = step & 3;
        PS_BEGIN();
        if (c == 0) {
            const size_t sidx = hg_seq(b, dir, head) * 16 + (dir ? 15 - jt : jt);
            if (dir == 1) { ML_STATE_LOAD(1); VM_WAIT(); __syncthreads(); if (w == 0) { __builtin_amdgcn_fence(__ATOMIC_ACQUIRE, "agent"); VM_WAIT(); } }
            __syncthreads();
#pragma unroll
            for (int q = 0; q < 2; ++q) { const int idx = l + 64 * q; *(LAS v4u*)(L + ML_CT + (16 * w + (idx >> 3)) * MS + (idx & 7) * 16) = stq[q];
                if (w == 4) *(LAS v4u*)(L + ML_CT + (128 + (idx >> 3)) * MS + (idx & 7) * 16) = sta[q]; }
            if (w == 0) { float ig[4], fg[4];
#pragma unroll
                for (int cc = 0; cc < 4; ++cc) { const int lt = 4 * l + cc; const size_t row = (size_t)ML_ROW3(4 * dir + (lt >> 6), lt & 63); ig[cc] = GT[row * 16 + (dir ? 8 : 0) + head]; fg[cc] = GT[row * 16 + (dir ? 12 : 4) + head]; }
                float bsum = 0.f; const float m0 = ((const float*)(a.ws + WS_MLSC))[sidx * 4 + 2]; (void)ml_scalars256<false>(L, ig, fg, m0, bsum, l); }
            __syncthreads();
#pragma unroll
            for (int m = 0; m < 4; ++m) { const v2u sv = *(const LAS v2u*)(L + ML_CT + (16 * w + c16) * MS + (16 * m + 4 * g) * 2); accC[m] = (f32x4){bflo(sv.x), bfhi(sv.x), bflo(sv.y), bfhi(sv.y)}; }
            if (w < 4) { const v2u sv = *(const LAS v2u*)(L + ML_CT + (128 + c16) * MS + (16 * w + 4 * g) * 2); accCA = (f32x4){bflo(sv.x), bfhi(sv.x), bflo(sv.y), bfhi(sv.y)}; }
        }
        PS_END(5);
        *(LAS v4u*)(L + ML_Q + qt * MS + qpart * 16) = R.qn; *(LAS v4u*)(L + ML_K + qt * MS + qpart * 16) = R.kn;
        ML_STORE_KV(R, c);
        if (step < 7) {
#define ROWF_(x_) ML_ROW3(step + 1, (x_))
            ML_LOAD_ALL(step + 1);
#undef ROWF_
        }
        PS_END(6); __syncthreads(); PS_END(10);
        const size_t orow = (size_t)ML_ROW3(step, qt);
        bf16* optr = OUT + orow * DM + 512 + head * 128 + 16 * qpart;
        v2u ptile[2]; int paddr[2] = {-1, -1};
#pragma unroll 1
        for (int rep = 0; rep < 2; ++rep) { const int tix = w + 8 * rep;
            if (tix < 10) {
                const int I = tix < 1 ? 0 : (tix < 3 ? 1 : (tix < 6 ? 2 : 3)); const int J = tix - (I * (I + 1)) / 2;
                const BF2 af = ldfrag2(L + ML_K + 16 * J * MS, MS, l), bf = ldfrag2(L + ML_Q + 16 * I * MS, MS, l);
                const int tloc = 16 * I + c16, s0 = 16 * J + 4 * g;
                const f32x4 av = *(const LAS f32x4*)(L + ML_TA + (c * 64 + s0) * 4); const float mu = *(const LAS float*)(L + ML_TMU + (c * 64 + tloc) * 4);
                f32x4 at = (f32x4){0.f, 0.f, 0.f, 0.f};
                at = MFMA16(af.k0, bf.k0, at); at = MFMA16(af.k1, bf.k1, at);
                float pr[4];
#pragma unroll
                for (int r = 0; r < 4; ++r) pr[r] = (s0 + r <= tloc) ? at[r] * ex2(av[r] - mu) : 0.f;
                ptile[rep].x = cvtpk(pr[0], pr[1]); ptile[rep].y = cvtpk(pr[2], pr[3]); paddr[rep] = ML_P + tloc * MS + s0 * 2;
            } }
        f32x4 accO[4], accOA = (f32x4){0.f, 0.f, 0.f, 0.f};
        const float carry = *(const LAS float*)(L + ML_SC + c * 4);
        const BF2 vf = ldfrag2(L + ML_VT + 16 * w * MS, MS, l);
        { const BF2 cf = ldfrag2(L + ML_CT + 16 * w * MS, MS, l);
            const BF2 q0 = ldfrag2(L + ML_Q + 0 * 16 * MS, MS, l), q1 = ldfrag2(L + ML_Q + 1 * 16 * MS, MS, l), q2 = ldfrag2(L + ML_Q + 2 * 16 * MS, MS, l), q3 = ldfrag2(L + ML_Q + 3 * 16 * MS, MS, l);
#pragma unroll
            for (int I = 0; I < 4; ++I) accO[I] = (f32x4){0.f, 0.f, 0.f, 0.f};
            accO[0] = MFMA16(q0.k0, cf.k0, accO[0]); accO[1] = MFMA16(q1.k0, cf.k0, accO[1]); accO[2] = MFMA16(q2.k0, cf.k0, accO[2]); accO[3] = MFMA16(q3.k0, cf.k0, accO[3]);
            accO[0] = MFMA16(q0.k1, cf.k1, accO[0]); accO[1] = MFMA16(q1.k1, cf.k1, accO[1]); accO[2] = MFMA16(q2.k1, cf.k1, accO[2]); accO[3] = MFMA16(q3.k1, cf.k1, accO[3]); }
        { const BF2 k0f = ldfrag2(L + ML_KTT + 0 * 16 * MS, MS, l), k1f = ldfrag2(L + ML_KTT + 1 * 16 * MS, MS, l), k2f = ldfrag2(L + ML_KTT + 2 * 16 * MS, MS, l), k3f = ldfrag2(L + ML_KTT + 3 * 16 * MS, MS, l);
#pragma unroll
            for (int I = 0; I < 4; ++I) accC[I] = accC[I] * carry;
            accC[0] = MFMA16(k0f.k0, vf.k0, accC[0]); accC[1] = MFMA16(k1f.k0, vf.k0, accC[1]); accC[2] = MFMA16(k2f.k0, vf.k0, accC[2]); accC[3] = MFMA16(k3f.k0, vf.k0, accC[3]);
            accC[0] = MFMA16(k0f.k1, vf.k1, accC[0]); accC[1] = MFMA16(k1f.k1, vf.k1, accC[1]); accC[2] = MFMA16(k2f.k1, vf.k1, accC[2]); accC[3] = MFMA16(k3f.k1, vf.k1, accC[3]); }
#pragma unroll
        for (int I = 0; I < 4; ++I) { const f32x4 iw = *(const LAS f32x4*)(L + ML_TIW + (c * 64 + 16 * I + 4 * g) * 4); accO[I] = accO[I] * iw; }
        BF2 af = vf;
        if (w < 4) { const BF2 cfa = ldfrag2(L + ML_CT + 128 * MS, MS, l), qw_ = ldfrag2(L + ML_Q + 16 * w * MS, MS, l), kw_ = ldfrag2(L + ML_KTT + 16 * w * MS, MS, l);
            af = ldfrag2(L + ML_VT + 128 * MS, MS, l);
            const f32x4 iwa = *(const LAS f32x4*)(L + ML_TIW + (c * 64 + 16 * w + 4 * g) * 4);
            accCA = accCA * carry;
            accOA = MFMA16(qw_.k0, cfa.k0, accOA); accCA = MFMA16(kw_.k0, af.k0, accCA); accOA = MFMA16(qw_.k1, cfa.k1, accOA); accCA = MFMA16(kw_.k1, af.k1, accCA);
            accOA = accOA * iwa; }
#pragma unroll
        for (int rep = 0; rep < 2; ++rep) if (paddr[rep] >= 0) *(LAS v2u*)(L + paddr[rep]) = ptile[rep];
        v4u pf0 = (v4u){0u, 0u, 0u, 0u}, pf1 = pf0, pg0 = pf0, pg1 = pf0;
        if (dir) { pf0 = *(const v4u*)optr; pf1 = *(const v4u*)(optr + 8); const bf16* gp = P + orow * LDP + 3584 + head * 128 + 16 * qpart; pg0 = *(const v4u*)gp; pg1 = *(const v4u*)(gp + 8); }
        PS_END(7); __syncthreads(); PS_END(10);
        { const BF2 p0 = ldfrag2(L + ML_P + 0 * 16 * MS, MS, l), p1 = ldfrag2(L + ML_P + 1 * 16 * MS, MS, l), p2 = ldfrag2(L + ML_P + 2 * 16 * MS, MS, l), p3 = ldfrag2(L + ML_P + 3 * 16 * MS, MS, l);
            accO[0] = MFMA16(p0.k0, vf.k0, accO[0]); accO[1] = MFMA16(p1.k0, vf.k0, accO[1]); accO[2] = MFMA16(p2.k0, vf.k0, accO[2]); accO[3] = MFMA16(p3.k0, vf.k0, accO[3]);
            accO[0] = MFMA16(p0.k1, vf.k1, accO[0]); accO[1] = MFMA16(p1.k1, vf.k1, accO[1]); accO[2] = MFMA16(p2.k1, vf.k1, accO[2]); accO[3] = MFMA16(p3.k1, vf.k1, accO[3]);
            if (w < 4) { const BF2 pw_ = ldfrag2(L + ML_P + 16 * w * MS, MS, l); accOA = MFMA16(pw_.k0, af.k0, accOA); accOA = MFMA16(pw_.k1, af.k1, accOA); } }
#pragma unroll
        for (int m = 0; m < 4; ++m) { v2u o; o.x = cvtpk(accC[m][0], accC[m][1]); o.y = cvtpk(accC[m][2], accC[m][3]); *(LAS v2u*)(L + ML_CT + (16 * w + c16) * MS + (16 * m + 4 * g) * 2) = o; }
        if (w < 4) { v2u o; o.x = cvtpk(accCA[0], accCA[1]); o.y = cvtpk(accCA[2], accCA[3]); *(LAS v2u*)(L + ML_CT + (128 + c16) * MS + (16 * w + 4 * g) * 2) = o;
            if (c16 == 0) { const f32x4 em = *(const LAS f32x4*)(L + ML_TEM + (c * 64 + 16 * w + 4 * g) * 4); f32x4 ri;
#pragma unroll
                for (int r = 0; r < 4; ++r) ri[r] = __builtin_amdgcn_rcpf(fmaxf(fabsf(accOA[r]), em[r]));
                *(LAS f32x4*)(L + ML_TRI + (16 * w + 4 * g) * 4) = ri; } }
#pragma unroll
        for (int I = 0; I < 4; ++I)
#pragma unroll
            for (int r = 0; r < 4; ++r) *(LAS float*)(L + ML_OT + (16 * I + 4 * g + r) * OT_S + (16 * w + c16) * 4) = accO[I][r];
        PS_END(8); __syncthreads(); PS_END(10);
        { float ov[16]; const float ri = *(const LAS float*)(L + ML_TRI + qt * 4);
#pragma unroll
            for (int q = 0; q < 4; ++q) { const f32x4 t4 = *(const LAS f32x4*)(L + ML_OT + qt * OT_S + (16 * qpart + 4 * q) * 4); ov[4 * q] = t4.x * ri; ov[4 * q + 1] = t4.y * ri; ov[4 * q + 2] = t4.z * ri; ov[4 * q + 3] = t4.w * ri; }
            if (dir) {
                float fo[16], gt[16];
#pragma unroll
                for (int q = 0; q < 4; ++q) { fo[2 * q] = bflo(pf0[q]); fo[2 * q + 1] = bfhi(pf0[q]); fo[8 + 2 * q] = bflo(pf1[q]); fo[8 + 2 * q + 1] = bfhi(pf1[q]);
                    gt[2 * q] = bflo(pg0[q]); gt[2 * q + 1] = bfhi(pg0[q]); gt[8 + 2 * q] = bflo(pg1[q]); gt[8 + 2 * q + 1] = bfhi(pg1[q]); }
                float ss = 0.f;
#pragma unroll
                for (int i = 0; i < 16; ++i) { ov[i] += fo[i]; ss += ov[i] * ov[i]; }
                ss += __shfl_xor(ss, 1); ss += __shfl_xor(ss, 2); ss += __shfl_xor(ss, 4);
                const float rstd = __builtin_amdgcn_rsqf(ss * (1.f / 128.f) + EPSN);
#pragma unroll
                for (int q = 0; q < 4; ++q) { const f32x4 nw4 = *(const LAS f32x4*)(L + ML_NW + (16 * qpart + 4 * q) * 4);
                    ov[4 * q] *= rstd * nw4.x * gt[4 * q]; ov[4 * q + 1] *= rstd * nw4.y * gt[4 * q + 1]; ov[4 * q + 2] *= rstd * nw4.z * gt[4 * q + 2]; ov[4 * q + 3] *= rstd * nw4.w * gt[4 * q + 3]; }
            }
            *(v4u*)optr = (v4u){cvtpk(ov[0], ov[1]), cvtpk(ov[2], ov[3]), cvtpk(ov[4], ov[5]), cvtpk(ov[6], ov[7])};
            *(v4u*)(optr + 8) = (v4u){cvtpk(ov[8], ov[9]), cvtpk(ov[10], ov[11]), cvtpk(ov[12], ov[13]), cvtpk(ov[14], ov[15])}; }
        PS_END(9);
    }
#undef ML_ROW3
#undef ML_LOAD_ALL
#undef ML_STATE_LOAD
}
__device__ __forceinline__ void final_norm_phase(const Args& a, const Ctx& T, const bf16* X3) {
    f32x4 wv[4];
#pragma unroll
    for (int j = 0; j < 4; ++j) wv[j] = *((const f32x4*)a.in[I_FNW] + T.lane + 64 * j);
    f32x4 v[4];
    if (T.gw < MLAT) norm_load_row(v, X3, true, nullptr, T.gw, T.lane);
    for (int m = T.gw; m < MLAT; m += T.NGW) {
        f32x4 cur[4]; float s = 0.f;
#pragma unroll
        for (int j = 0; j < 4; ++j) { cur[j] = v[j]; s += (v[j].x * v[j].x + v[j].y * v[j].y) + (v[j].z * v[j].z + v[j].w * v[j].w); }
        { const int mn = m + T.NGW; if (mn < MLAT) norm_load_row(v, X3, true, nullptr, mn, T.lane); }
        const float rstd = __builtin_amdgcn_rsqf(wave_sum(s) * (1.f / DM) + EPSN);
        f32x4* xr = (f32x4*)(a.out + (size_t)m * DM) + T.lane;
#pragma unroll
        for (int j = 0; j < 4; ++j) xr[64 * j] = cur[j] * rstd * wv[j];
    }
}

__device__ __forceinline__ void gates_phase(const Args& a, const Ctx& T) {
    const bf16* XNc = (const bf16*)(a.ws + WS_XN); const bf16* WG = (const bf16*)(a.ws + WS_WG); float* GT = (float*)(a.ws + WS_GATES);
    const int l = T.lane, r = l & 15, g = l >> 4;
    const float bias = a.in[I_MLGB][r];
    for (int rg = T.gw; rg < MALL / 16; rg += T.NGW) {
        f32x4 acc = (f32x4){0.f, 0.f, 0.f, 0.f};
        const bf16* pa = XNc + (size_t)(16 * rg + r) * DM + 8 * g; const bf16* pb = WG + (size_t)r * DM + 8 * g;
#pragma unroll 8
        for (int ks = 0; ks < 32; ++ks) { const bf16x8 av = *(const bf16x8*)(pa + ks * 32); const bf16x8 bv = *(const bf16x8*)(pb + ks * 32); acc = MFMA16(av, bv, acc); }
#pragma unroll
        for (int q = 0; q < 4; ++q) GT[(size_t)(16 * rg + 4 * g + q) * 16 + r] = acc[q] + bias;
    }
}

__global__ void __launch_bounds__(NTHREADS, 2) fwd_kernel(Args a) {
    extern __shared__ __attribute__((aligned(16))) unsigned char lds_raw[];
    Ctx T;
    T.lds = (LAS unsigned char*)lds_raw;
    T.tid = threadIdx.x; T.lane = T.tid & 63; T.wave = __builtin_amdgcn_readfirstlane(T.tid >> 6);
    T.G = gridDim.x; { const int bx = blockIdx.x; T.vcu = (T.G % 8 == 0) ? (bx % 8) * (T.G / 8) + bx / 8 : bx; }
    T.gw = T.vcu * NWAVES + T.wave; T.NGW = T.G * NWAVES;
    volatile LAS unsigned* MISC = (volatile LAS unsigned*)(T.lds + MISC_OFF);
    for (int u = T.tid; u < (LDS_BYTES - LDSCTL_OFF) / 4; u += NTHREADS) ((LAS unsigned*)(T.lds + LDSCTL_OFF))[u] = 0u;
    __syncthreads();
    XcdBarrier bar; bar.bar = (unsigned*)(a.ws + WS_CTL) + CW_BAR; bar.x = 0; bar.st = nullptr;
    const bool multi = (a.ph_hi - a.ph_lo) > 1;
    if (multi) bar = xcd_barrier_post((unsigned*)(a.ws + WS_CTL) + CW_BAR, MISC + 8);
    const int lo = a.ph_lo, hi = a.ph_hi;
#ifndef REP_MASK
#define REP_MASK 0
#endif
#define IN(k) (lo <= (k) && (k) < hi)
#ifndef PROF_K
#define PROF_K -1
#endif
#define STAMP(k) do { if (PROF_K >= 0 && ((k) == PROF_K || (k) == PROF_K + 1) && blockIdx.x == 0 && T.tid == 0) { const unsigned long long t_ = __builtin_amdgcn_s_memrealtime(); MISC[16 + 2 * ((k) - PROF_K)] = (unsigned)t_; MISC[17 + 2 * ((k) - PROF_K)] = (unsigned)(t_ >> 32); } } while (0)
#define REPS(k) for (int rep_ = 0; rep_ < (((REP_MASK >> (k)) & 1) ? 2 : 1); ++rep_)
#if (REP_MASK >> 18) & 1
#define SEAM(k) do { if (IN(k) && IN((k) + 1)) { xcd_barrier(bar); xcd_barrier(bar); } } while (0)
#else
#define SEAM(k) do { if (IN(k) && IN((k) + 1)) xcd_barrier(bar); STAMP((k) + 1); } while (0)
#endif
    bf16* XN = (bf16*)(a.ws + WS_XN); bf16* HB = (bf16*)(a.ws + WS_PROJ); bf16* PROJ = (bf16*)(a.ws + WS_PROJ);
    const float* mods = (const float*)(a.ws + WS_MODS);
    bf16* XB1 = (bf16*)a.out; bf16* XB2 = (bf16*)a.out + (size_t)MLAT * DM; bf16* XB3 = (bf16*)(a.ws + WS_PROJ + 96 * MiB);
    const int bx = (int)blockIdx.x;

    STAMP(0);
    if (IN(0)) REPS(0) { mods_phase(a, T); convert_ffn(a, T, a.in[I_F1W1], a.in[I_F1W2]); convert_mix(a, T);
        if (T.tid < 64) { const int e = bx * 64 + T.tid; if (e < 16384) { const int q = e >> 10, k = e & 1023; ((bf16*)(a.ws + WS_WG))[q * 1024 + k] = (bf16)f2bf(a.in[I_WIN][(size_t)k * DIN + NPROJ + q]); } } }
    SEAM(0);
    if (IN(1)) norm_mod_rows<false, false>(a, T, a.in[I_X], a.in[I_CTX], MALL, a.in[I_N1W], 0, 1);
    SEAM(1);
    if (IN(2)) REPS(2) { pg8::Gemm g{XN, (const bf16*)(a.ws + WS_W1), MALL, 2 * DFF, DM, DM}; pg8::StaticOrder S; S.init(MALL, 2 * DFF, T.G, bx);
        pg8::EpiSwiglu E{HB, DFF}; pg8::gemm_phase<pg8::EpiSwiglu, pg8::StaticOrder, true, true>(T.lds, g, S, E); }
    SEAM(2);
    if (IN(3)) { pg8::Gemm g{HB, (const bf16*)(a.ws + WS_W2), MALL, DM, DFF, DFF}; pg8::DownOrder S; S.lat.init(MLAT, DM, T.G, bx); S.c = bx;
        pg8::EpiDown1 E{a.in[I_X], XB1, mods + 2 * 1024, 0.5f, (bf16*)(a.ws + WS_SLAB)}; pg8::gemm_phase<pg8::EpiDown1, pg8::DownOrder, true, true>(T.lds, g, S, E); }
    SEAM(3);
    if (IN(4)) REPS(4) { norm_mod_rows<true, true>(a, T, XB1, a.in[I_CTX], MALL, a.in[I_N2W], 3, 4); convert_ffn(a, T, a.in[I_F2W1], a.in[I_F2W2]); }
    SEAM(4);
    if (IN(5)) { pg8::Gemm g{XN, (const bf16*)(a.ws + WS_WIN), MALL, NPROJ, DM, DM}; pg8::ProjOrder S; S.lat.init(MLAT, NPROJ, T.G, bx); S.c = bx;
        pg8::EpiProjAll E{{PROJ, LDP}, (bf16*)(a.ws + WS_SLAB2)}; pg8::gemm_phase<pg8::EpiProjAll, pg8::ProjOrder, true, true>(T.lds, g, S, E); }
    SEAM(5);
    if (IN(6)) { gates_phase(a, T); ctx_combine(a, T); conv_phase(a, T); }
    SEAM(6);
    if (IN(7)) REPS(7) { hg_pass1_items(a, T, T.vcu, T.G, 256); ml_pass1_items(a, T, T.vcu, T.G, 256); }
    SEAM(7);
    if (IN(8)) pass2_all(a, T);
    SEAM(8);
    if (IN(9)) REPS(9) { for (int it = T.vcu; it < 256; it += T.G) hg_pass3_item(a, T, it, XN); for (int it = T.vcu; it < 256; it += T.G) ml_pass3_item(a, T, it, XN); }
    SEAM(9);
    if (IN(10)) { pg8::Gemm g{XN, (const bf16*)(a.ws + WS_WOUT), MLAT, DM, DM, DM}; pg8::StaticOrder S; S.init(MLAT, DM, T.G, bx);
        pg8::EpiResidB<true> E{XB1, XB2, mods + 5 * 1024, 1.0f}; pg8::gemm_phase<pg8::EpiResidB<true>, pg8::StaticOrder, true, true>(T.lds, g, S, E); }
    SEAM(10);
    if (IN(11)) REPS(11) norm_mod_rows<false, true>(a, T, XB2, nullptr, MLAT, a.in[I_N3W], 6, 7);
    SEAM(11);
    if (IN(12)) REPS(12) { pg8::Gemm g{XN, (const bf16*)(a.ws + WS_W1), MLAT, 2 * DFF, DM, DM}; pg8::StaticOrder S; S.init(MLAT, 2 * DFF, T.G, bx);
        pg8::EpiSwiglu E{HB, DFF}; pg8::gemm_phase<pg8::EpiSwiglu, pg8::StaticOrder, true, true>(T.lds, g, S, E); }
    SEAM(12);
    if (IN(13)) { pg8::Gemm g{HB, (const bf16*)(a.ws + WS_W2), MLAT, DM, DFF, DFF}; pg8::StaticOrder S; S.init(MLAT, DM, T.G, bx);
        pg8::EpiResidB<true> E{XB2, XB3, mods + 8 * 1024, 0.5f}; pg8::gemm_phase<pg8::EpiResidB<true>, pg8::StaticOrder, true, true>(T.lds, g, S, E); }
    SEAM(13);
    if (IN(14)) final_norm_phase(a, T, XB3);
    STAMP(15);
    if (PROF_S >= 0 && blockIdx.x == 0 && T.tid == 0) { const unsigned long long dt_ = ((((unsigned long long)MISC[23]) << 32) | MISC[22]) * 8ull, te_ = __builtin_amdgcn_s_memrealtime(); while (__builtin_amdgcn_s_memrealtime() - te_ < dt_) __builtin_amdgcn_s_sleep(8); }
    if (PROF_K >= 0 && blockIdx.x == 0 && T.tid == 0) { const unsigned long long t0_ = ((unsigned long long)MISC[17] << 32) | MISC[16], t1_ = ((unsigned long long)MISC[19] << 32) | MISC[18];
        const unsigned long long dt_ = (t1_ - t0_) * 8ull, te_ = __builtin_amdgcn_s_memrealtime(); while (__builtin_amdgcn_s_memrealtime() - te_ < dt_) __builtin_amdgcn_s_sleep(8); }
#undef IN
#undef SEAM
}

extern "C" void kernel_launch(void* const* d_in, const int* in_sizes, int n_in, void* d_out, int out_size, void* d_ws, size_t ws_size, hipStream_t stream) {
    static int grid = 0;
    if (grid == 0) {
        if (n_in != 22 || out_size != MLAT * DM || ws_size < WS_END) { fprintf(stderr, "kernel_launch: unexpected shapes (n_in %d out %d ws %zu)\n", n_in, out_size, ws_size); grid = -1; return; }
        int dev = 0, cus = 0;
        if (hipGetDevice(&dev) != hipSuccess || hipDeviceGetAttribute(&cus, hipDeviceAttributeMultiprocessorCount, dev) != hipSuccess) { grid = -1; return; }
        if (hipFuncSetAttribute((const void*)fwd_kernel, hipFuncAttributeMaxDynamicSharedMemorySize, LDS_BYTES) != hipSuccess) { fprintf(stderr, "kernel_launch: hipFuncSetAttribute failed\n"); grid = -1; return; }
        (void)hipGetLastError();
        grid = cus;
    }
    if (grid < 0) return;
    (void)hipMemsetAsync((char*)d_ws + WS_CTL, 0, CTL_ZERO_BYTES, stream);
    (void)hipMemsetAsync((char*)d_ws + WS_MODS, 0, 5 * NMODC * sizeof(float), stream);
    Args a{};
    for (int i = 0; i < 22; ++i) a.in[i] = (const float*)d_in[i];
    a.out = (float*)d_out; a.ws = (unsigned char*)d_ws;
#if ONE_LAUNCH
    a.ph_lo = 0; a.ph_hi = NPHASES;
    hipLaunchKernelGGL(fwd_kernel, dim3(grid), dim3(NTHREADS), LDS_BYTES, stream, a);
#else
    for (int p = 0; p < NPHASES; ++p) { a.ph_lo = p; a.ph_hi = p + 1; hipLaunchKernelGGL(fwd_kernel, dim3(grid), dim3(NTHREADS), LDS_BYTES, stream, a); }
#endif
}
```

```cpp
#include <hip/hip_runtime.h>
#include <cstdio>
#include <cstdint>
#ifndef PROF_S
#define PROF_S -1
#endif
#define PG8_PS_BEGIN() do { if (PROF_S == 20 && blockIdx.x == 0 && threadIdx.x == 0) { const unsigned long long t_ = __builtin_amdgcn_s_memrealtime(); volatile __attribute__((address_space(3))) unsigned* M_ = (volatile __attribute__((address_space(3))) unsigned*)(lds + 162816 + 320); M_[20] = (unsigned)t_; M_[21] = (unsigned)(t_ >> 32); } } while (0)
#define PG8_PS_END() do { if (PROF_S == 20 && blockIdx.x == 0 && threadIdx.x == 0) { const unsigned long long t_ = __builtin_amdgcn_s_memrealtime(); volatile __attribute__((address_space(3))) unsigned* M_ = (volatile __attribute__((address_space(3))) unsigned*)(lds + 162816 + 320); \
    const unsigned long long p_ = ((unsigned long long)M_[21] << 32) | M_[20]; const unsigned long long a_ = (((unsigned long long)M_[23] << 32) | M_[22]) + (t_ - p_); M_[22] = (unsigned)a_; M_[23] = (unsigned)(a_ >> 32); } } while (0)
namespace pg8 {
#define PG8_LAS __attribute__((address_space(3)))
typedef unsigned short bf16_t;
typedef short bf16x8 __attribute__((ext_vector_type(8)));
typedef float f32x4 __attribute__((ext_vector_type(4)));
typedef unsigned u32x4 __attribute__((ext_vector_type(4)));
constexpr int BM = 256, BK = 64, HALF = 128, HTB = HALF * BK * 2  , STAGE_BYTES = 8 * HTB, NXCD = 8, WGM = 8;

__host__ __device__ __forceinline__ int lds_byte(int r, int c) { const int st = (r >> 4) * 2 + (c >> 5), rr = r & 15, cc = c & 31, ob = rr * 64 + cc * 2; return st * 1024 + (ob ^ (((ob >> 9) & 1) << 5)); }
__host__ __device__ __forceinline__ void stage_rc(int b, int& R, int& C) { const int st = b / 1024, sb = b % 1024, swz = sb ^ (((sb >> 9) & 1) << 5); R = (st >> 1) * 16 + swz / 64; C = (st & 1) * 32 + (swz % 64) / 2; }
__host__ __device__ __forceinline__ int perm32(int rho) { const int n = rho >> 4, i = rho & 15; return 8 * (i >> 2) + 4 * n + (i & 3); }

struct Unit { int pm, pn, kofs, kt; };
struct Gemm { const bf16_t* A; const bf16_t* Bt; int M, N, K, ld; };

struct StaticOrder {
    int nM, nN, nwg, G, c;
    __host__ __device__ void init(int M, int N, int G_, int c_) { nM = M / BM; nN = N / BM; nwg = nM * nN; G = G_; c = c_; }
    __host__ __device__ bool next(int i, Unit& u) const {
        const long L = (long)i * G + c; if (L >= nwg) return false;
        int wgid = (int)L; { const int q = nwg / NXCD, r = nwg % NXCD, xcd = wgid % NXCD, off = wgid / NXCD; wgid = (xcd < r ? xcd * (q + 1) : r * (q + 1) + (xcd - r) * q) + off; }
        const int nig = WGM * nN, gid = wgid / nig, fm = gid * WGM, gsz = (nM - fm) < WGM ? (nM - fm) : WGM;
        u.pm = fm + ((wgid % nig) % gsz); u.pn = (wgid % nig) / gsz; u.kofs = 0; u.kt = 0; return true;
    }
    __device__ __forceinline__ void a_ready(const Unit&) const {}
    __device__ __forceinline__ void done(const Unit&) const {}
};
typedef float pg8_f32x2 __attribute__((ext_vector_type(2))); typedef __bf16 pg8_bf16x2 __attribute__((ext_vector_type(2)));
__device__ __forceinline__ unsigned cvt_pk_bf16(float lo, float hi) { const pg8_f32x2 v = {lo, hi}; const pg8_bf16x2 b = __builtin_convertvector(v, pg8_bf16x2); return __builtin_bit_cast(unsigned, b); }
typedef float f32x2 __attribute__((ext_vector_type(2)));
__device__ __forceinline__ float fast_sigmoid(float v) { return __builtin_amdgcn_rcpf(1.0f + __builtin_amdgcn_exp2f(-1.4426950408889634f * v)); }
__device__ __forceinline__ float fast_silu(float v) { return v * fast_sigmoid(v); }

struct EpiSwiglu {
    static constexpr bool PERM = true, AFTER_DRAIN = false;
    bf16_t* H; int ldh;
    __device__ __forceinline__ void operator()(const f32x4 (&acc)[2][2][4][2], const Unit& u, int wr, int wc, int fr, int fq) const {
        typedef float f2 __attribute__((ext_vector_type(2)));
        const int row0 = u.pm * BM + wr * 64 + fr, col0 = u.pn * HALF + wc * 32 + 8 * fq;
#pragma unroll
        for (int ai = 0; ai < 2; ++ai)
#pragma unroll
            for (int m = 0; m < 4; ++m) { bf16_t* rowp = H + (size_t)(row0 + ai * HALF + m * 16) * ldh + col0;
                unsigned wv[4];
#pragma unroll
                for (int n = 0; n < 2; ++n)
#pragma unroll
                    for (int h = 0; h < 2; ++h) {
                        const f2 g = {acc[ai][0][m][n][2 * h], acc[ai][0][m][n][2 * h + 1]}, uu = {acc[ai][1][m][n][2 * h], acc[ai][1][m][n][2 * h + 1]};
                        const f2 x = g * (-1.4426950408889634f);
                        f2 d; d.x = __builtin_amdgcn_exp2f(x.x); d.y = __builtin_amdgcn_exp2f(x.y); d = d + 1.0f;
                        f2 r; r.x = __builtin_amdgcn_rcpf(d.x); r.y = __builtin_amdgcn_rcpf(d.y);
                        const f2 o = (g * uu) * r;
                        wv[n * 2 + h] = cvt_pk_bf16(o.x, o.y); }
                u32x4 w; w.x = wv[0]; w.y = wv[1]; w.z = wv[2]; w.w = wv[3];
                __builtin_nontemporal_store(w, (u32x4*)rowp); }
    }
};

struct EpiResid {
    static constexpr bool PERM = false, AFTER_DRAIN = false;
    const float* base_lat; const float* base_ctx; float* out_lat; float* out_ctx; const float* gate; float coef;
    __device__ __forceinline__ void operator()(const f32x4 (&acc)[2][2][4][2], const Unit& u, int wr, int wc, int fr, int fq) const {
        const bool isctx = u.pm >= 64;
        const float* base = isctx ? base_ctx + (size_t)(u.pm - 64) * BM * 1024 : base_lat + (size_t)u.pm * BM * 1024;
        float* out = isctx ? out_ctx + (size_t)(u.pm - 64) * BM * 1024 : out_lat + (size_t)u.pm * BM * 1024;
        const float* g = gate + (size_t)(isctx ? 4 : (u.pm >> 4)) * 9216;
        const int col0 = u.pn * BM + wc * 32 + 4 * fq;
        f32x4 gv[2][2];
#pragma unroll
        for (int bj = 0; bj < 2; ++bj)
#pragma unroll
            for (int n = 0; n < 2; ++n) gv[bj][n] = *(const f32x4*)(g + col0 + bj * HALF + n * 16) * coef;
#pragma unroll
        for (int ai = 0; ai < 2; ++ai)
#pragma unroll
            for (int m = 0; m < 4; ++m) { const size_t off = (size_t)(ai * HALF + wr * 64 + m * 16 + fr) * 1024 + col0;
#pragma unroll
                for (int bj = 0; bj < 2; ++bj)
#pragma unroll
                    for (int n = 0; n < 2; ++n) { const f32x4 b = *(const f32x4*)(base + off + bj * HALF + n * 16);
                        *(f32x4*)(out + off + bj * HALF + n * 16) = b + gv[bj][n] * acc[ai][bj][m][n]; } }
    }
};

struct EpiProj {
    static constexpr bool PERM = true, AFTER_DRAIN = false;
    bf16_t* O; int ldc;
    template <int MODE>
    __device__ __forceinline__ void body(const f32x4 (&acc)[2][2][4][2], int row0, int col0) const {
#pragma unroll
        for (int ai = 0; ai < 2; ++ai)
#pragma unroll
            for (int m = 0; m < 4; ++m) { bf16_t* rowp = O + (size_t)(row0 + ai * HALF + m * 16) * ldc + col0;
#pragma unroll
                for (int bj = 0; bj < 2; ++bj) { float r[8];
#pragma unroll
                    for (int n = 0; n < 2; ++n)
#pragma unroll
                        for (int i = 0; i < 4; ++i) { const float v = acc[ai][bj][m][n][i];
                            r[n * 4 + i] = MODE == 0 ? v : (MODE == 1 ? fast_silu(v) * 0.08838834764831845f : (MODE == 2 ? fast_silu(v) : fast_sigmoid(v))); }
                    u32x4 w; w.x = cvt_pk_bf16(r[0], r[1]); w.y = cvt_pk_bf16(r[2], r[3]); w.z = cvt_pk_bf16(r[4], r[5]); w.w = cvt_pk_bf16(r[6], r[7]);
                    *(u32x4*)(rowp + bj * HALF) = w; } }
    }
    __device__ __forceinline__ void operator()(const f32x4 (&acc)[2][2][4][2], const Unit& u, int wr, int wc, int fr, int fq) const {
        const int row0 = u.pm * BM + wr * 64 + fr, col0 = u.pn * BM + wc * 32 + 8 * fq;
        const int mode = (u.pn < 2) ? 1 : ((u.pn == 4 || u.pn == 5) ? 2 : (u.pn >= 14 ? 3 : 0));
        if (mode == 0) body<0>(acc, row0, col0); else if (mode == 1) body<1>(acc, row0, col0); else if (mode == 2) body<2>(acc, row0, col0); else body<3>(acc, row0, col0);
    }
};

struct DownOrder {
    StaticOrder lat; int c;
    __device__ __forceinline__ bool next(int i, Unit& u) const {
        if (i == 0) return lat.next(0, u);
        if (i != 1 || c >= 176) return false;
        const int ks = c % 11, t = c / 11; u.pn = t & 3; u.pm = 64 + (t >> 2); u.kofs = ks * 256; u.kt = 4; return true; }
    __device__ __forceinline__ void a_ready(const Unit&) const {}
    __device__ __forceinline__ void done(const Unit&) const {}
};
struct EpiDown1 {
    static constexpr bool PERM = true, AFTER_DRAIN = false;
    const float* base; bf16_t* out; const float* gate; float coef; bf16_t* slab;
    __device__ __forceinline__ void operator()(const f32x4 (&acc)[2][2][4][2], const Unit& u, int wr, int wc, int fr, int fq) const {
        const int col0 = u.pn * BM + wc * 32 + 8 * fq;
        if (u.kt) {
            bf16_t* o = slab + ((size_t)(u.kofs >> 8) * 1024 + (size_t)(u.pm - 64) * BM) * 1024 + col0;
#pragma unroll
            for (int ai = 0; ai < 2; ++ai)
#pragma unroll
                for (int m = 0; m < 4; ++m) { bf16_t* rowp = o + (size_t)(ai * HALF + wr * 64 + m * 16 + fr) * 1024;
#pragma unroll
                    for (int bj = 0; bj < 2; ++bj) { const f32x4 v0 = acc[ai][bj][m][0], v1 = acc[ai][bj][m][1];
                        u32x4 w; w.x = cvt_pk_bf16(v0[0], v0[1]); w.y = cvt_pk_bf16(v0[2], v0[3]); w.z = cvt_pk_bf16(v1[0], v1[1]); w.w = cvt_pk_bf16(v1[2], v1[3]);
                        *(u32x4*)(rowp + bj * HALF) = w; } }
            return;
        }
        const float* g = gate + (size_t)(u.pm >> 4) * 9216;
        f32x4 gv[2][2];
#pragma unroll
        for (int bj = 0; bj < 2; ++bj)
#pragma unroll
            for (int n = 0; n < 2; ++n) gv[bj][n] = *(const f32x4*)(g + col0 + bj * HALF + 4 * n) * coef;
#pragma unroll
        for (int ai = 0; ai < 2; ++ai)
#pragma unroll
            for (int m = 0; m < 4; ++m) { const size_t off = (size_t)(u.pm * BM + ai * HALF + wr * 64 + m * 16 + fr) * 1024 + col0;
#pragma unroll
                for (int bj = 0; bj < 2; ++bj) { const f32x4 b0 = *(const f32x4*)(base + off + bj * HALF), b1 = *(const f32x4*)(base + off + bj * HALF + 4);
                    const f32x4 v0 = b0 + gv[bj][0] * acc[ai][bj][m][0], v1 = b1 + gv[bj][1] * acc[ai][bj][m][1];
                    u32x4 w; w.x = cvt_pk_bf16(v0[0], v0[1]); w.y = cvt_pk_bf16(v0[2], v0[3]); w.z = cvt_pk_bf16(v1[0], v1[1]); w.w = cvt_pk_bf16(v1[2], v1[3]);
                    *(u32x4*)(out + off + bj * HALF) = w; } }
    }
};
struct ProjOrder {
    StaticOrder lat; int c;
    __device__ __forceinline__ bool next(int i, Unit& u) const {
        if (i < 4) return lat.next(i, u);
        if (i != 4 || c >= 144) return false;
        const int ks = c & 3, t = c >> 2, t9 = t % 9;
        u.pm = 64 + t / 9; u.pn = t9 < 2 ? 2 + t9 : (t9 < 6 ? 4 + t9 : 5 + t9); u.kofs = ks * 256; u.kt = 4; return true; }
    __device__ __forceinline__ void a_ready(const Unit&) const {}
    __device__ __forceinline__ void done(const Unit&) const {}
};
struct EpiProjAll {
    static constexpr bool PERM = true, AFTER_DRAIN = false;
    EpiProj lat; bf16_t* slab;
    __device__ __forceinline__ void operator()(const f32x4 (&acc)[2][2][4][2], const Unit& u, int wr, int wc, int fr, int fq) const {
        if (!u.kt) { lat(acc, u, wr, wc, fr, fq); return; }
        const int t9 = u.pn < 4 ? u.pn - 2 : (u.pn < 10 ? u.pn - 4 : u.pn - 5);
        bf16_t* out = slab + ((size_t)(u.kofs >> 8) * 1024 + (size_t)(u.pm - 64) * BM) * 2304 + t9 * 256 + wc * 32 + 8 * fq;
#pragma unroll
        for (int ai = 0; ai < 2; ++ai)
#pragma unroll
            for (int m = 0; m < 4; ++m) { bf16_t* rowp = out + (size_t)(ai * HALF + wr * 64 + m * 16 + fr) * 2304;
#pragma unroll
                for (int bj = 0; bj < 2; ++bj) { const f32x4 v0 = acc[ai][bj][m][0], v1 = acc[ai][bj][m][1];
                    u32x4 w; w.x = cvt_pk_bf16(v0[0], v0[1]); w.y = cvt_pk_bf16(v0[2], v0[3]); w.z = cvt_pk_bf16(v1[0], v1[1]); w.w = cvt_pk_bf16(v1[2], v1[3]);
                    *(u32x4*)(rowp + bj * HALF) = w; } }
    }
};

template <bool BASE_BF16>
struct EpiResidB {
    static constexpr bool PERM = true, AFTER_DRAIN = false;
    const void* base; bf16_t* out; const float* gate; float coef;
    __device__ __forceinline__ void operator()(const f32x4 (&acc)[2][2][4][2], const Unit& u, int wr, int wc, int fr, int fq) const {
        const float* g = gate + (size_t)(u.pm >> 4) * 9216;
        const int col0 = u.pn * BM + wc * 32 + 8 * fq;
        f32x4 gv[2][2];
#pragma unroll
        for (int bj = 0; bj < 2; ++bj)
#pragma unroll
            for (int n = 0; n < 2; ++n) gv[bj][n] = *(const f32x4*)(g + col0 + bj * HALF + 4 * n) * coef;
#pragma unroll
        for (int ai = 0; ai < 2; ++ai)
#pragma unroll
            for (int m = 0; m < 4; ++m) { const size_t off = (size_t)(u.pm * BM + ai * HALF + wr * 64 + m * 16 + fr) * 1024 + col0;
#pragma unroll
                for (int bj = 0; bj < 2; ++bj) { f32x4 b0, b1;
                    if (BASE_BF16) { const u32x4 bw = *(const u32x4*)((const bf16_t*)base + off + bj * HALF);
                        b0 = (f32x4){__builtin_bit_cast(float, bw.x << 16), __builtin_bit_cast(float, bw.x & 0xffff0000u), __builtin_bit_cast(float, bw.y << 16), __builtin_bit_cast(float, bw.y & 0xffff0000u)};
                        b1 = (f32x4){__builtin_bit_cast(float, bw.z << 16), __builtin_bit_cast(float, bw.z & 0xffff0000u), __builtin_bit_cast(float, bw.w << 16), __builtin_bit_cast(float, bw.w & 0xffff0000u)}; }
                    else { b0 = *(const f32x4*)((const float*)base + off + bj * HALF); b1 = *(const f32x4*)((const float*)base + off + bj * HALF + 4); }
                    const f32x4 v0 = b0 + gv[bj][0] * acc[ai][bj][m][0], v1 = b1 + gv[bj][1] * acc[ai][bj][m][1];
                    u32x4 w; w.x = cvt_pk_bf16(v0[0], v0[1]); w.y = cvt_pk_bf16(v0[2], v0[3]); w.z = cvt_pk_bf16(v1[0], v1[1]); w.w = cvt_pk_bf16(v1[2], v1[3]);
                    *(u32x4*)(out + off + bj * HALF) = w; } }
    }
};

template <class Epi, class Sched, bool ALIGN_EPI = false, bool SP2 = false>
__device__ __forceinline__ void gemm_phase(PG8_LAS unsigned char* lds, const Gemm g, const Sched& S, const Epi& E) {
    const int tid = threadIdx.x, wid = __builtin_amdgcn_readfirstlane(tid >> 6), lane = tid & 63, wr = wid >> 2, wc = wid & 3, fr = lane & 15, fq = lane >> 4;
    const int K = g.K, nt = K / BK, LD = g.ld;
    unsigned voffA[2], voffB[2];
#pragma unroll
    for (int i = 0; i < 2; ++i) { int R, C; stage_rc(tid * 16 + i * 8192, R, C); const int Rb = Epi::PERM ? ((R & ~31) + perm32(R & 31)) : R;
        voffA[i] = (unsigned)(R * LD + C) * 2u; voffB[i] = (unsigned)(Rb * LD + C) * 2u; }
    const size_t kstep = (size_t)(BK * 2);
    const size_t hstep = (size_t)HALF * LD * 2;
    const size_t tstep = 2 * hstep;
    const unsigned ldsw = (unsigned)wid * 1024u;
    const int aoff = lds_byte(wr * 64 + fr, fq * 8), boff = lds_byte(wc * 32 + fr, fq * 8);
#define PG8_SA(b, h) (((b) * 2 + (h)) * HTB)
#define PG8_SB(b, h) ((4 + (b) * 2 + (h)) * HTB)
#define PG8_STAGE(bufoff, gbase, voff) do { _Pragma("unroll") for (int _i = 0; _i < 2; ++_i) \
        __builtin_amdgcn_global_load_lds((const unsigned*)((const char*)(gbase) + (voff)[_i]), (PG8_LAS unsigned*)(lds + (bufoff) + ldsw + _i * 8192), 16, 0, 0); } while (0)
#define PG8_LDA(dst, b, h) do { _Pragma("unroll") for (int m = 0; m < 4; ++m) _Pragma("unroll") for (int k = 0; k < 2; ++k) dst[m][k] = *(const PG8_LAS bf16x8*)(lds + PG8_SA(b, h) + aoff + m * 2048 + k * 1024); } while (0)
#define PG8_LDB(dst, b, h) do { _Pragma("unroll") for (int n = 0; n < 2; ++n) _Pragma("unroll") for (int k = 0; k < 2; ++k) dst[n][k] = *(const PG8_LAS bf16x8*)(lds + PG8_SB(b, h) + boff + n * 2048 + k * 1024); } while (0)
#define PG8_MMA(ai, bj, At, Bt) do { __builtin_amdgcn_s_setprio(1); _Pragma("unroll") for (int m = 0; m < 4; ++m) _Pragma("unroll") for (int n = 0; n < 2; ++n) _Pragma("unroll") for (int k = 0; k < 2; ++k) \
        acc[ai][bj][m][n] = __builtin_amdgcn_mfma_f32_16x16x32_bf16(Bt[n][k], At[m][k], acc[ai][bj][m][n], 0, 0, 0); __builtin_amdgcn_s_setprio(0); } while (0)
#define PG8_WAIT_V(n) asm volatile("s_waitcnt vmcnt(" #n ")" ::: "memory")
#define PG8_WAIT_L(n) asm volatile("s_waitcnt lgkmcnt(" #n ")" ::: "memory")
#define PG8_BAR __builtin_amdgcn_s_barrier()
#define PG8_SCHED __builtin_amdgcn_sched_barrier(0)
    Unit cur, nxt; int ui = 0;
    if (!S.next(0, cur)) return;
    f32x4 acc[2][2][4][2];
#pragma unroll
    for (int a = 0; a < 2; ++a)
#pragma unroll
        for (int b = 0; b < 2; ++b)
#pragma unroll
            for (int m = 0; m < 4; ++m)
#pragma unroll
                for (int n = 0; n < 2; ++n) acc[a][b][m][n] = (f32x4){0.f, 0.f, 0.f, 0.f};
    bf16x8 At[4][2], B0[2][2], B1[2][2];
    const char* cA = (const char*)g.A + (size_t)cur.pm * tstep + (size_t)cur.kofs * 2; const char* cB = (const char*)g.Bt + (size_t)cur.pn * tstep + (size_t)cur.kofs * 2;
    S.a_ready(cur);
    if constexpr (SP2) {
        PG8_STAGE(PG8_SB(0, 0), cB, voffB); PG8_STAGE(PG8_SB(0, 1), cB + hstep, voffB); PG8_STAGE(PG8_SA(0, 0), cA, voffA); PG8_STAGE(PG8_SA(0, 1), cA + hstep, voffA);
        if (wr == 1) PG8_BAR;
        PG8_WAIT_V(2); PG8_BAR;
        PG8_STAGE(PG8_SB(1, 0), cB + kstep, voffB); PG8_STAGE(PG8_SA(1, 0), cA + kstep, voffA); PG8_STAGE(PG8_SB(1, 1), cB + hstep + kstep, voffB);
        PG8_WAIT_V(6); PG8_BAR;
    } else {
        PG8_STAGE(PG8_SB(0, 0), cB, voffB); PG8_STAGE(PG8_SA(0, 0), cA, voffA); PG8_STAGE(PG8_SB(0, 1), cB + hstep, voffB); PG8_STAGE(PG8_SA(0, 1), cA + hstep, voffA);
        if (wr == 1) PG8_BAR;
        PG8_WAIT_V(4); PG8_BAR;
        PG8_STAGE(PG8_SB(1, 0), cB + kstep, voffB); PG8_STAGE(PG8_SA(1, 0), cA + kstep, voffA); PG8_STAGE(PG8_SB(1, 1), cB + hstep + kstep, voffB);
        PG8_WAIT_V(6); PG8_BAR;
    }
    for (;;) {
        const bool has_next = S.next(ui + 1, nxt);
        const char* nA = has_next ? (const char*)g.A + (size_t)nxt.pm * tstep + (size_t)nxt.kofs * 2 : cA; const char* nB = has_next ? (const char*)g.Bt + (size_t)nxt.pn * tstep + (size_t)nxt.kofs * 2 : cB;
        const int ntu = cur.kt ? cur.kt : nt;
        for (int t = 0; t < ntu; t += 2) {
            const bool last = (t == ntu - 2);
            const char* a1 = cA + (size_t)(t + 1) * kstep;
            const char* a2 = last ? nA : cA + (size_t)(t + 2) * kstep; const char* b2 = last ? nB : cB + (size_t)(t + 2) * kstep;
            const char* a3 = a2 + kstep; const char* b3 = b2 + kstep;
            if (last && has_next) S.a_ready(nxt);
            if constexpr (SP2) {
            PG8_LDB(B0, 0, 0); PG8_LDB(B1, 0, 1); PG8_SCHED; PG8_LDA(At, 0, 0); PG8_STAGE(PG8_SA(1, 1), a1 + hstep, voffA);
            PG8_WAIT_V(8); PG8_WAIT_L(0); PG8_BAR; PG8_MMA(0, 0, At, B0); PG8_MMA(0, 1, At, B1); PG8_BAR; PG8_SCHED;
            PG8_LDA(At, 0, 1); PG8_STAGE(PG8_SB(0, 0), b2, voffB); PG8_STAGE(PG8_SB(0, 1), b2 + hstep, voffB); PG8_STAGE(PG8_SA(0, 0), a2, voffA);
            PG8_WAIT_V(8); PG8_WAIT_L(0); PG8_BAR; PG8_MMA(1, 0, At, B0); PG8_MMA(1, 1, At, B1); PG8_BAR; PG8_SCHED;
            PG8_LDB(B0, 1, 0); PG8_LDB(B1, 1, 1); PG8_SCHED; PG8_LDA(At, 1, 0); PG8_STAGE(PG8_SA(0, 1), a2 + hstep, voffA);
            PG8_WAIT_V(8); PG8_WAIT_L(0); PG8_BAR; PG8_MMA(0, 0, At, B0); PG8_MMA(0, 1, At, B1); PG8_BAR; PG8_SCHED;
            PG8_LDA(At, 1, 1); PG8_STAGE(PG8_SB(1, 0), b3, voffB); PG8_STAGE(PG8_SB(1, 1), b3 + hstep, voffB); PG8_STAGE(PG8_SA(1, 0), a3, voffA);
            PG8_WAIT_V(8); PG8_WAIT_L(0); PG8_BAR; PG8_MMA(1, 0, At, B0); PG8_MMA(1, 1, At, B1); PG8_BAR; PG8_SCHED;
            } else {
            PG8_LDB(B0, 0, 0); PG8_SCHED; PG8_LDA(At, 0, 0); PG8_STAGE(PG8_SA(1, 1), a1 + hstep, voffA);
            PG8_WAIT_L(8); PG8_BAR; PG8_WAIT_L(0); PG8_MMA(0, 0, At, B0); PG8_BAR; PG8_SCHED;
            PG8_LDB(B1, 0, 1); PG8_STAGE(PG8_SB(0, 0), b2, voffB);
            PG8_BAR; PG8_WAIT_L(0); PG8_MMA(0, 1, At, B1); PG8_BAR;
            PG8_LDA(At, 0, 1); PG8_STAGE(PG8_SA(0, 0), a2, voffA);
            PG8_BAR; PG8_WAIT_L(0); PG8_MMA(1, 0, At, B0); PG8_BAR; PG8_SCHED;
            PG8_STAGE(PG8_SB(0, 1), b2 + hstep, voffB);
            PG8_WAIT_V(6); PG8_BAR; PG8_MMA(1, 1, At, B1); PG8_BAR;
            PG8_LDB(B0, 1, 0); PG8_SCHED; PG8_LDA(At, 1, 0); PG8_STAGE(PG8_SA(0, 1), a2 + hstep, voffA);
            PG8_WAIT_L(8); PG8_BAR; PG8_WAIT_L(0); PG8_MMA(0, 0, At, B0); PG8_BAR; PG8_SCHED;
            PG8_LDB(B1, 1, 1); PG8_STAGE(PG8_SB(1, 0), b3, voffB);
            PG8_BAR; PG8_WAIT_L(0); PG8_MMA(0, 1, At, B1); PG8_BAR;
            PG8_LDA(At, 1, 1); PG8_STAGE(PG8_SA(1, 0), a3, voffA);
            PG8_BAR; PG8_WAIT_L(0); PG8_MMA(1, 0, At, B0); PG8_BAR; PG8_SCHED;
            PG8_STAGE(PG8_SB(1, 1), b3 + hstep, voffB);
            PG8_WAIT_V(6); PG8_BAR; PG8_MMA(1, 1, At, B1); PG8_BAR;
            }
        }
        if constexpr (ALIGN_EPI) { if (wr == 0) PG8_BAR; }
        if constexpr (!Epi::AFTER_DRAIN) { PG8_PS_BEGIN(); E(acc, cur, wr, wc, fr, fq); S.done(cur); PG8_PS_END(); }
        if (!has_next) break;
#pragma unroll
        for (int a = 0; a < 2; ++a)
#pragma unroll
            for (int b = 0; b < 2; ++b)
#pragma unroll
                for (int m = 0; m < 4; ++m)
#pragma unroll
                    for (int n = 0; n < 2; ++n) acc[a][b][m][n] = (f32x4){0.f, 0.f, 0.f, 0.f};
        cur = nxt; cA = nA; cB = nB; ++ui;
        if constexpr (ALIGN_EPI) { if (wr == 1) PG8_BAR; }
    }
    PG8_WAIT_V(0);
    if constexpr (!ALIGN_EPI) { if (wr == 0) PG8_BAR; }
    PG8_BAR;
    if constexpr (Epi::AFTER_DRAIN) { E.fused(acc, cur, wr, wc, fr, fq, lds, wid, lane); S.done(cur); }
#undef PG8_SA
#undef PG8_SB
#undef PG8_STAGE
#undef PG8_LDA
#undef PG8_LDB
#undef PG8_MMA
#undef PG8_WAIT_V
#undef PG8_WAIT_L
#undef PG8_BAR
#undef PG8_SCHED
}
}
constexpr int DM = 1024, NB = 4, SEQ = 4096, NCTX = 256, DFF = 2816, DIN = 4112, NPROJ = 4096, NMODC = 9216;
constexpr int LDP = 4224;
constexpr int MLAT = NB * SEQ, MCTX = NB * NCTX, MALL = MLAT + MCTX;
constexpr float EPSN = 1e-6f;
constexpr int NWAVES = 8, NTHREADS = 512;
#ifndef ONE_LAUNCH
#define ONE_LAUNCH 1
#endif
constexpr int NPHASES = 15;

constexpr size_t MiB = 1u << 20;
constexpr size_t WS_CTL = 0, CTL_ZERO_BYTES = 64 * 1024;
constexpr size_t WS_MODS = 1 * MiB;
constexpr size_t WS_GATES = 1 * MiB + 512 * 1024;
constexpr size_t WS_W1 = 3 * MiB;
constexpr size_t WS_W2 = 14 * MiB;
constexpr size_t WS_WIN = 20 * MiB;
constexpr size_t WS_WOUT = 28 * MiB;
constexpr size_t WS_XN = 34 * MiB;
constexpr size_t WS_PROJ = 68 * MiB;
constexpr size_t WS_QK = 209 * MiB;
constexpr size_t WS_END = 256 * MiB;
constexpr size_t WS_HGST = 237 * MiB;
constexpr size_t WS_HGG = 253 * MiB;
constexpr size_t WS_WG = 2 * MiB + 640 * 1024;
constexpr size_t WS_MLST = 226 * MiB;
constexpr size_t WS_MLSC = 236 * MiB;
constexpr size_t WS_SLAB = 204 * MiB;
constexpr size_t WS_SLAB2 = 237 * MiB;
constexpr int CW_BAR = 1024;

constexpr int RING_BYTES = 131072;
constexpr int LDSCTL_OFF = 162816, MISC_OFF = LDSCTL_OFF + 320;
constexpr int LDS_BYTES = 163840;

#define GAS __attribute__((address_space(1)))
#define LAS __attribute__((address_space(3)))
typedef unsigned short bf16;
typedef unsigned v4u __attribute__((ext_vector_type(4)));
typedef unsigned v2u __attribute__((ext_vector_type(2)));
typedef float f32x4 __attribute__((ext_vector_type(4)));
#define LDS_WAIT() asm volatile("s_waitcnt lgkmcnt(0)" ::: "memory")
#define VM_WAIT() asm volatile("s_waitcnt vmcnt(0)" ::: "memory")
__device__ __forceinline__ unsigned f2bf(float f) { unsigned u = __builtin_bit_cast(unsigned, f); return (u + 0x7fffu + ((u >> 16) & 1u)) >> 16; }
__device__ __forceinline__ unsigned pk2(float lo, float hi) { return f2bf(lo) | (f2bf(hi) << 16); }
__device__ __forceinline__ float bf2f(unsigned short h) { return __builtin_bit_cast(float, (unsigned)h << 16); }
__device__ __forceinline__ float bflo(unsigned w) { return __builtin_bit_cast(float, w << 16); }
__device__ __forceinline__ float bfhi(unsigned w) { return __builtin_bit_cast(float, w & 0xffff0000u); }
__device__ __forceinline__ float sigmoidf_(float v) { return 1.0f / (1.0f + __expf(-v)); }
__device__ __forceinline__ float fast_sig(float v) { return __builtin_amdgcn_rcpf(1.0f + __builtin_amdgcn_exp2f(-1.4426950408889634f * v)); }
__device__ __forceinline__ float siluf_(float v) { return v * sigmoidf_(v); }
__device__ __forceinline__ float wave_sum(float v) {
#pragma unroll
    for (int o = 1; o < 64; o <<= 1) v += __shfl_xor(v, o);
    return v;
}

#ifndef PROF_S
#define PROF_S -1
#endif
#define PS_BEGIN() do { if (PROF_S >= 0 && blockIdx.x == 0 && threadIdx.x == 0) { const unsigned long long t_ = __builtin_amdgcn_s_memrealtime(); volatile LAS unsigned* M_ = (volatile LAS unsigned*)(T.lds + MISC_OFF); M_[20] = (unsigned)t_; M_[21] = (unsigned)(t_ >> 32); } } while (0)
#define PS_END(id) do { if (PROF_S >= 0 && blockIdx.x == 0 && threadIdx.x == 0) { const unsigned long long t_ = __builtin_amdgcn_s_memrealtime(); volatile LAS unsigned* M_ = (volatile LAS unsigned*)(T.lds + MISC_OFF); \
    if ((id) == PROF_S) { const unsigned long long p_ = ((unsigned long long)M_[21] << 32) | M_[20]; const unsigned long long a_ = (((unsigned long long)M_[23] << 32) | M_[22]) + (t_ - p_); M_[22] = (unsigned)a_; M_[23] = (unsigned)(a_ >> 32); } \
    M_[20] = (unsigned)t_; M_[21] = (unsigned)(t_ >> 32); } } while (0)
#define XB_TMO      128
#define XB_XCNT(j)  (256  + 64 * (j))
#define XB_XSUB(j)  (1280 + 64 * (j))
#define XB_XGEN(j)  (2304 + 64 * (j))
#define XB_TOP      3328
#define XB_TOPGEN   3392
#define XCD_BAR_WORDS 3456
#define XB_SPIN_CAP (1u << 18)

__device__ __forceinline__ unsigned xb_ld(unsigned* p)              { return __hip_atomic_load(p, __ATOMIC_RELAXED, __HIP_MEMORY_SCOPE_AGENT); }
__device__ __forceinline__ unsigned xb_add(unsigned* p, unsigned v) { return __hip_atomic_fetch_add(p, v, __ATOMIC_RELAXED, __HIP_MEMORY_SCOPE_AGENT); }
__device__ __forceinline__ unsigned xb_xcc_id() { return (unsigned)__builtin_amdgcn_s_getreg((3 << 11) | 20) & 0xFu; }
#define XB_SPIN(cond, bar) do { unsigned _sp = 0; while (cond) { __builtin_amdgcn_s_sleep(1); \
    if ((++_sp & 255u) == 0u) { if (xb_ld(&(bar)[XB_TMO])) break; if (_sp > XB_SPIN_CAP) { atomicAdd(&(bar)[XB_TMO], 1u); break; } } } } while (0)

struct XcdBarrier {
    unsigned* bar; unsigned x;
    volatile LAS unsigned* st;
};

__device__ __forceinline__ XcdBarrier xcd_barrier_post(unsigned* bar, volatile LAS unsigned* st) {
    XcdBarrier b; b.bar = bar; b.x = xb_xcc_id(); b.st = st;
    if (threadIdx.x == 0) (void)xb_add(&bar[XB_XCNT(b.x)], 1u);
    return b;
}
__device__ __forceinline__ void xcd_barrier_complete(unsigned* bar, unsigned x, unsigned& nloc, unsigned& nx) {
    const unsigned G = gridDim.x * gridDim.y * gridDim.z;
    unsigned sum, cnt, mine, sp = 0u;
    for (;;) {
        sum = 0u; cnt = 0u; mine = 0u;
#pragma unroll
        for (unsigned j = 0; j < 16; ++j) { const unsigned c = xb_ld(&bar[XB_XCNT(j)]); sum += c; cnt += (c > 0u) ? 1u : 0u; mine = (j == x) ? c : mine; }
        if (sum == G) break;
        __builtin_amdgcn_s_sleep(1);
        if ((++sp & 255u) == 0u) { if (xb_ld(&bar[XB_TMO])) break; if (sp > XB_SPIN_CAP) { atomicAdd(&bar[XB_TMO], 1u); break; } }
    }
    nloc = mine > 0u ? mine : 1u; nx = cnt > 0u ? cnt : 1u;
}

__device__ __forceinline__ void xcd_barrier(const XcdBarrier& b) {
    asm volatile("s_waitcnt vmcnt(0)" ::: "memory");
    __syncthreads();
    if (threadIdx.x == 0) {
        unsigned* bar = b.bar;
        __builtin_amdgcn_s_waitcnt(0);
        unsigned nloc = b.st[0], nx = b.st[1];
        if (nloc == 0u) { xcd_barrier_complete(bar, b.x, nloc, nx); b.st[0] = nloc; b.st[1] = nx; }
        const unsigned old = xb_add(&bar[XB_XSUB(b.x)], 1u);
        const unsigned gen = old / nloc;
        if (old + 1u == (gen + 1u) * nloc) {
            __builtin_amdgcn_fence(__ATOMIC_RELEASE, "agent");
            asm volatile("s_waitcnt vmcnt(0)" ::: "memory");
            const unsigned og = xb_add(&bar[XB_TOP], 1u);
            const unsigned tg = og / nx;
            if (og + 1u == (tg + 1u) * nx) xb_add(&bar[XB_TOPGEN], 1u);
            else XB_SPIN(xb_ld(&bar[XB_TOPGEN]) == tg, bar);
            __builtin_amdgcn_fence(__ATOMIC_ACQUIRE, "agent");
            xb_add(&bar[XB_XGEN(b.x)], 1u);
            asm volatile("s_waitcnt vmcnt(0)" ::: "memory");
        } else {
            XB_SPIN(xb_ld(&bar[XB_XGEN(b.x)]) == gen, bar);
            __builtin_amdgcn_fence(__ATOMIC_ACQUIRE, "agent");
            asm volatile("s_waitcnt vmcnt(0)" ::: "memory");
        }
    }
    __syncthreads();
}
struct Args {
    const float* in[22]; float* out; unsigned char* ws; int ph_lo, ph_hi;
};
enum { I_X = 0, I_C, I_CTX, I_CCTX, I_WMOD, I_BMOD, I_N1W, I_F1W1, I_F1W2, I_N2W, I_WIN, I_MLGB, I_CONVW, I_CONVB, I_LBLOG, I_HGNW, I_MLNW, I_WOUT, I_N3W, I_F2W1, I_F2W2, I_FNW };

struct Ctx {
    LAS unsigned char* lds;
    int tid, lane, wave, vcu, G, gw, NGW;
};

__device__ __forceinline__ void mods_phase(const Args& a, const Ctx& T) {
    LAS float* sL = (LAS float*)T.lds;
    LAS float* red = (LAS float*)(T.lds + 20480);
    const float* c = a.in[I_C]; const float* cc = a.in[I_CCTX];
    for (int i = T.tid; i < 5 * 1024; i += NTHREADS) { const int r = i >> 10, k = i & 1023; const float v = r < 4 ? c[r * 1024 + k] : cc[k]; sL[i] = siluf_(v); }
    __syncthreads();
    typedef float f2 __attribute__((ext_vector_type(2)));
    for (int item = T.vcu; item < 576; item += T.G) {
        const int cb = item >> 3, kr = item & 7; const int k0 = kr * 128 + T.wave * 16;
        const float* W = a.in[I_WMOD] + (size_t)k0 * NMODC + cb * 128 + 2 * T.lane;
        f2 wv[16];
#pragma unroll
        for (int k = 0; k < 16; ++k) wv[k] = __builtin_nontemporal_load((const f2*)(W + (size_t)k * NMODC));
        float acc[5][2];
#pragma unroll
        for (int r = 0; r < 5; ++r) { acc[r][0] = 0.f; acc[r][1] = 0.f; }
#pragma unroll
        for (int k = 0; k < 16; ++k)
#pragma unroll
            for (int r = 0; r < 5; ++r) { const float s = sL[r * 1024 + k0 + k]; acc[r][0] += s * wv[k].x; acc[r][1] += s * wv[k].y; }
#pragma unroll
        for (int r = 0; r < 5; ++r) *(LAS f2*)(red + (T.wave * 5 + r) * 128 + 2 * T.lane) = (f2){acc[r][0], acc[r][1]};
        __syncthreads();
        for (int o = T.tid; o < 640; o += NTHREADS) { const int r = o >> 7, cl = o & 127; float s = 0.f;
#pragma unroll
            for (int w = 0; w < 8; ++w) s += red[(w * 5 + r) * 128 + cl];
            const int col = cb * 128 + cl; if (kr == 0) s += a.in[I_BMOD][col];
            atomicAdd((float*)(a.ws + WS_MODS) + r * NMODC + col, s); }
        __syncthreads();
    }
}

__device__ __forceinline__ void transpose_item(const float* W, int ldw, int K, bf16* WT, int k0, int n0, int dest_row0, LAS float* scr, int lane) {
    float tv[32];
#pragma unroll
    for (int i = 0; i < 32; ++i) tv[i] = __builtin_nontemporal_load(W + (size_t)(k0 + 2 * i + (lane >> 5)) * ldw + n0 + (lane & 31));
#pragma unroll
    for (int i = 0; i < 32; ++i) scr[(2 * i + (lane >> 5)) * 33 + (lane & 31)] = tv[i];
    LDS_WAIT(); asm volatile("" ::: "memory");
    const int c = lane & 7;
#pragma unroll
    for (int j = 0; j < 4; ++j) { const int n = (lane >> 3) + 8 * j; const LAS float* s = scr + (8 * c) * 33 + n;
        v4u o; o.x = pk2(s[0 * 33], s[1 * 33]); o.y = pk2(s[2 * 33], s[3 * 33]); o.z = pk2(s[4 * 33], s[5 * 33]); o.w = pk2(s[6 * 33], s[7 * 33]);
        *(GAS v4u*)(WT + (size_t)(dest_row0 + n) * K + k0 + 8 * c) = o; }
    LDS_WAIT(); asm volatile("" ::: "memory");
}
__device__ __forceinline__ void convert_ffn(const Args& a, const Ctx& T, const float* w1, const float* w2) {
    LAS float* scr = (LAS float*)(T.lds + T.wave * 16384);
    bf16* W1 = (bf16*)(a.ws + WS_W1); bf16* W2 = (bf16*)(a.ws + WS_W2);
    constexpr int I1 = 16 * 176, I2 = 44 * 32;
    for (int it = T.gw; it < I1 + I2; it += T.NGW) {
        if (it < I1) { const int kb = it / 176, nb = it % 176, n0 = nb * 32;
            const int dest = n0 < DFF ? (n0 >> 7) * 256 + (n0 & 127) : ((n0 - DFF) >> 7) * 256 + 128 + ((n0 - DFF) & 127);
            transpose_item(w1, 2 * DFF, DM, W1, kb * 64, n0, dest, scr, T.lane); }
        else { const int r = it - I1, kb = r / 32, nb = r % 32; transpose_item(w2, DM, DFF, W2, kb * 64, nb * 32, nb * 32, scr, T.lane); }
    }
}
__device__ __forceinline__ void convert_mix(const Args& a, const Ctx& T) {
    LAS float* scr = (LAS float*)(T.lds + T.wave * 16384);
    bf16* WI = (bf16*)(a.ws + WS_WIN); bf16* WO = (bf16*)(a.ws + WS_WOUT);
    constexpr int I1 = 16 * 128, I2 = 16 * 32;
    for (int it = T.gw; it < I1 + I2; it += T.NGW) {
        if (it < I1) { const int kb = it / 128, nb = it % 128; transpose_item(a.in[I_WIN], DIN, DM, WI, kb * 64, nb * 32, nb * 32, scr, T.lane); }
        else { const int r = it - I1, kb = r / 32, nb = r % 32; transpose_item(a.in[I_WOUT], DM, DM, WO, kb * 64, nb * 32, nb * 32, scr, T.lane); }
    }
}

__device__ __forceinline__ void norm_load_row(f32x4 (&v)[4], const void* src_lat, bool latbf, const float* src_ctx, int m, int lane) {
    if (m < MLAT) {
        if (latbf) { const v2u* xr = (const v2u*)((const bf16*)src_lat + (size_t)m * DM) + lane;
#pragma unroll
            for (int j = 0; j < 4; ++j) { const v2u w = xr[64 * j]; v[j] = (f32x4){bflo(w.x), bfhi(w.x), bflo(w.y), bfhi(w.y)}; } }
        else { const f32x4* xr = (const f32x4*)((const float*)src_lat + (size_t)m * DM) + lane;
#pragma unroll
            for (int j = 0; j < 4; ++j) v[j] = xr[64 * j]; }
    } else { const f32x4* xr = (const f32x4*)(src_ctx + (size_t)(m - MLAT) * DM) + lane;
#pragma unroll
        for (int j = 0; j < 4; ++j) v[j] = xr[64 * j]; }
}
template <bool CTXSLAB, bool LATBF>
__device__ __forceinline__ void norm_mod_rows(const Args& a, const Ctx& T, const void* src_lat, const float* src_ctx, int nrows, const float* nw, int shift_idx, int scale_idx) {
    const float* mods = (const float*)(a.ws + WS_MODS);
    bf16* XN = (bf16*)(a.ws + WS_XN);
    f32x4 wv[4];
#pragma unroll
    for (int j = 0; j < 4; ++j) wv[j] = *((const f32x4*)nw + T.lane + 64 * j);
    f32x4 v[4];
    if (T.gw < nrows) norm_load_row(v, src_lat, LATBF, src_ctx, T.gw, T.lane);
    for (int m = T.gw; m < nrows; m += T.NGW) {
        const float* mr = mods + (size_t)(m < MLAT ? (m >> 12) : 4) * NMODC;
        f32x4 sh[4], sc[4];
#pragma unroll
        for (int j = 0; j < 4; ++j) { sh[j] = *((const f32x4*)(mr + shift_idx * 1024) + T.lane + 64 * j); sc[j] = *((const f32x4*)(mr + scale_idx * 1024) + T.lane + 64 * j); }
        f32x4 cur[4]; float s = 0.f;
        if (CTXSLAB && m >= MLAT) {
            const float* gr = mods + (size_t)4 * NMODC + 2 * 1024;
#pragma unroll
            for (int j = 0; j < 4; ++j) { f32x4 acc = (f32x4){0.f, 0.f, 0.f, 0.f};
#pragma unroll 1
                for (int ks = 0; ks < 11; ++ks) { const v2u sw_ = *((const v2u*)((const bf16*)(a.ws + WS_SLAB) + ((size_t)ks * 1024 + (m - MLAT)) * 1024) + T.lane + 64 * j); acc += (f32x4){bflo(sw_.x), bfhi(sw_.x), bflo(sw_.y), bfhi(sw_.y)}; }
                v[j] = v[j] + acc * (*((const f32x4*)gr + T.lane + 64 * j) * 0.5f); }
        }
#pragma unroll
        for (int j = 0; j < 4; ++j) { cur[j] = v[j]; s += (v[j].x * v[j].x + v[j].y * v[j].y) + (v[j].z * v[j].z + v[j].w * v[j].w); }
        { const int mn = m + T.NGW; if (mn < nrows) norm_load_row(v, src_lat, LATBF, src_ctx, mn, T.lane); }
        const float rstd = __builtin_amdgcn_rsqf(wave_sum(s) * (1.f / DM) + EPSN);
        unsigned long long* o8 = (unsigned long long*)(XN + (size_t)m * DM) + T.lane;
#pragma unroll
        for (int j = 0; j < 4; ++j) { const f32x4 y = (cur[j] * rstd * wv[j]) * (sc[j] + 1.0f) + sh[j];
            o8[64 * j] = (unsigned long long)pk2(y.x, y.y) | ((unsigned long long)pk2(y.z, y.w) << 32); }
    }
}

struct ConvTaps { v4u t[9]; };
__device__ __forceinline__ void conv_load(ConvTaps& R, const bf16* P, int m, int ch0) {
    const v4u z = (v4u){0u, 0u, 0u, 0u};
    const int b = m >> 12, t = m & 4095, r = t >> 6, c = t & 63;
#pragma unroll
    for (int dr = -1; dr <= 1; ++dr)
#pragma unroll
        for (int dc = -1; dc <= 1; ++dc) { const int rr = r + dr, c2 = c + dc; const bool ok = rr >= 0 && rr < 64 && c2 >= 0 && c2 < 64;
            R.t[(dr + 1) * 3 + dc + 1] = ok ? *(const v4u*)(P + (size_t)(b * 4096 + rr * 64 + c2) * LDP + 2560 + ch0) : z; }
}
__device__ __forceinline__ void ctx_combine(const Args& a, const Ctx& T) {
    const bf16* S2 = (const bf16*)(a.ws + WS_SLAB2); bf16* P = (bf16*)(a.ws + WS_PROJ);
    for (int task = T.vcu * NTHREADS + T.tid; task < 1024 * 256; task += T.G * NTHREADS) {
        const int r = task >> 8, q = task & 255; const int t8 = q >> 5, c8 = (q & 31) * 8; const int t9 = t8 < 6 ? t8 : t8 + 1;
        const int pn = t9 < 2 ? 2 + t9 : (t9 < 6 ? 4 + t9 : 5 + t9);
        float s[8] = {0.f, 0.f, 0.f, 0.f, 0.f, 0.f, 0.f, 0.f};
#pragma unroll
        for (int ks = 0; ks < 4; ++ks) { const v4u pv = *(const v4u*)(S2 + ((size_t)ks * 1024 + r) * 2304 + t9 * 256 + c8);
            s[0] += bflo(pv.x); s[1] += bfhi(pv.x); s[2] += bflo(pv.y); s[3] += bfhi(pv.y); s[4] += bflo(pv.z); s[5] += bfhi(pv.z); s[6] += bflo(pv.w); s[7] += bfhi(pv.w); }
        *(v4u*)(P + (size_t)(MLAT + r) * LDP + pn * 256 + c8) = (v4u){pk2(s[0], s[1]), pk2(s[2], s[3]), pk2(s[4], s[5]), pk2(s[6], s[7])};
    }
}
__device__ __forceinline__ void conv_phase(const Args& a, const Ctx& T) {
    const bf16* P = (const bf16*)(a.ws + WS_PROJ); bf16* QK = (bf16*)(a.ws + WS_QK);
    const float* cw = a.in[I_CONVW]; const float* cb = a.in[I_CONVB];
    const int gid = T.vcu * NTHREADS + T.tid; const int ch0 = (gid & 63) * 8; const int m0 = gid >> 6, mstep = (T.G * NTHREADS) >> 6;
    {
        float w[9][8], bias[8];
#pragma unroll
        for (int k = 0; k < 9; ++k)
#pragma unroll
            for (int i = 0; i < 8; ++i) w[k][i] = cw[k * 512 + ch0 + i];
#pragma unroll
        for (int i = 0; i < 8; ++i) bias[i] = cb[ch0 + i];
        const float sc = ch0 < 256 ? 0.125f : 1.0f;
        ConvTaps R;
        if (m0 < MLAT) conv_load(R, P, m0, ch0);
        for (int m = m0; m < MLAT; m += mstep) {
            float acc[8];
#pragma unroll
            for (int i = 0; i < 8; ++i) acc[i] = bias[i];
#pragma unroll
            for (int k = 0; k < 9; ++k) { const v4u pv = R.t[k];
                acc[0] += w[k][0] * bflo(pv.x); acc[1] += w[k][1] * bfhi(pv.x); acc[2] += w[k][2] * bflo(pv.y); acc[3] += w[k][3] * bfhi(pv.y);
                acc[4] += w[k][4] * bflo(pv.z); acc[5] += w[k][5] * bfhi(pv.z); acc[6] += w[k][6] * bflo(pv.w); acc[7] += w[k][7] * bfhi(pv.w); }
            if (m + mstep < MLAT) conv_load(R, P, m + mstep, ch0);
#pragma unroll
            for (int i = 0; i < 8; ++i) acc[i] = acc[i] * fast_sig(acc[i]) * sc;
            v4u o; o.x = pk2(acc[0], acc[1]); o.y = pk2(acc[2], acc[3]); o.z = pk2(acc[4], acc[5]); o.w = pk2(acc[6], acc[7]);
            *(v4u*)(QK + (size_t)m * 512 + ch0) = o;
        }
    }
    {
        const bf16* S2 = (const bf16*)(a.ws + WS_SLAB2);
#pragma unroll 1
        for (int task = gid; task < MCTX * 32; task += T.G * NTHREADS) {
            const int mc = task >> 5, c8 = (task & 31) * 8, b = mc >> 8, t = mc & 255;
            float acc[8];
#pragma unroll
            for (int i = 0; i < 8; ++i) acc[i] = cb[256 + c8 + i];
#pragma unroll 1
            for (int d = -1; d <= 1; ++d) { const int t2 = t + d; if (t2 < 0 || t2 >= 256) continue;
                float s[8] = {0.f, 0.f, 0.f, 0.f, 0.f, 0.f, 0.f, 0.f};
#pragma unroll
                for (int ks = 0; ks < 4; ++ks) { const v4u pv = *(const v4u*)(S2 + ((size_t)ks * 1024 + b * 256 + t2) * 2304 + 6 * 256 + c8);
                    s[0] += bflo(pv.x); s[1] += bfhi(pv.x); s[2] += bflo(pv.y); s[3] += bfhi(pv.y); s[4] += bflo(pv.z); s[5] += bfhi(pv.z); s[6] += bflo(pv.w); s[7] += bfhi(pv.w); }
                const float* wk = cw + (3 + d + 1) * 512 + 256 + c8;
#pragma unroll
                for (int i = 0; i < 8; ++i) acc[i] += wk[i] * bf2f((unsigned short)f2bf(s[i])); }
#pragma unroll
            for (int i = 0; i < 8; ++i) acc[i] = acc[i] * fast_sig(acc[i]);
            v4u o; o.x = pk2(acc[0], acc[1]); o.y = pk2(acc[2], acc[3]); o.z = pk2(acc[4], acc[5]); o.w = pk2(acc[6], acc[7]);
            *(v4u*)(QK + (size_t)(MLAT + mc) * 512 + 256 + c8) = o;
        }
    }
}

typedef short bf16x8 __attribute__((ext_vector_type(8)));
typedef float f32x2 __attribute__((ext_vector_type(2)));
#define MFMA16(a, b, c) __builtin_amdgcn_mfma_f32_16x16x32_bf16((a), (b), (c), 0, 0, 0)
template <int KSTEPS>
__device__ __forceinline__ void mma_tile(f32x4& acc, const LAS unsigned char* A, int sa, const LAS unsigned char* B, int sb, int lane) {
    const LAS unsigned char* pa = A + (lane & 15) * sa + (lane >> 4) * 16; const LAS unsigned char* pb = B + (lane & 15) * sb + (lane >> 4) * 16;
#pragma unroll
    for (int ks = 0; ks < KSTEPS; ++ks) { const bf16x8 av = *(const LAS bf16x8*)(pa + ks * 64); const bf16x8 bv = *(const LAS bf16x8*)(pb + ks * 64); acc = MFMA16(av, bv, acc); }
}
typedef __bf16 bf16x2_t __attribute__((ext_vector_type(2)));
__device__ __forceinline__ unsigned cvtpk(float lo, float hi) { const f32x2 v = {lo, hi}; const bf16x2_t b = __builtin_convertvector(v, bf16x2_t); return __builtin_bit_cast(unsigned, b); }
struct BF2 { bf16x8 k0, k1; };
struct BF4 { bf16x8 k0, k1, k2, k3; };
__device__ __forceinline__ BF2 ldfrag2(const LAS unsigned char* B, int sb, int lane) { const LAS unsigned char* p = B + (lane & 15) * sb + (lane >> 4) * 16; BF2 f; f.k0 = *(const LAS bf16x8*)p; f.k1 = *(const LAS bf16x8*)(p + 64); return f; }
__device__ __forceinline__ BF4 ldfrag4(const LAS unsigned char* B, int sb, int lane) { const LAS unsigned char* p = B + (lane & 15) * sb + (lane >> 4) * 16; BF4 f; f.k0 = *(const LAS bf16x8*)p; f.k1 = *(const LAS bf16x8*)(p + 64); f.k2 = *(const LAS bf16x8*)(p + 128); f.k3 = *(const LAS bf16x8*)(p + 192); return f; }
__device__ __forceinline__ void mma2(f32x4& acc, const LAS unsigned char* A, int sa, const BF2& b, int lane) { const LAS unsigned char* p = A + (lane & 15) * sa + (lane >> 4) * 16;
    acc = MFMA16(*(const LAS bf16x8*)p, b.k0, acc); acc = MFMA16(*(const LAS bf16x8*)(p + 64), b.k1, acc); }
__device__ __forceinline__ void mma4(f32x4& acc, const LAS unsigned char* A, int sa, const BF4& b, int lane) { const LAS unsigned char* p = A + (lane & 15) * sa + (lane >> 4) * 16;
    acc = MFMA16(*(const LAS bf16x8*)p, b.k0, acc); acc = MFMA16(*(const LAS bf16x8*)(p + 64), b.k1, acc); acc = MFMA16(*(const LAS bf16x8*)(p + 128), b.k2, acc); acc = MFMA16(*(const LAS bf16x8*)(p + 192), b.k3, acc); }
__device__ __forceinline__ float ex2(float v) { return __builtin_amdgcn_exp2f(v); }
__device__ __forceinline__ float lg2(float v) { return __builtin_amdgcn_logf(v); }

constexpr int HS_ND = 272;
constexpr int HS_T = 160;
constexpr int HL_QD = 0, HL_KD = HL_QD + 64 * HS_ND, HL_X = HL_KD + 64 * HS_ND, HL_QE = HL_X + 64 * HS_ND;
constexpr int HL_KTT = HL_QE + 64 * HS_ND;
constexpr int HL_VT = HL_KTT + 128 * HS_T;
constexpr int HL_ST = HL_VT + 128 * HS_T;
constexpr int HL_P = HL_ST + 128 * HS_ND;
constexpr int HL_SEG = HL_P + 64 * HS_T;
constexpr int HL_FAC = HL_SEG + 4096;
constexpr int HL_NW = HL_FAC + 512;
constexpr int HL_END = HL_NW + 512;
constexpr int HL_OT = HL_QD, OT_S = 132 * 4;
static_assert(64 * OT_S <= 2 * 64 * HS_ND, "o tile overlay");
static_assert(HL_END <= 160 * 1024 - 1024, "HGRN2 LDS map");

constexpr size_t HG_SLOT_BYTES = 128 * 128 * 2;
__device__ __forceinline__ size_t hg_seq(int b, int dir, int head) { return (size_t)((b * 2 + dir) * 4 + head); }

__device__ __forceinline__ int sc_row(int b, int dir, int js, int lt) {
    if (js == 0) return MLAT + b * NCTX + (dir ? NCTX - 1 - lt : lt);
    const int q = 256 * (js - 1) + lt; return b * SEQ + (dir ? SEQ - 1 - q : q);
}

constexpr int P1_S = 544;
constexpr int P1_KTT = 0, P1_VT = P1_KTT + 128 * P1_S, P1_SEG = P1_VT + 128 * P1_S, P1_END = P1_SEG + 4096;
static_assert(P1_END <= 159 * 1024, "pass-1 LDS map");
__device__ __forceinline__ int p1_row(int b, int blk, int lt) { return blk < 0 ? MLAT + b * NCTX + lt : b * SEQ + 256 * blk + lt; }
template <int DIR>
__device__ __forceinline__ void hg_p1_dir(const Args& a, const Ctx& T, int b, int head, int blk, int slot, bool load_v) {
    const bf16* P = (const bf16*)(a.ws + WS_PROJ);
    LAS unsigned char* L = T.lds;
    const int w = T.wave, l = T.lane, g = l >> 4, c16 = l & 15;
    const int ch = head * 128 + 2 * l;
    const float* lbl = a.in[I_LBLOG];
    float lb[2];
#pragma unroll
    for (int x = 0; x < 2; ++x) lb[x] = sigmoidf_(lbl[DIR * 512 + ch + x] - lbl[(2 + DIR) * 512 + ch + x]);
    unsigned fw[32];
#pragma unroll
    for (int i = 0; i < 32; ++i) fw[i] = *(const unsigned*)(P + (size_t)p1_row(b, blk, 32 * w + i) * LDP + (DIR ? 2048 : 1536) + ch);
    if (load_v) {
        unsigned vw[32];
#pragma unroll
        for (int i = 0; i < 32; ++i) vw[i] = *(const unsigned*)(P + (size_t)p1_row(b, blk, 32 * w + i) * LDP + 512 + ch);
#pragma unroll
        for (int x = 0; x < 2; ++x)
#pragma unroll
            for (int q = 0; q < 4; ++q) { unsigned pv[4];
#pragma unroll
                for (int i = 0; i < 8; i += 2) { const unsigned v0 = x ? (vw[8 * q + i] >> 16) : (vw[8 * q + i] & 0xffffu), v1 = x ? (vw[8 * q + i + 1] >> 16) : (vw[8 * q + i + 1] & 0xffffu); pv[i >> 1] = v0 | (v1 << 16); }
                *(LAS v4u*)(L + P1_VT + (2 * l + x) * P1_S + 64 * w + 16 * q) = (v4u){pv[0], pv[1], pv[2], pv[3]}; }
    }
    float tot[2] = {0.f, 0.f};
#pragma unroll
    for (int i = 0; i < 32; ++i) {
        const float s0 = fast_sig(bflo(fw[i])), s1 = fast_sig(bfhi(fw[i]));
        tot[0] += lg2(lb[0] + (1.f - lb[0]) * s0); tot[1] += lg2(lb[1] + (1.f - lb[1]) * s1); }
    *(LAS f32x2*)(L + P1_SEG + (w * 128 + 2 * l) * 4) = (f32x2){tot[0], tot[1]};
    __syncthreads();
    float after[2] = {0.f, 0.f}, all[2] = {0.f, 0.f};
#pragma unroll
    for (int ww = 0; ww < 8; ++ww) { const f32x2 t2 = *(const LAS f32x2*)(L + P1_SEG + (ww * 128 + 2 * l) * 4); all[0] += t2.x; all[1] += t2.y;
        if (DIR ? (ww < w) : (ww > w)) { after[0] += t2.x; after[1] += t2.y; } }
#pragma unroll
    for (int x = 0; x < 2; ++x) {
        float run = after[x];
#pragma unroll
        for (int q = 0; q < 4; ++q) { float kv[8];
#pragma unroll
            for (int ii = 0; ii < 8; ++ii) { const int i = DIR ? 8 * q + ii : 31 - (8 * q + ii);
                const float fp = x ? bfhi(fw[i]) : bflo(fw[i]); const float sg = fast_sig(fp); const float f = lb[x] + (1.f - lb[x]) * sg;
                kv[ii] = (1.f - lb[x]) * (1.f - sg) * ex2(run); run += lg2(f); }
            if (DIR) *(LAS v4u*)(L + P1_KTT + (2 * l + x) * P1_S + 64 * w + 16 * q) = (v4u){cvtpk(kv[0], kv[1]), cvtpk(kv[2], kv[3]), cvtpk(kv[4], kv[5]), cvtpk(kv[6], kv[7])};
            else *(LAS v4u*)(L + P1_KTT + (2 * l + x) * P1_S + 64 * w + 16 * (3 - q)) = (v4u){cvtpk(kv[7], kv[6]), cvtpk(kv[5], kv[4]), cvtpk(kv[3], kv[2]), cvtpk(kv[1], kv[0])};
        }
    }
    __syncthreads();
    f32x4 accS[8];
#pragma unroll
    for (int m = 0; m < 8; ++m) accS[m] = (f32x4){0.f, 0.f, 0.f, 0.f};
#pragma unroll
    for (int kh = 0; kh < 4; ++kh) {
        const BF2 vf = ldfrag2(L + P1_VT + 16 * w * P1_S + 128 * kh, P1_S, l);
#pragma unroll
        for (int mh = 0; mh < 8; mh += 4) { BF2 kf[4];
#pragma unroll
            for (int m = 0; m < 4; ++m) kf[m] = ldfrag2(L + P1_KTT + 16 * (mh + m) * P1_S + 128 * kh, P1_S, l);
#pragma unroll
            for (int m = 0; m < 4; ++m) accS[mh + m] = MFMA16(kf[m].k0, vf.k0, accS[mh + m]);
#pragma unroll
            for (int m = 0; m < 4; ++m) accS[mh + m] = MFMA16(kf[m].k1, vf.k1, accS[mh + m]); } }
    const size_t sidx = hg_seq(b, DIR, head) * 16 + slot;
    bf16* ST = (bf16*)(a.ws + WS_HGST + sidx * HG_SLOT_BYTES);
#pragma unroll
    for (int m = 0; m < 8; ++m) { v2u o; o.x = cvtpk(accS[m][0], accS[m][1]); o.y = cvtpk(accS[m][2], accS[m][3]); *(v2u*)(ST + (size_t)(16 * w + c16) * 128 + 16 * m + 4 * g) = o; }
    if (w == 0) *(f32x2*)((float*)(a.ws + WS_HGG) + sidx * 128 + 2 * l) = (f32x2){ex2(all[0]), ex2(all[1])};
}
__device__ __forceinline__ void hg_pass1_items(const Args& a, const Ctx& T0, int first, int stride, int limit) {
#pragma unroll 1
    for (int item = first; item < limit; item += stride) {
        Ctx T = T0; asm volatile("" : "+v"(T.lane)); T.tid = T.wave * 64 + T.lane;
        const int k = item & 15, head = (item >> 4) & 3, b = item >> 6;
        const int blkF = k == 0 ? -1 : (k == 15 ? 0 : k), slotF = k == 0 ? 0 : (k == 15 ? 1 : k + 1);
        const int blkB = k == 0 ? -1 : (k == 15 ? 15 : k), slotB = k == 0 ? 0 : (k == 15 ? 1 : 16 - k);
        __syncthreads();
        hg_p1_dir<0>(a, T, b, head, blkF, slotF, true);
        __syncthreads();
        hg_p1_dir<1>(a, T, b, head, blkB, slotB, blkB != blkF);
    }
}

__device__ __forceinline__ void hg_pass2(const Args& a, const Ctx& T) {
    const int ntask = 32 * 2048;
    for (int task = T.vcu * NTHREADS + T.tid; task < ntask; task += T.G * NTHREADS) {
        const int seq = task >> 11, el = (task & 2047) * 8, d0 = el & 127;
        float r[8];
#pragma unroll
        for (int i = 0; i < 8; ++i) r[i] = 0.f;
        for (int j = 0; j < 16; ++j) {
            v4u* p = (v4u*)(a.ws + WS_HGST + ((size_t)seq * 16 + j) * HG_SLOT_BYTES + (size_t)el * 2);
            const float* G = (const float*)(a.ws + WS_HGG) + ((size_t)seq * 16 + j) * 128 + d0;
            const v4u dv = *p; const f32x4 g0 = *(const f32x4*)G, g1 = *(const f32x4*)(G + 4);
            r[0] = g0.x * r[0] + bflo(dv.x); r[1] = g0.y * r[1] + bfhi(dv.x); r[2] = g0.z * r[2] + bflo(dv.y); r[3] = g0.w * r[3] + bfhi(dv.y);
            r[4] = g1.x * r[4] + bflo(dv.z); r[5] = g1.y * r[5] + bfhi(dv.z); r[6] = g1.z * r[6] + bflo(dv.w); r[7] = g1.w * r[7] + bfhi(dv.w);
            *p = (v4u){pk2(r[0], r[1]), pk2(r[2], r[3]), pk2(r[4], r[5]), pk2(r[6], r[7])};
        }
    }
}

struct HgP3Pre { unsigned fw[8], qw[8], vw[8]; };
__device__ __forceinline__ void hg_p3_load(HgP3Pre& R, const bf16* P, int b, int head, int jt, int step, int w, int l) {
    const int dir = step >> 2, c = step & 3; const int ch = head * 128 + 2 * l;
#pragma unroll
    for (int i = 0; i < 8; ++i) { const int lt = 64 * c + 8 * w + i; const size_t row = (size_t)(b * SEQ + 256 * jt + (dir ? 255 - lt : lt));
        R.fw[i] = *(const unsigned*)(P + row * LDP + (dir ? 2048 : 1536) + ch); R.qw[i] = *(const unsigned*)(P + row * LDP + ch); R.vw[i] = *(const unsigned*)(P + row * LDP + 512 + ch); }
}
__device__ __forceinline__ void hg_pass3_item(const Args& a, const Ctx& T0, int item, bf16* OUT) {
    const int jt = item & 15, head = (item >> 4) & 3, b = item >> 6;
    const bf16* P = (const bf16*)(a.ws + WS_PROJ);
    Ctx T = T0; asm volatile("" : "+v"(T.lane));
    T.tid = T.wave * 64 + T.lane;
    LAS unsigned char* L = T.lds;
    const int w = T.wave, l = T.lane, g = l >> 4, c16 = l & 15;
    const int ch = head * 128 + 2 * l;
    const float* lbl = a.in[I_LBLOG];
    __syncthreads();
    for (int i = T.tid; i < 64 * HS_T / 16; i += NTHREADS) *(LAS v4u*)(L + HL_P + i * 16) = (v4u){0u, 0u, 0u, 0u};
    if (T.tid < 128) *(LAS float*)(L + HL_NW + T.tid * 4) = a.in[I_HGNW][head * 128 + T.tid];
    HgP3Pre R;
    hg_p3_load(R, P, b, head, jt, 0, w, l);
    v4u stq[4];
#define HG_STATE_LOAD(dir_) do { const bf16* STg_ = (const bf16*)(a.ws + WS_HGST + (hg_seq(b, (dir_), head) * 16 + ((dir_) ? 15 - jt : jt)) * HG_SLOT_BYTES); \
        _Pragma("unroll") for (int q_ = 0; q_ < 4; ++q_) { const int idx_ = l + 64 * q_; stq[q_] = *(const v4u*)(STg_ + (size_t)(16 * w + (idx_ >> 4)) * 128 + (idx_ & 15) * 8); } } while (0)
    HG_STATE_LOAD(0);
    f32x4 accS[8];
    float lb[2] = {0.f, 0.f};
    const int ot = T.tid >> 3, opart = T.tid & 7;
#pragma unroll 1
    for (int step = 0; step < 8; ++step) {
        const int dir = step >> 2, c = step & 3;
        PS_BEGIN();
        if (c == 0) {
#pragma unroll
            for (int x = 0; x < 2; ++x) lb[x] = sigmoidf_(lbl[dir * 512 + ch + x] - lbl[(2 + dir) * 512 + ch + x]);
            if (dir == 1) { HG_STATE_LOAD(1); VM_WAIT(); __syncthreads(); if (w == 0) { __builtin_amdgcn_fence(__ATOMIC_ACQUIRE, "agent"); VM_WAIT(); } __syncthreads(); }
#pragma unroll
            for (int q = 0; q < 4; ++q) { const int idx = l + 64 * q; *(LAS v4u*)(L + HL_ST + (16 * w + (idx >> 4)) * HS_ND + (idx & 15) * 16) = stq[q]; }
            LDS_WAIT();
#pragma unroll
            for (int m = 0; m < 8; ++m) { const v2u sv = *(const LAS v2u*)(L + HL_ST + (16 * w + c16) * HS_ND + (16 * m + 4 * g) * 2); accS[m] = (f32x4){bflo(sv.x), bfhi(sv.x), bflo(sv.y), bfhi(sv.y)}; }
        }
        PS_END(11);
        float kk[2][8], cl[2][8]; unsigned qw[8], vw[8];
#pragma unroll
        for (int i = 0; i < 8; ++i) { qw[i] = R.qw[i]; vw[i] = R.vw[i]; }
#pragma unroll
        for (int x = 0; x < 2; ++x) { float run = 0.f;
#pragma unroll
            for (int i = 0; i < 8; ++i) { const float fp = x ? bfhi(R.fw[i]) : bflo(R.fw[i]); const float sg = fast_sig(fp); const float f = lb[x] + (1.f - lb[x]) * sg;
                kk[x][i] = (1.f - lb[x]) * (1.f - sg); run += lg2(f); cl[x][i] = run; } }
        if (step < 7) hg_p3_load(R, P, b, head, jt, step + 1, w, l);
        *(LAS f32x2*)(L + HL_SEG + (w * 128 + 2 * l) * 4) = (f32x2){cl[0][7], cl[1][7]};
        PS_END(0); __syncthreads(); PS_END(1);
        const int half = w >> 2;
        float pre[2], mid[2], fx[2], fqe[2], fkt[2];
#pragma unroll
        for (int x = 0; x < 2; ++x) {
            float tt[8];
#pragma unroll
            for (int ww = 0; ww < 8; ++ww) tt[ww] = *(const LAS float*)(L + HL_SEG + (ww * 128 + 2 * l + x) * 4);
            const float r15 = tt[0] + tt[1], r31 = r15 + tt[2] + tt[3], r47 = r31 + tt[4] + tt[5], r63 = r47 + tt[6] + tt[7];
            float p = 0.f;
#pragma unroll
            for (int ww = 0; ww < 8; ++ww) if (ww < w) p += tt[ww];
            pre[x] = p; mid[x] = half ? r47 : r15;
            fx[x] = half ? ex2(r47 - r31) : ex2(r31 - r15); fqe[x] = ex2(mid[x]); fkt[x] = ex2(r63 - mid[x]);
            if (w == 0) *(LAS float*)(L + HL_FAC + (2 * l + x) * 4) = ex2(r63);
        }
        float ktv[2][8];
#pragma unroll
        for (int i = 0; i < 8; ++i) {
            float qd[2], kd[2], xv[2], qe[2];
#pragma unroll
            for (int x = 0; x < 2; ++x) { const float cc = pre[x] + cl[x][i] - mid[x]; const float eq = ex2(cc), ek = ex2(-cc); const float q = x ? bfhi(qw[i]) : bflo(qw[i]);
                qd[x] = q * eq; kd[x] = kk[x][i] * ek; xv[x] = (half ? qd[x] : kd[x]) * fx[x]; qe[x] = qd[x] * fqe[x]; ktv[x][i] = kd[x] * fkt[x]; }
            const int off = (8 * w + i) * HS_ND + 4 * l;
            *(LAS unsigned*)(L + HL_QD + off) = cvtpk(qd[0], qd[1]); *(LAS unsigned*)(L + HL_KD + off) = cvtpk(kd[0], kd[1]);
            *(LAS unsigned*)(L + HL_X + off) = cvtpk(xv[0], xv[1]); *(LAS unsigned*)(L + HL_QE + off) = cvtpk(qe[0], qe[1]);
        }
#pragma unroll
        for (int x = 0; x < 2; ++x) {
            unsigned pv[4];
#pragma unroll
            for (int i = 0; i < 8; i += 2) { const unsigned v0 = x ? (vw[i] >> 16) : (vw[i] & 0xffffu), v1 = x ? (vw[i + 1] >> 16) : (vw[i + 1] & 0xffffu); pv[i >> 1] = v0 | (v1 << 16); }
            *(LAS v4u*)(L + HL_KTT + (2 * l + x) * HS_T + 16 * w) = (v4u){cvtpk(ktv[x][0], ktv[x][1]), cvtpk(ktv[x][2], ktv[x][3]), cvtpk(ktv[x][4], ktv[x][5]), cvtpk(ktv[x][6], ktv[x][7])};
            *(LAS v4u*)(L + HL_VT + (2 * l + x) * HS_T + 16 * w) = (v4u){pv[0], pv[1], pv[2], pv[3]};
        }
        PS_END(0); __syncthreads(); PS_END(1);
        const size_t orow = (size_t)(b * SEQ + 256 * jt + (dir ? 255 - (64 * c + ot) : 64 * c + ot));
        bf16* optr = OUT + orow * DM + head * 128 + 16 * opart;
        v4u pf0 = (v4u){0u, 0u, 0u, 0u}, pf1 = pf0, pg0 = pf0, pg1 = pf0;
        if (dir) { pf0 = *(const v4u*)optr; pf1 = *(const v4u*)(optr + 8); const bf16* gp = P + orow * LDP + 1024 + head * 128 + 16 * opart; pg0 = *(const v4u*)gp; pg1 = *(const v4u*)(gp + 8); }
        v2u ptile[2]; int paddr[2] = {-1, -1};
#pragma unroll
        for (int rep = 0; rep < 2; ++rep) { const int tix = w + 8 * rep;
            if (tix < 10) {
                const int I = tix < 1 ? 0 : (tix < 3 ? 1 : (tix < 6 ? 2 : 3)); const int J = tix - (I * (I + 1)) / 2;
                const bool same = (I >> 1) == (J >> 1);
                const int abase = same ? HL_KD : HL_X, bbase = same ? HL_QD : HL_X;
                const BF4 af = ldfrag4(L + abase + 16 * J * HS_ND, HS_ND, l), bf = ldfrag4(L + bbase + 16 * I * HS_ND, HS_ND, l);
                f32x4 at = (f32x4){0.f, 0.f, 0.f, 0.f};
                at = MFMA16(af.k0, bf.k0, at); at = MFMA16(af.k1, bf.k1, at); at = MFMA16(af.k2, bf.k2, at); at = MFMA16(af.k3, bf.k3, at);
                const int tloc = 16 * I + c16, s0 = 16 * J + 4 * g;
                float pr[4];
#pragma unroll
                for (int r = 0; r < 4; ++r) pr[r] = (s0 + r <= tloc) ? at[r] : 0.f;
                ptile[rep].x = cvtpk(pr[0], pr[1]); ptile[rep].y = cvtpk(pr[2], pr[3]); paddr[rep] = HL_P + tloc * HS_T + s0 * 2;
            } }
        f32x4 accO[4];
        { const BF4 sf = ldfrag4(L + HL_ST + 16 * w * HS_ND, HS_ND, l);
#pragma unroll
            for (int I = 0; I < 4; ++I) accO[I] = (f32x4){0.f, 0.f, 0.f, 0.f};
#pragma unroll
            for (int ih = 0; ih < 4; ih += 2) {
                const BF4 q0 = ldfrag4(L + HL_QE + ih * 16 * HS_ND, HS_ND, l), q1 = ldfrag4(L + HL_QE + (ih + 1) * 16 * HS_ND, HS_ND, l);
                accO[ih] = MFMA16(q0.k0, sf.k0, accO[ih]); accO[ih + 1] = MFMA16(q1.k0, sf.k0, accO[ih + 1]);
                accO[ih] = MFMA16(q0.k1, sf.k1, accO[ih]); accO[ih + 1] = MFMA16(q1.k1, sf.k1, accO[ih + 1]);
                accO[ih] = MFMA16(q0.k2, sf.k2, accO[ih]); accO[ih + 1] = MFMA16(q1.k2, sf.k2, accO[ih + 1]);
                accO[ih] = MFMA16(q0.k3, sf.k3, accO[ih]); accO[ih + 1] = MFMA16(q1.k3, sf.k3, accO[ih + 1]); } }
        const BF2 vf = ldfrag2(L + HL_VT + 16 * w * HS_T, HS_T, l);
#pragma unroll
        for (int mh = 0; mh < 8; mh += 4) {
            BF2 kf[4]; f32x4 gv[4];
#pragma unroll
            for (int m = 0; m < 4; ++m) { kf[m] = ldfrag2(L + HL_KTT + 16 * (mh + m) * HS_T, HS_T, l); gv[m] = *(const LAS f32x4*)(L + HL_FAC + (16 * (mh + m) + 4 * g) * 4); }
#pragma unroll
            for (int m = 0; m < 4; ++m) accS[mh + m] = accS[mh + m] * gv[m];
#pragma unroll
            for (int m = 0; m < 4; ++m) accS[mh + m] = MFMA16(kf[m].k0, vf.k0, accS[mh + m]);
#pragma unroll
            for (int m = 0; m < 4; ++m) accS[mh + m] = MFMA16(kf[m].k1, vf.k1, accS[mh + m]);
        }
#pragma unroll
        for (int rep = 0; rep < 2; ++rep) if (paddr[rep] >= 0) *(LAS v2u*)(L + paddr[rep]) = ptile[rep];
        PS_END(2); __syncthreads(); PS_END(1);
        { const BF2 p0 = ldfrag2(L + HL_P + 0 * 16 * HS_T, HS_T, l), p1 = ldfrag2(L + HL_P + 1 * 16 * HS_T, HS_T, l), p2 = ldfrag2(L + HL_P + 2 * 16 * HS_T, HS_T, l), p3 = ldfrag2(L + HL_P + 3 * 16 * HS_T, HS_T, l);
            accO[0] = MFMA16(p0.k0, vf.k0, accO[0]); accO[1] = MFMA16(p1.k0, vf.k0, accO[1]); accO[2] = MFMA16(p2.k0, vf.k0, accO[2]); accO[3] = MFMA16(p3.k0, vf.k0, accO[3]);
            accO[0] = MFMA16(p0.k1, vf.k1, accO[0]); accO[1] = MFMA16(p1.k1, vf.k1, accO[1]); accO[2] = MFMA16(p2.k1, vf.k1, accO[2]); accO[3] = MFMA16(p3.k1, vf.k1, accO[3]); }
#pragma unroll
        for (int m = 0; m < 8; ++m) { v2u o; o.x = cvtpk(accS[m][0], accS[m][1]); o.y = cvtpk(accS[m][2], accS[m][3]); *(LAS v2u*)(L + HL_ST + (16 * w + c16) * HS_ND + (16 * m + 4 * g) * 2) = o; }
#pragma unroll
        for (int I = 0; I < 4; ++I)
#pragma unroll
            for (int r = 0; r < 4; ++r) *(LAS float*)(L + HL_OT + (16 * I + 4 * g + r) * OT_S + (16 * w + c16) * 4) = accO[I][r];
        PS_END(3); __syncthreads(); PS_END(1);
        { float ov[16];
#pragma unroll
            for (int q = 0; q < 4; ++q) { const f32x4 t4 = *(const LAS f32x4*)(L + HL_OT + ot * OT_S + (16 * opart + 4 * q) * 4); ov[4 * q] = t4.x; ov[4 * q + 1] = t4.y; ov[4 * q + 2] = t4.z; ov[4 * q + 3] = t4.w; }
            if (dir) {
                float fo[16], gt[16];
#pragma unroll
                for (int q = 0; q < 4; ++q) { fo[2 * q] = bflo(pf0[q]); fo[2 * q + 1] = bfhi(pf0[q]); fo[8 + 2 * q] = bflo(pf1[q]); fo[8 + 2 * q + 1] = bfhi(pf1[q]);
                    gt[2 * q] = bflo(pg0[q]); gt[2 * q + 1] = bfhi(pg0[q]); gt[8 + 2 * q] = bflo(pg1[q]); gt[8 + 2 * q + 1] = bfhi(pg1[q]); }
                float ss = 0.f;
#pragma unroll
                for (int i = 0; i < 16; ++i) { ov[i] += fo[i]; ss += ov[i] * ov[i]; }
                ss += __shfl_xor(ss, 1); ss += __shfl_xor(ss, 2); ss += __shfl_xor(ss, 4);
                const float rstd = __builtin_amdgcn_rsqf(ss * (1.f / 128.f) + EPSN);
#pragma unroll
                for (int q = 0; q < 4; ++q) { const f32x4 nw4 = *(const LAS f32x4*)(L + HL_NW + (16 * opart + 4 * q) * 4);
                    ov[4 * q] *= rstd * nw4.x * gt[4 * q]; ov[4 * q + 1] *= rstd * nw4.y * gt[4 * q + 1]; ov[4 * q + 2] *= rstd * nw4.z * gt[4 * q + 2]; ov[4 * q + 3] *= rstd * nw4.w * gt[4 * q + 3]; }
            }
            *(v4u*)optr = (v4u){cvtpk(ov[0], ov[1]), cvtpk(ov[2], ov[3]), cvtpk(ov[4], ov[5]), cvtpk(ov[6], ov[7])};
            *(v4u*)(optr + 8) = (v4u){cvtpk(ov[8], ov[9]), cvtpk(ov[10], ov[11]), cvtpk(ov[12], ov[13]), cvtpk(ov[14], ov[15])}; }
        PS_END(4);
    }
}

constexpr int MS = 160;
constexpr int ML_Q = 0, ML_K = ML_Q + 64 * MS, ML_KTT = ML_K + 64 * MS, ML_VT = ML_KTT + 64 * MS, ML_CT = ML_VT + 144 * MS, ML_P = ML_CT + 144 * MS;
constexpr int ML_TA = ML_P + 64 * MS;
constexpr int ML_TMU = ML_TA + 1024, ML_TIW = ML_TMU + 1024, ML_TSW = ML_TIW + 1024, ML_TEM = ML_TSW + 1024;
constexpr int ML_TRI = ML_TEM + 1024;
constexpr int ML_SC = ML_TRI + 256;
constexpr int ML_NW = ML_SC + 64;
constexpr int ML_OT = ML_NW + 512;
constexpr int ML_END = ML_OT + 64 * OT_S;
static_assert(ML_END <= 159 * 1024, "mLSTM LDS map");
constexpr size_t ML_SLOT_BYTES = 144 * 64 * 2;
constexpr float LOG2E = 1.4426950408889634f;

__device__ __forceinline__ float wave_incl_sum(float v, int lane) {
#pragma unroll
    for (int o = 1; o < 64; o <<= 1) { const float t = __shfl_up(v, o); if (lane >= o) v += t; }
    return v;
}
__device__ __forceinline__ float wave_incl_max(float v, int lane) {
#pragma unroll
    for (int o = 1; o < 64; o <<= 1) { const float t = __shfl_up(v, o); if (lane >= o) v = fmaxf(v, t); }
    return v;
}
template <bool WHOLE>
__device__ __forceinline__ float ml_scalars256(LAS unsigned char* L, const float (&ig)[4], const float (&fg)[4], float m_prev, float& bsum, int lane, int tb = 0) {
    f32x4 B, av, mu;
    { float run = 0.f;
#pragma unroll
        for (int i = 0; i < 4; ++i) { run += (fminf(fg[i], 0.f) - log1pf(__expf(-fabsf(fg[i])))) * LOG2E; B[i] = run; } }
    { const float incl = wave_incl_sum(B[3], lane); B = B + (incl - B[3]); }
#pragma unroll
    for (int i = 0; i < 4; ++i) av[i] = ig[i] * LOG2E - B[i];
    *(LAS f32x4*)(L + tb + ML_TA + lane * 16) = av;
    { float pm = av[0]; mu[0] = pm; pm = fmaxf(pm, av[1]); mu[1] = pm; pm = fmaxf(pm, av[2]); mu[2] = pm; pm = fmaxf(pm, av[3]); mu[3] = pm;
        const float inclm = wave_incl_max(pm, lane); float exm = __shfl_up(inclm, 1); if (lane == 0) exm = m_prev; exm = fmaxf(exm, m_prev);
#pragma unroll
        for (int i = 0; i < 4; ++i) mu[i] = fmaxf(mu[i], exm); }
    *(LAS f32x4*)(L + tb + ML_TMU + lane * 16) = mu;
    { f32x4 te;
#pragma unroll
        for (int i = 0; i < 4; ++i) te[i] = ex2(-(B[i] + mu[i]));
        *(LAS f32x4*)(L + tb + ML_TEM + lane * 16) = te; }
    const float b255 = __shfl(B[3], 63), mu255 = __shfl(mu[3], 63);
    const int c = lane >> 4;
    const float mu_end = WHOLE ? mu255 : __shfl(mu[3], 16 * c + 15); float mu_start = __shfl(mu[3], (16 * c + 63) & 63); if (c == 0) mu_start = m_prev;
    { f32x4 ti;
#pragma unroll
        for (int i = 0; i < 4; ++i) ti[i] = ex2(mu_start - mu[i]);
        *(LAS f32x4*)(L + tb + ML_TIW + lane * 16) = ti; }
    { f32x4 ts;
#pragma unroll
        for (int i = 0; i < 4; ++i) ts[i] = ex2(av[i] - mu_end);
        *(LAS f32x4*)(L + tb + ML_TSW + lane * 16) = ts; }
    if ((lane & 15) == 0) *(LAS float*)(L + tb + ML_SC + c * 4) = ex2(mu_start - mu_end);
    bsum = b255;
    return b255 + mu255;
}
__device__ __forceinline__ void ml_aug_rows(LAS unsigned char* L, int tid) {
    for (int i = tid; i < 16 * 8; i += NTHREADS) { const int r = i >> 3, q = i & 7; const unsigned v = r == 0 ? 0x3F803F80u : 0u; *(LAS v4u*)(L + ML_VT + (128 + r) * MS + q * 16) = (v4u){v, v, v, v}; }
}
struct MlPre { unsigned kw[8], vw[8]; v4u qn, kn; };
#define ML_LOAD_KV(R, ROWF) do { \
    if (T.tid < 256) { const int dp_ = T.tid & 31, tg_ = T.tid >> 5; _Pragma("unroll") for (int i = 0; i < 8; ++i) { const size_t row_ = (size_t)(ROWF(8 * tg_ + i)); (R).kw[i] = *(const unsigned*)(QK + row_ * 512 + 256 + head * 64 + 2 * dp_); } } \
    { const int ep_ = T.tid & 63, tg_ = T.tid >> 6; _Pragma("unroll") for (int i = 0; i < 8; ++i) { const size_t row_ = (size_t)(ROWF(8 * tg_ + i)); (R).vw[i] = *(const unsigned*)(P + row_ * LDP + 3072 + head * 128 + 2 * ep_); } } \
} while (0)
#define ML_STORE_KV(R, cch) do { \
    if (T.tid < 256) { const int dp_ = T.tid & 31, tg_ = T.tid >> 5; \
        const f32x4 s0_ = *(const LAS f32x4*)(L + ML_TSW + ((cch) * 64 + 8 * tg_) * 4), s1_ = *(const LAS f32x4*)(L + ML_TSW + ((cch) * 64 + 8 * tg_ + 4) * 4); \
        const float sw_[8] = {s0_.x, s0_.y, s0_.z, s0_.w, s1_.x, s1_.y, s1_.z, s1_.w}; \
        _Pragma("unroll") for (int x = 0; x < 2; ++x) { float kv_[8]; _Pragma("unroll") for (int i = 0; i < 8; ++i) kv_[i] = (x ? bfhi((R).kw[i]) : bflo((R).kw[i])) * sw_[i]; \
            *(LAS v4u*)(L + ML_KTT + (2 * dp_ + x) * MS + 16 * tg_) = (v4u){cvtpk(kv_[0], kv_[1]), cvtpk(kv_[2], kv_[3]), cvtpk(kv_[4], kv_[5]), cvtpk(kv_[6], kv_[7])}; } } \
    { const int ep_ = T.tid & 63, tg_ = T.tid >> 6; \
        _Pragma("unroll") for (int x = 0; x < 2; ++x) { unsigned pv_[4]; \
            _Pragma("unroll") for (int i = 0; i < 8; i += 2) { const unsigned v0_ = x ? ((R).vw[i] >> 16) : ((R).vw[i] & 0xffffu), v1_ = x ? ((R).vw[i + 1] >> 16) : ((R).vw[i + 1] & 0xffffu); pv_[i >> 1] = v0_ | (v1_ << 16); } \
            *(LAS v4u*)(L + ML_VT + (2 * ep_ + x) * MS + 16 * tg_) = (v4u){pv_[0], pv_[1], pv_[2], pv_[3]}; } } \
} while (0)

constexpr int Q1_KTT = 0, Q1_VT = Q1_KTT + 64 * P1_S, Q1_TAB = Q1_VT + 144 * P1_S;
constexpr int Q1_TB = Q1_TAB - ML_TA;
static_assert(ML_SC + Q1_TB + 64 <= 159 * 1024, "mLSTM pass-1 LDS map");
template <int DIR>
__device__ __forceinline__ void ml_p1_dir(const Args& a, const Ctx& T, int b, int head, int blk, int slot, const unsigned (&kw)[16], const float (&ig)[4], const float (&fg)[4]) {
    LAS unsigned char* L = T.lds;
    const int w = T.wave, l = T.lane, g = l >> 4, c16 = l & 15;
    float mloc = 0.f, bsum = 0.f;
    if (w == 0) mloc = ml_scalars256<true>(L, ig, fg, -1e30f, bsum, l, Q1_TB);
    __syncthreads();
    { const int dp = T.tid & 31, tg = T.tid >> 5;
        float sw[16];
#pragma unroll
        for (int q = 0; q < 4; ++q) { const int s0 = 16 * tg + 4 * q;
            const f32x4 t4 = *(const LAS f32x4*)(L + Q1_TB + ML_TSW + (DIR ? 252 - s0 : s0) * 4);
            sw[4 * q] = DIR ? t4.w : t4.x; sw[4 * q + 1] = DIR ? t4.z : t4.y; sw[4 * q + 2] = DIR ? t4.y : t4.z; sw[4 * q + 3] = DIR ? t4.x : t4.w; }
#pragma unroll
        for (int x = 0; x < 2; ++x)
#pragma unroll
            for (int q = 0; q < 2; ++q) { float kv[8];
#pragma unroll
                for (int i = 0; i < 8; ++i) kv[i] = (x ? bfhi(kw[8 * q + i]) : bflo(kw[8 * q + i])) * sw[8 * q + i];
                *(LAS v4u*)(L + Q1_KTT + (2 * dp + x) * P1_S + 32 * tg + 16 * q) = (v4u){cvtpk(kv[0], kv[1]), cvtpk(kv[2], kv[3]), cvtpk(kv[4], kv[5]), cvtpk(kv[6], kv[7])}; } }
    __syncthreads();
    f32x4 accC[4], accCA = (f32x4){0.f, 0.f, 0.f, 0.f};
#pragma unroll
    for (int m = 0; m < 4; ++m) accC[m] = (f32x4){0.f, 0.f, 0.f, 0.f};
#pragma unroll
    for (int kh = 0; kh < 4; ++kh) {
        const BF2 vf = ldfrag2(L + Q1_VT + 16 * w * P1_S + 128 * kh, P1_S, l);
        BF2 kf[4];
#pragma unroll
        for (int m = 0; m < 4; ++m) kf[m] = ldfrag2(L + Q1_KTT + 16 * m * P1_S + 128 * kh, P1_S, l);
#pragma unroll
        for (int m = 0; m < 4; ++m) accC[m] = MFMA16(kf[m].k0, vf.k0, accC[m]);
#pragma unroll
        for (int m = 0; m < 4; ++m) accC[m] = MFMA16(kf[m].k1, vf.k1, accC[m]);
        if (w < 4) { const BF2 af = ldfrag2(L + Q1_VT + 128 * P1_S + 128 * kh, P1_S, l); const BF2 kfw = ldfrag2(L + Q1_KTT + 16 * w * P1_S + 128 * kh, P1_S, l);
            accCA = MFMA16(kfw.k0, af.k0, accCA); accCA = MFMA16(kfw.k1, af.k1, accCA); } }
    const size_t sidx = hg_seq(b, DIR, head) * 16 + slot;
    bf16* CT = (bf16*)(a.ws + WS_MLST + sidx * ML_SLOT_BYTES);
#pragma unroll
    for (int m = 0; m < 4; ++m) { v2u o; o.x = cvtpk(accC[m][0], accC[m][1]); o.y = cvtpk(accC[m][2], accC[m][3]); *(v2u*)(CT + (size_t)(16 * w + c16) * 64 + 16 * m + 4 * g) = o; }
    if (w < 4) { v2u o; o.x = cvtpk(accCA[0], accCA[1]); o.y = cvtpk(accCA[2], accCA[3]); *(v2u*)(CT + (size_t)(128 + c16) * 64 + 16 * w + 4 * g) = o; }
    if (T.tid == 0) { float* sc = (float*)(a.ws + WS_MLSC) + sidx * 4; sc[0] = mloc; sc[1] = bsum; }
}
__device__ __forceinline__ void ml_pass1_items(const Args& a, const Ctx& T0, int first, int stride, int limit) {
    const bf16* P = (const bf16*)(a.ws + WS_PROJ); const bf16* QK = (const bf16*)(a.ws + WS_QK); const float* GT = (const float*)(a.ws + WS_GATES);
    __syncthreads();
    for (int i = T0.tid; i < 16 * 32; i += NTHREADS) { const int r = i >> 5, q = i & 31; const unsigned v = r == 0 ? 0x3F803F80u : 0u; *(LAS v4u*)(T0.lds + Q1_VT + (128 + r) * P1_S + q * 16) = (v4u){v, v, v, v}; }
#pragma unroll 1
    for (int item = first; item < limit; item += stride) {
        Ctx T = T0; asm volatile("" : "+v"(T.lane)); T.tid = T.wave * 64 + T.lane;
        LAS unsigned char* L = T.lds;
        const int w = T.wave, l = T.lane;
        const int k = item & 15, head = (item >> 4) & 3, b = item >> 6;
        const int blkF = k == 0 ? -1 : (k == 15 ? 0 : k), slotF = k == 0 ? 0 : (k == 15 ? 1 : k + 1);
        const int blkB = k == 0 ? -1 : (k == 15 ? 15 : k), slotB = k == 0 ? 0 : (k == 15 ? 1 : 16 - k);
#pragma unroll 1
        for (int dir = 0; dir < 2; ++dir) {
            const int blk = dir ? blkB : blkF;
            float ig[4] = {0.f, 0.f, 0.f, 0.f}, fg[4] = {0.f, 0.f, 0.f, 0.f};
            if (w == 0) {
#pragma unroll
                for (int c = 0; c < 4; ++c) { const int u = 4 * l + c; const size_t row = (size_t)p1_row(b, blk, dir ? 255 - u : u); ig[c] = GT[row * 16 + (dir ? 8 : 0) + head]; fg[c] = GT[row * 16 + (dir ? 12 : 4) + head]; } }
            unsigned kw[16];
            { const int dp = T.tid & 31, tg = T.tid >> 5;
#pragma unroll
                for (int i = 0; i < 16; ++i) kw[i] = *(const unsigned*)(QK + (size_t)p1_row(b, blk, 16 * tg + i) * 512 + 256 + head * 64 + 2 * dp); }
            __syncthreads();
            if (dir == 0 || blkB != blkF) {
                const int ep = T.tid & 63, tg = T.tid >> 6; unsigned vw[32];
#pragma unroll
                for (int i = 0; i < 32; ++i) vw[i] = *(const unsigned*)(P + (size_t)p1_row(b, blk, 32 * tg + i) * LDP + 3072 + head * 128 + 2 * ep);
#pragma unroll
                for (int x = 0; x < 2; ++x)
#pragma unroll
                    for (int q = 0; q < 4; ++q) { unsigned pv[4];
#pragma unroll
                        for (int i = 0; i < 8; i += 2) { const unsigned v0 = x ? (vw[8 * q + i] >> 16) : (vw[8 * q + i] & 0xffffu), v1 = x ? (vw[8 * q + i + 1] >> 16) : (vw[8 * q + i + 1] & 0xffffu); pv[i >> 1] = v0 | (v1 << 16); }
                        *(LAS v4u*)(L + Q1_VT + (2 * ep + x) * P1_S + 64 * tg + 16 * q) = (v4u){pv[0], pv[1], pv[2], pv[3]}; }
            }
            if (dir == 0) ml_p1_dir<0>(a, T, b, head, blk, slotF, kw, ig, fg); else ml_p1_dir<1>(a, T, b, head, blk, slotB, kw, ig, fg);
        }
    }
}

__device__ __forceinline__ void pass2_all(const Args& a, const Ctx& T) {
    const int gid = T.vcu * NTHREADS + T.tid;
    if (gid < 32 * 2048) {
        const int seq = gid >> 11, el = (gid & 2047) * 8, d0 = el & 127;
        float r[8];
#pragma unroll
        for (int i = 0; i < 8; ++i) r[i] = 0.f;
#pragma unroll 1
        for (int j0 = 0; j0 < 16; j0 += 4) {
            v4u dv[4]; f32x4 g0[4], g1[4];
#pragma unroll
            for (int jj = 0; jj < 4; ++jj) { const size_t sidx = (size_t)seq * 16 + j0 + jj; dv[jj] = *(const v4u*)(a.ws + WS_HGST + sidx * HG_SLOT_BYTES + (size_t)el * 2);
                const float* G = (const float*)(a.ws + WS_HGG) + sidx * 128 + d0; g0[jj] = *(const f32x4*)G; g1[jj] = *(const f32x4*)(G + 4); }
#pragma unroll
            for (int jj = 0; jj < 4; ++jj) { const size_t sidx = (size_t)seq * 16 + j0 + jj;
                r[0] = g0[jj].x * r[0] + bflo(dv[jj].x); r[1] = g0[jj].y * r[1] + bfhi(dv[jj].x); r[2] = g0[jj].z * r[2] + bflo(dv[jj].y); r[3] = g0[jj].w * r[3] + bfhi(dv[jj].y);
                r[4] = g1[jj].x * r[4] + bflo(dv[jj].z); r[5] = g1[jj].y * r[5] + bfhi(dv[jj].z); r[6] = g1[jj].z * r[6] + bflo(dv[jj].w); r[7] = g1[jj].w * r[7] + bfhi(dv[jj].w);
                *(v4u*)(a.ws + WS_HGST + sidx * HG_SLOT_BYTES + (size_t)el * 2) = (v4u){cvtpk(r[0], r[1]), cvtpk(r[2], r[3]), cvtpk(r[4], r[5]), cvtpk(r[6], r[7])}; }
        }
    } else if (gid < 32 * 2048 + 32 * 1152) {
        const int t2 = gid - 32 * 2048; const int seq = t2 / 1152, el = (t2 % 1152) * 8;
        float r[8], m = 0.f;
#pragma unroll
        for (int i = 0; i < 8; ++i) r[i] = 0.f;
#pragma unroll 1
        for (int j0 = 0; j0 < 16; j0 += 4) {
            v4u dv[4]; float ml[4], bt[4];
#pragma unroll
            for (int jj = 0; jj < 4; ++jj) { const size_t sidx = (size_t)seq * 16 + j0 + jj; dv[jj] = *(const v4u*)(a.ws + WS_MLST + sidx * ML_SLOT_BYTES + (size_t)el * 2);
                const float* sc = (const float*)(a.ws + WS_MLSC) + sidx * 4; ml[jj] = sc[0]; bt[jj] = sc[1]; }
#pragma unroll
            for (int jj = 0; jj < 4; ++jj) { const size_t sidx = (size_t)seq * 16 + j0 + jj;
                const float mn = fmaxf(bt[jj] + m, ml[jj]); const float cA = ex2(bt[jj] + m - mn), cB = ex2(ml[jj] - mn); m = mn;
                r[0] = cA * r[0] + cB * bflo(dv[jj].x); r[1] = cA * r[1] + cB * bfhi(dv[jj].x); r[2] = cA * r[2] + cB * bflo(dv[jj].y); r[3] = cA * r[3] + cB * bfhi(dv[jj].y);
                r[4] = cA * r[4] + cB * bflo(dv[jj].z); r[5] = cA * r[5] + cB * bfhi(dv[jj].z); r[6] = cA * r[6] + cB * bflo(dv[jj].w); r[7] = cA * r[7] + cB * bfhi(dv[jj].w);
                *(v4u*)(a.ws + WS_MLST + sidx * ML_SLOT_BYTES + (size_t)el * 2) = (v4u){cvtpk(r[0], r[1]), cvtpk(r[2], r[3]), cvtpk(r[4], r[5]), cvtpk(r[6], r[7])};
                if (el == 0) ((float*)(a.ws + WS_MLSC))[sidx * 4 + 2] = mn; }
        }
    }
}

__device__ __forceinline__ void ml_pass3_item(const Args& a, const Ctx& T0, int item, bf16* OUT) {
    const int jt = item & 15, head = (item >> 4) & 3, b = item >> 6;
    const bf16* P = (const bf16*)(a.ws + WS_PROJ); const bf16* QK = (const bf16*)(a.ws + WS_QK); const float* GT = (const float*)(a.ws + WS_GATES);
    Ctx T = T0; asm volatile("" : "+v"(T.lane));
    T.tid = T.wave * 64 + T.lane;
    LAS unsigned char* L = T.lds;
    const int w = T.wave, l = T.lane, g = l >> 4, c16 = l & 15;
    __syncthreads();
    for (int i = T.tid; i < 64 * MS / 16; i += NTHREADS) *(LAS v4u*)(L + ML_P + i * 16) = (v4u){0u, 0u, 0u, 0u};
    ml_aug_rows(L, T.tid);
    if (T.tid < 128) *(LAS float*)(L + ML_NW + T.tid * 4) = a.in[I_MLNW][head * 128 + T.tid];
#define ML_ROW3(st_, lt_) (b * SEQ + 256 * jt + (((st_) >> 2) ? 255 - (64 * ((st_) & 3) + (lt_)) : 64 * ((st_) & 3) + (lt_)))
    MlPre R;
    const int qt = T.tid >> 3, qpart = T.tid & 7;
#define ML_LOAD_ALL(st_) do { ML_LOAD_KV(R, ROWF_); const size_t rq_ = (size_t)ML_ROW3((st_), qt); R.qn = *(const v4u*)(QK + rq_ * 512 + head * 64 + qpart * 8); R.kn = *(const v4u*)(QK + rq_ * 512 + 256 + head * 64 + qpart * 8); } while (0)
#define ROWF_(x_) ML_ROW3(0, (x_))
    ML_LOAD_ALL(0);
#undef ROWF_
    f32x4 accC[4], accCA = (f32x4){0.f, 0.f, 0.f, 0.f};
    v4u stq[2], sta[2];
#define ML_STATE_LOAD(dir_) do { const size_t sidx_ = hg_seq(b, (dir_), head) * 16 + ((dir_) ? 15 - jt : jt); const bf16* CTg_ = (const bf16*)(a.ws + WS_MLST + sidx_ * ML_SLOT_BYTES); \
        _Pragma("unroll") for (int q_ = 0; q_ < 2; ++q_) { const int idx_ = l + 64 * q_; stq[q_] = *(const v4u*)(CTg_ + (size_t)(16 * w + (idx_ >> 3)) * 64 + (idx_ & 7) * 8); \
            if (w == 4) sta[q_] = *(const v4u*)(CTg_ + (size_t)(128 + (idx_ >> 3)) * 64 + (idx_ & 7) * 8); } } while (0)
    ML_STATE_LOAD(0);
#pragma unroll 1
    for (int step = 0; step < 8; ++step) {
        const int dir = step >> 2, c = step & 3;
        PS_BEGIN();
        if (c == 0) {
            const size_t sidx = hg_seq(b, dir, head) * 16 + (dir ? 15 - jt : jt);
            if (dir == 1) { ML_STATE_LOAD(1); VM_WAIT(); __syncthreads(); if (w == 0) { __builtin_amdgcn_fence(__ATOMIC_ACQUIRE, "agent"); VM_WAIT(); } }
            __syncthreads();
#pragma unroll
            for (int q = 0; q < 2; ++q) { const int idx = l + 64 * q; *(LAS v4u*)(L + ML_CT + (16 * w + (idx >> 3)) * MS + (idx & 7) * 16) = stq[q];
                if (w == 4) *(LAS v4u*)(L + ML_CT + (128 + (idx >> 3)) * MS + (idx & 7) * 16) = sta[q]; }
            if (w == 0) { float ig[4], fg[4];
#pragma unroll
                for (int cc = 0; cc < 4; ++cc) { const int lt = 4 * l + cc; const size_t row = (size_t)ML_ROW3(4 * dir + (lt >> 6), lt & 63); ig[cc] = GT[row * 16 + (dir ? 8 : 0) + head]; fg[cc] = GT[row * 16 + (dir ? 12 : 4) + head]; }
                float bsum = 0.f; const float m0 = ((const float*)(a.ws + WS_MLSC))[sidx * 4 + 2]; (void)ml_scalars256<false>(L, ig, fg, m0, bsum, l); }
            __syncthreads();
#pragma unroll
            for (int m = 0; m < 4; ++m) { const v2u sv = *(const LAS v2u*)(L + ML_CT + (16 * w + c16) * MS + (16 * m + 4 * g) * 2); accC[m] = (f32x4){bflo(sv.x), bfhi(sv.x), bflo(sv.y), bfhi(sv.y)}; }
            if (w < 4) { const v2u sv = *(const LAS v2u*)(L + ML_CT + (128 + c16) * MS + (16 * w + 4 * g) * 2); accCA = (f32x4){bflo(sv.x), bfhi(sv.x), bflo(sv.y), bfhi(sv.y)}; }
        }
        PS_END(5);
        *(LAS v4u*)(L + ML_Q + qt * MS + qpart * 16) = R.qn; *(LAS v4u*)(L + ML_K + qt * MS + qpart * 16) = R.kn;
        ML_STORE_KV(R, c);
        if (step < 7) {
#define ROWF_(x_) ML_ROW3(step + 1, (x_))
            ML_LOAD_ALL(step + 1);
#undef ROWF_
        }
        PS_END(6); __syncthreads(); PS_END(10);
        const size_t orow = (size_t)ML_ROW3(step, qt);
        bf16* optr = OUT + orow * DM + 512 + head * 128 + 16 * qpart;
        v2u ptile[2]; int paddr[2] = {-1, -1};
#pragma unroll 1
        for (int rep = 0; rep < 2; ++rep) { const int tix = w + 8 * rep;
            if (tix < 10) {
                const int I = tix < 1 ? 0 : (tix < 3 ? 1 : (tix < 6 ? 2 : 3)); const int J = tix - (I * (I + 1)) / 2;
                const BF2 af = ldfrag2(L + ML_K + 16 * J * MS, MS, l), bf = ldfrag2(L + ML_Q + 16 * I * MS, MS, l);
                const int tloc = 16 * I + c16, s0 = 16 * J + 4 * g;
                const f32x4 av = *(const LAS f32x4*)(L + ML_TA + (c * 64 + s0) * 4); const float mu = *(const LAS float*)(L + ML_TMU + (c * 64 + tloc) * 4);
                f32x4 at = (f32x4){0.f, 0.f, 0.f, 0.f};
                at = MFMA16(af.k0, bf.k0, at); at = MFMA16(af.k1, bf.k1, at);
                float pr[4];
#pragma unroll
                for (int r = 0; r < 4; ++r) pr[r] = (s0 + r <= tloc) ? at[r] * ex2(av[r] - mu) : 0.f;
                ptile[rep].x = cvtpk(pr[0], pr[1]); ptile[rep].y = cvtpk(pr[2], pr[3]); paddr[rep] = ML_P + tloc * MS + s0 * 2;
            } }
        f32x4 accO[4], accOA = (f32x4){0.f, 0.f, 0.f, 0.f};
        const float carry = *(const LAS float*)(L + ML_SC + c * 4);
        const BF2 vf = ldfrag2(L + ML_VT + 16 * w * MS, MS, l);
        { const BF2 cf = ldfrag2(L + ML_CT + 16 * w * MS, MS, l);
            const BF2 q0 = ldfrag2(L + ML_Q + 0 * 16 * MS, MS, l), q1 = ldfrag2(L + ML_Q + 1 * 16 * MS, MS, l), q2 = ldfrag2(L + ML_Q + 2 * 16 * MS, MS, l), q3 = ldfrag2(L + ML_Q + 3 * 16 * MS, MS, l);
#pragma unroll
            for (int I = 0; I < 4; ++I) accO[I] = (f32x4){0.f, 0.f, 0.f, 0.f};
            accO[0] = MFMA16(q0.k0, cf.k0, accO[0]); accO[1] = MFMA16(q1.k0, cf.k0, accO[1]); accO[2] = MFMA16(q2.k0, cf.k0, accO[2]); accO[3] = MFMA16(q3.k0, cf.k0, accO[3]);
            accO[0] = MFMA16(q0.k1, cf.k1, accO[0]); accO[1] = MFMA16(q1.k1, cf.k1, accO[1]); accO[2] = MFMA16(q2.k1, cf.k1, accO[2]); accO[3] = MFMA16(q3.k1, cf.k1, accO[3]); }
        { const BF2 k0f = ldfrag2(L + ML_KTT + 0 * 16 * MS, MS, l), k1f = ldfrag2(L + ML_KTT + 1 * 16 * MS, MS, l), k2f = ldfrag2(L + ML_KTT + 2 * 16 * MS, MS, l), k3f = ldfrag2(L + ML_KTT + 3 * 16 * MS, MS, l);
#pragma unroll
            for (int I = 0; I < 4; ++I) accC[I] = accC[I] * carry;
            accC[0] = MFMA16(k0f.k0, vf.k0, accC[0]); accC[1] = MFMA16(k1f.k0, vf.k0, accC[1]); accC[2] = MFMA16(k2f.k0, vf.k0, accC[2]); accC[3] = MFMA16(k3f.k0, vf.k0, accC[3]);
            accC[0] = MFMA16(k0f.k1, vf.k1, accC[0]); accC[1] = MFMA16(k1f.k1, vf.k1, accC[1]); accC[2] = MFMA16(k2f.k1, vf.k1, accC[2]); accC[3] = MFMA16(k3f.k1, vf.k1, accC[3]); }
#pragma unroll
        for (int I = 0; I < 4; ++I) { const f32x4 iw = *(const LAS f32x4*)(L + ML_TIW + (c * 64 + 16 * I + 4 * g) * 4); accO[I] = accO[I] * iw; }
        BF2 af = vf;
        if (w < 4) { const BF2 cfa = ldfrag2(L + ML_CT + 128 * MS, MS, l), qw_ = ldfrag2(L + ML_Q + 16 * w * MS, MS, l), kw_ = ldfrag2(L + ML_KTT + 16 * w * MS, MS, l);
            af = ldfrag2(L + ML_VT + 128 * MS, MS, l);
            const f32x4 iwa = *(const LAS f32x4*)(L + ML_TIW + (c * 64 + 16 * w + 4 * g) * 4);
            accCA = accCA * carry;
            accOA = MFMA16(qw_.k0, cfa.k0, accOA); accCA = MFMA16(kw_.k0, af.k0, accCA); accOA = MFMA16(qw_.k1, cfa.k1, accOA); accCA = MFMA16(kw_.k1, af.k1, accCA);
            accOA = accOA * iwa; }
#pragma unroll
        for (int rep = 0; rep < 2; ++rep) if (paddr[rep] >= 0) *(LAS v2u*)(L + paddr[rep]) = ptile[rep];
        v4u pf0 = (v4u){0u, 0u, 0u, 0u}, pf1 = pf0, pg0 = pf0, pg1 = pf0;
        if (dir) { pf0 = *(const v4u*)optr; pf1 = *(const v4u*)(optr + 8); const bf16* gp = P + orow * LDP + 3584 + head * 128 + 16 * qpart; pg0 = *(const v4u*)gp; pg1 = *(const v4u*)(gp + 8); }
        PS_END(7); __syncthreads(); PS_END(10);
        { const BF2 p0 = ldfrag2(L + ML_P + 0 * 16 * MS, MS, l), p1 = ldfrag2(L + ML_P + 1 * 16 * MS, MS, l), p2 = ldfrag2(L + ML_P + 2 * 16 * MS, MS, l), p3 = ldfrag2(L + ML_P + 3 * 16 * MS, MS, l);
            accO[0] = MFMA16(p0.k0, vf.k0, accO[0]); accO[1] = MFMA16(p1.k0, vf.k0, accO[1]); accO[2] = MFMA16(p2.k0, vf.k0, accO[2]); accO[3] = MFMA16(p3.k0, vf.k0, accO[3]);
            accO[0] = MFMA16(p0.k1, vf.k1, accO[0]); accO[1] = MFMA16(p1.k1, vf.k1, accO[1]); accO[2] = MFMA16(p2.k1, vf.k1, accO[2]); accO[3] = MFMA16(p3.k1, vf.k1, accO[3]);
            if (w < 4) { const BF2 pw_ = ldfrag2(L + ML_P + 16 * w * MS, MS, l); accOA = MFMA16(pw_.k0, af.k0, accOA); accOA = MFMA16(pw_.k1, af.k1, accOA); } }
#pragma unroll
        for (int m = 0; m < 4; ++m) { v2u o; o.x = cvtpk(accC[m][0], accC[m][1]); o.y = cvtpk(accC[m][2], accC[m][3]); *(LAS v2u*)(L + ML_CT + (16 * w + c16) * MS + (16 * m + 4 * g) * 2) = o; }
        if (w < 4) { v2u o; o.x = cvtpk(accCA[0], accCA[1]); o.y = cvtpk(accCA[2], accCA[3]); *(LAS v2u*)(L + ML_CT + (128 + c16) * MS + (16 * w + 4 * g) * 2) = o;
            if (c16 == 0) { const f32x4 em = *(const LAS f32x4*)(L + ML_TEM + (c * 64 + 16 * w + 4 * g) * 4); f32x4 ri;
#pragma unroll
                for (int r = 0; r < 4; ++r) ri[r] = __builtin_amdgcn_rcpf(fmaxf(fabsf(accOA[r]), em[r]));
                *(LAS f32x4*)(L + ML_TRI + (16 * w + 4 * g) * 4) = ri; } }
#pragma unroll
        for (int I = 0; I < 4; ++I)
#pragma unroll
            for (int r = 0; r < 4; ++r) *(LAS float*)(L + ML_OT + (16 * I + 4 * g + r) * OT_S + (16 * w + c16) * 4) = accO[I][r];
        PS_END(8); __syncthreads(); PS_END(10);
        { float ov[16]; const float ri = *(const LAS float*)(L + ML_TRI + qt * 4);
#pragma unroll
            for (int q = 0; q < 4; ++q) { const f32x4 t4 = *(const LAS f32x4*)(L + ML_OT + qt * OT_S + (16 * qpart + 4 * q) * 4); ov[4 * q] = t4.x * ri; ov[4 * q + 1] = t4.y * ri; ov[4 * q + 2] = t4.z * ri; ov[4 * q + 3] = t4.w * ri; }
            if (dir) {
                float fo[16], gt[16];
#pragma unroll
                for (int q = 0; q < 4; ++q) { fo[2 * q] = bflo(pf0[q]); fo[2 * q + 1] = bfhi(pf0[q]); fo[8 + 2 * q] = bflo(pf1[q]); fo[8 + 2 * q + 1] = bfhi(pf1[q]);
                    gt[2 * q] = bflo(pg0[q]); gt[2 * q + 1] = bfhi(pg0[q]); gt[8 + 2 * q] = bflo(pg1[q]); gt[8 + 2 * q + 1] = bfhi(pg1[q]); }
                float ss = 0.f;
#pragma unroll
                for (int i = 0; i < 16; ++i) { ov[i] += fo[i]; ss += ov[i] * ov[i]; }
                ss += __shfl_xor(ss, 1); ss += __shfl_xor(ss, 2); ss += __shfl_xor(ss, 4);
                const float rstd = __builtin_amdgcn_rsqf(ss * (1.f / 128.f) + EPSN);
#pragma unroll
                for (int q = 0; q < 4; ++q) { const f32x4 nw4 = *(const LAS f32x4*)(L + ML_NW + (16 * qpart + 4 * q) * 4);
                    ov[4 * q] *= rstd * nw4.x * gt[4 * q]; ov[4 * q + 1] *= rstd * nw4.y * gt[4 * q + 1]; ov[4 * q + 2] *= rstd * nw4.z * gt[4 * q + 2]; ov[4 * q + 3] *= rstd * nw4.w * gt[4 * q + 3]; }
            }
            *(v4u*)optr = (v4u){cvtpk(ov[0], ov[1]), cvtpk(ov[2], ov[3]), cvtpk(ov[4], ov[5]), cvtpk(ov[6], ov[7])};
            *(v4u*)(optr + 8) = (v4u){cvtpk(ov[8], ov[9]), cvtpk(ov[10], ov[11]), cvtpk(ov[12], ov[13]), cvtpk(ov[14], ov[15])}; }
        PS_END(9);
    }
#undef ML_ROW3
#undef ML_LOAD_ALL
#undef ML_STATE_LOAD
}
__device__ __forceinline__ void final_norm_phase(const Args& a, const Ctx& T, const bf16* X3) {
    f32x4 wv[4];
#pragma unroll
    for (int j = 0; j < 4; ++j) wv[j] = *((const f32x4*)a.in[I_FNW] + T.lane + 64 * j);
    f32x4 v[4];
    if (T.gw < MLAT) norm_load_row(v, X3, true, nullptr, T.gw, T.lane);
    for (int m = T.gw; m < MLAT; m += T.NGW) {
        f32x4 cur[4]; float s = 0.f;
#pragma unroll
        for (int j = 0; j < 4; ++j) { cur[j] = v[j]; s += (v[j].x * v[j].x + v[j].y * v[j].y) + (v[j].z * v[j].z + v[j].w * v[j].w); }
        { const int mn = m + T.NGW; if (mn < MLAT) norm_load_row(v, X3, true, nullptr, mn, T.lane); }
        const float rstd = __builtin_amdgcn_rsqf(wave_sum(s) * (1.f / DM) + EPSN);
        f32x4* xr = (f32x4*)(a.out + (size_t)m * DM) + T.lane;
#pragma unroll
        for (int j = 0; j < 4; ++j) xr[64 * j] = cur[j] * rstd * wv[j];
    }
}

__device__ __forceinline__ void gates_phase(const Args& a, const Ctx& T) {
    const bf16* XNc = (const bf16*)(a.ws + WS_XN); const bf16* WG = (const bf16*)(a.ws + WS_WG); float* GT = (float*)(a.ws + WS_GATES);
    const int l = T.lane, r = l & 15, g = l >> 4;
    const float bias = a.in[I_MLGB][r];
    for (int rg = T.gw; rg < MALL / 16; rg += T.NGW) {
        f32x4 acc = (f32x4){0.f, 0.f, 0.f, 0.f};
        const bf16* pa = XNc + (size_t)(16 * rg + r) * DM + 8 * g; const bf16* pb = WG + (size_t)r * DM + 8 * g;
#pragma unroll 8
        for (int ks = 0; ks < 32; ++ks) { const bf16x8 av = *(const bf16x8*)(pa + ks * 32); const bf16x8 bv = *(const bf16x8*)(pb + ks * 32); acc = MFMA16(av, bv, acc); }
#pragma unroll
        for (int q = 0; q < 4; ++q) GT[(size_t)(16 * rg + 4 * g + q) * 16 + r] = acc[q] + bias;
    }
}

__global__ void __launch_bounds__(NTHREADS, 2) fwd_kernel(Args a) {
    extern __shared__ __attribute__((aligned(16))) unsigned char lds_raw[];
    Ctx T;
    T.lds = (LAS unsigned char*)lds_raw;
    T.tid = threadIdx.x; T.lane = T.tid & 63; T.wave = __builtin_amdgcn_readfirstlane(T.tid >> 6);
    T.G = gridDim.x; { const int bx = blockIdx.x; T.vcu = (T.G % 8 == 0) ? (bx % 8) * (T.G / 8) + bx / 8 : bx; }
    T.gw = T.vcu * NWAVES + T.wave; T.NGW = T.G * NWAVES;
    volatile LAS unsigned* MISC = (volatile LAS unsigned*)(T.lds + MISC_OFF);
    for (int u = T.tid; u < (LDS_BYTES - LDSCTL_OFF) / 4; u += NTHREADS) ((LAS unsigned*)(T.lds + LDSCTL_OFF))[u] = 0u;
    __syncthreads();
    XcdBarrier bar; bar.bar = (unsigned*)(a.ws + WS_CTL) + CW_BAR; bar.x = 0; bar.st = nullptr;
    const bool multi = (a.ph_hi - a.ph_lo) > 1;
    if (multi) bar = xcd_barrier_post((unsigned*)(a.ws + WS_CTL) + CW_BAR, MISC + 8);
    const int lo = a.ph_lo, hi = a.ph_hi;
#ifndef REP_MASK
#define REP_MASK 0
#endif
#define IN(k) (lo <= (k) && (k) < hi)
#ifndef PROF_K
#define PROF_K -1
#endif
#define STAMP(k) do { if (PROF_K >= 0 && ((k) == PROF_K || (k) == PROF_K + 1) && blockIdx.x == 0 && T.tid == 0) { const unsigned long long t_ = __builtin_amdgcn_s_memrealtime(); MISC[16 + 2 * ((k) - PROF_K)] = (unsigned)t_; MISC[17 + 2 * ((k) - PROF_K)] = (unsigned)(t_ >> 32); } } while (0)
#define REPS(k) for (int rep_ = 0; rep_ < (((REP_MASK >> (k)) & 1) ? 2 : 1); ++rep_)
#if (REP_MASK >> 18) & 1
#define SEAM(k) do { if (IN(k) && IN((k) + 1)) { xcd_barrier(bar); xcd_barrier(bar); } } while (0)
#else
#define SEAM(k) do { if (IN(k) && IN((k) + 1)) xcd_barrier(bar); STAMP((k) + 1); } while (0)
#endif
    bf16* XN = (bf16*)(a.ws + WS_XN); bf16* HB = (bf16*)(a.ws + WS_PROJ); bf16* PROJ = (bf16*)(a.ws + WS_PROJ);
    const float* mods = (const float*)(a.ws + WS_MODS);
    bf16* XB1 = (bf16*)a.out; bf16* XB2 = (bf16*)a.out + (size_t)MLAT * DM; bf16* XB3 = (bf16*)(a.ws + WS_PROJ + 96 * MiB);
    const int bx = (int)blockIdx.x;

    STAMP(0);
    if (IN(0)) REPS(0) { mods_phase(a, T); convert_ffn(a, T, a.in[I_F1W1], a.in[I_F1W2]); convert_mix(a, T);
        if (T.tid < 64) { const int e = bx * 64 + T.tid; if (e < 16384) { const int q = e >> 10, k = e & 1023; ((bf16*)(a.ws + WS_WG))[q * 1024 + k] = (bf16)f2bf(a.in[I_WIN][(size_t)k * DIN + NPROJ + q]); } } }
    SEAM(0);
    if (IN(1)) norm_mod_rows<false, false>(a, T, a.in[I_X], a.in[I_CTX], MALL, a.in[I_N1W], 0, 1);
    SEAM(1);
    if (IN(2)) REPS(2) { pg8::Gemm g{XN, (const bf16*)(a.ws + WS_W1), MALL, 2 * DFF, DM, DM}; pg8::StaticOrder S; S.init(MALL, 2 * DFF, T.G, bx);
        pg8::EpiSwiglu E{HB, DFF}; pg8::gemm_phase<pg8::EpiSwiglu, pg8::StaticOrder, true, true>(T.lds, g, S, E); }
    SEAM(2);
    if (IN(3)) { pg8::Gemm g{HB, (const bf16*)(a.ws + WS_W2), MALL, DM, DFF, DFF}; pg8::DownOrder S; S.lat.init(MLAT, DM, T.G, bx); S.c = bx;
        pg8::EpiDown1 E{a.in[I_X], XB1, mods + 2 * 1024, 0.5f, (bf16*)(a.ws + WS_SLAB)}; pg8::gemm_phase<pg8::EpiDown1, pg8::DownOrder, true, true>(T.lds, g, S, E); }
    SEAM(3);
    if (IN(4)) REPS(4) { norm_mod_rows<true, true>(a, T, XB1, a.in[I_CTX], MALL, a.in[I_N2W], 3, 4); convert_ffn(a, T, a.in[I_F2W1], a.in[I_F2W2]); }
    SEAM(4);
    if (IN(5)) { pg8::Gemm g{XN, (const bf16*)(a.ws + WS_WIN), MALL, NPROJ, DM, DM}; pg8::ProjOrder S; S.lat.init(MLAT, NPROJ, T.G, bx); S.c = bx;
        pg8::EpiProjAll E{{PROJ, LDP}, (bf16*)(a.ws + WS_SLAB2)}; pg8::gemm_phase<pg8::EpiProjAll, pg8::ProjOrder, true, true>(T.lds, g, S, E); }
    SEAM(5);
    if (IN(6)) { gates_phase(a, T); ctx_combine(a, T); conv_phase(a, T); }
    SEAM(6);
    if (IN(7)) REPS(7) { hg_pass1_items(a, T, T.vcu, T.G, 256); ml_pass1_items(a, T, T.vcu, T.G, 256); }
    SEAM(7);
    if (IN(8)) pass2_all(a, T);
    SEAM(8);
    if (IN(9)) REPS(9) { for (int it = T.vcu; it < 256; it += T.G) hg_pass3_item(a, T, it, XN); for (int it = T.vcu; it < 256; it += T.G) ml_pass3_item(a, T, it, XN); }
    SEAM(9);
    if (IN(10)) { pg8::Gemm g{XN, (const bf16*)(a.ws + WS_WOUT), MLAT, DM, DM, DM}; pg8::StaticOrder S; S.init(MLAT, DM, T.G, bx);
        pg8::EpiResidB<true> E{XB1, XB2, mods + 5 * 1024, 1.0f}; pg8::gemm_phase<pg8::EpiResidB<true>, pg8::StaticOrder, true, true>(T.lds, g, S, E); }
    SEAM(10);
    if (IN(11)) REPS(11) norm_mod_rows<false, true>(a, T, XB2, nullptr, MLAT, a.in[I_N3W], 6, 7);
    SEAM(11);
    if (IN(12)) REPS(12) { pg8::Gemm g{XN, (const bf16*)(a.ws + WS_W1), MLAT, 2 * DFF, DM, DM}; pg8::StaticOrder S; S.init(MLAT, 2 * DFF, T.G, bx);
        pg8::EpiSwiglu E{HB, DFF}; pg8::gemm_phase<pg8::EpiSwiglu, pg8::StaticOrder, true, true>(T.lds, g, S, E); }
    SEAM(12);
    if (IN(13)) { pg8::Gemm g{HB, (const bf16*)(a.ws + WS_W2), MLAT, DM, DFF, DFF}; pg8::StaticOrder S; S.init(MLAT, DM, T.G, bx);
        pg8::EpiResidB<true> E{XB2, XB3, mods + 8 * 1024, 0.5f}; pg8::gemm_phase<pg8::EpiResidB<true>, pg8::StaticOrder, true, true>(T.lds, g, S, E); }
    SEAM(13);
    if (IN(14)) final_norm_phase(a, T, XB3);
    STAMP(15);
    if (PROF_S >= 0 && blockIdx.x == 0 && T.tid == 0) { const unsigned long long dt_ = ((((unsigned long long)MISC[23]) << 32) | MISC[22]) * 8ull, te_ = __builtin_amdgcn_s_memrealtime(); while (__builtin_amdgcn_s_memrealtime() - te_ < dt_) __builtin_amdgcn_s_sleep(8); }
    if (PROF_K >= 0 && blockIdx.x == 0 && T.tid == 0) { const unsigned long long t0_ = ((unsigned long long)MISC[17] << 32) | MISC[16], t1_ = ((unsigned long long)MISC[19] << 32) | MISC[18];
        const unsigned long long dt_ = (t1_ - t0_) * 8ull, te_ = __builtin_amdgcn_s_memrealtime(); while (__builtin_amdgcn_s_memrealtime() - te_ < dt_) __builtin_amdgcn_s_sleep(8); }
#undef IN
#undef SEAM
}

extern "C" void kernel_launch(void* const* d_in, const int* in_sizes, int n_in, void* d_out, int out_size, void* d_ws, size_t ws_size, hipStream_t stream) {
    static int grid = 0;
    if (grid == 0) {
        if (n_in != 22 || out_size != MLAT * DM || ws_size < WS_END) { fprintf(stderr, "kernel_launch: unexpected shapes (n_in %d out %d ws %zu)\n", n_in, out_size, ws_size); grid = -1; return; }
        int dev = 0, cus = 0;
        if (hipGetDevice(&dev) != hipSuccess || hipDeviceGetAttribute(&cus, hipDeviceAttributeMultiprocessorCount, dev) != hipSuccess) { grid = -1; return; }
        if (hipFuncSetAttribute((const void*)fwd_kernel, hipFuncAttributeMaxDynamicSharedMemorySize, LDS_BYTES) != hipSuccess) { fprintf(stderr, "kernel_launch: hipFuncSetAttribute failed\n"); grid = -1; return; }
        (void)hipGetLastError();
        grid = cus;
    }
    if (grid < 0) return;
    (void)hipMemsetAsync((char*)d_ws + WS_CTL, 0, CTL_ZERO_BYTES, stream);
    (void)hipMemsetAsync((char*)d_ws + WS_MODS, 0, 5 * NMODC * sizeof(float), stream);
    Args a{};
    for (int i = 0; i < 22; ++i) a.in[i] = (const float*)d_in[i];
    a.out = (float*)d_out; a.ws = (unsigned char*)d_ws;
#if ONE_LAUNCH
    a.ph_lo = 0; a.ph_hi = NPHASES;
    hipLaunchKernelGGL(fwd_kernel, dim3(grid), dim3(NTHREADS), LDS_BYTES, stream, a);
#else
    for (int p = 0; p < NPHASES; ++p) { a.ph_lo = p; a.ph_hi = p + 1; hipLaunchKernelGGL(fwd_kernel, dim3(grid), dim3(NTHREADS), LDS_BYTES, stream, a); }
#endif
}
```

```cpp
#include <hip/hip_runtime.h>
#include <cstdio>
#include <cstdint>
#ifndef PROF_S
#define PROF_S -1
#endif
#define PG8_PS_BEGIN() do { if ((PROF_S == 20 || PROF_S == Epi::PROF_ID) && blockIdx.x == 0 && threadIdx.x == 0) { const unsigned long long t_ = __builtin_amdgcn_s_memrealtime(); volatile __attribute__((address_space(3))) unsigned* M_ = (volatile __attribute__((address_space(3))) unsigned*)(lds + 162816 + 320); M_[20] = (unsigned)t_; M_[21] = (unsigned)(t_ >> 32); } } while (0)
#define PG8_PS_END() do { if ((PROF_S == 20 || PROF_S == Epi::PROF_ID) && blockIdx.x == 0 && threadIdx.x == 0) { const unsigned long long t_ = __builtin_amdgcn_s_memrealtime(); volatile __attribute__((address_space(3))) unsigned* M_ = (volatile __attribute__((address_space(3))) unsigned*)(lds + 162816 + 320); \
    const unsigned long long p_ = ((unsigned long long)M_[21] << 32) | M_[20]; const unsigned long long a_ = (((unsigned long long)M_[23] << 32) | M_[22]) + (t_ - p_); M_[22] = (unsigned)a_; M_[23] = (unsigned)(a_ >> 32); } } while (0)
namespace pg8 {
#define PG8_LAS __attribute__((address_space(3)))
typedef unsigned short bf16_t;
typedef short bf16x8 __attribute__((ext_vector_type(8)));
typedef float f32x4 __attribute__((ext_vector_type(4)));
typedef unsigned u32x4 __attribute__((ext_vector_type(4)));
constexpr int BM = 256, BK = 64, HALF = 128, HTB = HALF * BK * 2  , STAGE_BYTES = 8 * HTB, NXCD = 8, WGM = 8;

__host__ __device__ __forceinline__ int lds_byte(int r, int c) { const int st = (r >> 4) * 2 + (c >> 5), rr = r & 15, cc = c & 31, ob = rr * 64 + cc * 2; return st * 1024 + (ob ^ (((ob >> 9) & 1) << 5)); }
__host__ __device__ __forceinline__ void stage_rc(int b, int& R, int& C) { const int st = b / 1024, sb = b % 1024, swz = sb ^ (((sb >> 9) & 1) << 5); R = (st >> 1) * 16 + swz / 64; C = (st & 1) * 32 + (swz % 64) / 2; }
__host__ __device__ __forceinline__ int perm32(int rho) { const int n = rho >> 4, i = rho & 15; return 8 * (i >> 2) + 4 * n + (i & 3); }

struct Unit { int pm, pn, kofs, kt, mh; };
struct Gemm { const bf16_t* A; const bf16_t* Bt; int M, N, K, ld; };

struct StaticOrder {
    int nM, nN, nwg, G, c;
    __host__ __device__ void init(int M, int N, int G_, int c_) { nM = M / BM; nN = N / BM; nwg = nM * nN; G = G_; c = c_; }
    __host__ __device__ bool next(int i, Unit& u) const { return at((long)i * G + c, u); }
    __host__ __device__ bool at(long L, Unit& u) const {
        if (L >= nwg) return false;
        int wgid = (int)L; { const int q = nwg / NXCD, r = nwg % NXCD, xcd = wgid % NXCD, off = wgid / NXCD; wgid = (xcd < r ? xcd * (q + 1) : r * (q + 1) + (xcd - r) * q) + off; }
        const int nig = WGM * nN, gid = wgid / nig, fm = gid * WGM, gsz = (nM - fm) < WGM ? (nM - fm) : WGM;
        u.pm = fm + ((wgid % nig) % gsz); u.pn = (wgid % nig) / gsz; u.kofs = 0; u.kt = 0; u.mh = 0; return true;
    }
    __device__ __forceinline__ void a_ready(const Unit&) const {}
    __device__ __forceinline__ void done(const Unit&) const {}
};
struct HalfTailOrder {
    StaticOrder lat; int nfull, hl, hmh;
    __host__ __device__ __forceinline__ void init(int M, int N, int G_, int c_) {
        lat.init(M, N, G_, c_); nfull = lat.nwg / lat.G; hl = -1; hmh = 0;
        const int rem = lat.nwg - nfull * lat.G;
        if (rem == 0) return;
        if (2 * rem > lat.G) { hl = -2; return; }
        if (lat.G % 8 == 0 && rem % 8 == 0) {
            const int xcd = c_ & 7, r = c_ >> 3; if ((r >> 1) < rem / 8) { hl = nfull * lat.G + 8 * (r >> 1) + xcd; hmh = 1 + (r & 1); } }
        else if ((c_ >> 1) < rem) { hl = nfull * lat.G + (c_ >> 1); hmh = 1 + (c_ & 1); }
    }
    __host__ __device__ __forceinline__ bool next(int i, Unit& u) const {
        if (i < nfull) return lat.next(i, u);
        if (i != nfull || hl == -1) return false;
        if (hl == -2) return lat.next(i, u);
        if (!lat.at((long)hl, u)) return false;
        u.mh = hmh; return true; }
    __device__ __forceinline__ void a_ready(const Unit&) const {}
    __device__ __forceinline__ void done(const Unit&) const {}
};
typedef float pg8_f32x2 __attribute__((ext_vector_type(2))); typedef __bf16 pg8_bf16x2 __attribute__((ext_vector_type(2)));
__device__ __forceinline__ unsigned cvt_pk_bf16(float lo, float hi) { const pg8_f32x2 v = {lo, hi}; const pg8_bf16x2 b = __builtin_convertvector(v, pg8_bf16x2); return __builtin_bit_cast(unsigned, b); }
typedef float f32x2 __attribute__((ext_vector_type(2)));
__device__ __forceinline__ float fast_sigmoid(float v) { return __builtin_amdgcn_rcpf(1.0f + __builtin_amdgcn_exp2f(-1.4426950408889634f * v)); }
__device__ __forceinline__ float fast_silu(float v) { return v * fast_sigmoid(v); }

struct EpiSwiglu {
    static constexpr bool PERM = true, AFTER_DRAIN = false; static constexpr int PROF_ID = 21;
    bf16_t* H; int ldh;
    __device__ __forceinline__ void operator()(const f32x4 (&acc)[2][2][4][2], const Unit& u, int wr, int wc, int fr, int fq) const {
        typedef float f2 __attribute__((ext_vector_type(2)));
        const int row0 = u.pm * BM + (u.mh == 2 ? HALF : 0) + wr * 64 + fr, col0 = u.pn * HALF + wc * 32 + 8 * fq;
#pragma unroll
        for (int ai = 0; ai < 2; ++ai) { if (ai == 1 && u.mh) break;
#pragma unroll
            for (int m = 0; m < 4; ++m) { bf16_t* rowp = H + (size_t)(row0 + ai * HALF + m * 16) * ldh + col0;
                unsigned wv[4];
#pragma unroll
                for (int n = 0; n < 2; ++n)
#pragma unroll
                    for (int h = 0; h < 2; ++h) {
                        const f2 g = {acc[ai][0][m][n][2 * h], acc[ai][0][m][n][2 * h + 1]}, uu = {acc[ai][1][m][n][2 * h], acc[ai][1][m][n][2 * h + 1]};
                        const f2 x = g * (-1.4426950408889634f);
                        f2 d; d.x = __builtin_amdgcn_exp2f(x.x); d.y = __builtin_amdgcn_exp2f(x.y); d = d + 1.0f;
                        f2 r; r.x = __builtin_amdgcn_rcpf(d.x); r.y = __builtin_amdgcn_rcpf(d.y);
                        const f2 o = (g * uu) * r;
                        wv[n * 2 + h] = cvt_pk_bf16(o.x, o.y); }
                u32x4 w; w.x = wv[0]; w.y = wv[1]; w.z = wv[2]; w.w = wv[3];
                *(u32x4*)rowp = w; } }
    }
};

struct EpiResid {
    static constexpr bool PERM = false, AFTER_DRAIN = false; static constexpr int PROF_ID = 29;
    const float* base_lat; const float* base_ctx; float* out_lat; float* out_ctx; const float* gate; float coef;
    __device__ __forceinline__ void operator()(const f32x4 (&acc)[2][2][4][2], const Unit& u, int wr, int wc, int fr, int fq) const {
        const bool isctx = u.pm >= 64;
        const float* base = isctx ? base_ctx + (size_t)(u.pm - 64) * BM * 1024 : base_lat + (size_t)u.pm * BM * 1024;
        float* out = isctx ? out_ctx + (size_t)(u.pm - 64) * BM * 1024 : out_lat + (size_t)u.pm * BM * 1024;
        const float* g = gate + (size_t)(isctx ? 4 : (u.pm >> 4)) * 9216;
        const int col0 = u.pn * BM + wc * 32 + 4 * fq;
        f32x4 gv[2][2];
#pragma unroll
        for (int bj = 0; bj < 2; ++bj)
#pragma unroll
            for (int n = 0; n < 2; ++n) gv[bj][n] = *(const f32x4*)(g + col0 + bj * HALF + n * 16) * coef;
#pragma unroll
        for (int ai = 0; ai < 2; ++ai)
#pragma unroll
            for (int m = 0; m < 4; ++m) { const size_t off = (size_t)(ai * HALF + wr * 64 + m * 16 + fr) * 1024 + col0;
#pragma unroll
                for (int bj = 0; bj < 2; ++bj)
#pragma unroll
                    for (int n = 0; n < 2; ++n) { const f32x4 b = *(const f32x4*)(base + off + bj * HALF + n * 16);
                        *(f32x4*)(out + off + bj * HALF + n * 16) = b + gv[bj][n] * acc[ai][bj][m][n]; } }
    }
};

struct EpiProj {
    static constexpr bool PERM = true, AFTER_DRAIN = false; static constexpr int PROF_ID = 28;
    bf16_t* O; int ldc;
    template <int MODE>
    __device__ __forceinline__ void body(const f32x4 (&acc)[2][2][4][2], int rowb, int colb, int lane) const {
        const int src4 = 4 * ((lane >> 2) + 16 * (lane & 3));
        bf16_t* obase = O + (size_t)(rowb + (lane >> 2)) * ldc + colb + 8 * (lane & 3);
#pragma unroll
        for (int ai = 0; ai < 2; ++ai)
#pragma unroll
            for (int m = 0; m < 4; ++m) { bf16_t* rowp = obase + (size_t)(ai * HALF + m * 16) * ldc;
#pragma unroll
                for (int bj = 0; bj < 2; ++bj) { float r[8];
#pragma unroll
                    for (int n = 0; n < 2; ++n)
#pragma unroll
                        for (int i = 0; i < 4; ++i) { const float v = acc[ai][bj][m][n][i];
                            r[n * 4 + i] = MODE == 0 ? v : (MODE == 1 ? fast_silu(v) * 0.08838834764831845f : (MODE == 2 ? fast_silu(v) : fast_sigmoid(v))); }
                    u32x4 w; w.x = (unsigned)__builtin_amdgcn_ds_bpermute(src4, (int)cvt_pk_bf16(r[0], r[1])); w.y = (unsigned)__builtin_amdgcn_ds_bpermute(src4, (int)cvt_pk_bf16(r[2], r[3]));
                    w.z = (unsigned)__builtin_amdgcn_ds_bpermute(src4, (int)cvt_pk_bf16(r[4], r[5])); w.w = (unsigned)__builtin_amdgcn_ds_bpermute(src4, (int)cvt_pk_bf16(r[6], r[7]));
                    *(u32x4*)(rowp + bj * HALF) = w; } }
    }
    __device__ __forceinline__ void operator()(const f32x4 (&acc)[2][2][4][2], const Unit& u, int wr, int wc, int fr, int fq) const {
        const int row0 = u.pm * BM + wr * 64, col0 = u.pn * BM + wc * 32, lane = fr + 16 * fq;
        const int mode = (u.pn < 2) ? 1 : ((u.pn == 4 || u.pn == 5) ? 2 : (u.pn >= 14 ? 3 : 0));
        if (mode == 0) body<0>(acc, row0, col0, lane); else if (mode == 1) body<1>(acc, row0, col0, lane); else if (mode == 2) body<2>(acc, row0, col0, lane); else body<3>(acc, row0, col0, lane);
    }
};

struct DownOrder {
    StaticOrder lat; int c;
    __device__ __forceinline__ bool next(int i, Unit& u) const {
        if (i == 0) return lat.next(0, u);
        if (i != 1 || c >= 176) return false;
        const int ks = c % 11, t = c / 11; u.pn = t & 3; u.pm = 64 + (t >> 2); u.kofs = ks * 256; u.kt = 4; u.mh = 0; return true; }
    __device__ __forceinline__ void a_ready(const Unit&) const {}
    __device__ __forceinline__ void done(const Unit&) const {}
};
struct EpiDown1 {
    static constexpr bool PERM = true, AFTER_DRAIN = false; static constexpr int PROF_ID = 22;
    const float* base; bf16_t* out; const float* gate; float coef; bf16_t* slab;
    __device__ __forceinline__ void operator()(const f32x4 (&acc)[2][2][4][2], const Unit& u, int wr, int wc, int fr, int fq) const {
        const int col0 = u.pn * BM + wc * 32 + 8 * fq;
        if (u.kt) {
            bf16_t* o = slab + ((size_t)(u.kofs >> 8) * 1024 + (size_t)(u.pm - 64) * BM) * 1024 + col0;
#pragma unroll
            for (int ai = 0; ai < 2; ++ai)
#pragma unroll
                for (int m = 0; m < 4; ++m) { bf16_t* rowp = o + (size_t)(ai * HALF + wr * 64 + m * 16 + fr) * 1024;
#pragma unroll
                    for (int bj = 0; bj < 2; ++bj) { const f32x4 v0 = acc[ai][bj][m][0], v1 = acc[ai][bj][m][1];
                        u32x4 w; w.x = cvt_pk_bf16(v0[0], v0[1]); w.y = cvt_pk_bf16(v0[2], v0[3]); w.z = cvt_pk_bf16(v1[0], v1[1]); w.w = cvt_pk_bf16(v1[2], v1[3]);
                        *(u32x4*)(rowp + bj * HALF) = w; } }
            return;
        }
        const int lane = fr + 16 * fq, src4 = 4 * ((lane >> 2) + 16 * (lane & 3));
        const int colL = u.pn * BM + wc * 32 + 8 * (lane & 3);
        const float* g = gate + (size_t)(u.pm >> 4) * 9216;
        f32x4 gv[2][2];
#pragma unroll
        for (int bj = 0; bj < 2; ++bj)
#pragma unroll
            for (int n = 0; n < 2; ++n) gv[bj][n] = *(const f32x4*)(g + colL + bj * HALF + 4 * n) * coef;
        const size_t off0 = (size_t)(u.pm * BM + wr * 64 + (lane >> 2)) * 1024 + colL;
#pragma unroll
        for (int am = 0; am < 4; ++am) {
            const int ai = am >> 1, m0 = (am & 1) * 2;
            f32x4 bf[2][2][2];
#pragma unroll
            for (int mm = 0; mm < 2; ++mm)
#pragma unroll
                for (int bj = 0; bj < 2; ++bj) { const size_t off = off0 + (size_t)(ai * HALF + (m0 + mm) * 16) * 1024 + bj * HALF; bf[mm][bj][0] = __builtin_nontemporal_load((const f32x4*)(base + off)); bf[mm][bj][1] = __builtin_nontemporal_load((const f32x4*)(base + off + 4)); }
#pragma unroll
            for (int mm = 0; mm < 2; ++mm)
#pragma unroll
                for (int bj = 0; bj < 2; ++bj) { const size_t off = off0 + (size_t)(ai * HALF + (m0 + mm) * 16) * 1024 + bj * HALF;
                    f32x4 a0, a1;
#pragma unroll
                    for (int e = 0; e < 4; ++e) { const float t0 = acc[ai][bj][m0 + mm][0][e], t1 = acc[ai][bj][m0 + mm][1][e];
                        a0[e] = __builtin_bit_cast(float, __builtin_amdgcn_ds_bpermute(src4, __builtin_bit_cast(int, t0))); a1[e] = __builtin_bit_cast(float, __builtin_amdgcn_ds_bpermute(src4, __builtin_bit_cast(int, t1))); }
                    const f32x4 v0 = bf[mm][bj][0] + gv[bj][0] * a0, v1 = bf[mm][bj][1] + gv[bj][1] * a1;
                    u32x4 w; w.x = cvt_pk_bf16(v0[0], v0[1]); w.y = cvt_pk_bf16(v0[2], v0[3]); w.z = cvt_pk_bf16(v1[0], v1[1]); w.w = cvt_pk_bf16(v1[2], v1[3]);
                    *(u32x4*)(out + off) = w; }
        }
    }
};
struct ProjOrder {
    StaticOrder lat; int c;
    __device__ __forceinline__ bool next(int i, Unit& u) const {
        if (i < 4) return lat.next(i, u);
        if (i != 4 || c >= 144) return false;
        const int ks = c & 3, t = c >> 2, t9 = t % 9;
        u.pm = 64 + t / 9; u.pn = t9 < 2 ? 2 + t9 : (t9 < 6 ? 4 + t9 : 5 + t9); u.kofs = ks * 256; u.kt = 4; u.mh = 0; return true; }
    __device__ __forceinline__ void a_ready(const Unit&) const {}
    __device__ __forceinline__ void done(const Unit&) const {}
};
struct EpiProjAll {
    static constexpr bool PERM = true, AFTER_DRAIN = false; static constexpr int PROF_ID = 23;
    EpiProj lat; bf16_t* slab;
    __device__ __forceinline__ void operator()(const f32x4 (&acc)[2][2][4][2], const Unit& u, int wr, int wc, int fr, int fq) const {
        if (!u.kt) { lat(acc, u, wr, wc, fr, fq); return; }
        const int t9 = u.pn < 4 ? u.pn - 2 : (u.pn < 10 ? u.pn - 4 : u.pn - 5);
        bf16_t* out = slab + ((size_t)(u.kofs >> 8) * 1024 + (size_t)(u.pm - 64) * BM) * 2304 + t9 * 256 + wc * 32 + 8 * fq;
#pragma unroll
        for (int ai = 0; ai < 2; ++ai)
#pragma unroll
            for (int m = 0; m < 4; ++m) { bf16_t* rowp = out + (size_t)(ai * HALF + wr * 64 + m * 16 + fr) * 2304;
#pragma unroll
                for (int bj = 0; bj < 2; ++bj) { const f32x4 v0 = acc[ai][bj][m][0], v1 = acc[ai][bj][m][1];
                    u32x4 w; w.x = cvt_pk_bf16(v0[0], v0[1]); w.y = cvt_pk_bf16(v0[2], v0[3]); w.z = cvt_pk_bf16(v1[0], v1[1]); w.w = cvt_pk_bf16(v1[2], v1[3]);
                    *(u32x4*)(rowp + bj * HALF) = w; } }
    }
};

template <bool BASE_BF16>
struct EpiResidB {
    static constexpr bool PERM = true, AFTER_DRAIN = false; static constexpr int PROF_ID = 24;
    const void* base; bf16_t* out; const float* gate; float coef;
    __device__ __forceinline__ void operator()(const f32x4 (&acc)[2][2][4][2], const Unit& u, int wr, int wc, int fr, int fq) const {
        const float* g = gate + (size_t)(u.pm >> 4) * 9216;
        const int col0 = u.pn * BM + wc * 32 + 8 * fq;
        f32x4 gv[2][2];
#pragma unroll
        for (int bj = 0; bj < 2; ++bj)
#pragma unroll
            for (int n = 0; n < 2; ++n) gv[bj][n] = *(const f32x4*)(g + col0 + bj * HALF + 4 * n) * coef;
        const size_t off0 = (size_t)(u.pm * BM + wr * 64 + fr) * 1024 + col0;
#pragma unroll
        for (int ai = 0; ai < 2; ++ai) {
            u32x4 bw[4][2]; f32x4 bf[4][2][2];
#pragma unroll
            for (int m = 0; m < 4; ++m)
#pragma unroll
                for (int bj = 0; bj < 2; ++bj) { const size_t off = off0 + (size_t)(ai * HALF + m * 16) * 1024 + bj * HALF;
                    if (BASE_BF16) bw[m][bj] = *(const u32x4*)((const bf16_t*)base + off);
                    else { bf[m][bj][0] = *(const f32x4*)((const float*)base + off); bf[m][bj][1] = *(const f32x4*)((const float*)base + off + 4); } }
#pragma unroll
            for (int m = 0; m < 4; ++m)
#pragma unroll
                for (int bj = 0; bj < 2; ++bj) { const size_t off = off0 + (size_t)(ai * HALF + m * 16) * 1024 + bj * HALF; f32x4 b0, b1;
                    if (BASE_BF16) { const u32x4 w_ = bw[m][bj];
                        b0 = (f32x4){__builtin_bit_cast(float, w_.x << 16), __builtin_bit_cast(float, w_.x & 0xffff0000u), __builtin_bit_cast(float, w_.y << 16), __builtin_bit_cast(float, w_.y & 0xffff0000u)};
                        b1 = (f32x4){__builtin_bit_cast(float, w_.z << 16), __builtin_bit_cast(float, w_.z & 0xffff0000u), __builtin_bit_cast(float, w_.w << 16), __builtin_bit_cast(float, w_.w & 0xffff0000u)}; }
                    else { b0 = bf[m][bj][0]; b1 = bf[m][bj][1]; }
                    const f32x4 v0 = b0 + gv[bj][0] * acc[ai][bj][m][0], v1 = b1 + gv[bj][1] * acc[ai][bj][m][1];
                    u32x4 w; w.x = cvt_pk_bf16(v0[0], v0[1]); w.y = cvt_pk_bf16(v0[2], v0[3]); w.z = cvt_pk_bf16(v1[0], v1[1]); w.w = cvt_pk_bf16(v1[2], v1[3]);
                    *(u32x4*)(out + off) = w; }
        }
    }
};

template <class Epi, class Sched, bool ALIGN_EPI = false, bool SP2 = false>
__device__ __forceinline__ void gemm_phase(PG8_LAS unsigned char* lds, const Gemm g, const Sched& S, const Epi& E) {
    const int tid = threadIdx.x, wid = __builtin_amdgcn_readfirstlane(tid >> 6), lane = tid & 63, wr = wid >> 2, wc = wid & 3, fr = lane & 15, fq = lane >> 4;
    const int K = g.K, nt = K / BK, LD = g.ld;
    unsigned voffA[2], voffB[2];
#pragma unroll
    for (int i = 0; i < 2; ++i) { int R, C; stage_rc(tid * 16 + i * 8192, R, C); const int Rb = Epi::PERM ? ((R & ~31) + perm32(R & 31)) : R;
        voffA[i] = (unsigned)(R * LD + C) * 2u; voffB[i] = (unsigned)(Rb * LD + C) * 2u; }
    const size_t kstep = (size_t)(BK * 2);
    const size_t hstep = (size_t)HALF * LD * 2;
    const size_t tstep = 2 * hstep;
    const unsigned ldsw = (unsigned)wid * 1024u;
    const int aoff = lds_byte(wr * 64 + fr, fq * 8), boff = lds_byte(wc * 32 + fr, fq * 8);
#define PG8_SA(b, h) (((b) * 2 + (h)) * HTB)
#define PG8_SB(b, h) ((4 + (b) * 2 + (h)) * HTB)
#define PG8_STAGE(bufoff, gbase, voff) do { _Pragma("unroll") for (int _i = 0; _i < 2; ++_i) \
        __builtin_amdgcn_global_load_lds((const unsigned*)((const char*)(gbase) + (voff)[_i]), (PG8_LAS unsigned*)(lds + (bufoff) + ldsw + _i * 8192), 16, 0, 0); } while (0)
#define PG8_LDA(dst, b, h) do { _Pragma("unroll") for (int m = 0; m < 4; ++m) _Pragma("unroll") for (int k = 0; k < 2; ++k) dst[m][k] = *(const PG8_LAS bf16x8*)(lds + PG8_SA(b, h) + aoff + m * 2048 + k * 1024); } while (0)
#define PG8_LDB(dst, b, h) do { _Pragma("unroll") for (int n = 0; n < 2; ++n) _Pragma("unroll") for (int k = 0; k < 2; ++k) dst[n][k] = *(const PG8_LAS bf16x8*)(lds + PG8_SB(b, h) + boff + n * 2048 + k * 1024); } while (0)
#define PG8_MMA(ai, bj, At, Bt) do { __builtin_amdgcn_s_setprio(1); _Pragma("unroll") for (int m = 0; m < 4; ++m) _Pragma("unroll") for (int n = 0; n < 2; ++n) _Pragma("unroll") for (int k = 0; k < 2; ++k) \
        acc[ai][bj][m][n] = __builtin_amdgcn_mfma_f32_16x16x32_bf16(Bt[n][k], At[m][k], acc[ai][bj][m][n], 0, 0, 0); __builtin_amdgcn_s_setprio(0); } while (0)
#define PG8_WAIT_V(n) asm volatile("s_waitcnt vmcnt(" #n ")" ::: "memory")
#define PG8_WAIT_L(n) asm volatile("s_waitcnt lgkmcnt(" #n ")" ::: "memory")
#define PG8_BAR __builtin_amdgcn_s_barrier()
#define PG8_SCHED __builtin_amdgcn_sched_barrier(0)
    Unit cur, nxt; int ui = 0;
    if (!S.next(0, cur)) return;
    f32x4 acc[2][2][4][2];
#pragma unroll
    for (int a = 0; a < 2; ++a)
#pragma unroll
        for (int b = 0; b < 2; ++b)
#pragma unroll
            for (int m = 0; m < 4; ++m)
#pragma unroll
                for (int n = 0; n < 2; ++n) acc[a][b][m][n] = (f32x4){0.f, 0.f, 0.f, 0.f};
    bf16x8 At[4][2], B0[2][2], B1[2][2];
    const char* cA = (const char*)g.A + (size_t)cur.pm * tstep + (size_t)cur.kofs * 2 + (cur.mh == 2 ? hstep : (size_t)0); const char* cB = (const char*)g.Bt + (size_t)cur.pn * tstep + (size_t)cur.kofs * 2;
    S.a_ready(cur);
    if constexpr (SP2) {
        PG8_STAGE(PG8_SB(0, 0), cB, voffB); PG8_STAGE(PG8_SB(0, 1), cB + hstep, voffB); PG8_STAGE(PG8_SA(0, 0), cA, voffA); PG8_STAGE(PG8_SA(0, 1), cA + hstep, voffA);
        if (wr == 1) PG8_BAR;
        PG8_WAIT_V(2); PG8_BAR;
        PG8_STAGE(PG8_SB(1, 0), cB + kstep, voffB); PG8_STAGE(PG8_SA(1, 0), cA + kstep, voffA); PG8_STAGE(PG8_SB(1, 1), cB + hstep + kstep, voffB);
        PG8_WAIT_V(6); PG8_BAR;
    } else {
        PG8_STAGE(PG8_SB(0, 0), cB, voffB); PG8_STAGE(PG8_SA(0, 0), cA, voffA); PG8_STAGE(PG8_SB(0, 1), cB + hstep, voffB); PG8_STAGE(PG8_SA(0, 1), cA + hstep, voffA);
        if (wr == 1) PG8_BAR;
        PG8_WAIT_V(4); PG8_BAR;
        PG8_STAGE(PG8_SB(1, 0), cB + kstep, voffB); PG8_STAGE(PG8_SA(1, 0), cA + kstep, voffA); PG8_STAGE(PG8_SB(1, 1), cB + hstep + kstep, voffB);
        PG8_WAIT_V(6); PG8_BAR;
    }
    for (;;) {
        const bool has_next = S.next(ui + 1, nxt);
        const char* nA = has_next ? (const char*)g.A + (size_t)nxt.pm * tstep + (size_t)nxt.kofs * 2 + (nxt.mh == 2 ? hstep : (size_t)0) : cA; const char* nB = has_next ? (const char*)g.Bt + (size_t)nxt.pn * tstep + (size_t)nxt.kofs * 2 : cB;
        const int ntu = cur.kt ? cur.kt : nt;
        if (SP2 && cur.mh) {
        for (int t = 0; t < ntu; t += 2) {
            const bool last = (t == ntu - 2);
            const char* a2 = last ? nA : cA + (size_t)(t + 2) * kstep; const char* b2 = last ? nB : cB + (size_t)(t + 2) * kstep;
            const char* a3 = a2 + kstep; const char* b3 = b2 + kstep;
            PG8_LDB(B0, 0, 0); PG8_LDB(B1, 0, 1); PG8_SCHED; PG8_LDA(At, 0, 0);
            PG8_WAIT_L(0); PG8_BAR; PG8_MMA(0, 0, At, B0); PG8_MMA(0, 1, At, B1); PG8_BAR; PG8_SCHED;
            PG8_STAGE(PG8_SB(0, 0), b2, voffB); PG8_STAGE(PG8_SB(0, 1), b2 + hstep, voffB); PG8_STAGE(PG8_SA(0, 0), a2, voffA);
            PG8_WAIT_V(6); PG8_BAR; PG8_BAR; PG8_SCHED;
            PG8_LDB(B0, 1, 0); PG8_LDB(B1, 1, 1); PG8_SCHED; PG8_LDA(At, 1, 0);
            PG8_WAIT_L(0); PG8_BAR; PG8_MMA(0, 0, At, B0); PG8_MMA(0, 1, At, B1); PG8_BAR; PG8_SCHED;
            PG8_STAGE(PG8_SB(1, 0), b3, voffB); PG8_STAGE(PG8_SB(1, 1), b3 + hstep, voffB); PG8_STAGE(PG8_SA(1, 0), a3, voffA);
            PG8_WAIT_V(6); PG8_BAR; PG8_BAR; PG8_SCHED;
        }
        } else
        for (int t = 0; t < ntu; t += 2) {
            const bool last = (t == ntu - 2);
            const char* a1 = cA + (size_t)(t + 1) * kstep;
            const char* a2 = last ? nA : cA + (size_t)(t + 2) * kstep; const char* b2 = last ? nB : cB + (size_t)(t + 2) * kstep;
            const char* a3 = a2 + kstep; const char* b3 = b2 + kstep;
            if (last && has_next) S.a_ready(nxt);
            if constexpr (SP2) {
            PG8_LDB(B0, 0, 0); PG8_LDB(B1, 0, 1); PG8_SCHED; PG8_LDA(At, 0, 0); PG8_STAGE(PG8_SA(1, 1), a1 + hstep, voffA);
            PG8_WAIT_V(8); PG8_WAIT_L(0); PG8_BAR; PG8_MMA(0, 0, At, B0); PG8_MMA(0, 1, At, B1); PG8_BAR; PG8_SCHED;
            PG8_LDA(At, 0, 1); PG8_STAGE(PG8_SB(0, 0), b2, voffB); PG8_STAGE(PG8_SB(0, 1), b2 + hstep, voffB); PG8_STAGE(PG8_SA(0, 0), a2, voffA);
            PG8_WAIT_V(8); PG8_WAIT_L(0); PG8_BAR; PG8_MMA(1, 0, At, B0); PG8_MMA(1, 1, At, B1); PG8_BAR; PG8_SCHED;
            PG8_LDB(B0, 1, 0); PG8_LDB(B1, 1, 1); PG8_SCHED; PG8_LDA(At, 1, 0); PG8_STAGE(PG8_SA(0, 1), a2 + hstep, voffA);
            PG8_WAIT_V(8); PG8_WAIT_L(0); PG8_BAR; PG8_MMA(0, 0, At, B0); PG8_MMA(0, 1, At, B1); PG8_BAR; PG8_SCHED;
            PG8_LDA(At, 1, 1); PG8_STAGE(PG8_SB(1, 0), b3, voffB); PG8_STAGE(PG8_SB(1, 1), b3 + hstep, voffB); PG8_STAGE(PG8_SA(1, 0), a3, voffA);
            PG8_WAIT_V(8); PG8_WAIT_L(0); PG8_BAR; PG8_MMA(1, 0, At, B0); PG8_MMA(1, 1, At, B1); PG8_BAR; PG8_SCHED;
            } else {
            PG8_LDB(B0, 0, 0); PG8_SCHED; PG8_LDA(At, 0, 0); PG8_STAGE(PG8_SA(1, 1), a1 + hstep, voffA);
            PG8_WAIT_L(8); PG8_BAR; PG8_WAIT_L(0); PG8_MMA(0, 0, At, B0); PG8_BAR; PG8_SCHED;
            PG8_LDB(B1, 0, 1); PG8_STAGE(PG8_SB(0, 0), b2, voffB);
            PG8_BAR; PG8_WAIT_L(0); PG8_MMA(0, 1, At, B1); PG8_BAR;
            PG8_LDA(At, 0, 1); PG8_STAGE(PG8_SA(0, 0), a2, voffA);
            PG8_BAR; PG8_WAIT_L(0); PG8_MMA(1, 0, At, B0); PG8_BAR; PG8_SCHED;
            PG8_STAGE(PG8_SB(0, 1), b2 + hstep, voffB);
            PG8_WAIT_V(6); PG8_BAR; PG8_MMA(1, 1, At, B1); PG8_BAR;
            PG8_LDB(B0, 1, 0); PG8_SCHED; PG8_LDA(At, 1, 0); PG8_STAGE(PG8_SA(0, 1), a2 + hstep, voffA);
            PG8_WAIT_L(8); PG8_BAR; PG8_WAIT_L(0); PG8_MMA(0, 0, At, B0); PG8_BAR; PG8_SCHED;
            PG8_LDB(B1, 1, 1); PG8_STAGE(PG8_SB(1, 0), b3, voffB);
            PG8_BAR; PG8_WAIT_L(0); PG8_MMA(0, 1, At, B1); PG8_BAR;
            PG8_LDA(At, 1, 1); PG8_STAGE(PG8_SA(1, 0), a3, voffA);
            PG8_BAR; PG8_WAIT_L(0); PG8_MMA(1, 0, At, B0); PG8_BAR; PG8_SCHED;
            PG8_STAGE(PG8_SB(1, 1), b3 + hstep, voffB);
            PG8_WAIT_V(6); PG8_BAR; PG8_MMA(1, 1, At, B1); PG8_BAR;
            }
        }
        if constexpr (ALIGN_EPI) { if (wr == 0) PG8_BAR; }
        if constexpr (!Epi::AFTER_DRAIN) { PG8_PS_BEGIN(); E(acc, cur, wr, wc, fr, fq); S.done(cur); PG8_PS_END(); }
        if (!has_next) break;
#pragma unroll
        for (int a = 0; a < 2; ++a)
#pragma unroll
            for (int b = 0; b < 2; ++b)
#pragma unroll
                for (int m = 0; m < 4; ++m)
#pragma unroll
                    for (int n = 0; n < 2; ++n) acc[a][b][m][n] = (f32x4){0.f, 0.f, 0.f, 0.f};
        cur = nxt; cA = nA; cB = nB; ++ui;
        if constexpr (ALIGN_EPI) { if (wr == 1) PG8_BAR; }
    }
    PG8_WAIT_V(0);
    if constexpr (!ALIGN_EPI) { if (wr == 0) PG8_BAR; }
    PG8_BAR;
    if constexpr (Epi::AFTER_DRAIN) { E.fused(acc, cur, wr, wc, fr, fq, lds, wid, lane); S.done(cur); }
#undef PG8_SA
#undef PG8_SB
#undef PG8_STAGE
#undef PG8_LDA
#undef PG8_LDB
#undef PG8_MMA
#undef PG8_WAIT_V
#undef PG8_WAIT_L
#undef PG8_BAR
#undef PG8_SCHED
}
}
constexpr int DM = 1024, NB = 4, SEQ = 4096, NCTX = 256, DFF = 2816, DIN = 4112, NPROJ = 4096, NMODC = 9216;
constexpr int LDP = 4224;
constexpr int MLAT = NB * SEQ, MCTX = NB * NCTX, MALL = MLAT + MCTX;
constexpr float EPSN = 1e-6f;
constexpr int NWAVES = 8, NTHREADS = 512;
#ifndef ONE_LAUNCH
#define ONE_LAUNCH 1
#endif
constexpr int NPHASES = 15;

constexpr size_t MiB = 1u << 20;
constexpr size_t WS_CTL = 0, CTL_BYTES = 32 * 1024;
constexpr size_t WS_MODS = CTL_BYTES;
constexpr size_t CTL_ZERO_BYTES = CTL_BYTES + 5 * 9216 * sizeof(float);
constexpr size_t WS_GATES = 1 * MiB + 512 * 1024;
constexpr size_t WS_W1 = 3 * MiB;
constexpr size_t WS_W2 = 14 * MiB;
constexpr size_t WS_WIN = 20 * MiB;
constexpr size_t WS_WOUT = 28 * MiB;
constexpr size_t WS_XN = 34 * MiB;
constexpr size_t WS_PROJ = 68 * MiB;
constexpr size_t WS_QK = 209 * MiB;
constexpr size_t WS_END = 256 * MiB;
constexpr size_t WS_HGST = 237 * MiB;
constexpr size_t WS_HGG = 253 * MiB;
constexpr size_t WS_WG = 2 * MiB + 640 * 1024;
constexpr size_t WS_MLST = 226 * MiB;
constexpr size_t WS_MLSC = 236 * MiB;
constexpr size_t WS_SLAB = 204 * MiB;
constexpr size_t WS_SLAB2 = 237 * MiB;
constexpr int CW_BAR = 1024;

constexpr int RING_BYTES = 131072;
constexpr int LDSCTL_OFF = 162816, MISC_OFF = LDSCTL_OFF + 320;
constexpr int LDS_BYTES = 163840;

#define GAS __attribute__((address_space(1)))
#define LAS __attribute__((address_space(3)))
typedef unsigned short bf16;
typedef unsigned v4u __attribute__((ext_vector_type(4)));
typedef unsigned v2u __attribute__((ext_vector_type(2)));
typedef float f32x4 __attribute__((ext_vector_type(4)));
#define LDS_WAIT() asm volatile("s_waitcnt lgkmcnt(0)" ::: "memory")
#define VM_WAIT() asm volatile("s_waitcnt vmcnt(0)" ::: "memory")
__device__ __forceinline__ unsigned f2bf(float f) { unsigned u = __builtin_bit_cast(unsigned, f); return (u + 0x7fffu + ((u >> 16) & 1u)) >> 16; }
__device__ __forceinline__ unsigned pk2(float lo, float hi) { return f2bf(lo) | (f2bf(hi) << 16); }
__device__ __forceinline__ float bf2f(unsigned short h) { return __builtin_bit_cast(float, (unsigned)h << 16); }
__device__ __forceinline__ float bflo(unsigned w) { return __builtin_bit_cast(float, w << 16); }
__device__ __forceinline__ float bfhi(unsigned w) { return __builtin_bit_cast(float, w & 0xffff0000u); }
__device__ __forceinline__ float sigmoidf_(float v) { return 1.0f / (1.0f + __expf(-v)); }
__device__ __forceinline__ float fast_sig(float v) { return __builtin_amdgcn_rcpf(1.0f + __builtin_amdgcn_exp2f(-1.4426950408889634f * v)); }
__device__ __forceinline__ float siluf_(float v) { return v * sigmoidf_(v); }
__device__ __forceinline__ float wave_sum(float v) {
#pragma unroll
    for (int o = 1; o < 64; o <<= 1) v += __shfl_xor(v, o);
    return v;
}

#ifndef PROF_S
#define PROF_S -1
#endif
#define PS_BEGIN() do { if (PROF_S >= 0 && blockIdx.x == 0 && threadIdx.x == 0) { const unsigned long long t_ = __builtin_amdgcn_s_memrealtime(); volatile LAS unsigned* M_ = (volatile LAS unsigned*)(T.lds + MISC_OFF); M_[20] = (unsigned)t_; M_[21] = (unsigned)(t_ >> 32); } } while (0)
#define PS_END(id) do { if (PROF_S >= 0 && blockIdx.x == 0 && threadIdx.x == 0) { const unsigned long long t_ = __builtin_amdgcn_s_memrealtime(); volatile LAS unsigned* M_ = (volatile LAS unsigned*)(T.lds + MISC_OFF); \
    if ((id) == PROF_S) { const unsigned long long p_ = ((unsigned long long)M_[21] << 32) | M_[20]; const unsigned long long a_ = (((unsigned long long)M_[23] << 32) | M_[22]) + (t_ - p_); M_[22] = (unsigned)a_; M_[23] = (unsigned)(a_ >> 32); } \
    M_[20] = (unsigned)t_; M_[21] = (unsigned)(t_ >> 32); } } while (0)
#define XB_TMO      128
#define XB_XCNT(j)  (256  + 64 * (j))
#define XB_XSUB(j)  (1280 + 64 * (j))
#define XB_XGEN(j)  (2304 + 64 * (j))
#define XB_TOP      3328
#define XB_TOPGEN   3392
#define XB_XLOC(j)  (3456 + 64 * (j))
#define XCD_BAR_WORDS 4480
#define XB_SPIN_CAP (1u << 18)

__device__ __forceinline__ unsigned xb_ld(unsigned* p)              { return __hip_atomic_load(p, __ATOMIC_RELAXED, __HIP_MEMORY_SCOPE_AGENT); }
__device__ __forceinline__ unsigned xb_add(unsigned* p, unsigned v) { return __hip_atomic_fetch_add(p, v, __ATOMIC_RELAXED, __HIP_MEMORY_SCOPE_AGENT); }
__device__ __forceinline__ unsigned xb_xcc_id() { return (unsigned)__builtin_amdgcn_s_getreg((3 << 11) | 20) & 0xFu; }
#define XB_SPIN(cond, bar) do { unsigned _sp = 0; while (cond) { __builtin_amdgcn_s_sleep(1); \
    if ((++_sp & 255u) == 0u) { if (xb_ld(&(bar)[XB_TMO])) break; if (_sp > XB_SPIN_CAP) { atomicAdd(&(bar)[XB_TMO], 1u); break; } } } } while (0)

struct XcdBarrier {
    unsigned* bar; unsigned x;
    volatile LAS unsigned* st;
};

__device__ __forceinline__ XcdBarrier xcd_barrier_post(unsigned* bar, volatile LAS unsigned* st) {
    XcdBarrier b; b.bar = bar; b.x = xb_xcc_id(); b.st = st;
    if (threadIdx.x == 0) st[4] = xb_add(&bar[XB_XCNT(b.x)], 1u);
    return b;
}
__device__ __forceinline__ void xcd_barrier_complete(unsigned* bar, unsigned x, unsigned& nloc, unsigned& nx, unsigned& uni) {
    const unsigned G = gridDim.x * gridDim.y * gridDim.z;
    unsigned sum, cnt, mine, sp = 0u;
    for (;;) {
        sum = 0u; cnt = 0u; mine = 0u; uni = 1u;
#pragma unroll
        for (unsigned j = 0; j < 16; ++j) { const unsigned c = xb_ld(&bar[XB_XCNT(j)]); sum += c; cnt += (c > 0u) ? 1u : 0u; mine = (j == x) ? c : mine; uni = (c == 0u || c * 8u == G) ? uni : 0u; }
        if (sum == G) break;
        __builtin_amdgcn_s_sleep(1);
        if ((++sp & 255u) == 0u) { if (xb_ld(&bar[XB_TMO])) break; if (sp > XB_SPIN_CAP) { atomicAdd(&bar[XB_TMO], 1u); break; } }
    }
    nloc = mine > 0u ? mine : 1u; nx = cnt > 0u ? cnt : 1u;
    uni = (uni != 0u && cnt == 8u && sum == G && G == 256u) ? 1u : 0u;
}

__device__ __forceinline__ void xcd_barrier_arrive(const XcdBarrier& b) {
    asm volatile("s_waitcnt vmcnt(0)" ::: "memory");
    __syncthreads();
    if (threadIdx.x == 0) {
        unsigned* bar = b.bar;
        __builtin_amdgcn_s_waitcnt(0);
        unsigned nloc = b.st[0], nx = b.st[1];
        if (nloc == 0u) { unsigned uni = 0u; xcd_barrier_complete(bar, b.x, nloc, nx, uni); b.st[0] = nloc; b.st[1] = nx; b.st[5] = uni; }
        const unsigned old = xb_add(&bar[XB_XSUB(b.x)], 1u);
        const unsigned gen = old / nloc;
        unsigned leader = 0u;
        if (old + 1u == (gen + 1u) * nloc) {
            leader = 1u;
            __builtin_amdgcn_fence(__ATOMIC_RELEASE, "agent");
            asm volatile("s_waitcnt vmcnt(0)" ::: "memory");
            (void)xb_add(&bar[XB_TOP], 1u);
        }
        b.st[3] = leader;
    }
}
template <bool DIRECT>
__device__ __forceinline__ void xcd_barrier_wait(const XcdBarrier& b) {
    if (threadIdx.x == 0) {
        unsigned* bar = b.bar;
        const unsigned want = b.st[2] + 1u, leader = b.st[3], wtop = want * b.st[1];
        if (leader || DIRECT) XB_SPIN((int)(xb_ld(&bar[XB_TOP]) - wtop) < 0, bar);
        else XB_SPIN((int)(xb_ld(&bar[XB_XGEN(b.x)]) - want) < 0, bar);
        __builtin_amdgcn_fence(__ATOMIC_ACQUIRE, "agent");
        if (leader) xb_add(&bar[XB_XGEN(b.x)], 1u);
        asm volatile("s_waitcnt vmcnt(0)" ::: "memory");
        b.st[2] = want;
    }
    __syncthreads();
}
__device__ __forceinline__ void xcd_barrier(const XcdBarrier& b) { xcd_barrier_arrive(b); xcd_barrier_wait<false>(b); }

__device__ __forceinline__ void xcd_local_barrier(const XcdBarrier& b) {
    asm volatile("s_waitcnt vmcnt(0)" ::: "memory");
    __syncthreads();
    if (threadIdx.x == 0) {
        unsigned* bar = b.bar;
        __builtin_amdgcn_s_waitcnt(0);
        const unsigned r = b.st[6] + 1u, want = r * b.st[0];
        (void)xb_add(&bar[XB_XLOC(b.x)], 1u);
        XB_SPIN((int)(xb_ld(&bar[XB_XLOC(b.x)]) - want) < 0, bar);
        __builtin_amdgcn_fence(__ATOMIC_ACQUIRE, "agent");
        asm volatile("s_waitcnt vmcnt(0)" ::: "memory");
        b.st[6] = r;
    }
    __syncthreads();
}
struct Args {
    const float* in[22]; float* out; unsigned char* ws; int ph_lo, ph_hi;
};
enum { I_X = 0, I_C, I_CTX, I_CCTX, I_WMOD, I_BMOD, I_N1W, I_F1W1, I_F1W2, I_N2W, I_WIN, I_MLGB, I_CONVW, I_CONVB, I_LBLOG, I_HGNW, I_MLNW, I_WOUT, I_N3W, I_F2W1, I_F2W2, I_FNW };

struct Ctx {
    LAS unsigned char* lds;
    int tid, lane, wave, vcu, G, gw, NGW, gwr;
};

__device__ __forceinline__ void mods_phase(const Args& a, const Ctx& T, int cb_lo, int cb_hi, int first, int stride) {
    LAS float* sL = (LAS float*)T.lds;
    LAS float* red = (LAS float*)(T.lds + 20480);
    const float* c = a.in[I_C]; const float* cc = a.in[I_CCTX];
    __syncthreads();
    for (int i = T.tid; i < 5 * 1024; i += NTHREADS) { const int r = i >> 10, k = i & 1023; const float v = r < 4 ? c[r * 1024 + k] : cc[k]; sL[i] = siluf_(v); }
    __syncthreads();
    typedef float f2 __attribute__((ext_vector_type(2)));
    for (int item = first; item < (cb_hi - cb_lo) * 8; item += stride) {
        const int cb = cb_lo + (item >> 3), kr = item & 7; const int k0 = kr * 128 + T.wave * 16;
        const float* W = a.in[I_WMOD] + (size_t)k0 * NMODC + cb * 128 + 2 * T.lane;
        f2 wv[16];
#pragma unroll
        for (int k = 0; k < 16; ++k) wv[k] = __builtin_nontemporal_load((const f2*)(W + (size_t)k * NMODC));
        float acc[5][2];
#pragma unroll
        for (int r = 0; r < 5; ++r) { acc[r][0] = 0.f; acc[r][1] = 0.f; }
#pragma unroll
        for (int k = 0; k < 16; ++k)
#pragma unroll
            for (int r = 0; r < 5; ++r) { const float s = sL[r * 1024 + k0 + k]; acc[r][0] += s * wv[k].x; acc[r][1] += s * wv[k].y; }
#pragma unroll
        for (int r = 0; r < 5; ++r) *(LAS f2*)(red + (T.wave * 5 + r) * 128 + 2 * T.lane) = (f2){acc[r][0], acc[r][1]};
        __syncthreads();
        for (int o = T.tid; o < 640; o += NTHREADS) { const int r = o >> 7, cl = o & 127; float s = 0.f;
#pragma unroll
            for (int w = 0; w < 8; ++w) s += red[(w * 5 + r) * 128 + cl];
            const int col = cb * 128 + cl; if (kr == 0) s += a.in[I_BMOD][col];
            atomicAdd((float*)(a.ws + WS_MODS) + r * NMODC + col, s); }
        __syncthreads();
    }
}

__device__ __forceinline__ void transpose_item(const float* W, int ldw, int K, bf16* WT, int k0, int n0, int dest_row0, LAS float* scr, int lane) {
    float tv[32];
#pragma unroll
    for (int i = 0; i < 32; ++i) tv[i] = __builtin_nontemporal_load(W + (size_t)(k0 + 2 * i + (lane >> 5)) * ldw + n0 + (lane & 31));
#pragma unroll
    for (int i = 0; i < 32; ++i) scr[(2 * i + (lane >> 5)) * 33 + (lane & 31)] = tv[i];
    LDS_WAIT(); asm volatile("" ::: "memory");
    const int c = lane & 7;
#pragma unroll
    for (int j = 0; j < 4; ++j) { const int n = (lane >> 3) + 8 * j; const LAS float* s = scr + (8 * c) * 33 + n;
        v4u o; o.x = pk2(s[0 * 33], s[1 * 33]); o.y = pk2(s[2 * 33], s[3 * 33]); o.z = pk2(s[4 * 33], s[5 * 33]); o.w = pk2(s[6 * 33], s[7 * 33]);
        *(GAS v4u*)(WT + (size_t)(dest_row0 + n) * K + k0 + 8 * c) = o; }
    LDS_WAIT(); asm volatile("" ::: "memory");
}
constexpr int CF_I1 = 16 * 176, CF_I2 = 44 * 32, CM_I1 = 16 * 128, CM_I2 = 16 * 32;
__device__ __forceinline__ void convert_ffn(const Args& a, const Ctx& T, const float* w1, const float* w2, int lo, int hi) {
    LAS float* scr = (LAS float*)(T.lds + T.wave * 16384);
    bf16* W1 = (bf16*)(a.ws + WS_W1); bf16* W2 = (bf16*)(a.ws + WS_W2);
    constexpr int I1 = CF_I1;
    for (int it = lo + T.gwr; it < hi; it += T.NGW) {
        if (it < I1) { const int kb = it / 176, nb = it % 176, n0 = nb * 32;
            const int dest = n0 < DFF ? (n0 >> 7) * 256 + (n0 & 127) : ((n0 - DFF) >> 7) * 256 + 128 + ((n0 - DFF) & 127);
            transpose_item(w1, 2 * DFF, DM, W1, kb * 64, n0, dest, scr, T.lane); }
        else { const int r = it - I1, kb = r / 32, nb = r % 32; transpose_item(w2, DM, DFF, W2, kb * 64, nb * 32, nb * 32, scr, T.lane); }
    }
}
__device__ __forceinline__ void convert_mix(const Args& a, const Ctx& T, int lo, int hi) {
    LAS float* scr = (LAS float*)(T.lds + T.wave * 16384);
    bf16* WI = (bf16*)(a.ws + WS_WIN); bf16* WO = (bf16*)(a.ws + WS_WOUT);
    constexpr int I1 = CM_I1;
    for (int it = lo + T.gwr; it < hi; it += T.NGW) {
        if (it < I1) { const int kb = it / 128, nb = it % 128; transpose_item(a.in[I_WIN], DIN, DM, WI, kb * 64, nb * 32, nb * 32, scr, T.lane); }
        else { const int r = it - I1, kb = r / 32, nb = r % 32; transpose_item(a.in[I_WOUT], DM, DM, WO, kb * 64, nb * 32, nb * 32, scr, T.lane); }
    }
}

__device__ __forceinline__ void norm_load_row(f32x4 (&v)[4], const void* src_lat, bool latbf, const float* src_ctx, int m, int lane) {
    if (m < MLAT) {
        if (latbf) { const v2u* xr = (const v2u*)((const bf16*)src_lat + (size_t)m * DM) + lane;
#pragma unroll
            for (int j = 0; j < 4; ++j) { const v2u w = __builtin_nontemporal_load(xr + 64 * j); v[j] = (f32x4){bflo(w.x), bfhi(w.x), bflo(w.y), bfhi(w.y)}; } }
        else { const f32x4* xr = (const f32x4*)((const float*)src_lat + (size_t)m * DM) + lane;
#pragma unroll
            for (int j = 0; j < 4; ++j) v[j] = __builtin_nontemporal_load(xr + 64 * j); }
    } else { const f32x4* xr = (const f32x4*)(src_ctx + (size_t)(m - MLAT) * DM) + lane;
#pragma unroll
        for (int j = 0; j < 4; ++j) v[j] = __builtin_nontemporal_load(xr + 64 * j); }
}
template <bool CTXSLAB, bool LATBF>
__device__ __forceinline__ void norm_mod_rows(const Args& a, const Ctx& T, const void* src_lat, const float* src_ctx, int nrows, const float* nw, int shift_idx, int scale_idx) {
    const float* mods = (const float*)(a.ws + WS_MODS);
    bf16* XN = (bf16*)(a.ws + WS_XN);
    f32x4 wv[4];
#pragma unroll
    for (int j = 0; j < 4; ++j) wv[j] = *((const f32x4*)nw + T.lane + 64 * j);
    int bsel, lbase, lstride, nlat, ctxm;
    if (T.G == 256) {
        const int xq = T.vcu >> 5, lw = (T.vcu & 31) * NWAVES + T.wave;
        bsel = xq >> 1; lbase = (xq & 1) * 2048 + lw; lstride = 256; nlat = 8;
        ctxm = (nrows > MLAT && lw < 128) ? MLAT + xq * 128 + lw : -1;
        if (CTXSLAB) {
            lstride = 128;
            if (lw < 128) nlat = 2; else { lbase = (xq & 1) * 2048 + 256 + (lw - 128); nlat = 14; ctxm = -1; }
        }
    } else {
        const int r0 = T.gw >> 2, rstep = T.NGW >> 2;
        bsel = T.gw & 3; lbase = r0; lstride = rstep; nlat = (4096 - r0 + rstep - 1) / rstep;
        ctxm = (nrows > MLAT && T.gw < nrows - MLAT) ? MLAT + T.gw : -1;
    }
    const bool hasctx = ctxm >= 0;
    const int nit = nlat + (hasctx ? 1 : 0);
    f32x4 v[4];
    f32x4 sh[4], sc[4];
    { const float* mr = mods + (size_t)bsel * NMODC;
#pragma unroll
      for (int j = 0; j < 4; ++j) { sh[j] = *((const f32x4*)(mr + shift_idx * 1024) + T.lane + 64 * j); sc[j] = *((const f32x4*)(mr + scale_idx * 1024) + T.lane + 64 * j) + 1.0f; } }
    if (nit > 0) norm_load_row(v, src_lat, LATBF, src_ctx, nlat > 0 ? bsel * 4096 + lbase : ctxm, T.lane);
    for (int i = 0; i < nit; ++i) {
        const int m = i < nlat ? bsel * 4096 + lbase + lstride * i : ctxm;
        if (i == nlat) { const float* mr = mods + (size_t)4 * NMODC;
#pragma unroll
            for (int j = 0; j < 4; ++j) { sh[j] = *((const f32x4*)(mr + shift_idx * 1024) + T.lane + 64 * j); sc[j] = *((const f32x4*)(mr + scale_idx * 1024) + T.lane + 64 * j) + 1.0f; } }
        f32x4 cur[4]; float s = 0.f;
        if (CTXSLAB && m >= MLAT) {
            const float* gr = mods + (size_t)4 * NMODC + 2 * 1024;
            const v2u* sp = (const v2u*)((const bf16*)(a.ws + WS_SLAB) + (size_t)(m - MLAT) * 1024) + T.lane;
            f32x4 acc[4];
#pragma unroll
            for (int j = 0; j < 4; ++j) acc[j] = (f32x4){0.f, 0.f, 0.f, 0.f};
#pragma unroll 1
            for (int k0 = 0; k0 < 12; k0 += 4) {
                v2u sw_[4][4];
#pragma unroll
                for (int kk = 0; kk < 4; ++kk)
#pragma unroll
                    for (int j = 0; j < 4; ++j) sw_[kk][j] = (k0 + kk < 11) ? __builtin_nontemporal_load(sp + (size_t)(k0 + kk) * 262144 + 64 * j) : (v2u){0u, 0u};
#pragma unroll
                for (int kk = 0; kk < 4; ++kk)
#pragma unroll
                    for (int j = 0; j < 4; ++j) acc[j] += (f32x4){bflo(sw_[kk][j].x), bfhi(sw_[kk][j].x), bflo(sw_[kk][j].y), bfhi(sw_[kk][j].y)};
            }
#pragma unroll
            for (int j = 0; j < 4; ++j) v[j] = v[j] + acc[j] * (*((const f32x4*)gr + T.lane + 64 * j) * 0.5f);
        }
#pragma unroll
        for (int j = 0; j < 4; ++j) { cur[j] = v[j]; s += (v[j].x * v[j].x + v[j].y * v[j].y) + (v[j].z * v[j].z + v[j].w * v[j].w); }
        if (i + 1 < nit) norm_load_row(v, src_lat, LATBF, src_ctx, i + 1 < nlat ? bsel * 4096 + lbase + lstride * (i + 1) : ctxm, T.lane);
        const float rstd = __builtin_amdgcn_rsqf(wave_sum(s) * (1.f / DM) + EPSN);
        unsigned long long* o8 = (unsigned long long*)(XN + (size_t)m * DM) + T.lane;
#pragma unroll
        for (int j = 0; j < 4; ++j) { const f32x4 y = (cur[j] * rstd * wv[j]) * sc[j] + sh[j];
            o8[64 * j] = (unsigned long long)pk2(y.x, y.y) | ((unsigned long long)pk2(y.z, y.w) << 32); }
    }
}

struct ConvTaps { v4u t[9]; };
__device__ __forceinline__ void conv_load(ConvTaps& R, const bf16* P, int m, int ch0) {
    const v4u z = (v4u){0u, 0u, 0u, 0u};
    const int b = m >> 12, t = m & 4095, r = t >> 6, c = t & 63;
#pragma unroll
    for (int dr = -1; dr <= 1; ++dr)
#pragma unroll
        for (int dc = -1; dc <= 1; ++dc) { const int rr = r + dr, c2 = c + dc; const bool ok = rr >= 0 && rr < 64 && c2 >= 0 && c2 < 64;
            R.t[(dr + 1) * 3 + dc + 1] = ok ? *(const v4u*)(P + (size_t)(b * 4096 + rr * 64 + c2) * LDP + 2560 + ch0) : z; }
}
__device__ __forceinline__ void ctx_combine(const Args& a, const Ctx& T) {
    const bf16* S2 = (const bf16*)(a.ws + WS_SLAB2); bf16* P = (bf16*)(a.ws + WS_PROJ);
    for (int task = T.vcu * NTHREADS + T.tid; task < 1024 * 256; task += T.G * NTHREADS) {
        const int r = task >> 8, q = task & 255; const int t8 = q >> 5, c8 = (q & 31) * 8; const int t9 = t8 < 6 ? t8 : t8 + 1;
        const int pn = t9 < 2 ? 2 + t9 : (t9 < 6 ? 4 + t9 : 5 + t9);
        float s[8] = {0.f, 0.f, 0.f, 0.f, 0.f, 0.f, 0.f, 0.f};
#pragma unroll
        for (int ks = 0; ks < 4; ++ks) { const v4u pv = __builtin_nontemporal_load((const v4u*)(S2 + ((size_t)ks * 1024 + r) * 2304 + t9 * 256 + c8));
            s[0] += bflo(pv.x); s[1] += bfhi(pv.x); s[2] += bflo(pv.y); s[3] += bfhi(pv.y); s[4] += bflo(pv.z); s[5] += bfhi(pv.z); s[6] += bflo(pv.w); s[7] += bfhi(pv.w); }
        *(v4u*)(P + (size_t)(MLAT + r) * LDP + pn * 256 + c8) = (v4u){pk2(s[0], s[1]), pk2(s[2], s[3]), pk2(s[4], s[5]), pk2(s[6], s[7])};
    }
}
__device__ __forceinline__ void conv_phase(const Args& a, const Ctx& T) {
    const bf16* P = (const bf16*)(a.ws + WS_PROJ); bf16* QK = (bf16*)(a.ws + WS_QK);
    const float* cw = a.in[I_CONVW]; const float* cb = a.in[I_CONVB];
    const int gid = T.vcu * NTHREADS + T.tid;
    {
        const int ch0 = T.lane * 8;
        float w[9][8], bias[8];
#pragma unroll
        for (int k = 0; k < 9; ++k)
#pragma unroll
            for (int i = 0; i < 8; ++i) w[k][i] = cw[k * 512 + ch0 + i];
#pragma unroll
        for (int i = 0; i < 8; ++i) bias[i] = cb[ch0 + i];
        const float sc = ch0 < 256 ? 0.125f : 1.0f;
        const v4u z = (v4u){0u, 0u, 0u, 0u};
#pragma unroll 1
        for (int job = T.gw; job < NB * 64 * 8; job += T.NGW) {
            const int b = job >> 9, r = (job >> 3) & 63, c0 = (job & 7) * 8;
#pragma unroll 1
            for (int h = 0; h < 2; ++h) {
                const int cb0 = c0 + 4 * h - 1;
                v4u tp[3][6];
#pragma unroll
                for (int dr = 0; dr < 3; ++dr)
#pragma unroll
                    for (int jc = 0; jc < 6; ++jc) { const int rr = r + dr - 1, cc = cb0 + jc; const bool ok = rr >= 0 && rr < 64 && cc >= 0 && cc < 64;
                        tp[dr][jc] = ok ? *(const v4u*)(P + (size_t)(b * 4096 + rr * 64 + cc) * LDP + 2560 + ch0) : z; }
#pragma unroll
                for (int i = 0; i < 4; ++i) {
                    float acc[8];
#pragma unroll
                    for (int e = 0; e < 8; ++e) acc[e] = bias[e];
#pragma unroll
                    for (int dr = 0; dr < 3; ++dr)
#pragma unroll
                        for (int dc = 0; dc < 3; ++dc) { const v4u pv = tp[dr][i + dc]; const int k = dr * 3 + dc;
                            acc[0] += w[k][0] * bflo(pv.x); acc[1] += w[k][1] * bfhi(pv.x); acc[2] += w[k][2] * bflo(pv.y); acc[3] += w[k][3] * bfhi(pv.y);
                            acc[4] += w[k][4] * bflo(pv.z); acc[5] += w[k][5] * bfhi(pv.z); acc[6] += w[k][6] * bflo(pv.w); acc[7] += w[k][7] * bfhi(pv.w); }
#pragma unroll
                    for (int e = 0; e < 8; ++e) acc[e] = acc[e] * fast_sig(acc[e]) * sc;
                    v4u o; o.x = pk2(acc[0], acc[1]); o.y = pk2(acc[2], acc[3]); o.z = pk2(acc[4], acc[5]); o.w = pk2(acc[6], acc[7]);
                    *(v4u*)(QK + (size_t)(b * 4096 + r * 64 + c0 + 4 * h + i) * 512 + ch0) = o;
                }
            }
        }
    }
    {
        const bf16* S2 = (const bf16*)(a.ws + WS_SLAB2);
#pragma unroll 1
        for (int task = gid; task < MCTX * 32; task += T.G * NTHREADS) {
            const int mc = task >> 5, c8 = (task & 31) * 8, b = mc >> 8, t = mc & 255;
            float acc[8];
#pragma unroll
            for (int i = 0; i < 8; ++i) acc[i] = cb[256 + c8 + i];
#pragma unroll 1
            for (int d = -1; d <= 1; ++d) { const int t2 = t + d; if (t2 < 0 || t2 >= 256) continue;
                float s[8] = {0.f, 0.f, 0.f, 0.f, 0.f, 0.f, 0.f, 0.f};
#pragma unroll
                for (int ks = 0; ks < 4; ++ks) { const v4u pv = *(const v4u*)(S2 + ((size_t)ks * 1024 + b * 256 + t2) * 2304 + 6 * 256 + c8);
                    s[0] += bflo(pv.x); s[1] += bfhi(pv.x); s[2] += bflo(pv.y); s[3] += bfhi(pv.y); s[4] += bflo(pv.z); s[5] += bfhi(pv.z); s[6] += bflo(pv.w); s[7] += bfhi(pv.w); }
                const float* wk = cw + (3 + d + 1) * 512 + 256 + c8;
#pragma unroll
                for (int i = 0; i < 8; ++i) acc[i] += wk[i] * bf2f((unsigned short)f2bf(s[i])); }
#pragma unroll
            for (int i = 0; i < 8; ++i) acc[i] = acc[i] * fast_sig(acc[i]);
            v4u o; o.x = pk2(acc[0], acc[1]); o.y = pk2(acc[2], acc[3]); o.z = pk2(acc[4], acc[5]); o.w = pk2(acc[6], acc[7]);
            *(v4u*)(QK + (size_t)(MLAT + mc) * 512 + 256 + c8) = o;
        }
    }
}

typedef short bf16x8 __attribute__((ext_vector_type(8)));
typedef float f32x2 __attribute__((ext_vector_type(2)));
#define MFMA16(a, b, c) __builtin_amdgcn_mfma_f32_16x16x32_bf16((a), (b), (c), 0, 0, 0)
template <int KSTEPS>
__device__ __forceinline__ void mma_tile(f32x4& acc, const LAS unsigned char* A, int sa, const LAS unsigned char* B, int sb, int lane) {
    const LAS unsigned char* pa = A + (lane & 15) * sa + (lane >> 4) * 16; const LAS unsigned char* pb = B + (lane & 15) * sb + (lane >> 4) * 16;
#pragma unroll
    for (int ks = 0; ks < KSTEPS; ++ks) { const bf16x8 av = *(const LAS bf16x8*)(pa + ks * 64); const bf16x8 bv = *(const LAS bf16x8*)(pb + ks * 64); acc = MFMA16(av, bv, acc); }
}
typedef __bf16 bf16x2_t __attribute__((ext_vector_type(2)));
__device__ __forceinline__ unsigned cvtpk(float lo, float hi) { const f32x2 v = {lo, hi}; const bf16x2_t b = __builtin_convertvector(v, bf16x2_t); return __builtin_bit_cast(unsigned, b); }
struct BF2 { bf16x8 k0, k1; };
struct BF4 { bf16x8 k0, k1, k2, k3; };
__device__ __forceinline__ BF2 ldfrag2(const LAS unsigned char* B, int sb, int lane) { const LAS unsigned char* p = B + (lane & 15) * sb + (lane >> 4) * 16; BF2 f; f.k0 = *(const LAS bf16x8*)p; f.k1 = *(const LAS bf16x8*)(p + 64); return f; }
__device__ __forceinline__ BF4 ldfrag4(const LAS unsigned char* B, int sb, int lane) { const LAS unsigned char* p = B + (lane & 15) * sb + (lane >> 4) * 16; BF4 f; f.k0 = *(const LAS bf16x8*)p; f.k1 = *(const LAS bf16x8*)(p + 64); f.k2 = *(const LAS bf16x8*)(p + 128); f.k3 = *(const LAS bf16x8*)(p + 192); return f; }
__device__ __forceinline__ void mma2(f32x4& acc, const LAS unsigned char* A, int sa, const BF2& b, int lane) { const LAS unsigned char* p = A + (lane & 15) * sa + (lane >> 4) * 16;
    acc = MFMA16(*(const LAS bf16x8*)p, b.k0, acc); acc = MFMA16(*(const LAS bf16x8*)(p + 64), b.k1, acc); }
__device__ __forceinline__ void mma4(f32x4& acc, const LAS unsigned char* A, int sa, const BF4& b, int lane) { const LAS unsigned char* p = A + (lane & 15) * sa + (lane >> 4) * 16;
    acc = MFMA16(*(const LAS bf16x8*)p, b.k0, acc); acc = MFMA16(*(const LAS bf16x8*)(p + 64), b.k1, acc); acc = MFMA16(*(const LAS bf16x8*)(p + 128), b.k2, acc); acc = MFMA16(*(const LAS bf16x8*)(p + 192), b.k3, acc); }
__device__ __forceinline__ float ex2(float v) { return __builtin_amdgcn_exp2f(v); }
__device__ __forceinline__ float lg2(float v) { return __builtin_amdgcn_logf(v); }

constexpr int HS_ND = 272;
constexpr int HS_T = 160;
constexpr int HL_QD = 0, HL_KD = HL_QD + 64 * HS_ND, HL_X = HL_KD + 64 * HS_ND, HL_QE = HL_X + 64 * HS_ND;
constexpr int HL_KTT = HL_QE + 64 * HS_ND;
constexpr int HL_VT = HL_KTT + 128 * HS_T;
constexpr int HL_ST = HL_VT + 128 * HS_T;
constexpr int HL_P = HL_ST + 128 * HS_ND;
constexpr int HL_SEG = HL_P + 64 * HS_T;
constexpr int HL_FAC = HL_SEG + 4096;
constexpr int HL_NW = HL_FAC + 512;
constexpr int HL_END = HL_NW + 512;
constexpr int HL_OT = HL_QD, OT_S = 132 * 4;
static_assert(64 * OT_S <= 2 * 64 * HS_ND, "o tile overlay");
static_assert(HL_END <= 160 * 1024 - 1024, "HGRN2 LDS map");

constexpr size_t HG_SLOT_BYTES = 128 * 128 * 2;
__device__ __forceinline__ size_t hg_seq(int b, int dir, int head) { return (size_t)((b * 2 + dir) * 4 + head); }

__device__ __forceinline__ int sc_row(int b, int dir, int js, int lt) {
    if (js == 0) return MLAT + b * NCTX + (dir ? NCTX - 1 - lt : lt);
    const int q = 256 * (js - 1) + lt; return b * SEQ + (dir ? SEQ - 1 - q : q);
}

constexpr int P1_S = 544;
constexpr int P1_KTT = 0, P1_VT = P1_KTT + 128 * P1_S, P1_SEG = P1_VT + 128 * P1_S, P1_END = P1_SEG + 4096;
static_assert(P1_END <= 159 * 1024, "pass-1 LDS map");
__device__ __forceinline__ int p1_row(int b, int blk, int lt) { return blk < 0 ? MLAT + b * NCTX + lt : b * SEQ + 256 * blk + lt; }
template <int DIR>
__device__ __forceinline__ void hg_p1_dir(const Args& a, const Ctx& T, int b, int head, int blk, int slot, bool load_v) {
    const bf16* P = (const bf16*)(a.ws + WS_PROJ);
    LAS unsigned char* L = T.lds;
    const int w = T.wave, l = T.lane, g = l >> 4, c16 = l & 15;
    const int ch = head * 128 + 2 * l;
    const float* lbl = a.in[I_LBLOG];
    float lb[2];
#pragma unroll
    for (int x = 0; x < 2; ++x) lb[x] = sigmoidf_(lbl[DIR * 512 + ch + x] - lbl[(2 + DIR) * 512 + ch + x]);
    unsigned fw[32];
#pragma unroll
    for (int i = 0; i < 32; ++i) fw[i] = *(const unsigned*)(P + (size_t)p1_row(b, blk, 32 * w + i) * LDP + (DIR ? 2048 : 1536) + ch);
    if (load_v) {
        unsigned vw[32];
#pragma unroll
        for (int i = 0; i < 32; ++i) vw[i] = *(const unsigned*)(P + (size_t)p1_row(b, blk, 32 * w + i) * LDP + 512 + ch);
#pragma unroll
        for (int x = 0; x < 2; ++x)
#pragma unroll
            for (int q = 0; q < 4; ++q) { unsigned pv[4];
#pragma unroll
                for (int i = 0; i < 8; i += 2) { const unsigned v0 = x ? (vw[8 * q + i] >> 16) : (vw[8 * q + i] & 0xffffu), v1 = x ? (vw[8 * q + i + 1] >> 16) : (vw[8 * q + i + 1] & 0xffffu); pv[i >> 1] = v0 | (v1 << 16); }
                *(LAS v4u*)(L + P1_VT + (2 * l + x) * P1_S + 64 * w + 16 * q) = (v4u){pv[0], pv[1], pv[2], pv[3]}; }
    }
    float om[2][32];
    float tot[2] = {1.f, 1.f};
#pragma unroll
    for (int i = 0; i < 32; ++i) {
        om[0][i] = (1.f - lb[0]) * fast_sig(-bflo(fw[i])); om[1][i] = (1.f - lb[1]) * fast_sig(-bfhi(fw[i]));
        tot[0] *= 1.f - om[0][i]; tot[1] *= 1.f - om[1][i]; }
    *(LAS f32x2*)(L + P1_SEG + (w * 128 + 2 * l) * 4) = (f32x2){tot[0], tot[1]};
    __syncthreads();
    float after[2] = {1.f, 1.f}, all[2] = {1.f, 1.f};
#pragma unroll
    for (int ww = 0; ww < 8; ++ww) { const f32x2 t2 = *(const LAS f32x2*)(L + P1_SEG + (ww * 128 + 2 * l) * 4); all[0] *= t2.x; all[1] *= t2.y;
        if (DIR ? (ww < w) : (ww > w)) { after[0] *= t2.x; after[1] *= t2.y; } }
#pragma unroll
    for (int x = 0; x < 2; ++x) {
        float run = after[x];
#pragma unroll
        for (int q = 0; q < 4; ++q) { float kv[8];
#pragma unroll
            for (int ii = 0; ii < 8; ++ii) { const int i = DIR ? 8 * q + ii : 31 - (8 * q + ii);
                kv[ii] = om[x][i] * run; run *= 1.f - om[x][i]; }
            if (DIR) *(LAS v4u*)(L + P1_KTT + (2 * l + x) * P1_S + 64 * w + 16 * q) = (v4u){cvtpk(kv[0], kv[1]), cvtpk(kv[2], kv[3]), cvtpk(kv[4], kv[5]), cvtpk(kv[6], kv[7])};
            else *(LAS v4u*)(L + P1_KTT + (2 * l + x) * P1_S + 64 * w + 16 * (3 - q)) = (v4u){cvtpk(kv[7], kv[6]), cvtpk(kv[5], kv[4]), cvtpk(kv[3], kv[2]), cvtpk(kv[1], kv[0])};
        }
    }
    __syncthreads();
    f32x4 accS[8];
#pragma unroll
    for (int m = 0; m < 8; ++m) accS[m] = (f32x4){0.f, 0.f, 0.f, 0.f};
#pragma unroll
    for (int kh = 0; kh < 4; ++kh) {
        const BF2 vf = ldfrag2(L + P1_VT + 16 * w * P1_S + 128 * kh, P1_S, l);
#pragma unroll
        for (int mh = 0; mh < 8; mh += 4) { BF2 kf[4];
#pragma unroll
            for (int m = 0; m < 4; ++m) kf[m] = ldfrag2(L + P1_KTT + 16 * (mh + m) * P1_S + 128 * kh, P1_S, l);
#pragma unroll
            for (int m = 0; m < 4; ++m) accS[mh + m] = MFMA16(kf[m].k0, vf.k0, accS[mh + m]);
#pragma unroll
            for (int m = 0; m < 4; ++m) accS[mh + m] = MFMA16(kf[m].k1, vf.k1, accS[mh + m]); } }
    const size_t sidx = hg_seq(b, DIR, head) * 16 + slot;
    bf16* ST = (bf16*)(a.ws + WS_HGST + sidx * HG_SLOT_BYTES);
#pragma unroll
    for (int m = 0; m < 8; ++m) { v2u o; o.x = cvtpk(accS[m][0], accS[m][1]); o.y = cvtpk(accS[m][2], accS[m][3]); *(v2u*)(ST + (size_t)(16 * w + c16) * 128 + 16 * m + 4 * g) = o; }
    if (w == 0) *(f32x2*)((float*)(a.ws + WS_HGG) + sidx * 128 + 2 * l) = (f32x2){all[0], all[1]};
}
__device__ __forceinline__ void hg_pass1_items(const Args& a, const Ctx& T0, int first, int stride, int limit) {
#pragma unroll 1
    for (int item = first; item < limit; item += stride) {
        Ctx T = T0; asm volatile("" : "+v"(T.lane)); T.tid = T.wave * 64 + T.lane;
        const int k = item & 15, head = (item >> 4) & 3, b = item >> 6;
        const int blkF = k == 0 ? -1 : (k == 15 ? 0 : k), slotF = k == 0 ? 0 : (k == 15 ? 1 : k + 1);
        const int blkB = k == 0 ? -1 : (k == 15 ? 15 : k), slotB = k == 0 ? 0 : (k == 15 ? 1 : 16 - k);
        __syncthreads();
        hg_p1_dir<0>(a, T, b, head, blkF, slotF, true);
        __syncthreads();
        hg_p1_dir<1>(a, T, b, head, blkB, slotB, blkB != blkF);
    }
}

__device__ __forceinline__ void hg_pass2(const Args& a, const Ctx& T) {
    const int ntask = 32 * 2048;
    for (int task = T.vcu * NTHREADS + T.tid; task < ntask; task += T.G * NTHREADS) {
        const int seq = task >> 11, el = (task & 2047) * 8, d0 = el & 127;
        float r[8];
#pragma unroll
        for (int i = 0; i < 8; ++i) r[i] = 0.f;
        for (int j = 0; j < 16; ++j) {
            v4u* p = (v4u*)(a.ws + WS_HGST + ((size_t)seq * 16 + j) * HG_SLOT_BYTES + (size_t)el * 2);
            const float* G = (const float*)(a.ws + WS_HGG) + ((size_t)seq * 16 + j) * 128 + d0;
            const v4u dv = *p; const f32x4 g0 = *(const f32x4*)G, g1 = *(const f32x4*)(G + 4);
            r[0] = g0.x * r[0] + bflo(dv.x); r[1] = g0.y * r[1] + bfhi(dv.x); r[2] = g0.z * r[2] + bflo(dv.y); r[3] = g0.w * r[3] + bfhi(dv.y);
            r[4] = g1.x * r[4] + bflo(dv.z); r[5] = g1.y * r[5] + bfhi(dv.z); r[6] = g1.z * r[6] + bflo(dv.w); r[7] = g1.w * r[7] + bfhi(dv.w);
            *p = (v4u){pk2(r[0], r[1]), pk2(r[2], r[3]), pk2(r[4], r[5]), pk2(r[6], r[7])};
        }
    }
}

struct HgP3Pre { unsigned fw[8], qw[8], vw[8]; };
__device__ __forceinline__ void hg_p3_load(HgP3Pre& R, const bf16* P, int b, int head, int jt, int step, int w, int l) {
    const int dir = step >> 2, c = step & 3; const int ch = head * 128 + 2 * l;
#pragma unroll
    for (int i = 0; i < 8; ++i) { const int lt = 64 * c + 8 * w + i; const size_t row = (size_t)(b * SEQ + 256 * jt + (dir ? 255 - lt : lt));
        R.fw[i] = __builtin_nontemporal_load((const unsigned*)(P + row * LDP + (dir ? 2048 : 1536) + ch)); R.qw[i] = __builtin_nontemporal_load((const unsigned*)(P + row * LDP + ch)); R.vw[i] = __builtin_nontemporal_load((const unsigned*)(P + row * LDP + 512 + ch)); }
}
__device__ __forceinline__ void hg_pass3_item(const Args& a, const Ctx& T0, int item, bf16* OUT) {
    const int jt = item & 15, head = (item >> 4) & 3, b = item >> 6;
    const bf16* P = (const bf16*)(a.ws + WS_PROJ);
    Ctx T = T0; asm volatile("" : "+v"(T.lane));
    T.tid = T.wave * 64 + T.lane;
    LAS unsigned char* L = T.lds;
    const int w = T.wave, l = T.lane, g = l >> 4, c16 = l & 15;
    const int ch = head * 128 + 2 * l;
    const float* lbl = a.in[I_LBLOG];
    __syncthreads();
    for (int i = T.tid; i < 64 * HS_T / 16; i += NTHREADS) *(LAS v4u*)(L + HL_P + i * 16) = (v4u){0u, 0u, 0u, 0u};
    if (T.tid < 128) *(LAS float*)(L + HL_NW + T.tid * 4) = a.in[I_HGNW][head * 128 + T.tid];
    HgP3Pre R;
    hg_p3_load(R, P, b, head, jt, 0, w, l);
    v4u stq[4];
#define HG_STATE_LOAD(dir_) do { const bf16* STg_ = (const bf16*)(a.ws + WS_HGST + (hg_seq(b, (dir_), head) * 16 + ((dir_) ? 15 - jt : jt)) * HG_SLOT_BYTES); \
        _Pragma("unroll") for (int q_ = 0; q_ < 4; ++q_) { const int idx_ = l + 64 * q_; stq[q_] = __builtin_nontemporal_load((const v4u*)(STg_ + (size_t)(16 * w + (idx_ >> 4)) * 128 + (idx_ & 15) * 8)); } } while (0)
    HG_STATE_LOAD(0);
    f32x4 accS[8];
    float lb[2] = {0.f, 0.f};
    const int ot = T.tid >> 3, opart = T.tid & 7;
#pragma unroll 1
    for (int step = 0; step < 8; ++step) {
        const int dir = step >> 2, c = step & 3;
        PS_BEGIN();
        if (c == 0) {
#pragma unroll
            for (int x = 0; x < 2; ++x) lb[x] = sigmoidf_(lbl[dir * 512 + ch + x] - lbl[(2 + dir) * 512 + ch + x]);
            if (dir == 1) { HG_STATE_LOAD(1); VM_WAIT(); __syncthreads(); if (w == 0) { __builtin_amdgcn_fence(__ATOMIC_ACQUIRE, "agent"); VM_WAIT(); } __syncthreads(); }
#pragma unroll
            for (int q = 0; q < 4; ++q) { const int idx = l + 64 * q; *(LAS v4u*)(L + HL_ST + (16 * w + (idx >> 4)) * HS_ND + (idx & 15) * 16) = stq[q]; }
            LDS_WAIT();
#pragma unroll
            for (int m = 0; m < 8; ++m) { const v2u sv = *(const LAS v2u*)(L + HL_ST + (16 * w + c16) * HS_ND + (16 * m + 4 * g) * 2); accS[m] = (f32x4){bflo(sv.x), bfhi(sv.x), bflo(sv.y), bfhi(sv.y)}; }
        }
        PS_END(11);
        float kk[2][8], cl[2][8]; unsigned qw[8], vw[8];
#pragma unroll
        for (int i = 0; i < 8; ++i) { qw[i] = R.qw[i]; vw[i] = R.vw[i]; }
#pragma unroll
        for (int x = 0; x < 2; ++x) { float run = 0.f;
#pragma unroll
            for (int i = 0; i < 8; ++i) { const float fp = x ? bfhi(R.fw[i]) : bflo(R.fw[i]); const float sg = fast_sig(fp); const float f = lb[x] + (1.f - lb[x]) * sg;
                kk[x][i] = (1.f - lb[x]) * (1.f - sg); run += lg2(f); cl[x][i] = run; } }
        if (step < 7) hg_p3_load(R, P, b, head, jt, step + 1, w, l);
        *(LAS f32x2*)(L + HL_SEG + (w * 128 + 2 * l) * 4) = (f32x2){cl[0][7], cl[1][7]};
        PS_END(0); __syncthreads(); PS_END(1);
        const int half = w >> 2;
        float pre[2], mid[2], fx[2], fqe[2], fkt[2];
#pragma unroll
        for (int x = 0; x < 2; ++x) {
            float tt[8];
#pragma unroll
            for (int ww = 0; ww < 8; ++ww) tt[ww] = *(const LAS float*)(L + HL_SEG + (ww * 128 + 2 * l + x) * 4);
            const float r15 = tt[0] + tt[1], r31 = r15 + tt[2] + tt[3], r47 = r31 + tt[4] + tt[5], r63 = r47 + tt[6] + tt[7];
            float p = 0.f;
#pragma unroll
            for (int ww = 0; ww < 8; ++ww) if (ww < w) p += tt[ww];
            pre[x] = p; mid[x] = half ? r47 : r15;
            fx[x] = half ? ex2(r47 - r31) : ex2(r31 - r15); fqe[x] = ex2(mid[x]); fkt[x] = ex2(r63 - mid[x]);
            if (w == 0) *(LAS float*)(L + HL_FAC + (2 * l + x) * 4) = ex2(r63);
        }
        float ktv[2][8];
#pragma unroll
        for (int i = 0; i < 8; ++i) {
            float qd[2], kd[2], xv[2], qe[2];
#pragma unroll
            for (int x = 0; x < 2; ++x) { const float cc = pre[x] + cl[x][i] - mid[x]; const float eq = ex2(cc), ek = ex2(-cc); const float q = x ? bfhi(qw[i]) : bflo(qw[i]);
                qd[x] = q * eq; kd[x] = kk[x][i] * ek; xv[x] = (half ? qd[x] : kd[x]) * fx[x]; qe[x] = qd[x] * fqe[x]; ktv[x][i] = kd[x] * fkt[x]; }
            const int off = (8 * w + i) * HS_ND + 4 * l;
            *(LAS unsigned*)(L + HL_QD + off) = cvtpk(qd[0], qd[1]); *(LAS unsigned*)(L + HL_KD + off) = cvtpk(kd[0], kd[1]);
            *(LAS unsigned*)(L + HL_X + off) = cvtpk(xv[0], xv[1]); *(LAS unsigned*)(L + HL_QE + off) = cvtpk(qe[0], qe[1]);
        }
#pragma unroll
        for (int x = 0; x < 2; ++x) {
            unsigned pv[4];
#pragma unroll
            for (int i = 0; i < 8; i += 2) { const unsigned v0 = x ? (vw[i] >> 16) : (vw[i] & 0xffffu), v1 = x ? (vw[i + 1] >> 16) : (vw[i + 1] & 0xffffu); pv[i >> 1] = v0 | (v1 << 16); }
            *(LAS v4u*)(L + HL_KTT + (2 * l + x) * HS_T + 16 * w) = (v4u){cvtpk(ktv[x][0], ktv[x][1]), cvtpk(ktv[x][2], ktv[x][3]), cvtpk(ktv[x][4], ktv[x][5]), cvtpk(ktv[x][6], ktv[x][7])};
            *(LAS v4u*)(L + HL_VT + (2 * l + x) * HS_T + 16 * w) = (v4u){pv[0], pv[1], pv[2], pv[3]};
        }
        PS_END(0); __syncthreads(); PS_END(1);
        const size_t orow = (size_t)(b * SEQ + 256 * jt + (dir ? 255 - (64 * c + ot) : 64 * c + ot));
        bf16* optr = OUT + orow * DM + head * 128 + 16 * opart;
        v4u pf0 = (v4u){0u, 0u, 0u, 0u}, pf1 = pf0, pg0 = pf0, pg1 = pf0;
        if (dir) { pf0 = *(const v4u*)optr; pf1 = *(const v4u*)(optr + 8); const bf16* gp = P + orow * LDP + 1024 + head * 128 + 16 * opart; pg0 = __builtin_nontemporal_load((const v4u*)gp); pg1 = __builtin_nontemporal_load((const v4u*)(gp + 8)); }
        v2u ptile[2]; int paddr[2] = {-1, -1};
#pragma unroll
        for (int rep = 0; rep < 2; ++rep) { const int tix = w + 8 * rep;
            if (tix < 10) {
                const int I = tix < 1 ? 0 : (tix < 3 ? 1 : (tix < 6 ? 2 : 3)); const int J = tix - (I * (I + 1)) / 2;
                const bool same = (I >> 1) == (J >> 1);
                const int abase = same ? HL_KD : HL_X, bbase = same ? HL_QD : HL_X;
                const BF4 af = ldfrag4(L + abase + 16 * J * HS_ND, HS_ND, l), bf = ldfrag4(L + bbase + 16 * I * HS_ND, HS_ND, l);
                f32x4 at = (f32x4){0.f, 0.f, 0.f, 0.f};
                at = MFMA16(af.k0, bf.k0, at); at = MFMA16(af.k1, bf.k1, at); at = MFMA16(af.k2, bf.k2, at); at = MFMA16(af.k3, bf.k3, at);
                const int tloc = 16 * I + c16, s0 = 16 * J + 4 * g;
                float pr[4];
#pragma unroll
                for (int r = 0; r < 4; ++r) pr[r] = (s0 + r <= tloc) ? at[r] : 0.f;
                ptile[rep].x = cvtpk(pr[0], pr[1]); ptile[rep].y = cvtpk(pr[2], pr[3]); paddr[rep] = HL_P + tloc * HS_T + s0 * 2;
            } }
        f32x4 accO[4];
        { const BF4 sf = ldfrag4(L + HL_ST + 16 * w * HS_ND, HS_ND, l);
#pragma unroll
            for (int I = 0; I < 4; ++I) accO[I] = (f32x4){0.f, 0.f, 0.f, 0.f};
#pragma unroll
            for (int ih = 0; ih < 4; ih += 2) {
                const BF4 q0 = ldfrag4(L + HL_QE + ih * 16 * HS_ND, HS_ND, l), q1 = ldfrag4(L + HL_QE + (ih + 1) * 16 * HS_ND, HS_ND, l);
                accO[ih] = MFMA16(q0.k0, sf.k0, accO[ih]); accO[ih + 1] = MFMA16(q1.k0, sf.k0, accO[ih + 1]);
                accO[ih] = MFMA16(q0.k1, sf.k1, accO[ih]); accO[ih + 1] = MFMA16(q1.k1, sf.k1, accO[ih + 1]);
                accO[ih] = MFMA16(q0.k2, sf.k2, accO[ih]); accO[ih + 1] = MFMA16(q1.k2, sf.k2, accO[ih + 1]);
                accO[ih] = MFMA16(q0.k3, sf.k3, accO[ih]); accO[ih + 1] = MFMA16(q1.k3, sf.k3, accO[ih + 1]); } }
        const BF2 vf = ldfrag2(L + HL_VT + 16 * w * HS_T, HS_T, l);
#pragma unroll
        for (int mh = 0; mh < 8; mh += 4) {
            BF2 kf[4]; f32x4 gv[4];
#pragma unroll
            for (int m = 0; m < 4; ++m) { kf[m] = ldfrag2(L + HL_KTT + 16 * (mh + m) * HS_T, HS_T, l); gv[m] = *(const LAS f32x4*)(L + HL_FAC + (16 * (mh + m) + 4 * g) * 4); }
#pragma unroll
            for (int m = 0; m < 4; ++m) accS[mh + m] = accS[mh + m] * gv[m];
#pragma unroll
            for (int m = 0; m < 4; ++m) accS[mh + m] = MFMA16(kf[m].k0, vf.k0, accS[mh + m]);
#pragma unroll
            for (int m = 0; m < 4; ++m) accS[mh + m] = MFMA16(kf[m].k1, vf.k1, accS[mh + m]);
        }
#pragma unroll
        for (int rep = 0; rep < 2; ++rep) if (paddr[rep] >= 0) *(LAS v2u*)(L + paddr[rep]) = ptile[rep];
        PS_END(2); __syncthreads(); PS_END(1);
        { const BF2 p0 = ldfrag2(L + HL_P + 0 * 16 * HS_T, HS_T, l), p1 = ldfrag2(L + HL_P + 1 * 16 * HS_T, HS_T, l), p2 = ldfrag2(L + HL_P + 2 * 16 * HS_T, HS_T, l), p3 = ldfrag2(L + HL_P + 3 * 16 * HS_T, HS_T, l);
            accO[0] = MFMA16(p0.k0, vf.k0, accO[0]); accO[1] = MFMA16(p1.k0, vf.k0, accO[1]); accO[2] = MFMA16(p2.k0, vf.k0, accO[2]); accO[3] = MFMA16(p3.k0, vf.k0, accO[3]);
            accO[0] = MFMA16(p0.k1, vf.k1, accO[0]); accO[1] = MFMA16(p1.k1, vf.k1, accO[1]); accO[2] = MFMA16(p2.k1, vf.k1, accO[2]); accO[3] = MFMA16(p3.k1, vf.k1, accO[3]); }
#pragma unroll
        for (int m = 0; m < 8; ++m) { v2u o; o.x = cvtpk(accS[m][0], accS[m][1]); o.y = cvtpk(accS[m][2], accS[m][3]); *(LAS v2u*)(L + HL_ST + (16 * w + c16) * HS_ND + (16 * m + 4 * g) * 2) = o; }
#pragma unroll
        for (int I = 0; I < 4; ++I)
#pragma unroll
            for (int r = 0; r < 4; ++r) *(LAS float*)(L + HL_OT + (16 * I + 4 * g + r) * OT_S + (16 * w + c16) * 4) = accO[I][r];
        PS_END(3); __syncthreads(); PS_END(1);
        { float ov[16];
#pragma unroll
            for (int q = 0; q < 4; ++q) { const f32x4 t4 = *(const LAS f32x4*)(L + HL_OT + ot * OT_S + (16 * opart + 4 * q) * 4); ov[4 * q] = t4.x; ov[4 * q + 1] = t4.y; ov[4 * q + 2] = t4.z; ov[4 * q + 3] = t4.w; }
            if (dir) {
                float fo[16], gt[16];
#pragma unroll
                for (int q = 0; q < 4; ++q) { fo[2 * q] = bflo(pf0[q]); fo[2 * q + 1] = bfhi(pf0[q]); fo[8 + 2 * q] = bflo(pf1[q]); fo[8 + 2 * q + 1] = bfhi(pf1[q]);
                    gt[2 * q] = bflo(pg0[q]); gt[2 * q + 1] = bfhi(pg0[q]); gt[8 + 2 * q] = bflo(pg1[q]); gt[8 + 2 * q + 1] = bfhi(pg1[q]); }
                float ss = 0.f;
#pragma unroll
                for (int i = 0; i < 16; ++i) { ov[i] += fo[i]; ss += ov[i] * ov[i]; }
                ss += __shfl_xor(ss, 1); ss += __shfl_xor(ss, 2); ss += __shfl_xor(ss, 4);
                const float rstd = __builtin_amdgcn_rsqf(ss * (1.f / 128.f) + EPSN);
#pragma unroll
                for (int q = 0; q < 4; ++q) { const f32x4 nw4 = *(const LAS f32x4*)(L + HL_NW + (16 * opart + 4 * q) * 4);
                    ov[4 * q] *= rstd * nw4.x * gt[4 * q]; ov[4 * q + 1] *= rstd * nw4.y * gt[4 * q + 1]; ov[4 * q + 2] *= rstd * nw4.z * gt[4 * q + 2]; ov[4 * q + 3] *= rstd * nw4.w * gt[4 * q + 3]; }
            }
            *(v4u*)optr = (v4u){cvtpk(ov[0], ov[1]), cvtpk(ov[2], ov[3]), cvtpk(ov[4], ov[5]), cvtpk(ov[6], ov[7])};
            *(v4u*)(optr + 8) = (v4u){cvtpk(ov[8], ov[9]), cvtpk(ov[10], ov[11]), cvtpk(ov[12], ov[13]), cvtpk(ov[14], ov[15])}; }
        PS_END(4);
    }
}

constexpr int MS = 160;
constexpr int ML_Q = 0, ML_K = ML_Q + 64 * MS, ML_KTT = ML_K + 64 * MS, ML_VT = ML_KTT + 64 * MS, ML_CT = ML_VT + 144 * MS, ML_P = ML_CT + 144 * MS;
constexpr int ML_TA = ML_P + 64 * MS;
constexpr int ML_TMU = ML_TA + 1024, ML_TIW = ML_TMU + 1024, ML_TSW = ML_TIW + 1024, ML_TEM = ML_TSW + 1024;
constexpr int ML_TRI = ML_TEM + 1024;
constexpr int ML_SC = ML_TRI + 256;
constexpr int ML_NW = ML_SC + 64;
constexpr int ML_OT = ML_NW + 512;
constexpr int ML_END = ML_OT + 64 * OT_S;
static_assert(ML_END <= 159 * 1024, "mLSTM LDS map");
constexpr size_t ML_SLOT_BYTES = 144 * 64 * 2;
constexpr float LOG2E = 1.4426950408889634f;

__device__ __forceinline__ float wave_incl_sum(float v, int lane) {
#pragma unroll
    for (int o = 1; o < 64; o <<= 1) { const float t = __shfl_up(v, o); if (lane >= o) v += t; }
    return v;
}
__device__ __forceinline__ float wave_incl_max(float v, int lane) {
#pragma unroll
    for (int o = 1; o < 64; o <<= 1) { const float t = __shfl_up(v, o); if (lane >= o) v = fmaxf(v, t); }
    return v;
}
template <bool WHOLE>
__device__ __forceinline__ float ml_scalars256(LAS unsigned char* L, const float (&ig)[4], const float (&fg)[4], float m_prev, float& bsum, int lane, int tb = 0) {
    f32x4 B, av, mu;
    { float run = 0.f;
#pragma unroll
        for (int i = 0; i < 4; ++i) { run += (fminf(fg[i], 0.f) - log1pf(__expf(-fabsf(fg[i])))) * LOG2E; B[i] = run; } }
    { const float incl = wave_incl_sum(B[3], lane); B = B + (incl - B[3]); }
#pragma unroll
    for (int i = 0; i < 4; ++i) av[i] = ig[i] * LOG2E - B[i];
    *(LAS f32x4*)(L + tb + ML_TA + lane * 16) = av;
    { float pm = av[0]; mu[0] = pm; pm = fmaxf(pm, av[1]); mu[1] = pm; pm = fmaxf(pm, av[2]); mu[2] = pm; pm = fmaxf(pm, av[3]); mu[3] = pm;
        const float inclm = wave_incl_max(pm, lane); float exm = __shfl_up(inclm, 1); if (lane == 0) exm = m_prev; exm = fmaxf(exm, m_prev);
#pragma unroll
        for (int i = 0; i < 4; ++i) mu[i] = fmaxf(mu[i], exm); }
    *(LAS f32x4*)(L + tb + ML_TMU + lane * 16) = mu;
    { f32x4 te;
#pragma unroll
        for (int i = 0; i < 4; ++i) te[i] = ex2(-(B[i] + mu[i]));
        *(LAS f32x4*)(L + tb + ML_TEM + lane * 16) = te; }
    const float b255 = __shfl(B[3], 63), mu255 = __shfl(mu[3], 63);
    const int c = lane >> 4;
    const float mu_end = WHOLE ? mu255 : __shfl(mu[3], 16 * c + 15); float mu_start = __shfl(mu[3], (16 * c + 63) & 63); if (c == 0) mu_start = m_prev;
    { f32x4 ti;
#pragma unroll
        for (int i = 0; i < 4; ++i) ti[i] = ex2(mu_start - mu[i]);
        *(LAS f32x4*)(L + tb + ML_TIW + lane * 16) = ti; }
    { f32x4 ts;
#pragma unroll
        for (int i = 0; i < 4; ++i) ts[i] = ex2(av[i] - mu_end);
        *(LAS f32x4*)(L + tb + ML_TSW + lane * 16) = ts; }
    if ((lane & 15) == 0) *(LAS float*)(L + tb + ML_SC + c * 4) = ex2(mu_start - mu_end);
    bsum = b255;
    return b255 + mu255;
}
__device__ __forceinline__ void ml_aug_rows(LAS unsigned char* L, int tid) {
    for (int i = tid; i < 16 * 8; i += NTHREADS) { const int r = i >> 3, q = i & 7; const unsigned v = r == 0 ? 0x3F803F80u : 0u; *(LAS v4u*)(L + ML_VT + (128 + r) * MS + q * 16) = (v4u){v, v, v, v}; }
}
struct MlPre { unsigned kw[8], vw[8]; v4u qn, kn; };
#define ML_LOAD_KV(R, ROWF) do { \
    if (T.tid < 256) { const int dp_ = T.tid & 31, tg_ = T.tid >> 5; _Pragma("unroll") for (int i = 0; i < 8; ++i) { const size_t row_ = (size_t)(ROWF(8 * tg_ + i)); (R).kw[i] = __builtin_nontemporal_load((const unsigned*)(QK + row_ * 512 + 256 + head * 64 + 2 * dp_)); } } \
    { const int ep_ = T.tid & 63, tg_ = T.tid >> 6; _Pragma("unroll") for (int i = 0; i < 8; ++i) { const size_t row_ = (size_t)(ROWF(8 * tg_ + i)); (R).vw[i] = __builtin_nontemporal_load((const unsigned*)(P + row_ * LDP + 3072 + head * 128 + 2 * ep_)); } } \
} while (0)
#define ML_STORE_KV(R, cch) do { \
    if (T.tid < 256) { const int dp_ = T.tid & 31, tg_ = T.tid >> 5; \
        const f32x4 s0_ = *(const LAS f32x4*)(L + ML_TSW + ((cch) * 64 + 8 * tg_) * 4), s1_ = *(const LAS f32x4*)(L + ML_TSW + ((cch) * 64 + 8 * tg_ + 4) * 4); \
        const float sw_[8] = {s0_.x, s0_.y, s0_.z, s0_.w, s1_.x, s1_.y, s1_.z, s1_.w}; \
        _Pragma("unroll") for (int x = 0; x < 2; ++x) { float kv_[8]; _Pragma("unroll") for (int i = 0; i < 8; ++i) kv_[i] = (x ? bfhi((R).kw[i]) : bflo((R).kw[i])) * sw_[i]; \
            *(LAS v4u*)(L + ML_KTT + (2 * dp_ + x) * MS + 16 * tg_) = (v4u){cvtpk(kv_[0], kv_[1]), cvtpk(kv_[2], kv_[3]), cvtpk(kv_[4], kv_[5]), cvtpk(kv_[6], kv_[7])}; } } \
    { const int ep_ = T.tid & 63, tg_ = T.tid >> 6; \
        _Pragma("unroll") for (int x = 0; x < 2; ++x) { unsigned pv_[4]; \
            _Pragma("unroll") for (int i = 0; i < 8; i += 2) { const unsigned v0_ = x ? ((R).vw[i] >> 16) : ((R).vw[i] & 0xffffu), v1_ = x ? ((R).vw[i + 1] >> 16) : ((R).vw[i + 1] & 0xffffu); pv_[i >> 1] = v0_ | (v1_ << 16); } \
            *(LAS v4u*)(L + ML_VT + (2 * ep_ + x) * MS + 16 * tg_) = (v4u){pv_[0], pv_[1], pv_[2], pv_[3]}; } } \
} while (0)

constexpr int Q1_KTT = 0, Q1_VT = Q1_KTT + 64 * P1_S, Q1_TAB = Q1_VT + 144 * P1_S;
constexpr int Q1_TB = Q1_TAB - ML_TA;
static_assert(ML_SC + Q1_TB + 64 <= 159 * 1024, "mLSTM pass-1 LDS map");
template <int DIR>
__device__ __forceinline__ void ml_p1_dir(const Args& a, const Ctx& T, int b, int head, int blk, int slot, const unsigned (&kw)[16], const float (&ig)[4], const float (&fg)[4]) {
    LAS unsigned char* L = T.lds;
    const int w = T.wave, l = T.lane, g = l >> 4, c16 = l & 15;
    float mloc = 0.f, bsum = 0.f;
    if (w == 0) mloc = ml_scalars256<true>(L, ig, fg, -1e30f, bsum, l, Q1_TB);
    __syncthreads();
    { const int dp = T.tid & 31, tg = T.tid >> 5;
        float sw[16];
#pragma unroll
        for (int q = 0; q < 4; ++q) { const int s0 = 16 * tg + 4 * q;
            const f32x4 t4 = *(const LAS f32x4*)(L + Q1_TB + ML_TSW + (DIR ? 252 - s0 : s0) * 4);
            sw[4 * q] = DIR ? t4.w : t4.x; sw[4 * q + 1] = DIR ? t4.z : t4.y; sw[4 * q + 2] = DIR ? t4.y : t4.z; sw[4 * q + 3] = DIR ? t4.x : t4.w; }
#pragma unroll
        for (int x = 0; x < 2; ++x)
#pragma unroll
            for (int q = 0; q < 2; ++q) { float kv[8];
#pragma unroll
                for (int i = 0; i < 8; ++i) kv[i] = (x ? bfhi(kw[8 * q + i]) : bflo(kw[8 * q + i])) * sw[8 * q + i];
                *(LAS v4u*)(L + Q1_KTT + (2 * dp + x) * P1_S + 32 * tg + 16 * q) = (v4u){cvtpk(kv[0], kv[1]), cvtpk(kv[2], kv[3]), cvtpk(kv[4], kv[5]), cvtpk(kv[6], kv[7])}; } }
    __syncthreads();
    f32x4 accC[4], accCA = (f32x4){0.f, 0.f, 0.f, 0.f};
#pragma unroll
    for (int m = 0; m < 4; ++m) accC[m] = (f32x4){0.f, 0.f, 0.f, 0.f};
#pragma unroll
    for (int kh = 0; kh < 4; ++kh) {
        const BF2 vf = ldfrag2(L + Q1_VT + 16 * w * P1_S + 128 * kh, P1_S, l);
        BF2 kf[4];
#pragma unroll
        for (int m = 0; m < 4; ++m) kf[m] = ldfrag2(L + Q1_KTT + 16 * m * P1_S + 128 * kh, P1_S, l);
#pragma unroll
        for (int m = 0; m < 4; ++m) accC[m] = MFMA16(kf[m].k0, vf.k0, accC[m]);
#pragma unroll
        for (int m = 0; m < 4; ++m) accC[m] = MFMA16(kf[m].k1, vf.k1, accC[m]);
        if (w < 4) { const BF2 af = ldfrag2(L + Q1_VT + 128 * P1_S + 128 * kh, P1_S, l); const BF2 kfw = ldfrag2(L + Q1_KTT + 16 * w * P1_S + 128 * kh, P1_S, l);
            accCA = MFMA16(kfw.k0, af.k0, accCA); accCA = MFMA16(kfw.k1, af.k1, accCA); } }
    const size_t sidx = hg_seq(b, DIR, head) * 16 + slot;
    bf16* CT = (bf16*)(a.ws + WS_MLST + sidx * ML_SLOT_BYTES);
#pragma unroll
    for (int m = 0; m < 4; ++m) { v2u o; o.x = cvtpk(accC[m][0], accC[m][1]); o.y = cvtpk(accC[m][2], accC[m][3]); *(v2u*)(CT + (size_t)(16 * w + c16) * 64 + 16 * m + 4 * g) = o; }
    if (w < 4) { v2u o; o.x = cvtpk(accCA[0], accCA[1]); o.y = cvtpk(accCA[2], accCA[3]); *(v2u*)(CT + (size_t)(128 + c16) * 64 + 16 * w + 4 * g) = o; }
    if (T.tid == 0) { float* sc = (float*)(a.ws + WS_MLSC) + sidx * 4; sc[0] = mloc; sc[1] = bsum; }
}
__device__ __forceinline__ void ml_pass1_items(const Args& a, const Ctx& T0, int first, int stride, int limit) {
    const bf16* P = (const bf16*)(a.ws + WS_PROJ); const bf16* QK = (const bf16*)(a.ws + WS_QK); const float* GT = (const float*)(a.ws + WS_GATES);
    __syncthreads();
    for (int i = T0.tid; i < 16 * 32; i += NTHREADS) { const int r = i >> 5, q = i & 31; const unsigned v = r == 0 ? 0x3F803F80u : 0u; *(LAS v4u*)(T0.lds + Q1_VT + (128 + r) * P1_S + q * 16) = (v4u){v, v, v, v}; }
#pragma unroll 1
    for (int item = first; item < limit; item += stride) {
        Ctx T = T0; asm volatile("" : "+v"(T.lane)); T.tid = T.wave * 64 + T.lane;
        LAS unsigned char* L = T.lds;
        const int w = T.wave, l = T.lane;
        const int k = item & 15, head = (item >> 4) & 3, b = item >> 6;
        const int blkF = k == 0 ? -1 : (k == 15 ? 0 : k), slotF = k == 0 ? 0 : (k == 15 ? 1 : k + 1);
        const int blkB = k == 0 ? -1 : (k == 15 ? 15 : k), slotB = k == 0 ? 0 : (k == 15 ? 1 : 16 - k);
#pragma unroll 1
        for (int dir = 0; dir < 2; ++dir) {
            const int blk = dir ? blkB : blkF;
            float ig[4] = {0.f, 0.f, 0.f, 0.f}, fg[4] = {0.f, 0.f, 0.f, 0.f};
            if (w == 0) {
#pragma unroll
                for (int c = 0; c < 4; ++c) { const int u = 4 * l + c; const size_t row = (size_t)p1_row(b, blk, dir ? 255 - u : u); ig[c] = GT[row * 16 + (dir ? 8 : 0) + head]; fg[c] = GT[row * 16 + (dir ? 12 : 4) + head]; } }
            unsigned kw[16];
            { const int dp = T.tid & 31, tg = T.tid >> 5;
#pragma unroll
                for (int i = 0; i < 16; ++i) kw[i] = *(const unsigned*)(QK + (size_t)p1_row(b, blk, 16 * tg + i) * 512 + 256 + head * 64 + 2 * dp); }
            __syncthreads();
            if (dir == 0 || blkB != blkF) {
                const int ep = T.tid & 63, tg = T.tid >> 6; unsigned vw[32];
#pragma unroll
                for (int i = 0; i < 32; ++i) vw[i] = *(const unsigned*)(P + (size_t)p1_row(b, blk, 32 * tg + i) * LDP + 3072 + head * 128 + 2 * ep);
#pragma unroll
                for (int x = 0; x < 2; ++x)
#pragma unroll
                    for (int q = 0; q < 4; ++q) { unsigned pv[4];
#pragma unroll
                        for (int i = 0; i < 8; i += 2) { const unsigned v0 = x ? (vw[8 * q + i] >> 16) : (vw[8 * q + i] & 0xffffu), v1 = x ? (vw[8 * q + i + 1] >> 16) : (vw[8 * q + i + 1] & 0xffffu); pv[i >> 1] = v0 | (v1 << 16); }
                        *(LAS v4u*)(L + Q1_VT + (2 * ep + x) * P1_S + 64 * tg + 16 * q) = (v4u){pv[0], pv[1], pv[2], pv[3]}; }
            }
            if (dir == 0) ml_p1_dir<0>(a, T, b, head, blk, slotF, kw, ig, fg); else ml_p1_dir<1>(a, T, b, head, blk, slotB, kw, ig, fg);
        }
    }
}

__device__ __forceinline__ void pass2_all(const Args& a, const Ctx& T, bool xl) {
    int gid = T.vcu * NTHREADS + T.tid;
    int hgseq = gid >> 11, mlseq = (gid - 32 * 2048) / 1152, mlel = ((gid - 32 * 2048) % 1152) * 8; bool ishg = gid < 32 * 2048, isml = !ishg && gid < 32 * 2048 + 32 * 1152;
    if (xl) { const int x = T.vcu >> 5, g2 = (T.vcu & 31) * NTHREADS + T.tid;
        ishg = g2 < 4 * 2048; isml = !ishg && g2 < 4 * 2048 + 4 * 1152;
        const int ls = ishg ? (g2 >> 11) : (g2 - 4 * 2048) / 1152;
        const int sq = (int)hg_seq(x >> 1, ls >> 1, 2 * (x & 1) + (ls & 1));
        hgseq = sq; mlseq = sq; gid = g2; mlel = ((g2 - 4 * 2048) % 1152) * 8; }
    if (ishg) {
        const int seq = hgseq, el = (gid & 2047) * 8, d0 = el & 127;
        float r[8];
#pragma unroll
        for (int i = 0; i < 8; ++i) r[i] = 0.f;
#pragma unroll 1
        for (int j0 = 0; j0 < 16; j0 += 4) {
            v4u dv[4]; f32x4 g0[4], g1[4];
#pragma unroll
            for (int jj = 0; jj < 4; ++jj) { const size_t sidx = (size_t)seq * 16 + j0 + jj; dv[jj] = *(const v4u*)(a.ws + WS_HGST + sidx * HG_SLOT_BYTES + (size_t)el * 2);
                const float* G = (const float*)(a.ws + WS_HGG) + sidx * 128 + d0; g0[jj] = *(const f32x4*)G; g1[jj] = *(const f32x4*)(G + 4); }
#pragma unroll
            for (int jj = 0; jj < 4; ++jj) { const size_t sidx = (size_t)seq * 16 + j0 + jj;
                r[0] = g0[jj].x * r[0] + bflo(dv[jj].x); r[1] = g0[jj].y * r[1] + bfhi(dv[jj].x); r[2] = g0[jj].z * r[2] + bflo(dv[jj].y); r[3] = g0[jj].w * r[3] + bfhi(dv[jj].y);
                r[4] = g1[jj].x * r[4] + bflo(dv[jj].z); r[5] = g1[jj].y * r[5] + bfhi(dv[jj].z); r[6] = g1[jj].z * r[6] + bflo(dv[jj].w); r[7] = g1[jj].w * r[7] + bfhi(dv[jj].w);
                *(v4u*)(a.ws + WS_HGST + sidx * HG_SLOT_BYTES + (size_t)el * 2) = (v4u){cvtpk(r[0], r[1]), cvtpk(r[2], r[3]), cvtpk(r[4], r[5]), cvtpk(r[6], r[7])}; }
        }
    } else if (isml) {
        const int seq = mlseq, el = mlel;
        float r[8], m = 0.f;
#pragma unroll
        for (int i = 0; i < 8; ++i) r[i] = 0.f;
#pragma unroll 1
        for (int j0 = 0; j0 < 16; j0 += 4) {
            v4u dv[4]; float ml[4], bt[4];
#pragma unroll
            for (int jj = 0; jj < 4; ++jj) { const size_t sidx = (size_t)seq * 16 + j0 + jj; dv[jj] = *(const v4u*)(a.ws + WS_MLST + sidx * ML_SLOT_BYTES + (size_t)el * 2);
                const float* sc = (const float*)(a.ws + WS_MLSC) + sidx * 4; ml[jj] = sc[0]; bt[jj] = sc[1]; }
#pragma unroll
            for (int jj = 0; jj < 4; ++jj) { const size_t sidx = (size_t)seq * 16 + j0 + jj;
                const float mn = fmaxf(bt[jj] + m, ml[jj]); const float cA = ex2(bt[jj] + m - mn), cB = ex2(ml[jj] - mn); m = mn;
                r[0] = cA * r[0] + cB * bflo(dv[jj].x); r[1] = cA * r[1] + cB * bfhi(dv[jj].x); r[2] = cA * r[2] + cB * bflo(dv[jj].y); r[3] = cA * r[3] + cB * bfhi(dv[jj].y);
                r[4] = cA * r[4] + cB * bflo(dv[jj].z); r[5] = cA * r[5] + cB * bfhi(dv[jj].z); r[6] = cA * r[6] + cB * bflo(dv[jj].w); r[7] = cA * r[7] + cB * bfhi(dv[jj].w);
                *(v4u*)(a.ws + WS_MLST + sidx * ML_SLOT_BYTES + (size_t)el * 2) = (v4u){cvtpk(r[0], r[1]), cvtpk(r[2], r[3]), cvtpk(r[4], r[5]), cvtpk(r[6], r[7])};
                if (el == 0) ((float*)(a.ws + WS_MLSC))[sidx * 4 + 2] = mn; }
        }
    }
}

__device__ __forceinline__ void ml_pass3_item(const Args& a, const Ctx& T0, int item, bf16* OUT) {
    const int jt = item & 15, head = (item >> 4) & 3, b = item >> 6;
    const bf16* P = (const bf16*)(a.ws + WS_PROJ); const bf16* QK = (const bf16*)(a.ws + WS_QK); const float* GT = (const float*)(a.ws + WS_GATES);
    Ctx T = T0; asm volatile("" : "+v"(T.lane));
    T.tid = T.wave * 64 + T.lane;
    LAS unsigned char* L = T.lds;
    const int w = T.wave, l = T.lane, g = l >> 4, c16 = l & 15;
    __syncthreads();
    for (int i = T.tid; i < 64 * MS / 16; i += NTHREADS) *(LAS v4u*)(L + ML_P + i * 16) = (v4u){0u, 0u, 0u, 0u};
    ml_aug_rows(L, T.tid);
    if (T.tid < 128) *(LAS float*)(L + ML_NW + T.tid * 4) = a.in[I_MLNW][head * 128 + T.tid];
#define ML_ROW3(st_, lt_) (b * SEQ + 256 * jt + (((st_) >> 2) ? 255 - (64 * ((st_) & 3) + (lt_)) : 64 * ((st_) & 3) + (lt_)))
    MlPre R;
    const int qt = T.tid >> 3, qpart = T.tid & 7;
#define ML_LOAD_ALL(st_) do { ML_LOAD_KV(R, ROWF_); const size_t rq_ = (size_t)ML_ROW3((st_), qt); R.qn = __builtin_nontemporal_load((const v4u*)(QK + rq_ * 512 + head * 64 + qpart * 8)); R.kn = __builtin_nontemporal_load((const v4u*)(QK + rq_ * 512 + 256 + head * 64 + qpart * 8)); } while (0)
#define ROWF_(x_) ML_ROW3(0, (x_))
    ML_LOAD_ALL(0);
#undef ROWF_
    f32x4 accC[4], accCA = (f32x4){0.f, 0.f, 0.f, 0.f};
    v4u stq[2], sta[2];
#define ML_STATE_LOAD(dir_) do { const size_t sidx_ = hg_seq(b, (dir_), head) * 16 + ((dir_) ? 15 - jt : jt); const bf16* CTg_ = (const bf16*)(a.ws + WS_MLST + sidx_ * ML_SLOT_BYTES); \
        _Pragma("unroll") for (int q_ = 0; q_ < 2; ++q_) { const int idx_ = l + 64 * q_; stq[q_] = *(const v4u*)(CTg_ + (size_t)(16 * w + (idx_ >> 3)) * 64 + (idx_ & 7) * 8); \
            if (w == 4) sta[q_] = *(const v4u*)(CTg_ + (size_t)(128 + (idx_ >> 3)) * 64 + (idx_ & 7) * 8); } } while (0)
    ML_STATE_LOAD(0);
#pragma unroll 1
    for (int step = 0; step < 8; ++step) {
        const int dir = step >> 2, c = step & 3;
        PS_BEGIN();
        if (c == 0) {
            const size_t sidx = hg_seq(b, dir, head) * 16 + (dir ? 15 - jt : jt);
            if (dir == 1) { ML_STATE_LOAD(1); VM_WAIT(); __syncthreads(); if (w == 0) { __builtin_amdgcn_fence(__ATOMIC_ACQUIRE, "agent"); VM_WAIT(); } }
            __syncthreads();
#pragma unroll
            for (int q = 0; q < 2; ++q) { const int idx = l + 64 * q; *(LAS v4u*)(L + ML_CT + (16 * w + (idx >> 3)) * MS + (idx & 7) * 16) = stq[q];
                if (w == 4) *(LAS v4u*)(L + ML_CT + (128 + (idx >> 3)) * MS + (idx & 7) * 16) = sta[q]; }
            if (w == 0) { float ig[4], fg[4];
#pragma unroll
                for (int cc = 0; cc < 4; ++cc) { const int lt = 4 * l + cc; const size_t row = (size_t)ML_ROW3(4 * dir + (lt >> 6), lt & 63); ig[cc] = GT[row * 16 + (dir ? 8 : 0) + head]; fg[cc] = GT[row * 16 + (dir ? 12 : 4) + head]; }
                float bsum = 0.f; const float m0 = ((const float*)(a.ws + WS_MLSC))[sidx * 4 + 2]; (void)ml_scalars256<false>(L, ig, fg, m0, bsum, l); }
            __syncthreads();
#pragma unroll
            for (int m = 0; m < 4; ++m) { const v2u sv = *(const LAS v2u*)(L + ML_CT + (16 * w + c16) * MS + (16 * m + 4 * g) * 2); accC[m] = (f32x4){bflo(sv.x), bfhi(sv.x), bflo(sv.y), bfhi(sv.y)}; }
            if (w < 4) { const v2u sv = *(const LAS v2u*)(L + ML_CT + (128 + c16) * MS + (16 * w + 4 * g) * 2); accCA = (f32x4){bflo(sv.x), bfhi(sv.x), bflo(sv.y), bfhi(sv.y)}; }
        }
        PS_END(5);
        *(LAS v4u*)(L + ML_Q + qt * MS + qpart * 16) = R.qn; *(LAS v4u*)(L + ML_K + qt * MS + qpart * 16) = R.kn;
        ML_STORE_KV(R, c);
        if (step < 7) {
#define ROWF_(x_) ML_ROW3(step + 1, (x_))
            ML_LOAD_ALL(step + 1);
#undef ROWF_
        }
        PS_END(6); __syncthreads(); PS_END(10);
        const size_t orow = (size_t)ML_ROW3(step, qt);
        bf16* optr = OUT + orow * DM + 512 + head * 128 + 16 * qpart;
        v2u ptile[2]; int paddr[2] = {-1, -1};
#pragma unroll 1
        for (int rep = 0; rep < 2; ++rep) { const int tix = w + 8 * rep;
            if (tix < 10) {
                const int I = tix < 1 ? 0 : (tix < 3 ? 1 : (tix < 6 ? 2 : 3)); const int J = tix - (I * (I + 1)) / 2;
                const BF2 af = ldfrag2(L + ML_K + 16 * J * MS, MS, l), bf = ldfrag2(L + ML_Q + 16 * I * MS, MS, l);
                const int tloc = 16 * I + c16, s0 = 16 * J + 4 * g;
                const f32x4 av = *(const LAS f32x4*)(L + ML_TA + (c * 64 + s0) * 4); const float mu = *(const LAS float*)(L + ML_TMU + (c * 64 + tloc) * 4);
                f32x4 at = (f32x4){0.f, 0.f, 0.f, 0.f};
                at = MFMA16(af.k0, bf.k0, at); at = MFMA16(af.k1, bf.k1, at);
                float pr[4];
#pragma unroll
                for (int r = 0; r < 4; ++r) pr[r] = (s0 + r <= tloc) ? at[r] * ex2(av[r] - mu) : 0.f;
                ptile[rep].x = cvtpk(pr[0], pr[1]); ptile[rep].y = cvtpk(pr[2], pr[3]); paddr[rep] = ML_P + tloc * MS + s0 * 2;
            } }
        f32x4 accO[4], accOA = (f32x4){0.f, 0.f, 0.f, 0.f};
        const float carry = *(const LAS float*)(L + ML_SC + c * 4);
        const BF2 vf = ldfrag2(L + ML_VT + 16 * w * MS, MS, l);
        { const BF2 cf = ldfrag2(L + ML_CT + 16 * w * MS, MS, l);
            const BF2 q0 = ldfrag2(L + ML_Q + 0 * 16 * MS, MS, l), q1 = ldfrag2(L + ML_Q + 1 * 16 * MS, MS, l), q2 = ldfrag2(L + ML_Q + 2 * 16 * MS, MS, l), q3 = ldfrag2(L + ML_Q + 3 * 16 * MS, MS, l);
#pragma unroll
            for (int I = 0; I < 4; ++I) accO[I] = (f32x4){0.f, 0.f, 0.f, 0.f};
            accO[0] = MFMA16(q0.k0, cf.k0, accO[0]); accO[1] = MFMA16(q1.k0, cf.k0, accO[1]); accO[2] = MFMA16(q2.k0, cf.k0, accO[2]); accO[3] = MFMA16(q3.k0, cf.k0, accO[3]);
            accO[0] = MFMA16(q0.k1, cf.k1, accO[0]); accO[1] = MFMA16(q1.k1, cf.k1, accO[1]); accO[2] = MFMA16(q2.k1, cf.k1, accO[2]); accO[3] = MFMA16(q3.k1, cf.k1, accO[3]); }
        { const BF2 k0f = ldfrag2(L + ML_KTT + 0 * 16 * MS, MS, l), k1f = ldfrag2(L + ML_KTT + 1 * 16 * MS, MS, l), k2f = ldfrag2(L + ML_KTT + 2 * 16 * MS, MS, l), k3f = ldfrag2(L + ML_KTT + 3 * 16 * MS, MS, l);
#pragma unroll
            for (int I = 0; I < 4; ++I) accC[I] = accC[I] * carry;
            accC[0] = MFMA16(k0f.k0, vf.k0, accC[0]); accC[1] = MFMA16(k1f.k0, vf.k0, accC[1]); accC[2] = MFMA16(k2f.k0, vf.k0, accC[2]); accC[3] = MFMA16(k3f.k0, vf.k0, accC[3]);
            accC[0] = MFMA16(k0f.k1, vf.k1, accC[0]); accC[1] = MFMA16(k1f.k1, vf.k1, accC[1]); accC[2] = MFMA16(k2f.k1, vf.k1, accC[2]); accC[3] = MFMA16(k3f.k1, vf.k1, accC[3]); }
#pragma unroll
        for (int I = 0; I < 4; ++I) { const f32x4 iw = *(const LAS f32x4*)(L + ML_TIW + (c * 64 + 16 * I + 4 * g) * 4); accO[I] = accO[I] * iw; }
        BF2 af = vf;
        if (w < 4) { const BF2 cfa = ldfrag2(L + ML_CT + 128 * MS, MS, l), qw_ = ldfrag2(L + ML_Q + 16 * w * MS, MS, l), kw_ = ldfrag2(L + ML_KTT + 16 * w * MS, MS, l);
            af = ldfrag2(L + ML_VT + 128 * MS, MS, l);
            const f32x4 iwa = *(const LAS f32x4*)(L + ML_TIW + (c * 64 + 16 * w + 4 * g) * 4);
            accCA = accCA * carry;
            accOA = MFMA16(qw_.k0, cfa.k0, accOA); accCA = MFMA16(kw_.k0, af.k0, accCA); accOA = MFMA16(qw_.k1, cfa.k1, accOA); accCA = MFMA16(kw_.k1, af.k1, accCA);
            accOA = accOA * iwa; }
#pragma unroll
        for (int rep = 0; rep < 2; ++rep) if (paddr[rep] >= 0) *(LAS v2u*)(L + paddr[rep]) = ptile[rep];
        v4u pf0 = (v4u){0u, 0u, 0u, 0u}, pf1 = pf0, pg0 = pf0, pg1 = pf0;
        if (dir) { pf0 = *(const v4u*)optr; pf1 = *(const v4u*)(optr + 8); const bf16* gp = P + orow * LDP + 3584 + head * 128 + 16 * qpart; pg0 = __builtin_nontemporal_load((const v4u*)gp); pg1 = __builtin_nontemporal_load((const v4u*)(gp + 8)); }
        PS_END(7); __syncthreads(); PS_END(10);
        { const BF2 p0 = ldfrag2(L + ML_P + 0 * 16 * MS, MS, l), p1 = ldfrag2(L + ML_P + 1 * 16 * MS, MS, l), p2 = ldfrag2(L + ML_P + 2 * 16 * MS, MS, l), p3 = ldfrag2(L + ML_P + 3 * 16 * MS, MS, l);
            accO[0] = MFMA16(p0.k0, vf.k0, accO[0]); accO[1] = MFMA16(p1.k0, vf.k0, accO[1]); accO[2] = MFMA16(p2.k0, vf.k0, accO[2]); accO[3] = MFMA16(p3.k0, vf.k0, accO[3]);
            accO[0] = MFMA16(p0.k1, vf.k1, accO[0]); accO[1] = MFMA16(p1.k1, vf.k1, accO[1]); accO[2] = MFMA16(p2.k1, vf.k1, accO[2]); accO[3] = MFMA16(p3.k1, vf.k1, accO[3]);
            if (w < 4) { const BF2 pw_ = ldfrag2(L + ML_P + 16 * w * MS, MS, l); accOA = MFMA16(pw_.k0, af.k0, accOA); accOA = MFMA16(pw_.k1, af.k1, accOA); } }
#pragma unroll
        for (int m = 0; m < 4; ++m) { v2u o; o.x = cvtpk(accC[m][0], accC[m][1]); o.y = cvtpk(accC[m][2], accC[m][3]); *(LAS v2u*)(L + ML_CT + (16 * w + c16) * MS + (16 * m + 4 * g) * 2) = o; }
        if (w < 4) { v2u o; o.x = cvtpk(accCA[0], accCA[1]); o.y = cvtpk(accCA[2], accCA[3]); *(LAS v2u*)(L + ML_CT + (128 + c16) * MS + (16 * w + 4 * g) * 2) = o;
            if (c16 == 0) { const f32x4 em = *(const LAS f32x4*)(L + ML_TEM + (c * 64 + 16 * w + 4 * g) * 4); f32x4 ri;
#pragma unroll
                for (int r = 0; r < 4; ++r) ri[r] = __builtin_amdgcn_rcpf(fmaxf(fabsf(accOA[r]), em[r]));
                *(LAS f32x4*)(L + ML_TRI + (16 * w + 4 * g) * 4) = ri; } }
#pragma unroll
        for (int I = 0; I < 4; ++I)
#pragma unroll
            for (int r = 0; r < 4; ++r) *(LAS float*)(L + ML_OT + (16 * I + 4 * g + r) * OT_S + (16 * w + c16) * 4) = accO[I][r];
        PS_END(8); __syncthreads(); PS_END(10);
        { float ov[16]; const float ri = *(const LAS float*)(L + ML_TRI + qt * 4);
#pragma unroll
            for (int q = 0; q < 4; ++q) { const f32x4 t4 = *(const LAS f32x4*)(L + ML_OT + qt * OT_S + (16 * qpart + 4 * q) * 4); ov[4 * q] = t4.x * ri; ov[4 * q + 1] = t4.y * ri; ov[4 * q + 2] = t4.z * ri; ov[4 * q + 3] = t4.w * ri; }
            if (dir) {
                float fo[16], gt[16];
#pragma unroll
                for (int q = 0; q < 4; ++q) { fo[2 * q] = bflo(pf0[q]); fo[2 * q + 1] = bfhi(pf0[q]); fo[8 + 2 * q] = bflo(pf1[q]); fo[8 + 2 * q + 1] = bfhi(pf1[q]);
                    gt[2 * q] = bflo(pg0[q]); gt[2 * q + 1] = bfhi(pg0[q]); gt[8 + 2 * q] = bflo(pg1[q]); gt[8 + 2 * q + 1] = bfhi(pg1[q]); }
                float ss = 0.f;
#pragma unroll
                for (int i = 0; i < 16; ++i) { ov[i] += fo[i]; ss += ov[i] * ov[i]; }
                ss += __shfl_xor(ss, 1); ss += __shfl_xor(ss, 2); ss += __shfl_xor(ss, 4);
                const float rstd = __builtin_amdgcn_rsqf(ss * (1.f / 128.f) + EPSN);
#pragma unroll
                for (int q = 0; q < 4; ++q) { const f32x4 nw4 = *(const LAS f32x4*)(L + ML_NW + (16 * qpart + 4 * q) * 4);
                    ov[4 * q] *= rstd * nw4.x * gt[4 * q]; ov[4 * q + 1] *= rstd * nw4.y * gt[4 * q + 1]; ov[4 * q + 2] *= rstd * nw4.z * gt[4 * q + 2]; ov[4 * q + 3] *= rstd * nw4.w * gt[4 * q + 3]; }
            }
            *(v4u*)optr = (v4u){cvtpk(ov[0], ov[1]), cvtpk(ov[2], ov[3]), cvtpk(ov[4], ov[5]), cvtpk(ov[6], ov[7])};
            *(v4u*)(optr + 8) = (v4u){cvtpk(ov[8], ov[9]), cvtpk(ov[10], ov[11]), cvtpk(ov[12], ov[13]), cvtpk(ov[14], ov[15])}; }
        PS_END(9);
    }
#undef ML_ROW3
#undef ML_LOAD_ALL
#undef ML_STATE_LOAD
}
__device__ __forceinline__ void final_norm_phase(const Args& a, const Ctx& T, const bf16* X3) {
    f32x4 wv[4];
#pragma unroll
    for (int j = 0; j < 4; ++j) wv[j] = *((const f32x4*)a.in[I_FNW] + T.lane + 64 * j);
    f32x4 v[4];
    const int m0 = T.G == 256 ? (T.vcu >> 5) * 2048 + (T.vcu & 31) * NWAVES + T.wave : T.gw, mstep = T.G == 256 ? 256 : T.NGW, mend = T.G == 256 ? (T.vcu >> 5) * 2048 + 2048 : MLAT;
    if (m0 < mend) norm_load_row(v, X3, true, nullptr, m0, T.lane);
    for (int m = m0; m < mend; m += mstep) {
        f32x4 cur[4]; float s = 0.f;
#pragma unroll
        for (int j = 0; j < 4; ++j) { cur[j] = v[j]; s += (v[j].x * v[j].x + v[j].y * v[j].y) + (v[j].z * v[j].z + v[j].w * v[j].w); }
        { const int mn = m + mstep; if (mn < mend) norm_load_row(v, X3, true, nullptr, mn, T.lane); }
        const float rstd = __builtin_amdgcn_rsqf(wave_sum(s) * (1.f / DM) + EPSN);
        f32x4* xr = (f32x4*)(a.out + (size_t)m * DM) + T.lane;
#pragma unroll
        for (int j = 0; j < 4; ++j) __builtin_nontemporal_store(cur[j] * rstd * wv[j], xr + 64 * j);
    }
}

__device__ __forceinline__ void gates_phase(const Args& a, const Ctx& T) {
    const bf16* XNc = (const bf16*)(a.ws + WS_XN); const bf16* WG = (const bf16*)(a.ws + WS_WG); float* GT = (float*)(a.ws + WS_GATES);
    const int l = T.lane, r = l & 15, g = l >> 4;
    const float bias = a.in[I_MLGB][r];
    for (int rg = T.gw; rg < MALL / 16; rg += T.NGW) {
        f32x4 acc = (f32x4){0.f, 0.f, 0.f, 0.f};
        const bf16* pa = XNc + (size_t)(16 * rg + r) * DM + 8 * g; const bf16* pb = WG + (size_t)r * DM + 8 * g;
#pragma unroll 8
        for (int ks = 0; ks < 32; ++ks) { const bf16x8 av = __builtin_nontemporal_load((const bf16x8*)(pa + ks * 32)); const bf16x8 bv = *(const bf16x8*)(pb + ks * 32); acc = MFMA16(av, bv, acc); }
#pragma unroll
        for (int q = 0; q < 4; ++q) GT[(size_t)(16 * rg + 4 * g + q) * 16 + r] = acc[q] + bias;
    }
}

__global__ void __launch_bounds__(NTHREADS, 2) fwd_kernel(Args a) {
    extern __shared__ __attribute__((aligned(16))) unsigned char lds_raw[];
    Ctx T;
    T.lds = (LAS unsigned char*)lds_raw;
    T.tid = threadIdx.x; T.lane = T.tid & 63; T.wave = __builtin_amdgcn_readfirstlane(T.tid >> 6);
    T.G = gridDim.x; { const int bx = blockIdx.x; T.vcu = (T.G % 8 == 0) ? (bx % 8) * (T.G / 8) + bx / 8 : bx; }
    T.gw = T.vcu * NWAVES + T.wave; T.NGW = T.G * NWAVES; T.gwr = (NWAVES - 1 - T.wave) * T.G + T.vcu;
    volatile LAS unsigned* MISC = (volatile LAS unsigned*)(T.lds + MISC_OFF);
    for (int u = T.tid; u < (LDS_BYTES - LDSCTL_OFF) / 4; u += NTHREADS) ((LAS unsigned*)(T.lds + LDSCTL_OFF))[u] = 0u;
    __syncthreads();
    XcdBarrier bar; bar.bar = (unsigned*)(a.ws + WS_CTL) + CW_BAR; bar.x = 0; bar.st = nullptr;
    const bool multi = (a.ph_hi - a.ph_lo) > 1;
    if (multi) bar = xcd_barrier_post((unsigned*)(a.ws + WS_CTL) + CW_BAR, MISC + 8);
    const int lo = a.ph_lo, hi = a.ph_hi;
#ifndef REP_MASK
#define REP_MASK 0
#endif
#define IN(k) (lo <= (k) && (k) < hi)
#ifndef PROF_K
#define PROF_K -1
#endif
#define STAMP(k) do { if (PROF_K >= 0 && ((k) == PROF_K || (k) == PROF_K + 1) && blockIdx.x == 0 && T.tid == 0) { const unsigned long long t_ = __builtin_amdgcn_s_memrealtime(); MISC[16 + 2 * ((k) - PROF_K)] = (unsigned)t_; MISC[17 + 2 * ((k) - PROF_K)] = (unsigned)(t_ >> 32); } } while (0)
#define REPS(k) for (int rep_ = 0; rep_ < (((REP_MASK >> (k)) & 1) ? 2 : 1); ++rep_)
#if (REP_MASK >> 18) & 1
#define SEAM(k) do { if (IN(k) && IN((k) + 1)) { xcd_barrier(bar); xcd_barrier(bar); } } while (0)
#else
#define SEAM(k) do { if (IN(k) && IN((k) + 1)) xcd_barrier(bar); STAMP((k) + 1); } while (0)
#endif
#define SEAM2(k, ...) do { const bool sync_ = IN(k) && IN((k) + 1); if (sync_) xcd_barrier_arrive(bar); if (IN((k) + 1)) { __VA_ARGS__; } if (sync_) xcd_barrier_wait<true>(bar); else __syncthreads(); STAMP((k) + 1); } while (0)
#define SEAML(k) do { if (IN(k) && IN((k) + 1)) { if (xloc) xcd_local_barrier(bar); else xcd_barrier(bar); } STAMP((k) + 1); } while (0)
    bf16* XN = (bf16*)(a.ws + WS_XN); bf16* HB = (bf16*)(a.ws + WS_PROJ); bf16* PROJ = (bf16*)(a.ws + WS_PROJ);
    const float* mods = (const float*)(a.ws + WS_MODS);
    bf16* XB1 = (bf16*)a.out; bf16* XB2 = (bf16*)(a.ws + WS_QK); bf16* XB3 = (bf16*)(a.ws + WS_PROJ + 96 * MiB);
    const int bx = (int)blockIdx.x;

    STAMP(0);
    if (IN(0)) REPS(0) { mods_phase(a, T, 0, 64, T.vcu, T.G); convert_ffn(a, T, a.in[I_F1W1], a.in[I_F1W2], T.NGW, CF_I1); }
    SEAM2(0, convert_ffn(a, T, a.in[I_F1W1], a.in[I_F1W2], 0, T.NGW < CF_I1 ? T.NGW : CF_I1));
    if (IN(1)) norm_mod_rows<false, false>(a, T, a.in[I_X], a.in[I_CTX], MALL, a.in[I_N1W], 0, 1);
    SEAM2(1, { convert_ffn(a, T, a.in[I_F1W1], a.in[I_F1W2], CF_I1, CF_I1 + CF_I2);
        if (T.tid < 64) { const int e = bx * 64 + T.tid; if (e < 16384) { const int q = e >> 10, k = e & 1023; ((bf16*)(a.ws + WS_WG))[q * 1024 + k] = (bf16)f2bf(a.in[I_WIN][(size_t)k * DIN + NPROJ + q]); } } });
    if (IN(2)) REPS(2) { pg8::Gemm g{XN, (const bf16*)(a.ws + WS_W1), MALL, 2 * DFF, DM, DM}; pg8::StaticOrder S; S.init(MALL, 2 * DFF, T.G, bx);
        pg8::EpiSwiglu E{HB, DFF}; pg8::gemm_phase<pg8::EpiSwiglu, pg8::StaticOrder, true, true>(T.lds, g, S, E);
        const int nfull = (MALL / 256) * (2 * DFF / 256) % T.G;
        if (nfull > 0 && bx >= nfull) mods_phase(a, T, 64, 72, bx - nfull, T.G - nfull); else if (nfull == 0) mods_phase(a, T, 64, 72, T.vcu, T.G); }
    SEAM2(2, convert_mix(a, T, 0, CM_I1));
    if (IN(3)) { pg8::Gemm g{HB, (const bf16*)(a.ws + WS_W2), MALL, DM, DFF, DFF}; pg8::DownOrder S; S.lat.init(MLAT, DM, T.G, bx); S.c = bx;
        pg8::EpiDown1 E{a.in[I_X], XB1, mods + 2 * 1024, 0.5f, (bf16*)(a.ws + WS_SLAB)}; pg8::gemm_phase<pg8::EpiDown1, pg8::DownOrder, true, true>(T.lds, g, S, E); }
    SEAM2(3, convert_ffn(a, T, a.in[I_F2W1], a.in[I_F2W2], 0, 1056));
    if (IN(4)) REPS(4) norm_mod_rows<true, true>(a, T, XB1, a.in[I_CTX], MALL, a.in[I_N2W], 3, 4);
    SEAM2(4, convert_ffn(a, T, a.in[I_F2W1], a.in[I_F2W2], 1056, 2112));
    if (IN(5)) { pg8::Gemm g{XN, (const bf16*)(a.ws + WS_WIN), MALL, NPROJ, DM, DM}; pg8::ProjOrder S; S.lat.init(MLAT, NPROJ, T.G, bx); S.c = bx;
        pg8::EpiProjAll E{{PROJ, LDP}, (bf16*)(a.ws + WS_SLAB2)}; pg8::gemm_phase<pg8::EpiProjAll, pg8::ProjOrder, true, true>(T.lds, g, S, E);
        if (T.G == 256 && bx >= 144) {
            Ctx TL = T; TL.gwr = (NWAVES - 1 - T.wave) * 112 + (bx - 144); TL.NGW = 112 * NWAVES;
            convert_ffn(a, TL, a.in[I_F2W1], a.in[I_F2W2], 3168, CF_I1 + CF_I2); TL.gwr = (TL.gwr + 448) % 896; convert_mix(a, TL, CM_I1, CM_I1 + CM_I2); } }
    SEAM2(5, gates_phase(a, T));
    if (IN(6)) { ctx_combine(a, T); conv_phase(a, T); }
    SEAM2(6, convert_ffn(a, T, a.in[I_F2W1], a.in[I_F2W2], 2112, 3168));
    const bool xloc = multi && MISC[8 + 5] != 0u;
    int bxx = bx;
    if (xloc) { T.vcu = __builtin_amdgcn_readfirstlane((int)bar.x * 32 + (int)MISC[8 + 4]); T.gw = T.vcu * NWAVES + T.wave; T.gwr = (NWAVES - 1 - T.wave) * T.G + T.vcu; bxx = (T.vcu & 31) * 8 + (T.vcu >> 5); }
    if (IN(7)) REPS(7) { hg_pass1_items(a, T, T.vcu, T.G, 256); ml_pass1_items(a, T, T.vcu, T.G, 256); }
    SEAML(7);
    if (IN(8)) pass2_all(a, T, xloc);
    SEAML(8);
    if (IN(9)) REPS(9) { for (int it = T.vcu; it < 256; it += T.G) hg_pass3_item(a, T, it, XN); for (int it = T.vcu; it < 256; it += T.G) ml_pass3_item(a, T, it, XN); }
    SEAM(9);
    if (IN(10)) { pg8::Gemm g{XN, (const bf16*)(a.ws + WS_WOUT), MLAT, DM, DM, DM}; pg8::StaticOrder S; S.init(MLAT, DM, T.G, bxx);
        pg8::EpiResidB<true> E{XB1, XB2, mods + 5 * 1024, 1.0f}; pg8::gemm_phase<pg8::EpiResidB<true>, pg8::StaticOrder, true, true>(T.lds, g, S, E); }
    SEAML(10);
    if (IN(11)) REPS(11) norm_mod_rows<false, true>(a, T, XB2, nullptr, MLAT, a.in[I_N3W], 6, 7);
    SEAML(11);
    if (IN(12)) REPS(12) { pg8::Gemm g{XN, (const bf16*)(a.ws + WS_W1), MLAT, 2 * DFF, DM, DM}; pg8::HalfTailOrder S; S.init(MLAT, 2 * DFF, T.G, bxx);
        pg8::EpiSwiglu E{HB, DFF}; pg8::gemm_phase<pg8::EpiSwiglu, pg8::HalfTailOrder, true, true>(T.lds, g, S, E); }
    SEAML(12);
    if (IN(13)) { pg8::Gemm g{HB, (const bf16*)(a.ws + WS_W2), MLAT, DM, DFF, DFF}; pg8::StaticOrder S; S.init(MLAT, DM, T.G, bxx);
        pg8::EpiResidB<true> E{XB2, XB3, mods + 8 * 1024, 0.5f}; pg8::gemm_phase<pg8::EpiResidB<true>, pg8::StaticOrder, true, true>(T.lds, g, S, E); }
    if (IN(13) && IN(14) && xloc) {
        xcd_barrier_arrive(bar); xcd_local_barrier(bar);
        const int m0 = (T.vcu >> 5) * 2048 + (T.vcu & 31) * NWAVES + T.wave;
        v2u fx[8][4]; float frs[8];
#pragma unroll
        for (int i = 0; i < 8; ++i) { const v2u* xr = (const v2u*)(XB3 + (size_t)(m0 + 256 * i) * DM) + T.lane;
#pragma unroll
            for (int j = 0; j < 4; ++j) fx[i][j] = __builtin_nontemporal_load(xr + 64 * j); }
#pragma unroll
        for (int i = 0; i < 8; ++i) { float s_ = 0.f;
#pragma unroll
            for (int j = 0; j < 4; ++j) { const v2u w = fx[i][j]; const float e0 = bflo(w.x), e1 = bfhi(w.x), e2 = bflo(w.y), e3 = bfhi(w.y); s_ += (e0 * e0 + e1 * e1) + (e2 * e2 + e3 * e3); }
            frs[i] = __builtin_amdgcn_rsqf(wave_sum(s_) * (1.f / DM) + EPSN); }
        xcd_barrier_wait<true>(bar); STAMP(14);
        f32x4 fw[4];
#pragma unroll
        for (int j = 0; j < 4; ++j) fw[j] = *((const f32x4*)a.in[I_FNW] + T.lane + 64 * j);
#pragma unroll
        for (int i = 0; i < 8; ++i) { f32x4* xr = (f32x4*)(a.out + (size_t)(m0 + 256 * i) * DM) + T.lane;
#pragma unroll
            for (int j = 0; j < 4; ++j) { const v2u w = fx[i][j]; const f32x4 v = (f32x4){bflo(w.x), bfhi(w.x), bflo(w.y), bfhi(w.y)};
                __builtin_nontemporal_store(v * frs[i] * fw[j], xr + 64 * j); } }
    }
    else { SEAM(13); if (IN(14)) final_norm_phase(a, T, XB3); }
    STAMP(15);
    if (PROF_S >= 0 && blockIdx.x == 0 && T.tid == 0) { const unsigned long long dt_ = ((((unsigned long long)MISC[23]) << 32) | MISC[22]) * 8ull, te_ = __builtin_amdgcn_s_memrealtime(); while (__builtin_amdgcn_s_memrealtime() - te_ < dt_) __builtin_amdgcn_s_sleep(8); }
    if (PROF_K >= 0 && blockIdx.x == 0 && T.tid == 0) { const unsigned long long t0_ = ((unsigned long long)MISC[17] << 32) | MISC[16], t1_ = ((unsigned long long)MISC[19] << 32) | MISC[18];
        const unsigned long long dt_ = (t1_ - t0_) * 8ull, te_ = __builtin_amdgcn_s_memrealtime(); while (__builtin_amdgcn_s_memrealtime() - te_ < dt_) __builtin_amdgcn_s_sleep(8); }
#undef IN
#undef SEAM
#undef SEAM2
#undef SEAML
}

extern "C" void kernel_launch(void* const* d_in, const int* in_sizes, int n_in, void* d_out, int out_size, void* d_ws, size_t ws_size, hipStream_t stream) {
    static int grid = 0;
    if (grid == 0) {
        if (n_in != 22 || out_size != MLAT * DM || ws_size < WS_END) { fprintf(stderr, "kernel_launch: unexpected shapes (n_in %d out %d ws %zu)\n", n_in, out_size, ws_size); grid = -1; return; }
        int dev = 0, cus = 0;
        if (hipGetDevice(&dev) != hipSuccess || hipDeviceGetAttribute(&cus, hipDeviceAttributeMultiprocessorCount, dev) != hipSuccess) { grid = -1; return; }
        if (hipFuncSetAttribute((const void*)fwd_kernel, hipFuncAttributeMaxDynamicSharedMemorySize, LDS_BYTES) != hipSuccess) { fprintf(stderr, "kernel_launch: hipFuncSetAttribute failed\n"); grid = -1; return; }
        int per_cu = 0;
        if (hipOccupancyMaxActiveBlocksPerMultiprocessor(&per_cu, (const void*)fwd_kernel, NTHREADS, LDS_BYTES) != hipSuccess || per_cu < 1) { fprintf(stderr, "kernel_launch: occupancy query failed (%d blocks per CU)\n", per_cu); grid = -1; return; }
        (void)hipGetLastError();
        grid = cus;
    }
    if (grid < 0) return;
    (void)hipMemsetAsync((char*)d_ws + WS_CTL, 0, CTL_ZERO_BYTES, stream);
    Args a{};
    for (int i = 0; i < 22; ++i) a.in[i] = (const float*)d_in[i];
    a.out = (float*)d_out; a.ws = (unsigned char*)d_ws;
#if ONE_LAUNCH
    a.ph_lo = 0; a.ph_hi = NPHASES;
    hipLaunchKernelGGL(fwd_kernel, dim3(grid), dim3(NTHREADS), LDS_BYTES, stream, a);
#else
    for (int p = 0; p < NPHASES; ++p) { a.ph_lo = p; a.ph_hi = p + 1; hipLaunchKernelGGL(fwd_kernel, dim3(grid), dim3(NTHREADS), LDS_BYTES, stream, a); }
#endif
}
```
